# Optimizing an MI355X kernel written in HIP

```python
import jax, jax.numpy as jnp
from jax import lax
import numpy as np

D_MODEL = 1024
BATCH = 32
SEQ = 256
DEPTH = 2
DEC_BATCH = 4
DEC_SEQ = 1024
PAST_LEN = 256

GRID_W = 64
HEAD_DIM = 64
N_RWKV_HEADS = 8
RWKV_WIDTH = N_RWKV_HEADS * HEAD_DIM
N_Q_HEADS = 8
N_KV_HEADS = 2
GQA_GROUP = N_Q_HEADS // N_KV_HEADS
ATTN_WIDTH = N_Q_HEADS * HEAD_DIM
KV_WIDTH = N_KV_HEADS * HEAD_DIM
DECAY_RANK = 64
ICLR_RANK = 64
GATE_RANK = 128
D_FF = 4 * D_MODEL
Q_BLOCK = 128
ROPE_THETA = 10000.0
ROPE_FREQS = HEAD_DIM // 4
N_DIRS = 2
N_MOD = 6
NORM_EPS = 1e-6
GN_EPS = 64e-5
DECAY_SCALE = 0.606531
SPLIT_SIZES = (RWKV_WIDTH, RWKV_WIDTH, RWKV_WIDTH, DECAY_RANK, ICLR_RANK, GATE_RANK,
               ATTN_WIDTH, KV_WIDTH, KV_WIDTH, 2 * D_MODEL)
D_IN = 3 * RWKV_WIDTH + DECAY_RANK + ICLR_RANK + GATE_RANK + ATTN_WIDTH + 2 * KV_WIDTH + 2 * D_MODEL

kernel_name = "hybrid_rwkv7_gqa_dit_step"

F32 = jnp.float32


def rms_norm(x, g):
    xf = x.astype(F32)
    y = xf * lax.rsqrt(jnp.mean(xf * xf, axis=-1, keepdims=True) + NORM_EPS)
    return (y * g.astype(F32)).astype(x.dtype)


def centred_shift(z):
    zp = jnp.pad(z, ((0, 0), (1, 1), (0, 0)))
    return 0.5 * (zp[:, :-2] + zp[:, 2:])


def axial_rope_tables(n_rows):
    rows = jnp.repeat(jnp.arange(n_rows, dtype=F32), GRID_W)
    cols = jnp.tile(jnp.arange(GRID_W, dtype=F32), n_rows)
    half = HEAD_DIM // 2
    freqs = 1.0 / (ROPE_THETA ** (jnp.arange(0, half, 2, dtype=F32) / half))
    ang = jnp.stack([rows[:, None] * freqs, cols[:, None] * freqs], axis=1)
    return jnp.cos(ang), jnp.sin(ang)


def apply_rope(x, cos, sin):
    B, T, H, _ = x.shape
    xr = x.astype(F32).reshape(B, T, H, 2, 2, ROPE_FREQS)
    x1, x2 = xr[..., 0, :], xr[..., 1, :]
    c = cos[None, :, None]
    s = sin[None, :, None]
    out = jnp.stack([x1 * c - x2 * s, x2 * c + x1 * s], axis=-2)
    return out.reshape(B, T, H, HEAD_DIM).astype(x.dtype)


def block_attention(q, k, v):
    B, T = q.shape[0], q.shape[1]
    nb = T // Q_BLOCK
    qb = q.reshape(B, nb, Q_BLOCK, N_KV_HEADS, GQA_GROUP, HEAD_DIM).transpose(1, 0, 2, 3, 4, 5)
    scale = HEAD_DIM ** -0.5

    def one_block(q_blk):
        s = jnp.einsum('bqhgd,bkhd->bhgqk', q_blk, k).astype(F32) * scale
        p = jax.nn.softmax(s, axis=-1)
        return jnp.einsum('bhgqk,bkhd->bqhgd', p.astype(v.dtype), v)

    o = lax.map(one_block, qb)
    return o.transpose(1, 0, 2, 3, 4, 5).reshape(B, T, ATTN_WIDTH)


def wkv_scan(S0, r, w, kt, v, kh, a):
    xs = tuple(jnp.moveaxis(z.astype(F32), 2, 0) for z in (r, w, kt, v, kh, a))

    def step(S, inp):
        r_t, w_t, kt_t, v_t, kh_t, a_t = inp
        S_kh = jnp.einsum('bdhvk,bdhk->bdhv', S, kh_t)
        S = S * w_t[..., None, :] - S_kh[..., :, None] * (a_t * kh_t)[..., None, :] \
            + v_t[..., :, None] * kt_t[..., None, :]
        return S, jnp.einsum('bdhvk,bdhk->bdhv', S, r_t)

    S_fin, ys = lax.scan(step, S0.astype(F32), xs)
    return S_fin, jnp.moveaxis(ys, 0, 2)


def rwkv_branch(r_p, k_p, v_p, lw, la, lg, S0, P, l):
    B, T, C = r_p.shape
    dt = r_p.dtype
    mu = P['rwkv_mu'][l]
    r = r_p + mu[0] * (centred_shift(r_p) - r_p)
    k = k_p + mu[1] * (centred_shift(k_p) - k_p)
    v = v_p + mu[2] * (centred_shift(v_p) - v_p)
    heads = lambda z: z.reshape(z.shape[:-1] + (N_RWKV_HEADS, HEAD_DIM))
    kkf = heads(k * P['rwkv_k_k'][l]).astype(F32)
    kh = kkf * lax.rsqrt(jnp.sum(kkf * kkf, axis=-1, keepdims=True) + 1e-12)
    w_raw = jnp.einsum('btr,drc->bdtc', jnp.tanh(lw), P['decay_up'][l]) + P['decay_w0'][l][None, :, None, :]
    w = jnp.exp(-DECAY_SCALE * jax.nn.sigmoid(w_raw.astype(F32)))
    a = jax.nn.sigmoid((jnp.einsum('btr,drc->bdtc', la, P['iclr_up'][l])
                        + P['iclr_a0'][l][None, :, None, :]).astype(F32))
    kt = k[:, None].astype(F32) * (1.0 + (a - 1.0) * P['rwkv_k_a'][l].astype(F32))
    both = lambda z: jnp.stack([z, jnp.flip(z, axis=1)], axis=1)
    orient = lambda z: jnp.stack([z[:, 0], jnp.flip(z[:, 1], axis=1)], axis=1)
    rh, vh = heads(r), heads(v)
    kt_h = heads(kt)
    S_fin, y = wkv_scan(S0, both(rh), orient(heads(w)), orient(kt_h), both(vh), both(kh), orient(heads(a)))
    y = y[:, 0] + jnp.flip(y[:, 1], axis=1)
    mean = jnp.mean(y, axis=-1, keepdims=True)
    var = jnp.mean(jnp.square(y - mean), axis=-1, keepdims=True)
    yn = (y - mean) * lax.rsqrt(var + GN_EPS) * P['gn_w'][l].reshape(N_RWKV_HEADS, HEAD_DIM) \
        + P['gn_b'][l].reshape(N_RWKV_HEADS, HEAD_DIM)
    bonus = jnp.einsum('bthn,bdthn,hn->bth', rh.astype(F32), kt_h, P['rwkv_r_k'][l].astype(F32))[..., None] \
        * vh.astype(F32)
    g = jax.nn.sigmoid(lg) @ P['gate_up'][l]
    out = (yn + bonus).reshape(B, T, C).astype(dt) * g
    return out, S_fin.astype(dt)


def mixer(h, l, P, rope, ctx_k, ctx_v, S0):
    B, T, _ = h.shape
    proj = h @ P['w_in'][l]
    idx = np.cumsum(SPLIT_SIZES)[:-1].tolist()
    r_p, k_p, v_p, lw, la, lg, q_p, ka_p, va_p, gates = jnp.split(proj, idx, axis=-1)
    o_r, S_fin = rwkv_branch(r_p, k_p, v_p, lw, la, lg, S0, P, l)
    q = rms_norm(q_p.reshape(B, T, N_Q_HEADS, HEAD_DIM), P['q_gain'][l])
    k = rms_norm(ka_p.reshape(B, T, N_KV_HEADS, HEAD_DIM), P['k_gain'][l])
    v = va_p.reshape(B, T, N_KV_HEADS, HEAD_DIM)
    if rope is not None:
        q = apply_rope(q, rope[0], rope[1])
        k = apply_rope(k, rope[0], rope[1])
    k_own, v_own = k, v
    if ctx_k is not None:
        k = jnp.concatenate([ctx_k, k], axis=1)
        v = jnp.concatenate([ctx_v, v], axis=1)
    o_a = block_attention(q, k, v)
    g_r, g_a = jnp.split(gates, 2, axis=-1)
    merged = jax.nn.sigmoid(g_r) * (o_r @ P['w_br'][l, 0]) + jax.nn.sigmoid(g_a) * (o_a @ P['w_br'][l, 1])
    return merged @ P['w_out'][l], k_own, v_own, S_fin


def trunk_layer(x, cvec, l, P, rope, ctx_k, ctx_v, S0):
    mod = (jax.nn.silu(cvec) @ P['w_mod'][l] + P['b_mod'][l]).reshape(-1, 1, N_MOD * D_MODEL)
    sh1, sc1, g1, sh2, sc2, g2 = jnp.split(mod, N_MOD, axis=-1)
    ng = P['norm_g'][l]
    h = rms_norm(x, ng[0]) * (1.0 + sc1) + sh1
    m, k_new, v_new, S_fin = mixer(h, l, P, rope, ctx_k, ctx_v, S0)
    x = x + g1 * rms_norm(m, ng[1])
    h = rms_norm(x, ng[2]) * (1.0 + sc2) + sh2
    f = jnp.square(jax.nn.relu(h @ P['mlp_up'][l])) @ P['mlp_down'][l]
    x = x + g2 * rms_norm(f, ng[3])
    return x, k_new, v_new, S_fin


def setup_inputs(seed: int = 0) -> dict:
    key = jax.random.key(seed)
    ks = jax.random.split(key, 32)
    nrm = lambda k, shape, s: jax.random.normal(k, shape, F32) * s
    H, N, C = N_RWKV_HEADS, HEAD_DIM, RWKV_WIDTH
    return {
        'x_prompt': nrm(ks[0], (BATCH, SEQ, D_MODEL), 1.0),
        'x_sample': nrm(ks[1], (DEC_BATCH, DEC_SEQ, D_MODEL), 1.0),
        'cache_k': nrm(ks[2], (DEC_BATCH, DEPTH, PAST_LEN, N_KV_HEADS, HEAD_DIM), 1.0),
        'cache_v': nrm(ks[3], (DEC_BATCH, DEPTH, PAST_LEN, N_KV_HEADS, HEAD_DIM), 1.0),
        'state_wkv': nrm(ks[4], (DEC_BATCH, DEPTH, N_DIRS, H, N, N), 0.1),
        'c': nrm(ks[5], (DEC_BATCH, D_MODEL), 1.0),
        'c_ctx': nrm(ks[6], (D_MODEL,), 1.0),
        'w_in': nrm(ks[7], (DEPTH, D_MODEL, D_IN), D_MODEL ** -0.5),
        'w_br': nrm(ks[8], (DEPTH, 2, C, D_MODEL), C ** -0.5),
        'w_out': nrm(ks[9], (DEPTH, D_MODEL, D_MODEL), D_MODEL ** -0.5),
        'w_mod': nrm(ks[10], (DEPTH, D_MODEL, N_MOD * D_MODEL), D_MODEL ** -0.5),
        'b_mod': nrm(ks[11], (DEPTH, N_MOD * D_MODEL), 0.02),
        'norm_g': 1.0 + nrm(ks[12], (DEPTH, 4, D_MODEL), 0.05),
        'mlp_up': nrm(ks[13], (DEPTH, D_MODEL, D_FF), D_MODEL ** -0.5),
        'mlp_down': nrm(ks[14], (DEPTH, D_FF, D_MODEL), D_FF ** -0.5),
        'rwkv_mu': 0.5 + nrm(ks[15], (DEPTH, 3, C), 0.1),
        'rwkv_k_k': 0.85 + nrm(ks[16], (DEPTH, C), 0.05),
        'rwkv_k_a': 1.0 + nrm(ks[17], (DEPTH, C), 0.05),
        'rwkv_r_k': nrm(ks[18], (DEPTH, H, N), 0.1),
        'decay_w0': -1.0 + nrm(ks[19], (DEPTH, N_DIRS, C), 0.5),
        'decay_up': nrm(ks[20], (DEPTH, N_DIRS, DECAY_RANK, C), 0.1),
        'iclr_a0': nrm(ks[21], (DEPTH, N_DIRS, C), 0.3),
        'iclr_up': nrm(ks[22], (DEPTH, N_DIRS, ICLR_RANK, C), 0.1),
        'gate_up': nrm(ks[23], (DEPTH, GATE_RANK, C), GATE_RANK ** -0.5),
        'gn_w': 1.0 + nrm(ks[24], (DEPTH, C), 0.05),
        'gn_b': nrm(ks[25], (DEPTH, C), 0.02),
        'q_gain': 1.0 + nrm(ks[26], (DEPTH, HEAD_DIM), 0.05),
        'k_gain': 1.0 + nrm(ks[27], (DEPTH, HEAD_DIM), 0.05),
    }


def reference(x_prompt, x_sample, cache_k, cache_v, state_wkv, c, c_ctx, w_in, w_br, w_out, w_mod, b_mod,
              norm_g, mlp_up, mlp_down, rwkv_mu, rwkv_k_k, rwkv_k_a, rwkv_r_k, decay_w0, decay_up, iclr_a0,
              iclr_up, gate_up, gn_w, gn_b, q_gain, k_gain):
    P = dict(w_in=w_in, w_br=w_br, w_out=w_out, w_mod=w_mod, b_mod=b_mod, norm_g=norm_g, mlp_up=mlp_up,
             mlp_down=mlp_down, rwkv_mu=rwkv_mu, rwkv_k_k=rwkv_k_k, rwkv_k_a=rwkv_k_a, rwkv_r_k=rwkv_r_k,
             decay_w0=decay_w0, decay_up=decay_up, iclr_a0=iclr_a0, iclr_up=iclr_up, gate_up=gate_up,
             gn_w=gn_w, gn_b=gn_b, q_gain=q_gain, k_gain=k_gain)

    b_ctx = x_prompt.shape[0]
    S_zero = jnp.zeros((b_ctx, N_DIRS, N_RWKV_HEADS, HEAD_DIM, HEAD_DIM), x_prompt.dtype)
    y_prompt = x_prompt
    ks_list, vs_list, ss_list = [], [], []
    for l in range(DEPTH):
        y_prompt, k_l, v_l, s_l = trunk_layer(y_prompt, c_ctx, l, P, None, None, None, S_zero)
        ks_list.append(k_l)
        vs_list.append(v_l)
        ss_list.append(s_l)
    new_cache_k = jnp.stack(ks_list, axis=1)
    new_cache_v = jnp.stack(vs_list, axis=1)
    new_state_wkv = jnp.stack(ss_list, axis=1)

    n_rows = x_sample.shape[1] // GRID_W
    rope = axial_rope_tables(n_rows)
    y_sample = x_sample
    for l in range(DEPTH):
        y_sample, _, _, _ = trunk_layer(y_sample, c, l, P, rope, cache_k[:, l], cache_v[:, l], state_wkv[:, l])

    return (y_prompt, y_sample, new_cache_k, new_cache_v, new_state_wkv)
```

```cpp
#include <hip/hip_runtime.h>
#include <cstdio>
#include <cstdint>

#define GAS __attribute__((address_space(1)))
#define LAS __attribute__((address_space(3)))
typedef _Float16 f16;
typedef _Float16 f16x8 __attribute__((ext_vector_type(8)));
typedef _Float16 f16x4 __attribute__((ext_vector_type(4)));
typedef _Float16 f16x2 __attribute__((ext_vector_type(2)));
typedef float f32x4 __attribute__((ext_vector_type(4)));
typedef unsigned v4u __attribute__((ext_vector_type(4)));

constexpr int D = 1024, DIN = 4608, DFF = 4096, CW = 512, NL = 2, NH = 8, HD = 64;
constexpr int B_CTX = 32, T_CTX = 256, B_SMP = 4, T_SMP = 1024, PAST = 256, KV_SMP = PAST + T_SMP;
constexpr int M_CTX = B_CTX * T_CTX, M_SMP = B_SMP * T_SMP, M = M_CTX + M_SMP;
constexpr int NMOD = 6 * D;
constexpr int PC_R = 0, PC_K = 512, PC_V = 1024, PC_LW = 1536, PC_LA = 1600, PC_LG = 1664, PC_Q = 1792, PC_KA = 2304, PC_VA = 2432, PC_GR = 2560, PC_GA = 3584;
constexpr size_t O_Y = 0, O_CK = (size_t)M * D, O_CV = O_CK + (size_t)B_CTX * NL * T_CTX * 128, O_ST = O_CV + (size_t)B_CTX * NL * T_CTX * 128;
constexpr size_t O_TOTAL = O_ST + (size_t)B_CTX * NL * 2 * NH * HD * HD;

constexpr size_t MiB = 1u << 20;
constexpr size_t WS_CTL = 0, CTL_BYTES = 1 * MiB;
constexpr size_t WS_MOD = 1 * MiB;
constexpr size_t WS_W = 2 * MiB;
constexpr size_t WO_IN = 0, WO_BR = 9 * MiB, WO_OUT = 11 * MiB, WO_UP = 13 * MiB, WO_DN = 21 * MiB, WO_SM = 29 * MiB, WO_G = 29 * MiB + 512 * 1024;
constexpr size_t WS_R1 = 32 * MiB;
constexpr size_t WS_R2 = 140 * MiB;
constexpr size_t WS_R3 = 188 * MiB;
constexpr size_t WS_RK = 212 * MiB;
constexpr size_t WS_R4 = 213 * MiB;
constexpr size_t WS_KN = 237 * MiB;
constexpr size_t WS_VT = 241 * MiB;
constexpr size_t WS_END = 245 * MiB;
constexpr size_t KN_SMP_OFF = (size_t)B_CTX * 2 * T_CTX * 64;

constexpr int NWAVES = 8, NTHREADS = 512;
constexpr int LDS_BYTES = 147456;
constexpr int MISC_OFF = 131072 + 320;

#define XB_TMO      128
#define XB_XCNT(j)  (256  + 64 * (j))
#define XB_XSUB(j)  (1280 + 64 * (j))
#define XB_XGEN(j)  (2304 + 64 * (j))
#define XB_TOP      3328
#define XB_TOPGEN   3392
#define XCD_BAR_WORDS 3456
#define XB_SPIN_CAP (1u << 24)
constexpr int CW_BAR = 4096;

__device__ __forceinline__ unsigned xb_ld(unsigned* p)              { return __hip_atomic_load(p, __ATOMIC_RELAXED, __HIP_MEMORY_SCOPE_AGENT); }
__device__ __forceinline__ unsigned xb_add(unsigned* p, unsigned v) { return __hip_atomic_fetch_add(p, v, __ATOMIC_RELAXED, __HIP_MEMORY_SCOPE_AGENT); }
__device__ __forceinline__ unsigned xb_xcc_id() { return (unsigned)__builtin_amdgcn_s_getreg((3 << 11) | 20) & 0xFu; }
#define XB_SPIN(cond, bar) do { unsigned _sp = 0; while (cond) { __builtin_amdgcn_s_sleep(1); \
    if ((++_sp & 255u) == 0u) { if (xb_ld(&(bar)[XB_TMO])) break; if (_sp > XB_SPIN_CAP) { atomicAdd(&(bar)[XB_TMO], 1u); break; } } } } while (0)

struct XcdBarrier { unsigned* bar; unsigned x; volatile LAS unsigned* st; };

__device__ __forceinline__ XcdBarrier xcd_barrier_post(unsigned* bar, volatile LAS unsigned* st) {
    XcdBarrier b; b.bar = bar; b.x = xb_xcc_id(); b.st = st;
    if (threadIdx.x == 0) (void)xb_add(&bar[XB_XCNT(b.x)], 1u);
    return b;
}
__device__ __forceinline__ void xcd_barrier_complete(unsigned* bar, unsigned x, unsigned& nloc, unsigned& nx) {
    const unsigned G = gridDim.x * gridDim.y * gridDim.z;
    unsigned sum, cnt, mine, sp = 0u;
    for (;;) {
        sum = 0u; cnt = 0u; mine = 0u;
#pragma unroll
        for (unsigned j = 0; j < 16; ++j) { const unsigned c = xb_ld(&bar[XB_XCNT(j)]); sum += c; cnt += (c > 0u) ? 1u : 0u; mine = (j == x) ? c : mine; }
        if (sum == G) break;
        __builtin_amdgcn_s_sleep(1);
        if ((++sp & 255u) == 0u) { if (xb_ld(&bar[XB_TMO])) break; if (sp > XB_SPIN_CAP) { atomicAdd(&bar[XB_TMO], 1u); break; } }
    }
    nloc = mine > 0u ? mine : 1u; nx = cnt > 0u ? cnt : 1u;
}
__device__ __forceinline__ void xcd_barrier(const XcdBarrier& b) {
    asm volatile("s_waitcnt vmcnt(0)" ::: "memory");
    __syncthreads();
    if (threadIdx.x == 0) {
        unsigned* bar = b.bar;
        __builtin_amdgcn_s_waitcnt(0);
        unsigned nloc = b.st[0], nx = b.st[1];
        if (nloc == 0u) { xcd_barrier_complete(bar, b.x, nloc, nx); b.st[0] = nloc; b.st[1] = nx; }
        const unsigned old = xb_add(&bar[XB_XSUB(b.x)], 1u);
        const unsigned gen = old / nloc;
        if (old + 1u == (gen + 1u) * nloc) {
            __builtin_amdgcn_fence(__ATOMIC_RELEASE, "agent");
            asm volatile("s_waitcnt vmcnt(0)" ::: "memory");
            const unsigned og = xb_add(&bar[XB_TOP], 1u);
            const unsigned tg = og / nx;
            if (og + 1u == (tg + 1u) * nx) xb_add(&bar[XB_TOPGEN], 1u);
            else XB_SPIN(xb_ld(&bar[XB_TOPGEN]) == tg, bar);
            __builtin_amdgcn_fence(__ATOMIC_ACQUIRE, "agent");
            xb_add(&bar[XB_XGEN(b.x)], 1u);
            asm volatile("s_waitcnt vmcnt(0)" ::: "memory");
        } else {
            XB_SPIN(xb_ld(&bar[XB_XGEN(b.x)]) == gen, bar);
            __builtin_amdgcn_fence(__ATOMIC_ACQUIRE, "agent");
            asm volatile("s_waitcnt vmcnt(0)" ::: "memory");
        }
    }
    __syncthreads();
}

#define LDS_WAIT() asm volatile("s_waitcnt lgkmcnt(0)" ::: "memory")
__device__ __forceinline__ float wave_sum(float v) {
#pragma unroll
    for (int o = 1; o < 64; o <<= 1) v += __shfl_xor(v, o);
    return v;
}
__device__ __forceinline__ float wave_max(float v) {
#pragma unroll
    for (int o = 1; o < 64; o <<= 1) v = fmaxf(v, __shfl_xor(v, o));
    return v;
}
__device__ __forceinline__ float sigmoidf_(float x) { return 1.0f / (1.0f + __expf(-x)); }
__device__ __forceinline__ unsigned pkh(float lo, float hi) { f16x2 v = {(f16)lo, (f16)hi}; return __builtin_bit_cast(unsigned, v); }
__device__ __forceinline__ void row_info(int row, int& g, int& t, int& T) {
    if (row < M_CTX) { g = 0; t = row & (T_CTX - 1); T = T_CTX; }
    else { const int r = row - M_CTX; g = 1 + (r >> 10); t = r & (T_SMP - 1); T = T_SMP; }
}

struct Params {
    const float* in[28];
    float* out;
    unsigned char* ws;
};
struct Ctx {
    LAS unsigned char* lds;
    int tid, lane, wave, gw, ngw, gt, ngt;
};

__device__ __forceinline__ void conv_item(const float* W, int N, f16* WT, int ldt, int koff, LAS float* scr, int kb, int nb, int lane) {
    const int k0 = 64 * kb, n0 = 32 * nb;
#pragma unroll 8
    for (int i = 0; i < 32; ++i) { const int kk = 2 * i + (lane >> 5); scr[kk * 33 + (lane & 31)] = W[(size_t)(k0 + kk) * N + n0 + (lane & 31)]; }
    LDS_WAIT();
    const int c = lane & 7;
#pragma unroll
    for (int j = 0; j < 4; ++j) { const int n = (lane >> 3) + 8 * j; const LAS float* s = scr + (8 * c) * 33 + n;
        v4u o; o.x = pkh(s[0 * 33], s[1 * 33]); o.y = pkh(s[2 * 33], s[3 * 33]); o.z = pkh(s[4 * 33], s[5 * 33]); o.w = pkh(s[6 * 33], s[7 * 33]);
        *(v4u*)(WT + (size_t)(n0 + n) * ldt + koff + k0 + 8 * c) = o; }
    LDS_WAIT();
}
__device__ __forceinline__ void conv_weights(const Params& p, const Ctx& c, int l) {
    LAS float* scr = (LAS float*)(c.lds + c.wave * 16384);
    unsigned char* wb = p.ws + WS_W;
    f16* WinT = (f16*)(wb + WO_IN); f16* WbrT = (f16*)(wb + WO_BR); f16* WoutT = (f16*)(wb + WO_OUT); f16* WupT = (f16*)(wb + WO_UP); f16* WdnT = (f16*)(wb + WO_DN);
    f16* WsmT = (f16*)(wb + WO_SM); f16* WgT = (f16*)(wb + WO_G);
    const float* w_in = p.in[7] + (size_t)l * D * DIN; const float* w_br = p.in[8] + (size_t)l * 2 * CW * D; const float* w_out = p.in[9] + (size_t)l * D * D;
    const float* w_up = p.in[13] + (size_t)l * D * DFF; const float* w_dn = p.in[14] + (size_t)l * DFF * D;
    const float* dec_up = p.in[20] + (size_t)l * 2 * 64 * CW; const float* icl_up = p.in[22] + (size_t)l * 2 * 64 * CW; const float* gate_up = p.in[23] + (size_t)l * 128 * CW;
    constexpr int I0 = 16 * 144, I1 = 8 * 32, I2 = 8 * 32, I3 = 16 * 32, I4 = 16 * 128, I5 = 64 * 32, I6 = 16, I7 = 16, I8 = 16, I9 = 16, I10 = 2 * 16;
    constexpr int NIT = I0 + I1 + I2 + I3 + I4 + I5 + I6 + I7 + I8 + I9 + I10;
    for (int it = c.gw; it < NIT; it += c.ngw) {
        int r = it;
        if (r < I0) { conv_item(w_in, DIN, WinT, D, 0, scr, r / 144, r % 144, c.lane); continue; } r -= I0;
        if (r < I1) { conv_item(w_br, D, WbrT, D, 0, scr, r / 32, r % 32, c.lane); continue; } r -= I1;
        if (r < I2) { conv_item(w_br + (size_t)CW * D, D, WbrT, D, CW, scr, r / 32, r % 32, c.lane); continue; } r -= I2;
        if (r < I3) { conv_item(w_out, D, WoutT, D, 0, scr, r / 32, r % 32, c.lane); continue; } r -= I3;
        if (r < I4) { conv_item(w_up, DFF, WupT, D, 0, scr, r / 128, r % 128, c.lane); continue; } r -= I4;
        if (r < I5) { conv_item(w_dn, D, WdnT, DFF, 0, scr, r / 32, r % 32, c.lane); continue; } r -= I5;
        if (r < I6) { conv_item(dec_up, CW, WsmT, 128, 0, scr, 0, r, c.lane); continue; } r -= I6;
        if (r < I7) { conv_item(dec_up + 64 * CW, CW, WsmT + (size_t)512 * 128, 128, 0, scr, 0, r, c.lane); continue; } r -= I7;
        if (r < I8) { conv_item(icl_up, CW, WsmT + (size_t)1024 * 128, 128, 64, scr, 0, r, c.lane); continue; } r -= I8;
        if (r < I9) { conv_item(icl_up + 64 * CW, CW, WsmT + (size_t)1536 * 128, 128, 64, scr, 0, r, c.lane); continue; } r -= I9;
        conv_item(gate_up, CW, WgT, 128, 0, scr, r / 16, r % 16, c.lane);
    }
    for (int i = c.gt; i < 2048 * 8; i += c.ngt) { const int row = i >> 3, ch = i & 7; const int col = (row < 1024 ? 64 : 0) + ch * 8;
        *(v4u*)(WsmT + (size_t)row * 128 + col) = (v4u){0u, 0u, 0u, 0u}; }
}

__device__ __forceinline__ void mod_phase(const Params& p, const Ctx& c) {
    LAS float* sl = (LAS float*)(c.lds);
    LAS float* part = (LAS float*)(c.lds + 32768);
    float* mod = (float*)(p.ws + WS_MOD);
    for (int i = c.tid; i < 5 * D; i += NTHREADS) { const int g = i >> 10, k = i & 1023; const float v = g == 0 ? p.in[6][k] : p.in[5][(g - 1) * D + k]; sl[i] = v / (1.0f + __expf(-v)); }
    __syncthreads();
    for (int it = blockIdx.x; it < NL * (NMOD / 64); it += gridDim.x) {
        const int l = it / (NMOD / 64), cc = it % (NMOD / 64);
        const float* w = p.in[10] + (size_t)l * D * NMOD + cc * 64 + c.lane;
        float a0 = 0.f, a1 = 0.f, a2 = 0.f, a3 = 0.f, a4 = 0.f;
        const int kb = c.wave * 128;
#pragma unroll 4
        for (int k = kb; k < kb + 128; ++k) { const float wv = w[(size_t)k * NMOD]; a0 += sl[k] * wv; a1 += sl[D + k] * wv; a2 += sl[2 * D + k] * wv; a3 += sl[3 * D + k] * wv; a4 += sl[4 * D + k] * wv; }
        LAS float* pw = part + c.wave * 320 + c.lane;
        pw[0] = a0; pw[64] = a1; pw[128] = a2; pw[192] = a3; pw[256] = a4;
        __syncthreads();
        if (c.tid < 320) { float s = 0.f;
#pragma unroll
            for (int w8 = 0; w8 < 8; ++w8) s += part[w8 * 320 + c.tid];
            const int g = c.tid >> 6, col = cc * 64 + (c.tid & 63);
            mod[((size_t)l * 5 + g) * NMOD + col] = s + p.in[11][(size_t)l * NMOD + col]; }
        __syncthreads();
    }
}

template <int MODE>
__device__ __forceinline__ void norm_phase(const Params& p, const Ctx& c, int l) {
    float* X = p.out; const f16* MO = (const f16*)(p.ws + WS_R2); f16* H = (f16*)(p.ws + WS_R4);
    const float* modb = (const float*)(p.ws + WS_MOD);
    for (int row = c.gw; row < M; row += c.ngw) {
        int g, t, T; row_info(row, g, t, T);
        f32x4 x[4];
        if (MODE == 0) { const float* src = row < M_CTX ? p.in[0] + (size_t)row * D : p.in[1] + (size_t)(row - M_CTX) * D;
#pragma unroll
            for (int j = 0; j < 4; ++j) x[j] = *(const f32x4*)(src + 256 * j + 4 * c.lane);
        } else {
            const float* mo_mod = modb + ((size_t)l * 5 + g) * NMOD + (MODE == 1 ? 2 * D : 5 * D);
            const float* ngp = p.in[12] + ((size_t)l * 4 + (MODE == 1 ? 1 : 3)) * D;
            float mv[4][4]; float ss = 0.f;
#pragma unroll
            for (int j = 0; j < 4; ++j) { const f16x4 h = *(const f16x4*)(MO + (size_t)row * D + 256 * j + 4 * c.lane);
#pragma unroll
                for (int e = 0; e < 4; ++e) { mv[j][e] = (float)h[e]; ss += mv[j][e] * mv[j][e]; } }
            const float rstd = rsqrtf(wave_sum(ss) * (1.0f / D) + 1e-6f);
#pragma unroll
            for (int j = 0; j < 4; ++j) { x[j] = *(const f32x4*)(X + (size_t)row * D + 256 * j + 4 * c.lane);
                const f32x4 gg = *(const f32x4*)(mo_mod + 256 * j + 4 * c.lane); const f32x4 nn = *(const f32x4*)(ngp + 256 * j + 4 * c.lane);
#pragma unroll
                for (int e = 0; e < 4; ++e) x[j][e] += gg[e] * (mv[j][e] * rstd * nn[e]); }
        }
#pragma unroll
        for (int j = 0; j < 4; ++j) *(f32x4*)(X + (size_t)row * D + 256 * j + 4 * c.lane) = x[j];
        const int ln = MODE == 2 ? l + 1 : l;
        if (ln < NL) {
            const float* mb = modb + ((size_t)ln * 5 + g) * NMOD + (MODE == 1 ? 3 * D : 0);
            const float* ngp = p.in[12] + ((size_t)ln * 4 + (MODE == 1 ? 2 : 0)) * D;
            float ss = 0.f;
#pragma unroll
            for (int j = 0; j < 4; ++j) ss += (x[j][0] * x[j][0] + x[j][1] * x[j][1]) + (x[j][2] * x[j][2] + x[j][3] * x[j][3]);
            const float rstd = rsqrtf(wave_sum(ss) * (1.0f / D) + 1e-6f);
#pragma unroll
            for (int j = 0; j < 4; ++j) { const f32x4 sh = *(const f32x4*)(mb + 256 * j + 4 * c.lane); const f32x4 sc = *(const f32x4*)(mb + D + 256 * j + 4 * c.lane);
                const f32x4 nn = *(const f32x4*)(ngp + 256 * j + 4 * c.lane);
                float o[4];
#pragma unroll
                for (int e = 0; e < 4; ++e) o[e] = x[j][e] * rstd * nn[e] * (1.0f + sc[e]) + sh[e];
                uint2 w; w.x = pkh(o[0], o[1]); w.y = pkh(o[2], o[3]);
                *(uint2*)(H + (size_t)row * D + 256 * j + 4 * c.lane) = w; }
        }
    }
}

template <class Epi>
__device__ __forceinline__ void naive_gemm(const f16* A, int lda, const f16* Bt, int K, int N, const Epi& epi, const Ctx& c) {
    const size_t total = (size_t)M * N;
    for (size_t idx = c.gt; idx < total; idx += c.ngt) {
        const int m = (int)(idx / N), n = (int)(idx % N);
        const f16* a = A + (size_t)m * lda; const f16* b = Bt + (size_t)n * K;
        float acc = 0.f;
        for (int k = 0; k < K; k += 8) { const f16x8 av = *(const f16x8*)(a + k); const f16x8 bv = *(const f16x8*)(b + k);
#pragma unroll
            for (int e = 0; e < 8; ++e) acc += (float)av[e] * (float)bv[e]; }
        epi(m, n, acc);
    }
}
struct EpiProj { f16* P;
    __device__ __forceinline__ void operator()(int m, int n, float v) const {
        if (n >= PC_LW && n < PC_LA) v = tanhf(v);
        else if ((n >= PC_LG && n < PC_Q) || n >= PC_GR) v = sigmoidf_(v);
        P[(size_t)m * DIN + n] = (f16)v; } };
struct EpiWA { f16* WA; const float* w0; const float* a0;
    __device__ __forceinline__ void operator()(int m, int n, float v) const {
        float o; if (n < 1024) o = __expf(-0.606531f * sigmoidf_(v + w0[n])); else o = sigmoidf_(v + a0[n - 1024]);
        WA[(size_t)m * 2048 + n] = (f16)o; } };
struct EpiF16 { f16* O; int ld;
    __device__ __forceinline__ void operator()(int m, int n, float v) const { O[(size_t)m * ld + n] = (f16)v; } };
struct EpiRelu2 { f16* O; int ld;
    __device__ __forceinline__ void operator()(int m, int n, float v) const { v = fmaxf(v, 0.f); O[(size_t)m * ld + n] = (f16)(v * v); } };
__device__ __forceinline__ void naive_merged(const Params& p, const Ctx& c) {
    const f16* OA = (const f16*)(p.ws + WS_R4); const f16* WbrT = (const f16*)(p.ws + WS_W + WO_BR); const f16* PROJ = (const f16*)(p.ws + WS_R1); f16* MG = (f16*)(p.ws + WS_R3);
    const size_t total = (size_t)M * D;
    for (size_t idx = c.gt; idx < total; idx += c.ngt) {
        const int m = (int)(idx / D), n = (int)(idx % D);
        const f16* a = OA + (size_t)m * D; const f16* b = WbrT + (size_t)n * D;
        float acc0 = 0.f, acc1 = 0.f;
        for (int k = 0; k < CW; k += 8) { const f16x8 av = *(const f16x8*)(a + k); const f16x8 bv = *(const f16x8*)(b + k);
#pragma unroll
            for (int e = 0; e < 8; ++e) acc0 += (float)av[e] * (float)bv[e]; }
        for (int k = CW; k < D; k += 8) { const f16x8 av = *(const f16x8*)(a + k); const f16x8 bv = *(const f16x8*)(b + k);
#pragma unroll
            for (int e = 0; e < 8; ++e) acc1 += (float)av[e] * (float)bv[e]; }
        const float sr = (float)PROJ[(size_t)m * DIN + PC_GR + n], sa = (float)PROJ[(size_t)m * DIN + PC_GA + n];
        MG[(size_t)m * D + n] = (f16)(sr * acc0 + sa * acc1);
    }
}

__device__ __forceinline__ void kv_prep(const Params& p, const Ctx& c, int l) {
    const f16* PROJ = (const f16*)(p.ws + WS_R1); f16* KN = (f16*)(p.ws + WS_KN); f16* VT = (f16*)(p.ws + WS_VT);
    const float kg = p.in[27][l * HD + c.lane];
    const int d = c.lane;
    for (int it = c.gw; it < M * 2; it += c.ngw) {
        const int row = it >> 1, kvh = it & 1;
        float kx = (float)PROJ[(size_t)row * DIN + PC_KA + kvh * HD + d]; const float vx = (float)PROJ[(size_t)row * DIN + PC_VA + kvh * HD + d];
        const float rstd = rsqrtf(wave_sum(kx * kx) * (1.0f / HD) + 1e-6f);
        kx = kx * rstd * kg;
        if (row < M_CTX) { const int b = row >> 8, t = row & 255;
            p.out[O_CK + ((((size_t)b * NL + l) * T_CTX + t) * 2 + kvh) * HD + d] = kx;
            p.out[O_CV + ((((size_t)b * NL + l) * T_CTX + t) * 2 + kvh) * HD + d] = vx;
            KN[(((size_t)b * 2 + kvh) * T_CTX + t) * HD + d] = (f16)kx;
            VT[(((size_t)b * 2 + kvh) * HD + d) * T_CTX + t] = (f16)vx;
        } else { const int r = row - M_CTX, b = r >> 10, t = r & 1023;
            const int axis = d >> 5, half = (d >> 4) & 1, f = d & 15;
            const float pos = (float)(axis == 0 ? (t >> 6) : (t & 63));
            const float freq = exp2f(-(float)f * (13.287712379549449f / 16.0f));
            const float ang = pos * freq; const float cs = cosf(ang), sn = sinf(ang);
            const float other = __shfl_xor(kx, 16);
            const float ko = half == 0 ? kx * cs - other * sn : kx * cs + other * sn;
            KN[KN_SMP_OFF + (((size_t)b * 2 + kvh) * KV_SMP + PAST + t) * HD + d] = (f16)ko;
            VT[KN_SMP_OFF + (((size_t)b * 2 + kvh) * HD + d) * KV_SMP + PAST + t] = (f16)vx;
        }
    }
    for (int it = c.gw; it < B_SMP * PAST * 2; it += c.ngw) {
        const int kvh = it & 1, j = (it >> 1) & 255, b = it >> 9;
        const size_t src = ((((size_t)b * NL + l) * PAST + j) * 2 + kvh) * HD + d;
        KN[KN_SMP_OFF + (((size_t)b * 2 + kvh) * KV_SMP + j) * HD + d] = (f16)p.in[2][src];
        VT[KN_SMP_OFF + (((size_t)b * 2 + kvh) * HD + d) * KV_SMP + j] = (f16)p.in[3][src];
    }
}

__device__ __forceinline__ void naive_scan(const Params& p, const Ctx& c, int l) {
    const f16* PROJ = (const f16*)(p.ws + WS_R1); const f16* WA = (const f16*)(p.ws + WS_R2);
    f16* Y = (f16*)(p.ws + WS_R3); float* RK = (float*)(p.ws + WS_RK);
    LAS float* st = (LAS float*)(c.lds + c.wave * 2048);
    const int NSCAN = (B_CTX + B_SMP) * 2 * NH;
    for (int it = c.gw; it < NSCAN; it += c.ngw) {
        const int h = it & 7, dir = (it >> 3) & 1, sq = it >> 4;
        const bool smp = sq >= B_CTX; const int T = smp ? T_SMP : T_CTX; const int row0 = smp ? M_CTX + (sq - B_CTX) * T_SMP : sq * T_CTX;
        const int ch = h * HD + c.lane;
        const float mu_r = p.in[15][(l * 3 + 0) * CW + ch], mu_k = p.in[15][(l * 3 + 1) * CW + ch], mu_v = p.in[15][(l * 3 + 2) * CW + ch];
        const float k_k = p.in[16][l * CW + ch], k_a = p.in[17][l * CW + ch], r_k = p.in[18][l * CW + ch];
        float S[64];
        if (smp) { const float* s0 = p.in[4] + (((((size_t)(sq - B_CTX) * NL + l) * 2 + dir) * NH + h) * HD + c.lane) * HD;
#pragma unroll
            for (int k = 0; k < 64; ++k) S[k] = s0[k];
        } else {
#pragma unroll
            for (int k = 0; k < 64; ++k) S[k] = 0.f;
        }
        for (int s = 0; s < T; ++s) {
            const int t = dir == 0 ? s : T - 1 - s; const size_t row = (size_t)row0 + t;
            const f16* pr = PROJ + row * DIN;
            const float rc = (float)pr[PC_R + ch], kc = (float)pr[PC_K + ch], vc = (float)pr[PC_V + ch];
            float rp = 0.f, kp = 0.f, vp = 0.f, rn = 0.f, kn = 0.f, vn = 0.f;
            if (t > 0) { rp = (float)pr[PC_R + ch - DIN]; kp = (float)pr[PC_K + ch - DIN]; vp = (float)pr[PC_V + ch - DIN]; }
            if (t < T - 1) { rn = (float)pr[PC_R + ch + DIN]; kn = (float)pr[PC_K + ch + DIN]; vn = (float)pr[PC_V + ch + DIN]; }
            const float r = rc + mu_r * (0.5f * (rp + rn) - rc), k = kc + mu_k * (0.5f * (kp + kn) - kc), v = vc + mu_v * (0.5f * (vp + vn) - vc);
            const float kk = k * k_k; const float kh = kk * rsqrtf(wave_sum(kk * kk) + 1e-12f);
            const float w = (float)WA[row * 2048 + dir * 512 + ch], a = (float)WA[row * 2048 + 1024 + dir * 512 + ch];
            const float kt = k * (1.0f + (a - 1.0f) * k_a), bb = a * kh;
            const float rks = wave_sum(r * kt * r_k);
            if (c.lane == 0) RK[((size_t)dir * M + row) * 8 + h] = rks;
            LDS_WAIT();
            st[c.lane] = kh; st[64 + c.lane] = w; st[128 + c.lane] = bb; st[192 + c.lane] = kt; st[256 + c.lane] = r;
            LDS_WAIT();
            float sk = 0.f;
#pragma unroll
            for (int k4 = 0; k4 < 64; k4 += 4) { const f32x4 q = *(const LAS f32x4*)(st + k4); sk += S[k4] * q[0] + S[k4 + 1] * q[1] + S[k4 + 2] * q[2] + S[k4 + 3] * q[3]; }
            float y = 0.f;
#pragma unroll
            for (int k4 = 0; k4 < 64; k4 += 4) { const f32x4 wq = *(const LAS f32x4*)(st + 64 + k4), bq = *(const LAS f32x4*)(st + 128 + k4), tq = *(const LAS f32x4*)(st + 192 + k4), rq = *(const LAS f32x4*)(st + 256 + k4);
#pragma unroll
                for (int e = 0; e < 4; ++e) { S[k4 + e] = S[k4 + e] * wq[e] - sk * bq[e] + v * tq[e]; y += S[k4 + e] * rq[e]; } }
            Y[((size_t)dir * M + row) * CW + ch] = (f16)y;
        }
        if (!smp) { float* so = p.out + O_ST + (((((size_t)sq * NL + l) * 2 + dir) * NH + h) * HD + c.lane) * HD;
#pragma unroll
            for (int k = 0; k < 64; ++k) so[k] = S[k]; }
    }
}

__device__ __forceinline__ void naive_attn(const Params& p, const Ctx& c, int l) {
    const f16* PROJ = (const f16*)(p.ws + WS_R1); const f16* KN = (const f16*)(p.ws + WS_KN); const f16* VT = (const f16*)(p.ws + WS_VT);
    f16* OA = (f16*)(p.ws + WS_R4);
    LAS float* ps = (LAS float*)(c.lds + 16384 + c.wave * 8192);
    const float qg = p.in[26][l * HD + c.lane];
    for (int it = c.gw; it < M * NH; it += c.ngw) {
        const int row = it >> 3, hq = it & 7, kvh = hq >> 2, d = c.lane;
        float qx = (float)PROJ[(size_t)row * DIN + PC_Q + hq * HD + d];
        qx = qx * rsqrtf(wave_sum(qx * qx) * (1.0f / HD) + 1e-6f) * qg;
        const f16* Kb; const f16* Vb; int L;
        if (row < M_CTX) { const int b = row >> 8; Kb = KN + ((size_t)b * 2 + kvh) * T_CTX * HD; Vb = VT + ((size_t)b * 2 + kvh) * HD * T_CTX; L = T_CTX; }
        else { const int r = row - M_CTX, b = r >> 10, t = r & 1023;
            const int axis = d >> 5, half = (d >> 4) & 1, f = d & 15;
            const float pos = (float)(axis == 0 ? (t >> 6) : (t & 63));
            const float ang = pos * exp2f(-(float)f * (13.287712379549449f / 16.0f)); const float cs = cosf(ang), sn = sinf(ang);
            const float other = __shfl_xor(qx, 16);
            qx = half == 0 ? qx * cs - other * sn : qx * cs + other * sn;
            Kb = KN + KN_SMP_OFF + ((size_t)b * 2 + kvh) * KV_SMP * HD; Vb = VT + KN_SMP_OFF + ((size_t)b * 2 + kvh) * HD * KV_SMP; L = KV_SMP; }
        LDS_WAIT();
        ps[d] = qx * 0.125f;
        LDS_WAIT();
        float mx = -1e30f;
        for (int j = c.lane; j < L; j += 64) { float s = 0.f;
#pragma unroll
            for (int k8 = 0; k8 < 64; k8 += 8) { const f16x8 kv = *(const f16x8*)(Kb + (size_t)j * HD + k8);
#pragma unroll
                for (int e = 0; e < 8; ++e) s += ps[k8 + e] * (float)kv[e]; }
            ps[64 + j] = s; mx = fmaxf(mx, s); }
        mx = wave_max(mx);
        float sum = 0.f;
        for (int j = c.lane; j < L; j += 64) { const float e = __expf(ps[64 + j] - mx); ps[64 + j] = e; sum += e; }
        sum = wave_sum(sum);
        LDS_WAIT();
        float o = 0.f;
        for (int j = 0; j < L; j += 8) { const f16x8 vv = *(const f16x8*)(Vb + (size_t)d * L + j);
#pragma unroll
            for (int e = 0; e < 8; ++e) o += ps[64 + j + e] * (float)vv[e]; }
        OA[(size_t)row * D + CW + hq * HD + d] = (f16)(o / sum);
    }
}

__device__ __forceinline__ void post_phase(const Params& p, const Ctx& c, int l) {
    const f16* PROJ = (const f16*)(p.ws + WS_R1); const f16* Y = (const f16*)(p.ws + WS_R3); const float* RK = (const float*)(p.ws + WS_RK);
    const f16* WgT = (const f16*)(p.ws + WS_W + WO_G); f16* OA = (f16*)(p.ws + WS_R4);
    for (int it = c.gw; it < M * NH; it += c.ngw) {
        const int row = it >> 3, h = it & 7, ch = h * HD + c.lane;
        int g, t, T; row_info(row, g, t, T);
        const float y = (float)Y[(size_t)row * CW + ch] + (float)Y[((size_t)M + row) * CW + ch];
        const float mean = wave_sum(y) * (1.0f / HD); const float dy = y - mean; const float var = wave_sum(dy * dy) * (1.0f / HD);
        const float yn = dy * rsqrtf(var + 64e-5f) * p.in[24][l * CW + ch] + p.in[25][l * CW + ch];
        const f16* pr = PROJ + (size_t)row * DIN;
        const float vc = (float)pr[PC_V + ch]; float vp = 0.f, vn = 0.f;
        if (t > 0) vp = (float)pr[PC_V + ch - DIN];
        if (t < T - 1) vn = (float)pr[PC_V + ch + DIN];
        const float v = vc + p.in[15][(l * 3 + 2) * CW + ch] * (0.5f * (vp + vn) - vc);
        const float bonus = (RK[(size_t)row * 8 + h] + RK[((size_t)M + row) * 8 + h]) * v;
        float gs = 0.f;
        for (int k = 0; k < 128; k += 8) { const f16x8 a = *(const f16x8*)(pr + PC_LG + k); const f16x8 b = *(const f16x8*)(WgT + (size_t)ch * 128 + k);
#pragma unroll
            for (int e = 0; e < 8; ++e) gs += (float)a[e] * (float)b[e]; }
        OA[(size_t)row * D + ch] = (f16)((yn + bonus) * gs);
    }
}

__global__ void __launch_bounds__(NTHREADS, 2) fwd_kernel(Params p) {
    extern __shared__ __attribute__((aligned(16))) unsigned char lds_raw[];
    Ctx c;
    c.lds = (LAS unsigned char*)lds_raw;
    c.tid = threadIdx.x; c.lane = c.tid & 63; c.wave = __builtin_amdgcn_readfirstlane(c.tid >> 6);
    c.gw = blockIdx.x * NWAVES + c.wave; c.ngw = gridDim.x * NWAVES; c.gt = blockIdx.x * NTHREADS + c.tid; c.ngt = gridDim.x * NTHREADS;
    volatile LAS unsigned* MISC = (volatile LAS unsigned*)(c.lds + MISC_OFF);
    if (c.tid < 32) MISC[c.tid] = 0u;
    __syncthreads();
    unsigned* ctl = (unsigned*)(p.ws + WS_CTL);
    XcdBarrier bar = xcd_barrier_post(ctl + CW_BAR, MISC + 8);
#define GRID_BAR() xcd_barrier(bar)

    unsigned char* wb = p.ws + WS_W;
    const f16* WinT = (const f16*)(wb + WO_IN); const f16* WoutT = (const f16*)(wb + WO_OUT); const f16* WupT = (const f16*)(wb + WO_UP); const f16* WdnT = (const f16*)(wb + WO_DN);
    const f16* WsmT = (const f16*)(wb + WO_SM);
    f16* PROJ = (f16*)(p.ws + WS_R1); f16* HID = (f16*)(p.ws + WS_R1); f16* WA = (f16*)(p.ws + WS_R2); f16* MO = (f16*)(p.ws + WS_R2);
    f16* MG = (f16*)(p.ws + WS_R3); f16* H = (f16*)(p.ws + WS_R4);

    conv_weights(p, c, 0);
    __syncthreads();
    mod_phase(p, c);
    GRID_BAR();
    norm_phase<0>(p, c, 0);
    GRID_BAR();
    for (int l = 0; l < NL; ++l) {
        naive_gemm(H, D, WinT, D, DIN, EpiProj{PROJ}, c);
        GRID_BAR();
        naive_gemm(PROJ + PC_LW, DIN, WsmT, 128, 2048, EpiWA{WA, p.in[19] + (size_t)l * 2 * CW, p.in[21] + (size_t)l * 2 * CW}, c);
        kv_prep(p, c, l);
        GRID_BAR();
        naive_scan(p, c, l);
        naive_attn(p, c, l);
        GRID_BAR();
        post_phase(p, c, l);
        GRID_BAR();
        naive_merged(p, c);
        GRID_BAR();
        naive_gemm(MG, D, WoutT, D, D, EpiF16{MO, D}, c);
        GRID_BAR();
        norm_phase<1>(p, c, l);
        GRID_BAR();
        naive_gemm(H, D, WupT, D, DFF, EpiRelu2{HID, DFF}, c);
        GRID_BAR();
        naive_gemm(HID, DFF, WdnT, DFF, D, EpiF16{MO, D}, c);
        GRID_BAR();
        norm_phase<2>(p, c, l);
        if (l + 1 < NL) { __syncthreads(); conv_weights(p, c, l + 1); }
        GRID_BAR();
    }
}

extern "C" void kernel_launch(void* const* d_in, const int* in_sizes, int n_in, void* d_out, int out_size, void* d_ws, size_t ws_size, hipStream_t stream) {
    static int grid = 0;
    if (grid == 0) {
        if (n_in != 28 || (size_t)out_size != O_TOTAL || ws_size < WS_END) { fprintf(stderr, "kernel_launch: unexpected shapes n_in %d out %d ws %zu\n", n_in, out_size, ws_size); grid = -1; return; }
        int dev = 0, cus = 0;
        if (hipGetDevice(&dev) != hipSuccess || hipDeviceGetAttribute(&cus, hipDeviceAttributeMultiprocessorCount, dev) != hipSuccess) { grid = -1; return; }
        if (hipFuncSetAttribute((const void*)fwd_kernel, hipFuncAttributeMaxDynamicSharedMemorySize, LDS_BYTES) != hipSuccess) { fprintf(stderr, "kernel_launch: hipFuncSetAttribute failed\n"); grid = -1; return; }
        grid = cus;
    }
    if (grid < 0) return;
    (void)hipMemsetAsync((char*)d_ws + WS_CTL, 0, CTL_BYTES, stream);
    Params p{};
    for (int i = 0; i < 28; ++i) p.in[i] = (const float*)d_in[i];
    p.out = (float*)d_out; p.ws = (unsigned char*)d_ws;
    hipLaunchKernelGGL(fwd_kernel, dim3(grid), dim3(NTHREADS), LDS_BYTES, stream, p);
}
```

```cpp
#include <hip/hip_runtime.h>
#include <cstdio>
#include <cstdint>

#define GAS __attribute__((address_space(1)))
#define LAS __attribute__((address_space(3)))
typedef _Float16 f16;
typedef _Float16 f16x8 __attribute__((ext_vector_type(8)));
typedef _Float16 f16x4 __attribute__((ext_vector_type(4)));
typedef _Float16 f16x2 __attribute__((ext_vector_type(2)));
typedef float f32x4 __attribute__((ext_vector_type(4)));
typedef unsigned v4u __attribute__((ext_vector_type(4)));

constexpr int D = 1024, DIN = 4608, DFF = 4096, CW = 512, NL = 2, NH = 8, HD = 64;
constexpr int B_CTX = 32, T_CTX = 256, B_SMP = 4, T_SMP = 1024, PAST = 256, KV_SMP = PAST + T_SMP;
constexpr int M_CTX = B_CTX * T_CTX, M_SMP = B_SMP * T_SMP, M = M_CTX + M_SMP;
constexpr int NMOD = 6 * D;
constexpr int PC_R = 0, PC_K = 512, PC_V = 1024, PC_LW = 1536, PC_LA = 1600, PC_LG = 1664, PC_Q = 1792, PC_KA = 2304, PC_VA = 2432, PC_GR = 2560, PC_GA = 3584;
constexpr size_t O_Y = 0, O_CK = (size_t)M * D, O_CV = O_CK + (size_t)B_CTX * NL * T_CTX * 128, O_ST = O_CV + (size_t)B_CTX * NL * T_CTX * 128;
constexpr size_t O_TOTAL = O_ST + (size_t)B_CTX * NL * 2 * NH * HD * HD;

constexpr size_t MiB = 1u << 20;
constexpr size_t WS_CTL = 0, CTL_BYTES = 1 * MiB;
constexpr size_t WS_MOD = 1 * MiB;
constexpr size_t WS_W = 2 * MiB;
constexpr size_t WO_IN = 0, WO_BR = 9 * MiB, WO_OUT = 11 * MiB, WO_UP = 13 * MiB, WO_DN = 21 * MiB, WO_SM = 29 * MiB, WO_G = 29 * MiB + 512 * 1024;
constexpr size_t WS_R1 = 32 * MiB;
constexpr size_t WS_R2 = 140 * MiB;
constexpr size_t WS_R3 = 188 * MiB;
constexpr size_t WS_RK = 212 * MiB;
constexpr size_t WS_R4 = 213 * MiB;
constexpr size_t WS_KN = 237 * MiB;
constexpr size_t WS_VT = 241 * MiB;
constexpr size_t WS_END = 245 * MiB;
constexpr size_t KN_SMP_OFF = (size_t)B_CTX * 2 * T_CTX * 64;

constexpr int NWAVES = 8, NTHREADS = 512;
constexpr int LDS_BYTES = 147456;
constexpr int MISC_OFF = 131072 + 320;

#define XB_TMO      128
#define XB_XCNT(j)  (256  + 64 * (j))
#define XB_XSUB(j)  (1280 + 64 * (j))
#define XB_XGEN(j)  (2304 + 64 * (j))
#define XB_TOP      3328
#define XB_TOPGEN   3392
#define XCD_BAR_WORDS 3456
#define XB_SPIN_CAP (1u << 24)
constexpr int CW_BAR = 4096;

__device__ __forceinline__ unsigned xb_ld(unsigned* p)              { return __hip_atomic_load(p, __ATOMIC_RELAXED, __HIP_MEMORY_SCOPE_AGENT); }
__device__ __forceinline__ unsigned xb_add(unsigned* p, unsigned v) { return __hip_atomic_fetch_add(p, v, __ATOMIC_RELAXED, __HIP_MEMORY_SCOPE_AGENT); }
__device__ __forceinline__ unsigned xb_xcc_id() { return (unsigned)__builtin_amdgcn_s_getreg((3 << 11) | 20) & 0xFu; }
#define XB_SPIN(cond, bar) do { unsigned _sp = 0; while (cond) { __builtin_amdgcn_s_sleep(1); \
    if ((++_sp & 255u) == 0u) { if (xb_ld(&(bar)[XB_TMO])) break; if (_sp > XB_SPIN_CAP) { atomicAdd(&(bar)[XB_TMO], 1u); break; } } } } while (0)

struct XcdBarrier { unsigned* bar; unsigned x; volatile LAS unsigned* st; };

__device__ __forceinline__ XcdBarrier xcd_barrier_post(unsigned* bar, volatile LAS unsigned* st) {
    XcdBarrier b; b.bar = bar; b.x = xb_xcc_id(); b.st = st;
    if (threadIdx.x == 0) (void)xb_add(&bar[XB_XCNT(b.x)], 1u);
    return b;
}
__device__ __forceinline__ void xcd_barrier_complete(unsigned* bar, unsigned x, unsigned& nloc, unsigned& nx) {
    const unsigned G = gridDim.x * gridDim.y * gridDim.z;
    unsigned sum, cnt, mine, sp = 0u;
    for (;;) {
        sum = 0u; cnt = 0u; mine = 0u;
#pragma unroll
        for (unsigned j = 0; j < 16; ++j) { const unsigned c = xb_ld(&bar[XB_XCNT(j)]); sum += c; cnt += (c > 0u) ? 1u : 0u; mine = (j == x) ? c : mine; }
        if (sum == G) break;
        __builtin_amdgcn_s_sleep(1);
        if ((++sp & 255u) == 0u) { if (xb_ld(&bar[XB_TMO])) break; if (sp > XB_SPIN_CAP) { atomicAdd(&bar[XB_TMO], 1u); break; } }
    }
    nloc = mine > 0u ? mine : 1u; nx = cnt > 0u ? cnt : 1u;
}
__device__ __forceinline__ void xcd_barrier(const XcdBarrier& b) {
    asm volatile("s_waitcnt vmcnt(0)" ::: "memory");
    __syncthreads();
    if (threadIdx.x == 0) {
        unsigned* bar = b.bar; unsigned bx = b.x;
        asm volatile("" : "+s"(bar), "+s"(bx));
        __builtin_amdgcn_s_waitcnt(0);
        unsigned nloc = b.st[0], nx = b.st[1];
        if (nloc == 0u) { xcd_barrier_complete(bar, bx, nloc, nx); b.st[0] = nloc; b.st[1] = nx; }
        const unsigned old = xb_add(&bar[XB_XSUB(bx)], 1u);
        const unsigned gen = old / nloc;
        if (old + 1u == (gen + 1u) * nloc) {
            __builtin_amdgcn_fence(__ATOMIC_RELEASE, "agent");
            asm volatile("s_waitcnt vmcnt(0)" ::: "memory");
            const unsigned og = xb_add(&bar[XB_TOP], 1u);
            const unsigned tg = og / nx;
            if (og + 1u == (tg + 1u) * nx) xb_add(&bar[XB_TOPGEN], 1u);
            else XB_SPIN(xb_ld(&bar[XB_TOPGEN]) == tg, bar);
            __builtin_amdgcn_fence(__ATOMIC_ACQUIRE, "agent");
            xb_add(&bar[XB_XGEN(bx)], 1u);
            asm volatile("s_waitcnt vmcnt(0)" ::: "memory");
        } else {
            XB_SPIN(xb_ld(&bar[XB_XGEN(bx)]) == gen, bar);
            __builtin_amdgcn_fence(__ATOMIC_ACQUIRE, "agent");
            asm volatile("s_waitcnt vmcnt(0)" ::: "memory");
        }
    }
    __syncthreads();
}

#define LDS_WAIT() asm volatile("s_waitcnt lgkmcnt(0)" ::: "memory")
__device__ __forceinline__ float wave_sum(float v) {
#pragma unroll
    for (int o = 1; o < 64; o <<= 1) v += __shfl_xor(v, o);
    return v;
}
__device__ __forceinline__ float wave_max(float v) {
#pragma unroll
    for (int o = 1; o < 64; o <<= 1) v = fmaxf(v, __shfl_xor(v, o));
    return v;
}
__device__ __forceinline__ float sigmoidf_(float x) { return 1.0f / (1.0f + __expf(-x)); }
__device__ __forceinline__ float tanhf_(float x) { return 1.0f - 2.0f / (1.0f + __expf(2.0f * x)); }
__device__ __forceinline__ unsigned pkh(float lo, float hi) { f16x2 v = {(f16)lo, (f16)hi}; return __builtin_bit_cast(unsigned, v); }
__device__ __forceinline__ void row_info(int row, int& g, int& t, int& T) {
    if (row < M_CTX) { g = 0; t = row & (T_CTX - 1); T = T_CTX; }
    else { const int r = row - M_CTX; g = 1 + (r >> 10); t = r & (T_SMP - 1); T = T_SMP; }
}

struct Params {
    const float* in[28];
    float* out;
    unsigned char* ws;
};
struct Ctx {
    LAS unsigned char* lds;
    int tid, lane, wave, gw, ngw, gt, ngt;
};
__device__ __forceinline__ Ctx fresh(const Ctx& c0) {
    Ctx c = c0; int t = c0.tid; asm volatile("" : "+v"(t));
    c.tid = t; c.lane = t & 63; c.wave = __builtin_amdgcn_readfirstlane(t >> 6);
    c.gw = blockIdx.x * 8 + c.wave; c.gt = blockIdx.x * 512 + t; return c; }

__device__ __forceinline__ void conv_item(const float* W, int N, f16* WT, int ldt, int koff, LAS float* scr, int kb, int nb, int lane) {
    const int k0 = 64 * kb, n0 = 32 * nb;
#pragma unroll 8
    for (int i = 0; i < 32; ++i) { const int kk = 2 * i + (lane >> 5); scr[kk * 33 + (lane & 31)] = W[(size_t)(k0 + kk) * N + n0 + (lane & 31)]; }
    LDS_WAIT();
    const int c = lane & 7;
#pragma unroll
    for (int j = 0; j < 4; ++j) { const int n = (lane >> 3) + 8 * j; const LAS float* s = scr + (8 * c) * 33 + n;
        v4u o; o.x = pkh(s[0 * 33], s[1 * 33]); o.y = pkh(s[2 * 33], s[3 * 33]); o.z = pkh(s[4 * 33], s[5 * 33]); o.w = pkh(s[6 * 33], s[7 * 33]);
        *(v4u*)(WT + (size_t)(n0 + n) * ldt + koff + k0 + 8 * c) = o; }
    LDS_WAIT();
}
__device__ __forceinline__ void conv_weights(const Params& p, const Ctx& c0, int l) {
    const Ctx c = fresh(c0);
    LAS float* scr = (LAS float*)(c.lds + c.wave * 16384);
    unsigned char* wb = p.ws + WS_W;
    f16* WinT = (f16*)(wb + WO_IN); f16* WbrT = (f16*)(wb + WO_BR); f16* WoutT = (f16*)(wb + WO_OUT); f16* WupT = (f16*)(wb + WO_UP); f16* WdnT = (f16*)(wb + WO_DN);
    f16* WsmT = (f16*)(wb + WO_SM); f16* WgT = (f16*)(wb + WO_G);
    const float* w_in = p.in[7] + (size_t)l * D * DIN; const float* w_br = p.in[8] + (size_t)l * 2 * CW * D; const float* w_out = p.in[9] + (size_t)l * D * D;
    const float* w_up = p.in[13] + (size_t)l * D * DFF; const float* w_dn = p.in[14] + (size_t)l * DFF * D;
    const float* dec_up = p.in[20] + (size_t)l * 2 * 64 * CW; const float* icl_up = p.in[22] + (size_t)l * 2 * 64 * CW; const float* gate_up = p.in[23] + (size_t)l * 128 * CW;
    constexpr int I0 = 16 * 144, I1 = 8 * 32, I2 = 8 * 32, I3 = 16 * 32, I4 = 16 * 128, I5 = 64 * 32, I6 = 16, I7 = 16, I8 = 16, I9 = 16, I10 = 2 * 16;
    constexpr int NIT = I0 + I1 + I2 + I3 + I4 + I5 + I6 + I7 + I8 + I9 + I10;
    for (int it = c.gw; it < NIT; it += c.ngw) {
        int r = it;
        if (r < I0) { conv_item(w_in, DIN, WinT, D, 0, scr, r / 144, r % 144, c.lane); continue; } r -= I0;
        if (r < I1) { conv_item(w_br, D, WbrT, D, 0, scr, r / 32, r % 32, c.lane); continue; } r -= I1;
        if (r < I2) { conv_item(w_br + (size_t)CW * D, D, WbrT, D, CW, scr, r / 32, r % 32, c.lane); continue; } r -= I2;
        if (r < I3) { conv_item(w_out, D, WoutT, D, 0, scr, r / 32, r % 32, c.lane); continue; } r -= I3;
        if (r < I4) { conv_item(w_up, DFF, WupT, D, 0, scr, r / 128, r % 128, c.lane); continue; } r -= I4;
        if (r < I5) { conv_item(w_dn, D, WdnT, DFF, 0, scr, r / 32, r % 32, c.lane); continue; } r -= I5;
        if (r < I6) { conv_item(dec_up, CW, WsmT, 128, 0, scr, 0, r, c.lane); continue; } r -= I6;
        if (r < I7) { conv_item(dec_up + 64 * CW, CW, WsmT + (size_t)512 * 128, 128, 0, scr, 0, r, c.lane); continue; } r -= I7;
        if (r < I8) { conv_item(icl_up, CW, WsmT + (size_t)1024 * 128, 128, 64, scr, 0, r, c.lane); continue; } r -= I8;
        if (r < I9) { conv_item(icl_up + 64 * CW, CW, WsmT + (size_t)1536 * 128, 128, 64, scr, 0, r, c.lane); continue; } r -= I9;
        conv_item(gate_up, CW, WgT, 128, 0, scr, r / 16, r % 16, c.lane);
    }
    for (int i = c.gt; i < 2048 * 8; i += c.ngt) { const int row = i >> 3, ch = i & 7; const int col = (row < 1024 ? 64 : 0) + ch * 8;
        *(v4u*)(WsmT + (size_t)row * 128 + col) = (v4u){0u, 0u, 0u, 0u}; }
}

__device__ __forceinline__ void mod_phase(const Params& p, const Ctx& c0) {
    const Ctx c = fresh(c0);
    LAS float* sl = (LAS float*)(c.lds);
    LAS float* part = (LAS float*)(c.lds + 32768);
    float* mod = (float*)(p.ws + WS_MOD);
    for (int i = c.tid; i < 5 * D; i += NTHREADS) { const int g = i >> 10, k = i & 1023; const float v = g == 0 ? p.in[6][k] : p.in[5][(g - 1) * D + k]; sl[i] = v / (1.0f + __expf(-v)); }
    __syncthreads();
    for (int it = blockIdx.x; it < NL * (NMOD / 64); it += gridDim.x) {
        const int l = it / (NMOD / 64), cc = it % (NMOD / 64);
        const float* w = p.in[10] + (size_t)l * D * NMOD + cc * 64 + c.lane;
        float a0 = 0.f, a1 = 0.f, a2 = 0.f, a3 = 0.f, a4 = 0.f;
        const int kb = c.wave * 128;
#pragma unroll 4
        for (int k = kb; k < kb + 128; ++k) { const float wv = w[(size_t)k * NMOD]; a0 += sl[k] * wv; a1 += sl[D + k] * wv; a2 += sl[2 * D + k] * wv; a3 += sl[3 * D + k] * wv; a4 += sl[4 * D + k] * wv; }
        LAS float* pw = part + c.wave * 320 + c.lane;
        pw[0] = a0; pw[64] = a1; pw[128] = a2; pw[192] = a3; pw[256] = a4;
        __syncthreads();
        if (c.tid < 320) { float s = 0.f;
#pragma unroll
            for (int w8 = 0; w8 < 8; ++w8) s += part[w8 * 320 + c.tid];
            const int g = c.tid >> 6, col = cc * 64 + (c.tid & 63);
            mod[((size_t)l * 5 + g) * NMOD + col] = s + p.in[11][(size_t)l * NMOD + col]; }
        __syncthreads();
    }
}

template <int MODE>
__device__ __forceinline__ void norm_phase(const Params& p, const Ctx& c0, int l) {
    const Ctx c = fresh(c0);
    float* X = p.out; const f16* MO = (const f16*)(p.ws + WS_R2); f16* H = (f16*)(p.ws + WS_R4);
    const float* modb = (const float*)(p.ws + WS_MOD);
    for (int row = c.gw; row < M; row += c.ngw) {
        int g, t, T; row_info(row, g, t, T);
        f32x4 x[4];
        if (MODE == 0) { const float* src = row < M_CTX ? p.in[0] + (size_t)row * D : p.in[1] + (size_t)(row - M_CTX) * D;
#pragma unroll
            for (int j = 0; j < 4; ++j) x[j] = *(const f32x4*)(src + 256 * j + 4 * c.lane);
        } else {
            const float* mo_mod = modb + ((size_t)l * 5 + g) * NMOD + (MODE == 1 ? 2 * D : 5 * D);
            const float* ngp = p.in[12] + ((size_t)l * 4 + (MODE == 1 ? 1 : 3)) * D;
            float mv[4][4]; float ss = 0.f;
#pragma unroll
            for (int j = 0; j < 4; ++j) { const f16x4 h = *(const f16x4*)(MO + (size_t)row * D + 256 * j + 4 * c.lane);
#pragma unroll
                for (int e = 0; e < 4; ++e) { mv[j][e] = (float)h[e]; ss += mv[j][e] * mv[j][e]; } }
            const float rstd = rsqrtf(wave_sum(ss) * (1.0f / D) + 1e-6f);
#pragma unroll
            for (int j = 0; j < 4; ++j) { x[j] = *(const f32x4*)(X + (size_t)row * D + 256 * j + 4 * c.lane);
                const f32x4 gg = *(const f32x4*)(mo_mod + 256 * j + 4 * c.lane); const f32x4 nn = *(const f32x4*)(ngp + 256 * j + 4 * c.lane);
#pragma unroll
                for (int e = 0; e < 4; ++e) x[j][e] += gg[e] * (mv[j][e] * rstd * nn[e]); }
        }
#pragma unroll
        for (int j = 0; j < 4; ++j) *(f32x4*)(X + (size_t)row * D + 256 * j + 4 * c.lane) = x[j];
        const int ln = MODE == 2 ? l + 1 : l;
        if (ln < NL) {
            const float* mb = modb + ((size_t)ln * 5 + g) * NMOD + (MODE == 1 ? 3 * D : 0);
            const float* ngp = p.in[12] + ((size_t)ln * 4 + (MODE == 1 ? 2 : 0)) * D;
            float ss = 0.f;
#pragma unroll
            for (int j = 0; j < 4; ++j) ss += (x[j][0] * x[j][0] + x[j][1] * x[j][1]) + (x[j][2] * x[j][2] + x[j][3] * x[j][3]);
            const float rstd = rsqrtf(wave_sum(ss) * (1.0f / D) + 1e-6f);
#pragma unroll
            for (int j = 0; j < 4; ++j) { const f32x4 sh = *(const f32x4*)(mb + 256 * j + 4 * c.lane); const f32x4 sc = *(const f32x4*)(mb + D + 256 * j + 4 * c.lane);
                const f32x4 nn = *(const f32x4*)(ngp + 256 * j + 4 * c.lane);
                float o[4];
#pragma unroll
                for (int e = 0; e < 4; ++e) o[e] = x[j][e] * rstd * nn[e] * (1.0f + sc[e]) + sh[e];
                uint2 w; w.x = pkh(o[0], o[1]); w.y = pkh(o[2], o[3]);
                *(uint2*)(H + (size_t)row * D + 256 * j + 4 * c.lane) = w; }
        }
    }
}

template <class Epi>
__device__ __forceinline__ void naive_gemm(const f16* A, int lda, const f16* Bt, int K, int N, const Epi& epi, const Ctx& c0) {
    const Ctx c = fresh(c0);
    const size_t total = (size_t)M * N;
    for (size_t idx = c.gt; idx < total; idx += c.ngt) {
        const int m = (int)(idx / N), n = (int)(idx % N);
        const f16* a = A + (size_t)m * lda; const f16* b = Bt + (size_t)n * K;
        float acc = 0.f;
        for (int k = 0; k < K; k += 8) { const f16x8 av = *(const f16x8*)(a + k); const f16x8 bv = *(const f16x8*)(b + k);
#pragma unroll
            for (int e = 0; e < 8; ++e) acc += (float)av[e] * (float)bv[e]; }
        epi(m, n, acc);
    }
}
struct EpiProj { f16* P;
    __device__ __forceinline__ void operator()(int m, int n, float v) const {
        if (n >= PC_LW && n < PC_LA) v = tanhf(v);
        else if ((n >= PC_LG && n < PC_Q) || n >= PC_GR) v = sigmoidf_(v);
        P[(size_t)m * DIN + n] = (f16)v; } };
struct EpiWA { f16* WA; const float* w0; const float* a0;
    __device__ __forceinline__ void operator()(int m, int n, float v) const {
        float o; if (n < 1024) o = __expf(-0.606531f * sigmoidf_(v + w0[n])); else o = sigmoidf_(v + a0[n - 1024]);
        WA[(size_t)m * 2048 + n] = (f16)o; } };
struct EpiF16 { f16* O; int ld;
    __device__ __forceinline__ void operator()(int m, int n, float v) const { O[(size_t)m * ld + n] = (f16)v; } };
struct EpiRelu2 { f16* O; int ld;
    __device__ __forceinline__ void operator()(int m, int n, float v) const { v = fmaxf(v, 0.f); O[(size_t)m * ld + n] = (f16)(v * v); } };
__device__ __forceinline__ void naive_merged(const Params& p, const Ctx& c0) {
    const Ctx c = fresh(c0);
    const f16* OA = (const f16*)(p.ws + WS_R4); const f16* WbrT = (const f16*)(p.ws + WS_W + WO_BR); const f16* PROJ = (const f16*)(p.ws + WS_R1); f16* MG = (f16*)(p.ws + WS_R3);
    const size_t total = (size_t)M * D;
    for (size_t idx = c.gt; idx < total; idx += c.ngt) {
        const int m = (int)(idx / D), n = (int)(idx % D);
        const f16* a = OA + (size_t)m * D; const f16* b = WbrT + (size_t)n * D;
        float acc0 = 0.f, acc1 = 0.f;
        for (int k = 0; k < CW; k += 8) { const f16x8 av = *(const f16x8*)(a + k); const f16x8 bv = *(const f16x8*)(b + k);
#pragma unroll
            for (int e = 0; e < 8; ++e) acc0 += (float)av[e] * (float)bv[e]; }
        for (int k = CW; k < D; k += 8) { const f16x8 av = *(const f16x8*)(a + k); const f16x8 bv = *(const f16x8*)(b + k);
#pragma unroll
            for (int e = 0; e < 8; ++e) acc1 += (float)av[e] * (float)bv[e]; }
        const float sr = (float)PROJ[(size_t)m * DIN + PC_GR + n], sa = (float)PROJ[(size_t)m * DIN + PC_GA + n];
        MG[(size_t)m * D + n] = (f16)(sr * acc0 + sa * acc1);
    }
}


namespace pg8 {
constexpr int BM = 256, BK = 64, HALF = 128, HTB = HALF * BK * 2, STAGE_BYTES = 8 * HTB, NXCD = 8, WGM = 8;
__host__ __device__ __forceinline__ int lds_byte(int r, int c) { const int st = (r >> 4) * 2 + (c >> 5), rr = r & 15, cc = c & 31, ob = rr * 64 + cc * 2; return st * 1024 + (ob ^ (((ob >> 9) & 1) << 5)); }
__host__ __device__ __forceinline__ void stage_rc(int b, int& R, int& C) { const int st = b / 1024, sb = b % 1024, swz = sb ^ (((sb >> 9) & 1) << 5); R = (st >> 1) * 16 + swz / 64; C = (st & 1) * 32 + (swz % 64) / 2; }
__host__ __device__ __forceinline__ int perm32(int rho) { const int n = rho >> 4, i = rho & 15; return 8 * (i >> 2) + 4 * n + (i & 3); }
struct Unit { int pm, pn; };
struct Gemm { const f16* A; const f16* Bt; int lda, ldb, K; };
struct StaticOrder {
    int nM, nN, nwg, G, c;
    __device__ void init(int Mr, int N, int G_, int c_) { nM = Mr / BM; nN = N / BM; nwg = nM * nN; G = G_; c = c_; }
    __device__ bool next(int i, Unit& u) const {
        const long L = (long)i * G + c; if (L >= nwg) return false;
        int wgid = (int)L; { const int q = nwg / NXCD, r = nwg % NXCD, xcd = wgid % NXCD, off = wgid / NXCD; wgid = (xcd < r ? xcd * (q + 1) : r * (q + 1) + (xcd - r) * q) + off; }
        const int nig = WGM * nN, gid = wgid / nig, fm = gid * WGM, gsz = (nM - fm) < WGM ? (nM - fm) : WGM;
        u.pm = fm + ((wgid % nig) % gsz); u.pn = (wgid % nig) / gsz; return true;
    }
};
template <class Epi, bool ALIGN_EPI = true, bool SP2 = true>
__device__ __forceinline__ void gemm_phase(LAS unsigned char* lds, const Gemm g, const StaticOrder& S, const Epi& E) {
    int tid = threadIdx.x; asm volatile("" : "+v"(tid));
    const int wid = __builtin_amdgcn_readfirstlane(tid >> 6), lane = tid & 63, wr = wid >> 2, wc = wid & 3, fr = lane & 15, fq = lane >> 4;
    const int K = g.K, nt = K / BK;
    unsigned voffA[2], voffB[2];
#pragma unroll
    for (int i = 0; i < 2; ++i) { int R, C; stage_rc(tid * 16 + i * 8192, R, C); const int Rb = (R & ~31) + perm32(R & 31);
        voffA[i] = (unsigned)(R * g.lda + C) * 2u; voffB[i] = (unsigned)(Rb * g.ldb + C) * 2u; }
    const unsigned kstep = (unsigned)(BK * 2);
    const unsigned hstepA = (unsigned)HALF * g.lda * 2, hstepB = (unsigned)HALF * g.ldb * 2;
    const unsigned tstepA = 2 * hstepA, tstepB = 2 * hstepB;
    const unsigned ldsw = (unsigned)wid * 1024u;
    const int aoff = lds_byte(wr * 64 + fr, fq * 8), boff = lds_byte(wc * 32 + fr, fq * 8);
#define PG8_SA(b, h) (((b) * 2 + (h)) * HTB)
#define PG8_SB(b, h) ((4 + (b) * 2 + (h)) * HTB)
#define PG8_STAGE(bufoff, gbase, soff, voff) do { _Pragma("unroll") for (int _i = 0; _i < 2; ++_i) \
        __builtin_amdgcn_raw_ptr_buffer_load_lds(rs##gbase, (LAS unsigned*)(lds + (bufoff) + ldsw + _i * 8192), 16, (voff)[_i], (int)(soff), 0, 0); } while (0)
#define PG8_LDA(dst, b, h) do { _Pragma("unroll") for (int m = 0; m < 4; ++m) _Pragma("unroll") for (int k = 0; k < 2; ++k) dst[m][k] = *(const LAS f16x8*)(lds + PG8_SA(b, h) + aoff + m * 2048 + k * 1024); } while (0)
#define PG8_LDB(dst, b, h) do { _Pragma("unroll") for (int n = 0; n < 2; ++n) _Pragma("unroll") for (int k = 0; k < 2; ++k) dst[n][k] = *(const LAS f16x8*)(lds + PG8_SB(b, h) + boff + n * 2048 + k * 1024); } while (0)
#define PG8_MMA(ai, bj, At, Bt) do { __builtin_amdgcn_s_setprio(1); _Pragma("unroll") for (int m = 0; m < 4; ++m) _Pragma("unroll") for (int n = 0; n < 2; ++n) _Pragma("unroll") for (int k = 0; k < 2; ++k) \
        acc[ai][bj][m][n] = __builtin_amdgcn_mfma_f32_16x16x32_f16(Bt[n][k], At[m][k], acc[ai][bj][m][n], 0, 0, 0); __builtin_amdgcn_s_setprio(0); } while (0)
#define PG8_WAIT_V(n) asm volatile("s_waitcnt vmcnt(" #n ")" ::: "memory")
#define PG8_WAIT_L(n) asm volatile("s_waitcnt lgkmcnt(" #n ")" ::: "memory")
#define PG8_BAR __builtin_amdgcn_s_barrier()
#define PG8_SCHED __builtin_amdgcn_sched_barrier(0)
    Unit cur, nxt; int ui = 0;
    if (!S.next(0, cur)) return;
    f32x4 acc[2][2][4][2];
#pragma unroll
    for (int a = 0; a < 2; ++a)
#pragma unroll
        for (int b = 0; b < 2; ++b)
#pragma unroll
            for (int m = 0; m < 4; ++m)
#pragma unroll
                for (int n = 0; n < 2; ++n) acc[a][b][m][n] = (f32x4){0.f, 0.f, 0.f, 0.f};
    f16x8 At[4][2], B0[2][2], B1[2][2];
    const auto rsA = __builtin_amdgcn_make_buffer_rsrc((void*)g.A, 0, 0x7fffffff, 0x00020000); const auto rsB = __builtin_amdgcn_make_buffer_rsrc((void*)g.Bt, 0, 0x7fffffff, 0x00020000);
    unsigned cA = (unsigned)cur.pm * tstepA, cB = (unsigned)cur.pn * tstepB;
    if constexpr (SP2) {
        PG8_STAGE(PG8_SB(0, 0), B, cB, voffB); PG8_STAGE(PG8_SB(0, 1), B, cB + hstepB, voffB); PG8_STAGE(PG8_SA(0, 0), A, cA, voffA); PG8_STAGE(PG8_SA(0, 1), A, cA + hstepA, voffA);
        if (wr == 1) PG8_BAR;
        PG8_WAIT_V(2); PG8_BAR;
        PG8_STAGE(PG8_SB(1, 0), B, cB + kstep, voffB); PG8_STAGE(PG8_SA(1, 0), A, cA + kstep, voffA); PG8_STAGE(PG8_SB(1, 1), B, cB + hstepB + kstep, voffB);
        PG8_WAIT_V(6); PG8_BAR;
    } else {
        PG8_STAGE(PG8_SB(0, 0), B, cB, voffB); PG8_STAGE(PG8_SA(0, 0), A, cA, voffA); PG8_STAGE(PG8_SB(0, 1), B, cB + hstepB, voffB); PG8_STAGE(PG8_SA(0, 1), A, cA + hstepA, voffA);
        if (wr == 1) PG8_BAR;
        PG8_WAIT_V(4); PG8_BAR;
        PG8_STAGE(PG8_SB(1, 0), B, cB + kstep, voffB); PG8_STAGE(PG8_SA(1, 0), A, cA + kstep, voffA); PG8_STAGE(PG8_SB(1, 1), B, cB + hstepB + kstep, voffB);
        PG8_WAIT_V(6); PG8_BAR;
    }
    for (;;) {
        const bool has_next = S.next(ui + 1, nxt);
        const unsigned nA = has_next ? (unsigned)nxt.pm * tstepA : cA, nB = has_next ? (unsigned)nxt.pn * tstepB : cB;
        for (int t = 0; t < nt; t += 2) {
            const bool last = (t == nt - 2);
            const unsigned a1 = cA + (unsigned)(t + 1) * kstep;
            const unsigned a2 = last ? nA : cA + (unsigned)(t + 2) * kstep, b2 = last ? nB : cB + (unsigned)(t + 2) * kstep;
            const unsigned a3 = a2 + kstep, b3 = b2 + kstep;
            if constexpr (SP2) {
            PG8_LDB(B0, 0, 0); PG8_LDB(B1, 0, 1); PG8_SCHED; PG8_LDA(At, 0, 0); PG8_STAGE(PG8_SA(1, 1), A, a1 + hstepA, voffA);
            PG8_WAIT_V(8); PG8_WAIT_L(0); PG8_BAR; PG8_MMA(0, 0, At, B0); PG8_MMA(0, 1, At, B1); PG8_BAR; PG8_SCHED;
            PG8_LDA(At, 0, 1); PG8_STAGE(PG8_SB(0, 0), B, b2, voffB); PG8_STAGE(PG8_SB(0, 1), B, b2 + hstepB, voffB); PG8_STAGE(PG8_SA(0, 0), A, a2, voffA);
            PG8_WAIT_V(8); PG8_WAIT_L(0); PG8_BAR; PG8_MMA(1, 0, At, B0); PG8_MMA(1, 1, At, B1); PG8_BAR; PG8_SCHED;
            PG8_LDB(B0, 1, 0); PG8_LDB(B1, 1, 1); PG8_SCHED; PG8_LDA(At, 1, 0); PG8_STAGE(PG8_SA(0, 1), A, a2 + hstepA, voffA);
            PG8_WAIT_V(8); PG8_WAIT_L(0); PG8_BAR; PG8_MMA(0, 0, At, B0); PG8_MMA(0, 1, At, B1); PG8_BAR; PG8_SCHED;
            PG8_LDA(At, 1, 1); PG8_STAGE(PG8_SB(1, 0), B, b3, voffB); PG8_STAGE(PG8_SB(1, 1), B, b3 + hstepB, voffB); PG8_STAGE(PG8_SA(1, 0), A, a3, voffA);
            PG8_WAIT_V(8); PG8_WAIT_L(0); PG8_BAR; PG8_MMA(1, 0, At, B0); PG8_MMA(1, 1, At, B1); PG8_BAR; PG8_SCHED;
            } else {
            PG8_LDB(B0, 0, 0); PG8_SCHED; PG8_LDA(At, 0, 0); PG8_STAGE(PG8_SA(1, 1), A, a1 + hstepA, voffA);
            PG8_WAIT_L(8); PG8_BAR; PG8_WAIT_L(0); PG8_MMA(0, 0, At, B0); PG8_BAR; PG8_SCHED;
            PG8_LDB(B1, 0, 1); PG8_STAGE(PG8_SB(0, 0), B, b2, voffB);
            PG8_BAR; PG8_WAIT_L(0); PG8_MMA(0, 1, At, B1); PG8_BAR;
            PG8_LDA(At, 0, 1); PG8_STAGE(PG8_SA(0, 0), A, a2, voffA);
            PG8_BAR; PG8_WAIT_L(0); PG8_MMA(1, 0, At, B0); PG8_BAR; PG8_SCHED;
            PG8_STAGE(PG8_SB(0, 1), B, b2 + hstepB, voffB);
            PG8_WAIT_V(6); PG8_BAR; PG8_MMA(1, 1, At, B1); PG8_BAR;
            PG8_LDB(B0, 1, 0); PG8_SCHED; PG8_LDA(At, 1, 0); PG8_STAGE(PG8_SA(0, 1), A, a2 + hstepA, voffA);
            PG8_WAIT_L(8); PG8_BAR; PG8_WAIT_L(0); PG8_MMA(0, 0, At, B0); PG8_BAR; PG8_SCHED;
            PG8_LDB(B1, 1, 1); PG8_STAGE(PG8_SB(1, 0), B, b3, voffB);
            PG8_BAR; PG8_WAIT_L(0); PG8_MMA(0, 1, At, B1); PG8_BAR;
            PG8_LDA(At, 1, 1); PG8_STAGE(PG8_SA(1, 0), A, a3, voffA);
            PG8_BAR; PG8_WAIT_L(0); PG8_MMA(1, 0, At, B0); PG8_BAR; PG8_SCHED;
            PG8_STAGE(PG8_SB(1, 1), B, b3 + hstepB, voffB);
            PG8_WAIT_V(6); PG8_BAR; PG8_MMA(1, 1, At, B1); PG8_BAR;
            }
        }
        if constexpr (ALIGN_EPI) { if (wr == 0) PG8_BAR; }
        E(acc, cur, wr, wc, fr, fq);
        if (!has_next) break;
#pragma unroll
        for (int a = 0; a < 2; ++a)
#pragma unroll
            for (int b = 0; b < 2; ++b)
#pragma unroll
                for (int m = 0; m < 4; ++m)
#pragma unroll
                    for (int n = 0; n < 2; ++n) acc[a][b][m][n] = (f32x4){0.f, 0.f, 0.f, 0.f};
        cur = nxt; cA = nA; cB = nB; ++ui;
        if constexpr (ALIGN_EPI) { if (wr == 1) PG8_BAR; }
    }
    PG8_WAIT_V(0);
    if constexpr (!ALIGN_EPI) { if (wr == 0) PG8_BAR; }
    PG8_BAR;
#undef PG8_SA
#undef PG8_SB
#undef PG8_STAGE
#undef PG8_LDA
#undef PG8_LDB
#undef PG8_MMA
#undef PG8_WAIT_V
#undef PG8_WAIT_L
#undef PG8_BAR
#undef PG8_SCHED
}
typedef f32x4 Acc[2][2][4][2];
#define PG8_EPI_LOOP(...) \
    const int row0 = u.pm * BM + wr * 64 + fr, col0 = u.pn * BM + wc * 32 + 8 * fq; \
    _Pragma("unroll") for (int ai = 0; ai < 2; ++ai) _Pragma("unroll") for (int m = 0; m < 4; ++m) { const int row = row0 + ai * HALF + m * 16; \
        _Pragma("unroll") for (int bj = 0; bj < 2; ++bj) { const int col = col0 + bj * HALF; f32x4 v0 = acc[ai][bj][m][0], v1 = acc[ai][bj][m][1]; __VA_ARGS__ } asm volatile("" ::: "memory"); }
__device__ __forceinline__ void store8(f16* p, f32x4 v0, f32x4 v1) { v4u w; w.x = pkh(v0[0], v0[1]); w.y = pkh(v0[2], v0[3]); w.z = pkh(v1[0], v1[1]); w.w = pkh(v1[2], v1[3]); *(v4u*)p = w; }
struct EpiProjF { f16* P;
    __device__ __forceinline__ void operator()(const Acc& acc, const Unit& u, int wr, int wc, int fr, int fq) const {
        PG8_EPI_LOOP(
            if (u.pn == 6) {
                if (col < PC_LA) { _Pragma("unroll") for (int e = 0; e < 4; ++e) { v0[e] = tanhf_(v0[e]); v1[e] = tanhf_(v1[e]); } }
                else if (col >= PC_LG) { _Pragma("unroll") for (int e = 0; e < 4; ++e) { v0[e] = sigmoidf_(v0[e]); v1[e] = sigmoidf_(v1[e]); } }
            } else if (u.pn >= 10) { _Pragma("unroll") for (int e = 0; e < 4; ++e) { v0[e] = sigmoidf_(v0[e]); v1[e] = sigmoidf_(v1[e]); } }
            store8(P + (size_t)row * DIN + col, v0, v1);
        )
    } };
struct EpiWAF { f16* WA; const float* w0; const float* a0;
    __device__ __forceinline__ void operator()(const Acc& acc, const Unit& u, int wr, int wc, int fr, int fq) const {
        PG8_EPI_LOOP(
            if (col < 1024) { const f32x4 b0 = *(const f32x4*)(w0 + col), b1 = *(const f32x4*)(w0 + col + 4);
                _Pragma("unroll") for (int e = 0; e < 4; ++e) { v0[e] = __expf(-0.606531f * sigmoidf_(v0[e] + b0[e])); v1[e] = __expf(-0.606531f * sigmoidf_(v1[e] + b1[e])); } }
            else { const f32x4 b0 = *(const f32x4*)(a0 + col - 1024), b1 = *(const f32x4*)(a0 + col - 1024 + 4);
                _Pragma("unroll") for (int e = 0; e < 4; ++e) { v0[e] = sigmoidf_(v0[e] + b0[e]); v1[e] = sigmoidf_(v1[e] + b1[e]); } }
            store8(WA + (size_t)row * 2048 + col, v0, v1);
        )
    } };
struct EpiF16F { f16* O; int ld;
    __device__ __forceinline__ void operator()(const Acc& acc, const Unit& u, int wr, int wc, int fr, int fq) const {
        PG8_EPI_LOOP( store8(O + (size_t)row * ld + col, v0, v1); )
    } };
struct EpiRelu2F { f16* O; int ld;
    __device__ __forceinline__ void operator()(const Acc& acc, const Unit& u, int wr, int wc, int fr, int fq) const {
        PG8_EPI_LOOP(
            _Pragma("unroll") for (int e = 0; e < 4; ++e) { const float a = fmaxf(v0[e], 0.f), b = fmaxf(v1[e], 0.f); v0[e] = a * a; v1[e] = b * b; }
            store8(O + (size_t)row * ld + col, v0, v1);
        )
    } };
template <int PASS> struct EpiMergeF { f16* MG; const f16* PROJ;
    __device__ __forceinline__ void operator()(const Acc& acc, const Unit& u, int wr, int wc, int fr, int fq) const {
        PG8_EPI_LOOP(
            const f16x8 gt = *(const f16x8*)(PROJ + (size_t)row * DIN + (PASS == 0 ? PC_GR : PC_GA) + col);
            _Pragma("unroll") for (int e = 0; e < 4; ++e) { v0[e] *= (float)gt[e]; v1[e] *= (float)gt[4 + e]; }
            if (PASS == 1) { const f16x8 pv = *(const f16x8*)(MG + (size_t)row * D + col);
                _Pragma("unroll") for (int e = 0; e < 4; ++e) { v0[e] += (float)pv[e]; v1[e] += (float)pv[4 + e]; } }
            store8(MG + (size_t)row * D + col, v0, v1);
        )
    } };
}

__device__ __forceinline__ void kv_prep(const Params& p, const Ctx& c0, int l) {
    const Ctx c = fresh(c0);
    const f16* PROJ = (const f16*)(p.ws + WS_R1); f16* KN = (f16*)(p.ws + WS_KN); f16* VT = (f16*)(p.ws + WS_VT);
    const float kg = p.in[27][l * HD + c.lane];
    const int d = c.lane;
    for (int it = c.gw; it < M * 2; it += c.ngw) {
        const int row = it >> 1, kvh = it & 1;
        float kx = (float)PROJ[(size_t)row * DIN + PC_KA + kvh * HD + d]; const float vx = (float)PROJ[(size_t)row * DIN + PC_VA + kvh * HD + d];
        const float rstd = rsqrtf(wave_sum(kx * kx) * (1.0f / HD) + 1e-6f);
        kx = kx * rstd * kg;
        if (row < M_CTX) { const int b = row >> 8, t = row & 255;
            p.out[O_CK + ((((size_t)b * NL + l) * T_CTX + t) * 2 + kvh) * HD + d] = kx;
            p.out[O_CV + ((((size_t)b * NL + l) * T_CTX + t) * 2 + kvh) * HD + d] = vx;
            KN[(((size_t)b * 2 + kvh) * T_CTX + t) * HD + d] = (f16)kx;
            VT[(((size_t)b * 2 + kvh) * HD + d) * T_CTX + t] = (f16)vx;
        } else { const int r = row - M_CTX, b = r >> 10, t = r & 1023;
            const int axis = d >> 5, half = (d >> 4) & 1, f = d & 15;
            const float pos = (float)(axis == 0 ? (t >> 6) : (t & 63));
            const float freq = exp2f(-(float)f * (13.287712379549449f / 16.0f));
            const float ang = pos * freq; const float cs = cosf(ang), sn = sinf(ang);
            const float other = __shfl_xor(kx, 16);
            const float ko = half == 0 ? kx * cs - other * sn : kx * cs + other * sn;
            KN[KN_SMP_OFF + (((size_t)b * 2 + kvh) * KV_SMP + PAST + t) * HD + d] = (f16)ko;
            VT[KN_SMP_OFF + (((size_t)b * 2 + kvh) * HD + d) * KV_SMP + PAST + t] = (f16)vx;
        }
    }
    for (int it = c.gw; it < B_SMP * PAST * 2; it += c.ngw) {
        const int kvh = it & 1, j = (it >> 1) & 255, b = it >> 9;
        const size_t src = ((((size_t)b * NL + l) * PAST + j) * 2 + kvh) * HD + d;
        KN[KN_SMP_OFF + (((size_t)b * 2 + kvh) * KV_SMP + j) * HD + d] = (f16)p.in[2][src];
        VT[KN_SMP_OFF + (((size_t)b * 2 + kvh) * HD + d) * KV_SMP + j] = (f16)p.in[3][src];
    }
}

__device__ __forceinline__ void naive_scan(const Params& p, const Ctx& c0, int l) {
    const Ctx c = fresh(c0);
    const f16* PROJ = (const f16*)(p.ws + WS_R1); const f16* WA = (const f16*)(p.ws + WS_R2);
    f16* Y = (f16*)(p.ws + WS_R3); float* RK = (float*)(p.ws + WS_RK);
    LAS float* st = (LAS float*)(c.lds + c.wave * 2048);
    const int NSCAN = (B_CTX + B_SMP) * 2 * NH;
    for (int it = c.gw; it < NSCAN; it += c.ngw) {
        const int h = it & 7, dir = (it >> 3) & 1, sq = it >> 4;
        const bool smp = sq >= B_CTX; const int T = smp ? T_SMP : T_CTX; const int row0 = smp ? M_CTX + (sq - B_CTX) * T_SMP : sq * T_CTX;
        const int ch = h * HD + c.lane;
        const float mu_r = p.in[15][(l * 3 + 0) * CW + ch], mu_k = p.in[15][(l * 3 + 1) * CW + ch], mu_v = p.in[15][(l * 3 + 2) * CW + ch];
        const float k_k = p.in[16][l * CW + ch], k_a = p.in[17][l * CW + ch], r_k = p.in[18][l * CW + ch];
        float S[64];
        if (smp) { const float* s0 = p.in[4] + (((((size_t)(sq - B_CTX) * NL + l) * 2 + dir) * NH + h) * HD + c.lane) * HD;
#pragma unroll
            for (int k = 0; k < 64; ++k) S[k] = s0[k];
        } else {
#pragma unroll
            for (int k = 0; k < 64; ++k) S[k] = 0.f;
        }
        for (int s = 0; s < T; ++s) {
            const int t = dir == 0 ? s : T - 1 - s; const size_t row = (size_t)row0 + t;
            const f16* pr = PROJ + row * DIN;
            const float rc = (float)pr[PC_R + ch], kc = (float)pr[PC_K + ch], vc = (float)pr[PC_V + ch];
            float rp = 0.f, kp = 0.f, vp = 0.f, rn = 0.f, kn = 0.f, vn = 0.f;
            if (t > 0) { rp = (float)pr[PC_R + ch - DIN]; kp = (float)pr[PC_K + ch - DIN]; vp = (float)pr[PC_V + ch - DIN]; }
            if (t < T - 1) { rn = (float)pr[PC_R + ch + DIN]; kn = (float)pr[PC_K + ch + DIN]; vn = (float)pr[PC_V + ch + DIN]; }
            const float r = rc + mu_r * (0.5f * (rp + rn) - rc), k = kc + mu_k * (0.5f * (kp + kn) - kc), v = vc + mu_v * (0.5f * (vp + vn) - vc);
            const float kk = k * k_k; const float kh = kk * rsqrtf(wave_sum(kk * kk) + 1e-12f);
            const float w = (float)WA[row * 2048 + dir * 512 + ch], a = (float)WA[row * 2048 + 1024 + dir * 512 + ch];
            const float kt = k * (1.0f + (a - 1.0f) * k_a), bb = a * kh;
            const float rks = wave_sum(r * kt * r_k);
            if (c.lane == 0) RK[((size_t)dir * M + row) * 8 + h] = rks;
            LDS_WAIT();
            st[c.lane] = kh; st[64 + c.lane] = w; st[128 + c.lane] = bb; st[192 + c.lane] = kt; st[256 + c.lane] = r;
            LDS_WAIT();
            float sk = 0.f;
#pragma unroll
            for (int k4 = 0; k4 < 64; k4 += 4) { const f32x4 q = *(const LAS f32x4*)(st + k4); sk += S[k4] * q[0] + S[k4 + 1] * q[1] + S[k4 + 2] * q[2] + S[k4 + 3] * q[3]; }
            float y = 0.f;
#pragma unroll
            for (int k4 = 0; k4 < 64; k4 += 4) { const f32x4 wq = *(const LAS f32x4*)(st + 64 + k4), bq = *(const LAS f32x4*)(st + 128 + k4), tq = *(const LAS f32x4*)(st + 192 + k4), rq = *(const LAS f32x4*)(st + 256 + k4);
#pragma unroll
                for (int e = 0; e < 4; ++e) { S[k4 + e] = S[k4 + e] * wq[e] - sk * bq[e] + v * tq[e]; y += S[k4 + e] * rq[e]; } }
            Y[((size_t)dir * M + row) * CW + ch] = (f16)y;
        }
        if (!smp) { float* so = p.out + O_ST + (((((size_t)sq * NL + l) * 2 + dir) * NH + h) * HD + c.lane) * HD;
#pragma unroll
            for (int k = 0; k < 64; ++k) so[k] = S[k]; }
    }
}

__device__ __forceinline__ void naive_attn(const Params& p, const Ctx& c0, int l) {
    const Ctx c = fresh(c0);
    const f16* PROJ = (const f16*)(p.ws + WS_R1); const f16* KN = (const f16*)(p.ws + WS_KN); const f16* VT = (const f16*)(p.ws + WS_VT);
    f16* OA = (f16*)(p.ws + WS_R4);
    LAS float* ps = (LAS float*)(c.lds + 16384 + c.wave * 8192);
    const float qg = p.in[26][l * HD + c.lane];
    for (int it = c.gw; it < M * NH; it += c.ngw) {
        const int row = it >> 3, hq = it & 7, kvh = hq >> 2, d = c.lane;
        float qx = (float)PROJ[(size_t)row * DIN + PC_Q + hq * HD + d];
        qx = qx * rsqrtf(wave_sum(qx * qx) * (1.0f / HD) + 1e-6f) * qg;
        const f16* Kb; const f16* Vb; int L;
        if (row < M_CTX) { const int b = row >> 8; Kb = KN + ((size_t)b * 2 + kvh) * T_CTX * HD; Vb = VT + ((size_t)b * 2 + kvh) * HD * T_CTX; L = T_CTX; }
        else { const int r = row - M_CTX, b = r >> 10, t = r & 1023;
            const int axis = d >> 5, half = (d >> 4) & 1, f = d & 15;
            const float pos = (float)(axis == 0 ? (t >> 6) : (t & 63));
            const float ang = pos * exp2f(-(float)f * (13.287712379549449f / 16.0f)); const float cs = cosf(ang), sn = sinf(ang);
            const float other = __shfl_xor(qx, 16);
            qx = half == 0 ? qx * cs - other * sn : qx * cs + other * sn;
            Kb = KN + KN_SMP_OFF + ((size_t)b * 2 + kvh) * KV_SMP * HD; Vb = VT + KN_SMP_OFF + ((size_t)b * 2 + kvh) * HD * KV_SMP; L = KV_SMP; }
        LDS_WAIT();
        ps[d] = qx * 0.125f;
        LDS_WAIT();
        float mx = -1e30f;
        for (int j = c.lane; j < L; j += 64) { float s = 0.f;
#pragma unroll
            for (int k8 = 0; k8 < 64; k8 += 8) { const f16x8 kv = *(const f16x8*)(Kb + (size_t)j * HD + k8);
#pragma unroll
                for (int e = 0; e < 8; ++e) s += ps[k8 + e] * (float)kv[e]; }
            ps[64 + j] = s; mx = fmaxf(mx, s); }
        mx = wave_max(mx);
        float sum = 0.f;
        for (int j = c.lane; j < L; j += 64) { const float e = __expf(ps[64 + j] - mx); ps[64 + j] = e; sum += e; }
        sum = wave_sum(sum);
        LDS_WAIT();
        float o = 0.f;
        for (int j = 0; j < L; j += 8) { const f16x8 vv = *(const f16x8*)(Vb + (size_t)d * L + j);
#pragma unroll
            for (int e = 0; e < 8; ++e) o += ps[64 + j + e] * (float)vv[e]; }
        OA[(size_t)row * D + CW + hq * HD + d] = (f16)(o / sum);
    }
}

__device__ __forceinline__ void post_phase(const Params& p, const Ctx& c0, int l) {
    const Ctx c = fresh(c0);
    const f16* PROJ = (const f16*)(p.ws + WS_R1); const f16* Y = (const f16*)(p.ws + WS_R3); const float* RK = (const float*)(p.ws + WS_RK);
    const f16* WgT = (const f16*)(p.ws + WS_W + WO_G); f16* OA = (f16*)(p.ws + WS_R4);
    for (int it = c.gw; it < M * NH; it += c.ngw) {
        const int row = it >> 3, h = it & 7, ch = h * HD + c.lane;
        int g, t, T; row_info(row, g, t, T);
        const float y = (float)Y[(size_t)row * CW + ch] + (float)Y[((size_t)M + row) * CW + ch];
        const float mean = wave_sum(y) * (1.0f / HD); const float dy = y - mean; const float var = wave_sum(dy * dy) * (1.0f / HD);
        const float yn = dy * rsqrtf(var + 64e-5f) * p.in[24][l * CW + ch] + p.in[25][l * CW + ch];
        const f16* pr = PROJ + (size_t)row * DIN;
        const float vc = (float)pr[PC_V + ch]; float vp = 0.f, vn = 0.f;
        if (t > 0) vp = (float)pr[PC_V + ch - DIN];
        if (t < T - 1) vn = (float)pr[PC_V + ch + DIN];
        const float v = vc + p.in[15][(l * 3 + 2) * CW + ch] * (0.5f * (vp + vn) - vc);
        const float bonus = (RK[(size_t)row * 8 + h] + RK[((size_t)M + row) * 8 + h]) * v;
        float gs = 0.f;
        for (int k = 0; k < 128; k += 8) { const f16x8 a = *(const f16x8*)(pr + PC_LG + k); const f16x8 b = *(const f16x8*)(WgT + (size_t)ch * 128 + k);
#pragma unroll
            for (int e = 0; e < 8; ++e) gs += (float)a[e] * (float)b[e]; }
        OA[(size_t)row * D + ch] = (f16)((yn + bonus) * gs);
    }
}

__global__ void __launch_bounds__(NTHREADS, 2) fwd_kernel(Params p) {
    extern __shared__ __attribute__((aligned(16))) unsigned char lds_raw[];
    Ctx c;
    c.lds = (LAS unsigned char*)lds_raw;
    c.tid = threadIdx.x; c.lane = c.tid & 63; c.wave = __builtin_amdgcn_readfirstlane(c.tid >> 6);
    c.gw = blockIdx.x * NWAVES + c.wave; c.ngw = gridDim.x * NWAVES; c.gt = blockIdx.x * NTHREADS + c.tid; c.ngt = gridDim.x * NTHREADS;
    volatile LAS unsigned* MISC = (volatile LAS unsigned*)(c.lds + MISC_OFF);
    if (c.tid < 32) MISC[c.tid] = 0u;
    __syncthreads();
    unsigned* ctl = (unsigned*)(p.ws + WS_CTL);
    XcdBarrier bar = xcd_barrier_post(ctl + CW_BAR, MISC + 8);
#define GRID_BAR() xcd_barrier(bar)

    unsigned char* wb = p.ws + WS_W;
    const f16* WinT = (const f16*)(wb + WO_IN); const f16* WoutT = (const f16*)(wb + WO_OUT); const f16* WupT = (const f16*)(wb + WO_UP); const f16* WdnT = (const f16*)(wb + WO_DN);
    const f16* WsmT = (const f16*)(wb + WO_SM);
    f16* PROJ = (f16*)(p.ws + WS_R1); f16* HID = (f16*)(p.ws + WS_R1); f16* WA = (f16*)(p.ws + WS_R2); f16* MO = (f16*)(p.ws + WS_R2);
    f16* MG = (f16*)(p.ws + WS_R3); f16* H = (f16*)(p.ws + WS_R4); const f16* OA = (const f16*)(p.ws + WS_R4); const f16* WbrT = (const f16*)(wb + WO_BR);

    conv_weights(p, c, 0);
    __syncthreads();
    mod_phase(p, c);
    GRID_BAR();
    norm_phase<0>(p, c, 0);
    GRID_BAR();
#pragma nounroll
    for (int l = 0; l < NL; ++l) {
        { pg8::Gemm g{H, WinT, D, D, D}; pg8::StaticOrder S; S.init(M, DIN, (int)gridDim.x, (int)blockIdx.x); pg8::gemm_phase(c.lds, g, S, pg8::EpiProjF{PROJ}); }
        GRID_BAR();
        { pg8::Gemm g{PROJ + PC_LW, WsmT, DIN, 128, 128}; pg8::StaticOrder S; S.init(M, 2048, (int)gridDim.x, (int)blockIdx.x);
          pg8::gemm_phase(c.lds, g, S, pg8::EpiWAF{WA, p.in[19] + (size_t)l * 2 * CW, p.in[21] + (size_t)l * 2 * CW}); }
        kv_prep(p, c, l);
        GRID_BAR();
        naive_scan(p, c, l);
        naive_attn(p, c, l);
        GRID_BAR();
        post_phase(p, c, l);
        GRID_BAR();
        { pg8::StaticOrder S; S.init(M, D, (int)gridDim.x, (int)blockIdx.x);
          pg8::Gemm g0{OA, WbrT, D, D, CW}; pg8::gemm_phase(c.lds, g0, S, pg8::EpiMergeF<0>{MG, PROJ});
          pg8::Gemm g1{OA + CW, WbrT + CW, D, D, CW}; pg8::gemm_phase(c.lds, g1, S, pg8::EpiMergeF<1>{MG, PROJ}); }
        GRID_BAR();
        { pg8::Gemm g{MG, WoutT, D, D, D}; pg8::StaticOrder S; S.init(M, D, (int)gridDim.x, (int)blockIdx.x); pg8::gemm_phase(c.lds, g, S, pg8::EpiF16F{MO, D}); }
        GRID_BAR();
        norm_phase<1>(p, c, l);
        GRID_BAR();
        { pg8::Gemm g{H, WupT, D, D, D}; pg8::StaticOrder S; S.init(M, DFF, (int)gridDim.x, (int)blockIdx.x); pg8::gemm_phase(c.lds, g, S, pg8::EpiRelu2F{HID, DFF}); }
        GRID_BAR();
        { pg8::Gemm g{HID, WdnT, DFF, DFF, DFF}; pg8::StaticOrder S; S.init(M, D, (int)gridDim.x, (int)blockIdx.x); pg8::gemm_phase(c.lds, g, S, pg8::EpiF16F{MO, D}); }
        GRID_BAR();
        norm_phase<2>(p, c, l);
        if (l + 1 < NL) { __syncthreads(); conv_weights(p, c, l + 1); }
        GRID_BAR();
    }
}

extern "C" void kernel_launch(void* const* d_in, const int* in_sizes, int n_in, void* d_out, int out_size, void* d_ws, size_t ws_size, hipStream_t stream) {
    static int grid = 0;
    if (grid == 0) {
        if (n_in != 28 || (size_t)out_size != O_TOTAL || ws_size < WS_END) { fprintf(stderr, "kernel_launch: unexpected shapes n_in %d out %d ws %zu\n", n_in, out_size, ws_size); grid = -1; return; }
        int dev = 0, cus = 0;
        if (hipGetDevice(&dev) != hipSuccess || hipDeviceGetAttribute(&cus, hipDeviceAttributeMultiprocessorCount, dev) != hipSuccess) { grid = -1; return; }
        if (hipFuncSetAttribute((const void*)fwd_kernel, hipFuncAttributeMaxDynamicSharedMemorySize, LDS_BYTES) != hipSuccess) { fprintf(stderr, "kernel_launch: hipFuncSetAttribute failed\n"); grid = -1; return; }
        grid = cus;
    }
    if (grid < 0) return;
    (void)hipMemsetAsync((char*)d_ws + WS_CTL, 0, CTL_BYTES, stream);
    Params p{};
    for (int i = 0; i < 28; ++i) p.in[i] = (const float*)d_in[i];
    p.out = (float*)d_out; p.ws = (unsigned char*)d_ws;
    hipLaunchKernelGGL(fwd_kernel, dim3(grid), dim3(NTHREADS), LDS_BYTES, stream, p);
}
```

```cpp
#include <hip/hip_runtime.h>
#include <cstdio>
#include <cstdint>

#define GAS __attribute__((address_space(1)))
#define LAS __attribute__((address_space(3)))
typedef _Float16 f16;
typedef _Float16 f16x8 __attribute__((ext_vector_type(8)));
typedef _Float16 f16x4 __attribute__((ext_vector_type(4)));
typedef _Float16 f16x2 __attribute__((ext_vector_type(2)));
typedef float f32x4 __attribute__((ext_vector_type(4)));
typedef unsigned v4u __attribute__((ext_vector_type(4)));

constexpr int D = 1024, DIN = 4608, DFF = 4096, CW = 512, NL = 2, NH = 8, HD = 64;
constexpr int B_CTX = 32, T_CTX = 256, B_SMP = 4, T_SMP = 1024, PAST = 256, KV_SMP = PAST + T_SMP;
constexpr int M_CTX = B_CTX * T_CTX, M_SMP = B_SMP * T_SMP, M = M_CTX + M_SMP;
constexpr int NMOD = 6 * D;
constexpr int PC_R = 0, PC_K = 512, PC_V = 1024, PC_LW = 1536, PC_LA = 1600, PC_LG = 1664, PC_Q = 1792, PC_KA = 2304, PC_VA = 2432, PC_GR = 2560, PC_GA = 3584;
constexpr size_t O_Y = 0, O_CK = (size_t)M * D, O_CV = O_CK + (size_t)B_CTX * NL * T_CTX * 128, O_ST = O_CV + (size_t)B_CTX * NL * T_CTX * 128;
constexpr size_t O_TOTAL = O_ST + (size_t)B_CTX * NL * 2 * NH * HD * HD;

constexpr size_t MiB = 1u << 20;
constexpr size_t WS_CTL = 0, CTL_BYTES = 1 * MiB;
constexpr size_t WS_MOD = 1 * MiB;
constexpr size_t WS_W = 2 * MiB;
constexpr size_t WO_IN = 0, WO_BR = 9 * MiB, WO_OUT = 11 * MiB, WO_UP = 13 * MiB, WO_DN = 21 * MiB, WO_SM = 29 * MiB, WO_G = 29 * MiB + 512 * 1024;
constexpr size_t WS_R1 = 32 * MiB;
constexpr size_t WS_R2 = 140 * MiB;
constexpr size_t WS_R3 = 188 * MiB;
constexpr size_t WS_RK = 212 * MiB;
constexpr size_t WS_R4 = 213 * MiB;
constexpr size_t WS_KN = 237 * MiB;
constexpr size_t WS_VT = 241 * MiB;
constexpr size_t WS_END = 245 * MiB;
constexpr size_t KN_SMP_OFF = (size_t)B_CTX * 2 * T_CTX * 64;

constexpr int NWAVES = 8, NTHREADS = 512;
constexpr int LDS_BYTES = 147456;
constexpr int MISC_OFF = 131072 + 320, PTAB_OFF = 131072 + 1024;

#define XB_TMO      128
#define XB_XCNT(j)  (256  + 64 * (j))
#define XB_XSUB(j)  (1280 + 64 * (j))
#define XB_XGEN(j)  (2304 + 64 * (j))
#define XB_TOP      3328
#define XB_TOPGEN   3392
#define XCD_BAR_WORDS 3456
#define XB_SPIN_CAP (1u << 24)
constexpr int CW_BAR = 4096;

__device__ __forceinline__ unsigned xb_ld(unsigned* p)              { return __hip_atomic_load(p, __ATOMIC_RELAXED, __HIP_MEMORY_SCOPE_AGENT); }
__device__ __forceinline__ unsigned xb_add(unsigned* p, unsigned v) { return __hip_atomic_fetch_add(p, v, __ATOMIC_RELAXED, __HIP_MEMORY_SCOPE_AGENT); }
__device__ __forceinline__ unsigned xb_xcc_id() { return (unsigned)__builtin_amdgcn_s_getreg((3 << 11) | 20) & 0xFu; }
#define XB_SPIN(cond, bar) do { unsigned _sp = 0; while (cond) { __builtin_amdgcn_s_sleep(1); \
    if ((++_sp & 255u) == 0u) { if (xb_ld(&(bar)[XB_TMO])) break; if (_sp > XB_SPIN_CAP) { atomicAdd(&(bar)[XB_TMO], 1u); break; } } } } while (0)

struct XcdBarrier { unsigned* bar; unsigned x; volatile LAS unsigned* st; };

__device__ __forceinline__ XcdBarrier xcd_barrier_post(unsigned* bar, volatile LAS unsigned* st) {
    XcdBarrier b; b.bar = bar; b.x = xb_xcc_id(); b.st = st;
    if (threadIdx.x == 0) (void)xb_add(&bar[XB_XCNT(b.x)], 1u);
    return b;
}
__device__ __forceinline__ void xcd_barrier_complete(unsigned* bar, unsigned x, unsigned& nloc, unsigned& nx) {
    const unsigned G = gridDim.x * gridDim.y * gridDim.z;
    unsigned sum, cnt, mine, sp = 0u;
    for (;;) {
        sum = 0u; cnt = 0u; mine = 0u;
#pragma unroll
        for (unsigned j = 0; j < 16; ++j) { const unsigned c = xb_ld(&bar[XB_XCNT(j)]); sum += c; cnt += (c > 0u) ? 1u : 0u; mine = (j == x) ? c : mine; }
        if (sum == G) break;
        __builtin_amdgcn_s_sleep(1);
        if ((++sp & 255u) == 0u) { if (xb_ld(&bar[XB_TMO])) break; if (sp > XB_SPIN_CAP) { atomicAdd(&bar[XB_TMO], 1u); break; } }
    }
    nloc = mine > 0u ? mine : 1u; nx = cnt > 0u ? cnt : 1u;
}
__device__ __forceinline__ void xcd_barrier(const XcdBarrier& b) {
    asm volatile("s_waitcnt vmcnt(0)" ::: "memory");
    __syncthreads();
    if (threadIdx.x == 0) {
        unsigned* bar = b.bar; unsigned bx = b.x;
        asm volatile("" : "+s"(bar), "+s"(bx));
        __builtin_amdgcn_s_waitcnt(0);
        unsigned nloc = b.st[0], nx = b.st[1];
        if (nloc == 0u) { xcd_barrier_complete(bar, bx, nloc, nx); b.st[0] = nloc; b.st[1] = nx; }
        const unsigned old = xb_add(&bar[XB_XSUB(bx)], 1u);
        const unsigned gen = old / nloc;
        if (old + 1u == (gen + 1u) * nloc) {
            __builtin_amdgcn_fence(__ATOMIC_RELEASE, "agent");
            asm volatile("s_waitcnt vmcnt(0)" ::: "memory");
            const unsigned og = xb_add(&bar[XB_TOP], 1u);
            const unsigned tg = og / nx;
            if (og + 1u == (tg + 1u) * nx) xb_add(&bar[XB_TOPGEN], 1u);
            else XB_SPIN(xb_ld(&bar[XB_TOPGEN]) == tg, bar);
            __builtin_amdgcn_fence(__ATOMIC_ACQUIRE, "agent");
            xb_add(&bar[XB_XGEN(bx)], 1u);
            asm volatile("s_waitcnt vmcnt(0)" ::: "memory");
        } else {
            XB_SPIN(xb_ld(&bar[XB_XGEN(bx)]) == gen, bar);
            __builtin_amdgcn_fence(__ATOMIC_ACQUIRE, "agent");
            asm volatile("s_waitcnt vmcnt(0)" ::: "memory");
        }
    }
    __syncthreads();
}

#define LDS_WAIT() asm volatile("s_waitcnt lgkmcnt(0)" ::: "memory")
__device__ __forceinline__ float wave_sum(float v) {
#pragma unroll
    for (int o = 1; o < 64; o <<= 1) v += __shfl_xor(v, o);
    return v;
}
__device__ __forceinline__ float wave_max(float v) {
#pragma unroll
    for (int o = 1; o < 64; o <<= 1) v = fmaxf(v, __shfl_xor(v, o));
    return v;
}
__device__ __forceinline__ float sigmoidf_(float x) { return 1.0f / (1.0f + __expf(-x)); }
__device__ __forceinline__ float tanhf_(float x) { return 1.0f - 2.0f / (1.0f + __expf(2.0f * x)); }
__device__ __forceinline__ unsigned pkh(float lo, float hi) { f16x2 v = {(f16)lo, (f16)hi}; return __builtin_bit_cast(unsigned, v); }
__device__ __forceinline__ void row_info(int row, int& g, int& t, int& T) {
    if (row < M_CTX) { g = 0; t = row & (T_CTX - 1); T = T_CTX; }
    else { const int r = row - M_CTX; g = 1 + (r >> 10); t = r & (T_SMP - 1); T = T_SMP; }
}

struct Params {
    const float* in[28];
    float* out;
    unsigned char* ws;
};
struct Ctx {
    LAS unsigned char* lds;
    int tid, lane, wave, gw, ngw, gt, ngt;
};
__device__ __forceinline__ int lane_id() { int ln; asm volatile("v_mbcnt_lo_u32_b32 %0, -1, 0\n\tv_mbcnt_hi_u32_b32 %0, -1, %0" : "=v"(ln)); return ln; }
__device__ __forceinline__ const float* inp(const Ctx& c, int i) {
    const unsigned long long v = ((const LAS unsigned long long*)(c.lds + PTAB_OFF))[i];
    const unsigned lo = __builtin_amdgcn_readfirstlane((unsigned)v), hi = __builtin_amdgcn_readfirstlane((unsigned)(v >> 32));
    return (const float*)(((unsigned long long)hi << 32) | lo); }
#define IN(i) inp(c, (i))
__device__ __forceinline__ Ctx fresh(const Ctx& c0) {
    Ctx c = c0; int w = c0.wave; asm volatile("" : "+s"(w)); int ln = lane_id(); asm volatile("" : "+v"(ln));
    c.wave = w; c.lane = ln; c.tid = w * 64 + ln;
    c.gw = blockIdx.x * 8 + w; c.gt = blockIdx.x * 512 + c.tid; return c; }

__device__ __forceinline__ void conv_item(const float* W, int N, f16* WT, int ldt, int koff, LAS float* scr, int kb, int nb, int lane) {
    const int k0 = 64 * kb, n0 = 32 * nb;
#pragma unroll 8
    for (int i = 0; i < 32; ++i) { const int kk = 2 * i + (lane >> 5); scr[kk * 33 + (lane & 31)] = W[(size_t)(k0 + kk) * N + n0 + (lane & 31)]; }
    LDS_WAIT();
    const int c = lane & 7;
#pragma unroll
    for (int j = 0; j < 4; ++j) { const int n = (lane >> 3) + 8 * j; const LAS float* s = scr + (8 * c) * 33 + n;
        v4u o; o.x = pkh(s[0 * 33], s[1 * 33]); o.y = pkh(s[2 * 33], s[3 * 33]); o.z = pkh(s[4 * 33], s[5 * 33]); o.w = pkh(s[6 * 33], s[7 * 33]);
        *(v4u*)(WT + (size_t)(n0 + n) * ldt + koff + k0 + 8 * c) = o; }
    LDS_WAIT();
}
__device__ __forceinline__ void conv_weights(const Params& p, const Ctx& c0, int l) {
    const Ctx c = fresh(c0);
    LAS float* scr = (LAS float*)(c.lds + c.wave * 16384);
    unsigned char* wb = p.ws + WS_W;
    f16* WinT = (f16*)(wb + WO_IN); f16* WbrT = (f16*)(wb + WO_BR); f16* WoutT = (f16*)(wb + WO_OUT); f16* WupT = (f16*)(wb + WO_UP); f16* WdnT = (f16*)(wb + WO_DN);
    f16* WsmT = (f16*)(wb + WO_SM); f16* WgT = (f16*)(wb + WO_G);
    const float* w_in = IN(7) + (size_t)l * D * DIN; const float* w_br = IN(8) + (size_t)l * 2 * CW * D; const float* w_out = IN(9) + (size_t)l * D * D;
    const float* w_up = IN(13) + (size_t)l * D * DFF; const float* w_dn = IN(14) + (size_t)l * DFF * D;
    const float* dec_up = IN(20) + (size_t)l * 2 * 64 * CW; const float* icl_up = IN(22) + (size_t)l * 2 * 64 * CW; const float* gate_up = IN(23) + (size_t)l * 128 * CW;
    constexpr int I0 = 16 * 144, I1 = 8 * 32, I2 = 8 * 32, I3 = 16 * 32, I4 = 16 * 128, I5 = 64 * 32, I6 = 16, I7 = 16, I8 = 16, I9 = 16, I10 = 2 * 16;
    constexpr int NIT = I0 + I1 + I2 + I3 + I4 + I5 + I6 + I7 + I8 + I9 + I10;
    for (int it = c.gw; it < NIT; it += c.ngw) {
        int r = it;
        if (r < I0) { conv_item(w_in, DIN, WinT, D, 0, scr, r / 144, r % 144, c.lane); continue; } r -= I0;
        if (r < I1) { conv_item(w_br, D, WbrT, D, 0, scr, r / 32, r % 32, c.lane); continue; } r -= I1;
        if (r < I2) { conv_item(w_br + (size_t)CW * D, D, WbrT, D, CW, scr, r / 32, r % 32, c.lane); continue; } r -= I2;
        if (r < I3) { conv_item(w_out, D, WoutT, D, 0, scr, r / 32, r % 32, c.lane); continue; } r -= I3;
        if (r < I4) { conv_item(w_up, DFF, WupT, D, 0, scr, r / 128, r % 128, c.lane); continue; } r -= I4;
        if (r < I5) { conv_item(w_dn, D, WdnT, DFF, 0, scr, r / 32, r % 32, c.lane); continue; } r -= I5;
        if (r < I6) { conv_item(dec_up, CW, WsmT, 128, 0, scr, 0, r, c.lane); continue; } r -= I6;
        if (r < I7) { conv_item(dec_up + 64 * CW, CW, WsmT + (size_t)512 * 128, 128, 0, scr, 0, r, c.lane); continue; } r -= I7;
        if (r < I8) { conv_item(icl_up, CW, WsmT + (size_t)1024 * 128, 128, 64, scr, 0, r, c.lane); continue; } r -= I8;
        if (r < I9) { conv_item(icl_up + 64 * CW, CW, WsmT + (size_t)1536 * 128, 128, 64, scr, 0, r, c.lane); continue; } r -= I9;
        conv_item(gate_up, CW, WgT, 128, 0, scr, r / 16, r % 16, c.lane);
    }
    for (int i = c.gt; i < 2048 * 8; i += c.ngt) { const int row = i >> 3, ch = i & 7; const int col = (row < 1024 ? 64 : 0) + ch * 8;
        *(v4u*)(WsmT + (size_t)row * 128 + col) = (v4u){0u, 0u, 0u, 0u}; }
}

__device__ __forceinline__ void mod_phase(const Params& p, const Ctx& c0) {
    const Ctx c = fresh(c0);
    LAS float* sl = (LAS float*)(c.lds);
    LAS float* part = (LAS float*)(c.lds + 32768);
    float* mod = (float*)(p.ws + WS_MOD);
    for (int i = c.tid; i < 5 * D; i += NTHREADS) { const int g = i >> 10, k = i & 1023; const float v = g == 0 ? IN(6)[k] : IN(5)[(g - 1) * D + k]; sl[i] = v / (1.0f + __expf(-v)); }
    __syncthreads();
    for (int it = blockIdx.x; it < NL * (NMOD / 64); it += gridDim.x) {
        const int l = it / (NMOD / 64), cc = it % (NMOD / 64);
        const float* w = IN(10) + (size_t)l * D * NMOD + cc * 64 + c.lane;
        float a0 = 0.f, a1 = 0.f, a2 = 0.f, a3 = 0.f, a4 = 0.f;
        const int kb = c.wave * 128;
#pragma unroll 4
        for (int k = kb; k < kb + 128; ++k) { const float wv = w[(size_t)k * NMOD]; a0 += sl[k] * wv; a1 += sl[D + k] * wv; a2 += sl[2 * D + k] * wv; a3 += sl[3 * D + k] * wv; a4 += sl[4 * D + k] * wv; }
        LAS float* pw = part + c.wave * 320 + c.lane;
        pw[0] = a0; pw[64] = a1; pw[128] = a2; pw[192] = a3; pw[256] = a4;
        __syncthreads();
        if (c.tid < 320) { float s = 0.f;
#pragma unroll
            for (int w8 = 0; w8 < 8; ++w8) s += part[w8 * 320 + c.tid];
            const int g = c.tid >> 6, col = cc * 64 + (c.tid & 63);
            mod[((size_t)l * 5 + g) * NMOD + col] = s + IN(11)[(size_t)l * NMOD + col]; }
        __syncthreads();
    }
}

template <int MODE>
__device__ __forceinline__ void norm_phase(const Params& p, const Ctx& c0, int l) {
    const Ctx c = fresh(c0);
    float* X = p.out; const f16* MO = (const f16*)(p.ws + WS_R2); f16* H = (f16*)(p.ws + WS_R4);
    const float* modb = (const float*)(p.ws + WS_MOD);
    for (int row = c.gw; row < M; row += c.ngw) {
        int g, t, T; row_info(row, g, t, T);
        f32x4 x[4];
        if (MODE == 0) { const float* src = row < M_CTX ? IN(0) + (size_t)row * D : IN(1) + (size_t)(row - M_CTX) * D;
#pragma unroll
            for (int j = 0; j < 4; ++j) x[j] = *(const f32x4*)(src + 256 * j + 4 * c.lane);
        } else {
            const float* mo_mod = modb + ((size_t)l * 5 + g) * NMOD + (MODE == 1 ? 2 * D : 5 * D);
            const float* ngp = IN(12) + ((size_t)l * 4 + (MODE == 1 ? 1 : 3)) * D;
            float mv[4][4]; float ss = 0.f;
#pragma unroll
            for (int j = 0; j < 4; ++j) { const f16x4 h = *(const f16x4*)(MO + (size_t)row * D + 256 * j + 4 * c.lane);
#pragma unroll
                for (int e = 0; e < 4; ++e) { mv[j][e] = (float)h[e]; ss += mv[j][e] * mv[j][e]; } }
            const float rstd = rsqrtf(wave_sum(ss) * (1.0f / D) + 1e-6f);
#pragma unroll
            for (int j = 0; j < 4; ++j) { x[j] = *(const f32x4*)(X + (size_t)row * D + 256 * j + 4 * c.lane);
                const f32x4 gg = *(const f32x4*)(mo_mod + 256 * j + 4 * c.lane); const f32x4 nn = *(const f32x4*)(ngp + 256 * j + 4 * c.lane);
#pragma unroll
                for (int e = 0; e < 4; ++e) x[j][e] += gg[e] * (mv[j][e] * rstd * nn[e]); }
        }
#pragma unroll
        for (int j = 0; j < 4; ++j) *(f32x4*)(X + (size_t)row * D + 256 * j + 4 * c.lane) = x[j];
        const int ln = MODE == 2 ? l + 1 : l;
        if (ln < NL) {
            const float* mb = modb + ((size_t)ln * 5 + g) * NMOD + (MODE == 1 ? 3 * D : 0);
            const float* ngp = IN(12) + ((size_t)ln * 4 + (MODE == 1 ? 2 : 0)) * D;
            float ss = 0.f;
#pragma unroll
            for (int j = 0; j < 4; ++j) ss += (x[j][0] * x[j][0] + x[j][1] * x[j][1]) + (x[j][2] * x[j][2] + x[j][3] * x[j][3]);
            const float rstd = rsqrtf(wave_sum(ss) * (1.0f / D) + 1e-6f);
#pragma unroll
            for (int j = 0; j < 4; ++j) { const f32x4 sh = *(const f32x4*)(mb + 256 * j + 4 * c.lane); const f32x4 sc = *(const f32x4*)(mb + D + 256 * j + 4 * c.lane);
                const f32x4 nn = *(const f32x4*)(ngp + 256 * j + 4 * c.lane);
                float o[4];
#pragma unroll
                for (int e = 0; e < 4; ++e) o[e] = x[j][e] * rstd * nn[e] * (1.0f + sc[e]) + sh[e];
                uint2 w; w.x = pkh(o[0], o[1]); w.y = pkh(o[2], o[3]);
                *(uint2*)(H + (size_t)row * D + 256 * j + 4 * c.lane) = w; }
        }
    }
}

template <class Epi>
__device__ __forceinline__ void naive_gemm(const f16* A, int lda, const f16* Bt, int K, int N, const Epi& epi, const Ctx& c0) {
    const Ctx c = fresh(c0);
    const size_t total = (size_t)M * N;
    for (size_t idx = c.gt; idx < total; idx += c.ngt) {
        const int m = (int)(idx / N), n = (int)(idx % N);
        const f16* a = A + (size_t)m * lda; const f16* b = Bt + (size_t)n * K;
        float acc = 0.f;
        for (int k = 0; k < K; k += 8) { const f16x8 av = *(const f16x8*)(a + k); const f16x8 bv = *(const f16x8*)(b + k);
#pragma unroll
            for (int e = 0; e < 8; ++e) acc += (float)av[e] * (float)bv[e]; }
        epi(m, n, acc);
    }
}
struct EpiProj { f16* P;
    __device__ __forceinline__ void operator()(int m, int n, float v) const {
        if (n >= PC_LW && n < PC_LA) v = tanhf(v);
        else if ((n >= PC_LG && n < PC_Q) || n >= PC_GR) v = sigmoidf_(v);
        P[(size_t)m * DIN + n] = (f16)v; } };
struct EpiWA { f16* WA; const float* w0; const float* a0;
    __device__ __forceinline__ void operator()(int m, int n, float v) const {
        float o; if (n < 1024) o = __expf(-0.606531f * sigmoidf_(v + w0[n])); else o = sigmoidf_(v + a0[n - 1024]);
        WA[(size_t)m * 2048 + n] = (f16)o; } };
struct EpiF16 { f16* O; int ld;
    __device__ __forceinline__ void operator()(int m, int n, float v) const { O[(size_t)m * ld + n] = (f16)v; } };
struct EpiRelu2 { f16* O; int ld;
    __device__ __forceinline__ void operator()(int m, int n, float v) const { v = fmaxf(v, 0.f); O[(size_t)m * ld + n] = (f16)(v * v); } };
__device__ __forceinline__ void naive_merged(const Params& p, const Ctx& c0) {
    const Ctx c = fresh(c0);
    const f16* OA = (const f16*)(p.ws + WS_R4); const f16* WbrT = (const f16*)(p.ws + WS_W + WO_BR); const f16* PROJ = (const f16*)(p.ws + WS_R1); f16* MG = (f16*)(p.ws + WS_R3);
    const size_t total = (size_t)M * D;
    for (size_t idx = c.gt; idx < total; idx += c.ngt) {
        const int m = (int)(idx / D), n = (int)(idx % D);
        const f16* a = OA + (size_t)m * D; const f16* b = WbrT + (size_t)n * D;
        float acc0 = 0.f, acc1 = 0.f;
        for (int k = 0; k < CW; k += 8) { const f16x8 av = *(const f16x8*)(a + k); const f16x8 bv = *(const f16x8*)(b + k);
#pragma unroll
            for (int e = 0; e < 8; ++e) acc0 += (float)av[e] * (float)bv[e]; }
        for (int k = CW; k < D; k += 8) { const f16x8 av = *(const f16x8*)(a + k); const f16x8 bv = *(const f16x8*)(b + k);
#pragma unroll
            for (int e = 0; e < 8; ++e) acc1 += (float)av[e] * (float)bv[e]; }
        const float sr = (float)PROJ[(size_t)m * DIN + PC_GR + n], sa = (float)PROJ[(size_t)m * DIN + PC_GA + n];
        MG[(size_t)m * D + n] = (f16)(sr * acc0 + sa * acc1);
    }
}


namespace pg8 {
constexpr int BM = 256, BK = 64, HALF = 128, HTB = HALF * BK * 2, STAGE_BYTES = 8 * HTB, NXCD = 8, WGM = 8;
__host__ __device__ __forceinline__ int lds_byte(int r, int c) { const int st = (r >> 4) * 2 + (c >> 5), rr = r & 15, cc = c & 31, ob = rr * 64 + cc * 2; return st * 1024 + (ob ^ (((ob >> 9) & 1) << 5)); }
__host__ __device__ __forceinline__ void stage_rc(int b, int& R, int& C) { const int st = b / 1024, sb = b % 1024, swz = sb ^ (((sb >> 9) & 1) << 5); R = (st >> 1) * 16 + swz / 64; C = (st & 1) * 32 + (swz % 64) / 2; }
__host__ __device__ __forceinline__ int perm32(int rho) { const int n = rho >> 4, i = rho & 15; return 8 * (i >> 2) + 4 * n + (i & 3); }
struct Unit { int pm, pn; };
struct Gemm { const f16* A; const f16* Bt; int lda, ldb, K; };
struct StaticOrder {
    int nM, nN, nwg, G, c;
    __device__ void init(int Mr, int N, int G_, int c_) { nM = Mr / BM; nN = N / BM; nwg = nM * nN; G = G_; c = c_; }
    __device__ bool next(int i, Unit& u) const {
        const long L = (long)i * G + c; if (L >= nwg) return false;
        int wgid = (int)L; { const int q = nwg / NXCD, r = nwg % NXCD, xcd = wgid % NXCD, off = wgid / NXCD; wgid = (xcd < r ? xcd * (q + 1) : r * (q + 1) + (xcd - r) * q) + off; }
        const int nig = WGM * nN, gid = wgid / nig, fm = gid * WGM, gsz = (nM - fm) < WGM ? (nM - fm) : WGM;
        u.pm = fm + ((wgid % nig) % gsz); u.pn = (wgid % nig) / gsz; return true;
    }
};
template <class Epi, bool ALIGN_EPI = true, bool SP2 = true>
__device__ __forceinline__ void gemm_phase(LAS unsigned char* lds, const Gemm g, const StaticOrder& S, const Epi& E, int wave_sgpr) {
    asm volatile("" : "+s"(wave_sgpr)); int tid = wave_sgpr * 64 + lane_id(); asm volatile("" : "+v"(tid));
    const int wid = __builtin_amdgcn_readfirstlane(tid >> 6), lane = tid & 63, wr = wid >> 2, wc = wid & 3, fr = lane & 15, fq = lane >> 4;
    const int K = g.K, nt = K / BK;
    unsigned voffA[2], voffB[2];
#pragma unroll
    for (int i = 0; i < 2; ++i) { int R, C; stage_rc(tid * 16 + i * 8192, R, C); const int Rb = (R & ~31) + perm32(R & 31);
        voffA[i] = (unsigned)(R * g.lda + C) * 2u; voffB[i] = (unsigned)(Rb * g.ldb + C) * 2u; }
    const unsigned kstep = (unsigned)(BK * 2);
    const unsigned hstepA = (unsigned)HALF * g.lda * 2, hstepB = (unsigned)HALF * g.ldb * 2;
    const unsigned tstepA = 2 * hstepA, tstepB = 2 * hstepB;
    const unsigned ldsw = (unsigned)wid * 1024u;
    const int aoff = lds_byte(wr * 64 + fr, fq * 8), boff = lds_byte(wc * 32 + fr, fq * 8);
#define PG8_SA(b, h) (((b) * 2 + (h)) * HTB)
#define PG8_SB(b, h) ((4 + (b) * 2 + (h)) * HTB)
#define PG8_STAGE(bufoff, gbase, soff, voff) do { _Pragma("unroll") for (int _i = 0; _i < 2; ++_i) \
        __builtin_amdgcn_raw_ptr_buffer_load_lds(rs##gbase, (LAS unsigned*)(lds + (bufoff) + ldsw + _i * 8192), 16, (voff)[_i], (int)(soff), 0, 0); } while (0)
#define PG8_LDA(dst, b, h) do { _Pragma("unroll") for (int m = 0; m < 4; ++m) _Pragma("unroll") for (int k = 0; k < 2; ++k) dst[m][k] = *(const LAS f16x8*)(lds + PG8_SA(b, h) + aoff + m * 2048 + k * 1024); } while (0)
#define PG8_LDB(dst, b, h) do { _Pragma("unroll") for (int n = 0; n < 2; ++n) _Pragma("unroll") for (int k = 0; k < 2; ++k) dst[n][k] = *(const LAS f16x8*)(lds + PG8_SB(b, h) + boff + n * 2048 + k * 1024); } while (0)
#define PG8_MMA(ai, bj, At, Bt) do { __builtin_amdgcn_s_setprio(1); _Pragma("unroll") for (int m = 0; m < 4; ++m) _Pragma("unroll") for (int n = 0; n < 2; ++n) _Pragma("unroll") for (int k = 0; k < 2; ++k) \
        acc[ai][bj][m][n] = __builtin_amdgcn_mfma_f32_16x16x32_f16(Bt[n][k], At[m][k], acc[ai][bj][m][n], 0, 0, 0); __builtin_amdgcn_s_setprio(0); } while (0)
#define PG8_WAIT_V(n) asm volatile("s_waitcnt vmcnt(" #n ")" ::: "memory")
#define PG8_WAIT_L(n) asm volatile("s_waitcnt lgkmcnt(" #n ")" ::: "memory")
#define PG8_BAR __builtin_amdgcn_s_barrier()
#define PG8_SCHED __builtin_amdgcn_sched_barrier(0)
    Unit cur, nxt; int ui = 0;
    if (!S.next(0, cur)) return;
    f32x4 acc[2][2][4][2];
#pragma unroll
    for (int a = 0; a < 2; ++a)
#pragma unroll
        for (int b = 0; b < 2; ++b)
#pragma unroll
            for (int m = 0; m < 4; ++m)
#pragma unroll
                for (int n = 0; n < 2; ++n) acc[a][b][m][n] = (f32x4){0.f, 0.f, 0.f, 0.f};
    f16x8 At[4][2], B0[2][2], B1[2][2];
    const auto rsA = __builtin_amdgcn_make_buffer_rsrc((void*)g.A, 0, 0x7fffffff, 0x00020000); const auto rsB = __builtin_amdgcn_make_buffer_rsrc((void*)g.Bt, 0, 0x7fffffff, 0x00020000);
    unsigned cA = (unsigned)cur.pm * tstepA, cB = (unsigned)cur.pn * tstepB;
    if constexpr (SP2) {
        PG8_STAGE(PG8_SB(0, 0), B, cB, voffB); PG8_STAGE(PG8_SB(0, 1), B, cB + hstepB, voffB); PG8_STAGE(PG8_SA(0, 0), A, cA, voffA); PG8_STAGE(PG8_SA(0, 1), A, cA + hstepA, voffA);
        if (wr == 1) PG8_BAR;
        PG8_WAIT_V(2); PG8_BAR;
        PG8_STAGE(PG8_SB(1, 0), B, cB + kstep, voffB); PG8_STAGE(PG8_SA(1, 0), A, cA + kstep, voffA); PG8_STAGE(PG8_SB(1, 1), B, cB + hstepB + kstep, voffB);
        PG8_WAIT_V(6); PG8_BAR;
    } else {
        PG8_STAGE(PG8_SB(0, 0), B, cB, voffB); PG8_STAGE(PG8_SA(0, 0), A, cA, voffA); PG8_STAGE(PG8_SB(0, 1), B, cB + hstepB, voffB); PG8_STAGE(PG8_SA(0, 1), A, cA + hstepA, voffA);
        if (wr == 1) PG8_BAR;
        PG8_WAIT_V(4); PG8_BAR;
        PG8_STAGE(PG8_SB(1, 0), B, cB + kstep, voffB); PG8_STAGE(PG8_SA(1, 0), A, cA + kstep, voffA); PG8_STAGE(PG8_SB(1, 1), B, cB + hstepB + kstep, voffB);
        PG8_WAIT_V(6); PG8_BAR;
    }
    for (;;) {
        const bool has_next = S.next(ui + 1, nxt);
        const unsigned nA = has_next ? (unsigned)nxt.pm * tstepA : cA, nB = has_next ? (unsigned)nxt.pn * tstepB : cB;
        for (int t = 0; t < nt; t += 2) {
            const bool last = (t == nt - 2);
            const unsigned a1 = cA + (unsigned)(t + 1) * kstep;
            const unsigned a2 = last ? nA : cA + (unsigned)(t + 2) * kstep, b2 = last ? nB : cB + (unsigned)(t + 2) * kstep;
            const unsigned a3 = a2 + kstep, b3 = b2 + kstep;
            if constexpr (SP2) {
            PG8_LDB(B0, 0, 0); PG8_LDB(B1, 0, 1); PG8_SCHED; PG8_LDA(At, 0, 0); PG8_STAGE(PG8_SA(1, 1), A, a1 + hstepA, voffA);
            PG8_WAIT_V(8); PG8_WAIT_L(0); PG8_BAR; PG8_MMA(0, 0, At, B0); PG8_MMA(0, 1, At, B1); PG8_BAR; PG8_SCHED;
            PG8_LDA(At, 0, 1); PG8_STAGE(PG8_SB(0, 0), B, b2, voffB); PG8_STAGE(PG8_SB(0, 1), B, b2 + hstepB, voffB); PG8_STAGE(PG8_SA(0, 0), A, a2, voffA);
            PG8_WAIT_V(8); PG8_WAIT_L(0); PG8_BAR; PG8_MMA(1, 0, At, B0); PG8_MMA(1, 1, At, B1); PG8_BAR; PG8_SCHED;
            PG8_LDB(B0, 1, 0); PG8_LDB(B1, 1, 1); PG8_SCHED; PG8_LDA(At, 1, 0); PG8_STAGE(PG8_SA(0, 1), A, a2 + hstepA, voffA);
            PG8_WAIT_V(8); PG8_WAIT_L(0); PG8_BAR; PG8_MMA(0, 0, At, B0); PG8_MMA(0, 1, At, B1); PG8_BAR; PG8_SCHED;
            PG8_LDA(At, 1, 1); PG8_STAGE(PG8_SB(1, 0), B, b3, voffB); PG8_STAGE(PG8_SB(1, 1), B, b3 + hstepB, voffB); PG8_STAGE(PG8_SA(1, 0), A, a3, voffA);
            PG8_WAIT_V(8); PG8_WAIT_L(0); PG8_BAR; PG8_MMA(1, 0, At, B0); PG8_MMA(1, 1, At, B1); PG8_BAR; PG8_SCHED;
            } else {
            PG8_LDB(B0, 0, 0); PG8_SCHED; PG8_LDA(At, 0, 0); PG8_STAGE(PG8_SA(1, 1), A, a1 + hstepA, voffA);
            PG8_WAIT_L(8); PG8_BAR; PG8_WAIT_L(0); PG8_MMA(0, 0, At, B0); PG8_BAR; PG8_SCHED;
            PG8_LDB(B1, 0, 1); PG8_STAGE(PG8_SB(0, 0), B, b2, voffB);
            PG8_BAR; PG8_WAIT_L(0); PG8_MMA(0, 1, At, B1); PG8_BAR;
            PG8_LDA(At, 0, 1); PG8_STAGE(PG8_SA(0, 0), A, a2, voffA);
            PG8_BAR; PG8_WAIT_L(0); PG8_MMA(1, 0, At, B0); PG8_BAR; PG8_SCHED;
            PG8_STAGE(PG8_SB(0, 1), B, b2 + hstepB, voffB);
            PG8_WAIT_V(6); PG8_BAR; PG8_MMA(1, 1, At, B1); PG8_BAR;
            PG8_LDB(B0, 1, 0); PG8_SCHED; PG8_LDA(At, 1, 0); PG8_STAGE(PG8_SA(0, 1), A, a2 + hstepA, voffA);
            PG8_WAIT_L(8); PG8_BAR; PG8_WAIT_L(0); PG8_MMA(0, 0, At, B0); PG8_BAR; PG8_SCHED;
            PG8_LDB(B1, 1, 1); PG8_STAGE(PG8_SB(1, 0), B, b3, voffB);
            PG8_BAR; PG8_WAIT_L(0); PG8_MMA(0, 1, At, B1); PG8_BAR;
            PG8_LDA(At, 1, 1); PG8_STAGE(PG8_SA(1, 0), A, a3, voffA);
            PG8_BAR; PG8_WAIT_L(0); PG8_MMA(1, 0, At, B0); PG8_BAR; PG8_SCHED;
            PG8_STAGE(PG8_SB(1, 1), B, b3 + hstepB, voffB);
            PG8_WAIT_V(6); PG8_BAR; PG8_MMA(1, 1, At, B1); PG8_BAR;
            }
        }
        if constexpr (ALIGN_EPI) { if (wr == 0) PG8_BAR; }
        E(acc, cur, wr, wc, fr, fq);
        if (!has_next) break;
#pragma unroll
        for (int a = 0; a < 2; ++a)
#pragma unroll
            for (int b = 0; b < 2; ++b)
#pragma unroll
                for (int m = 0; m < 4; ++m)
#pragma unroll
                    for (int n = 0; n < 2; ++n) acc[a][b][m][n] = (f32x4){0.f, 0.f, 0.f, 0.f};
        cur = nxt; cA = nA; cB = nB; ++ui;
        if constexpr (ALIGN_EPI) { if (wr == 1) PG8_BAR; }
    }
    PG8_WAIT_V(0);
    if constexpr (!ALIGN_EPI) { if (wr == 0) PG8_BAR; }
    PG8_BAR;
#undef PG8_SA
#undef PG8_SB
#undef PG8_STAGE
#undef PG8_LDA
#undef PG8_LDB
#undef PG8_MMA
#undef PG8_WAIT_V
#undef PG8_WAIT_L
#undef PG8_BAR
#undef PG8_SCHED
}
typedef f32x4 Acc[2][2][4][2];
#define PG8_EPI_LOOP(...) \
    const int row0 = u.pm * BM + wr * 64 + fr, col0 = u.pn * BM + wc * 32 + 8 * fq; \
    _Pragma("unroll") for (int ai = 0; ai < 2; ++ai) _Pragma("unroll") for (int m = 0; m < 4; ++m) { const int row = row0 + ai * HALF + m * 16; \
        _Pragma("unroll") for (int bj = 0; bj < 2; ++bj) { const int col = col0 + bj * HALF; f32x4 v0 = acc[ai][bj][m][0], v1 = acc[ai][bj][m][1]; __VA_ARGS__ } asm volatile("" ::: "memory"); }
__device__ __forceinline__ void store8(f16* p, f32x4 v0, f32x4 v1) { v4u w; w.x = pkh(v0[0], v0[1]); w.y = pkh(v0[2], v0[3]); w.z = pkh(v1[0], v1[1]); w.w = pkh(v1[2], v1[3]); *(v4u*)p = w; }
struct EpiProjF { f16* P;
    __device__ __forceinline__ void operator()(const Acc& acc, const Unit& u, int wr, int wc, int fr, int fq) const {
        PG8_EPI_LOOP(
            if (u.pn == 6) {
                if (col < PC_LA) { _Pragma("unroll") for (int e = 0; e < 4; ++e) { v0[e] = tanhf_(v0[e]); v1[e] = tanhf_(v1[e]); } }
                else if (col >= PC_LG) { _Pragma("unroll") for (int e = 0; e < 4; ++e) { v0[e] = sigmoidf_(v0[e]); v1[e] = sigmoidf_(v1[e]); } }
            } else if (u.pn >= 10) { _Pragma("unroll") for (int e = 0; e < 4; ++e) { v0[e] = sigmoidf_(v0[e]); v1[e] = sigmoidf_(v1[e]); } }
            store8(P + (size_t)row * DIN + col, v0, v1);
        )
    } };
struct EpiWAF { f16* WA; const float* w0; const float* a0;
    __device__ __forceinline__ void operator()(const Acc& acc, const Unit& u, int wr, int wc, int fr, int fq) const {
        PG8_EPI_LOOP(
            if (col < 1024) { const f32x4 b0 = *(const f32x4*)(w0 + col), b1 = *(const f32x4*)(w0 + col + 4);
                _Pragma("unroll") for (int e = 0; e < 4; ++e) { v0[e] = __expf(-0.606531f * sigmoidf_(v0[e] + b0[e])); v1[e] = __expf(-0.606531f * sigmoidf_(v1[e] + b1[e])); } }
            else { const f32x4 b0 = *(const f32x4*)(a0 + col - 1024), b1 = *(const f32x4*)(a0 + col - 1024 + 4);
                _Pragma("unroll") for (int e = 0; e < 4; ++e) { v0[e] = sigmoidf_(v0[e] + b0[e]); v1[e] = sigmoidf_(v1[e] + b1[e]); } }
            store8(WA + (size_t)row * 2048 + col, v0, v1);
        )
    } };
struct EpiF16F { f16* O; int ld;
    __device__ __forceinline__ void operator()(const Acc& acc, const Unit& u, int wr, int wc, int fr, int fq) const {
        PG8_EPI_LOOP( store8(O + (size_t)row * ld + col, v0, v1); )
    } };
struct EpiRelu2F { f16* O; int ld;
    __device__ __forceinline__ void operator()(const Acc& acc, const Unit& u, int wr, int wc, int fr, int fq) const {
        PG8_EPI_LOOP(
            _Pragma("unroll") for (int e = 0; e < 4; ++e) { const float a = fmaxf(v0[e], 0.f), b = fmaxf(v1[e], 0.f); v0[e] = a * a; v1[e] = b * b; }
            store8(O + (size_t)row * ld + col, v0, v1);
        )
    } };
template <int PASS> struct EpiMergeF { f16* MG; const f16* PROJ;
    __device__ __forceinline__ void operator()(const Acc& acc, const Unit& u, int wr, int wc, int fr, int fq) const {
        PG8_EPI_LOOP(
            const f16x8 gt = *(const f16x8*)(PROJ + (size_t)row * DIN + (PASS == 0 ? PC_GR : PC_GA) + col);
            _Pragma("unroll") for (int e = 0; e < 4; ++e) { v0[e] *= (float)gt[e]; v1[e] *= (float)gt[4 + e]; }
            if (PASS == 1) { const f16x8 pv = *(const f16x8*)(MG + (size_t)row * D + col);
                _Pragma("unroll") for (int e = 0; e < 4; ++e) { v0[e] += (float)pv[e]; v1[e] += (float)pv[4 + e]; } }
            store8(MG + (size_t)row * D + col, v0, v1);
        )
    } };
}

__device__ __forceinline__ void kv_prep(const Params& p, const Ctx& c0, int l) {
    const Ctx c = fresh(c0);
    const f16* PROJ = (const f16*)(p.ws + WS_R1); f16* KN = (f16*)(p.ws + WS_KN); f16* VT = (f16*)(p.ws + WS_VT);
    const float kg = IN(27)[l * HD + c.lane];
    const int d = c.lane;
    for (int it = c.gw; it < M * 2; it += c.ngw) {
        const int row = it >> 1, kvh = it & 1;
        float kx = (float)PROJ[(size_t)row * DIN + PC_KA + kvh * HD + d]; const float vx = (float)PROJ[(size_t)row * DIN + PC_VA + kvh * HD + d];
        const float rstd = rsqrtf(wave_sum(kx * kx) * (1.0f / HD) + 1e-6f);
        kx = kx * rstd * kg;
        if (row < M_CTX) { const int b = row >> 8, t = row & 255;
            p.out[O_CK + ((((size_t)b * NL + l) * T_CTX + t) * 2 + kvh) * HD + d] = kx;
            p.out[O_CV + ((((size_t)b * NL + l) * T_CTX + t) * 2 + kvh) * HD + d] = vx;
            KN[(((size_t)b * 2 + kvh) * T_CTX + t) * HD + d] = (f16)kx;
            VT[(((size_t)b * 2 + kvh) * HD + d) * T_CTX + t] = (f16)vx;
        } else { const int r = row - M_CTX, b = r >> 10, t = r & 1023;
            const int axis = d >> 5, half = (d >> 4) & 1, f = d & 15;
            const float pos = (float)(axis == 0 ? (t >> 6) : (t & 63));
            const float freq = exp2f(-(float)f * (13.287712379549449f / 16.0f));
            const float ang = pos * freq; const float cs = cosf(ang), sn = sinf(ang);
            const float other = __shfl_xor(kx, 16);
            const float ko = half == 0 ? kx * cs - other * sn : kx * cs + other * sn;
            KN[KN_SMP_OFF + (((size_t)b * 2 + kvh) * KV_SMP + PAST + t) * HD + d] = (f16)ko;
            VT[KN_SMP_OFF + (((size_t)b * 2 + kvh) * HD + d) * KV_SMP + PAST + t] = (f16)vx;
        }
    }
    for (int it = c.gw; it < B_SMP * PAST * 2; it += c.ngw) {
        const int kvh = it & 1, j = (it >> 1) & 255, b = it >> 9;
        const size_t src = ((((size_t)b * NL + l) * PAST + j) * 2 + kvh) * HD + d;
        KN[KN_SMP_OFF + (((size_t)b * 2 + kvh) * KV_SMP + j) * HD + d] = (f16)IN(2)[src];
        VT[KN_SMP_OFF + (((size_t)b * 2 + kvh) * HD + d) * KV_SMP + j] = (f16)IN(3)[src];
    }
}

__device__ __forceinline__ void naive_scan(const Params& p, const Ctx& c0, int l) {
    const Ctx c = fresh(c0);
    const f16* PROJ = (const f16*)(p.ws + WS_R1); const f16* WA = (const f16*)(p.ws + WS_R2);
    f16* Y = (f16*)(p.ws + WS_R3); float* RK = (float*)(p.ws + WS_RK);
    LAS float* st = (LAS float*)(c.lds + c.wave * 2048);
    const int NSCAN = (B_CTX + B_SMP) * 2 * NH;
    for (int it = c.gw; it < NSCAN; it += c.ngw) {
        const int h = it & 7, dir = (it >> 3) & 1, sq = it >> 4;
        const bool smp = sq >= B_CTX; const int T = smp ? T_SMP : T_CTX; const int row0 = smp ? M_CTX + (sq - B_CTX) * T_SMP : sq * T_CTX;
        const int ch = h * HD + c.lane;
        const float mu_r = IN(15)[(l * 3 + 0) * CW + ch], mu_k = IN(15)[(l * 3 + 1) * CW + ch], mu_v = IN(15)[(l * 3 + 2) * CW + ch];
        const float k_k = IN(16)[l * CW + ch], k_a = IN(17)[l * CW + ch], r_k = IN(18)[l * CW + ch];
        float S[64];
        if (smp) { const float* s0 = IN(4) + (((((size_t)(sq - B_CTX) * NL + l) * 2 + dir) * NH + h) * HD + c.lane) * HD;
#pragma unroll
            for (int k = 0; k < 64; ++k) S[k] = s0[k];
        } else {
#pragma unroll
            for (int k = 0; k < 64; ++k) S[k] = 0.f;
        }
        for (int s = 0; s < T; ++s) {
            const int t = dir == 0 ? s : T - 1 - s; const size_t row = (size_t)row0 + t;
            const f16* pr = PROJ + row * DIN;
            const float rc = (float)pr[PC_R + ch], kc = (float)pr[PC_K + ch], vc = (float)pr[PC_V + ch];
            float rp = 0.f, kp = 0.f, vp = 0.f, rn = 0.f, kn = 0.f, vn = 0.f;
            if (t > 0) { rp = (float)pr[PC_R + ch - DIN]; kp = (float)pr[PC_K + ch - DIN]; vp = (float)pr[PC_V + ch - DIN]; }
            if (t < T - 1) { rn = (float)pr[PC_R + ch + DIN]; kn = (float)pr[PC_K + ch + DIN]; vn = (float)pr[PC_V + ch + DIN]; }
            const float r = rc + mu_r * (0.5f * (rp + rn) - rc), k = kc + mu_k * (0.5f * (kp + kn) - kc), v = vc + mu_v * (0.5f * (vp + vn) - vc);
            const float kk = k * k_k; const float kh = kk * rsqrtf(wave_sum(kk * kk) + 1e-12f);
            const float w = (float)WA[row * 2048 + dir * 512 + ch], a = (float)WA[row * 2048 + 1024 + dir * 512 + ch];
            const float kt = k * (1.0f + (a - 1.0f) * k_a), bb = a * kh;
            const float rks = wave_sum(r * kt * r_k);
            if (c.lane == 0) RK[((size_t)dir * M + row) * 8 + h] = rks;
            LDS_WAIT();
            st[c.lane] = kh; st[64 + c.lane] = w; st[128 + c.lane] = bb; st[192 + c.lane] = kt; st[256 + c.lane] = r;
            LDS_WAIT();
            float sk = 0.f;
#pragma unroll
            for (int k4 = 0; k4 < 64; k4 += 4) { const f32x4 q = *(const LAS f32x4*)(st + k4); sk += S[k4] * q[0] + S[k4 + 1] * q[1] + S[k4 + 2] * q[2] + S[k4 + 3] * q[3]; }
            float y = 0.f;
#pragma unroll
            for (int k4 = 0; k4 < 64; k4 += 4) { const f32x4 wq = *(const LAS f32x4*)(st + 64 + k4), bq = *(const LAS f32x4*)(st + 128 + k4), tq = *(const LAS f32x4*)(st + 192 + k4), rq = *(const LAS f32x4*)(st + 256 + k4);
#pragma unroll
                for (int e = 0; e < 4; ++e) { S[k4 + e] = S[k4 + e] * wq[e] - sk * bq[e] + v * tq[e]; y += S[k4 + e] * rq[e]; } }
            Y[((size_t)dir * M + row) * CW + ch] = (f16)y;
        }
        if (!smp) { float* so = p.out + O_ST + (((((size_t)sq * NL + l) * 2 + dir) * NH + h) * HD + c.lane) * HD;
#pragma unroll
            for (int k = 0; k < 64; ++k) so[k] = S[k]; }
    }
}


constexpr int TC = 32, ST_STEP = 6 * 64, ST_BUF = TC * ST_STEP;
__device__ __forceinline__ float dpp_f(float x, const int ctrl) { return x; }
#define DPP_ADD(x, ctrl) (x) += __builtin_bit_cast(float, __builtin_amdgcn_update_dpp(0, __builtin_bit_cast(int, (x)), (ctrl), 0xF, 0xF, true))
__device__ __forceinline__ float dpp_sum8(float x) { DPP_ADD(x, 0xB1); DPP_ADD(x, 0x4E); DPP_ADD(x, 0x141); return x; }
__device__ __forceinline__ float dpp_sum16(float x) { DPP_ADD(x, 0xB1); DPP_ADD(x, 0x4E); DPP_ADD(x, 0x141); DPP_ADD(x, 0x140); return x; }
struct StageRegs { f16x4 r[3], k[3], v[3], w, a; };
__device__ __forceinline__ void scan_task(const Params& p, const Ctx& c, int l, int task) {
    const f16* PROJ = (const f16*)(p.ws + WS_R1); const f16* WA = (const f16*)(p.ws + WS_R2);
    f16* Y = (f16*)(p.ws + WS_R3); float* RK = (float*)(p.ws + WS_RK);
    LAS float* st = (LAS float*)c.lds;
    int sq, dir, h;
    if (task < 64) { h = task & 7; dir = (task >> 3) & 1; sq = B_CTX + (task >> 4); } else { const int id = task - 64; h = id & 7; dir = (id >> 3) & 1; sq = id >> 4; }
    const bool smp = sq >= B_CTX; const int T = smp ? T_SMP : T_CTX; const int row0 = smp ? M_CTX + (sq - B_CTX) * T_SMP : sq * T_CTX;
    const int nch = T / TC;
    const int tt = c.tid >> 4, cq = c.tid & 15, ch0 = h * HD + cq * 4;
    const f32x4 mu_r = *(const f32x4*)(IN(15) + (l * 3 + 0) * CW + ch0), mu_k = *(const f32x4*)(IN(15) + (l * 3 + 1) * CW + ch0), mu_v = *(const f32x4*)(IN(15) + (l * 3 + 2) * CW + ch0);
    const f32x4 k_k = *(const f32x4*)(IN(16) + l * CW + ch0), k_a = *(const f32x4*)(IN(17) + l * CW + ch0), r_k = *(const f32x4*)(IN(18) + l * CW + ch0);
    const int ks = c.lane & 7, srow = c.wave * 8 + (c.lane >> 3);
    float S[8];
    if (smp) { const float* s0 = IN(4) + (((((size_t)(sq - B_CTX) * NL + l) * 2 + dir) * NH + h) * HD + srow) * HD + ks * 8;
        const f32x4 a = *(const f32x4*)s0, b = *(const f32x4*)(s0 + 4);
        S[0] = a[0]; S[1] = a[1]; S[2] = a[2]; S[3] = a[3]; S[4] = b[0]; S[5] = b[1]; S[6] = b[2]; S[7] = b[3];
    } else {
#pragma unroll
        for (int j = 0; j < 8; ++j) S[j] = 0.f;
    }
    StageRegs sr;
    const f16x4 z4 = {(f16)0.f, (f16)0.f, (f16)0.f, (f16)0.f};
#define SCAN_LOAD(chunk) do { const int S_ = (chunk) * TC + tt; const int t_ = dir ? T - 1 - S_ : S_; const f16* pr_ = PROJ + (size_t)(row0 + t_) * DIN + ch0; \
        sr.r[1] = *(const f16x4*)(pr_ + PC_R); sr.k[1] = *(const f16x4*)(pr_ + PC_K); sr.v[1] = *(const f16x4*)(pr_ + PC_V); \
        if (t_ > 0) { sr.r[0] = *(const f16x4*)(pr_ - DIN + PC_R); sr.k[0] = *(const f16x4*)(pr_ - DIN + PC_K); sr.v[0] = *(const f16x4*)(pr_ - DIN + PC_V); } else { sr.r[0] = z4; sr.k[0] = z4; sr.v[0] = z4; } \
        if (t_ < T - 1) { sr.r[2] = *(const f16x4*)(pr_ + DIN + PC_R); sr.k[2] = *(const f16x4*)(pr_ + DIN + PC_K); sr.v[2] = *(const f16x4*)(pr_ + DIN + PC_V); } else { sr.r[2] = z4; sr.k[2] = z4; sr.v[2] = z4; } \
        const f16* wa_ = WA + (size_t)(row0 + t_) * 2048 + dir * 512 + ch0; sr.w = *(const f16x4*)wa_; sr.a = *(const f16x4*)(wa_ + 1024); } while (0)
#define SCAN_STAGE(chunk) do { const int S_ = (chunk) * TC + tt; const int t_ = dir ? T - 1 - S_ : S_; \
        f32x4 r_, k_, v_, kk_, w_, a_, kh_, kt_, b_; float ss_ = 0.f, rk_ = 0.f; \
        _Pragma("unroll") for (int e = 0; e < 4; ++e) { const float rc = (float)sr.r[1][e], kc = (float)sr.k[1][e], vc = (float)sr.v[1][e]; \
            r_[e] = rc + mu_r[e] * (0.5f * ((float)sr.r[0][e] + (float)sr.r[2][e]) - rc); k_[e] = kc + mu_k[e] * (0.5f * ((float)sr.k[0][e] + (float)sr.k[2][e]) - kc); \
            v_[e] = vc + mu_v[e] * (0.5f * ((float)sr.v[0][e] + (float)sr.v[2][e]) - vc); kk_[e] = k_[e] * k_k[e]; ss_ += kk_[e] * kk_[e]; w_[e] = (float)sr.w[e]; a_[e] = (float)sr.a[e]; } \
        ss_ = dpp_sum16(ss_); const float ri_ = rsqrtf(ss_ + 1e-12f); \
        _Pragma("unroll") for (int e = 0; e < 4; ++e) { kh_[e] = kk_[e] * ri_; kt_[e] = k_[e] * (1.0f + (a_[e] - 1.0f) * k_a[e]); b_[e] = a_[e] * kh_[e]; rk_ += r_[e] * kt_[e] * r_k[e]; } \
        rk_ = dpp_sum16(rk_); if (cq == 0) RK[((size_t)dir * M + row0 + t_) * 8 + h] = rk_; \
        LAS float* sb_ = st + ((chunk) & 1) * ST_BUF + tt * ST_STEP + cq * 4; \
        *(LAS f32x4*)(sb_) = kh_; *(LAS f32x4*)(sb_ + 64) = w_; *(LAS f32x4*)(sb_ + 128) = b_; *(LAS f32x4*)(sb_ + 192) = kt_; *(LAS f32x4*)(sb_ + 256) = r_; *(LAS f32x4*)(sb_ + 320) = v_; } while (0)
    SCAN_LOAD(0);
    SCAN_STAGE(0);
    __syncthreads();
    for (int chunk = 0; chunk < nch; ++chunk) {
        if (chunk + 1 < nch) SCAN_LOAD(chunk + 1);
        const LAS float* sb = st + (chunk & 1) * ST_BUF + ks * 8;
        const LAS float* vb = st + (chunk & 1) * ST_BUF + 320 + srow;
#pragma unroll 2
        for (int s = 0; s < TC; ++s) {
            const LAS float* q = sb + s * ST_STEP;
            const f32x4 kh0 = *(const LAS f32x4*)(q), kh1 = *(const LAS f32x4*)(q + 4);
            const f32x4 w0 = *(const LAS f32x4*)(q + 64), w1 = *(const LAS f32x4*)(q + 68);
            const f32x4 b0 = *(const LAS f32x4*)(q + 128), b1 = *(const LAS f32x4*)(q + 132);
            const f32x4 t0 = *(const LAS f32x4*)(q + 192), t1 = *(const LAS f32x4*)(q + 196);
            const f32x4 r0 = *(const LAS f32x4*)(q + 256), r1 = *(const LAS f32x4*)(q + 260);
            const float v = vb[s * ST_STEP];
            float sk = (S[0] * kh0[0] + S[1] * kh0[1]) + (S[2] * kh0[2] + S[3] * kh0[3]) + ((S[4] * kh1[0] + S[5] * kh1[1]) + (S[6] * kh1[2] + S[7] * kh1[3]));
            sk = dpp_sum8(sk);
#pragma unroll
            for (int e = 0; e < 4; ++e) { S[e] = S[e] * w0[e] + (v * t0[e] - sk * b0[e]); S[4 + e] = S[4 + e] * w1[e] + (v * t1[e] - sk * b1[e]); }
            float y = (S[0] * r0[0] + S[1] * r0[1]) + (S[2] * r0[2] + S[3] * r0[3]) + ((S[4] * r1[0] + S[5] * r1[1]) + (S[6] * r1[2] + S[7] * r1[3]));
            y = dpp_sum8(y);
            const int Sg = chunk * TC + s; const int t = dir ? T - 1 - Sg : Sg;
            if (ks == 0) Y[((size_t)dir * M + row0 + t) * CW + h * HD + srow] = (f16)y;
        }
        if (chunk + 1 < nch) SCAN_STAGE(chunk + 1);
        __syncthreads();
    }
#undef SCAN_LOAD
#undef SCAN_STAGE
    if (!smp) { float* so = p.out + O_ST + (((((size_t)sq * NL + l) * 2 + dir) * NH + h) * HD + srow) * HD + ks * 8;
        *(f32x4*)so = (f32x4){S[0], S[1], S[2], S[3]}; *(f32x4*)(so + 4) = (f32x4){S[4], S[5], S[6], S[7]}; }
}
__device__ __forceinline__ void fast_scan(const Params& p, const Ctx& c0, int l) {
    const Ctx c = fresh(c0);
    const int b = blockIdx.x;
    if (b < 64) scan_task(p, c, l, b);
    else for (int task = b; task < 576; task += 192) scan_task(p, c, l, task);
}

__device__ __forceinline__ void naive_attn(const Params& p, const Ctx& c0, int l) {
    const Ctx c = fresh(c0);
    const f16* PROJ = (const f16*)(p.ws + WS_R1); const f16* KN = (const f16*)(p.ws + WS_KN); const f16* VT = (const f16*)(p.ws + WS_VT);
    f16* OA = (f16*)(p.ws + WS_R4);
    LAS float* ps = (LAS float*)(c.lds + 16384 + c.wave * 8192);
    const float qg = IN(26)[l * HD + c.lane];
    for (int it = c.gw; it < M * NH; it += c.ngw) {
        const int row = it >> 3, hq = it & 7, kvh = hq >> 2, d = c.lane;
        float qx = (float)PROJ[(size_t)row * DIN + PC_Q + hq * HD + d];
        qx = qx * rsqrtf(wave_sum(qx * qx) * (1.0f / HD) + 1e-6f) * qg;
        const f16* Kb; const f16* Vb; int L;
        if (row < M_CTX) { const int b = row >> 8; Kb = KN + ((size_t)b * 2 + kvh) * T_CTX * HD; Vb = VT + ((size_t)b * 2 + kvh) * HD * T_CTX; L = T_CTX; }
        else { const int r = row - M_CTX, b = r >> 10, t = r & 1023;
            const int axis = d >> 5, half = (d >> 4) & 1, f = d & 15;
            const float pos = (float)(axis == 0 ? (t >> 6) : (t & 63));
            const float ang = pos * exp2f(-(float)f * (13.287712379549449f / 16.0f)); const float cs = cosf(ang), sn = sinf(ang);
            const float other = __shfl_xor(qx, 16);
            qx = half == 0 ? qx * cs - other * sn : qx * cs + other * sn;
            Kb = KN + KN_SMP_OFF + ((size_t)b * 2 + kvh) * KV_SMP * HD; Vb = VT + KN_SMP_OFF + ((size_t)b * 2 + kvh) * HD * KV_SMP; L = KV_SMP; }
        LDS_WAIT();
        ps[d] = qx * 0.125f;
        LDS_WAIT();
        float mx = -1e30f;
        for (int j = c.lane; j < L; j += 64) { float s = 0.f;
#pragma unroll
            for (int k8 = 0; k8 < 64; k8 += 8) { const f16x8 kv = *(const f16x8*)(Kb + (size_t)j * HD + k8);
#pragma unroll
                for (int e = 0; e < 8; ++e) s += ps[k8 + e] * (float)kv[e]; }
            ps[64 + j] = s; mx = fmaxf(mx, s); }
        mx = wave_max(mx);
        float sum = 0.f;
        for (int j = c.lane; j < L; j += 64) { const float e = __expf(ps[64 + j] - mx); ps[64 + j] = e; sum += e; }
        sum = wave_sum(sum);
        LDS_WAIT();
        float o = 0.f;
        for (int j = 0; j < L; j += 8) { const f16x8 vv = *(const f16x8*)(Vb + (size_t)d * L + j);
#pragma unroll
            for (int e = 0; e < 8; ++e) o += ps[64 + j + e] * (float)vv[e]; }
        OA[(size_t)row * D + CW + hq * HD + d] = (f16)(o / sum);
    }
}


typedef float f32x16 __attribute__((ext_vector_type(16)));
__device__ __forceinline__ int swap23(int r) { return (r & ~12) | ((r & 4) << 1) | ((r & 8) >> 1); }
__device__ __forceinline__ void attn_wave_task(const Params& p, const Ctx& c, int l, int task) {
    const f16* PROJ = (const f16*)(p.ws + WS_R1); const f16* KN = (const f16*)(p.ws + WS_KN); const f16* VT = (const f16*)(p.ws + WS_VT);
    f16* OA = (f16*)(p.ws + WS_R4);
    const int hq = task & 7, qb = task >> 3, kvh = hq >> 2;
    const int r32 = c.lane & 31, hh = c.lane >> 5;
    int rowq0, L; const f16* Kb; const f16* Vb; bool smp;
    if (qb < 128) { smp = true; rowq0 = M_CTX + qb * 32; const int b = qb >> 5; L = KV_SMP;
        Kb = KN + KN_SMP_OFF + ((size_t)b * 2 + kvh) * KV_SMP * HD; Vb = VT + KN_SMP_OFF + ((size_t)b * 2 + kvh) * HD * KV_SMP; }
    else { smp = false; rowq0 = (qb - 128) * 32; const int b = rowq0 >> 8; L = T_CTX;
        Kb = KN + ((size_t)b * 2 + kvh) * T_CTX * HD; Vb = VT + ((size_t)b * 2 + kvh) * HD * T_CTX; }
    const int row = rowq0 + r32;
    float x[4][8]; float ss = 0.f;
#pragma unroll
    for (int s = 0; s < 4; ++s) { const f16x8 q = *(const f16x8*)(PROJ + (size_t)row * DIN + PC_Q + hq * HD + 16 * s + 8 * hh);
#pragma unroll
        for (int j = 0; j < 8; ++j) { x[s][j] = (float)q[j]; ss += x[s][j] * x[s][j]; } }
    ss += __shfl_xor(ss, 32);
    const float rstd = rsqrtf(ss * (1.0f / HD) + 1e-6f);
#pragma unroll
    for (int s = 0; s < 4; ++s)
#pragma unroll
        for (int j = 0; j < 8; ++j) x[s][j] *= rstd * IN(26)[l * HD + 16 * s + 8 * hh + j];
    if (smp) { const int t = (row - M_CTX) & (T_SMP - 1); const float posr = (float)(t >> 6), posc = (float)(t & 63);
#pragma unroll
        for (int j = 0; j < 8; ++j) { const float freq = exp2f(-(float)(8 * hh + j) * (13.287712379549449f / 16.0f));
            const float ar = posr * freq, ac = posc * freq; const float cr = cosf(ar), sr = sinf(ar), cc = cosf(ac), sc = sinf(ac);
            const float a0 = x[0][j], a1 = x[1][j], b0 = x[2][j], b1 = x[3][j];
            x[0][j] = a0 * cr - a1 * sr; x[1][j] = a1 * cr + a0 * sr; x[2][j] = b0 * cc - b1 * sc; x[3][j] = b1 * cc + b0 * sc; } }
    f16x8 qf[4];
#pragma unroll
    for (int s = 0; s < 4; ++s)
#pragma unroll
        for (int j = 0; j < 8; ++j) qf[s][j] = (f16)(x[s][j] * (0.125f * 1.4426950408889634f));
    f32x16 o0, o1;
#pragma unroll
    for (int i = 0; i < 16; ++i) { o0[i] = 0.f; o1[i] = 0.f; }
    float mrun = -1e30f, lsum = 0.f;
    const f16* kp = Kb + (size_t)swap23(r32) * HD + 8 * hh;
    const f16* vp = Vb + (size_t)r32 * L + 8 * hh;
    const int ntile = L >> 5;
    f16x8 kf[4], vf[4];
#pragma unroll
    for (int s = 0; s < 4; ++s) kf[s] = *(const f16x8*)(kp + 16 * s);
    vf[0] = *(const f16x8*)(vp); vf[1] = *(const f16x8*)(vp + 16); vf[2] = *(const f16x8*)(vp + (size_t)32 * L); vf[3] = *(const f16x8*)(vp + (size_t)32 * L + 16);
    for (int kt = 0; kt < ntile; ++kt) {
        f16x8 kn[4], vn[4];
        const int ktn = kt + 1 < ntile ? kt + 1 : kt;
#pragma unroll
        for (int s = 0; s < 4; ++s) kn[s] = *(const f16x8*)(kp + (size_t)ktn * 32 * HD + 16 * s);
        vn[0] = *(const f16x8*)(vp + ktn * 32); vn[1] = *(const f16x8*)(vp + ktn * 32 + 16); vn[2] = *(const f16x8*)(vp + (size_t)32 * L + ktn * 32); vn[3] = *(const f16x8*)(vp + (size_t)32 * L + ktn * 32 + 16);
        f32x16 sa;
#pragma unroll
        for (int i = 0; i < 16; ++i) sa[i] = 0.f;
#pragma unroll
        for (int s = 0; s < 4; ++s) sa = __builtin_amdgcn_mfma_f32_32x32x16_f16(kf[s], qf[s], sa, 0, 0, 0);
        float mt = sa[0];
#pragma unroll
        for (int i = 1; i < 16; ++i) mt = fmaxf(mt, sa[i]);
        mt = fmaxf(mt, __shfl_xor(mt, 32));
        const float mn = fmaxf(mrun, mt); const float alpha = exp2f(mrun - mn); mrun = mn;
        float ps = 0.f;
#pragma unroll
        for (int i = 0; i < 16; ++i) { sa[i] = exp2f(sa[i] - mn); ps += sa[i]; }
        lsum = lsum * alpha + ps;
#pragma unroll
        for (int i = 0; i < 16; ++i) { o0[i] *= alpha; o1[i] *= alpha; }
        f16x8 pb0, pb1;
#pragma unroll
        for (int j = 0; j < 8; ++j) { pb0[j] = (f16)sa[j]; pb1[j] = (f16)sa[8 + j]; }
        o0 = __builtin_amdgcn_mfma_f32_32x32x16_f16(vf[0], pb0, o0, 0, 0, 0);
        o0 = __builtin_amdgcn_mfma_f32_32x32x16_f16(vf[1], pb1, o0, 0, 0, 0);
        o1 = __builtin_amdgcn_mfma_f32_32x32x16_f16(vf[2], pb0, o1, 0, 0, 0);
        o1 = __builtin_amdgcn_mfma_f32_32x32x16_f16(vf[3], pb1, o1, 0, 0, 0);
#pragma unroll
        for (int s = 0; s < 4; ++s) { kf[s] = kn[s]; vf[s] = vn[s]; }
    }
    lsum += __shfl_xor(lsum, 32);
    const float inv = 1.0f / lsum;
    f16* op = OA + (size_t)row * D + CW + hq * HD + 4 * hh;
#pragma unroll
    for (int g = 0; g < 4; ++g) {
        uint2 w0; w0.x = pkh(o0[4 * g] * inv, o0[4 * g + 1] * inv); w0.y = pkh(o0[4 * g + 2] * inv, o0[4 * g + 3] * inv);
        uint2 w1; w1.x = pkh(o1[4 * g] * inv, o1[4 * g + 1] * inv); w1.y = pkh(o1[4 * g + 2] * inv, o1[4 * g + 3] * inv);
        *(uint2*)(op + 8 * g) = w0; *(uint2*)(op + 32 + 8 * g) = w1; }
}
__device__ __forceinline__ void fast_attn(const Params& p, const Ctx& c0, int l) {
    const Ctx c = fresh(c0);
    if (blockIdx.x < 64) return;
    const int ws = (blockIdx.x - 64) * NWAVES + c.wave;
    for (int task = ws; task < 3072; task += 1536) attn_wave_task(p, c, l, task);
}

__device__ __forceinline__ void post_phase(const Params& p, const Ctx& c0, int l) {
    const Ctx c = fresh(c0);
    const f16* PROJ = (const f16*)(p.ws + WS_R1); const f16* Y = (const f16*)(p.ws + WS_R3); const float* RK = (const float*)(p.ws + WS_RK);
    const f16* WgT = (const f16*)(p.ws + WS_W + WO_G); f16* OA = (f16*)(p.ws + WS_R4);
    for (int it = c.gw; it < M * NH; it += c.ngw) {
        const int row = it >> 3, h = it & 7, ch = h * HD + c.lane;
        int g, t, T; row_info(row, g, t, T);
        const float y = (float)Y[(size_t)row * CW + ch] + (float)Y[((size_t)M + row) * CW + ch];
        const float mean = wave_sum(y) * (1.0f / HD); const float dy = y - mean; const float var = wave_sum(dy * dy) * (1.0f / HD);
        const float yn = dy * rsqrtf(var + 64e-5f) * IN(24)[l * CW + ch] + IN(25)[l * CW + ch];
        const f16* pr = PROJ + (size_t)row * DIN;
        const float vc = (float)pr[PC_V + ch]; float vp = 0.f, vn = 0.f;
        if (t > 0) vp = (float)pr[PC_V + ch - DIN];
        if (t < T - 1) vn = (float)pr[PC_V + ch + DIN];
        const float v = vc + IN(15)[(l * 3 + 2) * CW + ch] * (0.5f * (vp + vn) - vc);
        const float bonus = (RK[(size_t)row * 8 + h] + RK[((size_t)M + row) * 8 + h]) * v;
        float gs = 0.f;
        for (int k = 0; k < 128; k += 8) { const f16x8 a = *(const f16x8*)(pr + PC_LG + k); const f16x8 b = *(const f16x8*)(WgT + (size_t)ch * 128 + k);
#pragma unroll
            for (int e = 0; e < 8; ++e) gs += (float)a[e] * (float)b[e]; }
        OA[(size_t)row * D + ch] = (f16)((yn + bonus) * gs);
    }
}

__global__ void __launch_bounds__(NTHREADS, 2) fwd_kernel(Params p) {
    extern __shared__ __attribute__((aligned(16))) unsigned char lds_raw[];
    Ctx c;
    c.lds = (LAS unsigned char*)lds_raw;
    c.tid = threadIdx.x; c.lane = c.tid & 63; c.wave = __builtin_amdgcn_readfirstlane(c.tid >> 6);
    c.gw = blockIdx.x * NWAVES + c.wave; c.ngw = gridDim.x * NWAVES; c.gt = blockIdx.x * NTHREADS + c.tid; c.ngt = gridDim.x * NTHREADS;
    volatile LAS unsigned* MISC = (volatile LAS unsigned*)(c.lds + MISC_OFF);
    if (c.tid < 32) MISC[c.tid] = 0u;
    if (c.tid < 28) ((LAS unsigned long long*)(c.lds + PTAB_OFF))[c.tid] = (unsigned long long)p.in[c.tid];
    __syncthreads();
    unsigned* ctl = (unsigned*)(p.ws + WS_CTL);
    XcdBarrier bar = xcd_barrier_post(ctl + CW_BAR, MISC + 8);
#define GRID_BAR() xcd_barrier(bar)

    unsigned char* wb = p.ws + WS_W;
    const f16* WinT = (const f16*)(wb + WO_IN); const f16* WoutT = (const f16*)(wb + WO_OUT); const f16* WupT = (const f16*)(wb + WO_UP); const f16* WdnT = (const f16*)(wb + WO_DN);
    const f16* WsmT = (const f16*)(wb + WO_SM);
    f16* PROJ = (f16*)(p.ws + WS_R1); f16* HID = (f16*)(p.ws + WS_R1); f16* WA = (f16*)(p.ws + WS_R2); f16* MO = (f16*)(p.ws + WS_R2);
    f16* MG = (f16*)(p.ws + WS_R3); f16* H = (f16*)(p.ws + WS_R4); const f16* OA = (const f16*)(p.ws + WS_R4); const f16* WbrT = (const f16*)(wb + WO_BR);

    conv_weights(p, c, 0);
    __syncthreads();
    mod_phase(p, c);
    GRID_BAR();
    norm_phase<0>(p, c, 0);
    GRID_BAR();
#pragma nounroll
    for (int l = 0; l < NL; ++l) {
        { pg8::Gemm g{H, WinT, D, D, D}; pg8::StaticOrder S; S.init(M, DIN, (int)gridDim.x, (int)blockIdx.x); pg8::gemm_phase(c.lds, g, S, pg8::EpiProjF{PROJ}, c.wave); }
        GRID_BAR();
        { pg8::Gemm g{PROJ + PC_LW, WsmT, DIN, 128, 128}; pg8::StaticOrder S; S.init(M, 2048, (int)gridDim.x, (int)blockIdx.x);
          pg8::gemm_phase(c.lds, g, S, pg8::EpiWAF{WA, IN(19) + (size_t)l * 2 * CW, IN(21) + (size_t)l * 2 * CW}, c.wave); }
        kv_prep(p, c, l);
        GRID_BAR();
        fast_scan(p, c, l);
        __syncthreads();
        fast_attn(p, c, l);
        GRID_BAR();
        post_phase(p, c, l);
        GRID_BAR();
        { pg8::StaticOrder S; S.init(M, D, (int)gridDim.x, (int)blockIdx.x);
          pg8::Gemm g0{OA, WbrT, D, D, CW}; pg8::gemm_phase(c.lds, g0, S, pg8::EpiMergeF<0>{MG, PROJ}, c.wave);
          pg8::Gemm g1{OA + CW, WbrT + CW, D, D, CW}; pg8::gemm_phase(c.lds, g1, S, pg8::EpiMergeF<1>{MG, PROJ}, c.wave); }
        GRID_BAR();
        { pg8::Gemm g{MG, WoutT, D, D, D}; pg8::StaticOrder S; S.init(M, D, (int)gridDim.x, (int)blockIdx.x); pg8::gemm_phase(c.lds, g, S, pg8::EpiF16F{MO, D}, c.wave); }
        GRID_BAR();
        norm_phase<1>(p, c, l);
        GRID_BAR();
        { pg8::Gemm g{H, WupT, D, D, D}; pg8::StaticOrder S; S.init(M, DFF, (int)gridDim.x, (int)blockIdx.x); pg8::gemm_phase(c.lds, g, S, pg8::EpiRelu2F{HID, DFF}, c.wave); }
        GRID_BAR();
        { pg8::Gemm g{HID, WdnT, DFF, DFF, DFF}; pg8::StaticOrder S; S.init(M, D, (int)gridDim.x, (int)blockIdx.x); pg8::gemm_phase(c.lds, g, S, pg8::EpiF16F{MO, D}, c.wave); }
        GRID_BAR();
        norm_phase<2>(p, c, l);
        if (l + 1 < NL) { __syncthreads(); conv_weights(p, c, l + 1); }
        GRID_BAR();
    }
}

extern "C" void kernel_launch(void* const* d_in, const int* in_sizes, int n_in, void* d_out, int out_size, void* d_ws, size_t ws_size, hipStream_t stream) {
    static int grid = 0;
    if (grid == 0) {
        if (n_in != 28 || (size_t)out_size != O_TOTAL || ws_size < WS_END) { fprintf(stderr, "kernel_launch: unexpected shapes n_in %d out %d ws %zu\n", n_in, out_size, ws_size); grid = -1; return; }
        int dev = 0, cus = 0;
        if (hipGetDevice(&dev) != hipSuccess || hipDeviceGetAttribute(&cus, hipDeviceAttributeMultiprocessorCount, dev) != hipSuccess) { grid = -1; return; }
        if (hipFuncSetAttribute((const void*)fwd_kernel, hipFuncAttributeMaxDynamicSharedMemorySize, LDS_BYTES) != hipSuccess) { fprintf(stderr, "kernel_launch: hipFuncSetAttribute failed\n"); grid = -1; return; }
        grid = cus;
    }
    if (grid < 0) return;
    (void)hipMemsetAsync((char*)d_ws + WS_CTL, 0, CTL_BYTES, stream);
    Params p{};
    for (int i = 0; i < 28; ++i) p.in[i] = (const float*)d_in[i];
    p.out = (float*)d_out; p.ws = (unsigned char*)d_ws;
    hipLaunchKernelGGL(fwd_kernel, dim3(grid), dim3(NTHREADS), LDS_BYTES, stream, p);
}
```

```cpp
#include <hip/hip_runtime.h>
#include <cstdio>
#include <cstdint>

#define GAS __attribute__((address_space(1)))
#define LAS __attribute__((address_space(3)))
typedef _Float16 f16;
typedef _Float16 f16x8 __attribute__((ext_vector_type(8)));
typedef _Float16 f16x4 __attribute__((ext_vector_type(4)));
typedef _Float16 f16x2 __attribute__((ext_vector_type(2)));
typedef float f32x4 __attribute__((ext_vector_type(4)));
typedef float f32x16 __attribute__((ext_vector_type(16)));
typedef unsigned v4u __attribute__((ext_vector_type(4)));
typedef unsigned v2u __attribute__((ext_vector_type(2)));

constexpr int D = 1024, DIN = 4608, DFF = 4096, CW = 512, NL = 2, NH = 8, HD = 64;
constexpr int B_CTX = 32, T_CTX = 256, B_SMP = 4, T_SMP = 1024, PAST = 256, KV_SMP = PAST + T_SMP;
constexpr int M_CTX = B_CTX * T_CTX, M_SMP = B_SMP * T_SMP, M = M_CTX + M_SMP;
constexpr int NMOD = 6 * D;
constexpr int PC_R = 0, PC_K = 512, PC_V = 1024, PC_LW = 1536, PC_LA = 1600, PC_LG = 1664, PC_Q = 1792, PC_KA = 2304, PC_VA = 2432, PC_GR = 2560, PC_GA = 3584;
constexpr size_t O_Y = 0, O_CK = (size_t)M * D, O_CV = O_CK + (size_t)B_CTX * NL * T_CTX * 128, O_ST = O_CV + (size_t)B_CTX * NL * T_CTX * 128;
constexpr size_t O_TOTAL = O_ST + (size_t)B_CTX * NL * 2 * NH * HD * HD;

constexpr size_t MiB = 1u << 20;
constexpr size_t WS_CTL = 0, CTL_BYTES = 1 * MiB;
constexpr size_t WS_MOD = 1 * MiB;
constexpr size_t WS_W = 2 * MiB;
constexpr size_t WO_IN = 0, WO_BR = 9 * MiB, WO_OUT = 11 * MiB, WO_UP = 13 * MiB, WO_DN = 21 * MiB, WO_SM = 29 * MiB, WO_G = 29 * MiB + 512 * 1024;
constexpr size_t WS_R1 = 32 * MiB;
constexpr size_t WS_R2 = 140 * MiB;
constexpr size_t WS_R3 = 188 * MiB;
constexpr size_t WS_RK = 212 * MiB;
constexpr size_t WS_R4 = 213 * MiB;
constexpr size_t WS_KN = 237 * MiB;
constexpr size_t WS_VT = 241 * MiB;
constexpr size_t WS_END = 245 * MiB;
constexpr size_t KN_SMP_OFF = (size_t)B_CTX * 2 * T_CTX * 64;

constexpr int NWAVES = 8, NTHREADS = 512;
constexpr int LDS_BYTES = 147456;
constexpr int MISC_OFF = 131072 + 320, PTAB_OFF = 131072 + 1024;

#define XB_TMO      128
#define XB_XCNT(j)  (256  + 64 * (j))
#define XB_XSUB(j)  (1280 + 64 * (j))
#define XB_XGEN(j)  (2304 + 64 * (j))
#define XB_TOP      3328
#define XB_TOPGEN   3392
#define XCD_BAR_WORDS 3456
#define XB_SPIN_CAP (1u << 24)
constexpr int CW_BAR = 4096;

__device__ __forceinline__ unsigned xb_ld(unsigned* p)              { return __hip_atomic_load(p, __ATOMIC_RELAXED, __HIP_MEMORY_SCOPE_AGENT); }
__device__ __forceinline__ unsigned xb_add(unsigned* p, unsigned v) { return __hip_atomic_fetch_add(p, v, __ATOMIC_RELAXED, __HIP_MEMORY_SCOPE_AGENT); }
__device__ __forceinline__ unsigned xb_xcc_id() { return (unsigned)__builtin_amdgcn_s_getreg((3 << 11) | 20) & 0xFu; }
#define XB_SPIN(cond, bar) do { unsigned _sp = 0; while (cond) { __builtin_amdgcn_s_sleep(1); \
    if ((++_sp & 255u) == 0u) { if (xb_ld(&(bar)[XB_TMO])) break; if (_sp > XB_SPIN_CAP) { atomicAdd(&(bar)[XB_TMO], 1u); break; } } } } while (0)

struct XcdBarrier { unsigned* bar; unsigned x; volatile LAS unsigned* st; };

__device__ __forceinline__ XcdBarrier xcd_barrier_post(unsigned* bar, volatile LAS unsigned* st) {
    XcdBarrier b; b.bar = bar; b.x = xb_xcc_id(); b.st = st;
    if (threadIdx.x == 0) (void)xb_add(&bar[XB_XCNT(b.x)], 1u);
    return b;
}
__device__ __forceinline__ void xcd_barrier_complete(unsigned* bar, unsigned x, unsigned& nloc, unsigned& nx) {
    const unsigned G = gridDim.x * gridDim.y * gridDim.z;
    unsigned sum, cnt, mine, sp = 0u;
    for (;;) {
        sum = 0u; cnt = 0u; mine = 0u;
#pragma unroll
        for (unsigned j = 0; j < 16; ++j) { const unsigned c = xb_ld(&bar[XB_XCNT(j)]); sum += c; cnt += (c > 0u) ? 1u : 0u; mine = (j == x) ? c : mine; }
        if (sum == G) break;
        __builtin_amdgcn_s_sleep(1);
        if ((++sp & 255u) == 0u) { if (xb_ld(&bar[XB_TMO])) break; if (sp > XB_SPIN_CAP) { atomicAdd(&bar[XB_TMO], 1u); break; } }
    }
    nloc = mine > 0u ? mine : 1u; nx = cnt > 0u ? cnt : 1u;
}
__device__ __forceinline__ void xcd_barrier(const XcdBarrier& b) {
    asm volatile("s_waitcnt vmcnt(0)" ::: "memory");
    __syncthreads();
    if (threadIdx.x == 0) {
        unsigned* bar = b.bar; unsigned bx = b.x;
        asm volatile("" : "+s"(bar), "+s"(bx));
        __builtin_amdgcn_s_waitcnt(0);
        unsigned nloc = b.st[0], nx = b.st[1];
        if (nloc == 0u) { xcd_barrier_complete(bar, bx, nloc, nx); b.st[0] = nloc; b.st[1] = nx; }
        const unsigned old = xb_add(&bar[XB_XSUB(bx)], 1u);
        const unsigned gen = old / nloc;
        if (old + 1u == (gen + 1u) * nloc) {
            __builtin_amdgcn_fence(__ATOMIC_RELEASE, "agent");
            asm volatile("s_waitcnt vmcnt(0)" ::: "memory");
            const unsigned og = xb_add(&bar[XB_TOP], 1u);
            const unsigned tg = og / nx;
            if (og + 1u == (tg + 1u) * nx) xb_add(&bar[XB_TOPGEN], 1u);
            else XB_SPIN(xb_ld(&bar[XB_TOPGEN]) == tg, bar);
            __builtin_amdgcn_fence(__ATOMIC_ACQUIRE, "agent");
            xb_add(&bar[XB_XGEN(bx)], 1u);
            asm volatile("s_waitcnt vmcnt(0)" ::: "memory");
        } else {
            XB_SPIN(xb_ld(&bar[XB_XGEN(bx)]) == gen, bar);
            __builtin_amdgcn_fence(__ATOMIC_ACQUIRE, "agent");
            asm volatile("s_waitcnt vmcnt(0)" ::: "memory");
        }
    }
    __syncthreads();
}

#define LDS_WAIT() asm volatile("s_waitcnt lgkmcnt(0)" ::: "memory")
#define DPPF(x, ctrl, rmask, oldv) __builtin_bit_cast(float, __builtin_amdgcn_update_dpp(__builtin_bit_cast(int, (float)(oldv)), __builtin_bit_cast(int, (float)(x)), (ctrl), (rmask), 0xF, false))
__device__ __forceinline__ float wave_sum(float v) {
    v += DPPF(v, 0xB1, 0xF, 0.f); v += DPPF(v, 0x4E, 0xF, 0.f); v += DPPF(v, 0x141, 0xF, 0.f); v += DPPF(v, 0x140, 0xF, 0.f);
    v += DPPF(v, 0x142, 0xA, 0.f); v += DPPF(v, 0x143, 0xC, 0.f);
    return __builtin_bit_cast(float, __builtin_amdgcn_readlane(__builtin_bit_cast(int, v), 63));
}
__device__ __forceinline__ float dpp_f(float x, const int ctrl) { return x; }
#define DPP_ADD(x, ctrl) (x) += __builtin_bit_cast(float, __builtin_amdgcn_update_dpp(0, __builtin_bit_cast(int, (x)), (ctrl), 0xF, 0xF, true))
__device__ __forceinline__ float dpp_sum8(float x) { DPP_ADD(x, 0xB1); DPP_ADD(x, 0x4E); DPP_ADD(x, 0x141); return x; }
__device__ __forceinline__ float dpp_sum16(float x) { DPP_ADD(x, 0xB1); DPP_ADD(x, 0x4E); DPP_ADD(x, 0x141); DPP_ADD(x, 0x140); return x; }
__device__ __forceinline__ void swap32(float& a, float& b) { asm volatile("v_nop\n\tv_nop\n\tv_permlane32_swap_b32 %0, %1" : "+v"(a), "+v"(b)); }
__device__ __forceinline__ float half_sum(float v) { float a = v, b = v; swap32(a, b); return a + b; }
__device__ __forceinline__ float half_max(float v) { float a = v, b = v; swap32(a, b); return fmaxf(a, b); }
__device__ __forceinline__ float xor16(float v) { return __builtin_bit_cast(float, __builtin_amdgcn_ds_swizzle(__builtin_bit_cast(int, v), 0x401F)); }
__device__ __forceinline__ float sigmoidf_(float x) { return 1.0f / (1.0f + __expf(-x)); }
__device__ __forceinline__ float tanhf_(float x) { return 1.0f - 2.0f / (1.0f + __expf(2.0f * x)); }
__device__ __forceinline__ unsigned pkh(float lo, float hi) { f16x2 v = {(f16)lo, (f16)hi}; return __builtin_bit_cast(unsigned, v); }
__device__ __forceinline__ void row_info(int row, int& g, int& t, int& T) {
    if (row < M_CTX) { g = 0; t = row & (T_CTX - 1); T = T_CTX; }
    else { const int r = row - M_CTX; g = 1 + (r >> 10); t = r & (T_SMP - 1); T = T_SMP; }
}

struct Params {
    const float* in[28];
    float* out;
    unsigned char* ws;
};
struct DParams { GAS float* out; GAS unsigned char* ws; };
struct Ctx {
    LAS unsigned char* lds;
    int tid, lane, wave, gw, ngw, gt, ngt, bid;
};
__device__ __forceinline__ int lane_id() { int ln; asm volatile("v_mbcnt_lo_u32_b32 %0, -1, 0\n\tv_mbcnt_hi_u32_b32 %0, -1, %0" : "=v"(ln)); return ln; }
__device__ __forceinline__ const GAS float* inp(const Ctx& c, int i) {
    const unsigned long long v = ((const LAS unsigned long long*)(c.lds + PTAB_OFF))[i];
    const unsigned lo = __builtin_amdgcn_readfirstlane((unsigned)v), hi = __builtin_amdgcn_readfirstlane((unsigned)(v >> 32));
    return (const GAS float*)(((unsigned long long)hi << 32) | lo); }
#define IN(i) inp(c, (i))
#define FRESH_P(p0) DParams p; { float* o_ = (p0).out; unsigned char* w_ = (p0).ws; asm volatile("" : "+s"(o_), "+s"(w_)); p.out = (GAS float*)o_; p.ws = (GAS unsigned char*)w_; }
__device__ __forceinline__ Ctx fresh(const Ctx& c0) {
    Ctx c = c0; int w = c0.wave; asm volatile("" : "+s"(w)); int ln = lane_id(); asm volatile("" : "+v"(ln));
    int b = blockIdx.x; asm volatile("" : "+s"(b));
    c.wave = w; c.lane = ln; c.tid = w * 64 + ln; c.bid = b;
    c.gw = b * 8 + w; c.gt = b * 512 + c.tid; return c; }

__device__ __forceinline__ void conv_item(const GAS float* W, int N, GAS f16* WT, int ldt, int koff, LAS float* scr, int kb, int nb, int lane) {
    const int k0 = 64 * kb, n0 = 32 * nb;
#pragma unroll 8
    for (int i = 0; i < 32; ++i) { const int kk = 2 * i + (lane >> 5); scr[kk * 33 + (lane & 31)] = W[(size_t)(k0 + kk) * N + n0 + (lane & 31)]; }
    LDS_WAIT();
    const int c = lane & 7;
#pragma unroll
    for (int j = 0; j < 4; ++j) { const int n = (lane >> 3) + 8 * j; const LAS float* s = scr + (8 * c) * 33 + n;
        v4u o; o.x = pkh(s[0 * 33], s[1 * 33]); o.y = pkh(s[2 * 33], s[3 * 33]); o.z = pkh(s[4 * 33], s[5 * 33]); o.w = pkh(s[6 * 33], s[7 * 33]);
        *(GAS v4u*)(WT + (size_t)(n0 + n) * ldt + koff + k0 + 8 * c) = o; }
    LDS_WAIT();
}
__device__ __forceinline__ void conv_weights(const Params& p0, const Ctx& c0, int l) {
    const Ctx c = fresh(c0); FRESH_P(p0);
    LAS float* scr = (LAS float*)(c.lds + c.wave * 16384);
    GAS unsigned char* wb = p.ws + WS_W;
    GAS f16* WinT = (GAS f16*)(wb + WO_IN); GAS f16* WbrT = (GAS f16*)(wb + WO_BR); GAS f16* WoutT = (GAS f16*)(wb + WO_OUT); GAS f16* WupT = (GAS f16*)(wb + WO_UP); GAS f16* WdnT = (GAS f16*)(wb + WO_DN);
    GAS f16* WsmT = (GAS f16*)(wb + WO_SM); GAS f16* WgT = (GAS f16*)(wb + WO_G);
    const GAS float* w_in = IN(7) + (size_t)l * D * DIN; const GAS float* w_br = IN(8) + (size_t)l * 2 * CW * D; const GAS float* w_out = IN(9) + (size_t)l * D * D;
    const GAS float* w_up = IN(13) + (size_t)l * D * DFF; const GAS float* w_dn = IN(14) + (size_t)l * DFF * D;
    const GAS float* dec_up = IN(20) + (size_t)l * 2 * 64 * CW; const GAS float* icl_up = IN(22) + (size_t)l * 2 * 64 * CW; const GAS float* gate_up = IN(23) + (size_t)l * 128 * CW;
    constexpr int I0 = 16 * 144, I1 = 8 * 32, I2 = 8 * 32, I3 = 16 * 32, I4 = 16 * 128, I5 = 64 * 32, I6 = 16, I7 = 16, I8 = 16, I9 = 16, I10 = 2 * 16;
    constexpr int NIT = I0 + I1 + I2 + I3 + I4 + I5 + I6 + I7 + I8 + I9 + I10;
    for (int it = c.gw; it < NIT; it += c.ngw) {
        int r = it;
        if (r < I0) { conv_item(w_in, DIN, WinT, D, 0, scr, r / 144, r % 144, c.lane); continue; } r -= I0;
        if (r < I1) { conv_item(w_br, D, WbrT, D, 0, scr, r / 32, r % 32, c.lane); continue; } r -= I1;
        if (r < I2) { conv_item(w_br + (size_t)CW * D, D, WbrT, D, CW, scr, r / 32, r % 32, c.lane); continue; } r -= I2;
        if (r < I3) { conv_item(w_out, D, WoutT, D, 0, scr, r / 32, r % 32, c.lane); continue; } r -= I3;
        if (r < I4) { conv_item(w_up, DFF, WupT, D, 0, scr, r / 128, r % 128, c.lane); continue; } r -= I4;
        if (r < I5) { conv_item(w_dn, D, WdnT, DFF, 0, scr, r / 32, r % 32, c.lane); continue; } r -= I5;
        if (r < I6) { conv_item(dec_up, CW, WsmT, 128, 0, scr, 0, r, c.lane); continue; } r -= I6;
        if (r < I7) { conv_item(dec_up + 64 * CW, CW, WsmT + (size_t)512 * 128, 128, 0, scr, 0, r, c.lane); continue; } r -= I7;
        if (r < I8) { conv_item(icl_up, CW, WsmT + (size_t)1024 * 128, 128, 64, scr, 0, r, c.lane); continue; } r -= I8;
        if (r < I9) { conv_item(icl_up + 64 * CW, CW, WsmT + (size_t)1536 * 128, 128, 64, scr, 0, r, c.lane); continue; } r -= I9;
        conv_item(gate_up, CW, WgT, 128, 0, scr, r / 16, r % 16, c.lane);
    }
    for (int i = c.gt; i < 2048 * 8; i += c.ngt) { const int row = i >> 3, ch = i & 7; const int col = (row < 1024 ? 64 : 0) + ch * 8;
        *(GAS v4u*)(WsmT + (size_t)row * 128 + col) = (v4u){0u, 0u, 0u, 0u}; }
}

__device__ __forceinline__ void mod_phase(const Params& p0, const Ctx& c0) {
    const Ctx c = fresh(c0); FRESH_P(p0);
    LAS float* sl = (LAS float*)(c.lds);
    LAS float* part = (LAS float*)(c.lds + 32768);
    GAS float* mod = (GAS float*)(p.ws + WS_MOD);
    for (int i = c.tid; i < 5 * D; i += NTHREADS) { const int g = i >> 10, k = i & 1023; const float v = g == 0 ? IN(6)[k] : IN(5)[(g - 1) * D + k]; sl[i] = v / (1.0f + __expf(-v)); }
    __syncthreads();
    for (int it = c.bid; it < NL * (NMOD / 64); it += gridDim.x) {
        const int l = it / (NMOD / 64), cc = it % (NMOD / 64);
        const GAS float* w = IN(10) + (size_t)l * D * NMOD + cc * 64 + c.lane;
        float a0 = 0.f, a1 = 0.f, a2 = 0.f, a3 = 0.f, a4 = 0.f;
        const int kb = c.wave * 128;
#pragma unroll 4
        for (int k = kb; k < kb + 128; ++k) { const float wv = w[(size_t)k * NMOD]; a0 += sl[k] * wv; a1 += sl[D + k] * wv; a2 += sl[2 * D + k] * wv; a3 += sl[3 * D + k] * wv; a4 += sl[4 * D + k] * wv; }
        LAS float* pw = part + c.wave * 320 + c.lane;
        pw[0] = a0; pw[64] = a1; pw[128] = a2; pw[192] = a3; pw[256] = a4;
        __syncthreads();
        if (c.tid < 320) { float s = 0.f;
#pragma unroll
            for (int w8 = 0; w8 < 8; ++w8) s += part[w8 * 320 + c.tid];
            const int g = c.tid >> 6, col = cc * 64 + (c.tid & 63);
            mod[((size_t)l * 5 + g) * NMOD + col] = s + IN(11)[(size_t)l * NMOD + col]; }
        __syncthreads();
    }
}

template <int MODE>
__device__ __forceinline__ void norm_phase(const Params& p0, const Ctx& c0, int l) {
    const Ctx c = fresh(c0); FRESH_P(p0);
    GAS float* X = p.out; const GAS f16* MO = (const GAS f16*)(p.ws + WS_R2); GAS f16* H = (GAS f16*)(p.ws + WS_R4);
    const GAS float* modb = (const GAS float*)(p.ws + WS_MOD);
    for (int row = c.gw; row < M; row += c.ngw) {
        int g, t, T; row_info(row, g, t, T);
        f32x4 x[4];
        if (MODE == 0) { const GAS float* src = row < M_CTX ? IN(0) + (size_t)row * D : IN(1) + (size_t)(row - M_CTX) * D;
#pragma unroll
            for (int j = 0; j < 4; ++j) x[j] = *(const GAS f32x4*)(src + 256 * j + 4 * c.lane);
        } else {
            const GAS float* mo_mod = modb + ((size_t)l * 5 + g) * NMOD + (MODE == 1 ? 2 * D : 5 * D);
            const GAS float* ngp = IN(12) + ((size_t)l * 4 + (MODE == 1 ? 1 : 3)) * D;
            float mv[4][4]; float ss = 0.f;
#pragma unroll
            for (int j = 0; j < 4; ++j) { const f16x4 h = *(const GAS f16x4*)(MO + (size_t)row * D + 256 * j + 4 * c.lane);
#pragma unroll
                for (int e = 0; e < 4; ++e) { mv[j][e] = (float)h[e]; ss += mv[j][e] * mv[j][e]; } }
            const float rstd = rsqrtf(wave_sum(ss) * (1.0f / D) + 1e-6f);
#pragma unroll
            for (int j = 0; j < 4; ++j) { x[j] = *(const GAS f32x4*)(X + (size_t)row * D + 256 * j + 4 * c.lane);
                const f32x4 gg = *(const GAS f32x4*)(mo_mod + 256 * j + 4 * c.lane); const f32x4 nn = *(const GAS f32x4*)(ngp + 256 * j + 4 * c.lane);
#pragma unroll
                for (int e = 0; e < 4; ++e) x[j][e] += gg[e] * (mv[j][e] * rstd * nn[e]); }
        }
#pragma unroll
        for (int j = 0; j < 4; ++j) *(GAS f32x4*)(X + (size_t)row * D + 256 * j + 4 * c.lane) = x[j];
        const int ln = MODE == 2 ? l + 1 : l;
        if (ln < NL) {
            const GAS float* mb = modb + ((size_t)ln * 5 + g) * NMOD + (MODE == 1 ? 3 * D : 0);
            const GAS float* ngp = IN(12) + ((size_t)ln * 4 + (MODE == 1 ? 2 : 0)) * D;
            float ss = 0.f;
#pragma unroll
            for (int j = 0; j < 4; ++j) ss += (x[j][0] * x[j][0] + x[j][1] * x[j][1]) + (x[j][2] * x[j][2] + x[j][3] * x[j][3]);
            const float rstd = rsqrtf(wave_sum(ss) * (1.0f / D) + 1e-6f);
#pragma unroll
            for (int j = 0; j < 4; ++j) { const f32x4 sh = *(const GAS f32x4*)(mb + 256 * j + 4 * c.lane); const f32x4 sc = *(const GAS f32x4*)(mb + D + 256 * j + 4 * c.lane);
                const f32x4 nn = *(const GAS f32x4*)(ngp + 256 * j + 4 * c.lane);
                float o[4];
#pragma unroll
                for (int e = 0; e < 4; ++e) o[e] = x[j][e] * rstd * nn[e] * (1.0f + sc[e]) + sh[e];
                v2u w; w.x = pkh(o[0], o[1]); w.y = pkh(o[2], o[3]);
                *(GAS v2u*)(H + (size_t)row * D + 256 * j + 4 * c.lane) = w; }
        }
    }
}

namespace pg8 {
constexpr int BM = 256, BK = 64, HALF = 128, HTB = HALF * BK * 2, STAGE_BYTES = 8 * HTB, NXCD = 8, WGM = 8;
__host__ __device__ __forceinline__ int lds_byte(int r, int c) { const int st = (r >> 4) * 2 + (c >> 5), rr = r & 15, cc = c & 31, ob = rr * 64 + cc * 2; return st * 1024 + (ob ^ (((ob >> 9) & 1) << 5)); }
__host__ __device__ __forceinline__ void stage_rc(int b, int& R, int& C) { const int st = b / 1024, sb = b % 1024, swz = sb ^ (((sb >> 9) & 1) << 5); R = (st >> 1) * 16 + swz / 64; C = (st & 1) * 32 + (swz % 64) / 2; }
__host__ __device__ __forceinline__ int perm32(int rho) { const int n = rho >> 4, i = rho & 15; return 8 * (i >> 2) + 4 * n + (i & 3); }
struct Unit { int pm, pn; };
struct Gemm { const GAS f16* A; const GAS f16* Bt; int lda, ldb, K; };
struct StaticOrder {
    int nM, nN, nwg, G, c;
    __device__ void init(int Mr, int N, int G_, int c_) { nM = Mr / BM; nN = N / BM; nwg = nM * nN; G = G_; c = c_; }
    __device__ bool next(int i, Unit& u) const {
        const long L = (long)i * G + c; if (L >= nwg) return false;
        int wgid = (int)L; { const int q = nwg / NXCD, r = nwg % NXCD, xcd = wgid % NXCD, off = wgid / NXCD; wgid = (xcd < r ? xcd * (q + 1) : r * (q + 1) + (xcd - r) * q) + off; }
        const int nig = WGM * nN, gid = wgid / nig, fm = gid * WGM, gsz = (nM - fm) < WGM ? (nM - fm) : WGM;
        u.pm = fm + ((wgid % nig) % gsz); u.pn = (wgid % nig) / gsz; return true;
    }
};
template <class Epi, bool ALIGN_EPI = true, bool SP2 = true>
__device__ __forceinline__ void gemm_phase(LAS unsigned char* lds, const Gemm g, const StaticOrder& S, const Epi& E, int wave_sgpr) {
    asm volatile("" : "+s"(wave_sgpr)); int tid = wave_sgpr * 64 + lane_id(); asm volatile("" : "+v"(tid));
    const int wid = __builtin_amdgcn_readfirstlane(tid >> 6), lane = tid & 63, wr = wid >> 2, wc = wid & 3, fr = lane & 15, fq = lane >> 4;
    const int K = g.K, nt = K / BK;
    unsigned voffA[2], voffB[2];
#pragma unroll
    for (int i = 0; i < 2; ++i) { int R, C; stage_rc(tid * 16 + i * 8192, R, C); const int Rb = (R & ~31) + perm32(R & 31);
        voffA[i] = (unsigned)(R * g.lda + C) * 2u; voffB[i] = (unsigned)(Rb * g.ldb + C) * 2u; }
    const unsigned kstep = (unsigned)(BK * 2);
    const unsigned hstepA = (unsigned)HALF * g.lda * 2, hstepB = (unsigned)HALF * g.ldb * 2;
    const unsigned tstepA = 2 * hstepA, tstepB = 2 * hstepB;
    const unsigned ldsw = (unsigned)wid * 1024u;
    const int aoff = lds_byte(wr * 64 + fr, fq * 8), boff = lds_byte(wc * 32 + fr, fq * 8);
#define PG8_SA(b, h) (((b) * 2 + (h)) * HTB)
#define PG8_SB(b, h) ((4 + (b) * 2 + (h)) * HTB)
#define PG8_STAGE(bufoff, gbase, soff, voff) do { _Pragma("unroll") for (int _i = 0; _i < 2; ++_i) \
        __builtin_amdgcn_raw_ptr_buffer_load_lds(rs##gbase, (LAS unsigned*)(lds + (bufoff) + ldsw + _i * 8192), 16, (voff)[_i], (int)(soff), 0, 0); } while (0)
#define PG8_LDA(dst, b, h) do { _Pragma("unroll") for (int m = 0; m < 4; ++m) _Pragma("unroll") for (int k = 0; k < 2; ++k) dst[m][k] = *(const LAS f16x8*)(lds + PG8_SA(b, h) + aoff + m * 2048 + k * 1024); } while (0)
#define PG8_LDB(dst, b, h) do { _Pragma("unroll") for (int n = 0; n < 2; ++n) _Pragma("unroll") for (int k = 0; k < 2; ++k) dst[n][k] = *(const LAS f16x8*)(lds + PG8_SB(b, h) + boff + n * 2048 + k * 1024); } while (0)
#define PG8_MMA(ai, bj, At, Bt) do { __builtin_amdgcn_s_setprio(1); _Pragma("unroll") for (int m = 0; m < 4; ++m) _Pragma("unroll") for (int n = 0; n < 2; ++n) _Pragma("unroll") for (int k = 0; k < 2; ++k) \
        acc[ai][bj][m][n] = __builtin_amdgcn_mfma_f32_16x16x32_f16(Bt[n][k], At[m][k], acc[ai][bj][m][n], 0, 0, 0); __builtin_amdgcn_s_setprio(0); } while (0)
#define PG8_WAIT_V(n) asm volatile("s_waitcnt vmcnt(" #n ")" ::: "memory")
#define PG8_WAIT_L(n) asm volatile("s_waitcnt lgkmcnt(" #n ")" ::: "memory")
#define PG8_BAR __builtin_amdgcn_s_barrier()
#define PG8_SCHED __builtin_amdgcn_sched_barrier(0)
    Unit cur, nxt; int ui = 0;
    if (!S.next(0, cur)) return;
    f32x4 acc[2][2][4][2];
#pragma unroll
    for (int a = 0; a < 2; ++a)
#pragma unroll
        for (int b = 0; b < 2; ++b)
#pragma unroll
            for (int m = 0; m < 4; ++m)
#pragma unroll
                for (int n = 0; n < 2; ++n) acc[a][b][m][n] = (f32x4){0.f, 0.f, 0.f, 0.f};
    f16x8 At[4][2], B0[2][2], B1[2][2];
    const auto rsA = __builtin_amdgcn_make_buffer_rsrc((GAS void*)g.A, 0, 0x7fffffff, 0x00020000); const auto rsB = __builtin_amdgcn_make_buffer_rsrc((GAS void*)g.Bt, 0, 0x7fffffff, 0x00020000);
    unsigned cA = (unsigned)cur.pm * tstepA, cB = (unsigned)cur.pn * tstepB;
    if constexpr (SP2) {
        PG8_STAGE(PG8_SB(0, 0), B, cB, voffB); PG8_STAGE(PG8_SB(0, 1), B, cB + hstepB, voffB); PG8_STAGE(PG8_SA(0, 0), A, cA, voffA); PG8_STAGE(PG8_SA(0, 1), A, cA + hstepA, voffA);
        if (wr == 1) PG8_BAR;
        PG8_WAIT_V(2); PG8_BAR;
        PG8_STAGE(PG8_SB(1, 0), B, cB + kstep, voffB); PG8_STAGE(PG8_SA(1, 0), A, cA + kstep, voffA); PG8_STAGE(PG8_SB(1, 1), B, cB + hstepB + kstep, voffB);
        PG8_WAIT_V(6); PG8_BAR;
    } else {
        PG8_STAGE(PG8_SB(0, 0), B, cB, voffB); PG8_STAGE(PG8_SA(0, 0), A, cA, voffA); PG8_STAGE(PG8_SB(0, 1), B, cB + hstepB, voffB); PG8_STAGE(PG8_SA(0, 1), A, cA + hstepA, voffA);
        if (wr == 1) PG8_BAR;
        PG8_WAIT_V(4); PG8_BAR;
        PG8_STAGE(PG8_SB(1, 0), B, cB + kstep, voffB); PG8_STAGE(PG8_SA(1, 0), A, cA + kstep, voffA); PG8_STAGE(PG8_SB(1, 1), B, cB + hstepB + kstep, voffB);
        PG8_WAIT_V(6); PG8_BAR;
    }
    for (;;) {
        const bool has_next = S.next(ui + 1, nxt);
        const unsigned nA = has_next ? (unsigned)nxt.pm * tstepA : cA, nB = has_next ? (unsigned)nxt.pn * tstepB : cB;
        for (int t = 0; t < nt; t += 2) {
            const bool last = (t == nt - 2);
            const unsigned a1 = cA + (unsigned)(t + 1) * kstep;
            const unsigned a2 = last ? nA : cA + (unsigned)(t + 2) * kstep, b2 = last ? nB : cB + (unsigned)(t + 2) * kstep;
            const unsigned a3 = a2 + kstep, b3 = b2 + kstep;
            if constexpr (SP2) {
            PG8_LDB(B0, 0, 0); PG8_LDB(B1, 0, 1); PG8_SCHED; PG8_LDA(At, 0, 0); PG8_STAGE(PG8_SA(1, 1), A, a1 + hstepA, voffA);
            PG8_WAIT_V(8); PG8_WAIT_L(0); PG8_BAR; PG8_MMA(0, 0, At, B0); PG8_MMA(0, 1, At, B1); PG8_BAR; PG8_SCHED;
            PG8_LDA(At, 0, 1); PG8_STAGE(PG8_SB(0, 0), B, b2, voffB); PG8_STAGE(PG8_SB(0, 1), B, b2 + hstepB, voffB); PG8_STAGE(PG8_SA(0, 0), A, a2, voffA);
            PG8_WAIT_V(8); PG8_WAIT_L(0); PG8_BAR; PG8_MMA(1, 0, At, B0); PG8_MMA(1, 1, At, B1); PG8_BAR; PG8_SCHED;
            PG8_LDB(B0, 1, 0); PG8_LDB(B1, 1, 1); PG8_SCHED; PG8_LDA(At, 1, 0); PG8_STAGE(PG8_SA(0, 1), A, a2 + hstepA, voffA);
            PG8_WAIT_V(8); PG8_WAIT_L(0); PG8_BAR; PG8_MMA(0, 0, At, B0); PG8_MMA(0, 1, At, B1); PG8_BAR; PG8_SCHED;
            PG8_LDA(At, 1, 1); PG8_STAGE(PG8_SB(1, 0), B, b3, voffB); PG8_STAGE(PG8_SB(1, 1), B, b3 + hstepB, voffB); PG8_STAGE(PG8_SA(1, 0), A, a3, voffA);
            PG8_WAIT_V(8); PG8_WAIT_L(0); PG8_BAR; PG8_MMA(1, 0, At, B0); PG8_MMA(1, 1, At, B1); PG8_BAR; PG8_SCHED;
            } else {
            PG8_LDB(B0, 0, 0); PG8_SCHED; PG8_LDA(At, 0, 0); PG8_STAGE(PG8_SA(1, 1), A, a1 + hstepA, voffA);
            PG8_WAIT_L(8); PG8_BAR; PG8_WAIT_L(0); PG8_MMA(0, 0, At, B0); PG8_BAR; PG8_SCHED;
            PG8_LDB(B1, 0, 1); PG8_STAGE(PG8_SB(0, 0), B, b2, voffB);
            PG8_BAR; PG8_WAIT_L(0); PG8_MMA(0, 1, At, B1); PG8_BAR;
            PG8_LDA(At, 0, 1); PG8_STAGE(PG8_SA(0, 0), A, a2, voffA);
            PG8_BAR; PG8_WAIT_L(0); PG8_MMA(1, 0, At, B0); PG8_BAR; PG8_SCHED;
            PG8_STAGE(PG8_SB(0, 1), B, b2 + hstepB, voffB);
            PG8_WAIT_V(6); PG8_BAR; PG8_MMA(1, 1, At, B1); PG8_BAR;
            PG8_LDB(B0, 1, 0); PG8_SCHED; PG8_LDA(At, 1, 0); PG8_STAGE(PG8_SA(0, 1), A, a2 + hstepA, voffA);
            PG8_WAIT_L(8); PG8_BAR; PG8_WAIT_L(0); PG8_MMA(0, 0, At, B0); PG8_BAR; PG8_SCHED;
            PG8_LDB(B1, 1, 1); PG8_STAGE(PG8_SB(1, 0), B, b3, voffB);
            PG8_BAR; PG8_WAIT_L(0); PG8_MMA(0, 1, At, B1); PG8_BAR;
            PG8_LDA(At, 1, 1); PG8_STAGE(PG8_SA(1, 0), A, a3, voffA);
            PG8_BAR; PG8_WAIT_L(0); PG8_MMA(1, 0, At, B0); PG8_BAR; PG8_SCHED;
            PG8_STAGE(PG8_SB(1, 1), B, b3 + hstepB, voffB);
            PG8_WAIT_V(6); PG8_BAR; PG8_MMA(1, 1, At, B1); PG8_BAR;
            }
        }
        if constexpr (ALIGN_EPI) { if (wr == 0) PG8_BAR; }
        { const int ln2 = lane_id(); E(acc, cur, wr, wc, ln2 & 15, ln2 >> 4); }
        if (!has_next) break;
#pragma unroll
        for (int a = 0; a < 2; ++a)
#pragma unroll
            for (int b = 0; b < 2; ++b)
#pragma unroll
                for (int m = 0; m < 4; ++m)
#pragma unroll
                    for (int n = 0; n < 2; ++n) acc[a][b][m][n] = (f32x4){0.f, 0.f, 0.f, 0.f};
        cur = nxt; cA = nA; cB = nB; ++ui;
        if constexpr (ALIGN_EPI) { if (wr == 1) PG8_BAR; }
    }
    PG8_WAIT_V(0);
    if constexpr (!ALIGN_EPI) { if (wr == 0) PG8_BAR; }
    PG8_BAR;
#undef PG8_SA
#undef PG8_SB
#undef PG8_STAGE
#undef PG8_LDA
#undef PG8_LDB
#undef PG8_MMA
#undef PG8_WAIT_V
#undef PG8_WAIT_L
#undef PG8_BAR
#undef PG8_SCHED
}
typedef f32x4 Acc[2][2][4][2];
#define PG8_EPI_LOOP(...) \
    const int row0 = u.pm * BM + wr * 64 + fr, col0 = u.pn * BM + wc * 32 + 8 * fq; \
    _Pragma("unroll") for (int ai = 0; ai < 2; ++ai) _Pragma("unroll") for (int m = 0; m < 4; ++m) { const int row = row0 + ai * HALF + m * 16; \
        _Pragma("unroll") for (int bj = 0; bj < 2; ++bj) { const int col = col0 + bj * HALF; f32x4 v0 = acc[ai][bj][m][0], v1 = acc[ai][bj][m][1]; __VA_ARGS__ } asm volatile("" ::: "memory"); }
__device__ __forceinline__ void store8(GAS f16* p, f32x4 v0, f32x4 v1) { v4u w; w.x = pkh(v0[0], v0[1]); w.y = pkh(v0[2], v0[3]); w.z = pkh(v1[0], v1[1]); w.w = pkh(v1[2], v1[3]); *(GAS v4u*)p = w; }
struct EpiProjF { GAS f16* P;
    __device__ __forceinline__ void operator()(const Acc& acc, const Unit& u, int wr, int wc, int fr, int fq) const {
        PG8_EPI_LOOP(
            if (u.pn == 6) {
                if (col < PC_LA) { _Pragma("unroll") for (int e = 0; e < 4; ++e) { v0[e] = tanhf_(v0[e]); v1[e] = tanhf_(v1[e]); } }
                else if (col >= PC_LG) { _Pragma("unroll") for (int e = 0; e < 4; ++e) { v0[e] = sigmoidf_(v0[e]); v1[e] = sigmoidf_(v1[e]); } }
            } else if (u.pn >= 10) { _Pragma("unroll") for (int e = 0; e < 4; ++e) { v0[e] = sigmoidf_(v0[e]); v1[e] = sigmoidf_(v1[e]); } }
            store8(P + (size_t)row * DIN + col, v0, v1);
        )
    } };
#define DPPM(x, ctrl) (x) *= __builtin_bit_cast(float, __builtin_amdgcn_update_dpp(0x3f800000, __builtin_bit_cast(int, (x)), (ctrl), 0xF, 0xF, false))
struct EpiWAF { GAS f16* WA; const GAS float* w0; const GAS float* a0;
    __device__ __forceinline__ void operator()(const Acc& acc, const Unit& u, int wr, int wc, int fr, int fq) const {
        PG8_EPI_LOOP(
            if (col < 1024) { const f32x4 b0 = *(const GAS f32x4*)(w0 + col), b1 = *(const GAS f32x4*)(w0 + col + 4);
                float x[8];
                _Pragma("unroll") for (int e = 0; e < 4; ++e) { x[e] = __expf(-0.606531f * sigmoidf_(v0[e] + b0[e])); x[4 + e] = __expf(-0.606531f * sigmoidf_(v1[e] + b1[e])); }
                if (col < 512) {
                    _Pragma("unroll") for (int e = 0; e < 8; ++e) { DPPM(x[e], 0x111); DPPM(x[e], 0x112); DPPM(x[e], 0x114); DPPM(x[e], 0x118);
                        const float wm = __builtin_bit_cast(float, __builtin_amdgcn_ds_swizzle(__builtin_bit_cast(int, x[e]), 0x00F0)); x[e] = (fr == 7) ? wm : x[e] / wm; }
                } else {
                    _Pragma("unroll") for (int e = 0; e < 8; ++e) { DPPM(x[e], 0x101); DPPM(x[e], 0x102); DPPM(x[e], 0x104); DPPM(x[e], 0x108);
                        const float wm = __builtin_bit_cast(float, __builtin_amdgcn_ds_swizzle(__builtin_bit_cast(int, x[e]), 0x0110)); x[e] = (fr == 8) ? wm : x[e] / wm; }
                }
                _Pragma("unroll") for (int e = 0; e < 4; ++e) { v0[e] = x[e]; v1[e] = x[4 + e]; } }
            else { const f32x4 b0 = *(const GAS f32x4*)(a0 + col - 1024), b1 = *(const GAS f32x4*)(a0 + col - 1024 + 4);
                _Pragma("unroll") for (int e = 0; e < 4; ++e) { v0[e] = sigmoidf_(v0[e] + b0[e]); v1[e] = sigmoidf_(v1[e] + b1[e]); } }
            store8(WA + (size_t)row * 2048 + col, v0, v1);
        )
    } };
struct EpiF16F { GAS f16* O; int ld;
    __device__ __forceinline__ void operator()(const Acc& acc, const Unit& u, int wr, int wc, int fr, int fq) const {
        PG8_EPI_LOOP( store8(O + (size_t)row * ld + col, v0, v1); )
    } };
struct EpiRelu2F { GAS f16* O; int ld;
    __device__ __forceinline__ void operator()(const Acc& acc, const Unit& u, int wr, int wc, int fr, int fq) const {
        PG8_EPI_LOOP(
            _Pragma("unroll") for (int e = 0; e < 4; ++e) { const float a = fmaxf(v0[e], 0.f), b = fmaxf(v1[e], 0.f); v0[e] = a * a; v1[e] = b * b; }
            store8(O + (size_t)row * ld + col, v0, v1);
        )
    } };
template <int PASS> struct EpiMergeF { GAS f16* MG; const GAS f16* PROJ;
    __device__ __forceinline__ void operator()(const Acc& acc, const Unit& u, int wr, int wc, int fr, int fq) const {
        PG8_EPI_LOOP(
            const f16x8 gt = *(const GAS f16x8*)(PROJ + (size_t)row * DIN + (PASS == 0 ? PC_GR : PC_GA) + col);
            _Pragma("unroll") for (int e = 0; e < 4; ++e) { v0[e] *= (float)gt[e]; v1[e] *= (float)gt[4 + e]; }
            if (PASS == 1) { const f16x8 pv = *(const GAS f16x8*)(MG + (size_t)row * D + col);
                _Pragma("unroll") for (int e = 0; e < 4; ++e) { v0[e] += (float)pv[e]; v1[e] += (float)pv[4 + e]; } }
            store8(MG + (size_t)row * D + col, v0, v1);
        )
    } };
}

__device__ __forceinline__ void kv_prep(const Params& p0, const Ctx& c0, int l) {
    const Ctx c = fresh(c0); FRESH_P(p0);
    const GAS f16* PROJ = (const GAS f16*)(p.ws + WS_R1); GAS f16* KN = (GAS f16*)(p.ws + WS_KN); GAS f16* VT = (GAS f16*)(p.ws + WS_VT);
    const float kg = IN(27)[l * HD + c.lane];
    const int d = c.lane;
    for (int it = c.gw; it < M * 2; it += c.ngw) {
        const int row = it >> 1, kvh = it & 1;
        float kx = (float)PROJ[(size_t)row * DIN + PC_KA + kvh * HD + d]; const float vx = (float)PROJ[(size_t)row * DIN + PC_VA + kvh * HD + d];
        const float rstd = rsqrtf(wave_sum(kx * kx) * (1.0f / HD) + 1e-6f);
        kx = kx * rstd * kg;
        if (row < M_CTX) { const int b = row >> 8, t = row & 255;
            p.out[O_CK + ((((size_t)b * NL + l) * T_CTX + t) * 2 + kvh) * HD + d] = kx;
            p.out[O_CV + ((((size_t)b * NL + l) * T_CTX + t) * 2 + kvh) * HD + d] = vx;
            KN[(((size_t)b * 2 + kvh) * T_CTX + t) * HD + d] = (f16)kx;
            VT[(((size_t)b * 2 + kvh) * HD + d) * T_CTX + t] = (f16)vx;
        } else { const int r = row - M_CTX, b = r >> 10, t = r & 1023;
            const int axis = d >> 5, half = (d >> 4) & 1, f = d & 15;
            const float pos = (float)(axis == 0 ? (t >> 6) : (t & 63));
            const float freq = exp2f(-(float)f * (13.287712379549449f / 16.0f));
            const float ang = pos * freq; const float cs = __cosf(ang), sn = __sinf(ang);
            const float other = xor16(kx);
            const float ko = half == 0 ? kx * cs - other * sn : kx * cs + other * sn;
            KN[KN_SMP_OFF + (((size_t)b * 2 + kvh) * KV_SMP + PAST + t) * HD + d] = (f16)ko;
            VT[KN_SMP_OFF + (((size_t)b * 2 + kvh) * HD + d) * KV_SMP + PAST + t] = (f16)vx;
        }
    }
    for (int it = c.gw; it < B_SMP * PAST * 2; it += c.ngw) {
        const int kvh = it & 1, j = (it >> 1) & 255, b = it >> 9;
        const size_t src = ((((size_t)b * NL + l) * PAST + j) * 2 + kvh) * HD + d;
        KN[KN_SMP_OFF + (((size_t)b * 2 + kvh) * KV_SMP + j) * HD + d] = (f16)IN(2)[src];
        VT[KN_SMP_OFF + (((size_t)b * 2 + kvh) * HD + d) * KV_SMP + j] = (f16)IN(3)[src];
    }
}

constexpr int TC = 32, ST_STEP = 6 * 64, ST_BUF = TC * ST_STEP;
struct StageRegs { f16x4 r[3], k[3], v[3], w, a; };
__device__ __forceinline__ void scan_task(const DParams& p, const Ctx& c, int l, int task) {
    const GAS f16* PROJ = (const GAS f16*)(p.ws + WS_R1); const GAS f16* WA = (const GAS f16*)(p.ws + WS_R2);
    GAS f16* Y = (GAS f16*)(p.ws + WS_R3); GAS float* RK = (GAS float*)(p.ws + WS_RK);
    LAS float* st = (LAS float*)c.lds;
    int sq, dir, h;
    if (task < 64) { h = task & 7; dir = (task >> 3) & 1; sq = B_CTX + (task >> 4); } else { const int id = task - 64; h = id & 7; dir = (id >> 3) & 1; sq = id >> 4; }
    const bool smp = sq >= B_CTX; const int T = smp ? T_SMP : T_CTX; const int row0 = smp ? M_CTX + (sq - B_CTX) * T_SMP : sq * T_CTX;
    const int nch = T / TC;
    const int tt = c.tid >> 4, cq = c.tid & 15, ch0 = h * HD + cq * 4;
    const f32x4 mu_r = *(const GAS f32x4*)(IN(15) + (l * 3 + 0) * CW + ch0), mu_k = *(const GAS f32x4*)(IN(15) + (l * 3 + 1) * CW + ch0), mu_v = *(const GAS f32x4*)(IN(15) + (l * 3 + 2) * CW + ch0);
    const f32x4 k_k = *(const GAS f32x4*)(IN(16) + l * CW + ch0), k_a = *(const GAS f32x4*)(IN(17) + l * CW + ch0), r_k = *(const GAS f32x4*)(IN(18) + l * CW + ch0);
    const int ks = c.lane & 7, srow = c.wave * 8 + (c.lane >> 3);
    float S[8];
    if (smp) { const GAS float* s0 = IN(4) + (((((size_t)(sq - B_CTX) * NL + l) * 2 + dir) * NH + h) * HD + srow) * HD + ks * 8;
        const f32x4 a = *(const GAS f32x4*)s0, b = *(const GAS f32x4*)(s0 + 4);
        S[0] = a[0]; S[1] = a[1]; S[2] = a[2]; S[3] = a[3]; S[4] = b[0]; S[5] = b[1]; S[6] = b[2]; S[7] = b[3];
    } else {
#pragma unroll
        for (int j = 0; j < 8; ++j) S[j] = 0.f;
    }
    StageRegs sr;
    const f16x4 z4 = {(f16)0.f, (f16)0.f, (f16)0.f, (f16)0.f};
#define SCAN_LOAD(chunk) do { const int S_ = (chunk) * TC + tt; const int t_ = dir ? T - 1 - S_ : S_; const GAS f16* pr_ = PROJ + (size_t)(row0 + t_) * DIN + ch0; \
        sr.r[1] = *(const GAS f16x4*)(pr_ + PC_R); sr.k[1] = *(const GAS f16x4*)(pr_ + PC_K); sr.v[1] = *(const GAS f16x4*)(pr_ + PC_V); \
        if (t_ > 0) { sr.r[0] = *(const GAS f16x4*)(pr_ - DIN + PC_R); sr.k[0] = *(const GAS f16x4*)(pr_ - DIN + PC_K); sr.v[0] = *(const GAS f16x4*)(pr_ - DIN + PC_V); } else { sr.r[0] = z4; sr.k[0] = z4; sr.v[0] = z4; } \
        if (t_ < T - 1) { sr.r[2] = *(const GAS f16x4*)(pr_ + DIN + PC_R); sr.k[2] = *(const GAS f16x4*)(pr_ + DIN + PC_K); sr.v[2] = *(const GAS f16x4*)(pr_ + DIN + PC_V); } else { sr.r[2] = z4; sr.k[2] = z4; sr.v[2] = z4; } \
        const GAS f16* wa_ = WA + (size_t)(row0 + t_) * 2048 + dir * 512 + ch0; sr.w = *(const GAS f16x4*)wa_; sr.a = *(const GAS f16x4*)(wa_ + 1024); } while (0)
#define SCAN_STAGE(chunk) do { const int S_ = (chunk) * TC + tt; const int t_ = dir ? T - 1 - S_ : S_; \
        f32x4 r_, k_, v_, kk_, w_, a_, kh_, kt_, b_; float ss_ = 0.f, rk_ = 0.f; \
        _Pragma("unroll") for (int e = 0; e < 4; ++e) { const float rc = (float)sr.r[1][e], kc = (float)sr.k[1][e], vc = (float)sr.v[1][e]; \
            r_[e] = rc + mu_r[e] * (0.5f * ((float)sr.r[0][e] + (float)sr.r[2][e]) - rc); k_[e] = kc + mu_k[e] * (0.5f * ((float)sr.k[0][e] + (float)sr.k[2][e]) - kc); \
            v_[e] = vc + mu_v[e] * (0.5f * ((float)sr.v[0][e] + (float)sr.v[2][e]) - vc); kk_[e] = k_[e] * k_k[e]; ss_ += kk_[e] * kk_[e]; w_[e] = (float)sr.w[e]; a_[e] = (float)sr.a[e]; } \
        ss_ = dpp_sum16(ss_); const float ri_ = rsqrtf(ss_ + 1e-12f); \
        _Pragma("unroll") for (int e = 0; e < 4; ++e) { kh_[e] = kk_[e] * ri_; kt_[e] = k_[e] * (1.0f + (a_[e] - 1.0f) * k_a[e]); b_[e] = a_[e] * kh_[e]; rk_ += r_[e] * kt_[e] * r_k[e]; } \
        rk_ = dpp_sum16(rk_); if (cq == 0) RK[((size_t)dir * M + row0 + t_) * 8 + h] = rk_; \
        LAS float* sb_ = st + ((chunk) & 1) * ST_BUF + tt * ST_STEP + cq * 4; \
        *(LAS f32x4*)(sb_) = kh_; *(LAS f32x4*)(sb_ + 64) = w_; *(LAS f32x4*)(sb_ + 128) = b_; *(LAS f32x4*)(sb_ + 192) = kt_; *(LAS f32x4*)(sb_ + 256) = r_; *(LAS f32x4*)(sb_ + 320) = v_; } while (0)
    SCAN_LOAD(0);
    SCAN_STAGE(0);
    __syncthreads();
    for (int chunk = 0; chunk < nch; ++chunk) {
        if (chunk + 1 < nch) SCAN_LOAD(chunk + 1);
        const LAS float* sb = st + (chunk & 1) * ST_BUF + ks * 8;
        const LAS float* vb = st + (chunk & 1) * ST_BUF + 320 + srow;
#pragma unroll 2
        for (int s = 0; s < TC; ++s) {
            const LAS float* q = sb + s * ST_STEP;
            const f32x4 kh0 = *(const LAS f32x4*)(q), kh1 = *(const LAS f32x4*)(q + 4);
            const f32x4 w0 = *(const LAS f32x4*)(q + 64), w1 = *(const LAS f32x4*)(q + 68);
            const f32x4 b0 = *(const LAS f32x4*)(q + 128), b1 = *(const LAS f32x4*)(q + 132);
            const f32x4 t0 = *(const LAS f32x4*)(q + 192), t1 = *(const LAS f32x4*)(q + 196);
            const f32x4 r0 = *(const LAS f32x4*)(q + 256), r1 = *(const LAS f32x4*)(q + 260);
            const float v = vb[s * ST_STEP];
            float sk = (S[0] * kh0[0] + S[1] * kh0[1]) + (S[2] * kh0[2] + S[3] * kh0[3]) + ((S[4] * kh1[0] + S[5] * kh1[1]) + (S[6] * kh1[2] + S[7] * kh1[3]));
            sk = dpp_sum8(sk);
#pragma unroll
            for (int e = 0; e < 4; ++e) { S[e] = S[e] * w0[e] + (v * t0[e] - sk * b0[e]); S[4 + e] = S[4 + e] * w1[e] + (v * t1[e] - sk * b1[e]); }
            float y = (S[0] * r0[0] + S[1] * r0[1]) + (S[2] * r0[2] + S[3] * r0[3]) + ((S[4] * r1[0] + S[5] * r1[1]) + (S[6] * r1[2] + S[7] * r1[3]));
            y = dpp_sum8(y);
            const int Sg = chunk * TC + s; const int t = dir ? T - 1 - Sg : Sg;
            if (ks == 0) Y[((size_t)dir * M + row0 + t) * CW + h * HD + srow] = (f16)y;
        }
        if (chunk + 1 < nch) SCAN_STAGE(chunk + 1);
        __syncthreads();
    }
#undef SCAN_LOAD
#undef SCAN_STAGE
    if (!smp) { GAS float* so = p.out + O_ST + (((((size_t)sq * NL + l) * 2 + dir) * NH + h) * HD + srow) * HD + ks * 8;
        *(GAS f32x4*)so = (f32x4){S[0], S[1], S[2], S[3]}; *(GAS f32x4*)(so + 4) = (f32x4){S[4], S[5], S[6], S[7]}; }
}
__device__ __forceinline__ void fast_scan(const Params& p0, const Ctx& c0, int l) {
    const Ctx c = fresh(c0); FRESH_P(p0);
    const int b = c.bid;
    if (b < 64) scan_task(p, c, l, b);
    else for (int task = b; task < 576; task += 192) scan_task(p, c, l, task);
}


namespace ms {
constexpr int O_AM = 0, O_BM = 4608, O_AT = 9216, O_VP = 14336, O_GT = 19456, O_NF = 22016, O_WM = 23040, O_WE = 23296, BUF = 23552;
constexpr int RS = 144, RT = 80;
}
__device__ __forceinline__ void mscan_task(const DParams& p, const Ctx& c, int l, int task) {
    using namespace ms;
    const GAS f16* PROJ = (const GAS f16*)(p.ws + WS_R1); const GAS f16* WA = (const GAS f16*)(p.ws + WS_R2);
    GAS f16* Y = (GAS f16*)(p.ws + WS_R3); GAS float* RK = (GAS float*)(p.ws + WS_RK);
    int sq, dir, h;
    if (task < 64) { h = task & 7; dir = (task >> 3) & 1; sq = B_CTX + (task >> 4); } else { const int id = task - 64; h = id & 7; dir = (id >> 3) & 1; sq = id >> 4; }
    const bool smp = sq >= B_CTX; const int T = smp ? T_SMP : T_CTX; const int row0 = smp ? M_CTX + (sq - B_CTX) * T_SMP : sq * T_CTX;
    const int nch = T / 16;
    const int vl = c.lane & 31, hh = c.lane >> 5;
    const int tq = c.tid - 128, ss = (tq >> 4) & 15, cq = tq & 15, k0 = cq * 4, ch0 = h * HD + k0;
    LAS float* cst = (LAS float*)(c.lds + 3 * BUF);
    if (c.wave == 7) { const int chn_ = h * HD + c.lane;
        cst[c.lane] = IN(15)[(l * 3 + 0) * CW + chn_]; cst[64 + c.lane] = IN(15)[(l * 3 + 1) * CW + chn_]; cst[128 + c.lane] = IN(15)[(l * 3 + 2) * CW + chn_];
        cst[192 + c.lane] = IN(16)[l * CW + chn_]; cst[256 + c.lane] = IN(17)[l * CW + chn_]; cst[320 + c.lane] = IN(18)[l * CW + chn_]; }

#define MS_BARRIER() do { asm volatile("s_waitcnt lgkmcnt(0)" ::: "memory"); __builtin_amdgcn_s_barrier(); asm volatile("" ::: "memory"); } while (0)
    if (c.wave >= 2 && c.wave < 6) {
    f16x4 G_rc, G_kc, G_vc, G_rp, G_kp, G_vp, G_rn, G_kn, G_vn, G_av, G_wo, G_wp, G_w7;
    { const f16x4 z4 = {(f16)0.f, (f16)0.f, (f16)0.f, (f16)0.f}; G_rc = G_kc = G_vc = G_rp = G_kp = G_vp = G_rn = G_kn = G_vn = G_av = G_wo = G_wp = G_w7 = z4; }
        for (int it = -3; it < nch; ++it) {
            const int ch = it + 2;
            if (ch >= 0 && ch < nch) {
                LAS unsigned char* buf = c.lds + (ch % 3) * BUF;
                const int Sg = ch * 16 + ss; const int t = dir ? T - 1 - Sg : Sg; const size_t row = (size_t)row0 + t;
                const f32x4 mu_r = *(const LAS f32x4*)(cst + k0), mu_k = *(const LAS f32x4*)(cst + 64 + k0), mu_v = *(const LAS f32x4*)(cst + 128 + k0), k_k = *(const LAS f32x4*)(cst + 192 + k0), k_a = *(const LAS f32x4*)(cst + 256 + k0), r_k = *(const LAS f32x4*)(cst + 320 + k0);
                f32x4 r_, k_, v_, kk_, kh_, kt_, b_; float sq_ = 0.f, rk_ = 0.f;
#pragma unroll
                for (int e = 0; e < 4; ++e) { const float rcf = (float)G_rc[e], kcf = (float)G_kc[e], vcf = (float)G_vc[e];
                    r_[e] = rcf + mu_r[e] * (0.5f * ((float)G_rp[e] + (float)G_rn[e]) - rcf); k_[e] = kcf + mu_k[e] * (0.5f * ((float)G_kp[e] + (float)G_kn[e]) - kcf);
                    v_[e] = vcf + mu_v[e] * (0.5f * ((float)G_vp[e] + (float)G_vn[e]) - vcf); kk_[e] = k_[e] * k_k[e]; sq_ += kk_[e] * kk_[e]; }
                sq_ = dpp_sum16(sq_); const float ri_ = rsqrtf(sq_ + 1e-12f);
#pragma unroll
                for (int e = 0; e < 4; ++e) { const float a_ = (float)G_av[e]; kh_[e] = kk_[e] * ri_; kt_[e] = k_[e] * (1.0f + (a_ - 1.0f) * k_a[e]); b_[e] = a_ * kh_[e]; rk_ += r_[e] * kt_[e] * r_k[e]; }
                rk_ = dpp_sum16(rk_); if (cq == 0) RK[((size_t)dir * M + row) * 8 + h] = rk_;
                float al[4], be[4], ka[4], rho[4];
#pragma unroll
                for (int e = 0; e < 4; ++e) { const float wm7 = (float)G_w7[e]; const float om = ss == 7 ? 1.0f : (float)G_wo[e]; const float omp = ss == 0 ? 1.0f / wm7 : (ss == 8 ? 1.0f : (float)G_wp[e]);
                    const float iom = 1.0f / om; al[e] = omp * kh_[e]; be[e] = b_[e] * iom; ka[e] = kt_[e] * iom; rho[e] = om * r_[e]; }
                v2u w2;
                w2.x = pkh(al[0], al[1]); w2.y = pkh(al[2], al[3]); *(LAS v2u*)(buf + O_BM + ss * RS + k0 * 2) = w2;
                w2.x = pkh(rho[0], rho[1]); w2.y = pkh(rho[2], rho[3]); *(LAS v2u*)(buf + O_BM + (16 + ss) * RS + k0 * 2) = w2;
                w2.x = pkh(be[0], be[1]); w2.y = pkh(be[2], be[3]); *(LAS v2u*)(buf + O_AM + ss * RS + k0 * 2) = w2;
                w2.x = pkh(ka[0], ka[1]); w2.y = pkh(ka[2], ka[3]); *(LAS v2u*)(buf + O_AM + (16 + ss) * RS + k0 * 2) = w2;
#pragma unroll
                for (int e = 0; e < 4; ++e) { *(LAS f16*)(buf + O_AT + (k0 + e) * RT + ss * 2) = (f16)ka[e]; *(LAS f16*)(buf + O_AT + (k0 + e) * RT + (16 + ss) * 2) = (f16)be[e];
                    *(LAS f16*)(buf + O_VP + (k0 + e) * RT + ss * 2) = (f16)v_[e]; }
                if (ss == 15) { f32x4 wm_, we_;
#pragma unroll
                    for (int e = 0; e < 4; ++e) { wm_[e] = (float)G_w7[e]; we_[e] = (float)G_wo[e]; }
                    *(LAS f32x4*)(buf + O_WM + k0 * 4) = wm_; *(LAS f32x4*)(buf + O_WE + k0 * 4) = we_; }
            }
            const int chn = it + 3;
            if (chn < nch) {
                const int Sg = chn * 16 + ss; const int t = dir ? T - 1 - Sg : Sg; const size_t row = (size_t)row0 + t;
                const GAS f16* pr = PROJ + row * DIN + ch0;
                const f16x4 z4 = {(f16)0.f, (f16)0.f, (f16)0.f, (f16)0.f};
                G_rc = *(const GAS f16x4*)(pr + PC_R); G_kc = *(const GAS f16x4*)(pr + PC_K); G_vc = *(const GAS f16x4*)(pr + PC_V);
                G_rp = z4; G_kp = z4; G_vp = z4; G_rn = z4; G_kn = z4; G_vn = z4;
                if (t > 0) { G_rp = *(const GAS f16x4*)(pr - DIN + PC_R); G_kp = *(const GAS f16x4*)(pr - DIN + PC_K); G_vp = *(const GAS f16x4*)(pr - DIN + PC_V); }
                if (t < T - 1) { G_rn = *(const GAS f16x4*)(pr + DIN + PC_R); G_kn = *(const GAS f16x4*)(pr + DIN + PC_K); G_vn = *(const GAS f16x4*)(pr + DIN + PC_V); }
                G_av = *(const GAS f16x4*)(WA + row * 2048 + 1024 + dir * 512 + ch0);
                const GAS f16* wo = WA + row * 2048 + dir * 512 + ch0;
                G_wo = *(const GAS f16x4*)wo; G_wp = *(const GAS f16x4*)(wo + (ss > 0 ? (dir ? 2048 : -2048) : 0)); G_w7 = *(const GAS f16x4*)(wo + (long)(7 - ss) * (dir ? -2048 : 2048));
            }
            MS_BARRIER();
        }
    } else if (c.wave == 6) {
        for (int it = -3; it < nch; ++it) {
            const int ch = it + 1;
            if (ch >= 0 && ch < nch) {
                LAS unsigned char* buf = c.lds + (ch % 3) * BUF;
                f32x16 g;
#pragma unroll
                for (int i = 0; i < 16; ++i) g[i] = 0.f;
#pragma unroll
                for (int s = 0; s < 4; ++s) { const f16x8 a = *(const LAS f16x8*)(buf + O_AM + vl * RS + (16 * s + 8 * hh) * 2), b = *(const LAS f16x8*)(buf + O_BM + vl * RS + (16 * s + 8 * hh) * 2);
                    g = __builtin_amdgcn_mfma_f32_32x32x16_f16(a, b, g, 0, 0, 0); }
                const int tcol = vl & 15; const bool incl = vl >= 16;
#pragma unroll
                for (int gq = 0; gq < 4; ++gq) { float o[4];
#pragma unroll
                    for (int e = 0; e < 4; ++e) { const int ip = 8 * gq + 4 * hh + e, i = ip & 15; const bool ok = incl ? (i <= tcol) : (i < tcol); o[e] = ok ? g[4 * gq + e] : 0.f; }
                    v2u w2; w2.x = pkh(o[0], o[1]); w2.y = pkh(o[2], o[3]);
                    *(LAS v2u*)(buf + O_GT + vl * RT + (8 * gq + 4 * hh) * 2) = w2;
                    if (gq < 2 && vl < 16) *(LAS f32x4*)(buf + O_NF + vl * 64 + (8 * gq + 4 * hh) * 4) = (f32x4){o[0], o[1], o[2], o[3]}; }
            }
            MS_BARRIER();
        }
    } else if (c.wave == 7) {
        for (int it = -3; it < nch; ++it) MS_BARRIER();
    } else {
    f32x16 St0, St1;
#pragma unroll
    for (int i = 0; i < 16; ++i) { St0[i] = 0.f; St1[i] = 0.f; }
    if (smp) { float one_ = 1.0f; asm volatile("" : "+v"(one_));
        const GAS float* s0 = IN(4) + (((((size_t)(sq - B_CTX) * NL + l) * 2 + dir) * NH + h) * HD + 32 * c.wave + vl) * HD + 4 * hh;
#pragma unroll
        for (int g = 0; g < 4; ++g) { const f32x4 a = *(const GAS f32x4*)(s0 + 8 * g), b = *(const GAS f32x4*)(s0 + 32 + 8 * g);
#pragma unroll
            for (int e = 0; e < 4; ++e) { St0[4 * g + e] = a[e] * one_; St1[4 * g + e] = b[e] * one_; } }
    }
        for (int it = -3; it < nch; ++it) {
            const int ch = it;
            if (ch >= 0) {
                LAS unsigned char* buf = c.lds + (ch % 3) * BUF;
                const int v = 32 * c.wave + vl;
#pragma unroll
                for (int gq = 0; gq < 4; ++gq) { const f32x4 m0 = *(const LAS f32x4*)(buf + O_WM + (8 * gq + 4 * hh) * 4), m1 = *(const LAS f32x4*)(buf + O_WM + (32 + 8 * gq + 4 * hh) * 4);
#pragma unroll
                    for (int e = 0; e < 4; ++e) { St0[4 * gq + e] *= m0[e]; St1[4 * gq + e] *= m1[e]; } }
                f32x16 X;
#pragma unroll
                for (int i = 0; i < 16; ++i) X[i] = 0.f;
#pragma unroll
                for (int s = 0; s < 4; ++s) {
                    f16x8 sb;
#pragma unroll
                    for (int j = 0; j < 8; ++j) sb[j] = (f16)((s < 2) ? St0[8 * (s & 1) + j] : St1[8 * (s & 1) + j]);
                    const f16x4 lo = *(const LAS f16x4*)(buf + O_BM + vl * RS + (16 * s + 4 * hh) * 2), hi = *(const LAS f16x4*)(buf + O_BM + vl * RS + (16 * s + 8 + 4 * hh) * 2);
                    const f16x8 af = {lo[0], lo[1], lo[2], lo[3], hi[0], hi[1], hi[2], hi[3]};
                    X = __builtin_amdgcn_mfma_f32_32x32x16_f16(af, sb, X, 0, 0, 0);
                }
                { const f16x8 a = *(const LAS f16x8*)(buf + O_GT + vl * RT + (16 + 8 * hh) * 2), b = *(const LAS f16x8*)(buf + O_VP + v * RT + (8 * hh) * 2);
                  X = __builtin_amdgcn_mfma_f32_32x32x16_f16(a, b, X, 0, 0, 0); }
                const f16x8 aN = *(const LAS f16x8*)(buf + O_GT + vl * RT + (8 * hh) * 2);
                f16x8 pball;
#pragma unroll
                for (int j = 0; j < 8; ++j) pball[j] = (f16)0.f;
#define MS_BLK(a) do { const int xo_ = 4 * ((a) >> 1); \
                    const f32x4 n1_ = *(const LAS f32x4*)(buf + O_NF + (4 * (a) + 1) * 64 + 16 * (a)), n2_ = *(const LAS f32x4*)(buf + O_NF + (4 * (a) + 2) * 64 + 16 * (a)), n3_ = *(const LAS f32x4*)(buf + O_NF + (4 * (a) + 3) * 64 + 16 * (a)); \
                    float q0_ = X[xo_]; float q1_ = X[xo_ + 1] - q0_ * n1_[0]; float q2_ = X[xo_ + 2] - q0_ * n2_[0] - q1_ * n2_[1]; float q3_ = X[xo_ + 3] - q0_ * n3_[0] - q1_ * n3_[1] - q2_ * n3_[2]; \
                    if (((a) & 1) != ((a) >> 1)) { float a_, b_; \
                        a_ = q0_; b_ = q0_; swap32(a_, b_); q0_ = ((a) & 1) ? b_ : a_; a_ = q1_; b_ = q1_; swap32(a_, b_); q1_ = ((a) & 1) ? b_ : a_; \
                        a_ = q2_; b_ = q2_; swap32(a_, b_); q2_ = ((a) & 1) ? b_ : a_; a_ = q3_; b_ = q3_; swap32(a_, b_); q3_ = ((a) & 1) ? b_ : a_; } \
                    const bool hold_ = hh == ((a) >> 1); \
                    const f16 z_ = (f16)0.f; const f16 e0_ = hold_ ? (f16)(-q0_) : z_, e1_ = hold_ ? (f16)(-q1_) : z_, e2_ = hold_ ? (f16)(-q2_) : z_, e3_ = hold_ ? (f16)(-q3_) : z_; \
                    f16x8 pb_ = {z_, z_, z_, z_, z_, z_, z_, z_}; \
                    pb_[4 * ((a) & 1)] = e0_; pb_[4 * ((a) & 1) + 1] = e1_; pb_[4 * ((a) & 1) + 2] = e2_; pb_[4 * ((a) & 1) + 3] = e3_; \
                    if (hold_) { pball[4 * ((a) & 1)] = e0_; pball[4 * ((a) & 1) + 1] = e1_; pball[4 * ((a) & 1) + 2] = e2_; pball[4 * ((a) & 1) + 3] = e3_; } \
                    X = __builtin_amdgcn_mfma_f32_32x32x16_f16(aN, pb_, X, 0, 0, 0); } while (0)
                MS_BLK(0); MS_BLK(1); MS_BLK(2); MS_BLK(3);
#undef MS_BLK
#pragma unroll
                for (int r = 8; r < 16; ++r) { const int t = (r & 3) + 8 * ((r >> 2) - 2) + 4 * hh; const int Sg = ch * 16 + t; const int tok = dir ? T - 1 - Sg : Sg;
                    Y[((size_t)dir * M + row0 + tok) * CW + h * HD + v] = (f16)X[r]; }
#pragma unroll
                for (int s2 = 0; s2 < 2; ++s2) { const f16x8 b = s2 == 0 ? *(const LAS f16x8*)(buf + O_VP + v * RT + (8 * hh) * 2) : pball;
                    const f16x8 a0 = *(const LAS f16x8*)(buf + O_AT + vl * RT + (16 * s2 + 8 * hh) * 2), a1 = *(const LAS f16x8*)(buf + O_AT + (32 + vl) * RT + (16 * s2 + 8 * hh) * 2);
                    St0 = __builtin_amdgcn_mfma_f32_32x32x16_f16(a0, b, St0, 0, 0, 0); St1 = __builtin_amdgcn_mfma_f32_32x32x16_f16(a1, b, St1, 0, 0, 0); }
#pragma unroll
                for (int gq = 0; gq < 4; ++gq) { const f32x4 m0 = *(const LAS f32x4*)(buf + O_WE + (8 * gq + 4 * hh) * 4), m1 = *(const LAS f32x4*)(buf + O_WE + (32 + 8 * gq + 4 * hh) * 4);
#pragma unroll
                    for (int e = 0; e < 4; ++e) { St0[4 * gq + e] *= m0[e]; St1[4 * gq + e] *= m1[e]; } }
            }
            MS_BARRIER();
        }
    if (!smp) {
        GAS float* so = p.out + O_ST + (((((size_t)sq * NL + l) * 2 + dir) * NH + h) * HD + 32 * c.wave + vl) * HD + 4 * hh;
#pragma unroll
        for (int g = 0; g < 4; ++g) { *(GAS f32x4*)(so + 8 * g) = (f32x4){St0[4 * g], St0[4 * g + 1], St0[4 * g + 2], St0[4 * g + 3]};
            *(GAS f32x4*)(so + 32 + 8 * g) = (f32x4){St1[4 * g], St1[4 * g + 1], St1[4 * g + 2], St1[4 * g + 3]}; }
    }
    }
#undef MS_BARRIER
}
__device__ __forceinline__ void mfma_scan(const Params& p0, const Ctx& c0, int l) {
    const Ctx c = fresh(c0); FRESH_P(p0);
    const int b = c.bid;
    const int step = b < 64 ? 576 : 192;
#pragma nounroll
    for (int task = b; task < 576; task += step) mscan_task(p, c, l, task);
}

__device__ __forceinline__ int swap23(int r) { return (r & ~12) | ((r & 4) << 1) | ((r & 8) >> 1); }
__device__ __forceinline__ void attn_wave_task(const DParams& p, const Ctx& c, int l, int task) {
    const GAS f16* PROJ = (const GAS f16*)(p.ws + WS_R1); const GAS f16* KN = (const GAS f16*)(p.ws + WS_KN); const GAS f16* VT = (const GAS f16*)(p.ws + WS_VT);
    GAS f16* OA = (GAS f16*)(p.ws + WS_R4);
    const int hq = task & 7, qb = task >> 3, kvh = hq >> 2;
    const int r32 = c.lane & 31, hh = c.lane >> 5;
    int rowq0, L; const GAS f16* Kb; const GAS f16* Vb; bool smp;
    if (qb < 128) { smp = true; rowq0 = M_CTX + qb * 32; const int b = qb >> 5; L = KV_SMP;
        Kb = KN + KN_SMP_OFF + ((size_t)b * 2 + kvh) * KV_SMP * HD; Vb = VT + KN_SMP_OFF + ((size_t)b * 2 + kvh) * HD * KV_SMP; }
    else { smp = false; rowq0 = (qb - 128) * 32; const int b = rowq0 >> 8; L = T_CTX;
        Kb = KN + ((size_t)b * 2 + kvh) * T_CTX * HD; Vb = VT + ((size_t)b * 2 + kvh) * HD * T_CTX; }
    const int row = rowq0 + r32;
    float x[4][8]; float ss = 0.f;
#pragma unroll
    for (int s = 0; s < 4; ++s) { const f16x8 q = *(const GAS f16x8*)(PROJ + (size_t)row * DIN + PC_Q + hq * HD + 16 * s + 8 * hh);
#pragma unroll
        for (int j = 0; j < 8; ++j) { x[s][j] = (float)q[j]; ss += x[s][j] * x[s][j]; } }
    ss = half_sum(ss);
    const float rstd = rsqrtf(ss * (1.0f / HD) + 1e-6f);
#pragma unroll
    for (int s = 0; s < 4; ++s)
#pragma unroll
        for (int j = 0; j < 8; ++j) x[s][j] *= rstd * IN(26)[l * HD + 16 * s + 8 * hh + j];
    if (smp) { const int t = (row - M_CTX) & (T_SMP - 1); const float posr = (float)(t >> 6), posc = (float)(t & 63);
#pragma unroll
        for (int j = 0; j < 8; ++j) { const float freq = exp2f(-(float)(8 * hh + j) * (13.287712379549449f / 16.0f));
            const float ar = posr * freq, ac = posc * freq; const float cr = __cosf(ar), sr = __sinf(ar), cc = __cosf(ac), sc = __sinf(ac);
            const float a0 = x[0][j], a1 = x[1][j], b0 = x[2][j], b1 = x[3][j];
            x[0][j] = a0 * cr - a1 * sr; x[1][j] = a1 * cr + a0 * sr; x[2][j] = b0 * cc - b1 * sc; x[3][j] = b1 * cc + b0 * sc; } }
    f16x8 qf[4];
#pragma unroll
    for (int s = 0; s < 4; ++s)
#pragma unroll
        for (int j = 0; j < 8; ++j) qf[s][j] = (f16)(x[s][j] * (0.125f * 1.4426950408889634f));
    f32x16 o0, o1;
#pragma unroll
    for (int i = 0; i < 16; ++i) { o0[i] = 0.f; o1[i] = 0.f; }
    float mrun = -1e30f, lsum = 0.f;
    const GAS f16* kp = Kb + (size_t)swap23(r32) * HD + 8 * hh;
    const GAS f16* vp = Vb + (size_t)r32 * L + 8 * hh;
    const int ntile = L >> 5;
    f16x8 kf[4], vf[4];
#pragma unroll
    for (int s = 0; s < 4; ++s) kf[s] = *(const GAS f16x8*)(kp + 16 * s);
    vf[0] = *(const GAS f16x8*)(vp); vf[1] = *(const GAS f16x8*)(vp + 16); vf[2] = *(const GAS f16x8*)(vp + (size_t)32 * L); vf[3] = *(const GAS f16x8*)(vp + (size_t)32 * L + 16);
    for (int kt = 0; kt < ntile; ++kt) {
        f16x8 kn[4], vn[4];
        const int ktn = kt + 1 < ntile ? kt + 1 : kt;
#pragma unroll
        for (int s = 0; s < 4; ++s) kn[s] = *(const GAS f16x8*)(kp + (size_t)ktn * 32 * HD + 16 * s);
        vn[0] = *(const GAS f16x8*)(vp + ktn * 32); vn[1] = *(const GAS f16x8*)(vp + ktn * 32 + 16); vn[2] = *(const GAS f16x8*)(vp + (size_t)32 * L + ktn * 32); vn[3] = *(const GAS f16x8*)(vp + (size_t)32 * L + ktn * 32 + 16);
        f32x16 sa;
#pragma unroll
        for (int i = 0; i < 16; ++i) sa[i] = 0.f;
#pragma unroll
        for (int s = 0; s < 4; ++s) sa = __builtin_amdgcn_mfma_f32_32x32x16_f16(kf[s], qf[s], sa, 0, 0, 0);
        float mt = sa[0];
#pragma unroll
        for (int i = 1; i < 16; ++i) mt = fmaxf(mt, sa[i]);
        mt = half_max(mt);
        const float mn = fmaxf(mrun, mt); const float alpha = exp2f(mrun - mn); mrun = mn;
        float ps = 0.f;
#pragma unroll
        for (int i = 0; i < 16; ++i) { sa[i] = exp2f(sa[i] - mn); ps += sa[i]; }
        lsum = lsum * alpha + ps;
#pragma unroll
        for (int i = 0; i < 16; ++i) { o0[i] *= alpha; o1[i] *= alpha; }
        f16x8 pb0, pb1;
#pragma unroll
        for (int j = 0; j < 8; ++j) { pb0[j] = (f16)sa[j]; pb1[j] = (f16)sa[8 + j]; }
        o0 = __builtin_amdgcn_mfma_f32_32x32x16_f16(vf[0], pb0, o0, 0, 0, 0);
        o0 = __builtin_amdgcn_mfma_f32_32x32x16_f16(vf[1], pb1, o0, 0, 0, 0);
        o1 = __builtin_amdgcn_mfma_f32_32x32x16_f16(vf[2], pb0, o1, 0, 0, 0);
        o1 = __builtin_amdgcn_mfma_f32_32x32x16_f16(vf[3], pb1, o1, 0, 0, 0);
#pragma unroll
        for (int s = 0; s < 4; ++s) { kf[s] = kn[s]; vf[s] = vn[s]; }
    }
    lsum = half_sum(lsum);
    const float inv = 1.0f / lsum;
    GAS f16* op = OA + (size_t)row * D + CW + hq * HD + 4 * hh;
#pragma unroll
    for (int g = 0; g < 4; ++g) {
        v2u w0; w0.x = pkh(o0[4 * g] * inv, o0[4 * g + 1] * inv); w0.y = pkh(o0[4 * g + 2] * inv, o0[4 * g + 3] * inv);
        v2u w1; w1.x = pkh(o1[4 * g] * inv, o1[4 * g + 1] * inv); w1.y = pkh(o1[4 * g + 2] * inv, o1[4 * g + 3] * inv);
        *(GAS v2u*)(op + 8 * g) = w0; *(GAS v2u*)(op + 32 + 8 * g) = w1; }
}
constexpr int AT_KS = 144, AT_BUF = 2 * 64 * AT_KS;
__device__ __forceinline__ void attn_block_task(const DParams& p, const Ctx& c, int l, int item) {
    const GAS f16* PROJ = (const GAS f16*)(p.ws + WS_R1); const GAS f16* KN = (const GAS f16*)(p.ws + WS_KN); const GAS f16* VT = (const GAS f16*)(p.ws + WS_VT);
    GAS f16* OA = (GAS f16*)(p.ws + WS_R4);
    int rowq0, L, kvh; const GAS f16* Kb; const GAS f16* Vb; bool smp;
    if (item < 128) { smp = true; const int b = item >> 5; kvh = (item >> 4) & 1; rowq0 = M_CTX + b * T_SMP + (item & 15) * 64; L = KV_SMP;
        Kb = KN + KN_SMP_OFF + ((size_t)b * 2 + kvh) * KV_SMP * HD; Vb = VT + KN_SMP_OFF + ((size_t)b * 2 + kvh) * HD * KV_SMP; }
    else { smp = false; const int id = item - 128; const int b = id >> 3; kvh = (id >> 2) & 1; rowq0 = b * T_CTX + (id & 3) * 64; L = T_CTX;
        Kb = KN + ((size_t)b * 2 + kvh) * T_CTX * HD; Vb = VT + ((size_t)b * 2 + kvh) * HD * T_CTX; }
    const int hq = kvh * 4 + (c.wave & 3);
    const int r32 = c.lane & 31, hh = c.lane >> 5;
    const int row = rowq0 + 32 * (c.wave >> 2) + r32;
    const int kk = c.tid >> 3, chk = c.tid & 7;
    const GAS f16* ksrc = Kb + (size_t)kk * HD + chk * 8;
    const GAS f16* vsrc = Vb + (size_t)kk * L + chk * 8;
    const int sdst = kk * AT_KS + chk * 16;
    v4u kreg = *(const GAS v4u*)ksrc, vreg = *(const GAS v4u*)vsrc;
    float x[4][8]; float ss = 0.f;
#pragma unroll
    for (int s = 0; s < 4; ++s) { const f16x8 q = *(const GAS f16x8*)(PROJ + (size_t)row * DIN + PC_Q + hq * HD + 16 * s + 8 * hh);
#pragma unroll
        for (int j = 0; j < 8; ++j) { x[s][j] = (float)q[j]; ss += x[s][j] * x[s][j]; } }
    ss = half_sum(ss);
    const float rstd = rsqrtf(ss * (1.0f / HD) + 1e-6f);
#pragma unroll
    for (int s = 0; s < 4; ++s)
#pragma unroll
        for (int j = 0; j < 8; ++j) x[s][j] *= rstd * IN(26)[l * HD + 16 * s + 8 * hh + j];
    if (smp) { const int t = (row - M_CTX) & (T_SMP - 1); const float posr = (float)(t >> 6), posc = (float)(t & 63);
#pragma unroll
        for (int j = 0; j < 8; ++j) { const float freq = exp2f(-(float)(8 * hh + j) * (13.287712379549449f / 16.0f));
            const float ar = posr * freq, ac = posc * freq; const float cr = __cosf(ar), sr = __sinf(ar), cc = __cosf(ac), sc = __sinf(ac);
            const float a0 = x[0][j], a1 = x[1][j], b0 = x[2][j], b1 = x[3][j];
            x[0][j] = a0 * cr - a1 * sr; x[1][j] = a1 * cr + a0 * sr; x[2][j] = b0 * cc - b1 * sc; x[3][j] = b1 * cc + b0 * sc; } }
    f16x8 qf[4];
#pragma unroll
    for (int s = 0; s < 4; ++s)
#pragma unroll
        for (int j = 0; j < 8; ++j) qf[s][j] = (f16)(x[s][j] * (0.125f * 1.4426950408889634f));
    f32x16 o0, o1;
#pragma unroll
    for (int i = 0; i < 16; ++i) { o0[i] = 0.f; o1[i] = 0.f; }
    float mrun = -1e30f, lsum = 0.f;
    const int nstep = L >> 6;
    *(LAS v4u*)(c.lds + sdst) = kreg; *(LAS v4u*)(c.lds + 64 * AT_KS + sdst) = vreg;
    asm volatile("s_waitcnt lgkmcnt(0)" ::: "memory"); __builtin_amdgcn_s_barrier(); asm volatile("" ::: "memory");
    const int koff = swap23(r32) * AT_KS + 16 * hh, voff = 64 * AT_KS + r32 * AT_KS + 16 * hh;
    for (int st = 0; st < nstep; ++st) {
        if (st + 1 < nstep) { kreg = *(const GAS v4u*)(ksrc + (size_t)(st + 1) * 64 * HD); vreg = *(const GAS v4u*)(vsrc + (st + 1) * 64); }
        LAS unsigned char* sb = c.lds + (st & 1) * AT_BUF;
        f32x16 sa0, sa1;
#pragma unroll
        for (int i = 0; i < 16; ++i) { sa0[i] = 0.f; sa1[i] = 0.f; }
#pragma unroll
        for (int s = 0; s < 4; ++s) { const f16x8 k0 = *(const LAS f16x8*)(sb + koff + 32 * s), k1 = *(const LAS f16x8*)(sb + koff + 32 * AT_KS + 32 * s);
            sa0 = __builtin_amdgcn_mfma_f32_32x32x16_f16(k0, qf[s], sa0, 0, 0, 0); sa1 = __builtin_amdgcn_mfma_f32_32x32x16_f16(k1, qf[s], sa1, 0, 0, 0); }
        float mt = fmaxf(sa0[0], sa1[0]);
#pragma unroll
        for (int i = 1; i < 16; ++i) mt = fmaxf(mt, fmaxf(sa0[i], sa1[i]));
        mt = half_max(mt);
        const float mn = fmaxf(mrun, mt); const float alpha = exp2f(mrun - mn); mrun = mn;
        float ps = 0.f;
#pragma unroll
        for (int i = 0; i < 16; ++i) { sa0[i] = exp2f(sa0[i] - mn); sa1[i] = exp2f(sa1[i] - mn); ps += sa0[i] + sa1[i]; }
        lsum = lsum * alpha + ps;
#pragma unroll
        for (int i = 0; i < 16; ++i) { o0[i] *= alpha; o1[i] *= alpha; }
        f16x8 pb[4];
#pragma unroll
        for (int j = 0; j < 8; ++j) { pb[0][j] = (f16)sa0[j]; pb[1][j] = (f16)sa0[8 + j]; pb[2][j] = (f16)sa1[j]; pb[3][j] = (f16)sa1[8 + j]; }
#pragma unroll
        for (int q4 = 0; q4 < 4; ++q4) {
            const f16x8 v0 = *(const LAS f16x8*)(sb + voff + 32 * q4), v1 = *(const LAS f16x8*)(sb + voff + 32 * AT_KS + 32 * q4);
            o0 = __builtin_amdgcn_mfma_f32_32x32x16_f16(v0, pb[q4], o0, 0, 0, 0); o1 = __builtin_amdgcn_mfma_f32_32x32x16_f16(v1, pb[q4], o1, 0, 0, 0); }
        if (st + 1 < nstep) { LAS unsigned char* nb = c.lds + ((st + 1) & 1) * AT_BUF; *(LAS v4u*)(nb + sdst) = kreg; *(LAS v4u*)(nb + 64 * AT_KS + sdst) = vreg; }
        asm volatile("s_waitcnt lgkmcnt(0)" ::: "memory"); __builtin_amdgcn_s_barrier(); asm volatile("" ::: "memory");
    }
    lsum = half_sum(lsum);
    const float inv = 1.0f / lsum;
    GAS f16* op = OA + (size_t)row * D + CW + hq * HD + 4 * hh;
#pragma unroll
    for (int g = 0; g < 4; ++g) {
        v2u w0; w0.x = pkh(o0[4 * g] * inv, o0[4 * g + 1] * inv); w0.y = pkh(o0[4 * g + 2] * inv, o0[4 * g + 3] * inv);
        v2u w1; w1.x = pkh(o1[4 * g] * inv, o1[4 * g + 1] * inv); w1.y = pkh(o1[4 * g + 2] * inv, o1[4 * g + 3] * inv);
        *(GAS v2u*)(op + 8 * g) = w0; *(GAS v2u*)(op + 32 + 8 * g) = w1; }
}
__device__ __forceinline__ void fast_attn(const Params& p0, const Ctx& c0, int l) {
    const Ctx c = fresh(c0); FRESH_P(p0);
    unsigned* ctr = (unsigned*)(p0.ws + WS_CTL) + 8192 + 64 * l;
    volatile LAS unsigned* slot = (volatile LAS unsigned*)(c.lds + MISC_OFF) + 16;
    for (;;) {
        if (c.tid == 0) slot[0] = __hip_atomic_fetch_add(ctr, 1u, __ATOMIC_RELAXED, __HIP_MEMORY_SCOPE_AGENT);
        __syncthreads();
        const int item = (int)slot[0];
        __syncthreads();
        if (item >= 384) break;
        attn_block_task(p, c, l, item);
    }
}

__device__ __forceinline__ void post_phase(const Params& p0, const Ctx& c0, int l) {
    const Ctx c = fresh(c0); FRESH_P(p0);
    const GAS f16* PROJ = (const GAS f16*)(p.ws + WS_R1); const GAS f16* Y = (const GAS f16*)(p.ws + WS_R3); const GAS float* RK = (const GAS float*)(p.ws + WS_RK);
    GAS f16* OA = (GAS f16*)(p.ws + WS_R4);
    const int ch0 = c.lane * 8, h = c.lane >> 3;
    float gnw[8], gnb[8], muv[8];
    { const f32x4 a0 = *(const GAS f32x4*)(IN(24) + l * CW + ch0), a1 = *(const GAS f32x4*)(IN(24) + l * CW + ch0 + 4), b0 = *(const GAS f32x4*)(IN(25) + l * CW + ch0), b1 = *(const GAS f32x4*)(IN(25) + l * CW + ch0 + 4);
      const f32x4 m0 = *(const GAS f32x4*)(IN(15) + (l * 3 + 2) * CW + ch0), m1 = *(const GAS f32x4*)(IN(15) + (l * 3 + 2) * CW + ch0 + 4);
#pragma unroll
      for (int e = 0; e < 4; ++e) { gnw[e] = a0[e]; gnw[4 + e] = a1[e]; gnb[e] = b0[e]; gnb[4 + e] = b1[e]; muv[e] = m0[e]; muv[4 + e] = m1[e]; } }
    for (int row = c.gw; row < M; row += c.ngw) {
        int g, t, T; row_info(row, g, t, T);
        const GAS f16* pr = PROJ + (size_t)row * DIN + PC_V + ch0;
        const f16x8 y0 = *(const GAS f16x8*)(Y + (size_t)row * CW + ch0), y1 = *(const GAS f16x8*)(Y + ((size_t)M + row) * CW + ch0);
        const f16x8 vc = *(const GAS f16x8*)pr; const f16x8 gv = *(const GAS f16x8*)(OA + (size_t)row * D + ch0);
        f16x8 vp, vn;
#pragma unroll
        for (int e = 0; e < 8; ++e) { vp[e] = (f16)0.f; vn[e] = (f16)0.f; }
        if (t > 0) vp = *(const GAS f16x8*)(pr - DIN);
        if (t < T - 1) vn = *(const GAS f16x8*)(pr + DIN);
        const float rk = RK[(size_t)row * 8 + h] + RK[((size_t)M + row) * 8 + h];
        float y[8]; float s = 0.f;
#pragma unroll
        for (int e = 0; e < 8; ++e) { y[e] = (float)y0[e] + (float)y1[e]; s += y[e]; }
        const float mean = dpp_sum8(s) * (1.0f / HD); float q = 0.f;
#pragma unroll
        for (int e = 0; e < 8; ++e) { y[e] -= mean; q += y[e] * y[e]; }
        const float rstd = rsqrtf(dpp_sum8(q) * (1.0f / HD) + 64e-5f);
        float o[8];
#pragma unroll
        for (int e = 0; e < 8; ++e) { const float vcf = (float)vc[e]; const float v = vcf + muv[e] * (0.5f * ((float)vp[e] + (float)vn[e]) - vcf);
            o[e] = (y[e] * rstd * gnw[e] + gnb[e] + rk * v) * (float)gv[e]; }
        v4u w; w.x = pkh(o[0], o[1]); w.y = pkh(o[2], o[3]); w.z = pkh(o[4], o[5]); w.w = pkh(o[6], o[7]);
        *(GAS v4u*)(OA + (size_t)row * D + ch0) = w;
    }
}

__device__ __forceinline__ void gemm_proj(const Params& p0, const Ctx& c0) { const Ctx c = fresh(c0); FRESH_P(p0);
    pg8::Gemm g{(const GAS f16*)(p.ws + WS_R4), (const GAS f16*)(p.ws + WS_W + WO_IN), D, D, D}; pg8::StaticOrder S; S.init(M, DIN, (int)gridDim.x, c.bid);
    pg8::gemm_phase(c.lds, g, S, pg8::EpiProjF{(GAS f16*)(p.ws + WS_R1)}, c.wave); }
__device__ __forceinline__ void gemm_wa(const Params& p0, const Ctx& c0, int l) { const Ctx c = fresh(c0); FRESH_P(p0);
    pg8::Gemm g{(const GAS f16*)(p.ws + WS_R1) + PC_LW, (const GAS f16*)(p.ws + WS_W + WO_SM), DIN, 128, 128}; pg8::StaticOrder S; S.init(M, 2048, (int)gridDim.x, c.bid);
    pg8::gemm_phase(c.lds, g, S, pg8::EpiWAF{(GAS f16*)(p.ws + WS_R2), IN(19) + (size_t)l * 2 * CW, IN(21) + (size_t)l * 2 * CW}, c.wave); }
__device__ __forceinline__ void gemm_gate(const Params& p0, const Ctx& c0) { const Ctx c = fresh(c0); FRESH_P(p0);
    pg8::Gemm g{(const GAS f16*)(p.ws + WS_R1) + PC_LG, (const GAS f16*)(p.ws + WS_W + WO_G), DIN, 128, 128}; pg8::StaticOrder S; S.init(M, CW, (int)gridDim.x, c.bid);
    pg8::gemm_phase(c.lds, g, S, pg8::EpiF16F{(GAS f16*)(p.ws + WS_R4), D}, c.wave); }
__device__ __forceinline__ void gemm_merge(const Params& p0, const Ctx& c0) { const Ctx c = fresh(c0); FRESH_P(p0);
    const GAS f16* OA = (const GAS f16*)(p.ws + WS_R4); const GAS f16* WbrT = (const GAS f16*)(p.ws + WS_W + WO_BR); GAS f16* MG = (GAS f16*)(p.ws + WS_R3); const GAS f16* PROJ = (const GAS f16*)(p.ws + WS_R1);
    pg8::StaticOrder S; S.init(M, D, (int)gridDim.x, c.bid);
    pg8::Gemm g0{OA, WbrT, D, D, CW}; pg8::gemm_phase(c.lds, g0, S, pg8::EpiMergeF<0>{MG, PROJ}, c.wave);
    pg8::Gemm g1{OA + CW, WbrT + CW, D, D, CW}; pg8::gemm_phase(c.lds, g1, S, pg8::EpiMergeF<1>{MG, PROJ}, c.wave); }
__device__ __forceinline__ void gemm_out(const Params& p0, const Ctx& c0) { const Ctx c = fresh(c0); FRESH_P(p0);
    pg8::Gemm g{(const GAS f16*)(p.ws + WS_R3), (const GAS f16*)(p.ws + WS_W + WO_OUT), D, D, D}; pg8::StaticOrder S; S.init(M, D, (int)gridDim.x, c.bid);
    pg8::gemm_phase(c.lds, g, S, pg8::EpiF16F{(GAS f16*)(p.ws + WS_R2), D}, c.wave); }
__device__ __forceinline__ void gemm_up(const Params& p0, const Ctx& c0) { const Ctx c = fresh(c0); FRESH_P(p0);
    pg8::Gemm g{(const GAS f16*)(p.ws + WS_R4), (const GAS f16*)(p.ws + WS_W + WO_UP), D, D, D}; pg8::StaticOrder S; S.init(M, DFF, (int)gridDim.x, c.bid);
    pg8::gemm_phase(c.lds, g, S, pg8::EpiRelu2F{(GAS f16*)(p.ws + WS_R1), DFF}, c.wave); }
__device__ __forceinline__ void gemm_down(const Params& p0, const Ctx& c0) { const Ctx c = fresh(c0); FRESH_P(p0);
    pg8::Gemm g{(const GAS f16*)(p.ws + WS_R1), (const GAS f16*)(p.ws + WS_W + WO_DN), DFF, DFF, DFF}; pg8::StaticOrder S; S.init(M, D, (int)gridDim.x, c.bid);
    pg8::gemm_phase(c.lds, g, S, pg8::EpiF16F{(GAS f16*)(p.ws + WS_R2), D}, c.wave); }

__global__ void __launch_bounds__(NTHREADS, 2) fwd_kernel(Params p) {
    extern __shared__ __attribute__((aligned(16))) unsigned char lds_raw[];
    Ctx c;
    c.lds = (LAS unsigned char*)lds_raw;
    c.tid = threadIdx.x; c.lane = c.tid & 63; c.wave = __builtin_amdgcn_readfirstlane(c.tid >> 6);
    c.gw = blockIdx.x * NWAVES + c.wave; c.ngw = gridDim.x * NWAVES; c.gt = blockIdx.x * NTHREADS + c.tid; c.ngt = gridDim.x * NTHREADS;
    volatile LAS unsigned* MISC = (volatile LAS unsigned*)(c.lds + MISC_OFF);
    if (c.tid < 32) MISC[c.tid] = 0u;
    if (c.tid < 28) ((LAS unsigned long long*)(c.lds + PTAB_OFF))[c.tid] = (unsigned long long)p.in[c.tid];
    __syncthreads();
    unsigned* ctl = (unsigned*)(p.ws + WS_CTL);
    XcdBarrier bar = xcd_barrier_post(ctl + CW_BAR, MISC + 8);
#define GRID_BAR() xcd_barrier(bar)

    conv_weights(p, c, 0);
    __syncthreads();
    mod_phase(p, c);
    GRID_BAR();
    norm_phase<0>(p, c, 0);
    GRID_BAR();
#pragma nounroll
    for (int l = 0; l < NL; ++l) {
        gemm_proj(p, c);
        GRID_BAR();
        gemm_wa(p, c, l);
        gemm_gate(p, c);
        kv_prep(p, c, l);
        GRID_BAR();
        mfma_scan(p, c, l);
        __syncthreads();
        fast_attn(p, c, l);
        GRID_BAR();
        post_phase(p, c, l);
        GRID_BAR();
        gemm_merge(p, c);
        GRID_BAR();
        gemm_out(p, c);
        GRID_BAR();
        norm_phase<1>(p, c, l);
        GRID_BAR();
        gemm_up(p, c);
        GRID_BAR();
        gemm_down(p, c);
        GRID_BAR();
        norm_phase<2>(p, c, l);
        if (l + 1 < NL) { __syncthreads(); conv_weights(p, c, l + 1); }
        GRID_BAR();
    }
}

extern "C" void kernel_launch(void* const* d_in, const int* in_sizes, int n_in, void* d_out, int out_size, void* d_ws, size_t ws_size, hipStream_t stream) {
    static int grid = 0;
    if (grid == 0) {
        if (n_in != 28 || (size_t)out_size != O_TOTAL || ws_size < WS_END) { fprintf(stderr, "kernel_launch: unexpected shapes n_in %d out %d ws %zu\n", n_in, out_size, ws_size); grid = -1; return; }
        int dev = 0, cus = 0;
        if (hipGetDevice(&dev) != hipSuccess || hipDeviceGetAttribute(&cus, hipDeviceAttributeMultiprocessorCount, dev) != hipSuccess) { grid = -1; return; }
        if (hipFuncSetAttribute((const void*)fwd_kernel, hipFuncAttributeMaxDynamicSharedMemorySize, LDS_BYTES) != hipSuccess) { fprintf(stderr, "kernel_launch: hipFuncSetAttribute failed\n"); grid = -1; return; }
        grid = cus;
    }
    if (grid < 0) return;
    (void)hipMemsetAsync((char*)d_ws + WS_CTL, 0, CTL_BYTES, stream);
    Params p{};
    for (int i = 0; i < 28; ++i) p.in[i] = (const float*)d_in[i];
    p.out = (float*)d_out; p.ws = (unsigned char*)d_ws;
    hipLaunchKernelGGL(fwd_kernel, dim3(grid), dim3(NTHREADS), LDS_BYTES, stream, p);
}
```

```cpp
#include <hip/hip_runtime.h>
#include <cstdio>
#include <cstdint>

#define GAS __attribute__((address_space(1)))
#define LAS __attribute__((address_space(3)))
typedef _Float16 f16;
typedef _Float16 f16x8 __attribute__((ext_vector_type(8)));
typedef _Float16 f16x4 __attribute__((ext_vector_type(4)));
typedef _Float16 f16x2 __attribute__((ext_vector_type(2)));
typedef float f32x4 __attribute__((ext_vector_type(4)));
typedef float f32x16 __attribute__((ext_vector_type(16)));
typedef unsigned v4u __attribute__((ext_vector_type(4)));
typedef unsigned v2u __attribute__((ext_vector_type(2)));

constexpr int D = 1024, DIN = 4608, DFF = 4096, CW = 512, NL = 2, NH = 8, HD = 64;
constexpr int B_CTX = 32, T_CTX = 256, B_SMP = 4, T_SMP = 1024, PAST = 256, KV_SMP = PAST + T_SMP;
constexpr int M_CTX = B_CTX * T_CTX, M_SMP = B_SMP * T_SMP, M = M_CTX + M_SMP;
constexpr int NMOD = 6 * D;
constexpr int PC_R = 0, PC_K = 512, PC_V = 1024, PC_LW = 1536, PC_LA = 1600, PC_LG = 1664, PC_Q = 1792, PC_KA = 2304, PC_VA = 2432, PC_GR = 2560, PC_GA = 3584;
constexpr size_t O_Y = 0, O_CK = (size_t)M * D, O_CV = O_CK + (size_t)B_CTX * NL * T_CTX * 128, O_ST = O_CV + (size_t)B_CTX * NL * T_CTX * 128;
constexpr size_t O_TOTAL = O_ST + (size_t)B_CTX * NL * 2 * NH * HD * HD;

constexpr size_t MiB = 1u << 20;
constexpr size_t WS_CTL = 0, CTL_BYTES = 1 * MiB;
constexpr size_t WS_MOD = 1 * MiB;
constexpr size_t WS_W = 2 * MiB;
constexpr size_t WO_IN = 0, WO_BR = 9 * MiB, WO_OUT = 11 * MiB, WO_UP = 13 * MiB, WO_DN = 21 * MiB, WO_SM = 29 * MiB, WO_G = 29 * MiB + 512 * 1024;
constexpr size_t WS_R1 = 32 * MiB;
constexpr size_t WS_R2 = 140 * MiB;
constexpr size_t WS_R3 = 188 * MiB;
constexpr size_t WS_RK = 212 * MiB;
constexpr size_t WS_R4 = 213 * MiB;
constexpr size_t WS_KN = 237 * MiB;
constexpr size_t WS_VT = 241 * MiB;
constexpr size_t WS_END = 245 * MiB;
constexpr size_t KN_SMP_OFF = (size_t)B_CTX * 2 * T_CTX * 64;

constexpr int NWAVES = 8, NTHREADS = 512;
constexpr int LDS_BYTES = 147456;
constexpr int MISC_OFF = 131072 + 320, PTAB_OFF = 131072 + 1024;

#define XB_TMO      128
#define XB_XCNT(j)  (256  + 64 * (j))
#define XB_XSUB(j)  (1280 + 64 * (j))
#define XB_XGEN(j)  (2304 + 64 * (j))
#define XB_TOP      3328
#define XB_TOPGEN   3392
#define XCD_BAR_WORDS 3456
#define XB_SPIN_CAP (1u << 24)
constexpr int CW_BAR = 4096;

__device__ __forceinline__ unsigned xb_ld(unsigned* p)              { return __hip_atomic_load(p, __ATOMIC_RELAXED, __HIP_MEMORY_SCOPE_AGENT); }
__device__ __forceinline__ unsigned xb_add(unsigned* p, unsigned v) { return __hip_atomic_fetch_add(p, v, __ATOMIC_RELAXED, __HIP_MEMORY_SCOPE_AGENT); }
__device__ __forceinline__ unsigned xb_xcc_id() { return (unsigned)__builtin_amdgcn_s_getreg((3 << 11) | 20) & 0xFu; }
#define XB_SPIN(cond, bar) do { unsigned _sp = 0; while (cond) { __builtin_amdgcn_s_sleep(1); \
    if ((++_sp & 255u) == 0u) { if (xb_ld(&(bar)[XB_TMO])) break; if (_sp > XB_SPIN_CAP) { atomicAdd(&(bar)[XB_TMO], 1u); break; } } } } while (0)

struct XcdBarrier { unsigned* bar; unsigned x; volatile LAS unsigned* st; };

__device__ __forceinline__ XcdBarrier xcd_barrier_post(unsigned* bar, volatile LAS unsigned* st) {
    XcdBarrier b; b.bar = bar; b.x = xb_xcc_id(); b.st = st;
    if (threadIdx.x == 0) (void)xb_add(&bar[XB_XCNT(b.x)], 1u);
    return b;
}
__device__ __forceinline__ void xcd_barrier_complete(unsigned* bar, unsigned x, unsigned& nloc, unsigned& nx) {
    const unsigned G = gridDim.x * gridDim.y * gridDim.z;
    unsigned sum, cnt, mine, sp = 0u;
    for (;;) {
        sum = 0u; cnt = 0u; mine = 0u;
#pragma unroll
        for (unsigned j = 0; j < 16; ++j) { const unsigned c = xb_ld(&bar[XB_XCNT(j)]); sum += c; cnt += (c > 0u) ? 1u : 0u; mine = (j == x) ? c : mine; }
        if (sum == G) break;
        __builtin_amdgcn_s_sleep(1);
        if ((++sp & 255u) == 0u) { if (xb_ld(&bar[XB_TMO])) break; if (sp > XB_SPIN_CAP) { atomicAdd(&bar[XB_TMO], 1u); break; } }
    }
    nloc = mine > 0u ? mine : 1u; nx = cnt > 0u ? cnt : 1u;
}
__device__ __forceinline__ void xcd_barrier(const XcdBarrier& b) {
    asm volatile("s_waitcnt vmcnt(0)" ::: "memory");
    __syncthreads();
    if (threadIdx.x == 0) {
        unsigned* bar = b.bar; unsigned bx = b.x;
        asm volatile("" : "+s"(bar), "+s"(bx));
        __builtin_amdgcn_s_waitcnt(0);
        unsigned nloc = b.st[0], nx = b.st[1];
        if (nloc == 0u) { xcd_barrier_complete(bar, bx, nloc, nx); b.st[0] = nloc; b.st[1] = nx; }
        const unsigned old = xb_add(&bar[XB_XSUB(bx)], 1u);
        const unsigned gen = old / nloc;
        if (old + 1u == (gen + 1u) * nloc) {
            __builtin_amdgcn_fence(__ATOMIC_RELEASE, "agent");
            asm volatile("s_waitcnt vmcnt(0)" ::: "memory");
            const unsigned og = xb_add(&bar[XB_TOP], 1u);
            const unsigned tg = og / nx;
            if (og + 1u == (tg + 1u) * nx) xb_add(&bar[XB_TOPGEN], 1u);
            else XB_SPIN(xb_ld(&bar[XB_TOPGEN]) == tg, bar);
            __builtin_amdgcn_fence(__ATOMIC_ACQUIRE, "agent");
            xb_add(&bar[XB_XGEN(bx)], 1u);
            asm volatile("s_waitcnt vmcnt(0)" ::: "memory");
        } else {
            XB_SPIN(xb_ld(&bar[XB_XGEN(bx)]) == gen, bar);
            __builtin_amdgcn_fence(__ATOMIC_ACQUIRE, "agent");
            asm volatile("s_waitcnt vmcnt(0)" ::: "memory");
        }
    }
    __syncthreads();
}

#define LDS_WAIT() asm volatile("s_waitcnt lgkmcnt(0)" ::: "memory")
#define DPPF(x, ctrl, rmask, oldv) __builtin_bit_cast(float, __builtin_amdgcn_update_dpp(__builtin_bit_cast(int, (float)(oldv)), __builtin_bit_cast(int, (float)(x)), (ctrl), (rmask), 0xF, false))
__device__ __forceinline__ float wave_sum(float v) {
    v += DPPF(v, 0xB1, 0xF, 0.f); v += DPPF(v, 0x4E, 0xF, 0.f); v += DPPF(v, 0x141, 0xF, 0.f); v += DPPF(v, 0x140, 0xF, 0.f);
    v += DPPF(v, 0x142, 0xA, 0.f); v += DPPF(v, 0x143, 0xC, 0.f);
    return __builtin_bit_cast(float, __builtin_amdgcn_readlane(__builtin_bit_cast(int, v), 63));
}
__device__ __forceinline__ float dpp_f(float x, const int ctrl) { return x; }
#define DPP_ADD(x, ctrl) (x) += __builtin_bit_cast(float, __builtin_amdgcn_update_dpp(0, __builtin_bit_cast(int, (x)), (ctrl), 0xF, 0xF, true))
__device__ __forceinline__ float dpp_sum8(float x) { DPP_ADD(x, 0xB1); DPP_ADD(x, 0x4E); DPP_ADD(x, 0x141); return x; }
__device__ __forceinline__ float dpp_sum16(float x) { DPP_ADD(x, 0xB1); DPP_ADD(x, 0x4E); DPP_ADD(x, 0x141); DPP_ADD(x, 0x140); return x; }
__device__ __forceinline__ void swap32(float& a, float& b) { asm volatile("v_nop\n\tv_nop\n\tv_permlane32_swap_b32 %0, %1" : "+v"(a), "+v"(b)); }
__device__ __forceinline__ float half_sum(float v) { float a = v, b = v; swap32(a, b); return a + b; }
__device__ __forceinline__ float half_max(float v) { float a = v, b = v; swap32(a, b); return fmaxf(a, b); }
__device__ __forceinline__ float xor16(float v) { return __builtin_bit_cast(float, __builtin_amdgcn_ds_swizzle(__builtin_bit_cast(int, v), 0x401F)); }
__device__ __forceinline__ float sigmoidf_(float x) { return __builtin_amdgcn_rcpf(1.0f + __expf(-x)); }
__device__ __forceinline__ float tanhf_(float x) { return 1.0f - 2.0f * __builtin_amdgcn_rcpf(1.0f + __expf(2.0f * x)); }
__device__ __forceinline__ unsigned pkh(float lo, float hi) { f16x2 v = {(f16)lo, (f16)hi}; return __builtin_bit_cast(unsigned, v); }
__device__ __forceinline__ void row_info(int row, int& g, int& t, int& T) {
    if (row < M_CTX) { g = 0; t = row & (T_CTX - 1); T = T_CTX; }
    else { const int r = row - M_CTX; g = 1 + (r >> 10); t = r & (T_SMP - 1); T = T_SMP; }
}

struct Params {
    const float* in[28];
    float* out;
    unsigned char* ws;
};
struct DParams { GAS float* out; GAS unsigned char* ws; };
struct Ctx {
    LAS unsigned char* lds;
    int tid, lane, wave, gw, ngw, gt, ngt, bid;
};
__device__ __forceinline__ int lane_id() { int ln; asm volatile("v_mbcnt_lo_u32_b32 %0, -1, 0\n\tv_mbcnt_hi_u32_b32 %0, -1, %0" : "=v"(ln)); return ln; }
__device__ __forceinline__ const GAS float* inp(const Ctx& c, int i) {
    const unsigned long long v = ((const LAS unsigned long long*)(c.lds + PTAB_OFF))[i];
    const unsigned lo = __builtin_amdgcn_readfirstlane((unsigned)v), hi = __builtin_amdgcn_readfirstlane((unsigned)(v >> 32));
    return (const GAS float*)(((unsigned long long)hi << 32) | lo); }
#define IN(i) inp(c, (i))
#define FRESH_P(p0) DParams p; { float* o_ = (p0).out; unsigned char* w_ = (p0).ws; asm volatile("" : "+s"(o_), "+s"(w_)); p.out = (GAS float*)o_; p.ws = (GAS unsigned char*)w_; }
__device__ __forceinline__ Ctx fresh(const Ctx& c0) {
    Ctx c = c0; int w = c0.wave; asm volatile("" : "+s"(w)); int ln = lane_id(); asm volatile("" : "+v"(ln));
    int b = blockIdx.x; asm volatile("" : "+s"(b));
    c.wave = w; c.lane = ln; c.tid = w * 64 + ln; c.bid = b;
    c.gw = b * 8 + w; c.gt = b * 512 + c.tid; return c; }

__device__ __forceinline__ void conv_item(const GAS float* W, int N, GAS f16* WT, int ldt, int koff, LAS float* scr, int kb, int nb, int lane) {
    const int k0 = 64 * kb, n0 = 32 * nb;
#pragma unroll 8
    for (int i = 0; i < 32; ++i) { const int kk = 2 * i + (lane >> 5); scr[kk * 33 + (lane & 31)] = W[(size_t)(k0 + kk) * N + n0 + (lane & 31)]; }
    LDS_WAIT();
    const int c = lane & 7;
#pragma unroll
    for (int j = 0; j < 4; ++j) { const int n = (lane >> 3) + 8 * j; const LAS float* s = scr + (8 * c) * 33 + n;
        v4u o; o.x = pkh(s[0 * 33], s[1 * 33]); o.y = pkh(s[2 * 33], s[3 * 33]); o.z = pkh(s[4 * 33], s[5 * 33]); o.w = pkh(s[6 * 33], s[7 * 33]);
        *(GAS v4u*)(WT + (size_t)(n0 + n) * ldt + koff + k0 + 8 * c) = o; }
    LDS_WAIT();
}
__device__ __forceinline__ void conv_weights(const Params& p0, const Ctx& c0, int l) {
    const Ctx c = fresh(c0); FRESH_P(p0);
    LAS float* scr = (LAS float*)(c.lds + c.wave * 16384);
    GAS unsigned char* wb = p.ws + WS_W;
    GAS f16* WinT = (GAS f16*)(wb + WO_IN); GAS f16* WbrT = (GAS f16*)(wb + WO_BR); GAS f16* WoutT = (GAS f16*)(wb + WO_OUT); GAS f16* WupT = (GAS f16*)(wb + WO_UP); GAS f16* WdnT = (GAS f16*)(wb + WO_DN);
    GAS f16* WsmT = (GAS f16*)(wb + WO_SM); GAS f16* WgT = (GAS f16*)(wb + WO_G);
    const GAS float* w_in = IN(7) + (size_t)l * D * DIN; const GAS float* w_br = IN(8) + (size_t)l * 2 * CW * D; const GAS float* w_out = IN(9) + (size_t)l * D * D;
    const GAS float* w_up = IN(13) + (size_t)l * D * DFF; const GAS float* w_dn = IN(14) + (size_t)l * DFF * D;
    const GAS float* dec_up = IN(20) + (size_t)l * 2 * 64 * CW; const GAS float* icl_up = IN(22) + (size_t)l * 2 * 64 * CW; const GAS float* gate_up = IN(23) + (size_t)l * 128 * CW;
    constexpr int I0 = 16 * 144, I1 = 8 * 32, I2 = 8 * 32, I3 = 16 * 32, I4 = 16 * 128, I5 = 64 * 32, I6 = 16, I7 = 16, I8 = 16, I9 = 16, I10 = 2 * 16;
    constexpr int NIT = I0 + I1 + I2 + I3 + I4 + I5 + I6 + I7 + I8 + I9 + I10;
    for (int it = c.gw; it < NIT; it += c.ngw) {
        int r = it;
        if (r < I0) { conv_item(w_in, DIN, WinT, D, 0, scr, r / 144, r % 144, c.lane); continue; } r -= I0;
        if (r < I1) { conv_item(w_br, D, WbrT, D, 0, scr, r / 32, r % 32, c.lane); continue; } r -= I1;
        if (r < I2) { conv_item(w_br + (size_t)CW * D, D, WbrT, D, CW, scr, r / 32, r % 32, c.lane); continue; } r -= I2;
        if (r < I3) { conv_item(w_out, D, WoutT, D, 0, scr, r / 32, r % 32, c.lane); continue; } r -= I3;
        if (r < I4) { conv_item(w_up, DFF, WupT, D, 0, scr, r / 128, r % 128, c.lane); continue; } r -= I4;
        if (r < I5) { conv_item(w_dn, D, WdnT, DFF, 0, scr, r / 32, r % 32, c.lane); continue; } r -= I5;
        if (r < I6) { conv_item(dec_up, CW, WsmT, 128, 0, scr, 0, r, c.lane); continue; } r -= I6;
        if (r < I7) { conv_item(dec_up + 64 * CW, CW, WsmT + (size_t)512 * 128, 128, 0, scr, 0, r, c.lane); continue; } r -= I7;
        if (r < I8) { conv_item(icl_up, CW, WsmT + (size_t)1024 * 128, 128, 64, scr, 0, r, c.lane); continue; } r -= I8;
        if (r < I9) { conv_item(icl_up + 64 * CW, CW, WsmT + (size_t)1536 * 128, 128, 64, scr, 0, r, c.lane); continue; } r -= I9;
        conv_item(gate_up, CW, WgT, 128, 0, scr, r / 16, r % 16, c.lane);
    }
    for (int i = c.gt; i < 2048 * 8; i += c.ngt) { const int row = i >> 3, ch = i & 7; const int col = (row < 1024 ? 64 : 0) + ch * 8;
        *(GAS v4u*)(WsmT + (size_t)row * 128 + col) = (v4u){0u, 0u, 0u, 0u}; }
}

__device__ __forceinline__ void mod_phase(const Params& p0, const Ctx& c0) {
    const Ctx c = fresh(c0); FRESH_P(p0);
    LAS float* sl = (LAS float*)(c.lds);
    LAS float* part = (LAS float*)(c.lds + 32768);
    GAS float* mod = (GAS float*)(p.ws + WS_MOD);
    for (int i = c.tid; i < 5 * D; i += NTHREADS) { const int g = i >> 10, k = i & 1023; const float v = g == 0 ? IN(6)[k] : IN(5)[(g - 1) * D + k]; sl[i] = v / (1.0f + __expf(-v)); }
    __syncthreads();
    for (int it = c.bid; it < NL * (NMOD / 64) * 4; it += gridDim.x) {
        const int kq = it & 3, lc = it >> 2, l = lc / (NMOD / 64), cc = lc % (NMOD / 64);
        const int kb = kq * 256 + c.wave * 32;
        const GAS float* w = IN(10) + (size_t)l * D * NMOD + (size_t)kb * NMOD + cc * 64 + c.lane;
        float a0 = 0.f, a1 = 0.f, a2 = 0.f, a3 = 0.f, a4 = 0.f;
        float wv[32];
#pragma unroll
        for (int k = 0; k < 32; ++k) wv[k] = w[(size_t)k * NMOD];
#pragma unroll
        for (int k = 0; k < 32; ++k) { a0 += sl[kb + k] * wv[k]; a1 += sl[D + kb + k] * wv[k]; a2 += sl[2 * D + kb + k] * wv[k]; a3 += sl[3 * D + kb + k] * wv[k]; a4 += sl[4 * D + kb + k] * wv[k]; }
        LAS float* pw = part + c.wave * 320 + c.lane;
        pw[0] = a0; pw[64] = a1; pw[128] = a2; pw[192] = a3; pw[256] = a4;
        __syncthreads();
        if (c.tid < 320) { float s = 0.f;
#pragma unroll
            for (int w8 = 0; w8 < 8; ++w8) s += part[w8 * 320 + c.tid];
            const int g = c.tid >> 6, col = cc * 64 + (c.tid & 63);
            if (kq == 0) s += IN(11)[(size_t)l * NMOD + col];
            atomicAdd((float*)(mod + ((size_t)l * 5 + g) * NMOD + col), s); }
        __syncthreads();
    }
}

template <int MODE, int NB>
__device__ __forceinline__ void norm_rows(const DParams& p, const Ctx& c, int l, int row_first, int row_end, int row_step) {
    GAS float* X = p.out; const GAS f16* MO = (const GAS f16*)(p.ws + WS_R2); GAS f16* H = (GAS f16*)(p.ws + WS_R4);
    const GAS float* modb = (const GAS float*)(p.ws + WS_MOD);
    const GAS float* in0 = IN(0); const GAS float* in1 = IN(1); const GAS float* ngb = IN(12);
    for (int rowb = row_first; rowb < row_end; rowb += NB * row_step) {
        f32x4 x[NB][4]; f16x4 mh[NB][4];
#pragma unroll
        for (int b = 0; b < NB; ++b) { const int row = rowb + b * row_step;
            if (row < row_end) {
                if (MODE == 0) { const GAS float* src = row < M_CTX ? in0 + (size_t)row * D : in1 + (size_t)(row - M_CTX) * D;
#pragma unroll
                    for (int j = 0; j < 4; ++j) x[b][j] = __builtin_nontemporal_load((const GAS f32x4*)(src + 256 * j + 4 * c.lane)); }
                else {
#pragma unroll
                    for (int j = 0; j < 4; ++j) { x[b][j] = __builtin_nontemporal_load((const GAS f32x4*)(X + (size_t)row * D + 256 * j + 4 * c.lane));
                        mh[b][j] = __builtin_nontemporal_load((const GAS f16x4*)(MO + (size_t)row * D + 256 * j + 4 * c.lane)); } } } }
#pragma unroll
        for (int b = 0; b < NB; ++b) { const int row = rowb + b * row_step;
            if (row < row_end) {
                int g, t, T; row_info(row, g, t, T);
                if (MODE != 0) {
                    const GAS float* mo_mod = modb + ((size_t)l * 5 + g) * NMOD + (MODE == 1 ? 2 * D : 5 * D);
                    const GAS float* ngp = ngb + ((size_t)l * 4 + (MODE == 1 ? 1 : 3)) * D;
                    float mv[4][4]; float ss = 0.f;
#pragma unroll
                    for (int j = 0; j < 4; ++j)
#pragma unroll
                        for (int e = 0; e < 4; ++e) { mv[j][e] = (float)mh[b][j][e]; ss += mv[j][e] * mv[j][e]; }
                    const float rstd = rsqrtf(wave_sum(ss) * (1.0f / D) + 1e-6f);
#pragma unroll
                    for (int j = 0; j < 4; ++j) { const f32x4 gg = *(const GAS f32x4*)(mo_mod + 256 * j + 4 * c.lane); const f32x4 nn = *(const GAS f32x4*)(ngp + 256 * j + 4 * c.lane);
#pragma unroll
                        for (int e = 0; e < 4; ++e) x[b][j][e] += gg[e] * (mv[j][e] * rstd * nn[e]); }
                }
                const int ln = MODE == 2 ? l + 1 : l;
                if (ln < NL) {
                    const GAS float* mb = modb + ((size_t)ln * 5 + g) * NMOD + (MODE == 1 ? 3 * D : 0);
                    const GAS float* ngp = ngb + ((size_t)ln * 4 + (MODE == 1 ? 2 : 0)) * D;
                    float ss = 0.f;
#pragma unroll
                    for (int j = 0; j < 4; ++j) ss += (x[b][j][0] * x[b][j][0] + x[b][j][1] * x[b][j][1]) + (x[b][j][2] * x[b][j][2] + x[b][j][3] * x[b][j][3]);
                    const float rstd = rsqrtf(wave_sum(ss) * (1.0f / D) + 1e-6f);
#pragma unroll
                    for (int j = 0; j < 4; ++j) { const f32x4 sh = *(const GAS f32x4*)(mb + 256 * j + 4 * c.lane); const f32x4 sc = *(const GAS f32x4*)(mb + D + 256 * j + 4 * c.lane);
                        const f32x4 nn = *(const GAS f32x4*)(ngp + 256 * j + 4 * c.lane);
                        float o[4];
#pragma unroll
                        for (int e = 0; e < 4; ++e) o[e] = x[b][j][e] * rstd * nn[e] * (1.0f + sc[e]) + sh[e];
                        v2u w; w.x = pkh(o[0], o[1]); w.y = pkh(o[2], o[3]);
                        *(GAS v2u*)(H + (size_t)row * D + 256 * j + 4 * c.lane) = w; }
                }
#pragma unroll
                for (int j = 0; j < 4; ++j) __builtin_nontemporal_store(x[b][j], (GAS f32x4*)(X + (size_t)row * D + 256 * j + 4 * c.lane));
            } }
    }
}
template <int MODE>
__device__ __forceinline__ void norm_phase(const Params& p0, const Ctx& c0, int l) {
    const Ctx c = fresh(c0); FRESH_P(p0);
    norm_rows<MODE, 3>(p, c, l, c.gw, M, c.ngw);
}

namespace pg8 {
constexpr int BM = 256, BK = 64, HALF = 128, HTB = HALF * BK * 2, STAGE_BYTES = 8 * HTB, NXCD = 8, WGM = 8;
__host__ __device__ __forceinline__ int lds_byte(int r, int c) { const int st = (r >> 4) * 2 + (c >> 5), rr = r & 15, cc = c & 31, ob = rr * 64 + cc * 2; return st * 1024 + (ob ^ (((ob >> 9) & 1) << 5)); }
__host__ __device__ __forceinline__ void stage_rc(int b, int& R, int& C) { const int st = b / 1024, sb = b % 1024, swz = sb ^ (((sb >> 9) & 1) << 5); R = (st >> 1) * 16 + swz / 64; C = (st & 1) * 32 + (swz % 64) / 2; }
__host__ __device__ __forceinline__ int perm32(int rho) { const int n = rho >> 4, i = rho & 15; return 8 * (i >> 2) + 4 * n + (i & 3); }
struct Unit { int pm, pn; };
struct Gemm { const GAS f16* A; const GAS f16* Bt; int lda, ldb, K; };
struct StaticOrder {
    int nM, nN, nwg, G, c;
    __device__ void init(int Mr, int N, int G_, int c_, int bm = BM) { nM = Mr / bm; nN = N / BM; nwg = nM * nN; G = G_; c = c_; }
    __device__ bool next(int i, Unit& u) const {
        const long L = (long)i * G + c; if (L >= nwg) return false;
        int wgid = (int)L; { const int q = nwg / NXCD, r = nwg % NXCD, xcd = wgid % NXCD, off = wgid / NXCD; wgid = (xcd < r ? xcd * (q + 1) : r * (q + 1) + (xcd - r) * q) + off; }
        const int nig = WGM * nN, gid = wgid / nig, fm = gid * WGM, gsz = (nM - fm) < WGM ? (nM - fm) : WGM;
        u.pm = fm + ((wgid % nig) % gsz); u.pn = (wgid % nig) / gsz; return true;
    }
};
template <class Epi, int HA = 128, bool ALIGN_EPI = true, bool SP2 = true>
__device__ __forceinline__ void gemm_phase(LAS unsigned char* lds, const Gemm g, const StaticOrder& S, const Epi& E, int wave_sgpr) {
    asm volatile("" : "+s"(wave_sgpr)); int tid = wave_sgpr * 64 + lane_id(); asm volatile("" : "+v"(tid));
    const int wid = __builtin_amdgcn_readfirstlane(tid >> 6), lane = tid & 63, wr = wid >> 2, wc = wid & 3, fr = lane & 15, fq = lane >> 4;
    const int K = g.K, nt = K / BK;
    unsigned voffA[2], voffB[2];
#pragma unroll
    for (int i = 0; i < 2; ++i) { int R, C; stage_rc(tid * 16 + i * 8192, R, C); const int Rb = (R & ~31) + perm32(R & 31);
        voffA[i] = (unsigned)(R * g.lda + C) * 2u; voffB[i] = (unsigned)(Rb * g.ldb + C) * 2u; }
    const unsigned kstep = (unsigned)(BK * 2);
    constexpr int MF = HA / 32;
    const unsigned hstepA = (unsigned)HA * g.lda * 2, hstepB = (unsigned)HALF * g.ldb * 2;
    const unsigned tstepA = 2 * hstepA, tstepB = 2 * hstepB;
    const unsigned ldsw = (unsigned)wid * 1024u;
    const int aoff = lds_byte(wr * (HA / 2) + fr, fq * 8), boff = lds_byte(wc * 32 + fr, fq * 8);
#define PG8_SA(b, h) (((b) * 2 + (h)) * HTB)
#define PG8_SB(b, h) ((4 + (b) * 2 + (h)) * HTB)
#define PG8_STAGE(bufoff, gbase, soff, voff) do { _Pragma("unroll") for (int _i = 0; _i < 2; ++_i) \
        __builtin_amdgcn_raw_ptr_buffer_load_lds(rs##gbase, (LAS unsigned*)(lds + (bufoff) + ldsw + _i * 8192), 16, (voff)[_i], (int)(soff), 0, 0); } while (0)
#define PG8_LDA(dst, b, h) do { _Pragma("unroll") for (int m = 0; m < MF; ++m) _Pragma("unroll") for (int k = 0; k < 2; ++k) dst[m][k] = *(const LAS f16x8*)(lds + PG8_SA(b, h) + aoff + m * 2048 + k * 1024); } while (0)
#define PG8_LDB(dst, b, h) do { _Pragma("unroll") for (int n = 0; n < 2; ++n) _Pragma("unroll") for (int k = 0; k < 2; ++k) dst[n][k] = *(const LAS f16x8*)(lds + PG8_SB(b, h) + boff + n * 2048 + k * 1024); } while (0)
#define PG8_MMA(ai, bj, At, Bt) do { __builtin_amdgcn_s_setprio(1); _Pragma("unroll") for (int m = 0; m < MF; ++m) _Pragma("unroll") for (int n = 0; n < 2; ++n) _Pragma("unroll") for (int k = 0; k < 2; ++k) \
        acc[ai][bj][m][n] = __builtin_amdgcn_mfma_f32_16x16x32_f16(Bt[n][k], At[m][k], acc[ai][bj][m][n], 0, 0, 0); __builtin_amdgcn_s_setprio(0); } while (0)
#define PG8_WAIT_V(n) asm volatile("s_waitcnt vmcnt(" #n ")" ::: "memory")
#define PG8_WAIT_L(n) asm volatile("s_waitcnt lgkmcnt(" #n ")" ::: "memory")
#define PG8_BAR __builtin_amdgcn_s_barrier()
#define PG8_SCHED __builtin_amdgcn_sched_barrier(0)
    Unit cur, nxt; int ui = 0;
    if (!S.next(0, cur)) return;
    f32x4 acc[2][2][4][2];
#pragma unroll
    for (int a = 0; a < 2; ++a)
#pragma unroll
        for (int b = 0; b < 2; ++b)
#pragma unroll
            for (int m = 0; m < 4; ++m)
#pragma unroll
                for (int n = 0; n < 2; ++n) acc[a][b][m][n] = (f32x4){0.f, 0.f, 0.f, 0.f};
    f16x8 At[4][2], B0[2][2], B1[2][2];
    const auto rsA = __builtin_amdgcn_make_buffer_rsrc((GAS void*)g.A, 0, 0x7fffffff, 0x00020000); const auto rsB = __builtin_amdgcn_make_buffer_rsrc((GAS void*)g.Bt, 0, 0x7fffffff, 0x00020000);
    unsigned cA = (unsigned)cur.pm * tstepA, cB = (unsigned)cur.pn * tstepB;
    if constexpr (SP2) {
        PG8_STAGE(PG8_SB(0, 0), B, cB, voffB); PG8_STAGE(PG8_SB(0, 1), B, cB + hstepB, voffB); PG8_STAGE(PG8_SA(0, 0), A, cA, voffA); PG8_STAGE(PG8_SA(0, 1), A, cA + hstepA, voffA);
        if (wr == 1) PG8_BAR;
        PG8_WAIT_V(2); PG8_BAR;
        PG8_STAGE(PG8_SB(1, 0), B, cB + kstep, voffB); PG8_STAGE(PG8_SA(1, 0), A, cA + kstep, voffA); PG8_STAGE(PG8_SB(1, 1), B, cB + hstepB + kstep, voffB);
        PG8_WAIT_V(6); PG8_BAR;
    } else {
        PG8_STAGE(PG8_SB(0, 0), B, cB, voffB); PG8_STAGE(PG8_SA(0, 0), A, cA, voffA); PG8_STAGE(PG8_SB(0, 1), B, cB + hstepB, voffB); PG8_STAGE(PG8_SA(0, 1), A, cA + hstepA, voffA);
        if (wr == 1) PG8_BAR;
        PG8_WAIT_V(4); PG8_BAR;
        PG8_STAGE(PG8_SB(1, 0), B, cB + kstep, voffB); PG8_STAGE(PG8_SA(1, 0), A, cA + kstep, voffA); PG8_STAGE(PG8_SB(1, 1), B, cB + hstepB + kstep, voffB);
        PG8_WAIT_V(6); PG8_BAR;
    }
    for (;;) {
        const bool has_next = S.next(ui + 1, nxt);
        const unsigned nA = has_next ? (unsigned)nxt.pm * tstepA : cA, nB = has_next ? (unsigned)nxt.pn * tstepB : cB;
        for (int t = 0; t < nt; t += 2) {
            if constexpr (Epi::MID_T >= 0) { if (t == Epi::MID_T) { const int ln3 = lane_id(); E.template mid<HA>(acc, cur, wr, wc, ln3 & 15, ln3 >> 4); } }
            const bool last = (t == nt - 2);
            const unsigned a1 = cA + (unsigned)(t + 1) * kstep;
            const unsigned a2 = last ? nA : cA + (unsigned)(t + 2) * kstep, b2 = last ? nB : cB + (unsigned)(t + 2) * kstep;
            const unsigned a3 = a2 + kstep, b3 = b2 + kstep;
            if constexpr (SP2) {
            PG8_LDB(B0, 0, 0); PG8_LDB(B1, 0, 1); PG8_SCHED; PG8_LDA(At, 0, 0); PG8_STAGE(PG8_SA(1, 1), A, a1 + hstepA, voffA);
            PG8_WAIT_V(8); PG8_WAIT_L(0); PG8_BAR; PG8_MMA(0, 0, At, B0); PG8_MMA(0, 1, At, B1); PG8_BAR; PG8_SCHED;
            PG8_LDA(At, 0, 1); PG8_STAGE(PG8_SB(0, 0), B, b2, voffB); PG8_STAGE(PG8_SB(0, 1), B, b2 + hstepB, voffB); PG8_STAGE(PG8_SA(0, 0), A, a2, voffA);
            PG8_WAIT_V(8); PG8_WAIT_L(0); PG8_BAR; PG8_MMA(1, 0, At, B0); PG8_MMA(1, 1, At, B1); PG8_BAR; PG8_SCHED;
            PG8_LDB(B0, 1, 0); PG8_LDB(B1, 1, 1); PG8_SCHED; PG8_LDA(At, 1, 0); PG8_STAGE(PG8_SA(0, 1), A, a2 + hstepA, voffA);
            PG8_WAIT_V(8); PG8_WAIT_L(0); PG8_BAR; PG8_MMA(0, 0, At, B0); PG8_MMA(0, 1, At, B1); PG8_BAR; PG8_SCHED;
            PG8_LDA(At, 1, 1); PG8_STAGE(PG8_SB(1, 0), B, b3, voffB); PG8_STAGE(PG8_SB(1, 1), B, b3 + hstepB, voffB); PG8_STAGE(PG8_SA(1, 0), A, a3, voffA);
            PG8_WAIT_V(8); PG8_WAIT_L(0); PG8_BAR; PG8_MMA(1, 0, At, B0); PG8_MMA(1, 1, At, B1); PG8_BAR; PG8_SCHED;
            } else {
            PG8_LDB(B0, 0, 0); PG8_SCHED; PG8_LDA(At, 0, 0); PG8_STAGE(PG8_SA(1, 1), A, a1 + hstepA, voffA);
            PG8_WAIT_L(8); PG8_BAR; PG8_WAIT_L(0); PG8_MMA(0, 0, At, B0); PG8_BAR; PG8_SCHED;
            PG8_LDB(B1, 0, 1); PG8_STAGE(PG8_SB(0, 0), B, b2, voffB);
            PG8_BAR; PG8_WAIT_L(0); PG8_MMA(0, 1, At, B1); PG8_BAR;
            PG8_LDA(At, 0, 1); PG8_STAGE(PG8_SA(0, 0), A, a2, voffA);
            PG8_BAR; PG8_WAIT_L(0); PG8_MMA(1, 0, At, B0); PG8_BAR; PG8_SCHED;
            PG8_STAGE(PG8_SB(0, 1), B, b2 + hstepB, voffB);
            PG8_WAIT_V(6); PG8_BAR; PG8_MMA(1, 1, At, B1); PG8_BAR;
            PG8_LDB(B0, 1, 0); PG8_SCHED; PG8_LDA(At, 1, 0); PG8_STAGE(PG8_SA(0, 1), A, a2 + hstepA, voffA);
            PG8_WAIT_L(8); PG8_BAR; PG8_WAIT_L(0); PG8_MMA(0, 0, At, B0); PG8_BAR; PG8_SCHED;
            PG8_LDB(B1, 1, 1); PG8_STAGE(PG8_SB(1, 0), B, b3, voffB);
            PG8_BAR; PG8_WAIT_L(0); PG8_MMA(0, 1, At, B1); PG8_BAR;
            PG8_LDA(At, 1, 1); PG8_STAGE(PG8_SA(1, 0), A, a3, voffA);
            PG8_BAR; PG8_WAIT_L(0); PG8_MMA(1, 0, At, B0); PG8_BAR; PG8_SCHED;
            PG8_STAGE(PG8_SB(1, 1), B, b3 + hstepB, voffB);
            PG8_WAIT_V(6); PG8_BAR; PG8_MMA(1, 1, At, B1); PG8_BAR;
            }
        }
        if constexpr (ALIGN_EPI) { if (wr == 0) PG8_BAR; }
        { const int ln2 = lane_id(); E.template run<HA>(acc, cur, wr, wc, ln2 & 15, ln2 >> 4); }
        if (!has_next) break;
#pragma unroll
        for (int a = 0; a < 2; ++a)
#pragma unroll
            for (int b = 0; b < 2; ++b)
#pragma unroll
                for (int m = 0; m < 4; ++m)
#pragma unroll
                    for (int n = 0; n < 2; ++n) acc[a][b][m][n] = (f32x4){0.f, 0.f, 0.f, 0.f};
        cur = nxt; cA = nA; cB = nB; ++ui;
        if constexpr (ALIGN_EPI) { if (wr == 1) PG8_BAR; }
    }
    PG8_WAIT_V(0);
    if constexpr (!ALIGN_EPI) { if (wr == 0) PG8_BAR; }
    PG8_BAR;
#undef PG8_SA
#undef PG8_SB
#undef PG8_STAGE
#undef PG8_LDA
#undef PG8_LDB
#undef PG8_MMA
#undef PG8_WAIT_V
#undef PG8_WAIT_L
#undef PG8_BAR
#undef PG8_SCHED
}
typedef f32x4 Acc[2][2][4][2];
#define PG8_EPI_LOOP(...) \
    const int row0 = u.pm * (2 * HA) + wr * (HA / 2) + fr, col0 = u.pn * BM + wc * 32 + 8 * fq; \
    _Pragma("unroll") for (int ai = 0; ai < 2; ++ai) _Pragma("unroll") for (int m = 0; m < HA / 32; ++m) { const int row = row0 + ai * HA + m * 16; \
        _Pragma("unroll") for (int bj = 0; bj < 2; ++bj) { const int col = col0 + bj * HALF; f32x4 v0 = acc[ai][bj][m][0], v1 = acc[ai][bj][m][1]; __VA_ARGS__ } asm volatile("" ::: "memory"); }
__device__ __forceinline__ void store8(GAS f16* p, f32x4 v0, f32x4 v1) { v4u w; w.x = pkh(v0[0], v0[1]); w.y = pkh(v0[2], v0[3]); w.z = pkh(v1[0], v1[1]); w.w = pkh(v1[2], v1[3]); *(GAS v4u*)p = w; }
struct EpiProjF { static constexpr int MID_T = -1; GAS f16* P;
    template <int HA> __device__ __forceinline__ void run(const Acc& acc, const Unit& u, int wr, int wc, int fr, int fq) const {
        PG8_EPI_LOOP(
            if (u.pn == 6) {
                if (col < PC_LA) { _Pragma("unroll") for (int e = 0; e < 4; ++e) { v0[e] = tanhf_(v0[e]); v1[e] = tanhf_(v1[e]); } }
                else if (col >= PC_LG) { _Pragma("unroll") for (int e = 0; e < 4; ++e) { v0[e] = sigmoidf_(v0[e]); v1[e] = sigmoidf_(v1[e]); } }
            } else if (u.pn >= 10) { _Pragma("unroll") for (int e = 0; e < 4; ++e) { v0[e] = sigmoidf_(v0[e]); v1[e] = sigmoidf_(v1[e]); } }
            store8(P + (size_t)row * DIN + col, v0, v1);
        )
    } };
#define DPPM(x, ctrl) (x) *= __builtin_bit_cast(float, __builtin_amdgcn_update_dpp(0x3f800000, __builtin_bit_cast(int, (x)), (ctrl), 0xF, 0xF, false))
struct EpiWAF { static constexpr int MID_T = -1; GAS f16* WA; const GAS float* w0; const GAS float* a0;
    template <int HA> __device__ __forceinline__ void run(const Acc& acc, const Unit& u, int wr, int wc, int fr, int fq) const {
        PG8_EPI_LOOP(
            if (col < 1024) { const f32x4 b0 = *(const GAS f32x4*)(w0 + col), b1 = *(const GAS f32x4*)(w0 + col + 4);
                float x[8];
                _Pragma("unroll") for (int e = 0; e < 4; ++e) { x[e] = __expf(-0.606531f * sigmoidf_(v0[e] + b0[e])); x[4 + e] = __expf(-0.606531f * sigmoidf_(v1[e] + b1[e])); }
                if (col < 512) {
                    _Pragma("unroll") for (int e = 0; e < 8; ++e) { DPPM(x[e], 0x111); DPPM(x[e], 0x112); DPPM(x[e], 0x114); DPPM(x[e], 0x118);
                        const float wm = __builtin_bit_cast(float, __builtin_amdgcn_ds_swizzle(__builtin_bit_cast(int, x[e]), 0x00F0)); x[e] = (fr == 7) ? wm : x[e] * __builtin_amdgcn_rcpf(wm); }
                } else {
                    _Pragma("unroll") for (int e = 0; e < 8; ++e) { DPPM(x[e], 0x101); DPPM(x[e], 0x102); DPPM(x[e], 0x104); DPPM(x[e], 0x108);
                        const float wm = __builtin_bit_cast(float, __builtin_amdgcn_ds_swizzle(__builtin_bit_cast(int, x[e]), 0x0110)); x[e] = (fr == 8) ? wm : x[e] * __builtin_amdgcn_rcpf(wm); }
                }
                _Pragma("unroll") for (int e = 0; e < 4; ++e) { v0[e] = x[e]; v1[e] = x[4 + e]; } }
            else { const f32x4 b0 = *(const GAS f32x4*)(a0 + col - 1024), b1 = *(const GAS f32x4*)(a0 + col - 1024 + 4);
                _Pragma("unroll") for (int e = 0; e < 4; ++e) { v0[e] = sigmoidf_(v0[e] + b0[e]); v1[e] = sigmoidf_(v1[e] + b1[e]); } }
            store8(WA + (size_t)row * 2048 + col, v0, v1);
        )
    } };
struct EpiF16F { static constexpr int MID_T = -1; GAS f16* O; int ld;
    template <int HA> __device__ __forceinline__ void run(const Acc& acc, const Unit& u, int wr, int wc, int fr, int fq) const {
        PG8_EPI_LOOP( store8(O + (size_t)row * ld + col, v0, v1); )
    } };
struct EpiRelu2F { static constexpr int MID_T = -1; GAS f16* O; int ld;
    template <int HA> __device__ __forceinline__ void run(const Acc& acc, const Unit& u, int wr, int wc, int fr, int fq) const {
        PG8_EPI_LOOP(
            _Pragma("unroll") for (int e = 0; e < 4; ++e) { const float a = fmaxf(v0[e], 0.f), b = fmaxf(v1[e], 0.f); v0[e] = a * a; v1[e] = b * b; }
            store8(O + (size_t)row * ld + col, v0, v1);
        )
    } };
struct EpiMergeF { static constexpr int MID_T = 8; GAS f16* MG; const GAS f16* PROJ;
    template <int HA> __device__ __forceinline__ void mid(Acc& acc, const Unit& u, int wr, int wc, int fr, int fq) const {
        const int row0 = u.pm * (2 * HA) + wr * (HA / 2) + fr, col0 = u.pn * BM + wc * 32 + 8 * fq;
#pragma unroll
        for (int ai = 0; ai < 2; ++ai)
#pragma unroll
            for (int m = 0; m < HA / 32; ++m) { const int row = row0 + ai * HA + m * 16;
#pragma unroll
                for (int bj = 0; bj < 2; ++bj) { const int col = col0 + bj * HALF;
                    const f16x8 gr = *(const GAS f16x8*)(PROJ + (size_t)row * DIN + PC_GR + col), ga = *(const GAS f16x8*)(PROJ + (size_t)row * DIN + PC_GA + col);
#pragma unroll
                    for (int e = 0; e < 4; ++e) { acc[ai][bj][m][0][e] *= (float)gr[e] * __builtin_amdgcn_rcpf(fmaxf((float)ga[e], 1e-4f)); acc[ai][bj][m][1][e] *= (float)gr[4 + e] * __builtin_amdgcn_rcpf(fmaxf((float)ga[4 + e], 1e-4f)); } }
                asm volatile("" ::: "memory"); }
    }
    template <int HA> __device__ __forceinline__ void run(const Acc& acc, const Unit& u, int wr, int wc, int fr, int fq) const {
        PG8_EPI_LOOP(
            const f16x8 ga = *(const GAS f16x8*)(PROJ + (size_t)row * DIN + PC_GA + col);
            _Pragma("unroll") for (int e = 0; e < 4; ++e) { v0[e] *= fmaxf((float)ga[e], 1e-4f); v1[e] *= fmaxf((float)ga[4 + e], 1e-4f); }
            store8(MG + (size_t)row * D + col, v0, v1);
        )
    } };
}

__device__ __forceinline__ void kv_prep(const Params& p0, const Ctx& c0, int l) {
    const Ctx c = fresh(c0); FRESH_P(p0);
    const GAS f16* PROJ = (const GAS f16*)(p.ws + WS_R1); GAS f16* KN = (GAS f16*)(p.ws + WS_KN); GAS f16* VT = (GAS f16*)(p.ws + WS_VT);
    const int d = c.lane;
    const float kg = IN(27)[l * HD + d];
    const int axis = d >> 5, half = (d >> 4) & 1, f = d & 15;
    const float freq = exp2f(-(float)f * (13.287712379549449f / 16.0f));
    for (int it = c.gw; it < (M / 8) * 2; it += c.ngw) {
        const int kvh = it & 1, row0 = (it >> 1) * 8;
        float kx[8], vx[8];
#pragma unroll
        for (int r = 0; r < 8; ++r) { const GAS f16* pr = PROJ + (size_t)(row0 + r) * DIN + kvh * HD + d; kx[r] = (float)pr[PC_KA]; vx[r] = (float)pr[PC_VA]; }
#pragma unroll
        for (int r = 0; r < 8; ++r) kx[r] = kx[r] * rsqrtf(wave_sum(kx[r] * kx[r]) * (1.0f / HD) + 1e-6f) * kg;
        f16x8 vv;
#pragma unroll
        for (int r = 0; r < 8; ++r) vv[r] = (f16)vx[r];
        if (row0 < M_CTX) { const int b = row0 >> 8, t0 = row0 & 255;
#pragma unroll
            for (int r = 0; r < 8; ++r) { const size_t o = ((((size_t)b * NL + l) * T_CTX + t0 + r) * 2 + kvh) * HD + d;
                p.out[O_CK + o] = kx[r]; p.out[O_CV + o] = vx[r];
                KN[(((size_t)b * 2 + kvh) * T_CTX + t0 + r) * HD + d] = (f16)kx[r]; }
            *(GAS f16x8*)(VT + (((size_t)b * 2 + kvh) * HD + d) * T_CTX + t0) = vv;
        } else { const int rr = row0 - M_CTX, b = rr >> 10, t0 = rr & 1023;
#pragma unroll
            for (int r = 0; r < 8; ++r) { const int t = t0 + r; const float pos = (float)(axis == 0 ? (t >> 6) : (t & 63));
                const float ang = pos * freq; const float cs = __cosf(ang), sn = __sinf(ang);
                const float other = xor16(kx[r]);
                const float ko = half == 0 ? kx[r] * cs - other * sn : kx[r] * cs + other * sn;
                KN[KN_SMP_OFF + (((size_t)b * 2 + kvh) * KV_SMP + PAST + t) * HD + d] = (f16)ko; }
            *(GAS f16x8*)(VT + KN_SMP_OFF + (((size_t)b * 2 + kvh) * HD + d) * KV_SMP + PAST + t0) = vv;
        }
    }
    for (int it = c.gw; it < B_SMP * (PAST / 8) * 2; it += c.ngw) {
        const int kvh = it & 1, j0 = ((it >> 1) & 31) * 8, b = it >> 6;
        f16x8 vv;
#pragma unroll
        for (int r = 0; r < 8; ++r) { const size_t s = ((((size_t)b * NL + l) * PAST + j0 + r) * 2 + kvh) * HD + d;
            KN[KN_SMP_OFF + (((size_t)b * 2 + kvh) * KV_SMP + j0 + r) * HD + d] = (f16)IN(2)[s]; vv[r] = (f16)IN(3)[s]; }
        *(GAS f16x8*)(VT + KN_SMP_OFF + (((size_t)b * 2 + kvh) * HD + d) * KV_SMP + j0) = vv;
    }
}

constexpr int TC = 32, ST_STEP = 6 * 64, ST_BUF = TC * ST_STEP;
struct StageRegs { f16x4 r[3], k[3], v[3], w, a; };
__device__ __forceinline__ void scan_task(const DParams& p, const Ctx& c, int l, int task) {
    const GAS f16* PROJ = (const GAS f16*)(p.ws + WS_R1); const GAS f16* WA = (const GAS f16*)(p.ws + WS_R2);
    GAS f16* Y = (GAS f16*)(p.ws + WS_R3); GAS float* RK = (GAS float*)(p.ws + WS_RK);
    LAS float* st = (LAS float*)c.lds;
    int sq, dir, h;
    if (task < 64) { h = task & 7; dir = (task >> 3) & 1; sq = B_CTX + (task >> 4); } else { const int id = task - 64; h = id & 7; dir = (id >> 3) & 1; sq = id >> 4; }
    const bool smp = sq >= B_CTX; const int T = smp ? T_SMP : T_CTX; const int row0 = smp ? M_CTX + (sq - B_CTX) * T_SMP : sq * T_CTX;
    const int nch = T / TC;
    const int tt = c.tid >> 4, cq = c.tid & 15, ch0 = h * HD + cq * 4;
    const f32x4 mu_r = *(const GAS f32x4*)(IN(15) + (l * 3 + 0) * CW + ch0), mu_k = *(const GAS f32x4*)(IN(15) + (l * 3 + 1) * CW + ch0), mu_v = *(const GAS f32x4*)(IN(15) + (l * 3 + 2) * CW + ch0);
    const f32x4 k_k = *(const GAS f32x4*)(IN(16) + l * CW + ch0), k_a = *(const GAS f32x4*)(IN(17) + l * CW + ch0), r_k = *(const GAS f32x4*)(IN(18) + l * CW + ch0);
    const int ks = c.lane & 7, srow = c.wave * 8 + (c.lane >> 3);
    float S[8];
    if (smp) { const GAS float* s0 = IN(4) + (((((size_t)(sq - B_CTX) * NL + l) * 2 + dir) * NH + h) * HD + srow) * HD + ks * 8;
        const f32x4 a = *(const GAS f32x4*)s0, b = *(const GAS f32x4*)(s0 + 4);
        S[0] = a[0]; S[1] = a[1]; S[2] = a[2]; S[3] = a[3]; S[4] = b[0]; S[5] = b[1]; S[6] = b[2]; S[7] = b[3];
    } else {
#pragma unroll
        for (int j = 0; j < 8; ++j) S[j] = 0.f;
    }
    StageRegs sr;
    const f16x4 z4 = {(f16)0.f, (f16)0.f, (f16)0.f, (f16)0.f};
#define SCAN_LOAD(chunk) do { const int S_ = (chunk) * TC + tt; const int t_ = dir ? T - 1 - S_ : S_; const GAS f16* pr_ = PROJ + (size_t)(row0 + t_) * DIN + ch0; \
        sr.r[1] = *(const GAS f16x4*)(pr_ + PC_R); sr.k[1] = *(const GAS f16x4*)(pr_ + PC_K); sr.v[1] = *(const GAS f16x4*)(pr_ + PC_V); \
        if (t_ > 0) { sr.r[0] = *(const GAS f16x4*)(pr_ - DIN + PC_R); sr.k[0] = *(const GAS f16x4*)(pr_ - DIN + PC_K); sr.v[0] = *(const GAS f16x4*)(pr_ - DIN + PC_V); } else { sr.r[0] = z4; sr.k[0] = z4; sr.v[0] = z4; } \
        if (t_ < T - 1) { sr.r[2] = *(const GAS f16x4*)(pr_ + DIN + PC_R); sr.k[2] = *(const GAS f16x4*)(pr_ + DIN + PC_K); sr.v[2] = *(const GAS f16x4*)(pr_ + DIN + PC_V); } else { sr.r[2] = z4; sr.k[2] = z4; sr.v[2] = z4; } \
        const GAS f16* wa_ = WA + (size_t)(row0 + t_) * 2048 + dir * 512 + ch0; sr.w = *(const GAS f16x4*)wa_; sr.a = *(const GAS f16x4*)(wa_ + 1024); } while (0)
#define SCAN_STAGE(chunk) do { const int S_ = (chunk) * TC + tt; const int t_ = dir ? T - 1 - S_ : S_; \
        f32x4 r_, k_, v_, kk_, w_, a_, kh_, kt_, b_; float ss_ = 0.f, rk_ = 0.f; \
        _Pragma("unroll") for (int e = 0; e < 4; ++e) { const float rc = (float)sr.r[1][e], kc = (float)sr.k[1][e], vc = (float)sr.v[1][e]; \
            r_[e] = rc + mu_r[e] * (0.5f * ((float)sr.r[0][e] + (float)sr.r[2][e]) - rc); k_[e] = kc + mu_k[e] * (0.5f * ((float)sr.k[0][e] + (float)sr.k[2][e]) - kc); \
            v_[e] = vc + mu_v[e] * (0.5f * ((float)sr.v[0][e] + (float)sr.v[2][e]) - vc); kk_[e] = k_[e] * k_k[e]; ss_ += kk_[e] * kk_[e]; w_[e] = (float)sr.w[e]; a_[e] = (float)sr.a[e]; } \
        ss_ = dpp_sum16(ss_); const float ri_ = rsqrtf(ss_ + 1e-12f); \
        _Pragma("unroll") for (int e = 0; e < 4; ++e) { kh_[e] = kk_[e] * ri_; kt_[e] = k_[e] * (1.0f + (a_[e] - 1.0f) * k_a[e]); b_[e] = a_[e] * kh_[e]; rk_ += r_[e] * kt_[e] * r_k[e]; } \
        rk_ = dpp_sum16(rk_); if (cq == 0) RK[((size_t)dir * M + row0 + t_) * 8 + h] = rk_; \
        LAS float* sb_ = st + ((chunk) & 1) * ST_BUF + tt * ST_STEP + cq * 4; \
        *(LAS f32x4*)(sb_) = kh_; *(LAS f32x4*)(sb_ + 64) = w_; *(LAS f32x4*)(sb_ + 128) = b_; *(LAS f32x4*)(sb_ + 192) = kt_; *(LAS f32x4*)(sb_ + 256) = r_; *(LAS f32x4*)(sb_ + 320) = v_; } while (0)
    SCAN_LOAD(0);
    SCAN_STAGE(0);
    __syncthreads();
    for (int chunk = 0; chunk < nch; ++chunk) {
        if (chunk + 1 < nch) SCAN_LOAD(chunk + 1);
        const LAS float* sb = st + (chunk & 1) * ST_BUF + ks * 8;
        const LAS float* vb = st + (chunk & 1) * ST_BUF + 320 + srow;
#pragma unroll 2
        for (int s = 0; s < TC; ++s) {
            const LAS float* q = sb + s * ST_STEP;
            const f32x4 kh0 = *(const LAS f32x4*)(q), kh1 = *(const LAS f32x4*)(q + 4);
            const f32x4 w0 = *(const LAS f32x4*)(q + 64), w1 = *(const LAS f32x4*)(q + 68);
            const f32x4 b0 = *(const LAS f32x4*)(q + 128), b1 = *(const LAS f32x4*)(q + 132);
            const f32x4 t0 = *(const LAS f32x4*)(q + 192), t1 = *(const LAS f32x4*)(q + 196);
            const f32x4 r0 = *(const LAS f32x4*)(q + 256), r1 = *(const LAS f32x4*)(q + 260);
            const float v = vb[s * ST_STEP];
            float sk = (S[0] * kh0[0] + S[1] * kh0[1]) + (S[2] * kh0[2] + S[3] * kh0[3]) + ((S[4] * kh1[0] + S[5] * kh1[1]) + (S[6] * kh1[2] + S[7] * kh1[3]));
            sk = dpp_sum8(sk);
#pragma unroll
            for (int e = 0; e < 4; ++e) { S[e] = S[e] * w0[e] + (v * t0[e] - sk * b0[e]); S[4 + e] = S[4 + e] * w1[e] + (v * t1[e] - sk * b1[e]); }
            float y = (S[0] * r0[0] + S[1] * r0[1]) + (S[2] * r0[2] + S[3] * r0[3]) + ((S[4] * r1[0] + S[5] * r1[1]) + (S[6] * r1[2] + S[7] * r1[3]));
            y = dpp_sum8(y);
            const int Sg = chunk * TC + s; const int t = dir ? T - 1 - Sg : Sg;
            if (ks == 0) Y[((size_t)dir * M + row0 + t) * CW + h * HD + srow] = (f16)y;
        }
        if (chunk + 1 < nch) SCAN_STAGE(chunk + 1);
        __syncthreads();
    }
#undef SCAN_LOAD
#undef SCAN_STAGE
    if (!smp) { GAS float* so = p.out + O_ST + (((((size_t)sq * NL + l) * 2 + dir) * NH + h) * HD + srow) * HD + ks * 8;
        *(GAS f32x4*)so = (f32x4){S[0], S[1], S[2], S[3]}; *(GAS f32x4*)(so + 4) = (f32x4){S[4], S[5], S[6], S[7]}; }
}
__device__ __forceinline__ void fast_scan(const Params& p0, const Ctx& c0, int l) {
    const Ctx c = fresh(c0); FRESH_P(p0);
    const int b = c.bid;
    if (b < 64) scan_task(p, c, l, b);
    else for (int task = b; task < 576; task += 192) scan_task(p, c, l, task);
}


namespace ms {
constexpr int O_AM = 0, O_BM = 4608, O_AT = 9216, O_VP = 14336, O_GT = 19456, O_NF = 22016, O_WM = 23040, O_WE = 23296, BUF = 23552;
constexpr int RS = 144, RT = 80;
}
__device__ __forceinline__ void mscan_task(const DParams& p, const Ctx& c, int l, int task) {
    using namespace ms;
    const GAS f16* PROJ = (const GAS f16*)(p.ws + WS_R1); const GAS f16* WA = (const GAS f16*)(p.ws + WS_R2);
    GAS f16* Y = (GAS f16*)(p.ws + WS_R3); GAS float* RK = (GAS float*)(p.ws + WS_RK);
    int sq, dir, h;
    if (task < 64) { h = task & 7; dir = (task >> 3) & 1; sq = B_CTX + (task >> 4); } else { const int id = task - 64; h = id & 7; dir = (id >> 3) & 1; sq = id >> 4; }
    const bool smp = sq >= B_CTX; const int T = smp ? T_SMP : T_CTX; const int row0 = smp ? M_CTX + (sq - B_CTX) * T_SMP : sq * T_CTX;
    const int nch = T / 16;
    const int vl = c.lane & 31, hh = c.lane >> 5;
    const int tq = c.tid - 128, ss = (tq >> 4) & 15, cq = tq & 15, k0 = cq * 4, ch0 = h * HD + k0;
    LAS float* cst = (LAS float*)(c.lds + 3 * BUF);
    if (c.wave == 7) { const int chn_ = h * HD + c.lane;
        cst[c.lane] = IN(15)[(l * 3 + 0) * CW + chn_]; cst[64 + c.lane] = IN(15)[(l * 3 + 1) * CW + chn_]; cst[128 + c.lane] = IN(15)[(l * 3 + 2) * CW + chn_];
        cst[192 + c.lane] = IN(16)[l * CW + chn_]; cst[256 + c.lane] = IN(17)[l * CW + chn_]; cst[320 + c.lane] = IN(18)[l * CW + chn_]; }

#define MS_BARRIER() do { asm volatile("s_waitcnt lgkmcnt(0)" ::: "memory"); __builtin_amdgcn_s_barrier(); asm volatile("" ::: "memory"); } while (0)
    if (c.wave >= 2 && c.wave < 6) {
    f16x4 G_rc, G_kc, G_vc, G_rp, G_kp, G_vp, G_rn, G_kn, G_vn, G_av, G_wo, G_wp, G_w7;
    { const f16x4 z4 = {(f16)0.f, (f16)0.f, (f16)0.f, (f16)0.f}; G_rc = G_kc = G_vc = G_rp = G_kp = G_vp = G_rn = G_kn = G_vn = G_av = G_wo = G_wp = G_w7 = z4; }
        for (int it = -3; it < nch; ++it) {
            const int ch = it + 2;
            if (ch >= 0 && ch < nch) {
                LAS unsigned char* buf = c.lds + (ch % 3) * BUF;
                const int Sg = ch * 16 + ss; const int t = dir ? T - 1 - Sg : Sg; const size_t row = (size_t)row0 + t;
                const f32x4 mu_r = *(const LAS f32x4*)(cst + k0), mu_k = *(const LAS f32x4*)(cst + 64 + k0), mu_v = *(const LAS f32x4*)(cst + 128 + k0), k_k = *(const LAS f32x4*)(cst + 192 + k0), k_a = *(const LAS f32x4*)(cst + 256 + k0), r_k = *(const LAS f32x4*)(cst + 320 + k0);
                f32x4 r_, k_, v_, kk_, kh_, kt_, b_; float sq_ = 0.f, rk_ = 0.f;
#pragma unroll
                for (int e = 0; e < 4; ++e) { const float rcf = (float)G_rc[e], kcf = (float)G_kc[e], vcf = (float)G_vc[e];
                    r_[e] = rcf + mu_r[e] * (0.5f * ((float)G_rp[e] + (float)G_rn[e]) - rcf); k_[e] = kcf + mu_k[e] * (0.5f * ((float)G_kp[e] + (float)G_kn[e]) - kcf);
                    v_[e] = vcf + mu_v[e] * (0.5f * ((float)G_vp[e] + (float)G_vn[e]) - vcf); kk_[e] = k_[e] * k_k[e]; sq_ += kk_[e] * kk_[e]; }
                sq_ = dpp_sum16(sq_); const float ri_ = rsqrtf(sq_ + 1e-12f);
#pragma unroll
                for (int e = 0; e < 4; ++e) { const float a_ = (float)G_av[e]; kh_[e] = kk_[e] * ri_; kt_[e] = k_[e] * (1.0f + (a_ - 1.0f) * k_a[e]); b_[e] = a_ * kh_[e]; rk_ += r_[e] * kt_[e] * r_k[e]; }
                rk_ = dpp_sum16(rk_); if (cq == 0) RK[((size_t)dir * M + row) * 8 + h] = rk_;
                float al[4], be[4], ka[4], rho[4];
#pragma unroll
                for (int e = 0; e < 4; ++e) { const float wm7 = (float)G_w7[e]; const float om = ss == 7 ? 1.0f : (float)G_wo[e]; const float omp = ss == 0 ? __builtin_amdgcn_rcpf(wm7) : (ss == 8 ? 1.0f : (float)G_wp[e]);
                    const float iom = __builtin_amdgcn_rcpf(om); al[e] = omp * kh_[e]; be[e] = b_[e] * iom; ka[e] = kt_[e] * iom; rho[e] = om * r_[e]; }
                v2u w2;
                w2.x = pkh(al[0], al[1]); w2.y = pkh(al[2], al[3]); *(LAS v2u*)(buf + O_BM + ss * RS + k0 * 2) = w2;
                w2.x = pkh(rho[0], rho[1]); w2.y = pkh(rho[2], rho[3]); *(LAS v2u*)(buf + O_BM + (16 + ss) * RS + k0 * 2) = w2;
                w2.x = pkh(be[0], be[1]); w2.y = pkh(be[2], be[3]); *(LAS v2u*)(buf + O_AM + ss * RS + k0 * 2) = w2;
                w2.x = pkh(ka[0], ka[1]); w2.y = pkh(ka[2], ka[3]); *(LAS v2u*)(buf + O_AM + (16 + ss) * RS + k0 * 2) = w2;
#pragma unroll
                for (int e = 0; e < 4; ++e) { *(LAS f16*)(buf + O_AT + (k0 + e) * RT + ss * 2) = (f16)ka[e]; *(LAS f16*)(buf + O_AT + (k0 + e) * RT + (16 + ss) * 2) = (f16)be[e];
                    *(LAS f16*)(buf + O_VP + (k0 + e) * RT + ss * 2) = (f16)v_[e]; }
                if (ss == 15) { f32x4 wm_, we_;
#pragma unroll
                    for (int e = 0; e < 4; ++e) { wm_[e] = (float)G_w7[e]; we_[e] = (float)G_wo[e]; }
                    *(LAS f32x4*)(buf + O_WM + k0 * 4) = wm_; *(LAS f32x4*)(buf + O_WE + k0 * 4) = we_; }
            }
            const int chn = it + 3;
            if (chn < nch) {
                const int Sg = chn * 16 + ss; const int t = dir ? T - 1 - Sg : Sg; const size_t row = (size_t)row0 + t;
                const GAS f16* pr = PROJ + row * DIN + ch0;
                const f16x4 z4 = {(f16)0.f, (f16)0.f, (f16)0.f, (f16)0.f};
                G_rc = *(const GAS f16x4*)(pr + PC_R); G_kc = *(const GAS f16x4*)(pr + PC_K); G_vc = *(const GAS f16x4*)(pr + PC_V);
                G_rp = z4; G_kp = z4; G_vp = z4; G_rn = z4; G_kn = z4; G_vn = z4;
                if (t > 0) { G_rp = *(const GAS f16x4*)(pr - DIN + PC_R); G_kp = *(const GAS f16x4*)(pr - DIN + PC_K); G_vp = *(const GAS f16x4*)(pr - DIN + PC_V); }
                if (t < T - 1) { G_rn = *(const GAS f16x4*)(pr + DIN + PC_R); G_kn = *(const GAS f16x4*)(pr + DIN + PC_K); G_vn = *(const GAS f16x4*)(pr + DIN + PC_V); }
                G_av = *(const GAS f16x4*)(WA + row * 2048 + 1024 + dir * 512 + ch0);
                const GAS f16* wo = WA + row * 2048 + dir * 512 + ch0;
                G_wo = *(const GAS f16x4*)wo; G_wp = *(const GAS f16x4*)(wo + (ss > 0 ? (dir ? 2048 : -2048) : 0)); G_w7 = *(const GAS f16x4*)(wo + (long)(7 - ss) * (dir ? -2048 : 2048));
            }
            MS_BARRIER();
        }
    } else if (c.wave == 6) {
        for (int it = -3; it < nch; ++it) {
            const int ch = it + 1;
            if (ch >= 0 && ch < nch) {
                LAS unsigned char* buf = c.lds + (ch % 3) * BUF;
                f32x16 g;
#pragma unroll
                for (int i = 0; i < 16; ++i) g[i] = 0.f;
#pragma unroll
                for (int s = 0; s < 4; ++s) { const f16x8 a = *(const LAS f16x8*)(buf + O_AM + vl * RS + (16 * s + 8 * hh) * 2), b = *(const LAS f16x8*)(buf + O_BM + vl * RS + (16 * s + 8 * hh) * 2);
                    g = __builtin_amdgcn_mfma_f32_32x32x16_f16(a, b, g, 0, 0, 0); }
                const int tcol = vl & 15; const bool incl = vl >= 16;
#pragma unroll
                for (int gq = 0; gq < 4; ++gq) { float o[4];
#pragma unroll
                    for (int e = 0; e < 4; ++e) { const int ip = 8 * gq + 4 * hh + e, i = ip & 15; const bool ok = incl ? (i <= tcol) : (i < tcol); o[e] = ok ? g[4 * gq + e] : 0.f; }
                    v2u w2; w2.x = pkh(o[0], o[1]); w2.y = pkh(o[2], o[3]);
                    *(LAS v2u*)(buf + O_GT + vl * RT + (8 * gq + 4 * hh) * 2) = w2;
                    if (gq < 2 && vl < 16) *(LAS f32x4*)(buf + O_NF + vl * 64 + (8 * gq + 4 * hh) * 4) = (f32x4){o[0], o[1], o[2], o[3]}; }
            }
            MS_BARRIER();
        }
    } else if (c.wave == 7) {
        for (int it = -3; it < nch; ++it) MS_BARRIER();
    } else {
    f32x16 St0, St1;
#pragma unroll
    for (int i = 0; i < 16; ++i) { St0[i] = 0.f; St1[i] = 0.f; }
    if (smp) { float one_ = 1.0f; asm volatile("" : "+v"(one_));
        const GAS float* s0 = IN(4) + (((((size_t)(sq - B_CTX) * NL + l) * 2 + dir) * NH + h) * HD + 32 * c.wave + vl) * HD + 4 * hh;
#pragma unroll
        for (int g = 0; g < 4; ++g) { const f32x4 a = *(const GAS f32x4*)(s0 + 8 * g), b = *(const GAS f32x4*)(s0 + 32 + 8 * g);
#pragma unroll
            for (int e = 0; e < 4; ++e) { St0[4 * g + e] = a[e] * one_; St1[4 * g + e] = b[e] * one_; } }
    }
        for (int it = -3; it < nch; ++it) {
            const int ch = it;
            if (ch >= 0) {
                LAS unsigned char* buf = c.lds + (ch % 3) * BUF;
                const int v = 32 * c.wave + vl;
                if (ch == 0) {
#pragma unroll
                for (int gq = 0; gq < 4; ++gq) { const f32x4 m0 = *(const LAS f32x4*)(buf + O_WM + (8 * gq + 4 * hh) * 4), m1 = *(const LAS f32x4*)(buf + O_WM + (32 + 8 * gq + 4 * hh) * 4);
#pragma unroll
                    for (int e = 0; e < 4; ++e) { St0[4 * gq + e] *= m0[e]; St1[4 * gq + e] *= m1[e]; } }
                }
                f32x16 X;
#pragma unroll
                for (int i = 0; i < 16; ++i) X[i] = 0.f;
#pragma unroll
                for (int s = 0; s < 4; ++s) {
                    f16x8 sb;
#pragma unroll
                    for (int j = 0; j < 8; ++j) sb[j] = (f16)((s < 2) ? St0[8 * (s & 1) + j] : St1[8 * (s & 1) + j]);
                    const f16x4 lo = *(const LAS f16x4*)(buf + O_BM + vl * RS + (16 * s + 4 * hh) * 2), hi = *(const LAS f16x4*)(buf + O_BM + vl * RS + (16 * s + 8 + 4 * hh) * 2);
                    const f16x8 af = {lo[0], lo[1], lo[2], lo[3], hi[0], hi[1], hi[2], hi[3]};
                    X = __builtin_amdgcn_mfma_f32_32x32x16_f16(af, sb, X, 0, 0, 0);
                }
                { const f16x8 a = *(const LAS f16x8*)(buf + O_GT + vl * RT + (16 + 8 * hh) * 2), b = *(const LAS f16x8*)(buf + O_VP + v * RT + (8 * hh) * 2);
                  X = __builtin_amdgcn_mfma_f32_32x32x16_f16(a, b, X, 0, 0, 0); }
                const f16x8 aN = *(const LAS f16x8*)(buf + O_GT + vl * RT + (8 * hh) * 2);
                f16x8 pball;
#pragma unroll
                for (int j = 0; j < 8; ++j) pball[j] = (f16)0.f;
#define MS_BLK(a) do { const int xo_ = 4 * ((a) >> 1); \
                    const f32x4 n1_ = *(const LAS f32x4*)(buf + O_NF + (4 * (a) + 1) * 64 + 16 * (a)), n2_ = *(const LAS f32x4*)(buf + O_NF + (4 * (a) + 2) * 64 + 16 * (a)), n3_ = *(const LAS f32x4*)(buf + O_NF + (4 * (a) + 3) * 64 + 16 * (a)); \
                    float q0_ = X[xo_]; float q1_ = X[xo_ + 1] - q0_ * n1_[0]; float q2_ = X[xo_ + 2] - q0_ * n2_[0] - q1_ * n2_[1]; float q3_ = X[xo_ + 3] - q0_ * n3_[0] - q1_ * n3_[1] - q2_ * n3_[2]; \
                    if (((a) & 1) != ((a) >> 1)) { float a_, b_; \
                        a_ = q0_; b_ = q0_; swap32(a_, b_); q0_ = ((a) & 1) ? b_ : a_; a_ = q1_; b_ = q1_; swap32(a_, b_); q1_ = ((a) & 1) ? b_ : a_; \
                        a_ = q2_; b_ = q2_; swap32(a_, b_); q2_ = ((a) & 1) ? b_ : a_; a_ = q3_; b_ = q3_; swap32(a_, b_); q3_ = ((a) & 1) ? b_ : a_; } \
                    const bool hold_ = hh == ((a) >> 1); \
                    const f16 z_ = (f16)0.f; const f16 e0_ = hold_ ? (f16)(-q0_) : z_, e1_ = hold_ ? (f16)(-q1_) : z_, e2_ = hold_ ? (f16)(-q2_) : z_, e3_ = hold_ ? (f16)(-q3_) : z_; \
                    f16x8 pb_ = {z_, z_, z_, z_, z_, z_, z_, z_}; \
                    pb_[4 * ((a) & 1)] = e0_; pb_[4 * ((a) & 1) + 1] = e1_; pb_[4 * ((a) & 1) + 2] = e2_; pb_[4 * ((a) & 1) + 3] = e3_; \
                    if (hold_) { pball[4 * ((a) & 1)] = e0_; pball[4 * ((a) & 1) + 1] = e1_; pball[4 * ((a) & 1) + 2] = e2_; pball[4 * ((a) & 1) + 3] = e3_; } \
                    X = __builtin_amdgcn_mfma_f32_32x32x16_f16(aN, pb_, X, 0, 0, 0); } while (0)
                MS_BLK(0); MS_BLK(1); MS_BLK(2); MS_BLK(3);
#undef MS_BLK
#pragma unroll
                for (int r = 8; r < 16; ++r) { const int t = (r & 3) + 8 * ((r >> 2) - 2) + 4 * hh; const int Sg = ch * 16 + t; const int tok = dir ? T - 1 - Sg : Sg;
                    Y[((size_t)dir * M + row0 + tok) * CW + h * HD + v] = (f16)X[r]; }
#pragma unroll
                for (int s2 = 0; s2 < 2; ++s2) { const f16x8 b = s2 == 0 ? *(const LAS f16x8*)(buf + O_VP + v * RT + (8 * hh) * 2) : pball;
                    const f16x8 a0 = *(const LAS f16x8*)(buf + O_AT + vl * RT + (16 * s2 + 8 * hh) * 2), a1 = *(const LAS f16x8*)(buf + O_AT + (32 + vl) * RT + (16 * s2 + 8 * hh) * 2);
                    St0 = __builtin_amdgcn_mfma_f32_32x32x16_f16(a0, b, St0, 0, 0, 0); St1 = __builtin_amdgcn_mfma_f32_32x32x16_f16(a1, b, St1, 0, 0, 0); }
                { LAS unsigned char* nbuf = c.lds + ((ch + 1) % 3) * BUF; const bool more = ch + 1 < nch;
#pragma unroll
                for (int gq = 0; gq < 4; ++gq) { f32x4 m0 = *(const LAS f32x4*)(buf + O_WE + (8 * gq + 4 * hh) * 4), m1 = *(const LAS f32x4*)(buf + O_WE + (32 + 8 * gq + 4 * hh) * 4);
                    if (more) { m0 *= *(const LAS f32x4*)(nbuf + O_WM + (8 * gq + 4 * hh) * 4); m1 *= *(const LAS f32x4*)(nbuf + O_WM + (32 + 8 * gq + 4 * hh) * 4); }
#pragma unroll
                    for (int e = 0; e < 4; ++e) { St0[4 * gq + e] *= m0[e]; St1[4 * gq + e] *= m1[e]; } } }
            }
            MS_BARRIER();
        }
    if (!smp) {
        GAS float* so = p.out + O_ST + (((((size_t)sq * NL + l) * 2 + dir) * NH + h) * HD + 32 * c.wave + vl) * HD + 4 * hh;
#pragma unroll
        for (int g = 0; g < 4; ++g) { *(GAS f32x4*)(so + 8 * g) = (f32x4){St0[4 * g], St0[4 * g + 1], St0[4 * g + 2], St0[4 * g + 3]};
            *(GAS f32x4*)(so + 32 + 8 * g) = (f32x4){St1[4 * g], St1[4 * g + 1], St1[4 * g + 2], St1[4 * g + 3]}; }
    }
    }
#undef MS_BARRIER
}
__device__ __forceinline__ void mfma_scan(const Params& p0, const Ctx& c0, int l) {
    const Ctx c = fresh(c0); FRESH_P(p0);
    const int b = c.bid;
    const int step = b < 64 ? 576 : 192;
#pragma nounroll
    for (int task = b; task < 576; task += step) mscan_task(p, c, l, task);
}

__device__ __forceinline__ int swap23(int r) { return (r & ~12) | ((r & 4) << 1) | ((r & 8) >> 1); }
__device__ __forceinline__ void attn_wave_task(const DParams& p, const Ctx& c, int l, int task) {
    const GAS f16* PROJ = (const GAS f16*)(p.ws + WS_R1); const GAS f16* KN = (const GAS f16*)(p.ws + WS_KN); const GAS f16* VT = (const GAS f16*)(p.ws + WS_VT);
    GAS f16* OA = (GAS f16*)(p.ws + WS_R4);
    const int hq = task & 7, qb = task >> 3, kvh = hq >> 2;
    const int r32 = c.lane & 31, hh = c.lane >> 5;
    int rowq0, L; const GAS f16* Kb; const GAS f16* Vb; bool smp;
    if (qb < 128) { smp = true; rowq0 = M_CTX + qb * 32; const int b = qb >> 5; L = KV_SMP;
        Kb = KN + KN_SMP_OFF + ((size_t)b * 2 + kvh) * KV_SMP * HD; Vb = VT + KN_SMP_OFF + ((size_t)b * 2 + kvh) * HD * KV_SMP; }
    else { smp = false; rowq0 = (qb - 128) * 32; const int b = rowq0 >> 8; L = T_CTX;
        Kb = KN + ((size_t)b * 2 + kvh) * T_CTX * HD; Vb = VT + ((size_t)b * 2 + kvh) * HD * T_CTX; }
    const int row = rowq0 + r32;
    float x[4][8]; float ss = 0.f;
#pragma unroll
    for (int s = 0; s < 4; ++s) { const f16x8 q = *(const GAS f16x8*)(PROJ + (size_t)row * DIN + PC_Q + hq * HD + 16 * s + 8 * hh);
#pragma unroll
        for (int j = 0; j < 8; ++j) { x[s][j] = (float)q[j]; ss += x[s][j] * x[s][j]; } }
    ss = half_sum(ss);
    const float rstd = rsqrtf(ss * (1.0f / HD) + 1e-6f);
#pragma unroll
    for (int s = 0; s < 4; ++s)
#pragma unroll
        for (int j = 0; j < 8; ++j) x[s][j] *= rstd * IN(26)[l * HD + 16 * s + 8 * hh + j];
    if (smp) { const int t = (row - M_CTX) & (T_SMP - 1); const float posr = (float)(t >> 6), posc = (float)(t & 63);
#pragma unroll
        for (int j = 0; j < 8; ++j) { const float freq = exp2f(-(float)(8 * hh + j) * (13.287712379549449f / 16.0f));
            const float ar = posr * freq, ac = posc * freq; const float cr = __cosf(ar), sr = __sinf(ar), cc = __cosf(ac), sc = __sinf(ac);
            const float a0 = x[0][j], a1 = x[1][j], b0 = x[2][j], b1 = x[3][j];
            x[0][j] = a0 * cr - a1 * sr; x[1][j] = a1 * cr + a0 * sr; x[2][j] = b0 * cc - b1 * sc; x[3][j] = b1 * cc + b0 * sc; } }
    f16x8 qf[4];
#pragma unroll
    for (int s = 0; s < 4; ++s)
#pragma unroll
        for (int j = 0; j < 8; ++j) qf[s][j] = (f16)(x[s][j] * (0.125f * 1.4426950408889634f));
    f32x16 o0, o1;
#pragma unroll
    for (int i = 0; i < 16; ++i) { o0[i] = 0.f; o1[i] = 0.f; }
    float mrun = -1e30f, lsum = 0.f;
    const GAS f16* kp = Kb + (size_t)swap23(r32) * HD + 8 * hh;
    const GAS f16* vp = Vb + (size_t)r32 * L + 8 * hh;
    const int ntile = L >> 5;
    f16x8 kf[4], vf[4];
#pragma unroll
    for (int s = 0; s < 4; ++s) kf[s] = *(const GAS f16x8*)(kp + 16 * s);
    vf[0] = *(const GAS f16x8*)(vp); vf[1] = *(const GAS f16x8*)(vp + 16); vf[2] = *(const GAS f16x8*)(vp + (size_t)32 * L); vf[3] = *(const GAS f16x8*)(vp + (size_t)32 * L + 16);
    for (int kt = 0; kt < ntile; ++kt) {
        f16x8 kn[4], vn[4];
        const int ktn = kt + 1 < ntile ? kt + 1 : kt;
#pragma unroll
        for (int s = 0; s < 4; ++s) kn[s] = *(const GAS f16x8*)(kp + (size_t)ktn * 32 * HD + 16 * s);
        vn[0] = *(const GAS f16x8*)(vp + ktn * 32); vn[1] = *(const GAS f16x8*)(vp + ktn * 32 + 16); vn[2] = *(const GAS f16x8*)(vp + (size_t)32 * L + ktn * 32); vn[3] = *(const GAS f16x8*)(vp + (size_t)32 * L + ktn * 32 + 16);
        f32x16 sa;
#pragma unroll
        for (int i = 0; i < 16; ++i) sa[i] = 0.f;
#pragma unroll
        for (int s = 0; s < 4; ++s) sa = __builtin_amdgcn_mfma_f32_32x32x16_f16(kf[s], qf[s], sa, 0, 0, 0);
        float mt = sa[0];
#pragma unroll
        for (int i = 1; i < 16; ++i) mt = fmaxf(mt, sa[i]);
        mt = half_max(mt);
        const float mn = fmaxf(mrun, mt); const float alpha = exp2f(mrun - mn); mrun = mn;
        float ps = 0.f;
#pragma unroll
        for (int i = 0; i < 16; ++i) { sa[i] = exp2f(sa[i] - mn); ps += sa[i]; }
        lsum = lsum * alpha + ps;
#pragma unroll
        for (int i = 0; i < 16; ++i) { o0[i] *= alpha; o1[i] *= alpha; }
        f16x8 pb0, pb1;
#pragma unroll
        for (int j = 0; j < 8; ++j) { pb0[j] = (f16)sa[j]; pb1[j] = (f16)sa[8 + j]; }
        o0 = __builtin_amdgcn_mfma_f32_32x32x16_f16(vf[0], pb0, o0, 0, 0, 0);
        o0 = __builtin_amdgcn_mfma_f32_32x32x16_f16(vf[1], pb1, o0, 0, 0, 0);
        o1 = __builtin_amdgcn_mfma_f32_32x32x16_f16(vf[2], pb0, o1, 0, 0, 0);
        o1 = __builtin_amdgcn_mfma_f32_32x32x16_f16(vf[3], pb1, o1, 0, 0, 0);
#pragma unroll
        for (int s = 0; s < 4; ++s) { kf[s] = kn[s]; vf[s] = vn[s]; }
    }
    lsum = half_sum(lsum);
    const float inv = 1.0f / lsum;
    GAS f16* op = OA + (size_t)row * D + CW + hq * HD + 4 * hh;
#pragma unroll
    for (int g = 0; g < 4; ++g) {
        v2u w0; w0.x = pkh(o0[4 * g] * inv, o0[4 * g + 1] * inv); w0.y = pkh(o0[4 * g + 2] * inv, o0[4 * g + 3] * inv);
        v2u w1; w1.x = pkh(o1[4 * g] * inv, o1[4 * g + 1] * inv); w1.y = pkh(o1[4 * g + 2] * inv, o1[4 * g + 3] * inv);
        *(GAS v2u*)(op + 8 * g) = w0; *(GAS v2u*)(op + 32 + 8 * g) = w1; }
}
constexpr int AT_KS = 144, AT_BUF = 2 * 64 * AT_KS;
__device__ __forceinline__ void attn_block_task(const DParams& p, const Ctx& c, int l, int item) {
    const GAS f16* PROJ = (const GAS f16*)(p.ws + WS_R1); const GAS f16* KN = (const GAS f16*)(p.ws + WS_KN); const GAS f16* VT = (const GAS f16*)(p.ws + WS_VT);
    GAS f16* OA = (GAS f16*)(p.ws + WS_R4);
    int rowq0, L, kvh; const GAS f16* Kb; const GAS f16* Vb; bool smp;
    if (item < 128) { smp = true; const int b = item >> 5; kvh = (item >> 4) & 1; rowq0 = M_CTX + b * T_SMP + (item & 15) * 64; L = KV_SMP;
        Kb = KN + KN_SMP_OFF + ((size_t)b * 2 + kvh) * KV_SMP * HD; Vb = VT + KN_SMP_OFF + ((size_t)b * 2 + kvh) * HD * KV_SMP; }
    else { smp = false; const int id = item - 128; const int b = id >> 3; kvh = (id >> 2) & 1; rowq0 = b * T_CTX + (id & 3) * 64; L = T_CTX;
        Kb = KN + ((size_t)b * 2 + kvh) * T_CTX * HD; Vb = VT + ((size_t)b * 2 + kvh) * HD * T_CTX; }
    const int hq = kvh * 4 + (c.wave & 3);
    const int r32 = c.lane & 31, hh = c.lane >> 5;
    const int row = rowq0 + 32 * (c.wave >> 2) + r32;
    const int kk = c.tid >> 3, chk = c.tid & 7;
    const GAS f16* ksrc = Kb + (size_t)kk * HD + chk * 8;
    const GAS f16* vsrc = Vb + (size_t)kk * L + chk * 8;
    const int sdst = kk * AT_KS + chk * 16;
    v4u kreg = *(const GAS v4u*)ksrc, vreg = *(const GAS v4u*)vsrc;
    float x[4][8]; float ss = 0.f;
#pragma unroll
    for (int s = 0; s < 4; ++s) { const f16x8 q = *(const GAS f16x8*)(PROJ + (size_t)row * DIN + PC_Q + hq * HD + 16 * s + 8 * hh);
#pragma unroll
        for (int j = 0; j < 8; ++j) { x[s][j] = (float)q[j]; ss += x[s][j] * x[s][j]; } }
    ss = half_sum(ss);
    const float rstd = rsqrtf(ss * (1.0f / HD) + 1e-6f);
#pragma unroll
    for (int s = 0; s < 4; ++s)
#pragma unroll
        for (int j = 0; j < 8; ++j) x[s][j] *= rstd * IN(26)[l * HD + 16 * s + 8 * hh + j];
    if (smp) { const int t = (row - M_CTX) & (T_SMP - 1); const float posr = (float)(t >> 6), posc = (float)(t & 63);
#pragma unroll
        for (int j = 0; j < 8; ++j) { const float freq = exp2f(-(float)(8 * hh + j) * (13.287712379549449f / 16.0f));
            const float ar = posr * freq, ac = posc * freq; const float cr = __cosf(ar), sr = __sinf(ar), cc = __cosf(ac), sc = __sinf(ac);
            const float a0 = x[0][j], a1 = x[1][j], b0 = x[2][j], b1 = x[3][j];
            x[0][j] = a0 * cr - a1 * sr; x[1][j] = a1 * cr + a0 * sr; x[2][j] = b0 * cc - b1 * sc; x[3][j] = b1 * cc + b0 * sc; } }
    f16x8 qf[4];
#pragma unroll
    for (int s = 0; s < 4; ++s)
#pragma unroll
        for (int j = 0; j < 8; ++j) qf[s][j] = (f16)(x[s][j] * (0.125f * 1.4426950408889634f));
    f32x16 o0, o1;
#pragma unroll
    for (int i = 0; i < 16; ++i) { o0[i] = 0.f; o1[i] = 0.f; }
    float mrun = -1e30f, lsum = 0.f;
    const int nstep = L >> 6;
    *(LAS v4u*)(c.lds + sdst) = kreg; *(LAS v4u*)(c.lds + 64 * AT_KS + sdst) = vreg;
    asm volatile("s_waitcnt lgkmcnt(0)" ::: "memory"); __builtin_amdgcn_s_barrier(); asm volatile("" ::: "memory");
    const int koff = swap23(r32) * AT_KS + 16 * hh, voff = 64 * AT_KS + r32 * AT_KS + 16 * hh;
    for (int st = 0; st < nstep; ++st) {
        if (st + 1 < nstep) { kreg = *(const GAS v4u*)(ksrc + (size_t)(st + 1) * 64 * HD); vreg = *(const GAS v4u*)(vsrc + (st + 1) * 64); }
        LAS unsigned char* sb = c.lds + (st & 1) * AT_BUF;
        f32x16 sa0, sa1;
#pragma unroll
        for (int i = 0; i < 16; ++i) { sa0[i] = 0.f; sa1[i] = 0.f; }
#pragma unroll
        for (int s = 0; s < 4; ++s) { const f16x8 k0 = *(const LAS f16x8*)(sb + koff + 32 * s), k1 = *(const LAS f16x8*)(sb + koff + 32 * AT_KS + 32 * s);
            sa0 = __builtin_amdgcn_mfma_f32_32x32x16_f16(k0, qf[s], sa0, 0, 0, 0); sa1 = __builtin_amdgcn_mfma_f32_32x32x16_f16(k1, qf[s], sa1, 0, 0, 0); }
        float mt = fmaxf(sa0[0], sa1[0]);
#pragma unroll
        for (int i = 1; i < 16; ++i) mt = fmaxf(mt, fmaxf(sa0[i], sa1[i]));
        mt = half_max(mt);
        const float mn = fmaxf(mrun, mt); const float alpha = exp2f(mrun - mn); mrun = mn;
        float ps = 0.f;
#pragma unroll
        for (int i = 0; i < 16; ++i) { sa0[i] = exp2f(sa0[i] - mn); sa1[i] = exp2f(sa1[i] - mn); ps += sa0[i] + sa1[i]; }
        lsum = lsum * alpha + ps;
#pragma unroll
        for (int i = 0; i < 16; ++i) { o0[i] *= alpha; o1[i] *= alpha; }
        f16x8 pb[4];
#pragma unroll
        for (int j = 0; j < 8; ++j) { pb[0][j] = (f16)sa0[j]; pb[1][j] = (f16)sa0[8 + j]; pb[2][j] = (f16)sa1[j]; pb[3][j] = (f16)sa1[8 + j]; }
#pragma unroll
        for (int q4 = 0; q4 < 4; ++q4) {
            const f16x8 v0 = *(const LAS f16x8*)(sb + voff + 32 * q4), v1 = *(const LAS f16x8*)(sb + voff + 32 * AT_KS + 32 * q4);
            o0 = __builtin_amdgcn_mfma_f32_32x32x16_f16(v0, pb[q4], o0, 0, 0, 0); o1 = __builtin_amdgcn_mfma_f32_32x32x16_f16(v1, pb[q4], o1, 0, 0, 0); }
        if (st + 1 < nstep) { LAS unsigned char* nb = c.lds + ((st + 1) & 1) * AT_BUF; *(LAS v4u*)(nb + sdst) = kreg; *(LAS v4u*)(nb + 64 * AT_KS + sdst) = vreg; }
        asm volatile("s_waitcnt lgkmcnt(0)" ::: "memory"); __builtin_amdgcn_s_barrier(); asm volatile("" ::: "memory");
    }
    lsum = half_sum(lsum);
    const float inv = 1.0f / lsum;
    GAS f16* op = OA + (size_t)row * D + CW + hq * HD + 4 * hh;
#pragma unroll
    for (int g = 0; g < 4; ++g) {
        v2u w0; w0.x = pkh(o0[4 * g] * inv, o0[4 * g + 1] * inv); w0.y = pkh(o0[4 * g + 2] * inv, o0[4 * g + 3] * inv);
        v2u w1; w1.x = pkh(o1[4 * g] * inv, o1[4 * g + 1] * inv); w1.y = pkh(o1[4 * g + 2] * inv, o1[4 * g + 3] * inv);
        *(GAS v2u*)(op + 8 * g) = w0; *(GAS v2u*)(op + 32 + 8 * g) = w1; }
}
__device__ __forceinline__ void fast_attn(const Params& p0, const Ctx& c0, int l) {
    const Ctx c = fresh(c0); FRESH_P(p0);
    unsigned* ctr = (unsigned*)(p0.ws + WS_CTL) + 8192 + 64 * l;
    volatile LAS unsigned* slot = (volatile LAS unsigned*)(c.lds + MISC_OFF) + 16;
    for (;;) {
        if (c.tid == 0) slot[0] = __hip_atomic_fetch_add(ctr, 1u, __ATOMIC_RELAXED, __HIP_MEMORY_SCOPE_AGENT);
        __syncthreads();
        const int item = (int)slot[0];
        __syncthreads();
        if (item >= 384) break;
        attn_block_task(p, c, l, item);
    }
}

__device__ __forceinline__ void post_phase(const Params& p0, const Ctx& c0, int l) {
    const Ctx c = fresh(c0); FRESH_P(p0);
    const GAS f16* PROJ = (const GAS f16*)(p.ws + WS_R1); const GAS f16* Y = (const GAS f16*)(p.ws + WS_R3); const GAS float* RK = (const GAS float*)(p.ws + WS_RK);
    GAS f16* OA = (GAS f16*)(p.ws + WS_R4);
    const int ch0 = c.lane * 8, h = c.lane >> 3;
    float gnw[8], gnb[8], muv[8];
    { const f32x4 a0 = *(const GAS f32x4*)(IN(24) + l * CW + ch0), a1 = *(const GAS f32x4*)(IN(24) + l * CW + ch0 + 4), b0 = *(const GAS f32x4*)(IN(25) + l * CW + ch0), b1 = *(const GAS f32x4*)(IN(25) + l * CW + ch0 + 4);
      const f32x4 m0 = *(const GAS f32x4*)(IN(15) + (l * 3 + 2) * CW + ch0), m1 = *(const GAS f32x4*)(IN(15) + (l * 3 + 2) * CW + ch0 + 4);
#pragma unroll
      for (int e = 0; e < 4; ++e) { gnw[e] = a0[e]; gnw[4 + e] = a1[e]; gnb[e] = b0[e]; gnb[4 + e] = b1[e]; muv[e] = m0[e]; muv[4 + e] = m1[e]; } }
    for (int row = c.gw; row < M; row += c.ngw) {
        int g, t, T; row_info(row, g, t, T);
        const GAS f16* pr = PROJ + (size_t)row * DIN + PC_V + ch0;
        const f16x8 y0 = *(const GAS f16x8*)(Y + (size_t)row * CW + ch0), y1 = *(const GAS f16x8*)(Y + ((size_t)M + row) * CW + ch0);
        const f16x8 vc = *(const GAS f16x8*)pr; const f16x8 gv = *(const GAS f16x8*)(OA + (size_t)row * D + ch0);
        f16x8 vp, vn;
#pragma unroll
        for (int e = 0; e < 8; ++e) { vp[e] = (f16)0.f; vn[e] = (f16)0.f; }
        if (t > 0) vp = *(const GAS f16x8*)(pr - DIN);
        if (t < T - 1) vn = *(const GAS f16x8*)(pr + DIN);
        const float rk = RK[(size_t)row * 8 + h] + RK[((size_t)M + row) * 8 + h];
        float y[8]; float s = 0.f;
#pragma unroll
        for (int e = 0; e < 8; ++e) { y[e] = (float)y0[e] + (float)y1[e]; s += y[e]; }
        const float mean = dpp_sum8(s) * (1.0f / HD); float q = 0.f;
#pragma unroll
        for (int e = 0; e < 8; ++e) { y[e] -= mean; q += y[e] * y[e]; }
        const float rstd = rsqrtf(dpp_sum8(q) * (1.0f / HD) + 64e-5f);
        float o[8];
#pragma unroll
        for (int e = 0; e < 8; ++e) { const float vcf = (float)vc[e]; const float v = vcf + muv[e] * (0.5f * ((float)vp[e] + (float)vn[e]) - vcf);
            o[e] = (y[e] * rstd * gnw[e] + gnb[e] + rk * v) * (float)gv[e]; }
        v4u w; w.x = pkh(o[0], o[1]); w.y = pkh(o[2], o[3]); w.z = pkh(o[4], o[5]); w.w = pkh(o[6], o[7]);
        *(GAS v4u*)(OA + (size_t)row * D + ch0) = w;
    }
}

__device__ __forceinline__ void gemm_proj(const Params& p0, const Ctx& c0) { const Ctx c = fresh(c0); FRESH_P(p0);
    pg8::Gemm g{(const GAS f16*)(p.ws + WS_R4), (const GAS f16*)(p.ws + WS_W + WO_IN), D, D, D}; pg8::StaticOrder S; S.init(M, DIN, (int)gridDim.x, c.bid);
    pg8::gemm_phase(c.lds, g, S, pg8::EpiProjF{(GAS f16*)(p.ws + WS_R1)}, c.wave); }
__device__ __forceinline__ void gemm_wa(const Params& p0, const Ctx& c0, int l) { const Ctx c = fresh(c0); FRESH_P(p0);
    pg8::Gemm g{(const GAS f16*)(p.ws + WS_R1) + PC_LW, (const GAS f16*)(p.ws + WS_W + WO_SM), DIN, 128, 128}; pg8::StaticOrder S; S.init(M, 2048, (int)gridDim.x, c.bid);
    pg8::gemm_phase(c.lds, g, S, pg8::EpiWAF{(GAS f16*)(p.ws + WS_R2), IN(19) + (size_t)l * 2 * CW, IN(21) + (size_t)l * 2 * CW}, c.wave); }
__device__ __forceinline__ void gemm_gate(const Params& p0, const Ctx& c0) { const Ctx c = fresh(c0); FRESH_P(p0);
    pg8::Gemm g{(const GAS f16*)(p.ws + WS_R1) + PC_LG, (const GAS f16*)(p.ws + WS_W + WO_G), DIN, 128, 128}; pg8::StaticOrder S; S.init(M, CW, (int)gridDim.x, c.bid);
    pg8::gemm_phase(c.lds, g, S, pg8::EpiF16F{(GAS f16*)(p.ws + WS_R4), D}, c.wave); }
__device__ __forceinline__ void gemm_merge(const Params& p0, const Ctx& c0) { const Ctx c = fresh(c0); FRESH_P(p0);
    const GAS f16* OA = (const GAS f16*)(p.ws + WS_R4); const GAS f16* WbrT = (const GAS f16*)(p.ws + WS_W + WO_BR); GAS f16* MG = (GAS f16*)(p.ws + WS_R3); const GAS f16* PROJ = (const GAS f16*)(p.ws + WS_R1);
    pg8::StaticOrder S; S.init(M, D, (int)gridDim.x, c.bid, 192);
    pg8::Gemm g{OA, WbrT, D, D, D}; pg8::gemm_phase<pg8::EpiMergeF, 96>(c.lds, g, S, pg8::EpiMergeF{MG, PROJ}, c.wave); }
__device__ __forceinline__ void gemm_out(const Params& p0, const Ctx& c0) { const Ctx c = fresh(c0); FRESH_P(p0);
    pg8::Gemm g{(const GAS f16*)(p.ws + WS_R3), (const GAS f16*)(p.ws + WS_W + WO_OUT), D, D, D}; pg8::StaticOrder S; S.init(M, D, (int)gridDim.x, c.bid, 192);
    pg8::gemm_phase<pg8::EpiF16F, 96>(c.lds, g, S, pg8::EpiF16F{(GAS f16*)(p.ws + WS_R2), D}, c.wave); }
__device__ __forceinline__ void gemm_up(const Params& p0, const Ctx& c0) { const Ctx c = fresh(c0); FRESH_P(p0);
    pg8::Gemm g{(const GAS f16*)(p.ws + WS_R4), (const GAS f16*)(p.ws + WS_W + WO_UP), D, D, D}; pg8::StaticOrder S; S.init(M, DFF, (int)gridDim.x, c.bid);
    pg8::gemm_phase(c.lds, g, S, pg8::EpiRelu2F{(GAS f16*)(p.ws + WS_R1), DFF}, c.wave); }
__device__ __forceinline__ void gemm_down(const Params& p0, const Ctx& c0) { const Ctx c = fresh(c0); FRESH_P(p0);
    pg8::Gemm g{(const GAS f16*)(p.ws + WS_R1), (const GAS f16*)(p.ws + WS_W + WO_DN), DFF, DFF, DFF}; pg8::StaticOrder S; S.init(M, D, (int)gridDim.x, c.bid, 192);
    pg8::gemm_phase<pg8::EpiF16F, 96>(c.lds, g, S, pg8::EpiF16F{(GAS f16*)(p.ws + WS_R2), D}, c.wave); }

__global__ void __launch_bounds__(NTHREADS, 2) fwd_kernel(Params p) {
    extern __shared__ __attribute__((aligned(16))) unsigned char lds_raw[];
    Ctx c;
    c.lds = (LAS unsigned char*)lds_raw;
    c.tid = threadIdx.x; c.lane = c.tid & 63; c.wave = __builtin_amdgcn_readfirstlane(c.tid >> 6);
    c.gw = blockIdx.x * NWAVES + c.wave; c.ngw = gridDim.x * NWAVES; c.gt = blockIdx.x * NTHREADS + c.tid; c.ngt = gridDim.x * NTHREADS;
    volatile LAS unsigned* MISC = (volatile LAS unsigned*)(c.lds + MISC_OFF);
    if (c.tid < 32) MISC[c.tid] = 0u;
    if (c.tid < 28) ((LAS unsigned long long*)(c.lds + PTAB_OFF))[c.tid] = (unsigned long long)p.in[c.tid];
    __syncthreads();
    unsigned* ctl = (unsigned*)(p.ws + WS_CTL);
    XcdBarrier bar = xcd_barrier_post(ctl + CW_BAR, MISC + 8);
#define GRID_BAR() xcd_barrier(bar)

    conv_weights(p, c, 0);
    __syncthreads();
    mod_phase(p, c);
    GRID_BAR();
    norm_phase<0>(p, c, 0);
    GRID_BAR();
#pragma nounroll
    for (int l = 0; l < NL; ++l) {
        gemm_proj(p, c);
        GRID_BAR();
        gemm_wa(p, c, l);
        gemm_gate(p, c);
        kv_prep(p, c, l);
        GRID_BAR();
        mfma_scan(p, c, l);
        __syncthreads();
        fast_attn(p, c, l);
        GRID_BAR();
        post_phase(p, c, l);
        GRID_BAR();
        gemm_merge(p, c);
        GRID_BAR();
        gemm_out(p, c);
        GRID_BAR();
        norm_phase<1>(p, c, l);
        GRID_BAR();
        gemm_up(p, c);
        GRID_BAR();
        gemm_down(p, c);
        GRID_BAR();
        norm_phase<2>(p, c, l);
        if (l + 1 < NL) { __syncthreads(); conv_weights(p, c, l + 1); }
        GRID_BAR();
    }
}

extern "C" void kernel_launch(void* const* d_in, const int* in_sizes, int n_in, void* d_out, int out_size, void* d_ws, size_t ws_size, hipStream_t stream) {
    static int grid = 0;
    if (grid == 0) {
        if (n_in != 28 || (size_t)out_size != O_TOTAL || ws_size < WS_END) { fprintf(stderr, "kernel_launch: unexpected shapes n_in %d out %d ws %zu\n", n_in, out_size, ws_size); grid = -1; return; }
        int dev = 0, cus = 0;
        if (hipGetDevice(&dev) != hipSuccess || hipDeviceGetAttribute(&cus, hipDeviceAttributeMultiprocessorCount, dev) != hipSuccess) { grid = -1; return; }
        if (hipFuncSetAttribute((const void*)fwd_kernel, hipFuncAttributeMaxDynamicSharedMemorySize, LDS_BYTES) != hipSuccess) { fprintf(stderr, "kernel_launch: hipFuncSetAttribute failed\n"); grid = -1; return; }
        grid = cus;
    }
    if (grid < 0) return;
    (void)hipMemsetAsync((char*)d_ws + WS_CTL, 0, CTL_BYTES + MiB, stream);
    Params p{};
    for (int i = 0; i < 28; ++i) p.in[i] = (const float*)d_in[i];
    p.out = (float*)d_out; p.ws = (unsigned char*)d_ws;
    hipLaunchKernelGGL(fwd_kernel, dim3(grid), dim3(NTHREADS), LDS_BYTES, stream, p);
}
```

```cpp
#include <hip/hip_runtime.h>
#include <cstdio>
#include <cstdint>

#define GAS __attribute__((address_space(1)))
#define LAS __attribute__((address_space(3)))
typedef _Float16 f16;
typedef _Float16 f16x8 __attribute__((ext_vector_type(8)));
typedef _Float16 f16x4 __attribute__((ext_vector_type(4)));
typedef _Float16 f16x2 __attribute__((ext_vector_type(2)));
typedef float f32x4 __attribute__((ext_vector_type(4)));
typedef float f32x16 __attribute__((ext_vector_type(16)));
typedef unsigned v4u __attribute__((ext_vector_type(4)));
typedef unsigned v2u __attribute__((ext_vector_type(2)));

constexpr int D = 1024, DIN = 4608, DFF = 4096, CW = 512, NL = 2, NH = 8, HD = 64;
constexpr int B_CTX = 32, T_CTX = 256, B_SMP = 4, T_SMP = 1024, PAST = 256, KV_SMP = PAST + T_SMP;
constexpr int M_CTX = B_CTX * T_CTX, M_SMP = B_SMP * T_SMP, M = M_CTX + M_SMP;
constexpr int NMOD = 6 * D;
constexpr int PC_R = 0, PC_K = 512, PC_V = 1024, PC_LW = 1536, PC_LA = 1600, PC_LG = 1664, PC_Q = 1792, PC_KA = 2304, PC_VA = 2432, PC_GR = 2560, PC_GA = 3584;
constexpr size_t O_Y = 0, O_CK = (size_t)M * D, O_CV = O_CK + (size_t)B_CTX * NL * T_CTX * 128, O_ST = O_CV + (size_t)B_CTX * NL * T_CTX * 128;
constexpr size_t O_TOTAL = O_ST + (size_t)B_CTX * NL * 2 * NH * HD * HD;

constexpr size_t MiB = 1u << 20;
constexpr size_t WS_CTL = 0, CTL_BYTES = 1 * MiB;
constexpr size_t WS_MOD = 1 * MiB;
constexpr size_t WS_W = 2 * MiB;
constexpr size_t WO_IN = 0, WO_BR = 9 * MiB, WO_OUT = 11 * MiB, WO_UP = 13 * MiB, WO_DN = 21 * MiB, WO_SM = 29 * MiB, WO_G = 29 * MiB + 512 * 1024;
constexpr size_t WS_R1 = 32 * MiB;
constexpr size_t WS_R2 = 140 * MiB;
constexpr size_t WS_R3 = 188 * MiB;
constexpr size_t WS_RK = 212 * MiB;
constexpr size_t WS_R4 = 213 * MiB;
constexpr size_t WS_KN = 237 * MiB;
constexpr size_t WS_VT = 241 * MiB;
constexpr size_t WS_END = 245 * MiB;
constexpr size_t KN_SMP_OFF = (size_t)B_CTX * 2 * T_CTX * 64;

constexpr int NWAVES = 8, NTHREADS = 512;
constexpr int LDS_BYTES = 147456;
constexpr int MISC_OFF = 131072 + 320, PTAB_OFF = 131072 + 1024;

#define XB_TMO      128
#define XB_XCNT(j)  (256  + 64 * (j))
#define XB_XSUB(j)  (1280 + 64 * (j))
#define XB_XGEN(j)  (2304 + 64 * (j))
#define XB_TOP      3328
#define XB_TOPGEN   3392
#define XCD_BAR_WORDS 3456
#define XB_SPIN_CAP (1u << 24)
constexpr int CW_BAR = 4096;

__device__ __forceinline__ unsigned xb_ld(unsigned* p)              { return __hip_atomic_load(p, __ATOMIC_RELAXED, __HIP_MEMORY_SCOPE_AGENT); }
__device__ __forceinline__ unsigned xb_add(unsigned* p, unsigned v) { return __hip_atomic_fetch_add(p, v, __ATOMIC_RELAXED, __HIP_MEMORY_SCOPE_AGENT); }
__device__ __forceinline__ unsigned xb_xcc_id() { return (unsigned)__builtin_amdgcn_s_getreg((3 << 11) | 20) & 0xFu; }
#define XB_SPIN(cond, bar) do { unsigned _sp = 0; while (cond) { __builtin_amdgcn_s_sleep(1); \
    if ((++_sp & 255u) == 0u) { if (xb_ld(&(bar)[XB_TMO])) break; if (_sp > XB_SPIN_CAP) { atomicAdd(&(bar)[XB_TMO], 1u); break; } } } } while (0)

struct XcdBarrier { unsigned* bar; unsigned x; volatile LAS unsigned* st; };

__device__ __forceinline__ XcdBarrier xcd_barrier_post(unsigned* bar, volatile LAS unsigned* st) {
    XcdBarrier b; b.bar = bar; b.x = xb_xcc_id(); b.st = st;
    if (threadIdx.x == 0) (void)xb_add(&bar[XB_XCNT(b.x)], 1u);
    return b;
}
__device__ __forceinline__ void xcd_barrier_complete(unsigned* bar, unsigned x, unsigned& nloc, unsigned& nx) {
    const unsigned G = gridDim.x * gridDim.y * gridDim.z;
    unsigned sum, cnt, mine, sp = 0u;
    for (;;) {
        sum = 0u; cnt = 0u; mine = 0u;
#pragma unroll
        for (unsigned j = 0; j < 16; ++j) { const unsigned c = xb_ld(&bar[XB_XCNT(j)]); sum += c; cnt += (c > 0u) ? 1u : 0u; mine = (j == x) ? c : mine; }
        if (sum == G) break;
        __builtin_amdgcn_s_sleep(1);
        if ((++sp & 255u) == 0u) { if (xb_ld(&bar[XB_TMO])) break; if (sp > XB_SPIN_CAP) { atomicAdd(&bar[XB_TMO], 1u); break; } }
    }
    nloc = mine > 0u ? mine : 1u; nx = cnt > 0u ? cnt : 1u;
}
__device__ __forceinline__ void xcd_barrier(const XcdBarrier& b) {
    asm volatile("s_waitcnt vmcnt(0)" ::: "memory");
    __syncthreads();
    if (threadIdx.x == 0) {
        unsigned* bar = b.bar; unsigned bx = b.x;
        asm volatile("" : "+s"(bar), "+s"(bx));
        __builtin_amdgcn_s_waitcnt(0);
        unsigned nloc = b.st[0], nx = b.st[1];
        if (nloc == 0u) { xcd_barrier_complete(bar, bx, nloc, nx); b.st[0] = nloc; b.st[1] = nx; }
        const unsigned old = xb_add(&bar[XB_XSUB(bx)], 1u);
        const unsigned gen = old / nloc;
        if (old + 1u == (gen + 1u) * nloc) {
            __builtin_amdgcn_fence(__ATOMIC_RELEASE, "agent");
            asm volatile("s_waitcnt vmcnt(0)" ::: "memory");
            const unsigned og = xb_add(&bar[XB_TOP], 1u);
            const unsigned tg = og / nx;
            if (og + 1u == (tg + 1u) * nx) xb_add(&bar[XB_TOPGEN], 1u);
            else XB_SPIN(xb_ld(&bar[XB_TOPGEN]) == tg, bar);
            __builtin_amdgcn_fence(__ATOMIC_ACQUIRE, "agent");
            xb_add(&bar[XB_XGEN(bx)], 1u);
            asm volatile("s_waitcnt vmcnt(0)" ::: "memory");
        } else {
            XB_SPIN(xb_ld(&bar[XB_XGEN(bx)]) == gen, bar);
            __builtin_amdgcn_fence(__ATOMIC_ACQUIRE, "agent");
            asm volatile("s_waitcnt vmcnt(0)" ::: "memory");
        }
    }
    __syncthreads();
}

#define LDS_WAIT() asm volatile("s_waitcnt lgkmcnt(0)" ::: "memory")
#define DPPF(x, ctrl, rmask, oldv) __builtin_bit_cast(float, __builtin_amdgcn_update_dpp(__builtin_bit_cast(int, (float)(oldv)), __builtin_bit_cast(int, (float)(x)), (ctrl), (rmask), 0xF, false))
__device__ __forceinline__ float wave_sum(float v) {
    v += DPPF(v, 0xB1, 0xF, 0.f); v += DPPF(v, 0x4E, 0xF, 0.f); v += DPPF(v, 0x141, 0xF, 0.f); v += DPPF(v, 0x140, 0xF, 0.f);
    v += DPPF(v, 0x142, 0xA, 0.f); v += DPPF(v, 0x143, 0xC, 0.f);
    return __builtin_bit_cast(float, __builtin_amdgcn_readlane(__builtin_bit_cast(int, v), 63));
}
__device__ __forceinline__ float dpp_f(float x, const int ctrl) { return x; }
#define DPP_ADD(x, ctrl) (x) += __builtin_bit_cast(float, __builtin_amdgcn_update_dpp(0, __builtin_bit_cast(int, (x)), (ctrl), 0xF, 0xF, true))
__device__ __forceinline__ float dpp_sum8(float x) { DPP_ADD(x, 0xB1); DPP_ADD(x, 0x4E); DPP_ADD(x, 0x141); return x; }
__device__ __forceinline__ float dpp_sum16(float x) { DPP_ADD(x, 0xB1); DPP_ADD(x, 0x4E); DPP_ADD(x, 0x141); DPP_ADD(x, 0x140); return x; }
__device__ __forceinline__ void swap32(float& a, float& b) { asm volatile("v_nop\n\tv_nop\n\tv_permlane32_swap_b32 %0, %1" : "+v"(a), "+v"(b)); }
__device__ __forceinline__ float half_sum(float v) { float a = v, b = v; swap32(a, b); return a + b; }
__device__ __forceinline__ float half_max(float v) { float a = v, b = v; swap32(a, b); return fmaxf(a, b); }
__device__ __forceinline__ float xor16(float v) { return __builtin_bit_cast(float, __builtin_amdgcn_ds_swizzle(__builtin_bit_cast(int, v), 0x401F)); }
__device__ __forceinline__ float sigmoidf_(float x) { return __builtin_amdgcn_rcpf(1.0f + __expf(-x)); }
__device__ __forceinline__ float tanhf_(float x) { return 1.0f - 2.0f * __builtin_amdgcn_rcpf(1.0f + __expf(2.0f * x)); }
__device__ __forceinline__ unsigned pkh(float lo, float hi) { f16x2 v = {(f16)lo, (f16)hi}; return __builtin_bit_cast(unsigned, v); }
__device__ __forceinline__ void row_info(int row, int& g, int& t, int& T) {
    if (row < M_CTX) { g = 0; t = row & (T_CTX - 1); T = T_CTX; }
    else { const int r = row - M_CTX; g = 1 + (r >> 10); t = r & (T_SMP - 1); T = T_SMP; }
}

struct Params {
    const float* in[28];
    float* out;
    unsigned char* ws;
};
struct DParams { GAS float* out; GAS unsigned char* ws; };
struct Ctx {
    LAS unsigned char* lds;
    int tid, lane, wave, gw, ngw, gt, ngt, bid;
};
__device__ __forceinline__ int lane_id() { int ln; asm volatile("v_mbcnt_lo_u32_b32 %0, -1, 0\n\tv_mbcnt_hi_u32_b32 %0, -1, %0" : "=v"(ln)); return ln; }
__device__ __forceinline__ const GAS float* inp(const Ctx& c, int i) {
    const unsigned long long v = ((const LAS unsigned long long*)(c.lds + PTAB_OFF))[i];
    const unsigned lo = __builtin_amdgcn_readfirstlane((unsigned)v), hi = __builtin_amdgcn_readfirstlane((unsigned)(v >> 32));
    return (const GAS float*)(((unsigned long long)hi << 32) | lo); }
#define IN(i) inp(c, (i))
#define FRESH_P(p0) DParams p; { float* o_ = (p0).out; unsigned char* w_ = (p0).ws; asm volatile("" : "+s"(o_), "+s"(w_)); p.out = (GAS float*)o_; p.ws = (GAS unsigned char*)w_; }
__device__ __forceinline__ Ctx fresh(const Ctx& c0) {
    Ctx c = c0; int w = c0.wave; asm volatile("" : "+s"(w)); int ln = lane_id(); asm volatile("" : "+v"(ln));
    int b = blockIdx.x; asm volatile("" : "+s"(b));
    c.wave = w; c.lane = ln; c.tid = w * 64 + ln; c.bid = b;
    c.gw = b * 8 + w; c.gt = b * 512 + c.tid; return c; }

__device__ __forceinline__ void conv_item(const GAS float* W, int N, GAS f16* WT, int ldt, int koff, LAS float* scr, int kb, int nb, int lane) {
    const int k0 = 64 * kb, n0 = 32 * nb;
#pragma unroll 8
    for (int i = 0; i < 32; ++i) { const int kk = 2 * i + (lane >> 5); scr[kk * 33 + (lane & 31)] = W[(size_t)(k0 + kk) * N + n0 + (lane & 31)]; }
    LDS_WAIT();
    const int c = lane & 7;
#pragma unroll
    for (int j = 0; j < 4; ++j) { const int n = (lane >> 3) + 8 * j; const LAS float* s = scr + (8 * c) * 33 + n;
        v4u o; o.x = pkh(s[0 * 33], s[1 * 33]); o.y = pkh(s[2 * 33], s[3 * 33]); o.z = pkh(s[4 * 33], s[5 * 33]); o.w = pkh(s[6 * 33], s[7 * 33]);
        *(GAS v4u*)(WT + (size_t)(n0 + n) * ldt + koff + k0 + 8 * c) = o; }
    LDS_WAIT();
}
__device__ __forceinline__ void conv_weights(const Params& p0, const Ctx& c0, int l) {
    const Ctx c = fresh(c0); FRESH_P(p0);
    LAS float* scr = (LAS float*)(c.lds + c.wave * 16384);
    GAS unsigned char* wb = p.ws + WS_W;
    GAS f16* WinT = (GAS f16*)(wb + WO_IN); GAS f16* WbrT = (GAS f16*)(wb + WO_BR); GAS f16* WoutT = (GAS f16*)(wb + WO_OUT); GAS f16* WupT = (GAS f16*)(wb + WO_UP); GAS f16* WdnT = (GAS f16*)(wb + WO_DN);
    GAS f16* WsmT = (GAS f16*)(wb + WO_SM); GAS f16* WgT = (GAS f16*)(wb + WO_G);
    const GAS float* w_in = IN(7) + (size_t)l * D * DIN; const GAS float* w_br = IN(8) + (size_t)l * 2 * CW * D; const GAS float* w_out = IN(9) + (size_t)l * D * D;
    const GAS float* w_up = IN(13) + (size_t)l * D * DFF; const GAS float* w_dn = IN(14) + (size_t)l * DFF * D;
    const GAS float* dec_up = IN(20) + (size_t)l * 2 * 64 * CW; const GAS float* icl_up = IN(22) + (size_t)l * 2 * 64 * CW; const GAS float* gate_up = IN(23) + (size_t)l * 128 * CW;
    constexpr int I0 = 16 * 144, I1 = 8 * 32, I2 = 8 * 32, I3 = 16 * 32, I4 = 16 * 128, I5 = 64 * 32, I6 = 16, I7 = 16, I8 = 16, I9 = 16, I10 = 2 * 16;
    constexpr int NIT = I0 + I1 + I2 + I3 + I4 + I5 + I6 + I7 + I8 + I9 + I10;
    for (int it = c.gw; it < NIT; it += c.ngw) {
        int r = it;
        if (r < I0) { conv_item(w_in, DIN, WinT, D, 0, scr, r / 144, r % 144, c.lane); continue; } r -= I0;
        if (r < I1) { conv_item(w_br, D, WbrT, D, 0, scr, r / 32, r % 32, c.lane); continue; } r -= I1;
        if (r < I2) { conv_item(w_br + (size_t)CW * D, D, WbrT, D, CW, scr, r / 32, r % 32, c.lane); continue; } r -= I2;
        if (r < I3) { conv_item(w_out, D, WoutT, D, 0, scr, r / 32, r % 32, c.lane); continue; } r -= I3;
        if (r < I4) { conv_item(w_up, DFF, WupT, D, 0, scr, r / 128, r % 128, c.lane); continue; } r -= I4;
        if (r < I5) { conv_item(w_dn, D, WdnT, DFF, 0, scr, r / 32, r % 32, c.lane); continue; } r -= I5;
        if (r < I6) { conv_item(dec_up, CW, WsmT, 128, 0, scr, 0, r, c.lane); continue; } r -= I6;
        if (r < I7) { conv_item(dec_up + 64 * CW, CW, WsmT + (size_t)512 * 128, 128, 0, scr, 0, r, c.lane); continue; } r -= I7;
        if (r < I8) { conv_item(icl_up, CW, WsmT + (size_t)1024 * 128, 128, 64, scr, 0, r, c.lane); continue; } r -= I8;
        if (r < I9) { conv_item(icl_up + 64 * CW, CW, WsmT + (size_t)1536 * 128, 128, 64, scr, 0, r, c.lane); continue; } r -= I9;
        conv_item(gate_up, CW, WgT, 128, 0, scr, r / 16, r % 16, c.lane);
    }
    unsigned zz_ = 0u; asm volatile("" : "+v"(zz_));
    for (int i = c.gt; i < 2048 * 8; i += c.ngt) { const int row = i >> 3, ch = i & 7; const int col = (row < 1024 ? 64 : 0) + ch * 8;
        *(GAS v4u*)(WsmT + (size_t)row * 128 + col) = (v4u){zz_, zz_, zz_, zz_}; }
}

__device__ __forceinline__ void mod_phase(const Params& p0, const Ctx& c0) {
    const Ctx c = fresh(c0); FRESH_P(p0);
    LAS float* sl = (LAS float*)(c.lds);
    LAS float* part = (LAS float*)(c.lds + 32768);
    GAS float* mod = (GAS float*)(p.ws + WS_MOD);
    for (int i = c.tid; i < 5 * D; i += NTHREADS) { const int g = i >> 10, k = i & 1023; const float v = g == 0 ? IN(6)[k] : IN(5)[(g - 1) * D + k]; sl[i] = v / (1.0f + __expf(-v)); }
    __syncthreads();
    for (int it = c.bid; it < NL * (NMOD / 64) * 4; it += gridDim.x) {
        const int kq = it & 3, lc = it >> 2, l = lc / (NMOD / 64), cc = lc % (NMOD / 64);
        const int kb = kq * 256 + c.wave * 32;
        const GAS float* w = IN(10) + (size_t)l * D * NMOD + (size_t)kb * NMOD + cc * 64 + c.lane;
        float a0 = 0.f, a1 = 0.f, a2 = 0.f, a3 = 0.f, a4 = 0.f;
        float wv[32];
#pragma unroll
        for (int k = 0; k < 32; ++k) wv[k] = w[(size_t)k * NMOD];
#pragma unroll
        for (int k = 0; k < 32; ++k) { a0 += sl[kb + k] * wv[k]; a1 += sl[D + kb + k] * wv[k]; a2 += sl[2 * D + kb + k] * wv[k]; a3 += sl[3 * D + kb + k] * wv[k]; a4 += sl[4 * D + kb + k] * wv[k]; }
        LAS float* pw = part + c.wave * 320 + c.lane;
        pw[0] = a0; pw[64] = a1; pw[128] = a2; pw[192] = a3; pw[256] = a4;
        __syncthreads();
        if (c.tid < 320) { float s = 0.f;
#pragma unroll
            for (int w8 = 0; w8 < 8; ++w8) s += part[w8 * 320 + c.tid];
            const int g = c.tid >> 6, col = cc * 64 + (c.tid & 63);
            if (kq == 0) s += IN(11)[(size_t)l * NMOD + col];
            atomicAdd((float*)(mod + ((size_t)l * 5 + g) * NMOD + col), s); }
        __syncthreads();
    }
}

template <int MODE, int NB>
__device__ __forceinline__ void norm_rows(const DParams& p, const Ctx& c, int l, int row_first, int row_end, int row_step) {
    GAS float* X = p.out; const GAS f16* MO = (const GAS f16*)(p.ws + WS_R2); GAS f16* H = (GAS f16*)(p.ws + WS_R4);
    const GAS float* modb = (const GAS float*)(p.ws + WS_MOD);
    const GAS float* in0 = IN(0); const GAS float* in1 = IN(1); const GAS float* ngb = IN(12);
    for (int rowb = row_first; rowb < row_end; rowb += NB * row_step) {
        f32x4 x[NB][4]; f16x4 mh[NB][4];
#pragma unroll
        for (int b = 0; b < NB; ++b) { const int row = rowb + b * row_step;
            if (row < row_end) {
                if (MODE == 0) { const GAS float* src = row < M_CTX ? in0 + (size_t)row * D : in1 + (size_t)(row - M_CTX) * D;
#pragma unroll
                    for (int j = 0; j < 4; ++j) x[b][j] = __builtin_nontemporal_load((const GAS f32x4*)(src + 256 * j + 4 * c.lane)); }
                else { const GAS float* xs = (MODE == 1 && l == 0) ? (row < M_CTX ? in0 + (size_t)row * D : in1 + (size_t)(row - M_CTX) * D) : X + (size_t)row * D;
#pragma unroll
                    for (int j = 0; j < 4; ++j) { x[b][j] = __builtin_nontemporal_load((const GAS f32x4*)(xs + 256 * j + 4 * c.lane));
                        mh[b][j] = __builtin_nontemporal_load((const GAS f16x4*)(MO + (size_t)row * D + 256 * j + 4 * c.lane)); } } } }
#pragma unroll
        for (int b = 0; b < NB; ++b) { const int row = rowb + b * row_step;
            if (row < row_end) {
                int g, t, T; row_info(row, g, t, T);
                if (MODE != 0) {
                    const GAS float* mo_mod = modb + ((size_t)l * 5 + g) * NMOD + (MODE == 1 ? 2 * D : 5 * D);
                    const GAS float* ngp = ngb + ((size_t)l * 4 + (MODE == 1 ? 1 : 3)) * D;
                    float mv[4][4]; float ss = 0.f;
#pragma unroll
                    for (int j = 0; j < 4; ++j)
#pragma unroll
                        for (int e = 0; e < 4; ++e) { mv[j][e] = (float)mh[b][j][e]; ss += mv[j][e] * mv[j][e]; }
                    const float rstd = rsqrtf(wave_sum(ss) * (1.0f / D) + 1e-6f);
#pragma unroll
                    for (int j = 0; j < 4; ++j) { const f32x4 gg = *(const GAS f32x4*)(mo_mod + 256 * j + 4 * c.lane); const f32x4 nn = *(const GAS f32x4*)(ngp + 256 * j + 4 * c.lane);
#pragma unroll
                        for (int e = 0; e < 4; ++e) x[b][j][e] += gg[e] * (mv[j][e] * rstd * nn[e]); }
                }
                const int ln = MODE == 2 ? l + 1 : l;
                if (ln < NL) {
                    const GAS float* mb = modb + ((size_t)ln * 5 + g) * NMOD + (MODE == 1 ? 3 * D : 0);
                    const GAS float* ngp = ngb + ((size_t)ln * 4 + (MODE == 1 ? 2 : 0)) * D;
                    float ss = 0.f;
#pragma unroll
                    for (int j = 0; j < 4; ++j) ss += (x[b][j][0] * x[b][j][0] + x[b][j][1] * x[b][j][1]) + (x[b][j][2] * x[b][j][2] + x[b][j][3] * x[b][j][3]);
                    const float rstd = rsqrtf(wave_sum(ss) * (1.0f / D) + 1e-6f);
#pragma unroll
                    for (int j = 0; j < 4; ++j) { const f32x4 sh = *(const GAS f32x4*)(mb + 256 * j + 4 * c.lane); const f32x4 sc = *(const GAS f32x4*)(mb + D + 256 * j + 4 * c.lane);
                        const f32x4 nn = *(const GAS f32x4*)(ngp + 256 * j + 4 * c.lane);
                        float o[4];
#pragma unroll
                        for (int e = 0; e < 4; ++e) o[e] = x[b][j][e] * rstd * nn[e] * (1.0f + sc[e]) + sh[e];
                        v2u w; w.x = pkh(o[0], o[1]); w.y = pkh(o[2], o[3]);
                        *(GAS v2u*)(H + (size_t)row * D + 256 * j + 4 * c.lane) = w; }
                }
                if (MODE != 0) {
#pragma unroll
                for (int j = 0; j < 4; ++j) __builtin_nontemporal_store(x[b][j], (GAS f32x4*)(X + (size_t)row * D + 256 * j + 4 * c.lane)); }
            } }
    }
}
template <int MODE>
__device__ __forceinline__ void norm_phase(const Params& p0, const Ctx& c0, int l) {
    const Ctx c = fresh(c0); FRESH_P(p0);
    norm_rows<MODE, 3>(p, c, l, c.gw, M, c.ngw);
}

namespace pg8 {
constexpr int BM = 256, BK = 64, HALF = 128, HTB = HALF * BK * 2, STAGE_BYTES = 8 * HTB, NXCD = 8, WGM = 8;
__host__ __device__ __forceinline__ int lds_byte(int r, int c) { const int st = (r >> 4) * 2 + (c >> 5), rr = r & 15, cc = c & 31, ob = rr * 64 + cc * 2; return st * 1024 + (ob ^ (((ob >> 9) & 1) << 5)); }
__host__ __device__ __forceinline__ void stage_rc(int b, int& R, int& C) { const int st = b / 1024, sb = b % 1024, swz = sb ^ (((sb >> 9) & 1) << 5); R = (st >> 1) * 16 + swz / 64; C = (st & 1) * 32 + (swz % 64) / 2; }
__host__ __device__ __forceinline__ int perm32(int rho) { const int n = rho >> 4, i = rho & 15; return 8 * (i >> 2) + 4 * n + (i & 3); }
struct Unit { int pm, pn; };
struct Gemm { const GAS f16* A; const GAS f16* Bt; int lda, ldb, K; };
struct StaticOrder {
    int nM, nN, nwg, G, c;
    __device__ void init(int Mr, int N, int G_, int c_, int bm = BM) { nM = Mr / bm; nN = N / BM; nwg = nM * nN; G = G_; c = c_; }
    __device__ bool next(int i, Unit& u) const {
        const long L = (long)i * G + c; if (c < 0 || L >= nwg) return false;
        int wgid = (int)L; { const int q = nwg / NXCD, r = nwg % NXCD, xcd = wgid % NXCD, off = wgid / NXCD; wgid = (xcd < r ? xcd * (q + 1) : r * (q + 1) + (xcd - r) * q) + off; }
        const int nig = WGM * nN, gid = wgid / nig, fm = gid * WGM, gsz = (nM - fm) < WGM ? (nM - fm) : WGM;
        u.pm = fm + ((wgid % nig) % gsz); u.pn = (wgid % nig) / gsz; return true;
    }
};
template <class Epi, int HA = 128, bool ALIGN_EPI = true, bool SP2 = true>
__device__ __forceinline__ void gemm_phase(LAS unsigned char* lds, const Gemm g, const StaticOrder& S, const Epi& E, int wave_sgpr) {
    asm volatile("" : "+s"(wave_sgpr)); int tid = wave_sgpr * 64 + lane_id(); asm volatile("" : "+v"(tid));
    const int wid = __builtin_amdgcn_readfirstlane(tid >> 6), lane = tid & 63, wr = wid >> 2, wc = wid & 3, fr = lane & 15, fq = lane >> 4;
    const int K = g.K, nt = K / BK;
    unsigned voffA[2], voffB[2];
#pragma unroll
    for (int i = 0; i < 2; ++i) { int R, C; stage_rc(tid * 16 + i * 8192, R, C); const int Rb = (R & ~31) + perm32(R & 31);
        voffA[i] = (unsigned)(R * g.lda + C) * 2u; voffB[i] = (unsigned)(Rb * g.ldb + C) * 2u; }
    const unsigned kstep = (unsigned)(BK * 2);
    constexpr int MF = HA / 32;
    const unsigned hstepA = (unsigned)HA * g.lda * 2, hstepB = (unsigned)HALF * g.ldb * 2;
    const unsigned tstepA = 2 * hstepA, tstepB = 2 * hstepB;
    const unsigned ldsw = (unsigned)wid * 1024u;
    const int aoff = lds_byte(wr * (HA / 2) + fr, fq * 8), boff = lds_byte(wc * 32 + fr, fq * 8);
#define PG8_SA(b, h) (((b) * 2 + (h)) * HTB)
#define PG8_SB(b, h) ((4 + (b) * 2 + (h)) * HTB)
#define PG8_STAGE(bufoff, gbase, soff, voff) do { _Pragma("unroll") for (int _i = 0; _i < 2; ++_i) \
        __builtin_amdgcn_raw_ptr_buffer_load_lds(rs##gbase, (LAS unsigned*)(lds + (bufoff) + ldsw + _i * 8192), 16, (voff)[_i], (int)(soff), 0, 0); } while (0)
#define PG8_LDA(dst, b, h) do { _Pragma("unroll") for (int m = 0; m < MF; ++m) _Pragma("unroll") for (int k = 0; k < 2; ++k) dst[m][k] = *(const LAS f16x8*)(lds + PG8_SA(b, h) + aoff + m * 2048 + k * 1024); } while (0)
#define PG8_LDB(dst, b, h) do { _Pragma("unroll") for (int n = 0; n < 2; ++n) _Pragma("unroll") for (int k = 0; k < 2; ++k) dst[n][k] = *(const LAS f16x8*)(lds + PG8_SB(b, h) + boff + n * 2048 + k * 1024); } while (0)
#define PG8_MMA(ai, bj, At, Bt) do { __builtin_amdgcn_s_setprio(1); _Pragma("unroll") for (int m = 0; m < MF; ++m) _Pragma("unroll") for (int n = 0; n < 2; ++n) _Pragma("unroll") for (int k = 0; k < 2; ++k) \
        acc[ai][bj][m][n] = __builtin_amdgcn_mfma_f32_16x16x32_f16(Bt[n][k], At[m][k], acc[ai][bj][m][n], 0, 0, 0); __builtin_amdgcn_s_setprio(0); } while (0)
#define PG8_WAIT_V(n) asm volatile("s_waitcnt vmcnt(" #n ")" ::: "memory")
#define PG8_WAIT_L(n) asm volatile("s_waitcnt lgkmcnt(" #n ")" ::: "memory")
#define PG8_BAR __builtin_amdgcn_s_barrier()
#define PG8_SCHED __builtin_amdgcn_sched_barrier(0)
    Unit cur, nxt; int ui = 0;
    if (!S.next(0, cur)) return;
    f32x4 acc[2][2][4][2];
#pragma unroll
    for (int a = 0; a < 2; ++a)
#pragma unroll
        for (int b = 0; b < 2; ++b)
#pragma unroll
            for (int m = 0; m < 4; ++m)
#pragma unroll
                for (int n = 0; n < 2; ++n) acc[a][b][m][n] = (f32x4){0.f, 0.f, 0.f, 0.f};
    f16x8 At[4][2], B0[2][2], B1[2][2];
    const auto rsA = __builtin_amdgcn_make_buffer_rsrc((GAS void*)g.A, 0, 0x7fffffff, 0x00020000); const auto rsB = __builtin_amdgcn_make_buffer_rsrc((GAS void*)g.Bt, 0, 0x7fffffff, 0x00020000);
    unsigned cA = (unsigned)cur.pm * tstepA, cB = (unsigned)cur.pn * tstepB;
    if constexpr (SP2) {
        PG8_STAGE(PG8_SB(0, 0), B, cB, voffB); PG8_STAGE(PG8_SB(0, 1), B, cB + hstepB, voffB); PG8_STAGE(PG8_SA(0, 0), A, cA, voffA); PG8_STAGE(PG8_SA(0, 1), A, cA + hstepA, voffA);
        if (wr == 1) PG8_BAR;
        PG8_WAIT_V(2); PG8_BAR;
        PG8_STAGE(PG8_SB(1, 0), B, cB + kstep, voffB); PG8_STAGE(PG8_SA(1, 0), A, cA + kstep, voffA); PG8_STAGE(PG8_SB(1, 1), B, cB + hstepB + kstep, voffB);
        PG8_WAIT_V(6); PG8_BAR;
    } else {
        PG8_STAGE(PG8_SB(0, 0), B, cB, voffB); PG8_STAGE(PG8_SA(0, 0), A, cA, voffA); PG8_STAGE(PG8_SB(0, 1), B, cB + hstepB, voffB); PG8_STAGE(PG8_SA(0, 1), A, cA + hstepA, voffA);
        if (wr == 1) PG8_BAR;
        PG8_WAIT_V(4); PG8_BAR;
        PG8_STAGE(PG8_SB(1, 0), B, cB + kstep, voffB); PG8_STAGE(PG8_SA(1, 0), A, cA + kstep, voffA); PG8_STAGE(PG8_SB(1, 1), B, cB + hstepB + kstep, voffB);
        PG8_WAIT_V(6); PG8_BAR;
    }
    for (;;) {
        const bool has_next = S.next(ui + 1, nxt);
        const unsigned nA = has_next ? (unsigned)nxt.pm * tstepA : cA, nB = has_next ? (unsigned)nxt.pn * tstepB : cB;
        for (int t = 0; t < nt; t += 2) {
            if constexpr (Epi::MID_T >= 0) { if (t == Epi::MID_T) { const int ln3 = lane_id(); E.template mid<HA>(acc, cur, wr, wc, ln3 & 15, ln3 >> 4); } }
            const bool last = (t == nt - 2);
            const unsigned a1 = cA + (unsigned)(t + 1) * kstep;
            const unsigned a2 = last ? nA : cA + (unsigned)(t + 2) * kstep, b2 = last ? nB : cB + (unsigned)(t + 2) * kstep;
            const unsigned a3 = a2 + kstep, b3 = b2 + kstep;
            if constexpr (SP2) {
            PG8_LDB(B0, 0, 0); PG8_LDB(B1, 0, 1); PG8_SCHED; PG8_LDA(At, 0, 0); PG8_STAGE(PG8_SA(1, 1), A, a1 + hstepA, voffA);
            PG8_WAIT_V(8); PG8_WAIT_L(0); PG8_BAR; PG8_MMA(0, 0, At, B0); PG8_MMA(0, 1, At, B1); PG8_BAR; PG8_SCHED;
            PG8_LDA(At, 0, 1); PG8_STAGE(PG8_SB(0, 0), B, b2, voffB); PG8_STAGE(PG8_SB(0, 1), B, b2 + hstepB, voffB); PG8_STAGE(PG8_SA(0, 0), A, a2, voffA);
            PG8_WAIT_V(8); PG8_WAIT_L(0); PG8_BAR; PG8_MMA(1, 0, At, B0); PG8_MMA(1, 1, At, B1); PG8_BAR; PG8_SCHED;
            PG8_LDB(B0, 1, 0); PG8_LDB(B1, 1, 1); PG8_SCHED; PG8_LDA(At, 1, 0); PG8_STAGE(PG8_SA(0, 1), A, a2 + hstepA, voffA);
            PG8_WAIT_V(8); PG8_WAIT_L(0); PG8_BAR; PG8_MMA(0, 0, At, B0); PG8_MMA(0, 1, At, B1); PG8_BAR; PG8_SCHED;
            PG8_LDA(At, 1, 1); PG8_STAGE(PG8_SB(1, 0), B, b3, voffB); PG8_STAGE(PG8_SB(1, 1), B, b3 + hstepB, voffB); PG8_STAGE(PG8_SA(1, 0), A, a3, voffA);
            PG8_WAIT_V(8); PG8_WAIT_L(0); PG8_BAR; PG8_MMA(1, 0, At, B0); PG8_MMA(1, 1, At, B1); PG8_BAR; PG8_SCHED;
            } else {
            PG8_LDB(B0, 0, 0); PG8_SCHED; PG8_LDA(At, 0, 0); PG8_STAGE(PG8_SA(1, 1), A, a1 + hstepA, voffA);
            PG8_WAIT_L(8); PG8_BAR; PG8_WAIT_L(0); PG8_MMA(0, 0, At, B0); PG8_BAR; PG8_SCHED;
            PG8_LDB(B1, 0, 1); PG8_STAGE(PG8_SB(0, 0), B, b2, voffB);
            PG8_BAR; PG8_WAIT_L(0); PG8_MMA(0, 1, At, B1); PG8_BAR;
            PG8_LDA(At, 0, 1); PG8_STAGE(PG8_SA(0, 0), A, a2, voffA);
            PG8_BAR; PG8_WAIT_L(0); PG8_MMA(1, 0, At, B0); PG8_BAR; PG8_SCHED;
            PG8_STAGE(PG8_SB(0, 1), B, b2 + hstepB, voffB);
            PG8_WAIT_V(6); PG8_BAR; PG8_MMA(1, 1, At, B1); PG8_BAR;
            PG8_LDB(B0, 1, 0); PG8_SCHED; PG8_LDA(At, 1, 0); PG8_STAGE(PG8_SA(0, 1), A, a2 + hstepA, voffA);
            PG8_WAIT_L(8); PG8_BAR; PG8_WAIT_L(0); PG8_MMA(0, 0, At, B0); PG8_BAR; PG8_SCHED;
            PG8_LDB(B1, 1, 1); PG8_STAGE(PG8_SB(1, 0), B, b3, voffB);
            PG8_BAR; PG8_WAIT_L(0); PG8_MMA(0, 1, At, B1); PG8_BAR;
            PG8_LDA(At, 1, 1); PG8_STAGE(PG8_SA(1, 0), A, a3, voffA);
            PG8_BAR; PG8_WAIT_L(0); PG8_MMA(1, 0, At, B0); PG8_BAR; PG8_SCHED;
            PG8_STAGE(PG8_SB(1, 1), B, b3 + hstepB, voffB);
            PG8_WAIT_V(6); PG8_BAR; PG8_MMA(1, 1, At, B1); PG8_BAR;
            }
        }
        if constexpr (ALIGN_EPI) { if (wr == 0) PG8_BAR; }
        { const int ln2 = lane_id(); E.template run<HA>(acc, cur, wr, wc, ln2 & 15, ln2 >> 4); }
        if (!has_next) break;
#pragma unroll
        for (int a = 0; a < 2; ++a)
#pragma unroll
            for (int b = 0; b < 2; ++b)
#pragma unroll
                for (int m = 0; m < 4; ++m)
#pragma unroll
                    for (int n = 0; n < 2; ++n) acc[a][b][m][n] = (f32x4){0.f, 0.f, 0.f, 0.f};
        cur = nxt; cA = nA; cB = nB; ++ui;
        if constexpr (ALIGN_EPI) { if (wr == 1) PG8_BAR; }
    }
    PG8_WAIT_V(0);
    if constexpr (!ALIGN_EPI) { if (wr == 0) PG8_BAR; }
    PG8_BAR;
#undef PG8_SA
#undef PG8_SB
#undef PG8_STAGE
#undef PG8_LDA
#undef PG8_LDB
#undef PG8_MMA
#undef PG8_WAIT_V
#undef PG8_WAIT_L
#undef PG8_BAR
#undef PG8_SCHED
}
typedef f32x4 Acc[2][2][4][2];
#define PG8_EPI_LOOP(...) \
    const int row0 = u.pm * (2 * HA) + wr * (HA / 2) + fr, col0 = u.pn * BM + wc * 32 + 8 * fq; \
    _Pragma("unroll") for (int ai = 0; ai < 2; ++ai) _Pragma("unroll") for (int m = 0; m < HA / 32; ++m) { const int row = row0 + ai * HA + m * 16; \
        _Pragma("unroll") for (int bj = 0; bj < 2; ++bj) { const int col = col0 + bj * HALF; f32x4 v0 = acc[ai][bj][m][0], v1 = acc[ai][bj][m][1]; __VA_ARGS__ } asm volatile("" ::: "memory"); }
__device__ __forceinline__ void store8(GAS f16* p, f32x4 v0, f32x4 v1) { v4u w; w.x = pkh(v0[0], v0[1]); w.y = pkh(v0[2], v0[3]); w.z = pkh(v1[0], v1[1]); w.w = pkh(v1[2], v1[3]); *(GAS v4u*)p = w; }
struct EpiProjF { static constexpr int MID_T = -1; GAS f16* P;
    template <int HA> __device__ __forceinline__ void run(const Acc& acc, const Unit& u, int wr, int wc, int fr, int fq) const {
        PG8_EPI_LOOP(
            if (u.pn == 6) {
                if (col < PC_LA) { _Pragma("unroll") for (int e = 0; e < 4; ++e) { v0[e] = tanhf_(v0[e]); v1[e] = tanhf_(v1[e]); } }
                else if (col >= PC_LG) { _Pragma("unroll") for (int e = 0; e < 4; ++e) { v0[e] = sigmoidf_(v0[e]); v1[e] = sigmoidf_(v1[e]); } }
            } else if (u.pn >= 10) { _Pragma("unroll") for (int e = 0; e < 4; ++e) { v0[e] = sigmoidf_(v0[e]); v1[e] = sigmoidf_(v1[e]); } }
            store8(P + (size_t)row * DIN + col, v0, v1);
        )
    } };
#define DPPM(x, ctrl) (x) *= __builtin_bit_cast(float, __builtin_amdgcn_update_dpp(0x3f800000, __builtin_bit_cast(int, (x)), (ctrl), 0xF, 0xF, false))
struct EpiWAF { static constexpr int MID_T = -1; GAS f16* WA; const GAS float* w0; const GAS float* a0;
    template <int HA> __device__ __forceinline__ void run(const Acc& acc, const Unit& u, int wr, int wc, int fr, int fq) const {
        PG8_EPI_LOOP(
            if (col < 1024) { const f32x4 b0 = *(const GAS f32x4*)(w0 + col), b1 = *(const GAS f32x4*)(w0 + col + 4);
                float x[8];
                _Pragma("unroll") for (int e = 0; e < 4; ++e) { x[e] = __expf(-0.606531f * sigmoidf_(v0[e] + b0[e])); x[4 + e] = __expf(-0.606531f * sigmoidf_(v1[e] + b1[e])); }
                if (col < 512) {
                    _Pragma("unroll") for (int e = 0; e < 8; ++e) { DPPM(x[e], 0x111); DPPM(x[e], 0x112); DPPM(x[e], 0x114); DPPM(x[e], 0x118);
                        const float wm = __builtin_bit_cast(float, __builtin_amdgcn_ds_swizzle(__builtin_bit_cast(int, x[e]), 0x00F0)); x[e] = (fr == 7) ? wm : x[e] * __builtin_amdgcn_rcpf(wm); }
                } else {
                    _Pragma("unroll") for (int e = 0; e < 8; ++e) { DPPM(x[e], 0x101); DPPM(x[e], 0x102); DPPM(x[e], 0x104); DPPM(x[e], 0x108);
                        const float wm = __builtin_bit_cast(float, __builtin_amdgcn_ds_swizzle(__builtin_bit_cast(int, x[e]), 0x0110)); x[e] = (fr == 8) ? wm : x[e] * __builtin_amdgcn_rcpf(wm); }
                }
                _Pragma("unroll") for (int e = 0; e < 4; ++e) { v0[e] = x[e]; v1[e] = x[4 + e]; } }
            else { const f32x4 b0 = *(const GAS f32x4*)(a0 + col - 1024), b1 = *(const GAS f32x4*)(a0 + col - 1024 + 4);
                _Pragma("unroll") for (int e = 0; e < 4; ++e) { v0[e] = sigmoidf_(v0[e] + b0[e]); v1[e] = sigmoidf_(v1[e] + b1[e]); } }
            store8(WA + (size_t)row * 2048 + col, v0, v1);
        )
    } };
struct EpiF16F { static constexpr int MID_T = -1; GAS f16* O; int ld;
    template <int HA> __device__ __forceinline__ void run(const Acc& acc, const Unit& u, int wr, int wc, int fr, int fq) const {
        PG8_EPI_LOOP( store8(O + (size_t)row * ld + col, v0, v1); )
    } };
struct EpiRelu2F { static constexpr int MID_T = -1; GAS f16* O; int ld;
    template <int HA> __device__ __forceinline__ void run(const Acc& acc, const Unit& u, int wr, int wc, int fr, int fq) const {
        PG8_EPI_LOOP(
            _Pragma("unroll") for (int e = 0; e < 4; ++e) { const float a = fmaxf(v0[e], 0.f), b = fmaxf(v1[e], 0.f); v0[e] = a * a; v1[e] = b * b; }
            store8(O + (size_t)row * ld + col, v0, v1);
        )
    } };
struct EpiMergeF { static constexpr int MID_T = 8; GAS f16* MG; const GAS f16* PROJ;
    template <int HA> __device__ __forceinline__ void mid(Acc& acc, const Unit& u, int wr, int wc, int fr, int fq) const {
        const int row0 = u.pm * (2 * HA) + wr * (HA / 2) + fr, col0 = u.pn * BM + wc * 32 + 8 * fq;
#pragma unroll
        for (int ai = 0; ai < 2; ++ai)
#pragma unroll
            for (int m = 0; m < HA / 32; ++m) { const int row = row0 + ai * HA + m * 16;
#pragma unroll
                for (int bj = 0; bj < 2; ++bj) { const int col = col0 + bj * HALF;
                    const f16x8 gr = *(const GAS f16x8*)(PROJ + (size_t)row * DIN + PC_GR + col), ga = *(const GAS f16x8*)(PROJ + (size_t)row * DIN + PC_GA + col);
#pragma unroll
                    for (int e = 0; e < 4; ++e) { acc[ai][bj][m][0][e] *= (float)gr[e] * __builtin_amdgcn_rcpf(fmaxf((float)ga[e], 1e-4f)); acc[ai][bj][m][1][e] *= (float)gr[4 + e] * __builtin_amdgcn_rcpf(fmaxf((float)ga[4 + e], 1e-4f)); } }
                asm volatile("" ::: "memory"); }
    }
    template <int HA> __device__ __forceinline__ void run(const Acc& acc, const Unit& u, int wr, int wc, int fr, int fq) const {
        PG8_EPI_LOOP(
            const f16x8 ga = *(const GAS f16x8*)(PROJ + (size_t)row * DIN + PC_GA + col);
            _Pragma("unroll") for (int e = 0; e < 4; ++e) { v0[e] *= fmaxf((float)ga[e], 1e-4f); v1[e] *= fmaxf((float)ga[4 + e], 1e-4f); }
            store8(MG + (size_t)row * D + col, v0, v1);
        )
    } };
}

__device__ __forceinline__ void kv_prep(const Params& p0, const Ctx& c0, int l) {
    const Ctx c = fresh(c0); FRESH_P(p0);
    const GAS f16* PROJ = (const GAS f16*)(p.ws + WS_R1); GAS f16* KN = (GAS f16*)(p.ws + WS_KN); GAS f16* VT = (GAS f16*)(p.ws + WS_VT);
    const int d = c.lane;
    const float kg = IN(27)[l * HD + d];
    const int axis = d >> 5, half = (d >> 4) & 1, f = d & 15;
    const float freq = exp2f(-(float)f * (13.287712379549449f / 16.0f));
    for (int it = c.gw; it < (M / 8) * 2; it += c.ngw) {
        const int kvh = it & 1, row0 = (it >> 1) * 8;
        float kx[8], vx[8];
#pragma unroll
        for (int r = 0; r < 8; ++r) { const GAS f16* pr = PROJ + (size_t)(row0 + r) * DIN + kvh * HD + d; kx[r] = (float)pr[PC_KA]; vx[r] = (float)pr[PC_VA]; }
#pragma unroll
        for (int r = 0; r < 8; ++r) kx[r] = kx[r] * rsqrtf(wave_sum(kx[r] * kx[r]) * (1.0f / HD) + 1e-6f) * kg;
        f16x8 vv;
#pragma unroll
        for (int r = 0; r < 8; ++r) vv[r] = (f16)vx[r];
        if (row0 < M_CTX) { const int b = row0 >> 8, t0 = row0 & 255;
#pragma unroll
            for (int r = 0; r < 8; ++r) { const size_t o = ((((size_t)b * NL + l) * T_CTX + t0 + r) * 2 + kvh) * HD + d;
                p.out[O_CK + o] = kx[r]; p.out[O_CV + o] = vx[r];
                KN[(((size_t)b * 2 + kvh) * T_CTX + t0 + r) * HD + d] = (f16)kx[r]; }
            *(GAS f16x8*)(VT + (((size_t)b * 2 + kvh) * HD + d) * T_CTX + t0) = vv;
        } else { const int rr = row0 - M_CTX, b = rr >> 10, t0 = rr & 1023;
#pragma unroll
            for (int r = 0; r < 8; ++r) { const int t = t0 + r; const float pos = (float)(axis == 0 ? (t >> 6) : (t & 63));
                const float ang = pos * freq; const float cs = __cosf(ang), sn = __sinf(ang);
                const float other = xor16(kx[r]);
                const float ko = half == 0 ? kx[r] * cs - other * sn : kx[r] * cs + other * sn;
                KN[KN_SMP_OFF + (((size_t)b * 2 + kvh) * KV_SMP + PAST + t) * HD + d] = (f16)ko; }
            *(GAS f16x8*)(VT + KN_SMP_OFF + (((size_t)b * 2 + kvh) * HD + d) * KV_SMP + PAST + t0) = vv;
        }
    }
    for (int it = c.gw; it < B_SMP * (PAST / 8) * 2; it += c.ngw) {
        const int kvh = it & 1, j0 = ((it >> 1) & 31) * 8, b = it >> 6;
        f16x8 vv;
#pragma unroll
        for (int r = 0; r < 8; ++r) { const size_t s = ((((size_t)b * NL + l) * PAST + j0 + r) * 2 + kvh) * HD + d;
            KN[KN_SMP_OFF + (((size_t)b * 2 + kvh) * KV_SMP + j0 + r) * HD + d] = (f16)IN(2)[s]; vv[r] = (f16)IN(3)[s]; }
        *(GAS f16x8*)(VT + KN_SMP_OFF + (((size_t)b * 2 + kvh) * HD + d) * KV_SMP + j0) = vv;
    }
}

constexpr int TC = 32, ST_STEP = 6 * 64, ST_BUF = TC * ST_STEP;
struct StageRegs { f16x4 r[3], k[3], v[3], w, a; };
__device__ __forceinline__ void scan_task(const DParams& p, const Ctx& c, int l, int task) {
    const GAS f16* PROJ = (const GAS f16*)(p.ws + WS_R1); const GAS f16* WA = (const GAS f16*)(p.ws + WS_R2);
    GAS f16* Y = (GAS f16*)(p.ws + WS_R3); GAS float* RK = (GAS float*)(p.ws + WS_RK);
    LAS float* st = (LAS float*)c.lds;
    int sq, dir, h;
    if (task < 64) { h = task & 7; dir = (task >> 3) & 1; sq = B_CTX + (task >> 4); } else { const int id = task - 64; h = id & 7; dir = (id >> 3) & 1; sq = id >> 4; }
    const bool smp = sq >= B_CTX; const int T = smp ? T_SMP : T_CTX; const int row0 = smp ? M_CTX + (sq - B_CTX) * T_SMP : sq * T_CTX;
    const int nch = T / TC;
    const int tt = c.tid >> 4, cq = c.tid & 15, ch0 = h * HD + cq * 4;
    const f32x4 mu_r = *(const GAS f32x4*)(IN(15) + (l * 3 + 0) * CW + ch0), mu_k = *(const GAS f32x4*)(IN(15) + (l * 3 + 1) * CW + ch0), mu_v = *(const GAS f32x4*)(IN(15) + (l * 3 + 2) * CW + ch0);
    const f32x4 k_k = *(const GAS f32x4*)(IN(16) + l * CW + ch0), k_a = *(const GAS f32x4*)(IN(17) + l * CW + ch0), r_k = *(const GAS f32x4*)(IN(18) + l * CW + ch0);
    const int ks = c.lane & 7, srow = c.wave * 8 + (c.lane >> 3);
    float S[8];
    if (smp) { const GAS float* s0 = IN(4) + (((((size_t)(sq - B_CTX) * NL + l) * 2 + dir) * NH + h) * HD + srow) * HD + ks * 8;
        const f32x4 a = *(const GAS f32x4*)s0, b = *(const GAS f32x4*)(s0 + 4);
        S[0] = a[0]; S[1] = a[1]; S[2] = a[2]; S[3] = a[3]; S[4] = b[0]; S[5] = b[1]; S[6] = b[2]; S[7] = b[3];
    } else {
#pragma unroll
        for (int j = 0; j < 8; ++j) S[j] = 0.f;
    }
    StageRegs sr;
    const f16x4 z4 = {(f16)0.f, (f16)0.f, (f16)0.f, (f16)0.f};
#define SCAN_LOAD(chunk) do { const int S_ = (chunk) * TC + tt; const int t_ = dir ? T - 1 - S_ : S_; const GAS f16* pr_ = PROJ + (size_t)(row0 + t_) * DIN + ch0; \
        sr.r[1] = *(const GAS f16x4*)(pr_ + PC_R); sr.k[1] = *(const GAS f16x4*)(pr_ + PC_K); sr.v[1] = *(const GAS f16x4*)(pr_ + PC_V); \
        if (t_ > 0) { sr.r[0] = *(const GAS f16x4*)(pr_ - DIN + PC_R); sr.k[0] = *(const GAS f16x4*)(pr_ - DIN + PC_K); sr.v[0] = *(const GAS f16x4*)(pr_ - DIN + PC_V); } else { sr.r[0] = z4; sr.k[0] = z4; sr.v[0] = z4; } \
        if (t_ < T - 1) { sr.r[2] = *(const GAS f16x4*)(pr_ + DIN + PC_R); sr.k[2] = *(const GAS f16x4*)(pr_ + DIN + PC_K); sr.v[2] = *(const GAS f16x4*)(pr_ + DIN + PC_V); } else { sr.r[2] = z4; sr.k[2] = z4; sr.v[2] = z4; } \
        const GAS f16* wa_ = WA + (size_t)(row0 + t_) * 2048 + dir * 512 + ch0; sr.w = *(const GAS f16x4*)wa_; sr.a = *(const GAS f16x4*)(wa_ + 1024); } while (0)
#define SCAN_STAGE(chunk) do { const int S_ = (chunk) * TC + tt; const int t_ = dir ? T - 1 - S_ : S_; \
        f32x4 r_, k_, v_, kk_, w_, a_, kh_, kt_, b_; float ss_ = 0.f, rk_ = 0.f; \
        _Pragma("unroll") for (int e = 0; e < 4; ++e) { const float rc = (float)sr.r[1][e], kc = (float)sr.k[1][e], vc = (float)sr.v[1][e]; \
            r_[e] = rc + mu_r[e] * (0.5f * ((float)sr.r[0][e] + (float)sr.r[2][e]) - rc); k_[e] = kc + mu_k[e] * (0.5f * ((float)sr.k[0][e] + (float)sr.k[2][e]) - kc); \
            v_[e] = vc + mu_v[e] * (0.5f * ((float)sr.v[0][e] + (float)sr.v[2][e]) - vc); kk_[e] = k_[e] * k_k[e]; ss_ += kk_[e] * kk_[e]; w_[e] = (float)sr.w[e]; a_[e] = (float)sr.a[e]; } \
        ss_ = dpp_sum16(ss_); const float ri_ = rsqrtf(ss_ + 1e-12f); \
        _Pragma("unroll") for (int e = 0; e < 4; ++e) { kh_[e] = kk_[e] * ri_; kt_[e] = k_[e] * (1.0f + (a_[e] - 1.0f) * k_a[e]); b_[e] = a_[e] * kh_[e]; rk_ += r_[e] * kt_[e] * r_k[e]; } \
        rk_ = dpp_sum16(rk_); if (cq == 0) RK[((size_t)dir * M + row0 + t_) * 8 + h] = rk_; \
        LAS float* sb_ = st + ((chunk) & 1) * ST_BUF + tt * ST_STEP + cq * 4; \
        *(LAS f32x4*)(sb_) = kh_; *(LAS f32x4*)(sb_ + 64) = w_; *(LAS f32x4*)(sb_ + 128) = b_; *(LAS f32x4*)(sb_ + 192) = kt_; *(LAS f32x4*)(sb_ + 256) = r_; *(LAS f32x4*)(sb_ + 320) = v_; } while (0)
    SCAN_LOAD(0);
    SCAN_STAGE(0);
    __syncthreads();
    for (int chunk = 0; chunk < nch; ++chunk) {
        if (chunk + 1 < nch) SCAN_LOAD(chunk + 1);
        const LAS float* sb = st + (chunk & 1) * ST_BUF + ks * 8;
        const LAS float* vb = st + (chunk & 1) * ST_BUF + 320 + srow;
#pragma unroll 2
        for (int s = 0; s < TC; ++s) {
            const LAS float* q = sb + s * ST_STEP;
            const f32x4 kh0 = *(const LAS f32x4*)(q), kh1 = *(const LAS f32x4*)(q + 4);
            const f32x4 w0 = *(const LAS f32x4*)(q + 64), w1 = *(const LAS f32x4*)(q + 68);
            const f32x4 b0 = *(const LAS f32x4*)(q + 128), b1 = *(const LAS f32x4*)(q + 132);
            const f32x4 t0 = *(const LAS f32x4*)(q + 192), t1 = *(const LAS f32x4*)(q + 196);
            const f32x4 r0 = *(const LAS f32x4*)(q + 256), r1 = *(const LAS f32x4*)(q + 260);
            const float v = vb[s * ST_STEP];
            float sk = (S[0] * kh0[0] + S[1] * kh0[1]) + (S[2] * kh0[2] + S[3] * kh0[3]) + ((S[4] * kh1[0] + S[5] * kh1[1]) + (S[6] * kh1[2] + S[7] * kh1[3]));
            sk = dpp_sum8(sk);
#pragma unroll
            for (int e = 0; e < 4; ++e) { S[e] = S[e] * w0[e] + (v * t0[e] - sk * b0[e]); S[4 + e] = S[4 + e] * w1[e] + (v * t1[e] - sk * b1[e]); }
            float y = (S[0] * r0[0] + S[1] * r0[1]) + (S[2] * r0[2] + S[3] * r0[3]) + ((S[4] * r1[0] + S[5] * r1[1]) + (S[6] * r1[2] + S[7] * r1[3]));
            y = dpp_sum8(y);
            const int Sg = chunk * TC + s; const int t = dir ? T - 1 - Sg : Sg;
            if (ks == 0) Y[((size_t)dir * M + row0 + t) * CW + h * HD + srow] = (f16)y;
        }
        if (chunk + 1 < nch) SCAN_STAGE(chunk + 1);
        __syncthreads();
    }
#undef SCAN_LOAD
#undef SCAN_STAGE
    if (!smp) { GAS float* so = p.out + O_ST + (((((size_t)sq * NL + l) * 2 + dir) * NH + h) * HD + srow) * HD + ks * 8;
        *(GAS f32x4*)so = (f32x4){S[0], S[1], S[2], S[3]}; *(GAS f32x4*)(so + 4) = (f32x4){S[4], S[5], S[6], S[7]}; }
}
__device__ __forceinline__ void fast_scan(const Params& p0, const Ctx& c0, int l) {
    const Ctx c = fresh(c0); FRESH_P(p0);
    const int b = c.bid;
    if (b < 64) scan_task(p, c, l, b);
    else for (int task = b; task < 576; task += 192) scan_task(p, c, l, task);
}


namespace ms {
constexpr int O_AM = 0, O_BM = 4608, O_AT = 9216, O_VP = 14336, O_GT = 19456, O_NF = 22016, O_WM = 23040, O_WE = 23296, BUF = 23552;
constexpr int RS = 144, RT = 80;
}
__device__ __forceinline__ void mscan_task(const DParams& p, const Ctx& c, int l, int task) {
    using namespace ms;
    const GAS f16* PROJ = (const GAS f16*)(p.ws + WS_R1); const GAS f16* WA = (const GAS f16*)(p.ws + WS_R2);
    GAS f16* Y = (GAS f16*)(p.ws + WS_R3); GAS float* RK = (GAS float*)(p.ws + WS_RK);
    int sq, dir, h;
    if (task < 64) { h = task & 7; dir = (task >> 3) & 1; sq = B_CTX + (task >> 4); } else { const int id = task - 64; h = id & 7; dir = (id >> 3) & 1; sq = id >> 4; }
    const bool smp = sq >= B_CTX; const int T = smp ? T_SMP : T_CTX; const int row0 = smp ? M_CTX + (sq - B_CTX) * T_SMP : sq * T_CTX;
    const int nch = T / 16;
    const int vl = c.lane & 31, hh = c.lane >> 5;
    const int tq = c.tid - 128, ss = (tq >> 4) & 15, cq = tq & 15, k0 = cq * 4, ch0 = h * HD + k0;
    LAS float* cst = (LAS float*)(c.lds + 3 * BUF);
    if (c.wave == 7) { const int chn_ = h * HD + c.lane;
        cst[c.lane] = IN(15)[(l * 3 + 0) * CW + chn_]; cst[64 + c.lane] = IN(15)[(l * 3 + 1) * CW + chn_]; cst[128 + c.lane] = IN(15)[(l * 3 + 2) * CW + chn_];
        cst[192 + c.lane] = IN(16)[l * CW + chn_]; cst[256 + c.lane] = IN(17)[l * CW + chn_]; cst[320 + c.lane] = IN(18)[l * CW + chn_]; }

#define MS_BARRIER() do { asm volatile("s_waitcnt lgkmcnt(0)" ::: "memory"); __builtin_amdgcn_s_barrier(); asm volatile("" ::: "memory"); } while (0)
    if (c.wave >= 2 && c.wave < 6) {
    f16x4 G_rc, G_kc, G_vc, G_rp, G_kp, G_vp, G_rn, G_kn, G_vn, G_av, G_wo, G_wp, G_w7;
    { const f16x4 z4 = {(f16)0.f, (f16)0.f, (f16)0.f, (f16)0.f}; G_rc = G_kc = G_vc = G_rp = G_kp = G_vp = G_rn = G_kn = G_vn = G_av = G_wo = G_wp = G_w7 = z4; }
        for (int it = -3; it < nch; ++it) {
            const int ch = it + 2;
            if (ch >= 0 && ch < nch) {
                LAS unsigned char* buf = c.lds + (ch % 3) * BUF;
                const int Sg = ch * 16 + ss; const int t = dir ? T - 1 - Sg : Sg; const size_t row = (size_t)row0 + t;
                const f32x4 mu_r = *(const LAS f32x4*)(cst + k0), mu_k = *(const LAS f32x4*)(cst + 64 + k0), mu_v = *(const LAS f32x4*)(cst + 128 + k0), k_k = *(const LAS f32x4*)(cst + 192 + k0), k_a = *(const LAS f32x4*)(cst + 256 + k0), r_k = *(const LAS f32x4*)(cst + 320 + k0);
                f32x4 r_, k_, v_, kk_, kh_, kt_, b_; float sq_ = 0.f, rk_ = 0.f;
#pragma unroll
                for (int e = 0; e < 4; ++e) { const float rcf = (float)G_rc[e], kcf = (float)G_kc[e], vcf = (float)G_vc[e];
                    r_[e] = rcf + mu_r[e] * (0.5f * ((float)G_rp[e] + (float)G_rn[e]) - rcf); k_[e] = kcf + mu_k[e] * (0.5f * ((float)G_kp[e] + (float)G_kn[e]) - kcf);
                    v_[e] = vcf + mu_v[e] * (0.5f * ((float)G_vp[e] + (float)G_vn[e]) - vcf); kk_[e] = k_[e] * k_k[e]; sq_ += kk_[e] * kk_[e]; }
                sq_ = dpp_sum16(sq_); const float ri_ = rsqrtf(sq_ + 1e-12f);
#pragma unroll
                for (int e = 0; e < 4; ++e) { const float a_ = (float)G_av[e]; kh_[e] = kk_[e] * ri_; kt_[e] = k_[e] * (1.0f + (a_ - 1.0f) * k_a[e]); b_[e] = a_ * kh_[e]; rk_ += r_[e] * kt_[e] * r_k[e]; }
                rk_ = dpp_sum16(rk_); if (cq == 0) RK[((size_t)dir * M + row) * 8 + h] = rk_;
                float al[4], be[4], ka[4], rho[4];
#pragma unroll
                for (int e = 0; e < 4; ++e) { const float wm7 = (float)G_w7[e]; const float om = ss == 7 ? 1.0f : (float)G_wo[e]; const float omp = ss == 0 ? __builtin_amdgcn_rcpf(wm7) : (ss == 8 ? 1.0f : (float)G_wp[e]);
                    const float iom = __builtin_amdgcn_rcpf(om); al[e] = omp * kh_[e]; be[e] = b_[e] * iom; ka[e] = kt_[e] * iom; rho[e] = om * r_[e]; }
                v2u w2;
                w2.x = pkh(al[0], al[1]); w2.y = pkh(al[2], al[3]); *(LAS v2u*)(buf + O_BM + ss * RS + k0 * 2) = w2;
                w2.x = pkh(rho[0], rho[1]); w2.y = pkh(rho[2], rho[3]); *(LAS v2u*)(buf + O_BM + (16 + ss) * RS + k0 * 2) = w2;
                w2.x = pkh(be[0], be[1]); w2.y = pkh(be[2], be[3]); *(LAS v2u*)(buf + O_AM + ss * RS + k0 * 2) = w2;
                w2.x = pkh(ka[0], ka[1]); w2.y = pkh(ka[2], ka[3]); *(LAS v2u*)(buf + O_AM + (16 + ss) * RS + k0 * 2) = w2;
#pragma unroll
                for (int e = 0; e < 4; ++e) { *(LAS f16*)(buf + O_AT + (k0 + e) * RT + ss * 2) = (f16)ka[e]; *(LAS f16*)(buf + O_AT + (k0 + e) * RT + (16 + ss) * 2) = (f16)be[e];
                    *(LAS f16*)(buf + O_VP + (k0 + e) * RT + ss * 2) = (f16)v_[e]; }
                if (ss == 15) { f32x4 wm_, we_;
#pragma unroll
                    for (int e = 0; e < 4; ++e) { wm_[e] = (float)G_w7[e]; we_[e] = (float)G_wo[e]; }
                    *(LAS f32x4*)(buf + O_WM + k0 * 4) = wm_; *(LAS f32x4*)(buf + O_WE + k0 * 4) = we_; }
            }
            const int chn = it + 3;
            if (chn < nch) {
                const int Sg = chn * 16 + ss; const int t = dir ? T - 1 - Sg : Sg; const size_t row = (size_t)row0 + t;
                const GAS f16* pr = PROJ + row * DIN + ch0;
                const f16x4 z4 = {(f16)0.f, (f16)0.f, (f16)0.f, (f16)0.f};
                G_rc = *(const GAS f16x4*)(pr + PC_R); G_kc = *(const GAS f16x4*)(pr + PC_K); G_vc = *(const GAS f16x4*)(pr + PC_V);
                G_rp = z4; G_kp = z4; G_vp = z4; G_rn = z4; G_kn = z4; G_vn = z4;
                if (t > 0) { G_rp = *(const GAS f16x4*)(pr - DIN + PC_R); G_kp = *(const GAS f16x4*)(pr - DIN + PC_K); G_vp = *(const GAS f16x4*)(pr - DIN + PC_V); }
                if (t < T - 1) { G_rn = *(const GAS f16x4*)(pr + DIN + PC_R); G_kn = *(const GAS f16x4*)(pr + DIN + PC_K); G_vn = *(const GAS f16x4*)(pr + DIN + PC_V); }
                G_av = *(const GAS f16x4*)(WA + row * 2048 + 1024 + dir * 512 + ch0);
                const GAS f16* wo = WA + row * 2048 + dir * 512 + ch0;
                G_wo = *(const GAS f16x4*)wo; G_wp = *(const GAS f16x4*)(wo + (ss > 0 ? (dir ? 2048 : -2048) : 0)); G_w7 = *(const GAS f16x4*)(wo + (long)(7 - ss) * (dir ? -2048 : 2048));
            }
            MS_BARRIER();
        }
    } else if (c.wave == 6) {
        for (int it = -3; it < nch; ++it) {
            const int ch = it + 1;
            if (ch >= 0 && ch < nch) {
                LAS unsigned char* buf = c.lds + (ch % 3) * BUF;
                f32x16 g;
#pragma unroll
                for (int i = 0; i < 16; ++i) g[i] = 0.f;
#pragma unroll
                for (int s = 0; s < 4; ++s) { const f16x8 a = *(const LAS f16x8*)(buf + O_AM + vl * RS + (16 * s + 8 * hh) * 2), b = *(const LAS f16x8*)(buf + O_BM + vl * RS + (16 * s + 8 * hh) * 2);
                    g = __builtin_amdgcn_mfma_f32_32x32x16_f16(a, b, g, 0, 0, 0); }
                const int tcol = vl & 15; const bool incl = vl >= 16;
#pragma unroll
                for (int gq = 0; gq < 4; ++gq) { float o[4];
#pragma unroll
                    for (int e = 0; e < 4; ++e) { const int ip = 8 * gq + 4 * hh + e, i = ip & 15; const bool ok = incl ? (i <= tcol) : (i < tcol); o[e] = ok ? g[4 * gq + e] : 0.f; }
                    v2u w2; w2.x = pkh(o[0], o[1]); w2.y = pkh(o[2], o[3]);
                    *(LAS v2u*)(buf + O_GT + vl * RT + (8 * gq + 4 * hh) * 2) = w2;
                    if (gq < 2 && vl < 16) *(LAS f32x4*)(buf + O_NF + vl * 64 + (8 * gq + 4 * hh) * 4) = (f32x4){o[0], o[1], o[2], o[3]}; }
            }
            MS_BARRIER();
        }
    } else if (c.wave == 7) {
        unsigned pa0 = 0u, pa1 = 0u, pb0 = 0u, pb1 = 0u, pc0 = 0u, pc1 = 0u;
#define MS_TOUCH(chp_, r0_, r1_) do { const int chp = (chp_); if (chp < nch) { \
            _Pragma("unroll") for (int q_ = 0; q_ < 2; ++q_) { const int i_ = c.lane + 64 * q_; if (i_ < 86) { const GAS unsigned* a_; \
                if (i_ < 54) { const int rr_ = i_ / 3, sg_ = i_ - 3 * rr_; int t_ = dir ? T - 17 - 16 * chp + rr_ : 16 * chp - 1 + rr_; t_ = t_ < 0 ? 0 : (t_ > T - 1 ? T - 1 : t_); \
                    a_ = (const GAS unsigned*)(PROJ + (size_t)(row0 + t_) * DIN + (sg_ == 0 ? PC_R : (sg_ == 1 ? PC_K : PC_V)) + h * HD); } \
                else { const int j_ = i_ - 54, rr_ = j_ >> 1; const int t_ = dir ? T - 16 - 16 * chp + rr_ : 16 * chp + rr_; \
                    a_ = (const GAS unsigned*)(WA + (size_t)(row0 + t_) * 2048 + (j_ & 1) * 1024 + dir * 512 + h * HD); } \
                if (q_ == 0) r0_ = *a_; else r1_ = *a_; } } } } while (0)
        for (int it = -3; it < nch; it += 3) {
            asm volatile("" :: "v"(pa0), "v"(pa1));
            if (it == -3) { MS_TOUCH(0, pa0, pa1); asm volatile("" :: "v"(pa0), "v"(pa1)); MS_TOUCH(1, pa0, pa1); asm volatile("" :: "v"(pa0), "v"(pa1)); MS_TOUCH(2, pa0, pa1); asm volatile("" :: "v"(pa0), "v"(pa1));
                            MS_TOUCH(3, pa0, pa1); asm volatile("" :: "v"(pa0), "v"(pa1)); MS_TOUCH(4, pa0, pa1); asm volatile("" :: "v"(pa0), "v"(pa1)); MS_TOUCH(5, pa0, pa1); }
            else MS_TOUCH(it + 9, pa0, pa1);
            MS_BARRIER();
            if (it + 1 < nch) { asm volatile("" :: "v"(pb0), "v"(pb1)); MS_TOUCH(it + 10, pb0, pb1); MS_BARRIER(); }
            if (it + 2 < nch) { asm volatile("" :: "v"(pc0), "v"(pc1)); MS_TOUCH(it + 11, pc0, pc1); MS_BARRIER(); }
        }
#undef MS_TOUCH
    } else {
    f32x16 St0, St1;
#pragma unroll
    for (int i = 0; i < 16; ++i) { St0[i] = 0.f; St1[i] = 0.f; }
    if (smp) { float one_ = 1.0f; asm volatile("" : "+v"(one_));
        const GAS float* s0 = IN(4) + (((((size_t)(sq - B_CTX) * NL + l) * 2 + dir) * NH + h) * HD + 32 * c.wave + vl) * HD + 4 * hh;
#pragma unroll
        for (int g = 0; g < 4; ++g) { const f32x4 a = *(const GAS f32x4*)(s0 + 8 * g), b = *(const GAS f32x4*)(s0 + 32 + 8 * g);
#pragma unroll
            for (int e = 0; e < 4; ++e) { St0[4 * g + e] = a[e] * one_; St1[4 * g + e] = b[e] * one_; } }
    }
        for (int it = -3; it < nch; ++it) {
            const int ch = it;
            if (ch >= 0) {
                LAS unsigned char* buf = c.lds + (ch % 3) * BUF;
                const int v = 32 * c.wave + vl;
                if (ch == 0) {
#pragma unroll
                for (int gq = 0; gq < 4; ++gq) { const f32x4 m0 = *(const LAS f32x4*)(buf + O_WM + (8 * gq + 4 * hh) * 4), m1 = *(const LAS f32x4*)(buf + O_WM + (32 + 8 * gq + 4 * hh) * 4);
#pragma unroll
                    for (int e = 0; e < 4; ++e) { St0[4 * gq + e] *= m0[e]; St1[4 * gq + e] *= m1[e]; } }
                }
                f32x16 X;
#pragma unroll
                for (int i = 0; i < 16; ++i) X[i] = 0.f;
#pragma unroll
                for (int s = 0; s < 4; ++s) {
                    f16x8 sb;
#pragma unroll
                    for (int j = 0; j < 8; ++j) sb[j] = (f16)((s < 2) ? St0[8 * (s & 1) + j] : St1[8 * (s & 1) + j]);
                    const f16x4 lo = *(const LAS f16x4*)(buf + O_BM + vl * RS + (16 * s + 4 * hh) * 2), hi = *(const LAS f16x4*)(buf + O_BM + vl * RS + (16 * s + 8 + 4 * hh) * 2);
                    const f16x8 af = {lo[0], lo[1], lo[2], lo[3], hi[0], hi[1], hi[2], hi[3]};
                    X = __builtin_amdgcn_mfma_f32_32x32x16_f16(af, sb, X, 0, 0, 0);
                }
                { const f16x8 a = *(const LAS f16x8*)(buf + O_GT + vl * RT + (16 + 8 * hh) * 2), b = *(const LAS f16x8*)(buf + O_VP + v * RT + (8 * hh) * 2);
                  X = __builtin_amdgcn_mfma_f32_32x32x16_f16(a, b, X, 0, 0, 0); }
                const f16x8 aN = *(const LAS f16x8*)(buf + O_GT + vl * RT + (8 * hh) * 2);
                f16x8 pball;
#pragma unroll
                for (int j = 0; j < 8; ++j) pball[j] = (f16)0.f;
#define MS_BLK(a) do { const int xo_ = 4 * ((a) >> 1); \
                    const f32x4 n1_ = *(const LAS f32x4*)(buf + O_NF + (4 * (a) + 1) * 64 + 16 * (a)), n2_ = *(const LAS f32x4*)(buf + O_NF + (4 * (a) + 2) * 64 + 16 * (a)), n3_ = *(const LAS f32x4*)(buf + O_NF + (4 * (a) + 3) * 64 + 16 * (a)); \
                    float q0_ = X[xo_]; float q1_ = X[xo_ + 1] - q0_ * n1_[0]; float q2_ = X[xo_ + 2] - q0_ * n2_[0] - q1_ * n2_[1]; float q3_ = X[xo_ + 3] - q0_ * n3_[0] - q1_ * n3_[1] - q2_ * n3_[2]; \
                    if (((a) & 1) != ((a) >> 1)) { float a_, b_; \
                        a_ = q0_; b_ = q0_; swap32(a_, b_); q0_ = ((a) & 1) ? b_ : a_; a_ = q1_; b_ = q1_; swap32(a_, b_); q1_ = ((a) & 1) ? b_ : a_; \
                        a_ = q2_; b_ = q2_; swap32(a_, b_); q2_ = ((a) & 1) ? b_ : a_; a_ = q3_; b_ = q3_; swap32(a_, b_); q3_ = ((a) & 1) ? b_ : a_; } \
                    const bool hold_ = hh == ((a) >> 1); \
                    const f16 z_ = (f16)0.f; const f16 e0_ = hold_ ? (f16)(-q0_) : z_, e1_ = hold_ ? (f16)(-q1_) : z_, e2_ = hold_ ? (f16)(-q2_) : z_, e3_ = hold_ ? (f16)(-q3_) : z_; \
                    f16x8 pb_ = {z_, z_, z_, z_, z_, z_, z_, z_}; \
                    pb_[4 * ((a) & 1)] = e0_; pb_[4 * ((a) & 1) + 1] = e1_; pb_[4 * ((a) & 1) + 2] = e2_; pb_[4 * ((a) & 1) + 3] = e3_; \
                    if (hold_) { pball[4 * ((a) & 1)] = e0_; pball[4 * ((a) & 1) + 1] = e1_; pball[4 * ((a) & 1) + 2] = e2_; pball[4 * ((a) & 1) + 3] = e3_; } \
                    X = __builtin_amdgcn_mfma_f32_32x32x16_f16(aN, pb_, X, 0, 0, 0); } while (0)
                MS_BLK(0); MS_BLK(1); MS_BLK(2); MS_BLK(3);
#undef MS_BLK
#pragma unroll
                for (int r = 8; r < 16; ++r) { const int t = (r & 3) + 8 * ((r >> 2) - 2) + 4 * hh; const int Sg = ch * 16 + t; const int tok = dir ? T - 1 - Sg : Sg;
                    Y[((size_t)dir * M + row0 + tok) * CW + h * HD + v] = (f16)X[r]; }
#pragma unroll
                for (int s2 = 0; s2 < 2; ++s2) { const f16x8 b = s2 == 0 ? *(const LAS f16x8*)(buf + O_VP + v * RT + (8 * hh) * 2) : pball;
                    const f16x8 a0 = *(const LAS f16x8*)(buf + O_AT + vl * RT + (16 * s2 + 8 * hh) * 2), a1 = *(const LAS f16x8*)(buf + O_AT + (32 + vl) * RT + (16 * s2 + 8 * hh) * 2);
                    St0 = __builtin_amdgcn_mfma_f32_32x32x16_f16(a0, b, St0, 0, 0, 0); St1 = __builtin_amdgcn_mfma_f32_32x32x16_f16(a1, b, St1, 0, 0, 0); }
                { LAS unsigned char* nbuf = c.lds + ((ch + 1) % 3) * BUF; const bool more = ch + 1 < nch;
#pragma unroll
                for (int gq = 0; gq < 4; ++gq) { f32x4 m0 = *(const LAS f32x4*)(buf + O_WE + (8 * gq + 4 * hh) * 4), m1 = *(const LAS f32x4*)(buf + O_WE + (32 + 8 * gq + 4 * hh) * 4);
                    if (more) { m0 *= *(const LAS f32x4*)(nbuf + O_WM + (8 * gq + 4 * hh) * 4); m1 *= *(const LAS f32x4*)(nbuf + O_WM + (32 + 8 * gq + 4 * hh) * 4); }
#pragma unroll
                    for (int e = 0; e < 4; ++e) { St0[4 * gq + e] *= m0[e]; St1[4 * gq + e] *= m1[e]; } } }
            }
            MS_BARRIER();
        }
    if (!smp) {
        GAS float* so = p.out + O_ST + (((((size_t)sq * NL + l) * 2 + dir) * NH + h) * HD + 32 * c.wave + vl) * HD + 4 * hh;
#pragma unroll
        for (int g = 0; g < 4; ++g) { *(GAS f32x4*)(so + 8 * g) = (f32x4){St0[4 * g], St0[4 * g + 1], St0[4 * g + 2], St0[4 * g + 3]};
            *(GAS f32x4*)(so + 32 + 8 * g) = (f32x4){St1[4 * g], St1[4 * g + 1], St1[4 * g + 2], St1[4 * g + 3]}; }
    }
    }
#undef MS_BARRIER
}
__device__ __forceinline__ void mfma_scan(const Params& p0, const Ctx& c0, int l) {
    const Ctx c = fresh(c0); FRESH_P(p0);
    const int b = c.bid;
    const int step = b < 64 ? 576 : 192;
#pragma nounroll
    for (int task = b; task < 576; task += step) mscan_task(p, c, l, task);
}

__device__ __forceinline__ int swap23(int r) { return (r & ~12) | ((r & 4) << 1) | ((r & 8) >> 1); }
__device__ __forceinline__ void attn_wave_task(const DParams& p, const Ctx& c, int l, int task) {
    const GAS f16* PROJ = (const GAS f16*)(p.ws + WS_R1); const GAS f16* KN = (const GAS f16*)(p.ws + WS_KN); const GAS f16* VT = (const GAS f16*)(p.ws + WS_VT);
    GAS f16* OA = (GAS f16*)(p.ws + WS_R4);
    const int hq = task & 7, qb = task >> 3, kvh = hq >> 2;
    const int r32 = c.lane & 31, hh = c.lane >> 5;
    int rowq0, L; const GAS f16* Kb; const GAS f16* Vb; bool smp;
    if (qb < 128) { smp = true; rowq0 = M_CTX + qb * 32; const int b = qb >> 5; L = KV_SMP;
        Kb = KN + KN_SMP_OFF + ((size_t)b * 2 + kvh) * KV_SMP * HD; Vb = VT + KN_SMP_OFF + ((size_t)b * 2 + kvh) * HD * KV_SMP; }
    else { smp = false; rowq0 = (qb - 128) * 32; const int b = rowq0 >> 8; L = T_CTX;
        Kb = KN + ((size_t)b * 2 + kvh) * T_CTX * HD; Vb = VT + ((size_t)b * 2 + kvh) * HD * T_CTX; }
    const int row = rowq0 + r32;
    float x[4][8]; float ss = 0.f;
#pragma unroll
    for (int s = 0; s < 4; ++s) { const f16x8 q = *(const GAS f16x8*)(PROJ + (size_t)row * DIN + PC_Q + hq * HD + 16 * s + 8 * hh);
#pragma unroll
        for (int j = 0; j < 8; ++j) { x[s][j] = (float)q[j]; ss += x[s][j] * x[s][j]; } }
    ss = half_sum(ss);
    const float rstd = rsqrtf(ss * (1.0f / HD) + 1e-6f);
#pragma unroll
    for (int s = 0; s < 4; ++s)
#pragma unroll
        for (int j = 0; j < 8; ++j) x[s][j] *= rstd * IN(26)[l * HD + 16 * s + 8 * hh + j];
    if (smp) { const int t = (row - M_CTX) & (T_SMP - 1); const float posr = (float)(t >> 6), posc = (float)(t & 63);
#pragma unroll
        for (int j = 0; j < 8; ++j) { const float freq = exp2f(-(float)(8 * hh + j) * (13.287712379549449f / 16.0f));
            const float ar = posr * freq, ac = posc * freq; const float cr = __cosf(ar), sr = __sinf(ar), cc = __cosf(ac), sc = __sinf(ac);
            const float a0 = x[0][j], a1 = x[1][j], b0 = x[2][j], b1 = x[3][j];
            x[0][j] = a0 * cr - a1 * sr; x[1][j] = a1 * cr + a0 * sr; x[2][j] = b0 * cc - b1 * sc; x[3][j] = b1 * cc + b0 * sc; } }
    f16x8 qf[4];
#pragma unroll
    for (int s = 0; s < 4; ++s)
#pragma unroll
        for (int j = 0; j < 8; ++j) qf[s][j] = (f16)(x[s][j] * (0.125f * 1.4426950408889634f));
    f32x16 o0, o1;
#pragma unroll
    for (int i = 0; i < 16; ++i) { o0[i] = 0.f; o1[i] = 0.f; }
    float mrun = -1e30f, lsum = 0.f;
    const GAS f16* kp = Kb + (size_t)swap23(r32) * HD + 8 * hh;
    const GAS f16* vp = Vb + (size_t)r32 * L + 8 * hh;
    const int ntile = L >> 5;
    f16x8 kf[4], vf[4];
#pragma unroll
    for (int s = 0; s < 4; ++s) kf[s] = *(const GAS f16x8*)(kp + 16 * s);
    vf[0] = *(const GAS f16x8*)(vp); vf[1] = *(const GAS f16x8*)(vp + 16); vf[2] = *(const GAS f16x8*)(vp + (size_t)32 * L); vf[3] = *(const GAS f16x8*)(vp + (size_t)32 * L + 16);
    for (int kt = 0; kt < ntile; ++kt) {
        f16x8 kn[4], vn[4];
        const int ktn = kt + 1 < ntile ? kt + 1 : kt;
#pragma unroll
        for (int s = 0; s < 4; ++s) kn[s] = *(const GAS f16x8*)(kp + (size_t)ktn * 32 * HD + 16 * s);
        vn[0] = *(const GAS f16x8*)(vp + ktn * 32); vn[1] = *(const GAS f16x8*)(vp + ktn * 32 + 16); vn[2] = *(const GAS f16x8*)(vp + (size_t)32 * L + ktn * 32); vn[3] = *(const GAS f16x8*)(vp + (size_t)32 * L + ktn * 32 + 16);
        f32x16 sa;
#pragma unroll
        for (int i = 0; i < 16; ++i) sa[i] = 0.f;
#pragma unroll
        for (int s = 0; s < 4; ++s) sa = __builtin_amdgcn_mfma_f32_32x32x16_f16(kf[s], qf[s], sa, 0, 0, 0);
        float mt = sa[0];
#pragma unroll
        for (int i = 1; i < 16; ++i) mt = fmaxf(mt, sa[i]);
        mt = half_max(mt);
        const float mn = fmaxf(mrun, mt); const float alpha = exp2f(mrun - mn); mrun = mn;
        float ps = 0.f;
#pragma unroll
        for (int i = 0; i < 16; ++i) { sa[i] = exp2f(sa[i] - mn); ps += sa[i]; }
        lsum = lsum * alpha + ps;
#pragma unroll
        for (int i = 0; i < 16; ++i) { o0[i] *= alpha; o1[i] *= alpha; }
        f16x8 pb0, pb1;
#pragma unroll
        for (int j = 0; j < 8; ++j) { pb0[j] = (f16)sa[j]; pb1[j] = (f16)sa[8 + j]; }
        o0 = __builtin_amdgcn_mfma_f32_32x32x16_f16(vf[0], pb0, o0, 0, 0, 0);
        o0 = __builtin_amdgcn_mfma_f32_32x32x16_f16(vf[1], pb1, o0, 0, 0, 0);
        o1 = __builtin_amdgcn_mfma_f32_32x32x16_f16(vf[2], pb0, o1, 0, 0, 0);
        o1 = __builtin_amdgcn_mfma_f32_32x32x16_f16(vf[3], pb1, o1, 0, 0, 0);
#pragma unroll
        for (int s = 0; s < 4; ++s) { kf[s] = kn[s]; vf[s] = vn[s]; }
    }
    lsum = half_sum(lsum);
    const float inv = 1.0f / lsum;
    GAS f16* op = OA + (size_t)row * D + CW + hq * HD + 4 * hh;
#pragma unroll
    for (int g = 0; g < 4; ++g) {
        v2u w0; w0.x = pkh(o0[4 * g] * inv, o0[4 * g + 1] * inv); w0.y = pkh(o0[4 * g + 2] * inv, o0[4 * g + 3] * inv);
        v2u w1; w1.x = pkh(o1[4 * g] * inv, o1[4 * g + 1] * inv); w1.y = pkh(o1[4 * g + 2] * inv, o1[4 * g + 3] * inv);
        *(GAS v2u*)(op + 8 * g) = w0; *(GAS v2u*)(op + 32 + 8 * g) = w1; }
}
constexpr int AT_KS = 144, AT_BUF = 2 * 64 * AT_KS;
__device__ __forceinline__ void attn_block_task(const DParams& p, const Ctx& c, int l, int item) {
    const GAS f16* PROJ = (const GAS f16*)(p.ws + WS_R1); const GAS f16* KN = (const GAS f16*)(p.ws + WS_KN); const GAS f16* VT = (const GAS f16*)(p.ws + WS_VT);
    GAS f16* OA = (GAS f16*)(p.ws + WS_R4);
    int rowq0, L, kvh; const GAS f16* Kb; const GAS f16* Vb; bool smp;
    if (item < 128) { smp = true; const int b = item >> 5; kvh = (item >> 4) & 1; rowq0 = M_CTX + b * T_SMP + (item & 15) * 64; L = KV_SMP;
        Kb = KN + KN_SMP_OFF + ((size_t)b * 2 + kvh) * KV_SMP * HD; Vb = VT + KN_SMP_OFF + ((size_t)b * 2 + kvh) * HD * KV_SMP; }
    else { smp = false; const int id = item - 128; const int b = id >> 3; kvh = (id >> 2) & 1; rowq0 = b * T_CTX + (id & 3) * 64; L = T_CTX;
        Kb = KN + ((size_t)b * 2 + kvh) * T_CTX * HD; Vb = VT + ((size_t)b * 2 + kvh) * HD * T_CTX; }
    const int hq = kvh * 4 + (c.wave & 3);
    const int r32 = c.lane & 31, hh = c.lane >> 5;
    const int row = rowq0 + 32 * (c.wave >> 2) + r32;
    const int kk = c.tid >> 3, chk = c.tid & 7;
    const GAS f16* ksrc = Kb + (size_t)kk * HD + chk * 8;
    const GAS f16* vsrc = Vb + (size_t)kk * L + chk * 8;
    const int sdst = kk * AT_KS + chk * 16;
    v4u kreg = *(const GAS v4u*)ksrc, vreg = *(const GAS v4u*)vsrc;
    float x[4][8]; float ss = 0.f;
#pragma unroll
    for (int s = 0; s < 4; ++s) { const f16x8 q = *(const GAS f16x8*)(PROJ + (size_t)row * DIN + PC_Q + hq * HD + 16 * s + 8 * hh);
#pragma unroll
        for (int j = 0; j < 8; ++j) { x[s][j] = (float)q[j]; ss += x[s][j] * x[s][j]; } }
    ss = half_sum(ss);
    const float rstd = rsqrtf(ss * (1.0f / HD) + 1e-6f);
#pragma unroll
    for (int s = 0; s < 4; ++s)
#pragma unroll
        for (int j = 0; j < 8; ++j) x[s][j] *= rstd * IN(26)[l * HD + 16 * s + 8 * hh + j];
    if (smp) { const int t = (row - M_CTX) & (T_SMP - 1); const float posr = (float)(t >> 6), posc = (float)(t & 63);
#pragma unroll
        for (int j = 0; j < 8; ++j) { const float freq = exp2f(-(float)(8 * hh + j) * (13.287712379549449f / 16.0f));
            const float ar = posr * freq, ac = posc * freq; const float cr = __cosf(ar), sr = __sinf(ar), cc = __cosf(ac), sc = __sinf(ac);
            const float a0 = x[0][j], a1 = x[1][j], b0 = x[2][j], b1 = x[3][j];
            x[0][j] = a0 * cr - a1 * sr; x[1][j] = a1 * cr + a0 * sr; x[2][j] = b0 * cc - b1 * sc; x[3][j] = b1 * cc + b0 * sc; } }
    f16x8 qf[4];
#pragma unroll
    for (int s = 0; s < 4; ++s)
#pragma unroll
        for (int j = 0; j < 8; ++j) qf[s][j] = (f16)(x[s][j] * (0.125f * 1.4426950408889634f));
    f32x16 o0, o1;
#pragma unroll
    for (int i = 0; i < 16; ++i) { o0[i] = 0.f; o1[i] = 0.f; }
    float mrun = -1e30f, lsum = 0.f;
    const int nstep = L >> 6;
    *(LAS v4u*)(c.lds + sdst) = kreg; *(LAS v4u*)(c.lds + 64 * AT_KS + sdst) = vreg;
    asm volatile("s_waitcnt lgkmcnt(0)" ::: "memory"); __builtin_amdgcn_s_barrier(); asm volatile("" ::: "memory");
    const int koff = swap23(r32) * AT_KS + 16 * hh, voff = 64 * AT_KS + r32 * AT_KS + 16 * hh;
    for (int st = 0; st < nstep; ++st) {
        if (st + 1 < nstep) { kreg = *(const GAS v4u*)(ksrc + (size_t)(st + 1) * 64 * HD); vreg = *(const GAS v4u*)(vsrc + (st + 1) * 64); }
        LAS unsigned char* sb = c.lds + (st & 1) * AT_BUF;
        f32x16 sa0, sa1;
#pragma unroll
        for (int i = 0; i < 16; ++i) { sa0[i] = 0.f; sa1[i] = 0.f; }
#pragma unroll
        for (int s = 0; s < 4; ++s) { const f16x8 k0 = *(const LAS f16x8*)(sb + koff + 32 * s), k1 = *(const LAS f16x8*)(sb + koff + 32 * AT_KS + 32 * s);
            sa0 = __builtin_amdgcn_mfma_f32_32x32x16_f16(k0, qf[s], sa0, 0, 0, 0); sa1 = __builtin_amdgcn_mfma_f32_32x32x16_f16(k1, qf[s], sa1, 0, 0, 0); }
        float mt = fmaxf(sa0[0], sa1[0]);
#pragma unroll
        for (int i = 1; i < 16; ++i) mt = fmaxf(mt, fmaxf(sa0[i], sa1[i]));
        mt = half_max(mt);
        const float mn = fmaxf(mrun, mt); const float alpha = __builtin_amdgcn_exp2f(mrun - mn); mrun = mn;
        float ps = 0.f;
#pragma unroll
        for (int i = 0; i < 16; ++i) { sa0[i] = __builtin_amdgcn_exp2f(sa0[i] - mn); sa1[i] = __builtin_amdgcn_exp2f(sa1[i] - mn); ps += sa0[i] + sa1[i]; }
        lsum = lsum * alpha + ps;
#pragma unroll
        for (int i = 0; i < 16; ++i) { o0[i] *= alpha; o1[i] *= alpha; }
        f16x8 pb[4];
#pragma unroll
        for (int j = 0; j < 8; ++j) { pb[0][j] = (f16)sa0[j]; pb[1][j] = (f16)sa0[8 + j]; pb[2][j] = (f16)sa1[j]; pb[3][j] = (f16)sa1[8 + j]; }
#pragma unroll
        for (int q4 = 0; q4 < 4; ++q4) {
            const f16x8 v0 = *(const LAS f16x8*)(sb + voff + 32 * q4), v1 = *(const LAS f16x8*)(sb + voff + 32 * AT_KS + 32 * q4);
            o0 = __builtin_amdgcn_mfma_f32_32x32x16_f16(v0, pb[q4], o0, 0, 0, 0); o1 = __builtin_amdgcn_mfma_f32_32x32x16_f16(v1, pb[q4], o1, 0, 0, 0); }
        if (st + 1 < nstep) { LAS unsigned char* nb = c.lds + ((st + 1) & 1) * AT_BUF; *(LAS v4u*)(nb + sdst) = kreg; *(LAS v4u*)(nb + 64 * AT_KS + sdst) = vreg; }
        asm volatile("s_waitcnt lgkmcnt(0)" ::: "memory"); __builtin_amdgcn_s_barrier(); asm volatile("" ::: "memory");
    }
    lsum = half_sum(lsum);
    const float inv = 1.0f / lsum;
    GAS f16* op = OA + (size_t)row * D + CW + hq * HD + 4 * hh;
#pragma unroll
    for (int g = 0; g < 4; ++g) {
        v2u w0; w0.x = pkh(o0[4 * g] * inv, o0[4 * g + 1] * inv); w0.y = pkh(o0[4 * g + 2] * inv, o0[4 * g + 3] * inv);
        v2u w1; w1.x = pkh(o1[4 * g] * inv, o1[4 * g + 1] * inv); w1.y = pkh(o1[4 * g + 2] * inv, o1[4 * g + 3] * inv);
        *(GAS v2u*)(op + 8 * g) = w0; *(GAS v2u*)(op + 32 + 8 * g) = w1; }
}
__device__ __forceinline__ void fast_attn(const Params& p0, const Ctx& c0, int l) {
    const Ctx c = fresh(c0); FRESH_P(p0);
    unsigned* ctr = (unsigned*)(p0.ws + WS_CTL) + 8192 + 64 * l;
    volatile LAS unsigned* slot = (volatile LAS unsigned*)(c.lds + MISC_OFF) + 16;
    for (;;) {
        if (c.tid == 0) slot[0] = __hip_atomic_fetch_add(ctr, 1u, __ATOMIC_RELAXED, __HIP_MEMORY_SCOPE_AGENT);
        __syncthreads();
        const int item = (int)slot[0];
        __syncthreads();
        if (item >= 384) break;
        attn_block_task(p, c, l, item);
    }
}

__device__ __forceinline__ void post_phase(const Params& p0, const Ctx& c0, int l) {
    const Ctx c = fresh(c0); FRESH_P(p0);
    const GAS f16* PROJ = (const GAS f16*)(p.ws + WS_R1); const GAS f16* Y = (const GAS f16*)(p.ws + WS_R3); const GAS float* RK = (const GAS float*)(p.ws + WS_RK);
    GAS f16* OA = (GAS f16*)(p.ws + WS_R4);
    const int ch0 = c.lane * 8, h = c.lane >> 3;
    float gnw[8], gnb[8], muv[8];
    { const f32x4 a0 = *(const GAS f32x4*)(IN(24) + l * CW + ch0), a1 = *(const GAS f32x4*)(IN(24) + l * CW + ch0 + 4), b0 = *(const GAS f32x4*)(IN(25) + l * CW + ch0), b1 = *(const GAS f32x4*)(IN(25) + l * CW + ch0 + 4);
      const f32x4 m0 = *(const GAS f32x4*)(IN(15) + (l * 3 + 2) * CW + ch0), m1 = *(const GAS f32x4*)(IN(15) + (l * 3 + 2) * CW + ch0 + 4);
#pragma unroll
      for (int e = 0; e < 4; ++e) { gnw[e] = a0[e]; gnw[4 + e] = a1[e]; gnb[e] = b0[e]; gnb[4 + e] = b1[e]; muv[e] = m0[e]; muv[4 + e] = m1[e]; } }
    for (int row = c.gw; row < M; row += c.ngw) {
        int g, t, T; row_info(row, g, t, T);
        const GAS f16* pr = PROJ + (size_t)row * DIN + PC_V + ch0;
        const f16x8 y0 = *(const GAS f16x8*)(Y + (size_t)row * CW + ch0), y1 = *(const GAS f16x8*)(Y + ((size_t)M + row) * CW + ch0);
        const f16x8 vc = *(const GAS f16x8*)pr; const f16x8 gv = *(const GAS f16x8*)(OA + (size_t)row * D + ch0);
        f16x8 vp, vn;
#pragma unroll
        for (int e = 0; e < 8; ++e) { vp[e] = (f16)0.f; vn[e] = (f16)0.f; }
        if (t > 0) vp = *(const GAS f16x8*)(pr - DIN);
        if (t < T - 1) vn = *(const GAS f16x8*)(pr + DIN);
        const float rk = RK[(size_t)row * 8 + h] + RK[((size_t)M + row) * 8 + h];
        float y[8]; float s = 0.f;
#pragma unroll
        for (int e = 0; e < 8; ++e) { y[e] = (float)y0[e] + (float)y1[e]; s += y[e]; }
        const float mean = dpp_sum8(s) * (1.0f / HD); float q = 0.f;
#pragma unroll
        for (int e = 0; e < 8; ++e) { y[e] -= mean; q += y[e] * y[e]; }
        const float rstd = rsqrtf(dpp_sum8(q) * (1.0f / HD) + 64e-5f);
        float o[8];
#pragma unroll
        for (int e = 0; e < 8; ++e) { const float vcf = (float)vc[e]; const float v = vcf + muv[e] * (0.5f * ((float)vp[e] + (float)vn[e]) - vcf);
            o[e] = (y[e] * rstd * gnw[e] + gnb[e] + rk * v) * (float)gv[e]; }
        v4u w; w.x = pkh(o[0], o[1]); w.y = pkh(o[2], o[3]); w.z = pkh(o[4], o[5]); w.w = pkh(o[6], o[7]);
        *(GAS v4u*)(OA + (size_t)row * D + ch0) = w;
    }
}

__device__ __forceinline__ void gemm_proj(const Params& p0, const Ctx& c0) { const Ctx c = fresh(c0); FRESH_P(p0);
    pg8::Gemm g{(const GAS f16*)(p.ws + WS_R4), (const GAS f16*)(p.ws + WS_W + WO_IN), D, D, D}; pg8::StaticOrder S; S.init(M, DIN, (int)gridDim.x, c.bid);
    pg8::gemm_phase(c.lds, g, S, pg8::EpiProjF{(GAS f16*)(p.ws + WS_R1)}, c.wave); }
__device__ __forceinline__ void gemm_wa(const Params& p0, const Ctx& c0, int l) { const Ctx c = fresh(c0); FRESH_P(p0);
    pg8::Gemm g{(const GAS f16*)(p.ws + WS_R1) + PC_LW, (const GAS f16*)(p.ws + WS_W + WO_SM), DIN, 128, 128}; pg8::StaticOrder S; S.init(M, 2048, (int)gridDim.x, c.bid);
    pg8::gemm_phase(c.lds, g, S, pg8::EpiWAF{(GAS f16*)(p.ws + WS_R2), IN(19) + (size_t)l * 2 * CW, IN(21) + (size_t)l * 2 * CW}, c.wave); }
__device__ __forceinline__ void gemm_gate(const Params& p0, const Ctx& c0) { const Ctx c = fresh(c0); FRESH_P(p0);
    pg8::Gemm g{(const GAS f16*)(p.ws + WS_R1) + PC_LG, (const GAS f16*)(p.ws + WS_W + WO_G), DIN, 128, 128}; pg8::StaticOrder S; S.init(M, CW, (int)gridDim.x, c.bid - 128);
    pg8::gemm_phase(c.lds, g, S, pg8::EpiF16F{(GAS f16*)(p.ws + WS_R4), D}, c.wave); }
__device__ __forceinline__ void gemm_merge(const Params& p0, const Ctx& c0) { const Ctx c = fresh(c0); FRESH_P(p0);
    const GAS f16* OA = (const GAS f16*)(p.ws + WS_R4); const GAS f16* WbrT = (const GAS f16*)(p.ws + WS_W + WO_BR); GAS f16* MG = (GAS f16*)(p.ws + WS_R3); const GAS f16* PROJ = (const GAS f16*)(p.ws + WS_R1);
    pg8::StaticOrder S; S.init(M, D, (int)gridDim.x, c.bid, 192);
    pg8::Gemm g{OA, WbrT, D, D, D}; pg8::gemm_phase<pg8::EpiMergeF, 96>(c.lds, g, S, pg8::EpiMergeF{MG, PROJ}, c.wave); }
__device__ __forceinline__ void gemm_out(const Params& p0, const Ctx& c0) { const Ctx c = fresh(c0); FRESH_P(p0);
    pg8::Gemm g{(const GAS f16*)(p.ws + WS_R3), (const GAS f16*)(p.ws + WS_W + WO_OUT), D, D, D}; pg8::StaticOrder S; S.init(M, D, (int)gridDim.x, c.bid, 192);
    pg8::gemm_phase<pg8::EpiF16F, 96>(c.lds, g, S, pg8::EpiF16F{(GAS f16*)(p.ws + WS_R2), D}, c.wave); }
__device__ __forceinline__ void gemm_up(const Params& p0, const Ctx& c0) { const Ctx c = fresh(c0); FRESH_P(p0);
    pg8::Gemm g{(const GAS f16*)(p.ws + WS_R4), (const GAS f16*)(p.ws + WS_W + WO_UP), D, D, D}; pg8::StaticOrder S; S.init(M, DFF, (int)gridDim.x, c.bid);
    pg8::gemm_phase(c.lds, g, S, pg8::EpiRelu2F{(GAS f16*)(p.ws + WS_R1), DFF}, c.wave); }
__device__ __forceinline__ void gemm_down(const Params& p0, const Ctx& c0) { const Ctx c = fresh(c0); FRESH_P(p0);
    pg8::Gemm g{(const GAS f16*)(p.ws + WS_R1), (const GAS f16*)(p.ws + WS_W + WO_DN), DFF, DFF, DFF}; pg8::StaticOrder S; S.init(M, D, (int)gridDim.x, c.bid, 192);
    pg8::gemm_phase<pg8::EpiF16F, 96>(c.lds, g, S, pg8::EpiF16F{(GAS f16*)(p.ws + WS_R2), D}, c.wave); }

__global__ void __launch_bounds__(NTHREADS, 2) fwd_kernel(Params p) {
    extern __shared__ __attribute__((aligned(16))) unsigned char lds_raw[];
    Ctx c;
    c.lds = (LAS unsigned char*)lds_raw;
    c.tid = threadIdx.x; c.lane = c.tid & 63; c.wave = __builtin_amdgcn_readfirstlane(c.tid >> 6);
    c.gw = blockIdx.x * NWAVES + c.wave; c.ngw = gridDim.x * NWAVES; c.gt = blockIdx.x * NTHREADS + c.tid; c.ngt = gridDim.x * NTHREADS;
    volatile LAS unsigned* MISC = (volatile LAS unsigned*)(c.lds + MISC_OFF);
    if (c.tid < 32) MISC[c.tid] = 0u;
    if (c.tid < 28) ((LAS unsigned long long*)(c.lds + PTAB_OFF))[c.tid] = (unsigned long long)p.in[c.tid];
    __syncthreads();
    unsigned* ctl = (unsigned*)(p.ws + WS_CTL);
    XcdBarrier bar = xcd_barrier_post(ctl + CW_BAR, MISC + 8);
#define GRID_BAR() xcd_barrier(bar)

    conv_weights(p, c, 0);
    __syncthreads();
    mod_phase(p, c);
    GRID_BAR();
    norm_phase<0>(p, c, 0);
    GRID_BAR();
#pragma nounroll
    for (int l = 0; l < NL; ++l) {
        gemm_proj(p, c);
        GRID_BAR();
        gemm_wa(p, c, l);
        gemm_gate(p, c);
        kv_prep(p, c, l);
        GRID_BAR();
        mfma_scan(p, c, l);
        __syncthreads();
        fast_attn(p, c, l);
        GRID_BAR();
        post_phase(p, c, l);
        GRID_BAR();
        gemm_merge(p, c);
        GRID_BAR();
        gemm_out(p, c);
        GRID_BAR();
        norm_phase<1>(p, c, l);
        GRID_BAR();
        gemm_up(p, c);
        GRID_BAR();
        gemm_down(p, c);
        GRID_BAR();
        norm_phase<2>(p, c, l);
        if (l + 1 < NL) { __syncthreads(); conv_weights(p, c, l + 1); }
        GRID_BAR();
    }
}

extern "C" void kernel_launch(void* const* d_in, const int* in_sizes, int n_in, void* d_out, int out_size, void* d_ws, size_t ws_size, hipStream_t stream) {
    static int grid = 0;
    if (grid == 0) {
        if (n_in != 28 || (size_t)out_size != O_TOTAL || ws_size < WS_END) { fprintf(stderr, "kernel_launch: unexpected shapes n_in %d out %d ws %zu\n", n_in, out_size, ws_size); grid = -1; return; }
        int dev = 0, cus = 0;
        if (hipGetDevice(&dev) != hipSuccess || hipDeviceGetAttribute(&cus, hipDeviceAttributeMultiprocessorCount, dev) != hipSuccess) { grid = -1; return; }
        if (hipFuncSetAttribute((const void*)fwd_kernel, hipFuncAttributeMaxDynamicSharedMemorySize, LDS_BYTES) != hipSuccess) { fprintf(stderr, "kernel_launch: hipFuncSetAttribute failed\n"); grid = -1; return; }
        grid = cus;
    }
    if (grid < 0) return;
    (void)hipMemsetAsync((char*)d_ws + WS_CTL, 0, CTL_BYTES + MiB, stream);
    Params p{};
    for (int i = 0; i < 28; ++i) p.in[i] = (const float*)d_in[i];
    p.out = (float*)d_out; p.ws = (unsigned char*)d_ws;
    hipLaunchKernelGGL(fwd_kernel, dim3(grid), dim3(NTHREADS), LDS_BYTES, stream, p);
}
```

```cpp
#include <hip/hip_runtime.h>
#include <cstdio>
#include <cstdint>

#define GAS __attribute__((address_space(1)))
#define LAS __attribute__((address_space(3)))
typedef _Float16 f16;
typedef _Float16 f16x8 __attribute__((ext_vector_type(8)));
typedef _Float16 f16x4 __attribute__((ext_vector_type(4)));
typedef _Float16 f16x2 __attribute__((ext_vector_type(2)));
typedef float f32x4 __attribute__((ext_vector_type(4)));
typedef float f32x16 __attribute__((ext_vector_type(16)));
typedef unsigned v4u __attribute__((ext_vector_type(4)));
typedef unsigned v2u __attribute__((ext_vector_type(2)));

constexpr int D = 1024, DIN = 4608, DFF = 4096, CW = 512, NL = 2, NH = 8, HD = 64;
constexpr int B_CTX = 32, T_CTX = 256, B_SMP = 4, T_SMP = 1024, PAST = 256, KV_SMP = PAST + T_SMP;
constexpr int M_CTX = B_CTX * T_CTX, M_SMP = B_SMP * T_SMP, M = M_CTX + M_SMP;
constexpr int NMOD = 6 * D;
constexpr int PC_R = 0, PC_K = 512, PC_V = 1024, PC_LW = 1536, PC_LA = 1600, PC_LG = 1664, PC_Q = 1792, PC_KA = 2304, PC_VA = 2432, PC_GR = 2560, PC_GA = 3584;
constexpr size_t O_Y = 0, O_CK = (size_t)M * D, O_CV = O_CK + (size_t)B_CTX * NL * T_CTX * 128, O_ST = O_CV + (size_t)B_CTX * NL * T_CTX * 128;
constexpr size_t O_TOTAL = O_ST + (size_t)B_CTX * NL * 2 * NH * HD * HD;

constexpr size_t MiB = 1u << 20;
constexpr size_t WS_CTL = 0, CTL_BYTES = 1 * MiB;
constexpr size_t WS_MOD = 1 * MiB;
constexpr size_t WS_W = 2 * MiB;
constexpr size_t WO_IN = 0, WO_BR = 9 * MiB, WO_OUT = 11 * MiB, WO_UP = 13 * MiB, WO_DN = 21 * MiB, WO_SM = 29 * MiB, WO_G = 29 * MiB + 512 * 1024;
constexpr size_t WS_R1 = 32 * MiB;
constexpr size_t WS_R2 = 140 * MiB;
constexpr size_t WS_R3 = 188 * MiB;
constexpr size_t WS_RK = 212 * MiB;
constexpr size_t WS_R4 = 213 * MiB;
constexpr size_t WS_KN = 237 * MiB;
constexpr size_t WS_VT = 241 * MiB;
constexpr size_t WS_END = 245 * MiB;
constexpr size_t KN_SMP_OFF = (size_t)B_CTX * 2 * T_CTX * 64;

constexpr int NWAVES = 8, NTHREADS = 512;
constexpr int LDS_BYTES = 147456;
constexpr int MISC_OFF = 131072 + 320, PTAB_OFF = 131072 + 1024;

#define XB_TMO      128
#define XB_XCNT(j)  (256  + 64 * (j))
#define XB_XSUB(j)  (1280 + 64 * (j))
#define XB_XGEN(j)  (2304 + 64 * (j))
#define XB_TOP      3328
#define XB_TOPGEN   3392
#define XCD_BAR_WORDS 3456
#define XB_SPIN_CAP (1u << 24)
constexpr int CW_BAR = 4096;

__device__ __forceinline__ unsigned xb_ld(unsigned* p)              { return __hip_atomic_load(p, __ATOMIC_RELAXED, __HIP_MEMORY_SCOPE_AGENT); }
__device__ __forceinline__ unsigned xb_add(unsigned* p, unsigned v) { return __hip_atomic_fetch_add(p, v, __ATOMIC_RELAXED, __HIP_MEMORY_SCOPE_AGENT); }
__device__ __forceinline__ unsigned xb_xcc_id() { return (unsigned)__builtin_amdgcn_s_getreg((3 << 11) | 20) & 0xFu; }
#define XB_SPIN(cond, bar) do { unsigned _sp = 0; while (cond) { __builtin_amdgcn_s_sleep(1); \
    if ((++_sp & 255u) == 0u) { if (xb_ld(&(bar)[XB_TMO])) break; if (_sp > XB_SPIN_CAP) { atomicAdd(&(bar)[XB_TMO], 1u); break; } } } } while (0)

struct XcdBarrier { unsigned* bar; unsigned x; volatile LAS unsigned* st; };

__device__ __forceinline__ XcdBarrier xcd_barrier_post(unsigned* bar, volatile LAS unsigned* st) {
    XcdBarrier b; b.bar = bar; b.x = xb_xcc_id(); b.st = st;
    if (threadIdx.x == 0) (void)xb_add(&bar[XB_XCNT(b.x)], 1u);
    return b;
}
__device__ __forceinline__ void xcd_barrier_complete(unsigned* bar, unsigned x, unsigned& nloc, unsigned& nx) {
    const unsigned G = gridDim.x * gridDim.y * gridDim.z;
    unsigned sum, cnt, mine, sp = 0u;
    for (;;) {
        sum = 0u; cnt = 0u; mine = 0u;
#pragma unroll
        for (unsigned j = 0; j < 16; ++j) { const unsigned c = xb_ld(&bar[XB_XCNT(j)]); sum += c; cnt += (c > 0u) ? 1u : 0u; mine = (j == x) ? c : mine; }
        if (sum == G) break;
        __builtin_amdgcn_s_sleep(1);
        if ((++sp & 255u) == 0u) { if (xb_ld(&bar[XB_TMO])) break; if (sp > XB_SPIN_CAP) { atomicAdd(&bar[XB_TMO], 1u); break; } }
    }
    nloc = mine > 0u ? mine : 1u; nx = cnt > 0u ? cnt : 1u;
}
__device__ __forceinline__ void xcd_barrier(const XcdBarrier& b) {
    asm volatile("s_waitcnt vmcnt(0)" ::: "memory");
    __syncthreads();
    if (threadIdx.x == 0) {
        unsigned* bar = b.bar; unsigned bx = b.x;
        asm volatile("" : "+s"(bar), "+s"(bx));
        __builtin_amdgcn_s_waitcnt(0);
        unsigned nloc = b.st[0], nx = b.st[1];
        if (nloc == 0u) { xcd_barrier_complete(bar, bx, nloc, nx); b.st[0] = nloc; b.st[1] = nx; }
        const unsigned old = xb_add(&bar[XB_XSUB(bx)], 1u);
        const unsigned gen = old / nloc;
        if (old + 1u == (gen + 1u) * nloc) {
            __builtin_amdgcn_fence(__ATOMIC_RELEASE, "agent");
            asm volatile("s_waitcnt vmcnt(0)" ::: "memory");
            const unsigned og = xb_add(&bar[XB_TOP], 1u);
            const unsigned tg = og / nx;
            if (og + 1u == (tg + 1u) * nx) xb_add(&bar[XB_TOPGEN], 1u);
            else XB_SPIN(xb_ld(&bar[XB_TOPGEN]) == tg, bar);
            __builtin_amdgcn_fence(__ATOMIC_ACQUIRE, "agent");
            xb_add(&bar[XB_XGEN(bx)], 1u);
            asm volatile("s_waitcnt vmcnt(0)" ::: "memory");
        } else {
            XB_SPIN(xb_ld(&bar[XB_XGEN(bx)]) == gen, bar);
            __builtin_amdgcn_fence(__ATOMIC_ACQUIRE, "agent");
            asm volatile("s_waitcnt vmcnt(0)" ::: "memory");
        }
    }
    __syncthreads();
}

#define LDS_WAIT() asm volatile("s_waitcnt lgkmcnt(0)" ::: "memory")
#define DPPF(x, ctrl, rmask, oldv) __builtin_bit_cast(float, __builtin_amdgcn_update_dpp(__builtin_bit_cast(int, (float)(oldv)), __builtin_bit_cast(int, (float)(x)), (ctrl), (rmask), 0xF, false))
__device__ __forceinline__ float wave_sum(float v) {
    v += DPPF(v, 0xB1, 0xF, 0.f); v += DPPF(v, 0x4E, 0xF, 0.f); v += DPPF(v, 0x141, 0xF, 0.f); v += DPPF(v, 0x140, 0xF, 0.f);
    v += DPPF(v, 0x142, 0xA, 0.f); v += DPPF(v, 0x143, 0xC, 0.f);
    return __builtin_bit_cast(float, __builtin_amdgcn_readlane(__builtin_bit_cast(int, v), 63));
}
__device__ __forceinline__ float dpp_f(float x, const int ctrl) { return x; }
#define DPP_ADD(x, ctrl) (x) += __builtin_bit_cast(float, __builtin_amdgcn_update_dpp(0, __builtin_bit_cast(int, (x)), (ctrl), 0xF, 0xF, true))
__device__ __forceinline__ float dpp_sum8(float x) { DPP_ADD(x, 0xB1); DPP_ADD(x, 0x4E); DPP_ADD(x, 0x141); return x; }
__device__ __forceinline__ float dpp_sum16(float x) { DPP_ADD(x, 0xB1); DPP_ADD(x, 0x4E); DPP_ADD(x, 0x141); DPP_ADD(x, 0x140); return x; }
__device__ __forceinline__ void swap32(float& a, float& b) { asm volatile("v_nop\n\tv_nop\n\tv_permlane32_swap_b32 %0, %1" : "+v"(a), "+v"(b)); }
__device__ __forceinline__ float half_sum(float v) { float a = v, b = v; swap32(a, b); return a + b; }
__device__ __forceinline__ float half_max(float v) { float a = v, b = v; swap32(a, b); return fmaxf(a, b); }
__device__ __forceinline__ float xor16(float v) { return __builtin_bit_cast(float, __builtin_amdgcn_ds_swizzle(__builtin_bit_cast(int, v), 0x401F)); }
__device__ __forceinline__ float sigmoidf_(float x) { return __builtin_amdgcn_rcpf(1.0f + __expf(-x)); }
__device__ __forceinline__ float tanhf_(float x) { return 1.0f - 2.0f * __builtin_amdgcn_rcpf(1.0f + __expf(2.0f * x)); }
__device__ __forceinline__ unsigned pkh(float lo, float hi) { f16x2 v = {(f16)lo, (f16)hi}; return __builtin_bit_cast(unsigned, v); }
__device__ __forceinline__ void row_info(int row, int& g, int& t, int& T) {
    if (row < M_CTX) { g = 0; t = row & (T_CTX - 1); T = T_CTX; }
    else { const int r = row - M_CTX; g = 1 + (r >> 10); t = r & (T_SMP - 1); T = T_SMP; }
}

struct Params {
    const float* in[28];
    float* out;
    unsigned char* ws;
};
struct DParams { GAS float* out; GAS unsigned char* ws; };
struct Ctx {
    LAS unsigned char* lds;
    int tid, lane, wave, gw, ngw, gt, ngt, bid;
};
__device__ __forceinline__ int lane_id() { int ln; asm volatile("v_mbcnt_lo_u32_b32 %0, -1, 0\n\tv_mbcnt_hi_u32_b32 %0, -1, %0" : "=v"(ln)); return ln; }
__device__ __forceinline__ const GAS float* inp(const Ctx& c, int i) {
    const unsigned long long v = ((const LAS unsigned long long*)(c.lds + PTAB_OFF))[i];
    const unsigned lo = __builtin_amdgcn_readfirstlane((unsigned)v), hi = __builtin_amdgcn_readfirstlane((unsigned)(v >> 32));
    return (const GAS float*)(((unsigned long long)hi << 32) | lo); }
#define IN(i) inp(c, (i))
#define FRESH_P(p0) DParams p; { float* o_ = (p0).out; unsigned char* w_ = (p0).ws; asm volatile("" : "+s"(o_), "+s"(w_)); p.out = (GAS float*)o_; p.ws = (GAS unsigned char*)w_; }
__device__ __forceinline__ Ctx fresh(const Ctx& c0) {
    Ctx c = c0; int w = c0.wave; asm volatile("" : "+s"(w)); int ln = lane_id(); asm volatile("" : "+v"(ln));
    int b = blockIdx.x; asm volatile("" : "+s"(b));
    c.wave = w; c.lane = ln; c.tid = w * 64 + ln; c.bid = b;
    c.gw = b * 8 + w; c.gt = b * 512 + c.tid; return c; }

__device__ __forceinline__ void conv_item(const GAS float* W, int N, GAS f16* WT, int ldt, int koff, LAS float* scr, int kb, int nb, int lane) {
    const int k0 = 64 * kb, n0 = 32 * nb;
#pragma unroll 8
    for (int i = 0; i < 32; ++i) { const int kk = 2 * i + (lane >> 5); scr[kk * 33 + (lane & 31)] = W[(size_t)(k0 + kk) * N + n0 + (lane & 31)]; }
    LDS_WAIT();
    const int c = lane & 7;
#pragma unroll
    for (int j = 0; j < 4; ++j) { const int n = (lane >> 3) + 8 * j; const LAS float* s = scr + (8 * c) * 33 + n;
        v4u o; o.x = pkh(s[0 * 33], s[1 * 33]); o.y = pkh(s[2 * 33], s[3 * 33]); o.z = pkh(s[4 * 33], s[5 * 33]); o.w = pkh(s[6 * 33], s[7 * 33]);
        *(GAS v4u*)(WT + (size_t)(n0 + n) * ldt + koff + k0 + 8 * c) = o; }
    LDS_WAIT();
}
__device__ __forceinline__ void conv_weights(const Params& p0, const Ctx& c0, int l) {
    const Ctx c = fresh(c0); FRESH_P(p0);
    LAS float* scr = (LAS float*)(c.lds + c.wave * 16384);
    GAS unsigned char* wb = p.ws + WS_W;
    GAS f16* WinT = (GAS f16*)(wb + WO_IN); GAS f16* WbrT = (GAS f16*)(wb + WO_BR); GAS f16* WoutT = (GAS f16*)(wb + WO_OUT); GAS f16* WupT = (GAS f16*)(wb + WO_UP); GAS f16* WdnT = (GAS f16*)(wb + WO_DN);
    GAS f16* WsmT = (GAS f16*)(wb + WO_SM); GAS f16* WgT = (GAS f16*)(wb + WO_G);
    const GAS float* w_in = IN(7) + (size_t)l * D * DIN; const GAS float* w_br = IN(8) + (size_t)l * 2 * CW * D; const GAS float* w_out = IN(9) + (size_t)l * D * D;
    const GAS float* w_up = IN(13) + (size_t)l * D * DFF; const GAS float* w_dn = IN(14) + (size_t)l * DFF * D;
    const GAS float* dec_up = IN(20) + (size_t)l * 2 * 64 * CW; const GAS float* icl_up = IN(22) + (size_t)l * 2 * 64 * CW; const GAS float* gate_up = IN(23) + (size_t)l * 128 * CW;
    constexpr int I0 = 16 * 144, I1 = 8 * 32, I2 = 8 * 32, I3 = 16 * 32, I4 = 16 * 128, I5 = 64 * 32, I6 = 16, I7 = 16, I8 = 16, I9 = 16, I10 = 2 * 16;
    constexpr int NIT = I0 + I1 + I2 + I3 + I4 + I5 + I6 + I7 + I8 + I9 + I10;
    for (int it = c.gw; it < NIT; it += c.ngw) {
        int r = it;
        if (r < I0) { conv_item(w_in, DIN, WinT, D, 0, scr, r / 144, r % 144, c.lane); continue; } r -= I0;
        if (r < I1) { conv_item(w_br, D, WbrT, D, 0, scr, r / 32, r % 32, c.lane); continue; } r -= I1;
        if (r < I2) { conv_item(w_br + (size_t)CW * D, D, WbrT, D, CW, scr, r / 32, r % 32, c.lane); continue; } r -= I2;
        if (r < I3) { conv_item(w_out, D, WoutT, D, 0, scr, r / 32, r % 32, c.lane); continue; } r -= I3;
        if (r < I4) { conv_item(w_up, DFF, WupT, D, 0, scr, r / 128, r % 128, c.lane); continue; } r -= I4;
        if (r < I5) { conv_item(w_dn, D, WdnT, DFF, 0, scr, r / 32, r % 32, c.lane); continue; } r -= I5;
        if (r < I6) { conv_item(dec_up, CW, WsmT, 128, 0, scr, 0, r, c.lane); continue; } r -= I6;
        if (r < I7) { conv_item(dec_up + 64 * CW, CW, WsmT + (size_t)512 * 128, 128, 0, scr, 0, r, c.lane); continue; } r -= I7;
        if (r < I8) { conv_item(icl_up, CW, WsmT + (size_t)1024 * 128, 128, 64, scr, 0, r, c.lane); continue; } r -= I8;
        if (r < I9) { conv_item(icl_up + 64 * CW, CW, WsmT + (size_t)1536 * 128, 128, 64, scr, 0, r, c.lane); continue; } r -= I9;
        conv_item(gate_up, CW, WgT, 128, 0, scr, r / 16, r % 16, c.lane);
    }
    unsigned zz_ = 0u; asm volatile("" : "+v"(zz_));
    for (int i = c.gt; i < 2048 * 8; i += c.ngt) { const int row = i >> 3, ch = i & 7; const int col = (row < 1024 ? 64 : 0) + ch * 8;
        *(GAS v4u*)(WsmT + (size_t)row * 128 + col) = (v4u){zz_, zz_, zz_, zz_}; }
}

__device__ __forceinline__ void mod_phase(const Params& p0, const Ctx& c0) {
    const Ctx c = fresh(c0); FRESH_P(p0);
    LAS float* sl = (LAS float*)(c.lds);
    LAS float* part = (LAS float*)(c.lds + 32768);
    GAS float* mod = (GAS float*)(p.ws + WS_MOD);
    for (int i = c.tid; i < 5 * D; i += NTHREADS) { const int g = i >> 10, k = i & 1023; const float v = g == 0 ? IN(6)[k] : IN(5)[(g - 1) * D + k]; sl[i] = v / (1.0f + __expf(-v)); }
    __syncthreads();
    for (int it = c.bid; it < NL * (NMOD / 64) * 4; it += gridDim.x) {
        const int kq = it & 3, lc = it >> 2, l = lc / (NMOD / 64), cc = lc % (NMOD / 64);
        const int kb = kq * 256 + c.wave * 32;
        const GAS float* w = IN(10) + (size_t)l * D * NMOD + (size_t)kb * NMOD + cc * 64 + c.lane;
        float a0 = 0.f, a1 = 0.f, a2 = 0.f, a3 = 0.f, a4 = 0.f;
        float wv[32];
#pragma unroll
        for (int k = 0; k < 32; ++k) wv[k] = w[(size_t)k * NMOD];
#pragma unroll
        for (int k = 0; k < 32; ++k) { a0 += sl[kb + k] * wv[k]; a1 += sl[D + kb + k] * wv[k]; a2 += sl[2 * D + kb + k] * wv[k]; a3 += sl[3 * D + kb + k] * wv[k]; a4 += sl[4 * D + kb + k] * wv[k]; }
        LAS float* pw = part + c.wave * 320 + c.lane;
        pw[0] = a0; pw[64] = a1; pw[128] = a2; pw[192] = a3; pw[256] = a4;
        __syncthreads();
        if (c.tid < 320) { float s = 0.f;
#pragma unroll
            for (int w8 = 0; w8 < 8; ++w8) s += part[w8 * 320 + c.tid];
            const int g = c.tid >> 6, col = cc * 64 + (c.tid & 63);
            if (kq == 0) s += IN(11)[(size_t)l * NMOD + col];
            atomicAdd((float*)(mod + ((size_t)l * 5 + g) * NMOD + col), s); }
        __syncthreads();
    }
}

template <int MODE, int NB>
__device__ __forceinline__ void norm_rows(const DParams& p, const Ctx& c, int l, int row_first, int row_end, int row_step) {
    GAS float* X = p.out; const GAS f16* MO = (const GAS f16*)(p.ws + WS_R2); GAS f16* H = (GAS f16*)(p.ws + WS_R4);
    const GAS float* modb = (const GAS float*)(p.ws + WS_MOD);
    const GAS float* in0 = IN(0); const GAS float* in1 = IN(1); const GAS float* ngb = IN(12);
    for (int rowb = row_first; rowb < row_end; rowb += NB * row_step) {
        f32x4 x[NB][4]; f16x4 mh[NB][4];
#pragma unroll
        for (int b = 0; b < NB; ++b) { const int row = rowb + b * row_step;
            if (row < row_end) {
                if (MODE == 0) { const GAS float* src = row < M_CTX ? in0 + (size_t)row * D : in1 + (size_t)(row - M_CTX) * D;
#pragma unroll
                    for (int j = 0; j < 4; ++j) x[b][j] = __builtin_nontemporal_load((const GAS f32x4*)(src + 256 * j + 4 * c.lane)); }
                else { const GAS float* xs = (MODE == 1 && l == 0) ? (row < M_CTX ? in0 + (size_t)row * D : in1 + (size_t)(row - M_CTX) * D) : X + (size_t)row * D;
#pragma unroll
                    for (int j = 0; j < 4; ++j) { x[b][j] = __builtin_nontemporal_load((const GAS f32x4*)(xs + 256 * j + 4 * c.lane));
                        mh[b][j] = __builtin_nontemporal_load((const GAS f16x4*)(MO + (size_t)row * D + 256 * j + 4 * c.lane)); } } } }
#pragma unroll
        for (int b = 0; b < NB; ++b) { const int row = rowb + b * row_step;
            if (row < row_end) {
                int g, t, T; row_info(row, g, t, T);
                if (MODE != 0) {
                    const GAS float* mo_mod = modb + ((size_t)l * 5 + g) * NMOD + (MODE == 1 ? 2 * D : 5 * D);
                    const GAS float* ngp = ngb + ((size_t)l * 4 + (MODE == 1 ? 1 : 3)) * D;
                    float mv[4][4]; float ss = 0.f;
#pragma unroll
                    for (int j = 0; j < 4; ++j)
#pragma unroll
                        for (int e = 0; e < 4; ++e) { mv[j][e] = (float)mh[b][j][e]; ss += mv[j][e] * mv[j][e]; }
                    const float rstd = rsqrtf(wave_sum(ss) * (1.0f / D) + 1e-6f);
#pragma unroll
                    for (int j = 0; j < 4; ++j) { const f32x4 gg = *(const GAS f32x4*)(mo_mod + 256 * j + 4 * c.lane); const f32x4 nn = *(const GAS f32x4*)(ngp + 256 * j + 4 * c.lane);
#pragma unroll
                        for (int e = 0; e < 4; ++e) x[b][j][e] += gg[e] * (mv[j][e] * rstd * nn[e]); }
                }
                const int ln = MODE == 2 ? l + 1 : l;
                if (ln < NL) {
                    const GAS float* mb = modb + ((size_t)ln * 5 + g) * NMOD + (MODE == 1 ? 3 * D : 0);
                    const GAS float* ngp = ngb + ((size_t)ln * 4 + (MODE == 1 ? 2 : 0)) * D;
                    float ss = 0.f;
#pragma unroll
                    for (int j = 0; j < 4; ++j) ss += (x[b][j][0] * x[b][j][0] + x[b][j][1] * x[b][j][1]) + (x[b][j][2] * x[b][j][2] + x[b][j][3] * x[b][j][3]);
                    const float rstd = rsqrtf(wave_sum(ss) * (1.0f / D) + 1e-6f);
#pragma unroll
                    for (int j = 0; j < 4; ++j) { const f32x4 sh = *(const GAS f32x4*)(mb + 256 * j + 4 * c.lane); const f32x4 sc = *(const GAS f32x4*)(mb + D + 256 * j + 4 * c.lane);
                        const f32x4 nn = *(const GAS f32x4*)(ngp + 256 * j + 4 * c.lane);
                        float o[4];
#pragma unroll
                        for (int e = 0; e < 4; ++e) o[e] = x[b][j][e] * rstd * nn[e] * (1.0f + sc[e]) + sh[e];
                        v2u w; w.x = pkh(o[0], o[1]); w.y = pkh(o[2], o[3]);
                        *(GAS v2u*)(H + (size_t)row * D + 256 * j + 4 * c.lane) = w; }
                }
                if (MODE != 0) {
#pragma unroll
                for (int j = 0; j < 4; ++j) __builtin_nontemporal_store(x[b][j], (GAS f32x4*)(X + (size_t)row * D + 256 * j + 4 * c.lane)); }
            } }
    }
}
template <int MODE>
__device__ __forceinline__ void norm_phase(const Params& p0, const Ctx& c0, int l) {
    const Ctx c = fresh(c0); FRESH_P(p0);
    norm_rows<MODE, 3>(p, c, l, c.gw, M, c.ngw);
}

namespace pg8 {
constexpr int BM = 256, BK = 64, HALF = 128, HTB = HALF * BK * 2, STAGE_BYTES = 8 * HTB, NXCD = 8, WGM = 8;
__host__ __device__ __forceinline__ int lds_byte(int r, int c) { const int st = (r >> 4) * 2 + (c >> 5), rr = r & 15, cc = c & 31, ob = rr * 64 + cc * 2; return st * 1024 + (ob ^ (((ob >> 9) & 1) << 5)); }
__host__ __device__ __forceinline__ void stage_rc(int b, int& R, int& C) { const int st = b / 1024, sb = b % 1024, swz = sb ^ (((sb >> 9) & 1) << 5); R = (st >> 1) * 16 + swz / 64; C = (st & 1) * 32 + (swz % 64) / 2; }
__host__ __device__ __forceinline__ int perm32(int rho) { const int n = rho >> 4, i = rho & 15; return 8 * (i >> 2) + 4 * n + (i & 3); }
struct Unit { int pm, pn; };
struct Gemm { const GAS f16* A; const GAS f16* Bt; int lda, ldb, K; };
struct StaticOrder {
    int nM, nN, nwg, G, c;
    __device__ void init(int Mr, int N, int G_, int c_, int bm = BM) { nM = Mr / bm; nN = N / BM; nwg = nM * nN; G = G_; c = c_; }
    __device__ bool next(int i, Unit& u) const {
        const long L = (long)i * G + c; if (c < 0 || L >= nwg) return false;
        int wgid = (int)L; { const int q = nwg / NXCD, r = nwg % NXCD, xcd = wgid % NXCD, off = wgid / NXCD; wgid = (xcd < r ? xcd * (q + 1) : r * (q + 1) + (xcd - r) * q) + off; }
        const int nig = WGM * nN, gid = wgid / nig, fm = gid * WGM, gsz = (nM - fm) < WGM ? (nM - fm) : WGM;
        u.pm = fm + ((wgid % nig) % gsz); u.pn = (wgid % nig) / gsz; return true;
    }
};
template <class Epi, int HA = 128, bool ALIGN_EPI = true, bool SP2 = true>
__device__ __forceinline__ void gemm_phase(LAS unsigned char* lds, const Gemm g, const StaticOrder& S, const Epi& E, int wave_sgpr) {
    asm volatile("" : "+s"(wave_sgpr)); int tid = wave_sgpr * 64 + lane_id(); asm volatile("" : "+v"(tid));
    const int wid = __builtin_amdgcn_readfirstlane(tid >> 6), lane = tid & 63, wr = wid >> 2, wc = wid & 3, fr = lane & 15, fq = lane >> 4;
    const int K = g.K, nt = K / BK;
    unsigned voffA[2], voffB[2];
#pragma unroll
    for (int i = 0; i < 2; ++i) { int R, C; stage_rc(tid * 16 + i * 8192, R, C); const int Rb = (R & ~31) + perm32(R & 31);
        voffA[i] = (unsigned)(R * g.lda + C) * 2u; voffB[i] = (unsigned)(Rb * g.ldb + C) * 2u; }
    const unsigned kstep = (unsigned)(BK * 2);
    constexpr int MF = HA / 32;
    const unsigned hstepA = (unsigned)HA * g.lda * 2, hstepB = (unsigned)HALF * g.ldb * 2;
    const unsigned tstepA = 2 * hstepA, tstepB = 2 * hstepB;
    const unsigned ldsw = (unsigned)wid * 1024u;
    const int aoff = lds_byte(wr * (HA / 2) + fr, fq * 8), boff = lds_byte(wc * 32 + fr, fq * 8);
#define PG8_SA(b, h) (((b) * 2 + (h)) * HTB)
#define PG8_SB(b, h) ((4 + (b) * 2 + (h)) * HTB)
#define PG8_STAGE(bufoff, gbase, soff, voff) do { _Pragma("unroll") for (int _i = 0; _i < 2; ++_i) \
        __builtin_amdgcn_raw_ptr_buffer_load_lds(rs##gbase, (LAS unsigned*)(lds + (bufoff) + ldsw + _i * 8192), 16, (voff)[_i], (int)(soff), 0, 0); } while (0)
#define PG8_LDA(dst, b, h) do { _Pragma("unroll") for (int m = 0; m < MF; ++m) _Pragma("unroll") for (int k = 0; k < 2; ++k) dst[m][k] = *(const LAS f16x8*)(lds + PG8_SA(b, h) + aoff + m * 2048 + k * 1024); } while (0)
#define PG8_LDB(dst, b, h) do { _Pragma("unroll") for (int n = 0; n < 2; ++n) _Pragma("unroll") for (int k = 0; k < 2; ++k) dst[n][k] = *(const LAS f16x8*)(lds + PG8_SB(b, h) + boff + n * 2048 + k * 1024); } while (0)
#define PG8_MMA(ai, bj, At, Bt) do { __builtin_amdgcn_s_setprio(1); _Pragma("unroll") for (int m = 0; m < MF; ++m) _Pragma("unroll") for (int n = 0; n < 2; ++n) _Pragma("unroll") for (int k = 0; k < 2; ++k) \
        acc[ai][bj][m][n] = __builtin_amdgcn_mfma_f32_16x16x32_f16(Bt[n][k], At[m][k], acc[ai][bj][m][n], 0, 0, 0); __builtin_amdgcn_s_setprio(0); } while (0)
#define PG8_WAIT_V(n) asm volatile("s_waitcnt vmcnt(" #n ")" ::: "memory")
#define PG8_WAIT_L(n) asm volatile("s_waitcnt lgkmcnt(" #n ")" ::: "memory")
#define PG8_BAR __builtin_amdgcn_s_barrier()
#define PG8_SCHED __builtin_amdgcn_sched_barrier(0)
    Unit cur, nxt; int ui = 0;
    if (!S.next(0, cur)) return;
    f32x4 acc[2][2][4][2];
#pragma unroll
    for (int a = 0; a < 2; ++a)
#pragma unroll
        for (int b = 0; b < 2; ++b)
#pragma unroll
            for (int m = 0; m < 4; ++m)
#pragma unroll
                for (int n = 0; n < 2; ++n) acc[a][b][m][n] = (f32x4){0.f, 0.f, 0.f, 0.f};
    f16x8 At[4][2], B0[2][2], B1[2][2];
    const auto rsA = __builtin_amdgcn_make_buffer_rsrc((GAS void*)g.A, 0, 0x7fffffff, 0x00020000); const auto rsB = __builtin_amdgcn_make_buffer_rsrc((GAS void*)g.Bt, 0, 0x7fffffff, 0x00020000);
    unsigned cA = (unsigned)cur.pm * tstepA, cB = (unsigned)cur.pn * tstepB;
    if constexpr (SP2) {
        PG8_STAGE(PG8_SB(0, 0), B, cB, voffB); PG8_STAGE(PG8_SB(0, 1), B, cB + hstepB, voffB); PG8_STAGE(PG8_SA(0, 0), A, cA, voffA); PG8_STAGE(PG8_SA(0, 1), A, cA + hstepA, voffA);
        if (wr == 1) PG8_BAR;
        PG8_WAIT_V(2); PG8_BAR;
        PG8_STAGE(PG8_SB(1, 0), B, cB + kstep, voffB); PG8_STAGE(PG8_SA(1, 0), A, cA + kstep, voffA); PG8_STAGE(PG8_SB(1, 1), B, cB + hstepB + kstep, voffB);
        PG8_WAIT_V(6); PG8_BAR;
    } else {
        PG8_STAGE(PG8_SB(0, 0), B, cB, voffB); PG8_STAGE(PG8_SA(0, 0), A, cA, voffA); PG8_STAGE(PG8_SB(0, 1), B, cB + hstepB, voffB); PG8_STAGE(PG8_SA(0, 1), A, cA + hstepA, voffA);
        if (wr == 1) PG8_BAR;
        PG8_WAIT_V(4); PG8_BAR;
        PG8_STAGE(PG8_SB(1, 0), B, cB + kstep, voffB); PG8_STAGE(PG8_SA(1, 0), A, cA + kstep, voffA); PG8_STAGE(PG8_SB(1, 1), B, cB + hstepB + kstep, voffB);
        PG8_WAIT_V(6); PG8_BAR;
    }
    for (;;) {
        const bool has_next = S.next(ui + 1, nxt);
        const unsigned nA = has_next ? (unsigned)nxt.pm * tstepA : cA, nB = has_next ? (unsigned)nxt.pn * tstepB : cB;
        for (int t = 0; t < nt; t += 2) {
            if constexpr (Epi::MID_T >= 0) { if (t == Epi::MID_T) { const int ln3 = lane_id(); E.template mid<HA>(acc, cur, wr, wc, ln3 & 15, ln3 >> 4); } }
            const bool last = (t == nt - 2);
            const unsigned a1 = cA + (unsigned)(t + 1) * kstep;
            const unsigned a2 = last ? nA : cA + (unsigned)(t + 2) * kstep, b2 = last ? nB : cB + (unsigned)(t + 2) * kstep;
            const unsigned a3 = a2 + kstep, b3 = b2 + kstep;
            if constexpr (SP2) {
            PG8_LDB(B0, 0, 0); PG8_LDB(B1, 0, 1); PG8_SCHED; PG8_LDA(At, 0, 0); PG8_STAGE(PG8_SA(1, 1), A, a1 + hstepA, voffA);
            PG8_WAIT_V(8); PG8_WAIT_L(0); PG8_BAR; PG8_MMA(0, 0, At, B0); PG8_MMA(0, 1, At, B1); PG8_BAR; PG8_SCHED;
            PG8_LDA(At, 0, 1); PG8_STAGE(PG8_SB(0, 0), B, b2, voffB); PG8_STAGE(PG8_SB(0, 1), B, b2 + hstepB, voffB); PG8_STAGE(PG8_SA(0, 0), A, a2, voffA);
            PG8_WAIT_V(8); PG8_WAIT_L(0); PG8_BAR; PG8_MMA(1, 0, At, B0); PG8_MMA(1, 1, At, B1); PG8_BAR; PG8_SCHED;
            PG8_LDB(B0, 1, 0); PG8_LDB(B1, 1, 1); PG8_SCHED; PG8_LDA(At, 1, 0); PG8_STAGE(PG8_SA(0, 1), A, a2 + hstepA, voffA);
            PG8_WAIT_V(8); PG8_WAIT_L(0); PG8_BAR; PG8_MMA(0, 0, At, B0); PG8_MMA(0, 1, At, B1); PG8_BAR; PG8_SCHED;
            PG8_LDA(At, 1, 1); PG8_STAGE(PG8_SB(1, 0), B, b3, voffB); PG8_STAGE(PG8_SB(1, 1), B, b3 + hstepB, voffB); PG8_STAGE(PG8_SA(1, 0), A, a3, voffA);
            PG8_WAIT_V(8); PG8_WAIT_L(0); PG8_BAR; PG8_MMA(1, 0, At, B0); PG8_MMA(1, 1, At, B1); PG8_BAR; PG8_SCHED;
            } else {
            PG8_LDB(B0, 0, 0); PG8_SCHED; PG8_LDA(At, 0, 0); PG8_STAGE(PG8_SA(1, 1), A, a1 + hstepA, voffA);
            PG8_WAIT_L(8); PG8_BAR; PG8_WAIT_L(0); PG8_MMA(0, 0, At, B0); PG8_BAR; PG8_SCHED;
            PG8_LDB(B1, 0, 1); PG8_STAGE(PG8_SB(0, 0), B, b2, voffB);
            PG8_BAR; PG8_WAIT_L(0); PG8_MMA(0, 1, At, B1); PG8_BAR;
            PG8_LDA(At, 0, 1); PG8_STAGE(PG8_SA(0, 0), A, a2, voffA);
            PG8_BAR; PG8_WAIT_L(0); PG8_MMA(1, 0, At, B0); PG8_BAR; PG8_SCHED;
            PG8_STAGE(PG8_SB(0, 1), B, b2 + hstepB, voffB);
            PG8_WAIT_V(6); PG8_BAR; PG8_MMA(1, 1, At, B1); PG8_BAR;
            PG8_LDB(B0, 1, 0); PG8_SCHED; PG8_LDA(At, 1, 0); PG8_STAGE(PG8_SA(0, 1), A, a2 + hstepA, voffA);
            PG8_WAIT_L(8); PG8_BAR; PG8_WAIT_L(0); PG8_MMA(0, 0, At, B0); PG8_BAR; PG8_SCHED;
            PG8_LDB(B1, 1, 1); PG8_STAGE(PG8_SB(1, 0), B, b3, voffB);
            PG8_BAR; PG8_WAIT_L(0); PG8_MMA(0, 1, At, B1); PG8_BAR;
            PG8_LDA(At, 1, 1); PG8_STAGE(PG8_SA(1, 0), A, a3, voffA);
            PG8_BAR; PG8_WAIT_L(0); PG8_MMA(1, 0, At, B0); PG8_BAR; PG8_SCHED;
            PG8_STAGE(PG8_SB(1, 1), B, b3 + hstepB, voffB);
            PG8_WAIT_V(6); PG8_BAR; PG8_MMA(1, 1, At, B1); PG8_BAR;
            }
        }
        if constexpr (ALIGN_EPI) { if (wr == 0) PG8_BAR; }
        { const int ln2 = lane_id(); E.template run<HA>(acc, cur, wr, wc, ln2 & 15, ln2 >> 4); }
        if (!has_next) break;
#pragma unroll
        for (int a = 0; a < 2; ++a)
#pragma unroll
            for (int b = 0; b < 2; ++b)
#pragma unroll
                for (int m = 0; m < 4; ++m)
#pragma unroll
                    for (int n = 0; n < 2; ++n) acc[a][b][m][n] = (f32x4){0.f, 0.f, 0.f, 0.f};
        cur = nxt; cA = nA; cB = nB; ++ui;
        if constexpr (ALIGN_EPI) { if (wr == 1) PG8_BAR; }
    }
    PG8_WAIT_V(0);
    if constexpr (!ALIGN_EPI) { if (wr == 0) PG8_BAR; }
    PG8_BAR;
#undef PG8_SA
#undef PG8_SB
#undef PG8_STAGE
#undef PG8_LDA
#undef PG8_LDB
#undef PG8_MMA
#undef PG8_WAIT_V
#undef PG8_WAIT_L
#undef PG8_BAR
#undef PG8_SCHED
}
typedef f32x4 Acc[2][2][4][2];
#define PG8_EPI_LOOP(...) \
    const int row0 = u.pm * (2 * HA) + wr * (HA / 2) + fr, col0 = u.pn * BM + wc * 32 + 8 * fq; \
    _Pragma("unroll") for (int ai = 0; ai < 2; ++ai) _Pragma("unroll") for (int m = 0; m < HA / 32; ++m) { const int row = row0 + ai * HA + m * 16; \
        _Pragma("unroll") for (int bj = 0; bj < 2; ++bj) { const int col = col0 + bj * HALF; f32x4 v0 = acc[ai][bj][m][0], v1 = acc[ai][bj][m][1]; __VA_ARGS__ } asm volatile("" ::: "memory"); }
__device__ __forceinline__ void store8(GAS f16* p, f32x4 v0, f32x4 v1) { v4u w; w.x = pkh(v0[0], v0[1]); w.y = pkh(v0[2], v0[3]); w.z = pkh(v1[0], v1[1]); w.w = pkh(v1[2], v1[3]); *(GAS v4u*)p = w; }
struct EpiProjF { static constexpr int MID_T = -1; GAS f16* P;
    template <int HA> __device__ __forceinline__ void run(const Acc& acc, const Unit& u, int wr, int wc, int fr, int fq) const {
        PG8_EPI_LOOP(
            if (u.pn == 6) {
                if (col < PC_LA) { _Pragma("unroll") for (int e = 0; e < 4; ++e) { v0[e] = tanhf_(v0[e]); v1[e] = tanhf_(v1[e]); } }
                else if (col >= PC_LG) { _Pragma("unroll") for (int e = 0; e < 4; ++e) { v0[e] = sigmoidf_(v0[e]); v1[e] = sigmoidf_(v1[e]); } }
            } else if (u.pn >= 10) { _Pragma("unroll") for (int e = 0; e < 4; ++e) { v0[e] = sigmoidf_(v0[e]); v1[e] = sigmoidf_(v1[e]); } }
            store8(P + (size_t)row * DIN + col, v0, v1);
        )
    } };
#define DPPM(x, ctrl) (x) *= __builtin_bit_cast(float, __builtin_amdgcn_update_dpp(0x3f800000, __builtin_bit_cast(int, (x)), (ctrl), 0xF, 0xF, false))
struct EpiWAF { static constexpr int MID_T = -1; GAS f16* WA; const GAS float* w0; const GAS float* a0;
    template <int HA> __device__ __forceinline__ void run(const Acc& acc, const Unit& u, int wr, int wc, int fr, int fq) const {
        PG8_EPI_LOOP(
            if (col < 1024) { const f32x4 b0 = *(const GAS f32x4*)(w0 + col), b1 = *(const GAS f32x4*)(w0 + col + 4);
                float x[8];
                _Pragma("unroll") for (int e = 0; e < 4; ++e) { x[e] = __expf(-0.606531f * sigmoidf_(v0[e] + b0[e])); x[4 + e] = __expf(-0.606531f * sigmoidf_(v1[e] + b1[e])); }
                if (col < 512) {
                    _Pragma("unroll") for (int e = 0; e < 8; ++e) { DPPM(x[e], 0x111); DPPM(x[e], 0x112); DPPM(x[e], 0x114); DPPM(x[e], 0x118);
                        const float wm = __builtin_bit_cast(float, __builtin_amdgcn_ds_swizzle(__builtin_bit_cast(int, x[e]), 0x00F0)); x[e] = (fr == 7) ? wm : x[e] * __builtin_amdgcn_rcpf(wm); }
                } else {
                    _Pragma("unroll") for (int e = 0; e < 8; ++e) { DPPM(x[e], 0x101); DPPM(x[e], 0x102); DPPM(x[e], 0x104); DPPM(x[e], 0x108);
                        const float wm = __builtin_bit_cast(float, __builtin_amdgcn_ds_swizzle(__builtin_bit_cast(int, x[e]), 0x0110)); x[e] = (fr == 8) ? wm : x[e] * __builtin_amdgcn_rcpf(wm); }
                }
                _Pragma("unroll") for (int e = 0; e < 4; ++e) { v0[e] = x[e]; v1[e] = x[4 + e]; } }
            else { const f32x4 b0 = *(const GAS f32x4*)(a0 + col - 1024), b1 = *(const GAS f32x4*)(a0 + col - 1024 + 4);
                _Pragma("unroll") for (int e = 0; e < 4; ++e) { v0[e] = sigmoidf_(v0[e] + b0[e]); v1[e] = sigmoidf_(v1[e] + b1[e]); } }
            store8(WA + (size_t)row * 2048 + col, v0, v1);
        )
    } };
struct EpiF16F { static constexpr int MID_T = -1; GAS f16* O; int ld;
    template <int HA> __device__ __forceinline__ void run(const Acc& acc, const Unit& u, int wr, int wc, int fr, int fq) const {
        PG8_EPI_LOOP( store8(O + (size_t)row * ld + col, v0, v1); )
    } };
struct EpiRelu2F { static constexpr int MID_T = -1; GAS f16* O; int ld;
    template <int HA> __device__ __forceinline__ void run(const Acc& acc, const Unit& u, int wr, int wc, int fr, int fq) const {
        PG8_EPI_LOOP(
            _Pragma("unroll") for (int e = 0; e < 4; ++e) { const float a = fmaxf(v0[e], 0.f), b = fmaxf(v1[e], 0.f); v0[e] = a * a; v1[e] = b * b; }
            store8(O + (size_t)row * ld + col, v0, v1);
        )
    } };
struct EpiMergeF { static constexpr int MID_T = 8; GAS f16* MG; const GAS f16* PROJ;
    template <int HA> __device__ __forceinline__ void mid(Acc& acc, const Unit& u, int wr, int wc, int fr, int fq) const {
        const int row0 = u.pm * (2 * HA) + wr * (HA / 2) + fr, col0 = u.pn * BM + wc * 32 + 8 * fq;
#pragma unroll
        for (int ai = 0; ai < 2; ++ai)
#pragma unroll
            for (int m = 0; m < HA / 32; ++m) { const int row = row0 + ai * HA + m * 16;
#pragma unroll
                for (int bj = 0; bj < 2; ++bj) { const int col = col0 + bj * HALF;
                    const f16x8 gr = *(const GAS f16x8*)(PROJ + (size_t)row * DIN + PC_GR + col), ga = *(const GAS f16x8*)(PROJ + (size_t)row * DIN + PC_GA + col);
#pragma unroll
                    for (int e = 0; e < 4; ++e) { acc[ai][bj][m][0][e] *= (float)gr[e] * __builtin_amdgcn_rcpf(fmaxf((float)ga[e], 1e-4f)); acc[ai][bj][m][1][e] *= (float)gr[4 + e] * __builtin_amdgcn_rcpf(fmaxf((float)ga[4 + e], 1e-4f)); } }
                asm volatile("" ::: "memory"); }
    }
    template <int HA> __device__ __forceinline__ void run(const Acc& acc, const Unit& u, int wr, int wc, int fr, int fq) const {
        PG8_EPI_LOOP(
            const f16x8 ga = *(const GAS f16x8*)(PROJ + (size_t)row * DIN + PC_GA + col);
            _Pragma("unroll") for (int e = 0; e < 4; ++e) { v0[e] *= fmaxf((float)ga[e], 1e-4f); v1[e] *= fmaxf((float)ga[4 + e], 1e-4f); }
            store8(MG + (size_t)row * D + col, v0, v1);
        )
    } };
}

__device__ __forceinline__ void kv_prep(const Params& p0, const Ctx& c0, int l) {
    const Ctx c = fresh(c0); FRESH_P(p0);
    const GAS f16* PROJ = (const GAS f16*)(p.ws + WS_R1); GAS f16* KN = (GAS f16*)(p.ws + WS_KN); GAS f16* VT = (GAS f16*)(p.ws + WS_VT);
    const int d = c.lane;
    const float kg = IN(27)[l * HD + d];
    const int axis = d >> 5, half = (d >> 4) & 1, f = d & 15;
    const float freq = exp2f(-(float)f * (13.287712379549449f / 16.0f));
    for (int it = c.gw; it < (M / 8) * 2; it += c.ngw) {
        const int kvh = it & 1, row0 = (it >> 1) * 8;
        float kx[8], vx[8];
#pragma unroll
        for (int r = 0; r < 8; ++r) { const GAS f16* pr = PROJ + (size_t)(row0 + r) * DIN + kvh * HD + d; kx[r] = (float)pr[PC_KA]; vx[r] = (float)pr[PC_VA]; }
#pragma unroll
        for (int r = 0; r < 8; ++r) kx[r] = kx[r] * rsqrtf(wave_sum(kx[r] * kx[r]) * (1.0f / HD) + 1e-6f) * kg;
        f16x8 vv;
#pragma unroll
        for (int r = 0; r < 8; ++r) vv[r] = (f16)vx[r];
        if (row0 < M_CTX) { const int b = row0 >> 8, t0 = row0 & 255;
#pragma unroll
            for (int r = 0; r < 8; ++r) { const size_t o = ((((size_t)b * NL + l) * T_CTX + t0 + r) * 2 + kvh) * HD + d;
                p.out[O_CK + o] = kx[r]; p.out[O_CV + o] = vx[r];
                KN[(((size_t)b * 2 + kvh) * T_CTX + t0 + r) * HD + d] = (f16)kx[r]; }
            *(GAS f16x8*)(VT + (((size_t)b * 2 + kvh) * HD + d) * T_CTX + t0) = vv;
        } else { const int rr = row0 - M_CTX, b = rr >> 10, t0 = rr & 1023;
#pragma unroll
            for (int r = 0; r < 8; ++r) { const int t = t0 + r; const float pos = (float)(axis == 0 ? (t >> 6) : (t & 63));
                const float ang = pos * freq; const float cs = __cosf(ang), sn = __sinf(ang);
                const float other = xor16(kx[r]);
                const float ko = half == 0 ? kx[r] * cs - other * sn : kx[r] * cs + other * sn;
                KN[KN_SMP_OFF + (((size_t)b * 2 + kvh) * KV_SMP + PAST + t) * HD + d] = (f16)ko; }
            *(GAS f16x8*)(VT + KN_SMP_OFF + (((size_t)b * 2 + kvh) * HD + d) * KV_SMP + PAST + t0) = vv;
        }
    }
    for (int it = c.gw; it < B_SMP * (PAST / 8) * 2; it += c.ngw) {
        const int kvh = it & 1, j0 = ((it >> 1) & 31) * 8, b = it >> 6;
        f16x8 vv;
#pragma unroll
        for (int r = 0; r < 8; ++r) { const size_t s = ((((size_t)b * NL + l) * PAST + j0 + r) * 2 + kvh) * HD + d;
            KN[KN_SMP_OFF + (((size_t)b * 2 + kvh) * KV_SMP + j0 + r) * HD + d] = (f16)IN(2)[s]; vv[r] = (f16)IN(3)[s]; }
        *(GAS f16x8*)(VT + KN_SMP_OFF + (((size_t)b * 2 + kvh) * HD + d) * KV_SMP + j0) = vv;
    }
}

constexpr int TC = 32, ST_STEP = 6 * 64, ST_BUF = TC * ST_STEP;
struct StageRegs { f16x4 r[3], k[3], v[3], w, a; };
__device__ __forceinline__ void scan_task(const DParams& p, const Ctx& c, int l, int task) {
    const GAS f16* PROJ = (const GAS f16*)(p.ws + WS_R1); const GAS f16* WA = (const GAS f16*)(p.ws + WS_R2);
    GAS f16* Y = (GAS f16*)(p.ws + WS_R3); GAS float* RK = (GAS float*)(p.ws + WS_RK);
    LAS float* st = (LAS float*)c.lds;
    int sq, dir, h;
    if (task < 64) { h = task & 7; dir = (task >> 3) & 1; sq = B_CTX + (task >> 4); } else { const int id = task - 64; h = id & 7; dir = (id >> 3) & 1; sq = id >> 4; }
    const bool smp = sq >= B_CTX; const int T = smp ? T_SMP : T_CTX; const int row0 = smp ? M_CTX + (sq - B_CTX) * T_SMP : sq * T_CTX;
    const int nch = T / TC;
    const int tt = c.tid >> 4, cq = c.tid & 15, ch0 = h * HD + cq * 4;
    const f32x4 mu_r = *(const GAS f32x4*)(IN(15) + (l * 3 + 0) * CW + ch0), mu_k = *(const GAS f32x4*)(IN(15) + (l * 3 + 1) * CW + ch0), mu_v = *(const GAS f32x4*)(IN(15) + (l * 3 + 2) * CW + ch0);
    const f32x4 k_k = *(const GAS f32x4*)(IN(16) + l * CW + ch0), k_a = *(const GAS f32x4*)(IN(17) + l * CW + ch0), r_k = *(const GAS f32x4*)(IN(18) + l * CW + ch0);
    const int ks = c.lane & 7, srow = c.wave * 8 + (c.lane >> 3);
    float S[8];
    if (smp) { const GAS float* s0 = IN(4) + (((((size_t)(sq - B_CTX) * NL + l) * 2 + dir) * NH + h) * HD + srow) * HD + ks * 8;
        const f32x4 a = *(const GAS f32x4*)s0, b = *(const GAS f32x4*)(s0 + 4);
        S[0] = a[0]; S[1] = a[1]; S[2] = a[2]; S[3] = a[3]; S[4] = b[0]; S[5] = b[1]; S[6] = b[2]; S[7] = b[3];
    } else {
#pragma unroll
        for (int j = 0; j < 8; ++j) S[j] = 0.f;
    }
    StageRegs sr;
    const f16x4 z4 = {(f16)0.f, (f16)0.f, (f16)0.f, (f16)0.f};
#define SCAN_LOAD(chunk) do { const int S_ = (chunk) * TC + tt; const int t_ = dir ? T - 1 - S_ : S_; const GAS f16* pr_ = PROJ + (size_t)(row0 + t_) * DIN + ch0; \
        sr.r[1] = *(const GAS f16x4*)(pr_ + PC_R); sr.k[1] = *(const GAS f16x4*)(pr_ + PC_K); sr.v[1] = *(const GAS f16x4*)(pr_ + PC_V); \
        if (t_ > 0) { sr.r[0] = *(const GAS f16x4*)(pr_ - DIN + PC_R); sr.k[0] = *(const GAS f16x4*)(pr_ - DIN + PC_K); sr.v[0] = *(const GAS f16x4*)(pr_ - DIN + PC_V); } else { sr.r[0] = z4; sr.k[0] = z4; sr.v[0] = z4; } \
        if (t_ < T - 1) { sr.r[2] = *(const GAS f16x4*)(pr_ + DIN + PC_R); sr.k[2] = *(const GAS f16x4*)(pr_ + DIN + PC_K); sr.v[2] = *(const GAS f16x4*)(pr_ + DIN + PC_V); } else { sr.r[2] = z4; sr.k[2] = z4; sr.v[2] = z4; } \
        const GAS f16* wa_ = WA + (size_t)(row0 + t_) * 2048 + dir * 512 + ch0; sr.w = *(const GAS f16x4*)wa_; sr.a = *(const GAS f16x4*)(wa_ + 1024); } while (0)
#define SCAN_STAGE(chunk) do { const int S_ = (chunk) * TC + tt; const int t_ = dir ? T - 1 - S_ : S_; \
        f32x4 r_, k_, v_, kk_, w_, a_, kh_, kt_, b_; float ss_ = 0.f, rk_ = 0.f; \
        _Pragma("unroll") for (int e = 0; e < 4; ++e) { const float rc = (float)sr.r[1][e], kc = (float)sr.k[1][e], vc = (float)sr.v[1][e]; \
            r_[e] = rc + mu_r[e] * (0.5f * ((float)sr.r[0][e] + (float)sr.r[2][e]) - rc); k_[e] = kc + mu_k[e] * (0.5f * ((float)sr.k[0][e] + (float)sr.k[2][e]) - kc); \
            v_[e] = vc + mu_v[e] * (0.5f * ((float)sr.v[0][e] + (float)sr.v[2][e]) - vc); kk_[e] = k_[e] * k_k[e]; ss_ += kk_[e] * kk_[e]; w_[e] = (float)sr.w[e]; a_[e] = (float)sr.a[e]; } \
        ss_ = dpp_sum16(ss_); const float ri_ = rsqrtf(ss_ + 1e-12f); \
        _Pragma("unroll") for (int e = 0; e < 4; ++e) { kh_[e] = kk_[e] * ri_; kt_[e] = k_[e] * (1.0f + (a_[e] - 1.0f) * k_a[e]); b_[e] = a_[e] * kh_[e]; rk_ += r_[e] * kt_[e] * r_k[e]; } \
        rk_ = dpp_sum16(rk_); if (cq == 0) RK[((size_t)dir * M + row0 + t_) * 8 + h] = rk_; \
        LAS float* sb_ = st + ((chunk) & 1) * ST_BUF + tt * ST_STEP + cq * 4; \
        *(LAS f32x4*)(sb_) = kh_; *(LAS f32x4*)(sb_ + 64) = w_; *(LAS f32x4*)(sb_ + 128) = b_; *(LAS f32x4*)(sb_ + 192) = kt_; *(LAS f32x4*)(sb_ + 256) = r_; *(LAS f32x4*)(sb_ + 320) = v_; } while (0)
    SCAN_LOAD(0);
    SCAN_STAGE(0);
    __syncthreads();
    for (int chunk = 0; chunk < nch; ++chunk) {
        if (chunk + 1 < nch) SCAN_LOAD(chunk + 1);
        const LAS float* sb = st + (chunk & 1) * ST_BUF + ks * 8;
        const LAS float* vb = st + (chunk & 1) * ST_BUF + 320 + srow;
#pragma unroll 2
        for (int s = 0; s < TC; ++s) {
            const LAS float* q = sb + s * ST_STEP;
            const f32x4 kh0 = *(const LAS f32x4*)(q), kh1 = *(const LAS f32x4*)(q + 4);
            const f32x4 w0 = *(const LAS f32x4*)(q + 64), w1 = *(const LAS f32x4*)(q + 68);
            const f32x4 b0 = *(const LAS f32x4*)(q + 128), b1 = *(const LAS f32x4*)(q + 132);
            const f32x4 t0 = *(const LAS f32x4*)(q + 192), t1 = *(const LAS f32x4*)(q + 196);
            const f32x4 r0 = *(const LAS f32x4*)(q + 256), r1 = *(const LAS f32x4*)(q + 260);
            const float v = vb[s * ST_STEP];
            float sk = (S[0] * kh0[0] + S[1] * kh0[1]) + (S[2] * kh0[2] + S[3] * kh0[3]) + ((S[4] * kh1[0] + S[5] * kh1[1]) + (S[6] * kh1[2] + S[7] * kh1[3]));
            sk = dpp_sum8(sk);
#pragma unroll
            for (int e = 0; e < 4; ++e) { S[e] = S[e] * w0[e] + (v * t0[e] - sk * b0[e]); S[4 + e] = S[4 + e] * w1[e] + (v * t1[e] - sk * b1[e]); }
            float y = (S[0] * r0[0] + S[1] * r0[1]) + (S[2] * r0[2] + S[3] * r0[3]) + ((S[4] * r1[0] + S[5] * r1[1]) + (S[6] * r1[2] + S[7] * r1[3]));
            y = dpp_sum8(y);
            const int Sg = chunk * TC + s; const int t = dir ? T - 1 - Sg : Sg;
            if (ks == 0) Y[((size_t)dir * M + row0 + t) * CW + h * HD + srow] = (f16)y;
        }
        if (chunk + 1 < nch) SCAN_STAGE(chunk + 1);
        __syncthreads();
    }
#undef SCAN_LOAD
#undef SCAN_STAGE
    if (!smp) { GAS float* so = p.out + O_ST + (((((size_t)sq * NL + l) * 2 + dir) * NH + h) * HD + srow) * HD + ks * 8;
        *(GAS f32x4*)so = (f32x4){S[0], S[1], S[2], S[3]}; *(GAS f32x4*)(so + 4) = (f32x4){S[4], S[5], S[6], S[7]}; }
}
__device__ __forceinline__ void fast_scan(const Params& p0, const Ctx& c0, int l) {
    const Ctx c = fresh(c0); FRESH_P(p0);
    const int b = c.bid;
    if (b < 64) scan_task(p, c, l, b);
    else for (int task = b; task < 576; task += 192) scan_task(p, c, l, task);
}


namespace ms {
constexpr int O_AM = 0, O_BM = 4608, O_AT = 9216, O_VP = 14336, O_GT = 19456, O_NF = 22016, O_WM = 23040, O_WE = 23296, BUF = 23552;
constexpr int RS = 144, RT = 80;
}
__device__ __forceinline__ void mscan_task(const DParams& p, const Ctx& c, int l, int task) {
    using namespace ms;
    const GAS f16* PROJ = (const GAS f16*)(p.ws + WS_R1); const GAS f16* WA = (const GAS f16*)(p.ws + WS_R2);
    GAS f16* Y = (GAS f16*)(p.ws + WS_R3); GAS float* RK = (GAS float*)(p.ws + WS_RK);
    int sq, dir, h;
    if (task < 64) { h = task & 7; dir = (task >> 3) & 1; sq = B_CTX + (task >> 4); } else { const int id = task - 64; h = id & 7; dir = (id >> 3) & 1; sq = id >> 4; }
    const bool smp = sq >= B_CTX; const int T = smp ? T_SMP : T_CTX; const int row0 = smp ? M_CTX + (sq - B_CTX) * T_SMP : sq * T_CTX;
    const int nch = T / 16;
    const int vl = c.lane & 31, hh = c.lane >> 5;
    const int tq = c.tid - 128, ss = (tq >> 4) & 15, cq = tq & 15, k0 = cq * 4, ch0 = h * HD + k0;
    LAS float* cst = (LAS float*)(c.lds + 3 * BUF);
    if (c.wave == 7) { const int chn_ = h * HD + c.lane;
        cst[c.lane] = IN(15)[(l * 3 + 0) * CW + chn_]; cst[64 + c.lane] = IN(15)[(l * 3 + 1) * CW + chn_]; cst[128 + c.lane] = IN(15)[(l * 3 + 2) * CW + chn_];
        cst[192 + c.lane] = IN(16)[l * CW + chn_]; cst[256 + c.lane] = IN(17)[l * CW + chn_]; cst[320 + c.lane] = IN(18)[l * CW + chn_]; }

#define MS_BARRIER() do { asm volatile("s_waitcnt lgkmcnt(0)" ::: "memory"); __builtin_amdgcn_s_barrier(); asm volatile("" ::: "memory"); } while (0)
    if (c.wave >= 2 && c.wave < 6) {
    f16x4 G_rc, G_kc, G_vc, G_rp, G_kp, G_vp, G_rn, G_kn, G_vn, G_av, G_wo, G_wp, G_w7;
    { const f16x4 z4 = {(f16)0.f, (f16)0.f, (f16)0.f, (f16)0.f}; G_rc = G_kc = G_vc = G_rp = G_kp = G_vp = G_rn = G_kn = G_vn = G_av = G_wo = G_wp = G_w7 = z4; }
        for (int it = -3; it < nch; ++it) {
            const int ch = it + 2;
            if (ch >= 0 && ch < nch) {
                LAS unsigned char* buf = c.lds + (ch % 3) * BUF;
                const int Sg = ch * 16 + ss; const int t = dir ? T - 1 - Sg : Sg; const size_t row = (size_t)row0 + t;
                const f32x4 mu_r = *(const LAS f32x4*)(cst + k0), mu_k = *(const LAS f32x4*)(cst + 64 + k0), mu_v = *(const LAS f32x4*)(cst + 128 + k0), k_k = *(const LAS f32x4*)(cst + 192 + k0), k_a = *(const LAS f32x4*)(cst + 256 + k0), r_k = *(const LAS f32x4*)(cst + 320 + k0);
                f32x4 r_, k_, v_, kk_, kh_, kt_, b_; float sq_ = 0.f, rk_ = 0.f;
#pragma unroll
                for (int e = 0; e < 4; ++e) { const float rcf = (float)G_rc[e], kcf = (float)G_kc[e], vcf = (float)G_vc[e];
                    r_[e] = rcf + mu_r[e] * (0.5f * ((float)G_rp[e] + (float)G_rn[e]) - rcf); k_[e] = kcf + mu_k[e] * (0.5f * ((float)G_kp[e] + (float)G_kn[e]) - kcf);
                    v_[e] = vcf + mu_v[e] * (0.5f * ((float)G_vp[e] + (float)G_vn[e]) - vcf); kk_[e] = k_[e] * k_k[e]; sq_ += kk_[e] * kk_[e]; }
                sq_ = dpp_sum16(sq_); const float ri_ = rsqrtf(sq_ + 1e-12f);
#pragma unroll
                for (int e = 0; e < 4; ++e) { const float a_ = (float)G_av[e]; kh_[e] = kk_[e] * ri_; kt_[e] = k_[e] * (1.0f + (a_ - 1.0f) * k_a[e]); b_[e] = a_ * kh_[e]; rk_ += r_[e] * kt_[e] * r_k[e]; }
                rk_ = dpp_sum16(rk_); if (cq == 0) RK[((size_t)dir * M + row) * 8 + h] = rk_;
                float al[4], be[4], ka[4], rho[4];
#pragma unroll
                for (int e = 0; e < 4; ++e) { const float wm7 = (float)G_w7[e]; const float om = ss == 7 ? 1.0f : (float)G_wo[e]; const float omp = ss == 0 ? __builtin_amdgcn_rcpf(wm7) : (ss == 8 ? 1.0f : (float)G_wp[e]);
                    const float iom = __builtin_amdgcn_rcpf(om); al[e] = omp * kh_[e]; be[e] = b_[e] * iom; ka[e] = kt_[e] * iom; rho[e] = om * r_[e]; }
                v2u w2;
                w2.x = pkh(al[0], al[1]); w2.y = pkh(al[2], al[3]); *(LAS v2u*)(buf + O_BM + ss * RS + k0 * 2) = w2;
                w2.x = pkh(rho[0], rho[1]); w2.y = pkh(rho[2], rho[3]); *(LAS v2u*)(buf + O_BM + (16 + ss) * RS + k0 * 2) = w2;
                w2.x = pkh(be[0], be[1]); w2.y = pkh(be[2], be[3]); *(LAS v2u*)(buf + O_AM + ss * RS + k0 * 2) = w2;
                w2.x = pkh(ka[0], ka[1]); w2.y = pkh(ka[2], ka[3]); *(LAS v2u*)(buf + O_AM + (16 + ss) * RS + k0 * 2) = w2;
#pragma unroll
                for (int e = 0; e < 4; ++e) { *(LAS f16*)(buf + O_AT + (k0 + e) * RT + ss * 2) = (f16)ka[e]; *(LAS f16*)(buf + O_AT + (k0 + e) * RT + (16 + ss) * 2) = (f16)be[e];
                    *(LAS f16*)(buf + O_VP + (k0 + e) * RT + ss * 2) = (f16)v_[e]; }
                if (ss == 15) { f32x4 wm_, we_;
#pragma unroll
                    for (int e = 0; e < 4; ++e) { wm_[e] = (float)G_w7[e]; we_[e] = (float)G_wo[e]; }
                    *(LAS f32x4*)(buf + O_WM + k0 * 4) = wm_; *(LAS f32x4*)(buf + O_WE + k0 * 4) = we_; }
            }
            const int chn = it + 3;
            if (chn < nch) {
                const int Sg = chn * 16 + ss; const int t = dir ? T - 1 - Sg : Sg; const size_t row = (size_t)row0 + t;
                const GAS f16* pr = PROJ + row * DIN + ch0;
                const f16x4 z4 = {(f16)0.f, (f16)0.f, (f16)0.f, (f16)0.f};
                G_rc = *(const GAS f16x4*)(pr + PC_R); G_kc = *(const GAS f16x4*)(pr + PC_K); G_vc = *(const GAS f16x4*)(pr + PC_V);
                G_rp = z4; G_kp = z4; G_vp = z4; G_rn = z4; G_kn = z4; G_vn = z4;
                if (t > 0) { G_rp = *(const GAS f16x4*)(pr - DIN + PC_R); G_kp = *(const GAS f16x4*)(pr - DIN + PC_K); G_vp = *(const GAS f16x4*)(pr - DIN + PC_V); }
                if (t < T - 1) { G_rn = *(const GAS f16x4*)(pr + DIN + PC_R); G_kn = *(const GAS f16x4*)(pr + DIN + PC_K); G_vn = *(const GAS f16x4*)(pr + DIN + PC_V); }
                G_av = *(const GAS f16x4*)(WA + row * 2048 + 1024 + dir * 512 + ch0);
                const GAS f16* wo = WA + row * 2048 + dir * 512 + ch0;
                G_wo = *(const GAS f16x4*)wo; G_wp = *(const GAS f16x4*)(wo + (ss > 0 ? (dir ? 2048 : -2048) : 0)); G_w7 = *(const GAS f16x4*)(wo + (long)(7 - ss) * (dir ? -2048 : 2048));
            }
            MS_BARRIER();
        }
    } else if (c.wave == 6) {
        for (int it = -3; it < nch; ++it) {
            const int ch = it + 1;
            if (ch >= 0 && ch < nch) {
                LAS unsigned char* buf = c.lds + (ch % 3) * BUF;
                f32x16 g;
#pragma unroll
                for (int i = 0; i < 16; ++i) g[i] = 0.f;
#pragma unroll
                for (int s = 0; s < 4; ++s) { const f16x8 a = *(const LAS f16x8*)(buf + O_AM + vl * RS + (16 * s + 8 * hh) * 2), b = *(const LAS f16x8*)(buf + O_BM + vl * RS + (16 * s + 8 * hh) * 2);
                    g = __builtin_amdgcn_mfma_f32_32x32x16_f16(a, b, g, 0, 0, 0); }
                const int tcol = vl & 15; const bool incl = vl >= 16;
#pragma unroll
                for (int gq = 0; gq < 4; ++gq) { float o[4];
#pragma unroll
                    for (int e = 0; e < 4; ++e) { const int ip = 8 * gq + 4 * hh + e, i = ip & 15; const bool ok = incl ? (i <= tcol) : (i < tcol); o[e] = ok ? g[4 * gq + e] : 0.f; }
                    v2u w2; w2.x = pkh(o[0], o[1]); w2.y = pkh(o[2], o[3]);
                    *(LAS v2u*)(buf + O_GT + vl * RT + (8 * gq + 4 * hh) * 2) = w2;
                    if (gq < 2 && vl < 16) *(LAS f32x4*)(buf + O_NF + vl * 64 + (8 * gq + 4 * hh) * 4) = (f32x4){o[0], o[1], o[2], o[3]}; }
            }
            MS_BARRIER();
        }
    } else if (c.wave == 7) {
        unsigned pa0 = 0u, pa1 = 0u, pb0 = 0u, pb1 = 0u, pc0 = 0u, pc1 = 0u;
#define MS_TOUCH(chp_, r0_, r1_) do { const int chp = (chp_); if (chp < nch) { \
            _Pragma("unroll") for (int q_ = 0; q_ < 2; ++q_) { const int i_ = c.lane + 64 * q_; if (i_ < 86) { const GAS unsigned* a_; \
                if (i_ < 54) { const int rr_ = i_ / 3, sg_ = i_ - 3 * rr_; int t_ = dir ? T - 17 - 16 * chp + rr_ : 16 * chp - 1 + rr_; t_ = t_ < 0 ? 0 : (t_ > T - 1 ? T - 1 : t_); \
                    a_ = (const GAS unsigned*)(PROJ + (size_t)(row0 + t_) * DIN + (sg_ == 0 ? PC_R : (sg_ == 1 ? PC_K : PC_V)) + h * HD); } \
                else { const int j_ = i_ - 54, rr_ = j_ >> 1; const int t_ = dir ? T - 16 - 16 * chp + rr_ : 16 * chp + rr_; \
                    a_ = (const GAS unsigned*)(WA + (size_t)(row0 + t_) * 2048 + (j_ & 1) * 1024 + dir * 512 + h * HD); } \
                if (q_ == 0) r0_ = *a_; else r1_ = *a_; } } } } while (0)
        unsigned px0 = 0u, px1 = 0u, px2 = 0u, px3 = 0u, px4 = 0u, px5 = 0u;
        MS_TOUCH(0, px0, px1); MS_TOUCH(1, px2, px3); MS_TOUCH(2, px4, px5);
        for (int it = -3; it < nch; it += 3) {
            asm volatile("" :: "v"(pa0), "v"(pa1)); MS_TOUCH(it + 6, pa0, pa1); MS_BARRIER();
            if (it + 1 < nch) { asm volatile("" :: "v"(pb0), "v"(pb1)); MS_TOUCH(it + 7, pb0, pb1); MS_BARRIER(); }
            if (it + 2 < nch) { asm volatile("" :: "v"(pc0), "v"(pc1)); MS_TOUCH(it + 8, pc0, pc1); MS_BARRIER(); }
        }
        asm volatile("" :: "v"(px0), "v"(px1), "v"(px2), "v"(px3), "v"(px4), "v"(px5), "v"(pa0), "v"(pa1), "v"(pb0), "v"(pb1), "v"(pc0), "v"(pc1));
#undef MS_TOUCH
    } else {
    f32x16 St0, St1;
#pragma unroll
    for (int i = 0; i < 16; ++i) { St0[i] = 0.f; St1[i] = 0.f; }
    if (smp) { float one_ = 1.0f; asm volatile("" : "+v"(one_));
        const GAS float* s0 = IN(4) + (((((size_t)(sq - B_CTX) * NL + l) * 2 + dir) * NH + h) * HD + 32 * c.wave + vl) * HD + 4 * hh;
#pragma unroll
        for (int g = 0; g < 4; ++g) { const f32x4 a = *(const GAS f32x4*)(s0 + 8 * g), b = *(const GAS f32x4*)(s0 + 32 + 8 * g);
#pragma unroll
            for (int e = 0; e < 4; ++e) { St0[4 * g + e] = a[e] * one_; St1[4 * g + e] = b[e] * one_; } }
    }
        for (int it = -3; it < nch; ++it) {
            const int ch = it;
            if (ch >= 0) {
                LAS unsigned char* buf = c.lds + (ch % 3) * BUF;
                const int v = 32 * c.wave + vl;
                if (ch == 0) {
#pragma unroll
                for (int gq = 0; gq < 4; ++gq) { const f32x4 m0 = *(const LAS f32x4*)(buf + O_WM + (8 * gq + 4 * hh) * 4), m1 = *(const LAS f32x4*)(buf + O_WM + (32 + 8 * gq + 4 * hh) * 4);
#pragma unroll
                    for (int e = 0; e < 4; ++e) { St0[4 * gq + e] *= m0[e]; St1[4 * gq + e] *= m1[e]; } }
                }
                f32x16 X;
#pragma unroll
                for (int i = 0; i < 16; ++i) X[i] = 0.f;
#pragma unroll
                for (int s = 0; s < 4; ++s) {
                    f16x8 sb;
#pragma unroll
                    for (int j = 0; j < 8; ++j) sb[j] = (f16)((s < 2) ? St0[8 * (s & 1) + j] : St1[8 * (s & 1) + j]);
                    const f16x4 lo = *(const LAS f16x4*)(buf + O_BM + vl * RS + (16 * s + 4 * hh) * 2), hi = *(const LAS f16x4*)(buf + O_BM + vl * RS + (16 * s + 8 + 4 * hh) * 2);
                    const f16x8 af = {lo[0], lo[1], lo[2], lo[3], hi[0], hi[1], hi[2], hi[3]};
                    X = __builtin_amdgcn_mfma_f32_32x32x16_f16(af, sb, X, 0, 0, 0);
                }
                { const f16x8 a = *(const LAS f16x8*)(buf + O_GT + vl * RT + (16 + 8 * hh) * 2), b = *(const LAS f16x8*)(buf + O_VP + v * RT + (8 * hh) * 2);
                  X = __builtin_amdgcn_mfma_f32_32x32x16_f16(a, b, X, 0, 0, 0); }
                const f16x8 aN = *(const LAS f16x8*)(buf + O_GT + vl * RT + (8 * hh) * 2);
                f16x8 pball;
#pragma unroll
                for (int j = 0; j < 8; ++j) pball[j] = (f16)0.f;
#define MS_BLK(a) do { const int xo_ = 4 * ((a) >> 1); \
                    const f32x4 n1_ = *(const LAS f32x4*)(buf + O_NF + (4 * (a) + 1) * 64 + 16 * (a)), n2_ = *(const LAS f32x4*)(buf + O_NF + (4 * (a) + 2) * 64 + 16 * (a)), n3_ = *(const LAS f32x4*)(buf + O_NF + (4 * (a) + 3) * 64 + 16 * (a)); \
                    float q0_ = X[xo_]; float q1_ = X[xo_ + 1] - q0_ * n1_[0]; float q2_ = X[xo_ + 2] - q0_ * n2_[0] - q1_ * n2_[1]; float q3_ = X[xo_ + 3] - q0_ * n3_[0] - q1_ * n3_[1] - q2_ * n3_[2]; \
                    if (((a) & 1) != ((a) >> 1)) { float a_, b_; \
                        a_ = q0_; b_ = q0_; swap32(a_, b_); q0_ = ((a) & 1) ? b_ : a_; a_ = q1_; b_ = q1_; swap32(a_, b_); q1_ = ((a) & 1) ? b_ : a_; \
                        a_ = q2_; b_ = q2_; swap32(a_, b_); q2_ = ((a) & 1) ? b_ : a_; a_ = q3_; b_ = q3_; swap32(a_, b_); q3_ = ((a) & 1) ? b_ : a_; } \
                    const bool hold_ = hh == ((a) >> 1); \
                    const f16 z_ = (f16)0.f; const f16 e0_ = hold_ ? (f16)(-q0_) : z_, e1_ = hold_ ? (f16)(-q1_) : z_, e2_ = hold_ ? (f16)(-q2_) : z_, e3_ = hold_ ? (f16)(-q3_) : z_; \
                    f16x8 pb_ = {z_, z_, z_, z_, z_, z_, z_, z_}; \
                    pb_[4 * ((a) & 1)] = e0_; pb_[4 * ((a) & 1) + 1] = e1_; pb_[4 * ((a) & 1) + 2] = e2_; pb_[4 * ((a) & 1) + 3] = e3_; \
                    if (hold_) { pball[4 * ((a) & 1)] = e0_; pball[4 * ((a) & 1) + 1] = e1_; pball[4 * ((a) & 1) + 2] = e2_; pball[4 * ((a) & 1) + 3] = e3_; } \
                    X = __builtin_amdgcn_mfma_f32_32x32x16_f16(aN, pb_, X, 0, 0, 0); } while (0)
                MS_BLK(0); MS_BLK(1); MS_BLK(2); MS_BLK(3);
#undef MS_BLK
#pragma unroll
                for (int r = 8; r < 16; ++r) { const int t = (r & 3) + 8 * ((r >> 2) - 2) + 4 * hh; const int Sg = ch * 16 + t; const int tok = dir ? T - 1 - Sg : Sg;
                    Y[((size_t)dir * M + row0 + tok) * CW + h * HD + v] = (f16)X[r]; }
#pragma unroll
                for (int s2 = 0; s2 < 2; ++s2) { const f16x8 b = s2 == 0 ? *(const LAS f16x8*)(buf + O_VP + v * RT + (8 * hh) * 2) : pball;
                    const f16x8 a0 = *(const LAS f16x8*)(buf + O_AT + vl * RT + (16 * s2 + 8 * hh) * 2), a1 = *(const LAS f16x8*)(buf + O_AT + (32 + vl) * RT + (16 * s2 + 8 * hh) * 2);
                    St0 = __builtin_amdgcn_mfma_f32_32x32x16_f16(a0, b, St0, 0, 0, 0); St1 = __builtin_amdgcn_mfma_f32_32x32x16_f16(a1, b, St1, 0, 0, 0); }
                { LAS unsigned char* nbuf = c.lds + ((ch + 1) % 3) * BUF; const bool more = ch + 1 < nch;
#pragma unroll
                for (int gq = 0; gq < 4; ++gq) { f32x4 m0 = *(const LAS f32x4*)(buf + O_WE + (8 * gq + 4 * hh) * 4), m1 = *(const LAS f32x4*)(buf + O_WE + (32 + 8 * gq + 4 * hh) * 4);
                    if (more) { m0 *= *(const LAS f32x4*)(nbuf + O_WM + (8 * gq + 4 * hh) * 4); m1 *= *(const LAS f32x4*)(nbuf + O_WM + (32 + 8 * gq + 4 * hh) * 4); }
#pragma unroll
                    for (int e = 0; e < 4; ++e) { St0[4 * gq + e] *= m0[e]; St1[4 * gq + e] *= m1[e]; } } }
            }
            MS_BARRIER();
        }
    if (!smp) {
        GAS float* so = p.out + O_ST + (((((size_t)sq * NL + l) * 2 + dir) * NH + h) * HD + 32 * c.wave + vl) * HD + 4 * hh;
#pragma unroll
        for (int g = 0; g < 4; ++g) { *(GAS f32x4*)(so + 8 * g) = (f32x4){St0[4 * g], St0[4 * g + 1], St0[4 * g + 2], St0[4 * g + 3]};
            *(GAS f32x4*)(so + 32 + 8 * g) = (f32x4){St1[4 * g], St1[4 * g + 1], St1[4 * g + 2], St1[4 * g + 3]}; }
    }
    }
#undef MS_BARRIER
}
__device__ __forceinline__ void mfma_scan(const Params& p0, const Ctx& c0, int l) {
    const Ctx c = fresh(c0); FRESH_P(p0);
    const int b = c.bid, G = (int)gridDim.x;
    const bool deal = G >= 128;
    const int first = b, step = deal ? (b < 64 ? 576 : G - 64) : G;
#pragma nounroll
    for (int task = first; task < 576; task += step) mscan_task(p, c, l, task);
}

__device__ __forceinline__ int swap23(int r) { return (r & ~12) | ((r & 4) << 1) | ((r & 8) >> 1); }
__device__ __forceinline__ void attn_wave_task(const DParams& p, const Ctx& c, int l, int task) {
    const GAS f16* PROJ = (const GAS f16*)(p.ws + WS_R1); const GAS f16* KN = (const GAS f16*)(p.ws + WS_KN); const GAS f16* VT = (const GAS f16*)(p.ws + WS_VT);
    GAS f16* OA = (GAS f16*)(p.ws + WS_R4);
    const int hq = task & 7, qb = task >> 3, kvh = hq >> 2;
    const int r32 = c.lane & 31, hh = c.lane >> 5;
    int rowq0, L; const GAS f16* Kb; const GAS f16* Vb; bool smp;
    if (qb < 128) { smp = true; rowq0 = M_CTX + qb * 32; const int b = qb >> 5; L = KV_SMP;
        Kb = KN + KN_SMP_OFF + ((size_t)b * 2 + kvh) * KV_SMP * HD; Vb = VT + KN_SMP_OFF + ((size_t)b * 2 + kvh) * HD * KV_SMP; }
    else { smp = false; rowq0 = (qb - 128) * 32; const int b = rowq0 >> 8; L = T_CTX;
        Kb = KN + ((size_t)b * 2 + kvh) * T_CTX * HD; Vb = VT + ((size_t)b * 2 + kvh) * HD * T_CTX; }
    const int row = rowq0 + r32;
    float x[4][8]; float ss = 0.f;
#pragma unroll
    for (int s = 0; s < 4; ++s) { const f16x8 q = *(const GAS f16x8*)(PROJ + (size_t)row * DIN + PC_Q + hq * HD + 16 * s + 8 * hh);
#pragma unroll
        for (int j = 0; j < 8; ++j) { x[s][j] = (float)q[j]; ss += x[s][j] * x[s][j]; } }
    ss = half_sum(ss);
    const float rstd = rsqrtf(ss * (1.0f / HD) + 1e-6f);
#pragma unroll
    for (int s = 0; s < 4; ++s)
#pragma unroll
        for (int j = 0; j < 8; ++j) x[s][j] *= rstd * IN(26)[l * HD + 16 * s + 8 * hh + j];
    if (smp) { const int t = (row - M_CTX) & (T_SMP - 1); const float posr = (float)(t >> 6), posc = (float)(t & 63);
#pragma unroll
        for (int j = 0; j < 8; ++j) { const float freq = exp2f(-(float)(8 * hh + j) * (13.287712379549449f / 16.0f));
            const float ar = posr * freq, ac = posc * freq; const float cr = __cosf(ar), sr = __sinf(ar), cc = __cosf(ac), sc = __sinf(ac);
            const float a0 = x[0][j], a1 = x[1][j], b0 = x[2][j], b1 = x[3][j];
            x[0][j] = a0 * cr - a1 * sr; x[1][j] = a1 * cr + a0 * sr; x[2][j] = b0 * cc - b1 * sc; x[3][j] = b1 * cc + b0 * sc; } }
    f16x8 qf[4];
#pragma unroll
    for (int s = 0; s < 4; ++s)
#pragma unroll
        for (int j = 0; j < 8; ++j) qf[s][j] = (f16)(x[s][j] * (0.125f * 1.4426950408889634f));
    f32x16 o0, o1;
#pragma unroll
    for (int i = 0; i < 16; ++i) { o0[i] = 0.f; o1[i] = 0.f; }
    float mrun = -1e30f, lsum = 0.f;
    const GAS f16* kp = Kb + (size_t)swap23(r32) * HD + 8 * hh;
    const GAS f16* vp = Vb + (size_t)r32 * L + 8 * hh;
    const int ntile = L >> 5;
    f16x8 kf[4], vf[4];
#pragma unroll
    for (int s = 0; s < 4; ++s) kf[s] = *(const GAS f16x8*)(kp + 16 * s);
    vf[0] = *(const GAS f16x8*)(vp); vf[1] = *(const GAS f16x8*)(vp + 16); vf[2] = *(const GAS f16x8*)(vp + (size_t)32 * L); vf[3] = *(const GAS f16x8*)(vp + (size_t)32 * L + 16);
    for (int kt = 0; kt < ntile; ++kt) {
        f16x8 kn[4], vn[4];
        const int ktn = kt + 1 < ntile ? kt + 1 : kt;
#pragma unroll
        for (int s = 0; s < 4; ++s) kn[s] = *(const GAS f16x8*)(kp + (size_t)ktn * 32 * HD + 16 * s);
        vn[0] = *(const GAS f16x8*)(vp + ktn * 32); vn[1] = *(const GAS f16x8*)(vp + ktn * 32 + 16); vn[2] = *(const GAS f16x8*)(vp + (size_t)32 * L + ktn * 32); vn[3] = *(const GAS f16x8*)(vp + (size_t)32 * L + ktn * 32 + 16);
        f32x16 sa;
#pragma unroll
        for (int i = 0; i < 16; ++i) sa[i] = 0.f;
#pragma unroll
        for (int s = 0; s < 4; ++s) sa = __builtin_amdgcn_mfma_f32_32x32x16_f16(kf[s], qf[s], sa, 0, 0, 0);
        float mt = sa[0];
#pragma unroll
        for (int i = 1; i < 16; ++i) mt = fmaxf(mt, sa[i]);
        mt = half_max(mt);
        const float mn = fmaxf(mrun, mt); const float alpha = exp2f(mrun - mn); mrun = mn;
        float ps = 0.f;
#pragma unroll
        for (int i = 0; i < 16; ++i) { sa[i] = exp2f(sa[i] - mn); ps += sa[i]; }
        lsum = lsum * alpha + ps;
#pragma unroll
        for (int i = 0; i < 16; ++i) { o0[i] *= alpha; o1[i] *= alpha; }
        f16x8 pb0, pb1;
#pragma unroll
        for (int j = 0; j < 8; ++j) { pb0[j] = (f16)sa[j]; pb1[j] = (f16)sa[8 + j]; }
        o0 = __builtin_amdgcn_mfma_f32_32x32x16_f16(vf[0], pb0, o0, 0, 0, 0);
        o0 = __builtin_amdgcn_mfma_f32_32x32x16_f16(vf[1], pb1, o0, 0, 0, 0);
        o1 = __builtin_amdgcn_mfma_f32_32x32x16_f16(vf[2], pb0, o1, 0, 0, 0);
        o1 = __builtin_amdgcn_mfma_f32_32x32x16_f16(vf[3], pb1, o1, 0, 0, 0);
#pragma unroll
        for (int s = 0; s < 4; ++s) { kf[s] = kn[s]; vf[s] = vn[s]; }
    }
    lsum = half_sum(lsum);
    const float inv = 1.0f / lsum;
    GAS f16* op = OA + (size_t)row * D + CW + hq * HD + 4 * hh;
#pragma unroll
    for (int g = 0; g < 4; ++g) {
        v2u w0; w0.x = pkh(o0[4 * g] * inv, o0[4 * g + 1] * inv); w0.y = pkh(o0[4 * g + 2] * inv, o0[4 * g + 3] * inv);
        v2u w1; w1.x = pkh(o1[4 * g] * inv, o1[4 * g + 1] * inv); w1.y = pkh(o1[4 * g + 2] * inv, o1[4 * g + 3] * inv);
        *(GAS v2u*)(op + 8 * g) = w0; *(GAS v2u*)(op + 32 + 8 * g) = w1; }
}
constexpr int AT_KS = 144, AT_BUF = 2 * 64 * AT_KS;
__device__ __forceinline__ void attn_block_task(const DParams& p, const Ctx& c, int l, int item) {
    const GAS f16* PROJ = (const GAS f16*)(p.ws + WS_R1); const GAS f16* KN = (const GAS f16*)(p.ws + WS_KN); const GAS f16* VT = (const GAS f16*)(p.ws + WS_VT);
    GAS f16* OA = (GAS f16*)(p.ws + WS_R4);
    int rowq0, L, kvh; const GAS f16* Kb; const GAS f16* Vb; bool smp;
    if (item < 128) { smp = true; const int b = item >> 5; kvh = (item >> 4) & 1; rowq0 = M_CTX + b * T_SMP + (item & 15) * 64; L = KV_SMP;
        Kb = KN + KN_SMP_OFF + ((size_t)b * 2 + kvh) * KV_SMP * HD; Vb = VT + KN_SMP_OFF + ((size_t)b * 2 + kvh) * HD * KV_SMP; }
    else { smp = false; const int id = item - 128; const int b = id >> 3; kvh = (id >> 2) & 1; rowq0 = b * T_CTX + (id & 3) * 64; L = T_CTX;
        Kb = KN + ((size_t)b * 2 + kvh) * T_CTX * HD; Vb = VT + ((size_t)b * 2 + kvh) * HD * T_CTX; }
    const int hq = kvh * 4 + (c.wave & 3);
    const int r32 = c.lane & 31, hh = c.lane >> 5;
    const int row = rowq0 + 32 * (c.wave >> 2) + r32;
    const int kk = c.tid >> 3, chk = c.tid & 7;
    const GAS f16* ksrc = Kb + (size_t)kk * HD + chk * 8;
    const GAS f16* vsrc = Vb + (size_t)kk * L + chk * 8;
    const int sdst = kk * AT_KS + chk * 16;
    v4u kreg = *(const GAS v4u*)ksrc, vreg = *(const GAS v4u*)vsrc;
    float x[4][8]; float ss = 0.f;
#pragma unroll
    for (int s = 0; s < 4; ++s) { const f16x8 q = *(const GAS f16x8*)(PROJ + (size_t)row * DIN + PC_Q + hq * HD + 16 * s + 8 * hh);
#pragma unroll
        for (int j = 0; j < 8; ++j) { x[s][j] = (float)q[j]; ss += x[s][j] * x[s][j]; } }
    ss = half_sum(ss);
    const float rstd = rsqrtf(ss * (1.0f / HD) + 1e-6f);
#pragma unroll
    for (int s = 0; s < 4; ++s)
#pragma unroll
        for (int j = 0; j < 8; ++j) x[s][j] *= rstd * IN(26)[l * HD + 16 * s + 8 * hh + j];
    if (smp) { const int t = (row - M_CTX) & (T_SMP - 1); const float posr = (float)(t >> 6), posc = (float)(t & 63);
#pragma unroll
        for (int j = 0; j < 8; ++j) { const float freq = exp2f(-(float)(8 * hh + j) * (13.287712379549449f / 16.0f));
            const float ar = posr * freq, ac = posc * freq; const float cr = __cosf(ar), sr = __sinf(ar), cc = __cosf(ac), sc = __sinf(ac);
            const float a0 = x[0][j], a1 = x[1][j], b0 = x[2][j], b1 = x[3][j];
            x[0][j] = a0 * cr - a1 * sr; x[1][j] = a1 * cr + a0 * sr; x[2][j] = b0 * cc - b1 * sc; x[3][j] = b1 * cc + b0 * sc; } }
    f16x8 qf[4];
#pragma unroll
    for (int s = 0; s < 4; ++s)
#pragma unroll
        for (int j = 0; j < 8; ++j) qf[s][j] = (f16)(x[s][j] * (0.125f * 1.4426950408889634f));
    f32x16 o0, o1;
#pragma unroll
    for (int i = 0; i < 16; ++i) { o0[i] = 0.f; o1[i] = 0.f; }
    float mrun = -1e30f, lsum = 0.f;
    const int nstep = L >> 6;
    *(LAS v4u*)(c.lds + sdst) = kreg; *(LAS v4u*)(c.lds + 64 * AT_KS + sdst) = vreg;
    asm volatile("s_waitcnt lgkmcnt(0)" ::: "memory"); __builtin_amdgcn_s_barrier(); asm volatile("" ::: "memory");
    const int koff = swap23(r32) * AT_KS + 16 * hh, voff = 64 * AT_KS + r32 * AT_KS + 16 * hh;
    for (int st = 0; st < nstep; ++st) {
        if (st + 1 < nstep) { kreg = *(const GAS v4u*)(ksrc + (size_t)(st + 1) * 64 * HD); vreg = *(const GAS v4u*)(vsrc + (st + 1) * 64); }
        LAS unsigned char* sb = c.lds + (st & 1) * AT_BUF;
        f32x16 sa0, sa1;
#pragma unroll
        for (int i = 0; i < 16; ++i) { sa0[i] = 0.f; sa1[i] = 0.f; }
#pragma unroll
        for (int s = 0; s < 4; ++s) { const f16x8 k0 = *(const LAS f16x8*)(sb + koff + 32 * s), k1 = *(const LAS f16x8*)(sb + koff + 32 * AT_KS + 32 * s);
            sa0 = __builtin_amdgcn_mfma_f32_32x32x16_f16(k0, qf[s], sa0, 0, 0, 0); sa1 = __builtin_amdgcn_mfma_f32_32x32x16_f16(k1, qf[s], sa1, 0, 0, 0); }
        float mt = fmaxf(sa0[0], sa1[0]);
#pragma unroll
        for (int i = 1; i < 16; ++i) mt = fmaxf(mt, fmaxf(sa0[i], sa1[i]));
        mt = half_max(mt);
        const float mn = fmaxf(mrun, mt); const float alpha = __builtin_amdgcn_exp2f(mrun - mn); mrun = mn;
        float ps = 0.f;
#pragma unroll
        for (int i = 0; i < 16; ++i) { sa0[i] = __builtin_amdgcn_exp2f(sa0[i] - mn); sa1[i] = __builtin_amdgcn_exp2f(sa1[i] - mn); ps += sa0[i] + sa1[i]; }
        lsum = lsum * alpha + ps;
#pragma unroll
        for (int i = 0; i < 16; ++i) { o0[i] *= alpha; o1[i] *= alpha; }
        f16x8 pb[4];
#pragma unroll
        for (int j = 0; j < 8; ++j) { pb[0][j] = (f16)sa0[j]; pb[1][j] = (f16)sa0[8 + j]; pb[2][j] = (f16)sa1[j]; pb[3][j] = (f16)sa1[8 + j]; }
#pragma unroll
        for (int q4 = 0; q4 < 4; ++q4) {
            const f16x8 v0 = *(const LAS f16x8*)(sb + voff + 32 * q4), v1 = *(const LAS f16x8*)(sb + voff + 32 * AT_KS + 32 * q4);
            o0 = __builtin_amdgcn_mfma_f32_32x32x16_f16(v0, pb[q4], o0, 0, 0, 0); o1 = __builtin_amdgcn_mfma_f32_32x32x16_f16(v1, pb[q4], o1, 0, 0, 0); }
        if (st + 1 < nstep) { LAS unsigned char* nb = c.lds + ((st + 1) & 1) * AT_BUF; *(LAS v4u*)(nb + sdst) = kreg; *(LAS v4u*)(nb + 64 * AT_KS + sdst) = vreg; }
        asm volatile("s_waitcnt lgkmcnt(0)" ::: "memory"); __builtin_amdgcn_s_barrier(); asm volatile("" ::: "memory");
    }
    lsum = half_sum(lsum);
    const float inv = 1.0f / lsum;
    GAS f16* op = OA + (size_t)row * D + CW + hq * HD + 4 * hh;
#pragma unroll
    for (int g = 0; g < 4; ++g) {
        v2u w0; w0.x = pkh(o0[4 * g] * inv, o0[4 * g + 1] * inv); w0.y = pkh(o0[4 * g + 2] * inv, o0[4 * g + 3] * inv);
        v2u w1; w1.x = pkh(o1[4 * g] * inv, o1[4 * g + 1] * inv); w1.y = pkh(o1[4 * g + 2] * inv, o1[4 * g + 3] * inv);
        *(GAS v2u*)(op + 8 * g) = w0; *(GAS v2u*)(op + 32 + 8 * g) = w1; }
}
__device__ __forceinline__ void fast_attn(const Params& p0, const Ctx& c0, int l) {
    const Ctx c = fresh(c0); FRESH_P(p0);
    unsigned* ctr = (unsigned*)(p0.ws + WS_CTL) + 8192 + 64 * l;
    volatile LAS unsigned* slot = (volatile LAS unsigned*)(c.lds + MISC_OFF) + 16;
    for (;;) {
        if (c.tid == 0) slot[0] = __hip_atomic_fetch_add(ctr, 1u, __ATOMIC_RELAXED, __HIP_MEMORY_SCOPE_AGENT);
        __syncthreads();
        const int item = (int)slot[0];
        __syncthreads();
        if (item >= 384) break;
        attn_block_task(p, c, l, item);
    }
}

__device__ __forceinline__ void post_phase(const Params& p0, const Ctx& c0, int l) {
    const Ctx c = fresh(c0); FRESH_P(p0);
    const GAS f16* PROJ = (const GAS f16*)(p.ws + WS_R1); const GAS f16* Y = (const GAS f16*)(p.ws + WS_R3); const GAS float* RK = (const GAS float*)(p.ws + WS_RK);
    GAS f16* OA = (GAS f16*)(p.ws + WS_R4);
    const int ch0 = c.lane * 8, h = c.lane >> 3;
    float gnw[8], gnb[8], muv[8];
    { const f32x4 a0 = *(const GAS f32x4*)(IN(24) + l * CW + ch0), a1 = *(const GAS f32x4*)(IN(24) + l * CW + ch0 + 4), b0 = *(const GAS f32x4*)(IN(25) + l * CW + ch0), b1 = *(const GAS f32x4*)(IN(25) + l * CW + ch0 + 4);
      const f32x4 m0 = *(const GAS f32x4*)(IN(15) + (l * 3 + 2) * CW + ch0), m1 = *(const GAS f32x4*)(IN(15) + (l * 3 + 2) * CW + ch0 + 4);
#pragma unroll
      for (int e = 0; e < 4; ++e) { gnw[e] = a0[e]; gnw[4 + e] = a1[e]; gnb[e] = b0[e]; gnb[4 + e] = b1[e]; muv[e] = m0[e]; muv[4 + e] = m1[e]; } }
    for (int row = c.gw; row < M; row += c.ngw) {
        int g, t, T; row_info(row, g, t, T);
        const GAS f16* pr = PROJ + (size_t)row * DIN + PC_V + ch0;
        const f16x8 y0 = *(const GAS f16x8*)(Y + (size_t)row * CW + ch0), y1 = *(const GAS f16x8*)(Y + ((size_t)M + row) * CW + ch0);
        const f16x8 vc = *(const GAS f16x8*)pr; const f16x8 gv = *(const GAS f16x8*)(OA + (size_t)row * D + ch0);
        f16x8 vp, vn;
#pragma unroll
        for (int e = 0; e < 8; ++e) { vp[e] = (f16)0.f; vn[e] = (f16)0.f; }
        if (t > 0) vp = *(const GAS f16x8*)(pr - DIN);
        if (t < T - 1) vn = *(const GAS f16x8*)(pr + DIN);
        const float rk = RK[(size_t)row * 8 + h] + RK[((size_t)M + row) * 8 + h];
        float y[8]; float s = 0.f;
#pragma unroll
        for (int e = 0; e < 8; ++e) { y[e] = (float)y0[e] + (float)y1[e]; s += y[e]; }
        const float mean = dpp_sum8(s) * (1.0f / HD); float q = 0.f;
#pragma unroll
        for (int e = 0; e < 8; ++e) { y[e] -= mean; q += y[e] * y[e]; }
        const float rstd = rsqrtf(dpp_sum8(q) * (1.0f / HD) + 64e-5f);
        float o[8];
#pragma unroll
        for (int e = 0; e < 8; ++e) { const float vcf = (float)vc[e]; const float v = vcf + muv[e] * (0.5f * ((float)vp[e] + (float)vn[e]) - vcf);
            o[e] = (y[e] * rstd * gnw[e] + gnb[e] + rk * v) * (float)gv[e]; }
        v4u w; w.x = pkh(o[0], o[1]); w.y = pkh(o[2], o[3]); w.z = pkh(o[4], o[5]); w.w = pkh(o[6], o[7]);
        *(GAS v4u*)(OA + (size_t)row * D + ch0) = w;
    }
}

__device__ __forceinline__ void gemm_proj(const Params& p0, const Ctx& c0) { const Ctx c = fresh(c0); FRESH_P(p0);
    pg8::Gemm g{(const GAS f16*)(p.ws + WS_R4), (const GAS f16*)(p.ws + WS_W + WO_IN), D, D, D}; pg8::StaticOrder S; S.init(M, DIN, (int)gridDim.x, c.bid);
    pg8::gemm_phase(c.lds, g, S, pg8::EpiProjF{(GAS f16*)(p.ws + WS_R1)}, c.wave); }
__device__ __forceinline__ void gemm_wa(const Params& p0, const Ctx& c0, int l) { const Ctx c = fresh(c0); FRESH_P(p0);
    pg8::Gemm g{(const GAS f16*)(p.ws + WS_R1) + PC_LW, (const GAS f16*)(p.ws + WS_W + WO_SM), DIN, 128, 128}; pg8::StaticOrder S; S.init(M, 2048, (int)gridDim.x, c.bid);
    pg8::gemm_phase(c.lds, g, S, pg8::EpiWAF{(GAS f16*)(p.ws + WS_R2), IN(19) + (size_t)l * 2 * CW, IN(21) + (size_t)l * 2 * CW}, c.wave); }
__device__ __forceinline__ void gemm_gate(const Params& p0, const Ctx& c0) { const Ctx c = fresh(c0); FRESH_P(p0);
    pg8::Gemm g{(const GAS f16*)(p.ws + WS_R1) + PC_LG, (const GAS f16*)(p.ws + WS_W + WO_G), DIN, 128, 128}; pg8::StaticOrder S; if (gridDim.x >= 224) S.init(M, CW, (int)gridDim.x, c.bid - 128); else S.init(M, CW, (int)gridDim.x, c.bid);
    pg8::gemm_phase(c.lds, g, S, pg8::EpiF16F{(GAS f16*)(p.ws + WS_R4), D}, c.wave); }
__device__ __forceinline__ void gemm_merge(const Params& p0, const Ctx& c0) { const Ctx c = fresh(c0); FRESH_P(p0);
    const GAS f16* OA = (const GAS f16*)(p.ws + WS_R4); const GAS f16* WbrT = (const GAS f16*)(p.ws + WS_W + WO_BR); GAS f16* MG = (GAS f16*)(p.ws + WS_R3); const GAS f16* PROJ = (const GAS f16*)(p.ws + WS_R1);
    pg8::StaticOrder S; S.init(M, D, (int)gridDim.x, c.bid, 192);
    pg8::Gemm g{OA, WbrT, D, D, D}; pg8::gemm_phase<pg8::EpiMergeF, 96>(c.lds, g, S, pg8::EpiMergeF{MG, PROJ}, c.wave); }
__device__ __forceinline__ void gemm_out(const Params& p0, const Ctx& c0) { const Ctx c = fresh(c0); FRESH_P(p0);
    pg8::Gemm g{(const GAS f16*)(p.ws + WS_R3), (const GAS f16*)(p.ws + WS_W + WO_OUT), D, D, D}; pg8::StaticOrder S; S.init(M, D, (int)gridDim.x, c.bid, 192);
    pg8::gemm_phase<pg8::EpiF16F, 96>(c.lds, g, S, pg8::EpiF16F{(GAS f16*)(p.ws + WS_R2), D}, c.wave); }
__device__ __forceinline__ void gemm_up(const Params& p0, const Ctx& c0) { const Ctx c = fresh(c0); FRESH_P(p0);
    pg8::Gemm g{(const GAS f16*)(p.ws + WS_R4), (const GAS f16*)(p.ws + WS_W + WO_UP), D, D, D}; pg8::StaticOrder S; S.init(M, DFF, (int)gridDim.x, c.bid);
    pg8::gemm_phase(c.lds, g, S, pg8::EpiRelu2F{(GAS f16*)(p.ws + WS_R1), DFF}, c.wave); }
__device__ __forceinline__ void gemm_down(const Params& p0, const Ctx& c0) { const Ctx c = fresh(c0); FRESH_P(p0);
    pg8::Gemm g{(const GAS f16*)(p.ws + WS_R1), (const GAS f16*)(p.ws + WS_W + WO_DN), DFF, DFF, DFF}; pg8::StaticOrder S; S.init(M, D, (int)gridDim.x, c.bid, 192);
    pg8::gemm_phase<pg8::EpiF16F, 96>(c.lds, g, S, pg8::EpiF16F{(GAS f16*)(p.ws + WS_R2), D}, c.wave); }

__global__ void __launch_bounds__(NTHREADS, 2) fwd_kernel(Params p) {
    extern __shared__ __attribute__((aligned(16))) unsigned char lds_raw[];
    Ctx c;
    c.lds = (LAS unsigned char*)lds_raw;
    c.tid = threadIdx.x; c.lane = c.tid & 63; c.wave = __builtin_amdgcn_readfirstlane(c.tid >> 6);
    c.gw = blockIdx.x * NWAVES + c.wave; c.ngw = gridDim.x * NWAVES; c.gt = blockIdx.x * NTHREADS + c.tid; c.ngt = gridDim.x * NTHREADS;
    volatile LAS unsigned* MISC = (volatile LAS unsigned*)(c.lds + MISC_OFF);
    if (c.tid < 32) MISC[c.tid] = 0u;
    if (c.tid < 28) ((LAS unsigned long long*)(c.lds + PTAB_OFF))[c.tid] = (unsigned long long)p.in[c.tid];
    __syncthreads();
    unsigned* ctl = (unsigned*)(p.ws + WS_CTL);
    XcdBarrier bar = xcd_barrier_post(ctl + CW_BAR, MISC + 8);
#define GRID_BAR() xcd_barrier(bar)

    conv_weights(p, c, 0);
    __syncthreads();
    mod_phase(p, c);
    GRID_BAR();
    norm_phase<0>(p, c, 0);
    GRID_BAR();
#pragma nounroll
    for (int l = 0; l < NL; ++l) {
        gemm_proj(p, c);
        GRID_BAR();
        gemm_wa(p, c, l);
        gemm_gate(p, c);
        kv_prep(p, c, l);
        GRID_BAR();
        mfma_scan(p, c, l);
        __syncthreads();
        fast_attn(p, c, l);
        GRID_BAR();
        post_phase(p, c, l);
        GRID_BAR();
        gemm_merge(p, c);
        GRID_BAR();
        gemm_out(p, c);
        GRID_BAR();
        norm_phase<1>(p, c, l);
        GRID_BAR();
        gemm_up(p, c);
        GRID_BAR();
        gemm_down(p, c);
        GRID_BAR();
        norm_phase<2>(p, c, l);
        if (l + 1 < NL) { __syncthreads(); conv_weights(p, c, l + 1); }
        GRID_BAR();
    }
}

extern "C" void kernel_launch(void* const* d_in, const int* in_sizes, int n_in, void* d_out, int out_size, void* d_ws, size_t ws_size, hipStream_t stream) {
    static int grid = 0;
    if (grid == 0) {
        if (n_in != 28 || (size_t)out_size != O_TOTAL || ws_size < WS_END) { fprintf(stderr, "kernel_launch: unexpected shapes n_in %d out %d ws %zu\n", n_in, out_size, ws_size); grid = -1; return; }
        int dev = 0, cus = 0;
        if (hipGetDevice(&dev) != hipSuccess || hipDeviceGetAttribute(&cus, hipDeviceAttributeMultiprocessorCount, dev) != hipSuccess) { grid = -1; return; }
        if (hipFuncSetAttribute((const void*)fwd_kernel, hipFuncAttributeMaxDynamicSharedMemorySize, LDS_BYTES) != hipSuccess) { fprintf(stderr, "kernel_launch: hipFuncSetAttribute failed\n"); grid = -1; return; }
        grid = cus;
    }
    if (grid < 0) return;
    (void)hipMemsetAsync((char*)d_ws + WS_CTL, 0, CTL_BYTES + MiB, stream);
    Params p{};
    for (int i = 0; i < 28; ++i) p.in[i] = (const float*)d_in[i];
    p.out = (float*)d_out; p.ws = (unsigned char*)d_ws;
    hipLaunchKernelGGL(fwd_kernel, dim3(grid), dim3(NTHREADS), LDS_BYTES, stream, p);
}
```

```cpp
#include <hip/hip_runtime.h>
#include <cstdio>
#include <cstdint>

#define GAS __attribute__((address_space(1)))
#define LAS __attribute__((address_space(3)))
typedef _Float16 f16;
typedef _Float16 f16x8 __attribute__((ext_vector_type(8)));
typedef _Float16 f16x4 __attribute__((ext_vector_type(4)));
typedef _Float16 f16x2 __attribute__((ext_vector_type(2)));
typedef float f32x4 __attribute__((ext_vector_type(4)));
typedef float f32x16 __attribute__((ext_vector_type(16)));
typedef unsigned v4u __attribute__((ext_vector_type(4)));
typedef unsigned v2u __attribute__((ext_vector_type(2)));

constexpr int D = 1024, DIN = 4608, DFF = 4096, CW = 512, NL = 2, NH = 8, HD = 64;
constexpr int B_CTX = 32, T_CTX = 256, B_SMP = 4, T_SMP = 1024, PAST = 256, KV_SMP = PAST + T_SMP;
constexpr int M_CTX = B_CTX * T_CTX, M_SMP = B_SMP * T_SMP, M = M_CTX + M_SMP;
constexpr int NMOD = 6 * D;
constexpr int PC_R = 0, PC_K = 512, PC_V = 1024, PC_LW = 1536, PC_LA = 1600, PC_LG = 1664, PC_Q = 1792, PC_KA = 2304, PC_VA = 2432, PC_GR = 2560, PC_GA = 3584;
constexpr size_t O_Y = 0, O_CK = (size_t)M * D, O_CV = O_CK + (size_t)B_CTX * NL * T_CTX * 128, O_ST = O_CV + (size_t)B_CTX * NL * T_CTX * 128;
constexpr size_t O_TOTAL = O_ST + (size_t)B_CTX * NL * 2 * NH * HD * HD;

constexpr size_t MiB = 1u << 20;
constexpr size_t WS_CTL = 0, CTL_BYTES = 1 * MiB;
constexpr size_t WS_MOD = 1 * MiB;
constexpr size_t WS_W = 2 * MiB;
constexpr size_t WO_IN = 0, WO_BR = 9 * MiB, WO_OUT = 11 * MiB, WO_UP = 13 * MiB, WO_DN = 21 * MiB, WO_SM = 29 * MiB, WO_G = 29 * MiB + 512 * 1024;
constexpr size_t WS_R1 = 32 * MiB;
constexpr size_t WS_R2 = 140 * MiB;
constexpr size_t WS_R3 = 188 * MiB;
constexpr size_t WS_RK = 212 * MiB;
constexpr size_t WS_R4 = 213 * MiB;
constexpr size_t WS_KN = 237 * MiB;
constexpr size_t WS_VT = 241 * MiB;
constexpr size_t WS_END = 245 * MiB;
constexpr size_t KN_SMP_OFF = (size_t)B_CTX * 2 * T_CTX * 64;

constexpr int NWAVES = 8, NTHREADS = 512;
constexpr int LDS_BYTES = 147456;
constexpr int MISC_OFF = 131072 + 320, PTAB_OFF = 131072 + 1024;

#define XB_TMO      128
#define XB_XCNT(j)  (256  + 64 * (j))
#define XB_XSUB(j)  (1280 + 64 * (j))
#define XB_XGEN(j)  (2304 + 64 * (j))
#define XB_TOP      3328
#define XB_TOPGEN   3392
#define XCD_BAR_WORDS 3456
#define XB_SPIN_CAP (1u << 24)
constexpr int CW_BAR = 4096;

__device__ __forceinline__ unsigned xb_ld(unsigned* p)              { return __hip_atomic_load(p, __ATOMIC_RELAXED, __HIP_MEMORY_SCOPE_AGENT); }
__device__ __forceinline__ unsigned xb_add(unsigned* p, unsigned v) { return __hip_atomic_fetch_add(p, v, __ATOMIC_RELAXED, __HIP_MEMORY_SCOPE_AGENT); }
__device__ __forceinline__ unsigned xb_xcc_id() { return (unsigned)__builtin_amdgcn_s_getreg((3 << 11) | 20) & 0xFu; }
#define XB_SPIN(cond, bar) do { unsigned _sp = 0; while (cond) { __builtin_amdgcn_s_sleep(1); \
    if ((++_sp & 255u) == 0u) { if (xb_ld(&(bar)[XB_TMO])) break; if (_sp > XB_SPIN_CAP) { atomicAdd(&(bar)[XB_TMO], 1u); break; } } } } while (0)

struct XcdBarrier { unsigned* bar; unsigned x; volatile LAS unsigned* st; };

__device__ __forceinline__ XcdBarrier xcd_barrier_post(unsigned* bar, volatile LAS unsigned* st) {
    XcdBarrier b; b.bar = bar; b.x = xb_xcc_id(); b.st = st;
    if (threadIdx.x == 0) (void)xb_add(&bar[XB_XCNT(b.x)], 1u);
    return b;
}
__device__ __forceinline__ void xcd_barrier_complete(unsigned* bar, unsigned x, unsigned& nloc, unsigned& nx) {
    const unsigned G = gridDim.x * gridDim.y * gridDim.z;
    unsigned sum, cnt, mine, sp = 0u;
    for (;;) {
        sum = 0u; cnt = 0u; mine = 0u;
#pragma unroll
        for (unsigned j = 0; j < 16; ++j) { const unsigned c = xb_ld(&bar[XB_XCNT(j)]); sum += c; cnt += (c > 0u) ? 1u : 0u; mine = (j == x) ? c : mine; }
        if (sum == G) break;
        __builtin_amdgcn_s_sleep(1);
        if ((++sp & 255u) == 0u) { if (xb_ld(&bar[XB_TMO])) break; if (sp > XB_SPIN_CAP) { atomicAdd(&bar[XB_TMO], 1u); break; } }
    }
    nloc = mine > 0u ? mine : 1u; nx = cnt > 0u ? cnt : 1u;
}
__device__ __forceinline__ void xcd_barrier(const XcdBarrier& b) {
    asm volatile("s_waitcnt vmcnt(0)" ::: "memory");
    __syncthreads();
    if (threadIdx.x == 0) {
        unsigned* bar = b.bar; unsigned bx = b.x;
        asm volatile("" : "+s"(bar), "+s"(bx));
        __builtin_amdgcn_s_waitcnt(0);
        unsigned nloc = b.st[0], nx = b.st[1];
        if (nloc == 0u) { xcd_barrier_complete(bar, bx, nloc, nx); b.st[0] = nloc; b.st[1] = nx; }
        const unsigned old = xb_add(&bar[XB_XSUB(bx)], 1u);
        const unsigned gen = old / nloc;
        if (old + 1u == (gen + 1u) * nloc) {
            __builtin_amdgcn_fence(__ATOMIC_RELEASE, "agent");
            asm volatile("s_waitcnt vmcnt(0)" ::: "memory");
            const unsigned og = xb_add(&bar[XB_TOP], 1u);
            const unsigned tg = og / nx;
            if (og + 1u == (tg + 1u) * nx) xb_add(&bar[XB_TOPGEN], 1u);
            else XB_SPIN(xb_ld(&bar[XB_TOPGEN]) == tg, bar);
            __builtin_amdgcn_fence(__ATOMIC_ACQUIRE, "agent");
            xb_add(&bar[XB_XGEN(bx)], 1u);
            asm volatile("s_waitcnt vmcnt(0)" ::: "memory");
        } else {
            XB_SPIN(xb_ld(&bar[XB_XGEN(bx)]) == gen, bar);
            __builtin_amdgcn_fence(__ATOMIC_ACQUIRE, "agent");
            asm volatile("s_waitcnt vmcnt(0)" ::: "memory");
        }
    }
    __syncthreads();
}

#define LDS_WAIT() asm volatile("s_waitcnt lgkmcnt(0)" ::: "memory")
#define DPPF(x, ctrl, rmask, oldv) __builtin_bit_cast(float, __builtin_amdgcn_update_dpp(__builtin_bit_cast(int, (float)(oldv)), __builtin_bit_cast(int, (float)(x)), (ctrl), (rmask), 0xF, false))
__device__ __forceinline__ float wave_sum(float v) {
    v += DPPF(v, 0xB1, 0xF, 0.f); v += DPPF(v, 0x4E, 0xF, 0.f); v += DPPF(v, 0x141, 0xF, 0.f); v += DPPF(v, 0x140, 0xF, 0.f);
    v += DPPF(v, 0x142, 0xA, 0.f); v += DPPF(v, 0x143, 0xC, 0.f);
    return __builtin_bit_cast(float, __builtin_amdgcn_readlane(__builtin_bit_cast(int, v), 63));
}
__device__ __forceinline__ float dpp_f(float x, const int ctrl) { return x; }
#define DPP_ADD(x, ctrl) (x) += __builtin_bit_cast(float, __builtin_amdgcn_update_dpp(0, __builtin_bit_cast(int, (x)), (ctrl), 0xF, 0xF, true))
__device__ __forceinline__ float dpp_sum8(float x) { DPP_ADD(x, 0xB1); DPP_ADD(x, 0x4E); DPP_ADD(x, 0x141); return x; }
__device__ __forceinline__ float dpp_sum16(float x) { DPP_ADD(x, 0xB1); DPP_ADD(x, 0x4E); DPP_ADD(x, 0x141); DPP_ADD(x, 0x140); return x; }
__device__ __forceinline__ void swap32(float& a, float& b) { asm volatile("v_nop\n\tv_nop\n\tv_permlane32_swap_b32 %0, %1" : "+v"(a), "+v"(b)); }
__device__ __forceinline__ float half_sum(float v) { float a = v, b = v; swap32(a, b); return a + b; }
__device__ __forceinline__ float half_max(float v) { float a = v, b = v; swap32(a, b); return fmaxf(a, b); }
__device__ __forceinline__ float xor16(float v) { return __builtin_bit_cast(float, __builtin_amdgcn_ds_swizzle(__builtin_bit_cast(int, v), 0x401F)); }
__device__ __forceinline__ float sigmoidf_(float x) { return __builtin_amdgcn_rcpf(1.0f + __expf(-x)); }
__device__ __forceinline__ float tanhf_(float x) { return 1.0f - 2.0f * __builtin_amdgcn_rcpf(1.0f + __expf(2.0f * x)); }
__device__ __forceinline__ unsigned pkh(float lo, float hi) { f16x2 v = {(f16)lo, (f16)hi}; return __builtin_bit_cast(unsigned, v); }
__device__ __forceinline__ void row_info(int row, int& g, int& t, int& T) {
    if (row < M_CTX) { g = 0; t = row & (T_CTX - 1); T = T_CTX; }
    else { const int r = row - M_CTX; g = 1 + (r >> 10); t = r & (T_SMP - 1); T = T_SMP; }
}

struct Params {
    const float* in[28];
    float* out;
    unsigned char* ws;
};
struct DParams { GAS float* out; GAS unsigned char* ws; };
struct Ctx {
    LAS unsigned char* lds;
    int tid, lane, wave, gw, ngw, gt, ngt, bid;
};
__device__ __forceinline__ int lane_id() { int ln; asm volatile("v_mbcnt_lo_u32_b32 %0, -1, 0\n\tv_mbcnt_hi_u32_b32 %0, -1, %0" : "=v"(ln)); return ln; }
__device__ __forceinline__ const GAS float* inp(const Ctx& c, int i) {
    const unsigned long long v = ((const LAS unsigned long long*)(c.lds + PTAB_OFF))[i];
    const unsigned lo = __builtin_amdgcn_readfirstlane((unsigned)v), hi = __builtin_amdgcn_readfirstlane((unsigned)(v >> 32));
    return (const GAS float*)(((unsigned long long)hi << 32) | lo); }
#define IN(i) inp(c, (i))
#define FRESH_P(p0) DParams p; { float* o_ = (p0).out; unsigned char* w_ = (p0).ws; asm volatile("" : "+s"(o_), "+s"(w_)); p.out = (GAS float*)o_; p.ws = (GAS unsigned char*)w_; }
__device__ __forceinline__ Ctx fresh(const Ctx& c0) {
    Ctx c = c0; int w = c0.wave; asm volatile("" : "+s"(w)); int ln = lane_id(); asm volatile("" : "+v"(ln));
    int b = blockIdx.x; asm volatile("" : "+s"(b));
    c.wave = w; c.lane = ln; c.tid = w * 64 + ln; c.bid = b;
    c.gw = b * 8 + w; c.gt = b * 512 + c.tid; return c; }

__device__ __forceinline__ void conv_item(const GAS float* W, int N, GAS f16* WT, int ldt, int koff, LAS float* scr, int kb, int nb, int lane) {
    const int k0 = 64 * kb, n0 = 32 * nb;
#pragma unroll 8
    for (int i = 0; i < 32; ++i) { const int kk = 2 * i + (lane >> 5); scr[kk * 33 + (lane & 31)] = W[(size_t)(k0 + kk) * N + n0 + (lane & 31)]; }
    LDS_WAIT();
    const int c = lane & 7;
#pragma unroll
    for (int j = 0; j < 4; ++j) { const int n = (lane >> 3) + 8 * j; const LAS float* s = scr + (8 * c) * 33 + n;
        v4u o; o.x = pkh(s[0 * 33], s[1 * 33]); o.y = pkh(s[2 * 33], s[3 * 33]); o.z = pkh(s[4 * 33], s[5 * 33]); o.w = pkh(s[6 * 33], s[7 * 33]);
        *(GAS v4u*)(WT + (size_t)(n0 + n) * ldt + koff + k0 + 8 * c) = o; }
    LDS_WAIT();
}
__device__ __forceinline__ void conv_weights(const Params& p0, const Ctx& c0, int l) {
    const Ctx c = fresh(c0); FRESH_P(p0);
    LAS float* scr = (LAS float*)(c.lds + c.wave * 16384);
    GAS unsigned char* wb = p.ws + WS_W;
    GAS f16* WinT = (GAS f16*)(wb + WO_IN); GAS f16* WbrT = (GAS f16*)(wb + WO_BR); GAS f16* WoutT = (GAS f16*)(wb + WO_OUT); GAS f16* WupT = (GAS f16*)(wb + WO_UP); GAS f16* WdnT = (GAS f16*)(wb + WO_DN);
    GAS f16* WsmT = (GAS f16*)(wb + WO_SM); GAS f16* WgT = (GAS f16*)(wb + WO_G);
    const GAS float* w_in = IN(7) + (size_t)l * D * DIN; const GAS float* w_br = IN(8) + (size_t)l * 2 * CW * D; const GAS float* w_out = IN(9) + (size_t)l * D * D;
    const GAS float* w_up = IN(13) + (size_t)l * D * DFF; const GAS float* w_dn = IN(14) + (size_t)l * DFF * D;
    const GAS float* dec_up = IN(20) + (size_t)l * 2 * 64 * CW; const GAS float* icl_up = IN(22) + (size_t)l * 2 * 64 * CW; const GAS float* gate_up = IN(23) + (size_t)l * 128 * CW;
    constexpr int I0 = 16 * 144, I1 = 8 * 32, I2 = 8 * 32, I3 = 16 * 32, I4 = 16 * 128, I5 = 64 * 32, I6 = 16, I7 = 16, I8 = 16, I9 = 16, I10 = 2 * 16;
    constexpr int NIT = I0 + I1 + I2 + I3 + I4 + I5 + I6 + I7 + I8 + I9 + I10;
    for (int it = c.gw; it < NIT; it += c.ngw) {
        int r = it;
        if (r < I0) { conv_item(w_in, DIN, WinT, D, 0, scr, r / 144, r % 144, c.lane); continue; } r -= I0;
        if (r < I1) { conv_item(w_br, D, WbrT, D, 0, scr, r / 32, r % 32, c.lane); continue; } r -= I1;
        if (r < I2) { conv_item(w_br + (size_t)CW * D, D, WbrT, D, CW, scr, r / 32, r % 32, c.lane); continue; } r -= I2;
        if (r < I3) { conv_item(w_out, D, WoutT, D, 0, scr, r / 32, r % 32, c.lane); continue; } r -= I3;
        if (r < I4) { conv_item(w_up, DFF, WupT, D, 0, scr, r / 128, r % 128, c.lane); continue; } r -= I4;
        if (r < I5) { conv_item(w_dn, D, WdnT, DFF, 0, scr, r / 32, r % 32, c.lane); continue; } r -= I5;
        if (r < I6) { conv_item(dec_up, CW, WsmT, 128, 0, scr, 0, r, c.lane); continue; } r -= I6;
        if (r < I7) { conv_item(dec_up + 64 * CW, CW, WsmT + (size_t)512 * 128, 128, 0, scr, 0, r, c.lane); continue; } r -= I7;
        if (r < I8) { conv_item(icl_up, CW, WsmT + (size_t)1024 * 128, 128, 64, scr, 0, r, c.lane); continue; } r -= I8;
        if (r < I9) { conv_item(icl_up + 64 * CW, CW, WsmT + (size_t)1536 * 128, 128, 64, scr, 0, r, c.lane); continue; } r -= I9;
        conv_item(gate_up, CW, WgT, 128, 0, scr, r / 16, r % 16, c.lane);
    }
    unsigned zz_ = 0u; asm volatile("" : "+v"(zz_));
    for (int i = c.gt; i < 2048 * 8; i += c.ngt) { const int row = i >> 3, ch = i & 7; const int col = (row < 1024 ? 64 : 0) + ch * 8;
        *(GAS v4u*)(WsmT + (size_t)row * 128 + col) = (v4u){zz_, zz_, zz_, zz_}; }
}

__device__ __forceinline__ void mod_phase(const Params& p0, const Ctx& c0) {
    const Ctx c = fresh(c0); FRESH_P(p0);
    LAS float* sl = (LAS float*)(c.lds);
    LAS float* part = (LAS float*)(c.lds + 32768);
    GAS float* mod = (GAS float*)(p.ws + WS_MOD);
    for (int i = c.tid; i < 5 * D; i += NTHREADS) { const int g = i >> 10, k = i & 1023; const float v = g == 0 ? IN(6)[k] : IN(5)[(g - 1) * D + k]; sl[i] = v / (1.0f + __expf(-v)); }
    __syncthreads();
    for (int it = c.bid; it < NL * (NMOD / 64) * 4; it += gridDim.x) {
        const int kq = it & 3, lc = it >> 2, l = lc / (NMOD / 64), cc = lc % (NMOD / 64);
        const int kb = kq * 256 + c.wave * 32;
        const GAS float* w = IN(10) + (size_t)l * D * NMOD + (size_t)kb * NMOD + cc * 64 + c.lane;
        float a0 = 0.f, a1 = 0.f, a2 = 0.f, a3 = 0.f, a4 = 0.f;
        float wv[32];
#pragma unroll
        for (int k = 0; k < 32; ++k) wv[k] = w[(size_t)k * NMOD];
#pragma unroll
        for (int k = 0; k < 32; ++k) { a0 += sl[kb + k] * wv[k]; a1 += sl[D + kb + k] * wv[k]; a2 += sl[2 * D + kb + k] * wv[k]; a3 += sl[3 * D + kb + k] * wv[k]; a4 += sl[4 * D + kb + k] * wv[k]; }
        LAS float* pw = part + c.wave * 320 + c.lane;
        pw[0] = a0; pw[64] = a1; pw[128] = a2; pw[192] = a3; pw[256] = a4;
        __syncthreads();
        if (c.tid < 320) { float s = 0.f;
#pragma unroll
            for (int w8 = 0; w8 < 8; ++w8) s += part[w8 * 320 + c.tid];
            const int g = c.tid >> 6, col = cc * 64 + (c.tid & 63);
            if (kq == 0) s += IN(11)[(size_t)l * NMOD + col];
            atomicAdd((float*)(mod + ((size_t)l * 5 + g) * NMOD + col), s); }
        __syncthreads();
    }
}

template <int MODE, int NB>
__device__ __forceinline__ void norm_rows(const DParams& p, const Ctx& c, int l, int row_first, int row_end, int row_step) {
    GAS float* X = p.out; const GAS f16* MO = (const GAS f16*)(p.ws + WS_R2); GAS f16* H = (GAS f16*)(p.ws + WS_R4);
    const GAS float* modb = (const GAS float*)(p.ws + WS_MOD);
    const GAS float* in0 = IN(0); const GAS float* in1 = IN(1); const GAS float* ngb = IN(12);
    for (int rowb = row_first; rowb < row_end; rowb += NB * row_step) {
        f32x4 x[NB][4]; f16x4 mh[NB][4];
#pragma unroll
        for (int b = 0; b < NB; ++b) { const int row = rowb + b * row_step;
            if (row < row_end) {
                if (MODE == 0) { const GAS float* src = row < M_CTX ? in0 + (size_t)row * D : in1 + (size_t)(row - M_CTX) * D;
#pragma unroll
                    for (int j = 0; j < 4; ++j) x[b][j] = __builtin_nontemporal_load((const GAS f32x4*)(src + 256 * j + 4 * c.lane)); }
                else { const GAS float* xs = (MODE == 1 && l == 0) ? (row < M_CTX ? in0 + (size_t)row * D : in1 + (size_t)(row - M_CTX) * D) : X + (size_t)row * D;
#pragma unroll
                    for (int j = 0; j < 4; ++j) { x[b][j] = __builtin_nontemporal_load((const GAS f32x4*)(xs + 256 * j + 4 * c.lane));
                        mh[b][j] = __builtin_nontemporal_load((const GAS f16x4*)(MO + (size_t)row * D + 256 * j + 4 * c.lane)); } } } }
#pragma unroll
        for (int b = 0; b < NB; ++b) { const int row = rowb + b * row_step;
            if (row < row_end) {
                int g, t, T; row_info(row, g, t, T);
                if (MODE != 0) {
                    const GAS float* mo_mod = modb + ((size_t)l * 5 + g) * NMOD + (MODE == 1 ? 2 * D : 5 * D);
                    const GAS float* ngp = ngb + ((size_t)l * 4 + (MODE == 1 ? 1 : 3)) * D;
                    float mv[4][4]; float ss = 0.f;
#pragma unroll
                    for (int j = 0; j < 4; ++j)
#pragma unroll
                        for (int e = 0; e < 4; ++e) { mv[j][e] = (float)mh[b][j][e]; ss += mv[j][e] * mv[j][e]; }
                    const float rstd = rsqrtf(wave_sum(ss) * (1.0f / D) + 1e-6f);
#pragma unroll
                    for (int j = 0; j < 4; ++j) { const f32x4 gg = *(const GAS f32x4*)(mo_mod + 256 * j + 4 * c.lane); const f32x4 nn = *(const GAS f32x4*)(ngp + 256 * j + 4 * c.lane);
#pragma unroll
                        for (int e = 0; e < 4; ++e) x[b][j][e] += gg[e] * (mv[j][e] * rstd * nn[e]); }
                }
                const int ln = MODE == 2 ? l + 1 : l;
                if (ln < NL) {
                    const GAS float* mb = modb + ((size_t)ln * 5 + g) * NMOD + (MODE == 1 ? 3 * D : 0);
                    const GAS float* ngp = ngb + ((size_t)ln * 4 + (MODE == 1 ? 2 : 0)) * D;
                    float ss = 0.f;
#pragma unroll
                    for (int j = 0; j < 4; ++j) ss += (x[b][j][0] * x[b][j][0] + x[b][j][1] * x[b][j][1]) + (x[b][j][2] * x[b][j][2] + x[b][j][3] * x[b][j][3]);
                    const float rstd = rsqrtf(wave_sum(ss) * (1.0f / D) + 1e-6f);
#pragma unroll
                    for (int j = 0; j < 4; ++j) { const f32x4 sh = *(const GAS f32x4*)(mb + 256 * j + 4 * c.lane); const f32x4 sc = *(const GAS f32x4*)(mb + D + 256 * j + 4 * c.lane);
                        const f32x4 nn = *(const GAS f32x4*)(ngp + 256 * j + 4 * c.lane);
                        float o[4];
#pragma unroll
                        for (int e = 0; e < 4; ++e) o[e] = x[b][j][e] * rstd * nn[e] * (1.0f + sc[e]) + sh[e];
                        v2u w; w.x = pkh(o[0], o[1]); w.y = pkh(o[2], o[3]);
                        *(GAS v2u*)(H + (size_t)row * D + 256 * j + 4 * c.lane) = w; }
                }
                if (MODE != 0) {
#pragma unroll
                for (int j = 0; j < 4; ++j) __builtin_nontemporal_store(x[b][j], (GAS f32x4*)(X + (size_t)row * D + 256 * j + 4 * c.lane)); }
            } }
    }
}
template <int MODE>
__device__ __forceinline__ void norm_phase(const Params& p0, const Ctx& c0, int l) {
    const Ctx c = fresh(c0); FRESH_P(p0);
    norm_rows<MODE, 3>(p, c, l, c.gw, M, c.ngw);
}

namespace pg8 {
constexpr int BM = 256, BK = 64, HALF = 128, HTB = HALF * BK * 2, STAGE_BYTES = 8 * HTB, NXCD = 8, WGM = 8;
__host__ __device__ __forceinline__ int lds_byte(int r, int c) { const int st = (r >> 4) * 2 + (c >> 5), rr = r & 15, cc = c & 31, ob = rr * 64 + cc * 2; return st * 1024 + (ob ^ (((ob >> 9) & 1) << 5)); }
__host__ __device__ __forceinline__ void stage_rc(int b, int& R, int& C) { const int st = b / 1024, sb = b % 1024, swz = sb ^ (((sb >> 9) & 1) << 5); R = (st >> 1) * 16 + swz / 64; C = (st & 1) * 32 + (swz % 64) / 2; }
__host__ __device__ __forceinline__ int perm32(int rho) { const int n = rho >> 4, i = rho & 15; return 8 * (i >> 2) + 4 * n + (i & 3); }
struct Unit { int pm, pn; };
struct Gemm { const GAS f16* A; const GAS f16* Bt; int lda, ldb, K; };
struct StaticOrder {
    int nM, nN, nwg, G, c;
    __device__ void init(int Mr, int N, int G_, int c_, int bm = BM) { nM = Mr / bm; nN = N / BM; nwg = nM * nN; G = G_; c = c_; }
    __device__ bool next(int i, Unit& u) const {
        const long L = (long)i * G + c; if (c < 0 || L >= nwg) return false;
        int wgid = (int)L; { const int q = nwg / NXCD, r = nwg % NXCD, xcd = wgid % NXCD, off = wgid / NXCD; wgid = (xcd < r ? xcd * (q + 1) : r * (q + 1) + (xcd - r) * q) + off; }
        const int nig = WGM * nN, gid = wgid / nig, fm = gid * WGM, gsz = (nM - fm) < WGM ? (nM - fm) : WGM;
        u.pm = fm + ((wgid % nig) % gsz); u.pn = (wgid % nig) / gsz; return true;
    }
};
template <class Epi, int HA = 128, bool ALIGN_EPI = true, bool SP2 = true>
__device__ __forceinline__ void gemm_phase(LAS unsigned char* lds, const Gemm g, const StaticOrder& S, const Epi& E, int wave_sgpr) {
    asm volatile("" : "+s"(wave_sgpr)); int tid = wave_sgpr * 64 + lane_id(); asm volatile("" : "+v"(tid));
    const int wid = __builtin_amdgcn_readfirstlane(tid >> 6), lane = tid & 63, wr = wid >> 2, wc = wid & 3, fr = lane & 15, fq = lane >> 4;
    const int K = g.K, nt = K / BK;
    unsigned voffA[2], voffB[2];
#pragma unroll
    for (int i = 0; i < 2; ++i) { int R, C; stage_rc(tid * 16 + i * 8192, R, C); const int Rb = (R & ~31) + perm32(R & 31);
        voffA[i] = (unsigned)(R * g.lda + C) * 2u; voffB[i] = (unsigned)(Rb * g.ldb + C) * 2u; }
    const unsigned kstep = (unsigned)(BK * 2);
    constexpr int MF = HA / 32;
    const unsigned hstepA = (unsigned)HA * g.lda * 2, hstepB = (unsigned)HALF * g.ldb * 2;
    const unsigned tstepA = 2 * hstepA, tstepB = 2 * hstepB;
    const unsigned ldsw = (unsigned)wid * 1024u;
    const int aoff = lds_byte(wr * (HA / 2) + fr, fq * 8), boff = lds_byte(wc * 32 + fr, fq * 8);
#define PG8_SA(b, h) (((b) * 2 + (h)) * HTB)
#define PG8_SB(b, h) ((4 + (b) * 2 + (h)) * HTB)
#define PG8_STAGE(bufoff, gbase, soff, voff) do { _Pragma("unroll") for (int _i = 0; _i < 2; ++_i) \
        __builtin_amdgcn_raw_ptr_buffer_load_lds(rs##gbase, (LAS unsigned*)(lds + (bufoff) + ldsw + _i * 8192), 16, (voff)[_i], (int)(soff), 0, 0); } while (0)
#define PG8_LDA(dst, b, h) do { _Pragma("unroll") for (int m = 0; m < MF; ++m) _Pragma("unroll") for (int k = 0; k < 2; ++k) dst[m][k] = *(const LAS f16x8*)(lds + PG8_SA(b, h) + aoff + m * 2048 + k * 1024); } while (0)
#define PG8_LDB(dst, b, h) do { _Pragma("unroll") for (int n = 0; n < 2; ++n) _Pragma("unroll") for (int k = 0; k < 2; ++k) dst[n][k] = *(const LAS f16x8*)(lds + PG8_SB(b, h) + boff + n * 2048 + k * 1024); } while (0)
#define PG8_MMA(ai, bj, At, Bt) do { __builtin_amdgcn_s_setprio(1); _Pragma("unroll") for (int m = 0; m < MF; ++m) _Pragma("unroll") for (int n = 0; n < 2; ++n) _Pragma("unroll") for (int k = 0; k < 2; ++k) \
        acc[ai][bj][m][n] = __builtin_amdgcn_mfma_f32_16x16x32_f16(Bt[n][k], At[m][k], acc[ai][bj][m][n], 0, 0, 0); __builtin_amdgcn_s_setprio(0); } while (0)
#define PG8_WAIT_V(n) asm volatile("s_waitcnt vmcnt(" #n ")" ::: "memory")
#define PG8_WAIT_L(n) asm volatile("s_waitcnt lgkmcnt(" #n ")" ::: "memory")
#define PG8_BAR __builtin_amdgcn_s_barrier()
#define PG8_SCHED __builtin_amdgcn_sched_barrier(0)
    Unit cur, nxt; int ui = 0;
    if (!S.next(0, cur)) return;
    f32x4 acc[2][2][4][2];
#pragma unroll
    for (int a = 0; a < 2; ++a)
#pragma unroll
        for (int b = 0; b < 2; ++b)
#pragma unroll
            for (int m = 0; m < 4; ++m)
#pragma unroll
                for (int n = 0; n < 2; ++n) acc[a][b][m][n] = (f32x4){0.f, 0.f, 0.f, 0.f};
    f16x8 At[4][2], B0[2][2], B1[2][2];
    const auto rsA = __builtin_amdgcn_make_buffer_rsrc((GAS void*)g.A, 0, 0x7fffffff, 0x00020000); const auto rsB = __builtin_amdgcn_make_buffer_rsrc((GAS void*)g.Bt, 0, 0x7fffffff, 0x00020000);
    unsigned cA = (unsigned)cur.pm * tstepA, cB = (unsigned)cur.pn * tstepB;
    if constexpr (SP2) {
        PG8_STAGE(PG8_SB(0, 0), B, cB, voffB); PG8_STAGE(PG8_SB(0, 1), B, cB + hstepB, voffB); PG8_STAGE(PG8_SA(0, 0), A, cA, voffA); PG8_STAGE(PG8_SA(0, 1), A, cA + hstepA, voffA);
        if (wr == 1) PG8_BAR;
        PG8_WAIT_V(2); PG8_BAR;
        PG8_STAGE(PG8_SB(1, 0), B, cB + kstep, voffB); PG8_STAGE(PG8_SA(1, 0), A, cA + kstep, voffA); PG8_STAGE(PG8_SB(1, 1), B, cB + hstepB + kstep, voffB);
        PG8_WAIT_V(6); PG8_BAR;
    } else {
        PG8_STAGE(PG8_SB(0, 0), B, cB, voffB); PG8_STAGE(PG8_SA(0, 0), A, cA, voffA); PG8_STAGE(PG8_SB(0, 1), B, cB + hstepB, voffB); PG8_STAGE(PG8_SA(0, 1), A, cA + hstepA, voffA);
        if (wr == 1) PG8_BAR;
        PG8_WAIT_V(4); PG8_BAR;
        PG8_STAGE(PG8_SB(1, 0), B, cB + kstep, voffB); PG8_STAGE(PG8_SA(1, 0), A, cA + kstep, voffA); PG8_STAGE(PG8_SB(1, 1), B, cB + hstepB + kstep, voffB);
        PG8_WAIT_V(6); PG8_BAR;
    }
    for (;;) {
        const bool has_next = S.next(ui + 1, nxt);
        const unsigned nA = has_next ? (unsigned)nxt.pm * tstepA : cA, nB = has_next ? (unsigned)nxt.pn * tstepB : cB;
        for (int t = 0; t < nt; t += 2) {
            if constexpr (Epi::MID_T >= 0) { if (t == Epi::MID_T) { const int ln3 = lane_id(); E.template mid<HA>(acc, cur, wr, wc, ln3 & 15, ln3 >> 4); } }
            const bool last = (t == nt - 2);
            const unsigned a1 = cA + (unsigned)(t + 1) * kstep;
            const unsigned a2 = last ? nA : cA + (unsigned)(t + 2) * kstep, b2 = last ? nB : cB + (unsigned)(t + 2) * kstep;
            const unsigned a3 = a2 + kstep, b3 = b2 + kstep;
            if constexpr (SP2) {
            PG8_LDB(B0, 0, 0); PG8_LDB(B1, 0, 1); PG8_SCHED; PG8_LDA(At, 0, 0); PG8_STAGE(PG8_SA(1, 1), A, a1 + hstepA, voffA);
            PG8_WAIT_V(8); PG8_WAIT_L(0); PG8_BAR; PG8_MMA(0, 0, At, B0); PG8_MMA(0, 1, At, B1); PG8_BAR; PG8_SCHED;
            PG8_LDA(At, 0, 1); PG8_STAGE(PG8_SB(0, 0), B, b2, voffB); PG8_STAGE(PG8_SB(0, 1), B, b2 + hstepB, voffB); PG8_STAGE(PG8_SA(0, 0), A, a2, voffA);
            PG8_WAIT_V(8); PG8_WAIT_L(0); PG8_BAR; PG8_MMA(1, 0, At, B0); PG8_MMA(1, 1, At, B1); PG8_BAR; PG8_SCHED;
            PG8_LDB(B0, 1, 0); PG8_LDB(B1, 1, 1); PG8_SCHED; PG8_LDA(At, 1, 0); PG8_STAGE(PG8_SA(0, 1), A, a2 + hstepA, voffA);
            PG8_WAIT_V(8); PG8_WAIT_L(0); PG8_BAR; PG8_MMA(0, 0, At, B0); PG8_MMA(0, 1, At, B1); PG8_BAR; PG8_SCHED;
            PG8_LDA(At, 1, 1); PG8_STAGE(PG8_SB(1, 0), B, b3, voffB); PG8_STAGE(PG8_SB(1, 1), B, b3 + hstepB, voffB); PG8_STAGE(PG8_SA(1, 0), A, a3, voffA);
            PG8_WAIT_V(8); PG8_WAIT_L(0); PG8_BAR; PG8_MMA(1, 0, At, B0); PG8_MMA(1, 1, At, B1); PG8_BAR; PG8_SCHED;
            } else {
            PG8_LDB(B0, 0, 0); PG8_SCHED; PG8_LDA(At, 0, 0); PG8_STAGE(PG8_SA(1, 1), A, a1 + hstepA, voffA);
            PG8_WAIT_L(8); PG8_BAR; PG8_WAIT_L(0); PG8_MMA(0, 0, At, B0); PG8_BAR; PG8_SCHED;
            PG8_LDB(B1, 0, 1); PG8_STAGE(PG8_SB(0, 0), B, b2, voffB);
            PG8_BAR; PG8_WAIT_L(0); PG8_MMA(0, 1, At, B1); PG8_BAR;
            PG8_LDA(At, 0, 1); PG8_STAGE(PG8_SA(0, 0), A, a2, voffA);
            PG8_BAR; PG8_WAIT_L(0); PG8_MMA(1, 0, At, B0); PG8_BAR; PG8_SCHED;
            PG8_STAGE(PG8_SB(0, 1), B, b2 + hstepB, voffB);
            PG8_WAIT_V(6); PG8_BAR; PG8_MMA(1, 1, At, B1); PG8_BAR;
            PG8_LDB(B0, 1, 0); PG8_SCHED; PG8_LDA(At, 1, 0); PG8_STAGE(PG8_SA(0, 1), A, a2 + hstepA, voffA);
            PG8_WAIT_L(8); PG8_BAR; PG8_WAIT_L(0); PG8_MMA(0, 0, At, B0); PG8_BAR; PG8_SCHED;
            PG8_LDB(B1, 1, 1); PG8_STAGE(PG8_SB(1, 0), B, b3, voffB);
            PG8_BAR; PG8_WAIT_L(0); PG8_MMA(0, 1, At, B1); PG8_BAR;
            PG8_LDA(At, 1, 1); PG8_STAGE(PG8_SA(1, 0), A, a3, voffA);
            PG8_BAR; PG8_WAIT_L(0); PG8_MMA(1, 0, At, B0); PG8_BAR; PG8_SCHED;
            PG8_STAGE(PG8_SB(1, 1), B, b3 + hstepB, voffB);
            PG8_WAIT_V(6); PG8_BAR; PG8_MMA(1, 1, At, B1); PG8_BAR;
            }
        }
        if constexpr (ALIGN_EPI) { if (wr == 0) PG8_BAR; }
        { const int ln2 = lane_id(); E.template run<HA>(acc, cur, wr, wc, ln2 & 15, ln2 >> 4); }
        if (!has_next) break;
#pragma unroll
        for (int a = 0; a < 2; ++a)
#pragma unroll
            for (int b = 0; b < 2; ++b)
#pragma unroll
                for (int m = 0; m < 4; ++m)
#pragma unroll
                    for (int n = 0; n < 2; ++n) acc[a][b][m][n] = (f32x4){0.f, 0.f, 0.f, 0.f};
        cur = nxt; cA = nA; cB = nB; ++ui;
        if constexpr (ALIGN_EPI) { if (wr == 1) PG8_BAR; }
    }
    PG8_WAIT_V(0);
    if constexpr (!ALIGN_EPI) { if (wr == 0) PG8_BAR; }
    PG8_BAR;
#undef PG8_SA
#undef PG8_SB
#undef PG8_STAGE
#undef PG8_LDA
#undef PG8_LDB
#undef PG8_MMA
#undef PG8_WAIT_V
#undef PG8_WAIT_L
#undef PG8_BAR
#undef PG8_SCHED
}
typedef f32x4 Acc[2][2][4][2];
#define PG8_EPI_LOOP(...) \
    const int row0 = u.pm * (2 * HA) + wr * (HA / 2) + fr, col0 = u.pn * BM + wc * 32 + 8 * fq; \
    _Pragma("unroll") for (int ai = 0; ai < 2; ++ai) _Pragma("unroll") for (int m = 0; m < HA / 32; ++m) { const int row = row0 + ai * HA + m * 16; \
        _Pragma("unroll") for (int bj = 0; bj < 2; ++bj) { const int col = col0 + bj * HALF; f32x4 v0 = acc[ai][bj][m][0], v1 = acc[ai][bj][m][1]; __VA_ARGS__ } asm volatile("" ::: "memory"); }
__device__ __forceinline__ void store8(GAS f16* p, f32x4 v0, f32x4 v1) { v4u w; w.x = pkh(v0[0], v0[1]); w.y = pkh(v0[2], v0[3]); w.z = pkh(v1[0], v1[1]); w.w = pkh(v1[2], v1[3]); *(GAS v4u*)p = w; }
struct EpiProjF { static constexpr int MID_T = -1; GAS f16* P;
    template <int HA> __device__ __forceinline__ void run(const Acc& acc, const Unit& u, int wr, int wc, int fr, int fq) const {
        PG8_EPI_LOOP(
            if (u.pn == 6) {
                if (col < PC_LA) { _Pragma("unroll") for (int e = 0; e < 4; ++e) { v0[e] = tanhf_(v0[e]); v1[e] = tanhf_(v1[e]); } }
                else if (col >= PC_LG) { _Pragma("unroll") for (int e = 0; e < 4; ++e) { v0[e] = sigmoidf_(v0[e]); v1[e] = sigmoidf_(v1[e]); } }
            } else if (u.pn >= 10) { _Pragma("unroll") for (int e = 0; e < 4; ++e) { v0[e] = sigmoidf_(v0[e]); v1[e] = sigmoidf_(v1[e]); } }
            store8(P + (size_t)row * DIN + col, v0, v1);
        )
    } };
#define DPPM(x, ctrl) (x) *= __builtin_bit_cast(float, __builtin_amdgcn_update_dpp(0x3f800000, __builtin_bit_cast(int, (x)), (ctrl), 0xF, 0xF, false))
struct EpiWAF { static constexpr int MID_T = -1; GAS f16* WA; const GAS float* w0; const GAS float* a0;
    template <int HA> __device__ __forceinline__ void run(const Acc& acc, const Unit& u, int wr, int wc, int fr, int fq) const {
        PG8_EPI_LOOP(
            if (col < 1024) { const f32x4 b0 = *(const GAS f32x4*)(w0 + col), b1 = *(const GAS f32x4*)(w0 + col + 4);
                float x[8];
                _Pragma("unroll") for (int e = 0; e < 4; ++e) { x[e] = __expf(-0.606531f * sigmoidf_(v0[e] + b0[e])); x[4 + e] = __expf(-0.606531f * sigmoidf_(v1[e] + b1[e])); }
                if (col < 512) {
                    _Pragma("unroll") for (int e = 0; e < 8; ++e) { DPPM(x[e], 0x111); DPPM(x[e], 0x112); DPPM(x[e], 0x114); DPPM(x[e], 0x118);
                        const float wm = __builtin_bit_cast(float, __builtin_amdgcn_ds_swizzle(__builtin_bit_cast(int, x[e]), 0x00F0)); x[e] = (fr == 7) ? wm : x[e] * __builtin_amdgcn_rcpf(wm); }
                } else {
                    _Pragma("unroll") for (int e = 0; e < 8; ++e) { DPPM(x[e], 0x101); DPPM(x[e], 0x102); DPPM(x[e], 0x104); DPPM(x[e], 0x108);
                        const float wm = __builtin_bit_cast(float, __builtin_amdgcn_ds_swizzle(__builtin_bit_cast(int, x[e]), 0x0110)); x[e] = (fr == 8) ? wm : x[e] * __builtin_amdgcn_rcpf(wm); }
                }
                _Pragma("unroll") for (int e = 0; e < 4; ++e) { v0[e] = x[e]; v1[e] = x[4 + e]; } }
            else { const f32x4 b0 = *(const GAS f32x4*)(a0 + col - 1024), b1 = *(const GAS f32x4*)(a0 + col - 1024 + 4);
                _Pragma("unroll") for (int e = 0; e < 4; ++e) { v0[e] = sigmoidf_(v0[e] + b0[e]); v1[e] = sigmoidf_(v1[e] + b1[e]); } }
            store8(WA + (size_t)row * 2048 + col, v0, v1);
        )
    } };
struct EpiF16F { static constexpr int MID_T = -1; GAS f16* O; int ld;
    template <int HA> __device__ __forceinline__ void run(const Acc& acc, const Unit& u, int wr, int wc, int fr, int fq) const {
        PG8_EPI_LOOP( store8(O + (size_t)row * ld + col, v0, v1); )
    } };
struct EpiRelu2F { static constexpr int MID_T = -1; GAS f16* O; int ld;
    template <int HA> __device__ __forceinline__ void run(const Acc& acc, const Unit& u, int wr, int wc, int fr, int fq) const {
        PG8_EPI_LOOP(
            _Pragma("unroll") for (int e = 0; e < 4; ++e) { const float a = fmaxf(v0[e], 0.f), b = fmaxf(v1[e], 0.f); v0[e] = a * a; v1[e] = b * b; }
            store8(O + (size_t)row * ld + col, v0, v1);
        )
    } };
struct EpiMergeF { static constexpr int MID_T = 8; GAS f16* MG; const GAS f16* PROJ;
    template <int HA> __device__ __forceinline__ void mid(Acc& acc, const Unit& u, int wr, int wc, int fr, int fq) const {
        const int row0 = u.pm * (2 * HA) + wr * (HA / 2) + fr, col0 = u.pn * BM + wc * 32 + 8 * fq;
#pragma unroll
        for (int ai = 0; ai < 2; ++ai)
#pragma unroll
            for (int m = 0; m < HA / 32; ++m) { const int row = row0 + ai * HA + m * 16;
#pragma unroll
                for (int bj = 0; bj < 2; ++bj) { const int col = col0 + bj * HALF;
                    const f16x8 gr = *(const GAS f16x8*)(PROJ + (size_t)row * DIN + PC_GR + col), ga = *(const GAS f16x8*)(PROJ + (size_t)row * DIN + PC_GA + col);
#pragma unroll
                    for (int e = 0; e < 4; ++e) { acc[ai][bj][m][0][e] *= (float)gr[e] * __builtin_amdgcn_rcpf(fmaxf((float)ga[e], 1e-4f)); acc[ai][bj][m][1][e] *= (float)gr[4 + e] * __builtin_amdgcn_rcpf(fmaxf((float)ga[4 + e], 1e-4f)); } }
                asm volatile("" ::: "memory"); }
    }
    template <int HA> __device__ __forceinline__ void run(const Acc& acc, const Unit& u, int wr, int wc, int fr, int fq) const {
        PG8_EPI_LOOP(
            const f16x8 ga = *(const GAS f16x8*)(PROJ + (size_t)row * DIN + PC_GA + col);
            _Pragma("unroll") for (int e = 0; e < 4; ++e) { v0[e] *= fmaxf((float)ga[e], 1e-4f); v1[e] *= fmaxf((float)ga[4 + e], 1e-4f); }
            store8(MG + (size_t)row * D + col, v0, v1);
        )
    } };
}

__device__ __forceinline__ void kv_prep(const Params& p0, const Ctx& c0, int l) {
    const Ctx c = fresh(c0); FRESH_P(p0);
    const GAS f16* PROJ = (const GAS f16*)(p.ws + WS_R1); GAS f16* KN = (GAS f16*)(p.ws + WS_KN); GAS f16* VT = (GAS f16*)(p.ws + WS_VT);
    const int d = c.lane;
    const float kg = IN(27)[l * HD + d];
    const int axis = d >> 5, half = (d >> 4) & 1, f = d & 15;
    const float freq = exp2f(-(float)f * (13.287712379549449f / 16.0f));
    for (int it = c.gw; it < (M / 8) * 2; it += c.ngw) {
        const int kvh = it & 1, row0 = (it >> 1) * 8;
        float kx[8], vx[8];
#pragma unroll
        for (int r = 0; r < 8; ++r) { const GAS f16* pr = PROJ + (size_t)(row0 + r) * DIN + kvh * HD + d; kx[r] = (float)pr[PC_KA]; vx[r] = (float)pr[PC_VA]; }
#pragma unroll
        for (int r = 0; r < 8; ++r) kx[r] = kx[r] * rsqrtf(wave_sum(kx[r] * kx[r]) * (1.0f / HD) + 1e-6f) * kg;
        f16x8 vv;
#pragma unroll
        for (int r = 0; r < 8; ++r) vv[r] = (f16)vx[r];
        if (row0 < M_CTX) { const int b = row0 >> 8, t0 = row0 & 255;
#pragma unroll
            for (int r = 0; r < 8; ++r) { const size_t o = ((((size_t)b * NL + l) * T_CTX + t0 + r) * 2 + kvh) * HD + d;
                p.out[O_CK + o] = kx[r]; p.out[O_CV + o] = vx[r];
                KN[(((size_t)b * 2 + kvh) * T_CTX + t0 + r) * HD + d] = (f16)kx[r]; }
            *(GAS f16x8*)(VT + (((size_t)b * 2 + kvh) * HD + d) * T_CTX + t0) = vv;
        } else { const int rr = row0 - M_CTX, b = rr >> 10, t0 = rr & 1023;
#pragma unroll
            for (int r = 0; r < 8; ++r) { const int t = t0 + r; const float pos = (float)(axis == 0 ? (t >> 6) : (t & 63));
                const float ang = pos * freq; const float cs = __cosf(ang), sn = __sinf(ang);
                const float other = xor16(kx[r]);
                const float ko = half == 0 ? kx[r] * cs - other * sn : kx[r] * cs + other * sn;
                KN[KN_SMP_OFF + (((size_t)b * 2 + kvh) * KV_SMP + PAST + t) * HD + d] = (f16)ko; }
            *(GAS f16x8*)(VT + KN_SMP_OFF + (((size_t)b * 2 + kvh) * HD + d) * KV_SMP + PAST + t0) = vv;
        }
    }
    for (int it = c.gw; it < B_SMP * (PAST / 8) * 2; it += c.ngw) {
        const int kvh = it & 1, j0 = ((it >> 1) & 31) * 8, b = it >> 6;
        f16x8 vv;
#pragma unroll
        for (int r = 0; r < 8; ++r) { const size_t s = ((((size_t)b * NL + l) * PAST + j0 + r) * 2 + kvh) * HD + d;
            KN[KN_SMP_OFF + (((size_t)b * 2 + kvh) * KV_SMP + j0 + r) * HD + d] = (f16)IN(2)[s]; vv[r] = (f16)IN(3)[s]; }
        *(GAS f16x8*)(VT + KN_SMP_OFF + (((size_t)b * 2 + kvh) * HD + d) * KV_SMP + j0) = vv;
    }
}

constexpr int TC = 32, ST_STEP = 6 * 64, ST_BUF = TC * ST_STEP;
struct StageRegs { f16x4 r[3], k[3], v[3], w, a; };
__device__ __forceinline__ void scan_task(const DParams& p, const Ctx& c, int l, int task) {
    const GAS f16* PROJ = (const GAS f16*)(p.ws + WS_R1); const GAS f16* WA = (const GAS f16*)(p.ws + WS_R2);
    GAS f16* Y = (GAS f16*)(p.ws + WS_R3); GAS float* RK = (GAS float*)(p.ws + WS_RK);
    LAS float* st = (LAS float*)c.lds;
    int sq, dir, h;
    if (task < 64) { h = task & 7; dir = (task >> 3) & 1; sq = B_CTX + (task >> 4); } else { const int id = task - 64; h = id & 7; dir = (id >> 3) & 1; sq = id >> 4; }
    const bool smp = sq >= B_CTX; const int T = smp ? T_SMP : T_CTX; const int row0 = smp ? M_CTX + (sq - B_CTX) * T_SMP : sq * T_CTX;
    const int nch = T / TC;
    const int tt = c.tid >> 4, cq = c.tid & 15, ch0 = h * HD + cq * 4;
    const f32x4 mu_r = *(const GAS f32x4*)(IN(15) + (l * 3 + 0) * CW + ch0), mu_k = *(const GAS f32x4*)(IN(15) + (l * 3 + 1) * CW + ch0), mu_v = *(const GAS f32x4*)(IN(15) + (l * 3 + 2) * CW + ch0);
    const f32x4 k_k = *(const GAS f32x4*)(IN(16) + l * CW + ch0), k_a = *(const GAS f32x4*)(IN(17) + l * CW + ch0), r_k = *(const GAS f32x4*)(IN(18) + l * CW + ch0);
    const int ks = c.lane & 7, srow = c.wave * 8 + (c.lane >> 3);
    float S[8];
    if (smp) { const GAS float* s0 = IN(4) + (((((size_t)(sq - B_CTX) * NL + l) * 2 + dir) * NH + h) * HD + srow) * HD + ks * 8;
        const f32x4 a = *(const GAS f32x4*)s0, b = *(const GAS f32x4*)(s0 + 4);
        S[0] = a[0]; S[1] = a[1]; S[2] = a[2]; S[3] = a[3]; S[4] = b[0]; S[5] = b[1]; S[6] = b[2]; S[7] = b[3];
    } else {
#pragma unroll
        for (int j = 0; j < 8; ++j) S[j] = 0.f;
    }
    StageRegs sr;
    const f16x4 z4 = {(f16)0.f, (f16)0.f, (f16)0.f, (f16)0.f};
#define SCAN_LOAD(chunk) do { const int S_ = (chunk) * TC + tt; const int t_ = dir ? T - 1 - S_ : S_; const GAS f16* pr_ = PROJ + (size_t)(row0 + t_) * DIN + ch0; \
        sr.r[1] = *(const GAS f16x4*)(pr_ + PC_R); sr.k[1] = *(const GAS f16x4*)(pr_ + PC_K); sr.v[1] = *(const GAS f16x4*)(pr_ + PC_V); \
        if (t_ > 0) { sr.r[0] = *(const GAS f16x4*)(pr_ - DIN + PC_R); sr.k[0] = *(const GAS f16x4*)(pr_ - DIN + PC_K); sr.v[0] = *(const GAS f16x4*)(pr_ - DIN + PC_V); } else { sr.r[0] = z4; sr.k[0] = z4; sr.v[0] = z4; } \
        if (t_ < T - 1) { sr.r[2] = *(const GAS f16x4*)(pr_ + DIN + PC_R); sr.k[2] = *(const GAS f16x4*)(pr_ + DIN + PC_K); sr.v[2] = *(const GAS f16x4*)(pr_ + DIN + PC_V); } else { sr.r[2] = z4; sr.k[2] = z4; sr.v[2] = z4; } \
        const GAS f16* wa_ = WA + (size_t)(row0 + t_) * 2048 + dir * 512 + ch0; sr.w = *(const GAS f16x4*)wa_; sr.a = *(const GAS f16x4*)(wa_ + 1024); } while (0)
#define SCAN_STAGE(chunk) do { const int S_ = (chunk) * TC + tt; const int t_ = dir ? T - 1 - S_ : S_; \
        f32x4 r_, k_, v_, kk_, w_, a_, kh_, kt_, b_; float ss_ = 0.f, rk_ = 0.f; \
        _Pragma("unroll") for (int e = 0; e < 4; ++e) { const float rc = (float)sr.r[1][e], kc = (float)sr.k[1][e], vc = (float)sr.v[1][e]; \
            r_[e] = rc + mu_r[e] * (0.5f * ((float)sr.r[0][e] + (float)sr.r[2][e]) - rc); k_[e] = kc + mu_k[e] * (0.5f * ((float)sr.k[0][e] + (float)sr.k[2][e]) - kc); \
            v_[e] = vc + mu_v[e] * (0.5f * ((float)sr.v[0][e] + (float)sr.v[2][e]) - vc); kk_[e] = k_[e] * k_k[e]; ss_ += kk_[e] * kk_[e]; w_[e] = (float)sr.w[e]; a_[e] = (float)sr.a[e]; } \
        ss_ = dpp_sum16(ss_); const float ri_ = rsqrtf(ss_ + 1e-12f); \
        _Pragma("unroll") for (int e = 0; e < 4; ++e) { kh_[e] = kk_[e] * ri_; kt_[e] = k_[e] * (1.0f + (a_[e] - 1.0f) * k_a[e]); b_[e] = a_[e] * kh_[e]; rk_ += r_[e] * kt_[e] * r_k[e]; } \
        rk_ = dpp_sum16(rk_); if (cq == 0) RK[((size_t)dir * M + row0 + t_) * 8 + h] = rk_; \
        LAS float* sb_ = st + ((chunk) & 1) * ST_BUF + tt * ST_STEP + cq * 4; \
        *(LAS f32x4*)(sb_) = kh_; *(LAS f32x4*)(sb_ + 64) = w_; *(LAS f32x4*)(sb_ + 128) = b_; *(LAS f32x4*)(sb_ + 192) = kt_; *(LAS f32x4*)(sb_ + 256) = r_; *(LAS f32x4*)(sb_ + 320) = v_; } while (0)
    SCAN_LOAD(0);
    SCAN_STAGE(0);
    __syncthreads();
    for (int chunk = 0; chunk < nch; ++chunk) {
        if (chunk + 1 < nch) SCAN_LOAD(chunk + 1);
        const LAS float* sb = st + (chunk & 1) * ST_BUF + ks * 8;
        const LAS float* vb = st + (chunk & 1) * ST_BUF + 320 + srow;
#pragma unroll 2
        for (int s = 0; s < TC; ++s) {
            const LAS float* q = sb + s * ST_STEP;
            const f32x4 kh0 = *(const LAS f32x4*)(q), kh1 = *(const LAS f32x4*)(q + 4);
            const f32x4 w0 = *(const LAS f32x4*)(q + 64), w1 = *(const LAS f32x4*)(q + 68);
            const f32x4 b0 = *(const LAS f32x4*)(q + 128), b1 = *(const LAS f32x4*)(q + 132);
            const f32x4 t0 = *(const LAS f32x4*)(q + 192), t1 = *(const LAS f32x4*)(q + 196);
            const f32x4 r0 = *(const LAS f32x4*)(q + 256), r1 = *(const LAS f32x4*)(q + 260);
            const float v = vb[s * ST_STEP];
            float sk = (S[0] * kh0[0] + S[1] * kh0[1]) + (S[2] * kh0[2] + S[3] * kh0[3]) + ((S[4] * kh1[0] + S[5] * kh1[1]) + (S[6] * kh1[2] + S[7] * kh1[3]));
            sk = dpp_sum8(sk);
#pragma unroll
            for (int e = 0; e < 4; ++e) { S[e] = S[e] * w0[e] + (v * t0[e] - sk * b0[e]); S[4 + e] = S[4 + e] * w1[e] + (v * t1[e] - sk * b1[e]); }
            float y = (S[0] * r0[0] + S[1] * r0[1]) + (S[2] * r0[2] + S[3] * r0[3]) + ((S[4] * r1[0] + S[5] * r1[1]) + (S[6] * r1[2] + S[7] * r1[3]));
            y = dpp_sum8(y);
            const int Sg = chunk * TC + s; const int t = dir ? T - 1 - Sg : Sg;
            if (ks == 0) Y[((size_t)dir * M + row0 + t) * CW + h * HD + srow] = (f16)y;
        }
        if (chunk + 1 < nch) SCAN_STAGE(chunk + 1);
        __syncthreads();
    }
#undef SCAN_LOAD
#undef SCAN_STAGE
    if (!smp) { GAS float* so = p.out + O_ST + (((((size_t)sq * NL + l) * 2 + dir) * NH + h) * HD + srow) * HD + ks * 8;
        *(GAS f32x4*)so = (f32x4){S[0], S[1], S[2], S[3]}; *(GAS f32x4*)(so + 4) = (f32x4){S[4], S[5], S[6], S[7]}; }
}
__device__ __forceinline__ void fast_scan(const Params& p0, const Ctx& c0, int l) {
    const Ctx c = fresh(c0); FRESH_P(p0);
    const int b = c.bid;
    if (b < 64) scan_task(p, c, l, b);
    else for (int task = b; task < 576; task += 192) scan_task(p, c, l, task);
}


namespace ms {
constexpr int O_AM = 0, O_BM = 4608, O_AT = 9216, O_VP = 14336, O_GT = 19456, O_NF = 22016, O_WM = 23040, O_WE = 23296, BUF = 23552;
constexpr int RS = 144, RT = 80;
}
__device__ __forceinline__ void mscan_task(const DParams& p, const Ctx& c, int l, int task) {
    using namespace ms;
    const GAS f16* PROJ = (const GAS f16*)(p.ws + WS_R1); const GAS f16* WA = (const GAS f16*)(p.ws + WS_R2);
    GAS f16* Y = (GAS f16*)(p.ws + WS_R3); GAS float* RK = (GAS float*)(p.ws + WS_RK);
    int sq, dir, h;
    if (task < 64) { h = task & 7; dir = (task >> 3) & 1; sq = B_CTX + (task >> 4); } else { const int id = task - 64; h = id & 7; dir = (id >> 3) & 1; sq = id >> 4; }
    const bool smp = sq >= B_CTX; const int T = smp ? T_SMP : T_CTX; const int row0 = smp ? M_CTX + (sq - B_CTX) * T_SMP : sq * T_CTX;
    const int nch = T / 16;
    const int vl = c.lane & 31, hh = c.lane >> 5;
    const int tq = c.tid - 128, ss = (tq >> 4) & 15, cq = tq & 15, k0 = cq * 4, ch0 = h * HD + k0;
    LAS float* cst = (LAS float*)(c.lds + 3 * BUF);
    if (c.wave == 7) { const int chn_ = h * HD + c.lane;
        cst[c.lane] = IN(15)[(l * 3 + 0) * CW + chn_]; cst[64 + c.lane] = IN(15)[(l * 3 + 1) * CW + chn_]; cst[128 + c.lane] = IN(15)[(l * 3 + 2) * CW + chn_];
        cst[192 + c.lane] = IN(16)[l * CW + chn_]; cst[256 + c.lane] = IN(17)[l * CW + chn_]; cst[320 + c.lane] = IN(18)[l * CW + chn_]; }

#define MS_BARRIER() do { asm volatile("s_waitcnt lgkmcnt(0)" ::: "memory"); __builtin_amdgcn_s_barrier(); asm volatile("" ::: "memory"); } while (0)
    if (c.wave >= 2 && c.wave < 6) {
    f16x4 G_rc, G_kc, G_vc, G_rp, G_kp, G_vp, G_rn, G_kn, G_vn, G_av, G_wo, G_wp, G_w7;
    { const f16x4 z4 = {(f16)0.f, (f16)0.f, (f16)0.f, (f16)0.f}; G_rc = G_kc = G_vc = G_rp = G_kp = G_vp = G_rn = G_kn = G_vn = G_av = G_wo = G_wp = G_w7 = z4; }
        for (int it = -3; it < nch; ++it) {
            const int ch = it + 2;
            if (ch >= 0 && ch < nch) {
                LAS unsigned char* buf = c.lds + (ch % 3) * BUF;
                const int Sg = ch * 16 + ss; const int t = dir ? T - 1 - Sg : Sg; const size_t row = (size_t)row0 + t;
                const f32x4 mu_r = *(const LAS f32x4*)(cst + k0), mu_k = *(const LAS f32x4*)(cst + 64 + k0), mu_v = *(const LAS f32x4*)(cst + 128 + k0), k_k = *(const LAS f32x4*)(cst + 192 + k0), k_a = *(const LAS f32x4*)(cst + 256 + k0), r_k = *(const LAS f32x4*)(cst + 320 + k0);
                f32x4 r_, k_, v_, kk_, kh_, kt_, b_; float sq_ = 0.f, rk_ = 0.f;
                const float mp_ = t > 0 ? 0.5f : 0.f, mn_ = t < T - 1 ? 0.5f : 0.f;
#pragma unroll
                for (int e = 0; e < 4; ++e) { const float rcf = (float)G_rc[e], kcf = (float)G_kc[e], vcf = (float)G_vc[e];
                    r_[e] = rcf + mu_r[e] * ((mp_ * (float)G_rp[e] + mn_ * (float)G_rn[e]) - rcf); k_[e] = kcf + mu_k[e] * ((mp_ * (float)G_kp[e] + mn_ * (float)G_kn[e]) - kcf);
                    v_[e] = vcf + mu_v[e] * ((mp_ * (float)G_vp[e] + mn_ * (float)G_vn[e]) - vcf); kk_[e] = k_[e] * k_k[e]; sq_ += kk_[e] * kk_[e]; }
                sq_ = dpp_sum16(sq_); const float ri_ = rsqrtf(sq_ + 1e-12f);
#pragma unroll
                for (int e = 0; e < 4; ++e) { const float a_ = (float)G_av[e]; kh_[e] = kk_[e] * ri_; kt_[e] = k_[e] * (1.0f + (a_ - 1.0f) * k_a[e]); b_[e] = a_ * kh_[e]; rk_ += r_[e] * kt_[e] * r_k[e]; }
                rk_ = dpp_sum16(rk_); if (cq == 0) RK[((size_t)dir * M + row) * 8 + h] = rk_;
                float al[4], be[4], ka[4], rho[4];
#pragma unroll
                for (int e = 0; e < 4; ++e) { const float wm7 = (float)G_w7[e]; const float om = ss == 7 ? 1.0f : (float)G_wo[e]; const float omp = ss == 0 ? __builtin_amdgcn_rcpf(wm7) : (ss == 8 ? 1.0f : (float)G_wp[e]);
                    const float iom = __builtin_amdgcn_rcpf(om); al[e] = omp * kh_[e]; be[e] = b_[e] * iom; ka[e] = kt_[e] * iom; rho[e] = om * r_[e]; }
                v2u w2;
                w2.x = pkh(al[0], al[1]); w2.y = pkh(al[2], al[3]); *(LAS v2u*)(buf + O_BM + ss * RS + k0 * 2) = w2;
                w2.x = pkh(rho[0], rho[1]); w2.y = pkh(rho[2], rho[3]); *(LAS v2u*)(buf + O_BM + (16 + ss) * RS + k0 * 2) = w2;
                w2.x = pkh(be[0], be[1]); w2.y = pkh(be[2], be[3]); *(LAS v2u*)(buf + O_AM + ss * RS + k0 * 2) = w2;
                w2.x = pkh(ka[0], ka[1]); w2.y = pkh(ka[2], ka[3]); *(LAS v2u*)(buf + O_AM + (16 + ss) * RS + k0 * 2) = w2;
#pragma unroll
                for (int e = 0; e < 4; ++e) { *(LAS f16*)(buf + O_AT + (k0 + e) * RT + ss * 2) = (f16)ka[e]; *(LAS f16*)(buf + O_AT + (k0 + e) * RT + (16 + ss) * 2) = (f16)be[e];
                    *(LAS f16*)(buf + O_VP + (k0 + e) * RT + ss * 2) = (f16)v_[e]; }
                if (ss == 15) { f32x4 wm_, we_;
#pragma unroll
                    for (int e = 0; e < 4; ++e) { wm_[e] = (float)G_w7[e]; we_[e] = (float)G_wo[e]; }
                    *(LAS f32x4*)(buf + O_WM + k0 * 4) = wm_; *(LAS f32x4*)(buf + O_WE + k0 * 4) = we_; }
            }
            const int chn = it + 3;
            if (chn < nch) {
                const int Sg = chn * 16 + ss; const int t = dir ? T - 1 - Sg : Sg; const size_t row = (size_t)row0 + t;
                const GAS f16* pr = PROJ + row * DIN + ch0;
                const f16x4 z4 = {(f16)0.f, (f16)0.f, (f16)0.f, (f16)0.f};
                G_rc = *(const GAS f16x4*)(pr + PC_R); G_kc = *(const GAS f16x4*)(pr + PC_K); G_vc = *(const GAS f16x4*)(pr + PC_V);
                { const GAS f16* prp = t > 0 ? pr - DIN : pr; const GAS f16* prn = t < T - 1 ? pr + DIN : pr;
                  G_rp = *(const GAS f16x4*)(prp + PC_R); G_kp = *(const GAS f16x4*)(prp + PC_K); G_vp = *(const GAS f16x4*)(prp + PC_V);
                  G_rn = *(const GAS f16x4*)(prn + PC_R); G_kn = *(const GAS f16x4*)(prn + PC_K); G_vn = *(const GAS f16x4*)(prn + PC_V); }
                G_av = *(const GAS f16x4*)(WA + row * 2048 + 1024 + dir * 512 + ch0);
                const GAS f16* wo = WA + row * 2048 + dir * 512 + ch0;
                G_wo = *(const GAS f16x4*)wo; G_wp = *(const GAS f16x4*)(wo + (ss > 0 ? (dir ? 2048 : -2048) : 0)); G_w7 = *(const GAS f16x4*)(wo + (long)(7 - ss) * (dir ? -2048 : 2048));
            }
            MS_BARRIER();
        }
    } else if (c.wave == 6) {
        for (int it = -3; it < nch; ++it) {
            const int ch = it + 1;
            if (ch >= 0 && ch < nch) {
                LAS unsigned char* buf = c.lds + (ch % 3) * BUF;
                f32x16 g;
#pragma unroll
                for (int i = 0; i < 16; ++i) g[i] = 0.f;
#pragma unroll
                for (int s = 0; s < 4; ++s) { const f16x8 a = *(const LAS f16x8*)(buf + O_AM + vl * RS + (16 * s + 8 * hh) * 2), b = *(const LAS f16x8*)(buf + O_BM + vl * RS + (16 * s + 8 * hh) * 2);
                    g = __builtin_amdgcn_mfma_f32_32x32x16_f16(a, b, g, 0, 0, 0); }
                const int tcol = vl & 15; const bool incl = vl >= 16;
#pragma unroll
                for (int gq = 0; gq < 4; ++gq) { float o[4];
#pragma unroll
                    for (int e = 0; e < 4; ++e) { const int ip = 8 * gq + 4 * hh + e, i = ip & 15; const bool ok = incl ? (i <= tcol) : (i < tcol); o[e] = ok ? g[4 * gq + e] : 0.f; }
                    v2u w2; w2.x = pkh(o[0], o[1]); w2.y = pkh(o[2], o[3]);
                    *(LAS v2u*)(buf + O_GT + vl * RT + (8 * gq + 4 * hh) * 2) = w2;
                    if (gq < 2 && vl < 16) *(LAS f32x4*)(buf + O_NF + vl * 64 + (8 * gq + 4 * hh) * 4) = (f32x4){o[0], o[1], o[2], o[3]}; }
            }
            MS_BARRIER();
        }
    } else if (c.wave == 7) {
        unsigned pa0 = 0u, pa1 = 0u, pb0 = 0u, pb1 = 0u, pc0 = 0u, pc1 = 0u;
#define MS_TOUCH(chp_, r0_, r1_) do { const int chp = (chp_); if (chp < nch) { \
            _Pragma("unroll") for (int q_ = 0; q_ < 2; ++q_) { const int i_ = c.lane + 64 * q_; if (i_ < 86) { const GAS unsigned* a_; \
                if (i_ < 54) { const int rr_ = i_ / 3, sg_ = i_ - 3 * rr_; int t_ = dir ? T - 17 - 16 * chp + rr_ : 16 * chp - 1 + rr_; t_ = t_ < 0 ? 0 : (t_ > T - 1 ? T - 1 : t_); \
                    a_ = (const GAS unsigned*)(PROJ + (size_t)(row0 + t_) * DIN + (sg_ == 0 ? PC_R : (sg_ == 1 ? PC_K : PC_V)) + h * HD); } \
                else { const int j_ = i_ - 54, rr_ = j_ >> 1; const int t_ = dir ? T - 16 - 16 * chp + rr_ : 16 * chp + rr_; \
                    a_ = (const GAS unsigned*)(WA + (size_t)(row0 + t_) * 2048 + (j_ & 1) * 1024 + dir * 512 + h * HD); } \
                if (q_ == 0) r0_ = *a_; else r1_ = *a_; } } } } while (0)
        unsigned px0 = 0u, px1 = 0u, px2 = 0u, px3 = 0u, px4 = 0u, px5 = 0u;
        MS_TOUCH(0, px0, px1); MS_TOUCH(1, px2, px3); MS_TOUCH(2, px4, px5);
        for (int it = -3; it < nch; it += 3) {
            asm volatile("" :: "v"(pa0), "v"(pa1)); MS_TOUCH(it + 6, pa0, pa1); MS_BARRIER();
            if (it + 1 < nch) { asm volatile("" :: "v"(pb0), "v"(pb1)); MS_TOUCH(it + 7, pb0, pb1); MS_BARRIER(); }
            if (it + 2 < nch) { asm volatile("" :: "v"(pc0), "v"(pc1)); MS_TOUCH(it + 8, pc0, pc1); MS_BARRIER(); }
        }
        asm volatile("" :: "v"(px0), "v"(px1), "v"(px2), "v"(px3), "v"(px4), "v"(px5), "v"(pa0), "v"(pa1), "v"(pb0), "v"(pb1), "v"(pc0), "v"(pc1));
#undef MS_TOUCH
    } else {
    f32x16 St0, St1;
#pragma unroll
    for (int i = 0; i < 16; ++i) { St0[i] = 0.f; St1[i] = 0.f; }
    if (smp) { float one_ = 1.0f; asm volatile("" : "+v"(one_));
        const GAS float* s0 = IN(4) + (((((size_t)(sq - B_CTX) * NL + l) * 2 + dir) * NH + h) * HD + 32 * c.wave + vl) * HD + 4 * hh;
#pragma unroll
        for (int g = 0; g < 4; ++g) { const f32x4 a = *(const GAS f32x4*)(s0 + 8 * g), b = *(const GAS f32x4*)(s0 + 32 + 8 * g);
#pragma unroll
            for (int e = 0; e < 4; ++e) { St0[4 * g + e] = a[e] * one_; St1[4 * g + e] = b[e] * one_; } }
    }
        for (int it = -3; it < nch; ++it) {
            const int ch = it;
            if (ch >= 0) {
                LAS unsigned char* buf = c.lds + (ch % 3) * BUF;
                const int v = 32 * c.wave + vl;
                if (ch == 0) {
#pragma unroll
                for (int gq = 0; gq < 4; ++gq) { const f32x4 m0 = *(const LAS f32x4*)(buf + O_WM + (8 * gq + 4 * hh) * 4), m1 = *(const LAS f32x4*)(buf + O_WM + (32 + 8 * gq + 4 * hh) * 4);
#pragma unroll
                    for (int e = 0; e < 4; ++e) { St0[4 * gq + e] *= m0[e]; St1[4 * gq + e] *= m1[e]; } }
                }
                f16x4 bmlo[4], bmhi[4];
#pragma unroll
                for (int s = 0; s < 4; ++s) { bmlo[s] = *(const LAS f16x4*)(buf + O_BM + vl * RS + (16 * s + 4 * hh) * 2); bmhi[s] = *(const LAS f16x4*)(buf + O_BM + vl * RS + (16 * s + 8 + 4 * hh) * 2); }
                const f16x8 gtk = *(const LAS f16x8*)(buf + O_GT + vl * RT + (16 + 8 * hh) * 2), vpv = *(const LAS f16x8*)(buf + O_VP + v * RT + (8 * hh) * 2);
                const f16x8 aN = *(const LAS f16x8*)(buf + O_GT + vl * RT + (8 * hh) * 2);
                f32x4 nf[4][3];
#pragma unroll
                for (int a = 0; a < 4; ++a)
#pragma unroll
                    for (int e = 0; e < 3; ++e) nf[a][e] = *(const LAS f32x4*)(buf + O_NF + (4 * a + 1 + e) * 64 + 16 * a);
                f16x8 at0[2], at1[2];
#pragma unroll
                for (int s2 = 0; s2 < 2; ++s2) { at0[s2] = *(const LAS f16x8*)(buf + O_AT + vl * RT + (16 * s2 + 8 * hh) * 2); at1[s2] = *(const LAS f16x8*)(buf + O_AT + (32 + vl) * RT + (16 * s2 + 8 * hh) * 2); }
                f32x4 sc0[4], sc1[4];
                { LAS unsigned char* nbuf = c.lds + ((ch + 1) % 3) * BUF; const bool more = ch + 1 < nch;
#pragma unroll
                  for (int gq = 0; gq < 4; ++gq) { sc0[gq] = *(const LAS f32x4*)(buf + O_WE + (8 * gq + 4 * hh) * 4); sc1[gq] = *(const LAS f32x4*)(buf + O_WE + (32 + 8 * gq + 4 * hh) * 4);
                    if (more) { sc0[gq] *= *(const LAS f32x4*)(nbuf + O_WM + (8 * gq + 4 * hh) * 4); sc1[gq] *= *(const LAS f32x4*)(nbuf + O_WM + (32 + 8 * gq + 4 * hh) * 4); } } }
                f32x16 X;
#pragma unroll
                for (int i = 0; i < 16; ++i) X[i] = 0.f;
#pragma unroll
                for (int s = 0; s < 4; ++s) {
                    f16x8 sb;
#pragma unroll
                    for (int j = 0; j < 8; ++j) sb[j] = (f16)((s < 2) ? St0[8 * (s & 1) + j] : St1[8 * (s & 1) + j]);
                    const f16x8 af = {bmlo[s][0], bmlo[s][1], bmlo[s][2], bmlo[s][3], bmhi[s][0], bmhi[s][1], bmhi[s][2], bmhi[s][3]};
                    X = __builtin_amdgcn_mfma_f32_32x32x16_f16(af, sb, X, 0, 0, 0);
                }
                X = __builtin_amdgcn_mfma_f32_32x32x16_f16(gtk, vpv, X, 0, 0, 0);
                f16x8 pball;
#pragma unroll
                for (int j = 0; j < 8; ++j) pball[j] = (f16)0.f;
#define MS_BLK(a) do { const int xo_ = 4 * ((a) >> 1); \
                    const f32x4 n1_ = nf[a][0], n2_ = nf[a][1], n3_ = nf[a][2]; \
                    float q0_ = X[xo_]; float q1_ = X[xo_ + 1] - q0_ * n1_[0]; float q2_ = X[xo_ + 2] - q0_ * n2_[0] - q1_ * n2_[1]; float q3_ = X[xo_ + 3] - q0_ * n3_[0] - q1_ * n3_[1] - q2_ * n3_[2]; \
                    if (((a) & 1) != ((a) >> 1)) { float a_, b_; \
                        a_ = q0_; b_ = q0_; swap32(a_, b_); q0_ = ((a) & 1) ? b_ : a_; a_ = q1_; b_ = q1_; swap32(a_, b_); q1_ = ((a) & 1) ? b_ : a_; \
                        a_ = q2_; b_ = q2_; swap32(a_, b_); q2_ = ((a) & 1) ? b_ : a_; a_ = q3_; b_ = q3_; swap32(a_, b_); q3_ = ((a) & 1) ? b_ : a_; } \
                    const bool hold_ = hh == ((a) >> 1); \
                    const f16 z_ = (f16)0.f; const f16 e0_ = hold_ ? (f16)(-q0_) : z_, e1_ = hold_ ? (f16)(-q1_) : z_, e2_ = hold_ ? (f16)(-q2_) : z_, e3_ = hold_ ? (f16)(-q3_) : z_; \
                    f16x8 pb_ = {z_, z_, z_, z_, z_, z_, z_, z_}; \
                    pb_[4 * ((a) & 1)] = e0_; pb_[4 * ((a) & 1) + 1] = e1_; pb_[4 * ((a) & 1) + 2] = e2_; pb_[4 * ((a) & 1) + 3] = e3_; \
                    if (hold_) { pball[4 * ((a) & 1)] = e0_; pball[4 * ((a) & 1) + 1] = e1_; pball[4 * ((a) & 1) + 2] = e2_; pball[4 * ((a) & 1) + 3] = e3_; } \
                    X = __builtin_amdgcn_mfma_f32_32x32x16_f16(aN, pb_, X, 0, 0, 0); } while (0)
                MS_BLK(0); MS_BLK(1); MS_BLK(2); MS_BLK(3);
#undef MS_BLK
                St0 = __builtin_amdgcn_mfma_f32_32x32x16_f16(at0[0], vpv, St0, 0, 0, 0); St1 = __builtin_amdgcn_mfma_f32_32x32x16_f16(at1[0], vpv, St1, 0, 0, 0);
                St0 = __builtin_amdgcn_mfma_f32_32x32x16_f16(at0[1], pball, St0, 0, 0, 0); St1 = __builtin_amdgcn_mfma_f32_32x32x16_f16(at1[1], pball, St1, 0, 0, 0);
#pragma unroll
                for (int r = 8; r < 16; ++r) { const int t = (r & 3) + 8 * ((r >> 2) - 2) + 4 * hh; const int Sg = ch * 16 + t; const int tok = dir ? T - 1 - Sg : Sg;
                    Y[((size_t)dir * M + row0 + tok) * CW + h * HD + v] = (f16)X[r]; }
#pragma unroll
                for (int gq = 0; gq < 4; ++gq)
#pragma unroll
                    for (int e = 0; e < 4; ++e) { St0[4 * gq + e] *= sc0[gq][e]; St1[4 * gq + e] *= sc1[gq][e]; }
            }
            MS_BARRIER();
        }
    if (!smp) {
        GAS float* so = p.out + O_ST + (((((size_t)sq * NL + l) * 2 + dir) * NH + h) * HD + 32 * c.wave + vl) * HD + 4 * hh;
#pragma unroll
        for (int g = 0; g < 4; ++g) { *(GAS f32x4*)(so + 8 * g) = (f32x4){St0[4 * g], St0[4 * g + 1], St0[4 * g + 2], St0[4 * g + 3]};
            *(GAS f32x4*)(so + 32 + 8 * g) = (f32x4){St1[4 * g], St1[4 * g + 1], St1[4 * g + 2], St1[4 * g + 3]}; }
    }
    }
#undef MS_BARRIER
}
__device__ __forceinline__ void mfma_scan(const Params& p0, const Ctx& c0, int l) {
    const Ctx c = fresh(c0); FRESH_P(p0);
    const int b = c.bid, G = (int)gridDim.x;
    const bool deal = G >= 128;
    const int first = b, step = deal ? (b < 64 ? 576 : G - 64) : G;
#pragma nounroll
    for (int task = first; task < 576; task += step) mscan_task(p, c, l, task);
}

__device__ __forceinline__ int swap23(int r) { return (r & ~12) | ((r & 4) << 1) | ((r & 8) >> 1); }
__device__ __forceinline__ void attn_wave_task(const DParams& p, const Ctx& c, int l, int task) {
    const GAS f16* PROJ = (const GAS f16*)(p.ws + WS_R1); const GAS f16* KN = (const GAS f16*)(p.ws + WS_KN); const GAS f16* VT = (const GAS f16*)(p.ws + WS_VT);
    GAS f16* OA = (GAS f16*)(p.ws + WS_R4);
    const int hq = task & 7, qb = task >> 3, kvh = hq >> 2;
    const int r32 = c.lane & 31, hh = c.lane >> 5;
    int rowq0, L; const GAS f16* Kb; const GAS f16* Vb; bool smp;
    if (qb < 128) { smp = true; rowq0 = M_CTX + qb * 32; const int b = qb >> 5; L = KV_SMP;
        Kb = KN + KN_SMP_OFF + ((size_t)b * 2 + kvh) * KV_SMP * HD; Vb = VT + KN_SMP_OFF + ((size_t)b * 2 + kvh) * HD * KV_SMP; }
    else { smp = false; rowq0 = (qb - 128) * 32; const int b = rowq0 >> 8; L = T_CTX;
        Kb = KN + ((size_t)b * 2 + kvh) * T_CTX * HD; Vb = VT + ((size_t)b * 2 + kvh) * HD * T_CTX; }
    const int row = rowq0 + r32;
    float x[4][8]; float ss = 0.f;
#pragma unroll
    for (int s = 0; s < 4; ++s) { const f16x8 q = *(const GAS f16x8*)(PROJ + (size_t)row * DIN + PC_Q + hq * HD + 16 * s + 8 * hh);
#pragma unroll
        for (int j = 0; j < 8; ++j) { x[s][j] = (float)q[j]; ss += x[s][j] * x[s][j]; } }
    ss = half_sum(ss);
    const float rstd = rsqrtf(ss * (1.0f / HD) + 1e-6f);
#pragma unroll
    for (int s = 0; s < 4; ++s)
#pragma unroll
        for (int j = 0; j < 8; ++j) x[s][j] *= rstd * IN(26)[l * HD + 16 * s + 8 * hh + j];
    if (smp) { const int t = (row - M_CTX) & (T_SMP - 1); const float posr = (float)(t >> 6), posc = (float)(t & 63);
#pragma unroll
        for (int j = 0; j < 8; ++j) { const float freq = exp2f(-(float)(8 * hh + j) * (13.287712379549449f / 16.0f));
            const float ar = posr * freq, ac = posc * freq; const float cr = __cosf(ar), sr = __sinf(ar), cc = __cosf(ac), sc = __sinf(ac);
            const float a0 = x[0][j], a1 = x[1][j], b0 = x[2][j], b1 = x[3][j];
            x[0][j] = a0 * cr - a1 * sr; x[1][j] = a1 * cr + a0 * sr; x[2][j] = b0 * cc - b1 * sc; x[3][j] = b1 * cc + b0 * sc; } }
    f16x8 qf[4];
#pragma unroll
    for (int s = 0; s < 4; ++s)
#pragma unroll
        for (int j = 0; j < 8; ++j) qf[s][j] = (f16)(x[s][j] * (0.125f * 1.4426950408889634f));
    f32x16 o0, o1;
#pragma unroll
    for (int i = 0; i < 16; ++i) { o0[i] = 0.f; o1[i] = 0.f; }
    float mrun = -1e30f, lsum = 0.f;
    const GAS f16* kp = Kb + (size_t)swap23(r32) * HD + 8 * hh;
    const GAS f16* vp = Vb + (size_t)r32 * L + 8 * hh;
    const int ntile = L >> 5;
    f16x8 kf[4], vf[4];
#pragma unroll
    for (int s = 0; s < 4; ++s) kf[s] = *(const GAS f16x8*)(kp + 16 * s);
    vf[0] = *(const GAS f16x8*)(vp); vf[1] = *(const GAS f16x8*)(vp + 16); vf[2] = *(const GAS f16x8*)(vp + (size_t)32 * L); vf[3] = *(const GAS f16x8*)(vp + (size_t)32 * L + 16);
    for (int kt = 0; kt < ntile; ++kt) {
        f16x8 kn[4], vn[4];
        const int ktn = kt + 1 < ntile ? kt + 1 : kt;
#pragma unroll
        for (int s = 0; s < 4; ++s) kn[s] = *(const GAS f16x8*)(kp + (size_t)ktn * 32 * HD + 16 * s);
        vn[0] = *(const GAS f16x8*)(vp + ktn * 32); vn[1] = *(const GAS f16x8*)(vp + ktn * 32 + 16); vn[2] = *(const GAS f16x8*)(vp + (size_t)32 * L + ktn * 32); vn[3] = *(const GAS f16x8*)(vp + (size_t)32 * L + ktn * 32 + 16);
        f32x16 sa;
#pragma unroll
        for (int i = 0; i < 16; ++i) sa[i] = 0.f;
#pragma unroll
        for (int s = 0; s < 4; ++s) sa = __builtin_amdgcn_mfma_f32_32x32x16_f16(kf[s], qf[s], sa, 0, 0, 0);
        float mt = sa[0];
#pragma unroll
        for (int i = 1; i < 16; ++i) mt = fmaxf(mt, sa[i]);
        mt = half_max(mt);
        const float mn = fmaxf(mrun, mt); const float alpha = exp2f(mrun - mn); mrun = mn;
        float ps = 0.f;
#pragma unroll
        for (int i = 0; i < 16; ++i) { sa[i] = exp2f(sa[i] - mn); ps += sa[i]; }
        lsum = lsum * alpha + ps;
#pragma unroll
        for (int i = 0; i < 16; ++i) { o0[i] *= alpha; o1[i] *= alpha; }
        f16x8 pb0, pb1;
#pragma unroll
        for (int j = 0; j < 8; ++j) { pb0[j] = (f16)sa[j]; pb1[j] = (f16)sa[8 + j]; }
        o0 = __builtin_amdgcn_mfma_f32_32x32x16_f16(vf[0], pb0, o0, 0, 0, 0);
        o0 = __builtin_amdgcn_mfma_f32_32x32x16_f16(vf[1], pb1, o0, 0, 0, 0);
        o1 = __builtin_amdgcn_mfma_f32_32x32x16_f16(vf[2], pb0, o1, 0, 0, 0);
        o1 = __builtin_amdgcn_mfma_f32_32x32x16_f16(vf[3], pb1, o1, 0, 0, 0);
#pragma unroll
        for (int s = 0; s < 4; ++s) { kf[s] = kn[s]; vf[s] = vn[s]; }
    }
    lsum = half_sum(lsum);
    const float inv = 1.0f / lsum;
    GAS f16* op = OA + (size_t)row * D + CW + hq * HD + 4 * hh;
#pragma unroll
    for (int g = 0; g < 4; ++g) {
        v2u w0; w0.x = pkh(o0[4 * g] * inv, o0[4 * g + 1] * inv); w0.y = pkh(o0[4 * g + 2] * inv, o0[4 * g + 3] * inv);
        v2u w1; w1.x = pkh(o1[4 * g] * inv, o1[4 * g + 1] * inv); w1.y = pkh(o1[4 * g + 2] * inv, o1[4 * g + 3] * inv);
        *(GAS v2u*)(op + 8 * g) = w0; *(GAS v2u*)(op + 32 + 8 * g) = w1; }
}
constexpr int AT_KS = 144, AT_BUF = 2 * 64 * AT_KS;
__device__ __forceinline__ void attn_block_task(const DParams& p, const Ctx& c, int l, int item) {
    const GAS f16* PROJ = (const GAS f16*)(p.ws + WS_R1); const GAS f16* KN = (const GAS f16*)(p.ws + WS_KN); const GAS f16* VT = (const GAS f16*)(p.ws + WS_VT);
    GAS f16* OA = (GAS f16*)(p.ws + WS_R4);
    int rowq0, L, kvh; const GAS f16* Kb; const GAS f16* Vb; bool smp;
    if (item < 128) { smp = true; const int b = item >> 5; kvh = (item >> 4) & 1; rowq0 = M_CTX + b * T_SMP + (item & 15) * 64; L = KV_SMP;
        Kb = KN + KN_SMP_OFF + ((size_t)b * 2 + kvh) * KV_SMP * HD; Vb = VT + KN_SMP_OFF + ((size_t)b * 2 + kvh) * HD * KV_SMP; }
    else { smp = false; const int id = item - 128; const int b = id >> 3; kvh = (id >> 2) & 1; rowq0 = b * T_CTX + (id & 3) * 64; L = T_CTX;
        Kb = KN + ((size_t)b * 2 + kvh) * T_CTX * HD; Vb = VT + ((size_t)b * 2 + kvh) * HD * T_CTX; }
    const int hq = kvh * 4 + (c.wave & 3);
    const int r32 = c.lane & 31, hh = c.lane >> 5;
    const int row = rowq0 + 32 * (c.wave >> 2) + r32;
    const int kk = c.tid >> 3, chk = c.tid & 7;
    const GAS f16* ksrc = Kb + (size_t)kk * HD + chk * 8;
    const GAS f16* vsrc = Vb + (size_t)kk * L + chk * 8;
    const int sdst = kk * AT_KS + chk * 16;
    v4u kreg = *(const GAS v4u*)ksrc, vreg = *(const GAS v4u*)vsrc;
    float x[4][8]; float ss = 0.f;
#pragma unroll
    for (int s = 0; s < 4; ++s) { const f16x8 q = *(const GAS f16x8*)(PROJ + (size_t)row * DIN + PC_Q + hq * HD + 16 * s + 8 * hh);
#pragma unroll
        for (int j = 0; j < 8; ++j) { x[s][j] = (float)q[j]; ss += x[s][j] * x[s][j]; } }
    ss = half_sum(ss);
    const float rstd = rsqrtf(ss * (1.0f / HD) + 1e-6f);
#pragma unroll
    for (int s = 0; s < 4; ++s)
#pragma unroll
        for (int j = 0; j < 8; ++j) x[s][j] *= rstd * IN(26)[l * HD + 16 * s + 8 * hh + j];
    if (smp) { const int t = (row - M_CTX) & (T_SMP - 1); const float posr = (float)(t >> 6), posc = (float)(t & 63);
#pragma unroll
        for (int j = 0; j < 8; ++j) { const float freq = exp2f(-(float)(8 * hh + j) * (13.287712379549449f / 16.0f));
            const float ar = posr * freq, ac = posc * freq; const float cr = __cosf(ar), sr = __sinf(ar), cc = __cosf(ac), sc = __sinf(ac);
            const float a0 = x[0][j], a1 = x[1][j], b0 = x[2][j], b1 = x[3][j];
            x[0][j] = a0 * cr - a1 * sr; x[1][j] = a1 * cr + a0 * sr; x[2][j] = b0 * cc - b1 * sc; x[3][j] = b1 * cc + b0 * sc; } }
    f16x8 qf[4];
#pragma unroll
    for (int s = 0; s < 4; ++s)
#pragma unroll
        for (int j = 0; j < 8; ++j) qf[s][j] = (f16)(x[s][j] * (0.125f * 1.4426950408889634f));
    f32x16 o0, o1;
#pragma unroll
    for (int i = 0; i < 16; ++i) { o0[i] = 0.f; o1[i] = 0.f; }
    float mrun = -1e30f, lsum = 0.f;
    const int nstep = L >> 6;
    *(LAS v4u*)(c.lds + sdst) = kreg; *(LAS v4u*)(c.lds + 64 * AT_KS + sdst) = vreg;
    asm volatile("s_waitcnt lgkmcnt(0)" ::: "memory"); __builtin_amdgcn_s_barrier(); asm volatile("" ::: "memory");
    const int koff = swap23(r32) * AT_KS + 16 * hh, voff = 64 * AT_KS + r32 * AT_KS + 16 * hh;
    for (int st = 0; st < nstep; ++st) {
        if (st + 1 < nstep) { kreg = *(const GAS v4u*)(ksrc + (size_t)(st + 1) * 64 * HD); vreg = *(const GAS v4u*)(vsrc + (st + 1) * 64); }
        LAS unsigned char* sb = c.lds + (st & 1) * AT_BUF;
        f32x16 sa0, sa1;
#pragma unroll
        for (int i = 0; i < 16; ++i) { sa0[i] = 0.f; sa1[i] = 0.f; }
#pragma unroll
        for (int s = 0; s < 4; ++s) { const f16x8 k0 = *(const LAS f16x8*)(sb + koff + 32 * s), k1 = *(const LAS f16x8*)(sb + koff + 32 * AT_KS + 32 * s);
            sa0 = __builtin_amdgcn_mfma_f32_32x32x16_f16(k0, qf[s], sa0, 0, 0, 0); sa1 = __builtin_amdgcn_mfma_f32_32x32x16_f16(k1, qf[s], sa1, 0, 0, 0); }
        float mt = fmaxf(sa0[0], sa1[0]);
#pragma unroll
        for (int i = 1; i < 16; ++i) mt = fmaxf(mt, fmaxf(sa0[i], sa1[i]));
        mt = half_max(mt);
        const float mn = fmaxf(mrun, mt); const float alpha = __builtin_amdgcn_exp2f(mrun - mn); mrun = mn;
        float ps = 0.f;
#pragma unroll
        for (int i = 0; i < 16; ++i) { sa0[i] = __builtin_amdgcn_exp2f(sa0[i] - mn); sa1[i] = __builtin_amdgcn_exp2f(sa1[i] - mn); ps += sa0[i] + sa1[i]; }
        lsum = lsum * alpha + ps;
#pragma unroll
        for (int i = 0; i < 16; ++i) { o0[i] *= alpha; o1[i] *= alpha; }
        f16x8 pb[4];
#pragma unroll
        for (int j = 0; j < 8; ++j) { pb[0][j] = (f16)sa0[j]; pb[1][j] = (f16)sa0[8 + j]; pb[2][j] = (f16)sa1[j]; pb[3][j] = (f16)sa1[8 + j]; }
#pragma unroll
        for (int q4 = 0; q4 < 4; ++q4) {
            const f16x8 v0 = *(const LAS f16x8*)(sb + voff + 32 * q4), v1 = *(const LAS f16x8*)(sb + voff + 32 * AT_KS + 32 * q4);
            o0 = __builtin_amdgcn_mfma_f32_32x32x16_f16(v0, pb[q4], o0, 0, 0, 0); o1 = __builtin_amdgcn_mfma_f32_32x32x16_f16(v1, pb[q4], o1, 0, 0, 0); }
        if (st + 1 < nstep) { LAS unsigned char* nb = c.lds + ((st + 1) & 1) * AT_BUF; *(LAS v4u*)(nb + sdst) = kreg; *(LAS v4u*)(nb + 64 * AT_KS + sdst) = vreg; }
        asm volatile("s_waitcnt lgkmcnt(0)" ::: "memory"); __builtin_amdgcn_s_barrier(); asm volatile("" ::: "memory");
    }
    lsum = half_sum(lsum);
    const float inv = 1.0f / lsum;
    GAS f16* op = OA + (size_t)row * D + CW + hq * HD + 4 * hh;
#pragma unroll
    for (int g = 0; g < 4; ++g) {
        v2u w0; w0.x = pkh(o0[4 * g] * inv, o0[4 * g + 1] * inv); w0.y = pkh(o0[4 * g + 2] * inv, o0[4 * g + 3] * inv);
        v2u w1; w1.x = pkh(o1[4 * g] * inv, o1[4 * g + 1] * inv); w1.y = pkh(o1[4 * g + 2] * inv, o1[4 * g + 3] * inv);
        *(GAS v2u*)(op + 8 * g) = w0; *(GAS v2u*)(op + 32 + 8 * g) = w1; }
}
__device__ __forceinline__ void fast_attn(const Params& p0, const Ctx& c0, int l) {
    const Ctx c = fresh(c0); FRESH_P(p0);
    unsigned* ctr = (unsigned*)(p0.ws + WS_CTL) + 8192 + 64 * l;
    volatile LAS unsigned* slot = (volatile LAS unsigned*)(c.lds + MISC_OFF) + 16;
    for (;;) {
        if (c.tid == 0) slot[0] = __hip_atomic_fetch_add(ctr, 1u, __ATOMIC_RELAXED, __HIP_MEMORY_SCOPE_AGENT);
        __syncthreads();
        const int item = (int)slot[0];
        __syncthreads();
        if (item >= 384) break;
        attn_block_task(p, c, l, item);
    }
}

__device__ __forceinline__ void post_phase(const Params& p0, const Ctx& c0, int l) {
    const Ctx c = fresh(c0); FRESH_P(p0);
    const GAS f16* PROJ = (const GAS f16*)(p.ws + WS_R1); const GAS f16* Y = (const GAS f16*)(p.ws + WS_R3); const GAS float* RK = (const GAS float*)(p.ws + WS_RK);
    GAS f16* OA = (GAS f16*)(p.ws + WS_R4);
    const int ch0 = c.lane * 8, h = c.lane >> 3;
    float gnw[8], gnb[8], muv[8];
    { const f32x4 a0 = *(const GAS f32x4*)(IN(24) + l * CW + ch0), a1 = *(const GAS f32x4*)(IN(24) + l * CW + ch0 + 4), b0 = *(const GAS f32x4*)(IN(25) + l * CW + ch0), b1 = *(const GAS f32x4*)(IN(25) + l * CW + ch0 + 4);
      const f32x4 m0 = *(const GAS f32x4*)(IN(15) + (l * 3 + 2) * CW + ch0), m1 = *(const GAS f32x4*)(IN(15) + (l * 3 + 2) * CW + ch0 + 4);
#pragma unroll
      for (int e = 0; e < 4; ++e) { gnw[e] = a0[e]; gnw[4 + e] = a1[e]; gnb[e] = b0[e]; gnb[4 + e] = b1[e]; muv[e] = m0[e]; muv[4 + e] = m1[e]; } }
    for (int row = c.gw; row < M; row += c.ngw) {
        int g, t, T; row_info(row, g, t, T);
        const GAS f16* pr = PROJ + (size_t)row * DIN + PC_V + ch0;
        const f16x8 y0 = *(const GAS f16x8*)(Y + (size_t)row * CW + ch0), y1 = *(const GAS f16x8*)(Y + ((size_t)M + row) * CW + ch0);
        const f16x8 vc = *(const GAS f16x8*)pr; const f16x8 gv = *(const GAS f16x8*)(OA + (size_t)row * D + ch0);
        f16x8 vp, vn;
#pragma unroll
        for (int e = 0; e < 8; ++e) { vp[e] = (f16)0.f; vn[e] = (f16)0.f; }
        if (t > 0) vp = *(const GAS f16x8*)(pr - DIN);
        if (t < T - 1) vn = *(const GAS f16x8*)(pr + DIN);
        const float rk = RK[(size_t)row * 8 + h] + RK[((size_t)M + row) * 8 + h];
        float y[8]; float s = 0.f;
#pragma unroll
        for (int e = 0; e < 8; ++e) { y[e] = (float)y0[e] + (float)y1[e]; s += y[e]; }
        const float mean = dpp_sum8(s) * (1.0f / HD); float q = 0.f;
#pragma unroll
        for (int e = 0; e < 8; ++e) { y[e] -= mean; q += y[e] * y[e]; }
        const float rstd = rsqrtf(dpp_sum8(q) * (1.0f / HD) + 64e-5f);
        float o[8];
#pragma unroll
        for (int e = 0; e < 8; ++e) { const float vcf = (float)vc[e]; const float v = vcf + muv[e] * (0.5f * ((float)vp[e] + (float)vn[e]) - vcf);
            o[e] = (y[e] * rstd * gnw[e] + gnb[e] + rk * v) * (float)gv[e]; }
        v4u w; w.x = pkh(o[0], o[1]); w.y = pkh(o[2], o[3]); w.z = pkh(o[4], o[5]); w.w = pkh(o[6], o[7]);
        *(GAS v4u*)(OA + (size_t)row * D + ch0) = w;
    }
}

__device__ __forceinline__ void gemm_proj(const Params& p0, const Ctx& c0) { const Ctx c = fresh(c0); FRESH_P(p0);
    pg8::Gemm g{(const GAS f16*)(p.ws + WS_R4), (const GAS f16*)(p.ws + WS_W + WO_IN), D, D, D}; pg8::StaticOrder S; S.init(M, DIN, (int)gridDim.x, c.bid);
    pg8::gemm_phase(c.lds, g, S, pg8::EpiProjF{(GAS f16*)(p.ws + WS_R1)}, c.wave); }
__device__ __forceinline__ void gemm_wa(const Params& p0, const Ctx& c0, int l) { const Ctx c = fresh(c0); FRESH_P(p0);
    pg8::Gemm g{(const GAS f16*)(p.ws + WS_R1) + PC_LW, (const GAS f16*)(p.ws + WS_W + WO_SM), DIN, 128, 128}; pg8::StaticOrder S; S.init(M, 2048, (int)gridDim.x, c.bid);
    pg8::gemm_phase(c.lds, g, S, pg8::EpiWAF{(GAS f16*)(p.ws + WS_R2), IN(19) + (size_t)l * 2 * CW, IN(21) + (size_t)l * 2 * CW}, c.wave); }
__device__ __forceinline__ void gemm_gate(const Params& p0, const Ctx& c0) { const Ctx c = fresh(c0); FRESH_P(p0);
    pg8::Gemm g{(const GAS f16*)(p.ws + WS_R1) + PC_LG, (const GAS f16*)(p.ws + WS_W + WO_G), DIN, 128, 128}; pg8::StaticOrder S; if (gridDim.x >= 224) S.init(M, CW, (int)gridDim.x, c.bid - 128); else S.init(M, CW, (int)gridDim.x, c.bid);
    pg8::gemm_phase(c.lds, g, S, pg8::EpiF16F{(GAS f16*)(p.ws + WS_R4), D}, c.wave); }
__device__ __forceinline__ void gemm_merge(const Params& p0, const Ctx& c0) { const Ctx c = fresh(c0); FRESH_P(p0);
    const GAS f16* OA = (const GAS f16*)(p.ws + WS_R4); const GAS f16* WbrT = (const GAS f16*)(p.ws + WS_W + WO_BR); GAS f16* MG = (GAS f16*)(p.ws + WS_R3); const GAS f16* PROJ = (const GAS f16*)(p.ws + WS_R1);
    pg8::StaticOrder S; S.init(M, D, (int)gridDim.x, c.bid, 192);
    pg8::Gemm g{OA, WbrT, D, D, D}; pg8::gemm_phase<pg8::EpiMergeF, 96>(c.lds, g, S, pg8::EpiMergeF{MG, PROJ}, c.wave); }
__device__ __forceinline__ void gemm_out(const Params& p0, const Ctx& c0) { const Ctx c = fresh(c0); FRESH_P(p0);
    pg8::Gemm g{(const GAS f16*)(p.ws + WS_R3), (const GAS f16*)(p.ws + WS_W + WO_OUT), D, D, D}; pg8::StaticOrder S; S.init(M, D, (int)gridDim.x, c.bid, 192);
    pg8::gemm_phase<pg8::EpiF16F, 96>(c.lds, g, S, pg8::EpiF16F{(GAS f16*)(p.ws + WS_R2), D}, c.wave); }
__device__ __forceinline__ void gemm_up(const Params& p0, const Ctx& c0) { const Ctx c = fresh(c0); FRESH_P(p0);
    pg8::Gemm g{(const GAS f16*)(p.ws + WS_R4), (const GAS f16*)(p.ws + WS_W + WO_UP), D, D, D}; pg8::StaticOrder S; S.init(M, DFF, (int)gridDim.x, c.bid);
    pg8::gemm_phase(c.lds, g, S, pg8::EpiRelu2F{(GAS f16*)(p.ws + WS_R1), DFF}, c.wave); }
__device__ __forceinline__ void gemm_down(const Params& p0, const Ctx& c0) { const Ctx c = fresh(c0); FRESH_P(p0);
    pg8::Gemm g{(const GAS f16*)(p.ws + WS_R1), (const GAS f16*)(p.ws + WS_W + WO_DN), DFF, DFF, DFF}; pg8::StaticOrder S; S.init(M, D, (int)gridDim.x, c.bid, 192);
    pg8::gemm_phase<pg8::EpiF16F, 96>(c.lds, g, S, pg8::EpiF16F{(GAS f16*)(p.ws + WS_R2), D}, c.wave); }

__global__ void __launch_bounds__(NTHREADS, 2) fwd_kernel(Params p) {
    extern __shared__ __attribute__((aligned(16))) unsigned char lds_raw[];
    Ctx c;
    c.lds = (LAS unsigned char*)lds_raw;
    c.tid = threadIdx.x; c.lane = c.tid & 63; c.wave = __builtin_amdgcn_readfirstlane(c.tid >> 6);
    c.gw = blockIdx.x * NWAVES + c.wave; c.ngw = gridDim.x * NWAVES; c.gt = blockIdx.x * NTHREADS + c.tid; c.ngt = gridDim.x * NTHREADS;
    volatile LAS unsigned* MISC = (volatile LAS unsigned*)(c.lds + MISC_OFF);
    if (c.tid < 32) MISC[c.tid] = 0u;
    if (c.tid < 28) ((LAS unsigned long long*)(c.lds + PTAB_OFF))[c.tid] = (unsigned long long)p.in[c.tid];
    __syncthreads();
    unsigned* ctl = (unsigned*)(p.ws + WS_CTL);
    XcdBarrier bar = xcd_barrier_post(ctl + CW_BAR, MISC + 8);
#define GRID_BAR() xcd_barrier(bar)

    conv_weights(p, c, 0);
    __syncthreads();
    mod_phase(p, c);
    GRID_BAR();
    norm_phase<0>(p, c, 0);
    GRID_BAR();
#pragma nounroll
    for (int l = 0; l < NL; ++l) {
        gemm_proj(p, c);
        GRID_BAR();
        gemm_wa(p, c, l);
        gemm_gate(p, c);
        kv_prep(p, c, l);
        GRID_BAR();
        mfma_scan(p, c, l);
        __syncthreads();
        fast_attn(p, c, l);
        GRID_BAR();
        post_phase(p, c, l);
        GRID_BAR();
        gemm_merge(p, c);
        GRID_BAR();
        gemm_out(p, c);
        GRID_BAR();
        norm_phase<1>(p, c, l);
        GRID_BAR();
        gemm_up(p, c);
        GRID_BAR();
        gemm_down(p, c);
        GRID_BAR();
        norm_phase<2>(p, c, l);
        if (l + 1 < NL) { __syncthreads(); conv_weights(p, c, l + 1); }
        GRID_BAR();
    }
}

extern "C" void kernel_launch(void* const* d_in, const int* in_sizes, int n_in, void* d_out, int out_size, void* d_ws, size_t ws_size, hipStream_t stream) {
    static int grid = 0;
    if (grid == 0) {
        if (n_in != 28 || (size_t)out_size != O_TOTAL || ws_size < WS_END) { fprintf(stderr, "kernel_launch: unexpected shapes n_in %d out %d ws %zu\n", n_in, out_size, ws_size); grid = -1; return; }
        int dev = 0, cus = 0;
        if (hipGetDevice(&dev) != hipSuccess || hipDeviceGetAttribute(&cus, hipDeviceAttributeMultiprocessorCount, dev) != hipSuccess) { grid = -1; return; }
        if (hipFuncSetAttribute((const void*)fwd_kernel, hipFuncAttributeMaxDynamicSharedMemorySize, LDS_BYTES) != hipSuccess) { fprintf(stderr, "kernel_launch: hipFuncSetAttribute failed\n"); grid = -1; return; }
        grid = cus;
    }
    if (grid < 0) return;
    (void)hipMemsetAsync((char*)d_ws + WS_CTL, 0, CTL_BYTES + MiB, stream);
    Params p{};
    for (int i = 0; i < 28; ++i) p.in[i] = (const float*)d_in[i];
    p.out = (float*)d_out; p.ws = (unsigned char*)d_ws;
    hipLaunchKernelGGL(fwd_kernel, dim3(grid), dim3(NTHREADS), LDS_BYTES, stream, p);
}
```

```cpp
#include <hip/hip_runtime.h>
#include <cstdio>
#include <cstdint>

#define GAS __attribute__((address_space(1)))
#define LAS __attribute__((address_space(3)))
typedef _Float16 f16;
typedef _Float16 f16x8 __attribute__((ext_vector_type(8)));
typedef _Float16 f16x4 __attribute__((ext_vector_type(4)));
typedef _Float16 f16x2 __attribute__((ext_vector_type(2)));
typedef float f32x4 __attribute__((ext_vector_type(4)));
typedef float f32x16 __attribute__((ext_vector_type(16)));
typedef unsigned v4u __attribute__((ext_vector_type(4)));
typedef unsigned v2u __attribute__((ext_vector_type(2)));

constexpr int D = 1024, DIN = 4608, DFF = 4096, CW = 512, NL = 2, NH = 8, HD = 64;
constexpr int B_CTX = 32, T_CTX = 256, B_SMP = 4, T_SMP = 1024, PAST = 256, KV_SMP = PAST + T_SMP;
constexpr int M_CTX = B_CTX * T_CTX, M_SMP = B_SMP * T_SMP, M = M_CTX + M_SMP;
constexpr int NMOD = 6 * D;
constexpr int PC_R = 0, PC_K = 512, PC_V = 1024, PC_LW = 1536, PC_LA = 1600, PC_LG = 1664, PC_Q = 1792, PC_KA = 2304, PC_VA = 2432, PC_GR = 2560, PC_GA = 3584;
constexpr size_t O_Y = 0, O_CK = (size_t)M * D, O_CV = O_CK + (size_t)B_CTX * NL * T_CTX * 128, O_ST = O_CV + (size_t)B_CTX * NL * T_CTX * 128;
constexpr size_t O_TOTAL = O_ST + (size_t)B_CTX * NL * 2 * NH * HD * HD;

constexpr size_t MiB = 1u << 20;
constexpr size_t WS_CTL = 0, CTL_BYTES = 1 * MiB;
constexpr size_t WS_MOD = 1 * MiB;
constexpr size_t WS_W = 2 * MiB;
constexpr size_t WO_IN = 0, WO_BR = 9 * MiB, WO_OUT = 11 * MiB, WO_UP = 13 * MiB, WO_DN = 21 * MiB, WO_SM = 29 * MiB, WO_G = 29 * MiB + 512 * 1024;
constexpr size_t WS_R1 = 32 * MiB;
constexpr size_t WS_R2 = 140 * MiB;
constexpr size_t WS_R3 = 188 * MiB;
constexpr size_t WS_RK = 212 * MiB;
constexpr size_t WS_R4 = 213 * MiB;
constexpr size_t WS_KN = 237 * MiB;
constexpr size_t WS_VT = 241 * MiB;
constexpr size_t WS_END = 245 * MiB;
constexpr size_t KN_SMP_OFF = (size_t)B_CTX * 2 * T_CTX * 64;

constexpr int NWAVES = 8, NTHREADS = 512;
constexpr int LDS_BYTES = 147456;
constexpr int MISC_OFF = 131072 + 320, PTAB_OFF = 131072 + 1024;

#define XB_TMO      128
#define XB_XCNT(j)  (256  + 64 * (j))
#define XB_XSUB(j)  (1280 + 64 * (j))
#define XB_XGEN(j)  (2304 + 64 * (j))
#define XB_TOP      3328
#define XB_TOPGEN   3392
#define XCD_BAR_WORDS 3456
#define XB_SPIN_CAP (1u << 24)
constexpr int CW_BAR = 4096;

__device__ __forceinline__ unsigned xb_ld(unsigned* p)              { return __hip_atomic_load(p, __ATOMIC_RELAXED, __HIP_MEMORY_SCOPE_AGENT); }
__device__ __forceinline__ unsigned xb_add(unsigned* p, unsigned v) { return __hip_atomic_fetch_add(p, v, __ATOMIC_RELAXED, __HIP_MEMORY_SCOPE_AGENT); }
__device__ __forceinline__ unsigned xb_xcc_id() { return (unsigned)__builtin_amdgcn_s_getreg((3 << 11) | 20) & 0xFu; }
#define XB_SPIN(cond, bar) do { unsigned _sp = 0; while (cond) { __builtin_amdgcn_s_sleep(1); \
    if ((++_sp & 255u) == 0u) { if (xb_ld(&(bar)[XB_TMO])) break; if (_sp > XB_SPIN_CAP) { atomicAdd(&(bar)[XB_TMO], 1u); break; } } } } while (0)

struct XcdBarrier { unsigned* bar; unsigned x; volatile LAS unsigned* st; };

__device__ __forceinline__ XcdBarrier xcd_barrier_post(unsigned* bar, volatile LAS unsigned* st) {
    XcdBarrier b; b.bar = bar; b.x = xb_xcc_id(); b.st = st;
    if (threadIdx.x == 0) (void)xb_add(&bar[XB_XCNT(b.x)], 1u);
    return b;
}
__device__ __forceinline__ void xcd_barrier_complete(unsigned* bar, unsigned x, unsigned& nloc, unsigned& nx) {
    const unsigned G = gridDim.x * gridDim.y * gridDim.z;
    unsigned sum, cnt, mine, sp = 0u;
    for (;;) {
        sum = 0u; cnt = 0u; mine = 0u;
#pragma unroll
        for (unsigned j = 0; j < 16; ++j) { const unsigned c = xb_ld(&bar[XB_XCNT(j)]); sum += c; cnt += (c > 0u) ? 1u : 0u; mine = (j == x) ? c : mine; }
        if (sum == G) break;
        __builtin_amdgcn_s_sleep(1);
        if ((++sp & 255u) == 0u) { if (xb_ld(&bar[XB_TMO])) break; if (sp > XB_SPIN_CAP) { atomicAdd(&bar[XB_TMO], 1u); break; } }
    }
    nloc = mine > 0u ? mine : 1u; nx = cnt > 0u ? cnt : 1u;
}
__device__ __forceinline__ void xcd_barrier(const XcdBarrier& b) {
    asm volatile("s_waitcnt vmcnt(0)" ::: "memory");
    __syncthreads();
    if (threadIdx.x == 0) {
        unsigned* bar = b.bar; unsigned bx = b.x;
        asm volatile("" : "+s"(bar), "+s"(bx));
        __builtin_amdgcn_s_waitcnt(0);
        unsigned nloc = b.st[0], nx = b.st[1];
        if (nloc == 0u) { xcd_barrier_complete(bar, bx, nloc, nx); b.st[0] = nloc; b.st[1] = nx; }
        const unsigned old = xb_add(&bar[XB_XSUB(bx)], 1u);
        const unsigned gen = old / nloc;
        if (old + 1u == (gen + 1u) * nloc) {
            __builtin_amdgcn_fence(__ATOMIC_RELEASE, "agent");
            asm volatile("s_waitcnt vmcnt(0)" ::: "memory");
            const unsigned og = xb_add(&bar[XB_TOP], 1u);
            const unsigned tg = og / nx;
            if (og + 1u == (tg + 1u) * nx) xb_add(&bar[XB_TOPGEN], 1u);
            else XB_SPIN(xb_ld(&bar[XB_TOPGEN]) == tg, bar);
            __builtin_amdgcn_fence(__ATOMIC_ACQUIRE, "agent");
            xb_add(&bar[XB_XGEN(bx)], 1u);
            asm volatile("s_waitcnt vmcnt(0)" ::: "memory");
        } else {
            XB_SPIN(xb_ld(&bar[XB_XGEN(bx)]) == gen, bar);
            __builtin_amdgcn_fence(__ATOMIC_ACQUIRE, "agent");
            asm volatile("s_waitcnt vmcnt(0)" ::: "memory");
        }
    }
    __syncthreads();
}

#define LDS_WAIT() asm volatile("s_waitcnt lgkmcnt(0)" ::: "memory")
#define DPPF(x, ctrl, rmask, oldv) __builtin_bit_cast(float, __builtin_amdgcn_update_dpp(__builtin_bit_cast(int, (float)(oldv)), __builtin_bit_cast(int, (float)(x)), (ctrl), (rmask), 0xF, false))
__device__ __forceinline__ float wave_sum(float v) {
    v += DPPF(v, 0xB1, 0xF, 0.f); v += DPPF(v, 0x4E, 0xF, 0.f); v += DPPF(v, 0x141, 0xF, 0.f); v += DPPF(v, 0x140, 0xF, 0.f);
    v += DPPF(v, 0x142, 0xA, 0.f); v += DPPF(v, 0x143, 0xC, 0.f);
    return __builtin_bit_cast(float, __builtin_amdgcn_readlane(__builtin_bit_cast(int, v), 63));
}
__device__ __forceinline__ float dpp_f(float x, const int ctrl) { return x; }
#define DPP_ADD(x, ctrl) (x) += __builtin_bit_cast(float, __builtin_amdgcn_update_dpp(0, __builtin_bit_cast(int, (x)), (ctrl), 0xF, 0xF, true))
__device__ __forceinline__ float dpp_sum8(float x) { DPP_ADD(x, 0xB1); DPP_ADD(x, 0x4E); DPP_ADD(x, 0x141); return x; }
__device__ __forceinline__ float dpp_sum16(float x) { DPP_ADD(x, 0xB1); DPP_ADD(x, 0x4E); DPP_ADD(x, 0x141); DPP_ADD(x, 0x140); return x; }
__device__ __forceinline__ void swap32(float& a, float& b) { asm volatile("v_nop\n\tv_nop\n\tv_permlane32_swap_b32 %0, %1" : "+v"(a), "+v"(b)); }
__device__ __forceinline__ float half_sum(float v) { float a = v, b = v; swap32(a, b); return a + b; }
__device__ __forceinline__ float half_max(float v) { float a = v, b = v; swap32(a, b); return fmaxf(a, b); }
__device__ __forceinline__ float xor16(float v) { return __builtin_bit_cast(float, __builtin_amdgcn_ds_swizzle(__builtin_bit_cast(int, v), 0x401F)); }
__device__ __forceinline__ float sigmoidf_(float x) { return __builtin_amdgcn_rcpf(1.0f + __expf(-x)); }
__device__ __forceinline__ float tanhf_(float x) { return 1.0f - 2.0f * __builtin_amdgcn_rcpf(1.0f + __expf(2.0f * x)); }
__device__ __forceinline__ unsigned pkh(float lo, float hi) { f16x2 v = {(f16)lo, (f16)hi}; return __builtin_bit_cast(unsigned, v); }
__device__ __forceinline__ void row_info(int row, int& g, int& t, int& T) {
    if (row < M_CTX) { g = 0; t = row & (T_CTX - 1); T = T_CTX; }
    else { const int r = row - M_CTX; g = 1 + (r >> 10); t = r & (T_SMP - 1); T = T_SMP; }
}

struct Params {
    const float* in[28];
    float* out;
    unsigned char* ws;
};
struct DParams { GAS float* out; GAS unsigned char* ws; };
struct Ctx {
    LAS unsigned char* lds;
    int tid, lane, wave, gw, ngw, gt, ngt, bid;
};
__device__ __forceinline__ int lane_id() { int ln; asm volatile("v_mbcnt_lo_u32_b32 %0, -1, 0\n\tv_mbcnt_hi_u32_b32 %0, -1, %0" : "=v"(ln)); return ln; }
__device__ __forceinline__ const GAS float* inp(const Ctx& c, int i) {
    const unsigned long long v = ((const LAS unsigned long long*)(c.lds + PTAB_OFF))[i];
    const unsigned lo = __builtin_amdgcn_readfirstlane((unsigned)v), hi = __builtin_amdgcn_readfirstlane((unsigned)(v >> 32));
    return (const GAS float*)(((unsigned long long)hi << 32) | lo); }
#define IN(i) inp(c, (i))
#define FRESH_P(p0) DParams p; { float* o_ = (p0).out; unsigned char* w_ = (p0).ws; asm volatile("" : "+s"(o_), "+s"(w_)); p.out = (GAS float*)o_; p.ws = (GAS unsigned char*)w_; }
__device__ __forceinline__ Ctx fresh(const Ctx& c0) {
    Ctx c = c0; int w = c0.wave; asm volatile("" : "+s"(w)); int ln = lane_id(); asm volatile("" : "+v"(ln));
    int b = blockIdx.x; asm volatile("" : "+s"(b));
    c.wave = w; c.lane = ln; c.tid = w * 64 + ln; c.bid = b;
    c.gw = b * 8 + w; c.gt = b * 512 + c.tid; return c; }

__device__ __forceinline__ void conv_item(const GAS float* W, int N, GAS f16* WT, int ldt, int koff, LAS float* scr, int kb, int nb, int lane) {
    const int k0 = 64 * kb, n0 = 32 * nb;
#pragma unroll 8
    for (int i = 0; i < 32; ++i) { const int kk = 2 * i + (lane >> 5); scr[kk * 33 + (lane & 31)] = W[(size_t)(k0 + kk) * N + n0 + (lane & 31)]; }
    LDS_WAIT();
    const int c = lane & 7;
#pragma unroll
    for (int j = 0; j < 4; ++j) { const int n = (lane >> 3) + 8 * j; const LAS float* s = scr + (8 * c) * 33 + n;
        v4u o; o.x = pkh(s[0 * 33], s[1 * 33]); o.y = pkh(s[2 * 33], s[3 * 33]); o.z = pkh(s[4 * 33], s[5 * 33]); o.w = pkh(s[6 * 33], s[7 * 33]);
        *(GAS v4u*)(WT + (size_t)(n0 + n) * ldt + koff + k0 + 8 * c) = o; }
    LDS_WAIT();
}
__device__ __forceinline__ void conv_weights(const Params& p0, const Ctx& c0, int l) {
    const Ctx c = fresh(c0); FRESH_P(p0);
    LAS float* scr = (LAS float*)(c.lds + c.wave * 16384);
    GAS unsigned char* wb = p.ws + WS_W;
    GAS f16* WinT = (GAS f16*)(wb + WO_IN); GAS f16* WbrT = (GAS f16*)(wb + WO_BR); GAS f16* WoutT = (GAS f16*)(wb + WO_OUT); GAS f16* WupT = (GAS f16*)(wb + WO_UP); GAS f16* WdnT = (GAS f16*)(wb + WO_DN);
    GAS f16* WsmT = (GAS f16*)(wb + WO_SM); GAS f16* WgT = (GAS f16*)(wb + WO_G);
    const GAS float* w_in = IN(7) + (size_t)l * D * DIN; const GAS float* w_br = IN(8) + (size_t)l * 2 * CW * D; const GAS float* w_out = IN(9) + (size_t)l * D * D;
    const GAS float* w_up = IN(13) + (size_t)l * D * DFF; const GAS float* w_dn = IN(14) + (size_t)l * DFF * D;
    const GAS float* dec_up = IN(20) + (size_t)l * 2 * 64 * CW; const GAS float* icl_up = IN(22) + (size_t)l * 2 * 64 * CW; const GAS float* gate_up = IN(23) + (size_t)l * 128 * CW;
    constexpr int I0 = 16 * 144, I1 = 8 * 32, I2 = 8 * 32, I3 = 16 * 32, I4 = 16 * 128, I5 = 64 * 32, I6 = 16, I7 = 16, I8 = 16, I9 = 16, I10 = 2 * 16;
    constexpr int NIT = I0 + I1 + I2 + I3 + I4 + I5 + I6 + I7 + I8 + I9 + I10;
    for (int it = c.gw; it < NIT; it += c.ngw) {
        int r = it;
        if (r < I0) { conv_item(w_in, DIN, WinT, D, 0, scr, r / 144, r % 144, c.lane); continue; } r -= I0;
        if (r < I1) { conv_item(w_br, D, WbrT, D, 0, scr, r / 32, r % 32, c.lane); continue; } r -= I1;
        if (r < I2) { conv_item(w_br + (size_t)CW * D, D, WbrT, D, CW, scr, r / 32, r % 32, c.lane); continue; } r -= I2;
        if (r < I3) { conv_item(w_out, D, WoutT, D, 0, scr, r / 32, r % 32, c.lane); continue; } r -= I3;
        if (r < I4) { conv_item(w_up, DFF, WupT, D, 0, scr, r / 128, r % 128, c.lane); continue; } r -= I4;
        if (r < I5) { conv_item(w_dn, D, WdnT, DFF, 0, scr, r / 32, r % 32, c.lane); continue; } r -= I5;
        if (r < I6) { conv_item(dec_up, CW, WsmT, 128, 0, scr, 0, r, c.lane); continue; } r -= I6;
        if (r < I7) { conv_item(dec_up + 64 * CW, CW, WsmT + (size_t)512 * 128, 128, 0, scr, 0, r, c.lane); continue; } r -= I7;
        if (r < I8) { conv_item(icl_up, CW, WsmT + (size_t)1024 * 128, 128, 64, scr, 0, r, c.lane); continue; } r -= I8;
        if (r < I9) { conv_item(icl_up + 64 * CW, CW, WsmT + (size_t)1536 * 128, 128, 64, scr, 0, r, c.lane); continue; } r -= I9;
        conv_item(gate_up, CW, WgT, 128, 0, scr, r / 16, r % 16, c.lane);
    }
    unsigned zz_ = 0u; asm volatile("" : "+v"(zz_));
    for (int i = c.gt; i < 2048 * 8; i += c.ngt) { const int row = i >> 3, ch = i & 7; const int col = (row < 1024 ? 64 : 0) + ch * 8;
        *(GAS v4u*)(WsmT + (size_t)row * 128 + col) = (v4u){zz_, zz_, zz_, zz_}; }
}

__device__ __forceinline__ void mod_phase(const Params& p0, const Ctx& c0) {
    const Ctx c = fresh(c0); FRESH_P(p0);
    LAS float* sl = (LAS float*)(c.lds);
    LAS float* part = (LAS float*)(c.lds + 32768);
    GAS float* mod = (GAS float*)(p.ws + WS_MOD);
    for (int i = c.tid; i < 5 * D; i += NTHREADS) { const int g = i >> 10, k = i & 1023; const float v = g == 0 ? IN(6)[k] : IN(5)[(g - 1) * D + k]; sl[i] = v / (1.0f + __expf(-v)); }
    __syncthreads();
    for (int it = c.bid; it < NL * (NMOD / 64) * 4; it += gridDim.x) {
        const int kq = it & 3, lc = it >> 2, l = lc / (NMOD / 64), cc = lc % (NMOD / 64);
        const int kb = kq * 256 + c.wave * 32;
        const GAS float* w = IN(10) + (size_t)l * D * NMOD + (size_t)kb * NMOD + cc * 64 + c.lane;
        float a0 = 0.f, a1 = 0.f, a2 = 0.f, a3 = 0.f, a4 = 0.f;
        float wv[32];
#pragma unroll
        for (int k = 0; k < 32; ++k) wv[k] = w[(size_t)k * NMOD];
#pragma unroll
        for (int k = 0; k < 32; ++k) { a0 += sl[kb + k] * wv[k]; a1 += sl[D + kb + k] * wv[k]; a2 += sl[2 * D + kb + k] * wv[k]; a3 += sl[3 * D + kb + k] * wv[k]; a4 += sl[4 * D + kb + k] * wv[k]; }
        LAS float* pw = part + c.wave * 320 + c.lane;
        pw[0] = a0; pw[64] = a1; pw[128] = a2; pw[192] = a3; pw[256] = a4;
        __syncthreads();
        if (c.tid < 320) { float s = 0.f;
#pragma unroll
            for (int w8 = 0; w8 < 8; ++w8) s += part[w8 * 320 + c.tid];
            const int g = c.tid >> 6, col = cc * 64 + (c.tid & 63);
            if (kq == 0) s += IN(11)[(size_t)l * NMOD + col];
            atomicAdd((float*)(mod + ((size_t)l * 5 + g) * NMOD + col), s); }
        __syncthreads();
    }
}

template <int MODE, int NB>
__device__ __forceinline__ void norm_rows(const DParams& p, const Ctx& c, int l, int row_first, int row_end, int row_step) {
    GAS float* X = p.out; const GAS f16* MO = (const GAS f16*)(p.ws + WS_R2); GAS f16* H = (GAS f16*)(p.ws + WS_R4);
    const GAS float* modb = (const GAS float*)(p.ws + WS_MOD);
    const GAS float* in0 = IN(0); const GAS float* in1 = IN(1); const GAS float* ngb = IN(12);
    for (int rowb = row_first; rowb < row_end; rowb += NB * row_step) {
        f32x4 x[NB][4]; f16x4 mh[NB][4];
#pragma unroll
        for (int b = 0; b < NB; ++b) { const int row = rowb + b * row_step;
            if (row < row_end) {
                if (MODE == 0) { const GAS float* src = row < M_CTX ? in0 + (size_t)row * D : in1 + (size_t)(row - M_CTX) * D;
#pragma unroll
                    for (int j = 0; j < 4; ++j) x[b][j] = __builtin_nontemporal_load((const GAS f32x4*)(src + 256 * j + 4 * c.lane)); }
                else { const GAS float* xs = (MODE == 1 && l == 0) ? (row < M_CTX ? in0 + (size_t)row * D : in1 + (size_t)(row - M_CTX) * D) : X + (size_t)row * D;
#pragma unroll
                    for (int j = 0; j < 4; ++j) { x[b][j] = __builtin_nontemporal_load((const GAS f32x4*)(xs + 256 * j + 4 * c.lane));
                        mh[b][j] = __builtin_nontemporal_load((const GAS f16x4*)(MO + (size_t)row * D + 256 * j + 4 * c.lane)); } } } }
#pragma unroll
        for (int b = 0; b < NB; ++b) { const int row = rowb + b * row_step;
            if (row < row_end) {
                int g, t, T; row_info(row, g, t, T);
                if (MODE != 0) {
                    const GAS float* mo_mod = modb + ((size_t)l * 5 + g) * NMOD + (MODE == 1 ? 2 * D : 5 * D);
                    const GAS float* ngp = ngb + ((size_t)l * 4 + (MODE == 1 ? 1 : 3)) * D;
                    float mv[4][4]; float ss = 0.f;
#pragma unroll
                    for (int j = 0; j < 4; ++j)
#pragma unroll
                        for (int e = 0; e < 4; ++e) { mv[j][e] = (float)mh[b][j][e]; ss += mv[j][e] * mv[j][e]; }
                    const float rstd = rsqrtf(wave_sum(ss) * (1.0f / D) + 1e-6f);
#pragma unroll
                    for (int j = 0; j < 4; ++j) { const f32x4 gg = *(const GAS f32x4*)(mo_mod + 256 * j + 4 * c.lane); const f32x4 nn = *(const GAS f32x4*)(ngp + 256 * j + 4 * c.lane);
#pragma unroll
                        for (int e = 0; e < 4; ++e) x[b][j][e] += gg[e] * (mv[j][e] * rstd * nn[e]); }
                }
                const int ln = MODE == 2 ? l + 1 : l;
                if (ln < NL) {
                    const GAS float* mb = modb + ((size_t)ln * 5 + g) * NMOD + (MODE == 1 ? 3 * D : 0);
                    const GAS float* ngp = ngb + ((size_t)ln * 4 + (MODE == 1 ? 2 : 0)) * D;
                    float ss = 0.f;
#pragma unroll
                    for (int j = 0; j < 4; ++j) ss += (x[b][j][0] * x[b][j][0] + x[b][j][1] * x[b][j][1]) + (x[b][j][2] * x[b][j][2] + x[b][j][3] * x[b][j][3]);
                    const float rstd = rsqrtf(wave_sum(ss) * (1.0f / D) + 1e-6f);
#pragma unroll
                    for (int j = 0; j < 4; ++j) { const f32x4 sh = *(const GAS f32x4*)(mb + 256 * j + 4 * c.lane); const f32x4 sc = *(const GAS f32x4*)(mb + D + 256 * j + 4 * c.lane);
                        const f32x4 nn = *(const GAS f32x4*)(ngp + 256 * j + 4 * c.lane);
                        float o[4];
#pragma unroll
                        for (int e = 0; e < 4; ++e) o[e] = x[b][j][e] * rstd * nn[e] * (1.0f + sc[e]) + sh[e];
                        v2u w; w.x = pkh(o[0], o[1]); w.y = pkh(o[2], o[3]);
                        *(GAS v2u*)(H + (size_t)row * D + 256 * j + 4 * c.lane) = w; }
                }
                if (MODE != 0) {
#pragma unroll
                for (int j = 0; j < 4; ++j) __builtin_nontemporal_store(x[b][j], (GAS f32x4*)(X + (size_t)row * D + 256 * j + 4 * c.lane)); }
            } }
    }
}
template <int MODE>
__device__ __forceinline__ void norm_phase(const Params& p0, const Ctx& c0, int l) {
    const Ctx c = fresh(c0); FRESH_P(p0);
    norm_rows<MODE, 6>(p, c, l, c.gw, M, c.ngw);
}

namespace pg8 {
constexpr int BM = 256, BK = 64, HALF = 128, HTB = HALF * BK * 2, STAGE_BYTES = 8 * HTB, NXCD = 8, WGM = 8;
__host__ __device__ __forceinline__ int lds_byte(int r, int c) { const int st = (r >> 4) * 2 + (c >> 5), rr = r & 15, cc = c & 31, ob = rr * 64 + cc * 2; return st * 1024 + (ob ^ (((ob >> 9) & 1) << 5)); }
__host__ __device__ __forceinline__ void stage_rc(int b, int& R, int& C) { const int st = b / 1024, sb = b % 1024, swz = sb ^ (((sb >> 9) & 1) << 5); R = (st >> 1) * 16 + swz / 64; C = (st & 1) * 32 + (swz % 64) / 2; }
__host__ __device__ __forceinline__ int perm32(int rho) { const int n = rho >> 4, i = rho & 15; return 8 * (i >> 2) + 4 * n + (i & 3); }
struct Unit { int pm, pn; };
struct Gemm { const GAS f16* A; const GAS f16* Bt; int lda, ldb, K; };
struct StaticOrder {
    int nM, nN, nwg, G, c;
    __device__ void init(int Mr, int N, int G_, int c_, int bm = BM) { nM = Mr / bm; nN = N / BM; nwg = nM * nN; G = G_; c = c_; }
    __device__ bool next(int i, Unit& u) const {
        const long L = (long)i * G + c; if (c < 0 || L >= nwg) return false;
        int wgid = (int)L; { const int q = nwg / NXCD, r = nwg % NXCD, xcd = wgid % NXCD, off = wgid / NXCD; wgid = (xcd < r ? xcd * (q + 1) : r * (q + 1) + (xcd - r) * q) + off; }
        const int nig = WGM * nN, gid = wgid / nig, fm = gid * WGM, gsz = (nM - fm) < WGM ? (nM - fm) : WGM;
        u.pm = fm + ((wgid % nig) % gsz); u.pn = (wgid % nig) / gsz; return true;
    }
};
template <class Epi, int HA = 128, bool ALIGN_EPI = true, bool SP2 = true>
__device__ __forceinline__ void gemm_phase(LAS unsigned char* lds, const Gemm g, const StaticOrder& S, const Epi& E, int wave_sgpr) {
    asm volatile("" : "+s"(wave_sgpr)); int tid = wave_sgpr * 64 + lane_id(); asm volatile("" : "+v"(tid));
    const int wid = __builtin_amdgcn_readfirstlane(tid >> 6), lane = tid & 63, wr = wid >> 2, wc = wid & 3, fr = lane & 15, fq = lane >> 4;
    const int K = g.K, nt = K / BK;
    unsigned voffA[2], voffB[2];
#pragma unroll
    for (int i = 0; i < 2; ++i) { int R, C; stage_rc(tid * 16 + i * 8192, R, C); const int Rb = (R & ~31) + perm32(R & 31);
        voffA[i] = (unsigned)(R * g.lda + C) * 2u; voffB[i] = (unsigned)(Rb * g.ldb + C) * 2u; }
    const unsigned kstep = (unsigned)(BK * 2);
    constexpr int MF = HA / 32;
    const unsigned hstepA = (unsigned)HA * g.lda * 2, hstepB = (unsigned)HALF * g.ldb * 2;
    const unsigned tstepA = 2 * hstepA, tstepB = 2 * hstepB;
    const unsigned ldsw = (unsigned)wid * 1024u;
    const int aoff = lds_byte(wr * (HA / 2) + fr, fq * 8), boff = lds_byte(wc * 32 + fr, fq * 8);
#define PG8_SA(b, h) (((b) * 2 + (h)) * HTB)
#define PG8_SB(b, h) ((4 + (b) * 2 + (h)) * HTB)
#define PG8_STAGE(bufoff, gbase, soff, voff) do { _Pragma("unroll") for (int _i = 0; _i < 2; ++_i) \
        __builtin_amdgcn_raw_ptr_buffer_load_lds(rs##gbase, (LAS unsigned*)(lds + (bufoff) + ldsw + _i * 8192), 16, (voff)[_i], (int)(soff), 0, 0); } while (0)
#define PG8_LDA(dst, b, h) do { _Pragma("unroll") for (int m = 0; m < MF; ++m) _Pragma("unroll") for (int k = 0; k < 2; ++k) dst[m][k] = *(const LAS f16x8*)(lds + PG8_SA(b, h) + aoff + m * 2048 + k * 1024); } while (0)
#define PG8_LDB(dst, b, h) do { _Pragma("unroll") for (int n = 0; n < 2; ++n) _Pragma("unroll") for (int k = 0; k < 2; ++k) dst[n][k] = *(const LAS f16x8*)(lds + PG8_SB(b, h) + boff + n * 2048 + k * 1024); } while (0)
#define PG8_MMA(ai, bj, At, Bt) do { __builtin_amdgcn_s_setprio(1); _Pragma("unroll") for (int m = 0; m < MF; ++m) _Pragma("unroll") for (int n = 0; n < 2; ++n) _Pragma("unroll") for (int k = 0; k < 2; ++k) \
        acc[ai][bj][m][n] = __builtin_amdgcn_mfma_f32_16x16x32_f16(Bt[n][k], At[m][k], acc[ai][bj][m][n], 0, 0, 0); __builtin_amdgcn_s_setprio(0); } while (0)
#define PG8_WAIT_V(n) asm volatile("s_waitcnt vmcnt(" #n ")" ::: "memory")
#define PG8_WAIT_L(n) asm volatile("s_waitcnt lgkmcnt(" #n ")" ::: "memory")
#define PG8_BAR __builtin_amdgcn_s_barrier()
#define PG8_SCHED __builtin_amdgcn_sched_barrier(0)
    Unit cur, nxt; int ui = 0;
    if (!S.next(0, cur)) return;
    f32x4 acc[2][2][4][2];
#pragma unroll
    for (int a = 0; a < 2; ++a)
#pragma unroll
        for (int b = 0; b < 2; ++b)
#pragma unroll
            for (int m = 0; m < 4; ++m)
#pragma unroll
                for (int n = 0; n < 2; ++n) acc[a][b][m][n] = (f32x4){0.f, 0.f, 0.f, 0.f};
    f16x8 At[4][2], B0[2][2], B1[2][2];
    const auto rsA = __builtin_amdgcn_make_buffer_rsrc((GAS void*)g.A, 0, 0x7fffffff, 0x00020000); const auto rsB = __builtin_amdgcn_make_buffer_rsrc((GAS void*)g.Bt, 0, 0x7fffffff, 0x00020000);
    unsigned cA = (unsigned)cur.pm * tstepA, cB = (unsigned)cur.pn * tstepB;
    if constexpr (SP2) {
        PG8_STAGE(PG8_SB(0, 0), B, cB, voffB); PG8_STAGE(PG8_SB(0, 1), B, cB + hstepB, voffB); PG8_STAGE(PG8_SA(0, 0), A, cA, voffA); PG8_STAGE(PG8_SA(0, 1), A, cA + hstepA, voffA);
        if (wr == 1) PG8_BAR;
        PG8_WAIT_V(2); PG8_BAR;
        PG8_STAGE(PG8_SB(1, 0), B, cB + kstep, voffB); PG8_STAGE(PG8_SA(1, 0), A, cA + kstep, voffA); PG8_STAGE(PG8_SB(1, 1), B, cB + hstepB + kstep, voffB);
        PG8_WAIT_V(6); PG8_BAR;
    } else {
        PG8_STAGE(PG8_SB(0, 0), B, cB, voffB); PG8_STAGE(PG8_SA(0, 0), A, cA, voffA); PG8_STAGE(PG8_SB(0, 1), B, cB + hstepB, voffB); PG8_STAGE(PG8_SA(0, 1), A, cA + hstepA, voffA);
        if (wr == 1) PG8_BAR;
        PG8_WAIT_V(4); PG8_BAR;
        PG8_STAGE(PG8_SB(1, 0), B, cB + kstep, voffB); PG8_STAGE(PG8_SA(1, 0), A, cA + kstep, voffA); PG8_STAGE(PG8_SB(1, 1), B, cB + hstepB + kstep, voffB);
        PG8_WAIT_V(6); PG8_BAR;
    }
    for (;;) {
        const bool has_next = S.next(ui + 1, nxt);
        const unsigned nA = has_next ? (unsigned)nxt.pm * tstepA : cA, nB = has_next ? (unsigned)nxt.pn * tstepB : cB;
        for (int t = 0; t < nt; t += 2) {
            if constexpr (Epi::MID_T >= 0) { if (t == Epi::MID_T) { const int ln3 = lane_id(); E.template mid<HA>(acc, cur, wr, wc, ln3 & 15, ln3 >> 4); } }
            const bool last = (t == nt - 2);
            const unsigned a1 = cA + (unsigned)(t + 1) * kstep;
            const unsigned a2 = last ? nA : cA + (unsigned)(t + 2) * kstep, b2 = last ? nB : cB + (unsigned)(t + 2) * kstep;
            const unsigned a3 = a2 + kstep, b3 = b2 + kstep;
            if constexpr (SP2) {
            PG8_LDB(B0, 0, 0); PG8_LDB(B1, 0, 1); PG8_SCHED; PG8_LDA(At, 0, 0); PG8_STAGE(PG8_SA(1, 1), A, a1 + hstepA, voffA);
            PG8_WAIT_V(8); PG8_WAIT_L(0); PG8_BAR; PG8_MMA(0, 0, At, B0); PG8_MMA(0, 1, At, B1); PG8_BAR; PG8_SCHED;
            PG8_LDA(At, 0, 1); PG8_STAGE(PG8_SB(0, 0), B, b2, voffB); PG8_STAGE(PG8_SB(0, 1), B, b2 + hstepB, voffB); PG8_STAGE(PG8_SA(0, 0), A, a2, voffA);
            PG8_WAIT_V(8); PG8_WAIT_L(0); PG8_BAR; PG8_MMA(1, 0, At, B0); PG8_MMA(1, 1, At, B1); PG8_BAR; PG8_SCHED;
            PG8_LDB(B0, 1, 0); PG8_LDB(B1, 1, 1); PG8_SCHED; PG8_LDA(At, 1, 0); PG8_STAGE(PG8_SA(0, 1), A, a2 + hstepA, voffA);
            PG8_WAIT_V(8); PG8_WAIT_L(0); PG8_BAR; PG8_MMA(0, 0, At, B0); PG8_MMA(0, 1, At, B1); PG8_BAR; PG8_SCHED;
            PG8_LDA(At, 1, 1); PG8_STAGE(PG8_SB(1, 0), B, b3, voffB); PG8_STAGE(PG8_SB(1, 1), B, b3 + hstepB, voffB); PG8_STAGE(PG8_SA(1, 0), A, a3, voffA);
            PG8_WAIT_V(8); PG8_WAIT_L(0); PG8_BAR; PG8_MMA(1, 0, At, B0); PG8_MMA(1, 1, At, B1); PG8_BAR; PG8_SCHED;
            } else {
            PG8_LDB(B0, 0, 0); PG8_SCHED; PG8_LDA(At, 0, 0); PG8_STAGE(PG8_SA(1, 1), A, a1 + hstepA, voffA);
            PG8_WAIT_L(8); PG8_BAR; PG8_WAIT_L(0); PG8_MMA(0, 0, At, B0); PG8_BAR; PG8_SCHED;
            PG8_LDB(B1, 0, 1); PG8_STAGE(PG8_SB(0, 0), B, b2, voffB);
            PG8_BAR; PG8_WAIT_L(0); PG8_MMA(0, 1, At, B1); PG8_BAR;
            PG8_LDA(At, 0, 1); PG8_STAGE(PG8_SA(0, 0), A, a2, voffA);
            PG8_BAR; PG8_WAIT_L(0); PG8_MMA(1, 0, At, B0); PG8_BAR; PG8_SCHED;
            PG8_STAGE(PG8_SB(0, 1), B, b2 + hstepB, voffB);
            PG8_WAIT_V(6); PG8_BAR; PG8_MMA(1, 1, At, B1); PG8_BAR;
            PG8_LDB(B0, 1, 0); PG8_SCHED; PG8_LDA(At, 1, 0); PG8_STAGE(PG8_SA(0, 1), A, a2 + hstepA, voffA);
            PG8_WAIT_L(8); PG8_BAR; PG8_WAIT_L(0); PG8_MMA(0, 0, At, B0); PG8_BAR; PG8_SCHED;
            PG8_LDB(B1, 1, 1); PG8_STAGE(PG8_SB(1, 0), B, b3, voffB);
            PG8_BAR; PG8_WAIT_L(0); PG8_MMA(0, 1, At, B1); PG8_BAR;
            PG8_LDA(At, 1, 1); PG8_STAGE(PG8_SA(1, 0), A, a3, voffA);
            PG8_BAR; PG8_WAIT_L(0); PG8_MMA(1, 0, At, B0); PG8_BAR; PG8_SCHED;
            PG8_STAGE(PG8_SB(1, 1), B, b3 + hstepB, voffB);
            PG8_WAIT_V(6); PG8_BAR; PG8_MMA(1, 1, At, B1); PG8_BAR;
            }
        }
        if constexpr (ALIGN_EPI) { if (wr == 0) PG8_BAR; }
        { const int ln2 = lane_id(); E.template run<HA>(acc, cur, wr, wc, ln2 & 15, ln2 >> 4); }
        if (!has_next) break;
#pragma unroll
        for (int a = 0; a < 2; ++a)
#pragma unroll
            for (int b = 0; b < 2; ++b)
#pragma unroll
                for (int m = 0; m < 4; ++m)
#pragma unroll
                    for (int n = 0; n < 2; ++n) acc[a][b][m][n] = (f32x4){0.f, 0.f, 0.f, 0.f};
        cur = nxt; cA = nA; cB = nB; ++ui;
        if constexpr (ALIGN_EPI) { if (wr == 1) PG8_BAR; }
    }
    PG8_WAIT_V(0);
    if constexpr (!ALIGN_EPI) { if (wr == 0) PG8_BAR; }
    PG8_BAR;
#undef PG8_SA
#undef PG8_SB
#undef PG8_STAGE
#undef PG8_LDA
#undef PG8_LDB
#undef PG8_MMA
#undef PG8_WAIT_V
#undef PG8_WAIT_L
#undef PG8_BAR
#undef PG8_SCHED
}
typedef f32x4 Acc[2][2][4][2];
#define PG8_EPI_LOOP(...) \
    const int row0 = u.pm * (2 * HA) + wr * (HA / 2) + fr, col0 = u.pn * BM + wc * 32 + 8 * fq; \
    _Pragma("unroll") for (int ai = 0; ai < 2; ++ai) _Pragma("unroll") for (int m = 0; m < HA / 32; ++m) { const int row = row0 + ai * HA + m * 16; \
        _Pragma("unroll") for (int bj = 0; bj < 2; ++bj) { const int col = col0 + bj * HALF; f32x4 v0 = acc[ai][bj][m][0], v1 = acc[ai][bj][m][1]; __VA_ARGS__ } asm volatile("" ::: "memory"); }
__device__ __forceinline__ void store8(GAS f16* p, f32x4 v0, f32x4 v1) { v4u w; w.x = pkh(v0[0], v0[1]); w.y = pkh(v0[2], v0[3]); w.z = pkh(v1[0], v1[1]); w.w = pkh(v1[2], v1[3]); *(GAS v4u*)p = w; }
struct EpiProjF { static constexpr int MID_T = -1; GAS f16* P;
    template <int HA> __device__ __forceinline__ void run(const Acc& acc, const Unit& u, int wr, int wc, int fr, int fq) const {
        PG8_EPI_LOOP(
            if (u.pn == 6) {
                if (col < PC_LA) { _Pragma("unroll") for (int e = 0; e < 4; ++e) { v0[e] = tanhf_(v0[e]); v1[e] = tanhf_(v1[e]); } }
                else if (col >= PC_LG) { _Pragma("unroll") for (int e = 0; e < 4; ++e) { v0[e] = sigmoidf_(v0[e]); v1[e] = sigmoidf_(v1[e]); } }
            } else if (u.pn >= 10) { _Pragma("unroll") for (int e = 0; e < 4; ++e) { v0[e] = sigmoidf_(v0[e]); v1[e] = sigmoidf_(v1[e]); } }
            store8(P + (size_t)row * DIN + col, v0, v1);
        )
    } };
#define DPPM(x, ctrl) (x) *= __builtin_bit_cast(float, __builtin_amdgcn_update_dpp(0x3f800000, __builtin_bit_cast(int, (x)), (ctrl), 0xF, 0xF, false))
struct EpiWAF { static constexpr int MID_T = -1; GAS f16* WA; const GAS float* w0; const GAS float* a0;
    template <int HA> __device__ __forceinline__ void run(const Acc& acc, const Unit& u, int wr, int wc, int fr, int fq) const {
        PG8_EPI_LOOP(
            if (col < 1024) { const f32x4 b0 = *(const GAS f32x4*)(w0 + col), b1 = *(const GAS f32x4*)(w0 + col + 4);
                float x[8];
                _Pragma("unroll") for (int e = 0; e < 4; ++e) { x[e] = __expf(-0.606531f * sigmoidf_(v0[e] + b0[e])); x[4 + e] = __expf(-0.606531f * sigmoidf_(v1[e] + b1[e])); }
                if (col < 512) {
                    _Pragma("unroll") for (int e = 0; e < 8; ++e) { DPPM(x[e], 0x111); DPPM(x[e], 0x112); DPPM(x[e], 0x114); DPPM(x[e], 0x118);
                        const float wm = __builtin_bit_cast(float, __builtin_amdgcn_ds_swizzle(__builtin_bit_cast(int, x[e]), 0x00F0)); x[e] = (fr == 7) ? wm : x[e] * __builtin_amdgcn_rcpf(wm); }
                } else {
                    _Pragma("unroll") for (int e = 0; e < 8; ++e) { DPPM(x[e], 0x101); DPPM(x[e], 0x102); DPPM(x[e], 0x104); DPPM(x[e], 0x108);
                        const float wm = __builtin_bit_cast(float, __builtin_amdgcn_ds_swizzle(__builtin_bit_cast(int, x[e]), 0x0110)); x[e] = (fr == 8) ? wm : x[e] * __builtin_amdgcn_rcpf(wm); }
                }
                _Pragma("unroll") for (int e = 0; e < 4; ++e) { v0[e] = x[e]; v1[e] = x[4 + e]; } }
            else { const f32x4 b0 = *(const GAS f32x4*)(a0 + col - 1024), b1 = *(const GAS f32x4*)(a0 + col - 1024 + 4);
                _Pragma("unroll") for (int e = 0; e < 4; ++e) { v0[e] = sigmoidf_(v0[e] + b0[e]); v1[e] = sigmoidf_(v1[e] + b1[e]); } }
            store8(WA + (size_t)row * 2048 + col, v0, v1);
        )
    } };
struct EpiF16F { static constexpr int MID_T = -1; GAS f16* O; int ld;
    template <int HA> __device__ __forceinline__ void run(const Acc& acc, const Unit& u, int wr, int wc, int fr, int fq) const {
        PG8_EPI_LOOP( store8(O + (size_t)row * ld + col, v0, v1); )
    } };
struct EpiRelu2F { static constexpr int MID_T = -1; GAS f16* O; int ld;
    template <int HA> __device__ __forceinline__ void run(const Acc& acc, const Unit& u, int wr, int wc, int fr, int fq) const {
        PG8_EPI_LOOP(
            _Pragma("unroll") for (int e = 0; e < 4; ++e) { const float a = fmaxf(v0[e], 0.f), b = fmaxf(v1[e], 0.f); v0[e] = a * a; v1[e] = b * b; }
            store8(O + (size_t)row * ld + col, v0, v1);
        )
    } };
struct EpiMergeF { static constexpr int MID_T = 8; GAS f16* MG; const GAS f16* PROJ;
    template <int HA> __device__ __forceinline__ void mid(Acc& acc, const Unit& u, int wr, int wc, int fr, int fq) const {
        const int row0 = u.pm * (2 * HA) + wr * (HA / 2) + fr, col0 = u.pn * BM + wc * 32 + 8 * fq;
#pragma unroll
        for (int ai = 0; ai < 2; ++ai)
#pragma unroll
            for (int m = 0; m < HA / 32; ++m) { const int row = row0 + ai * HA + m * 16;
#pragma unroll
                for (int bj = 0; bj < 2; ++bj) { const int col = col0 + bj * HALF;
                    const f16x8 gr = *(const GAS f16x8*)(PROJ + (size_t)row * DIN + PC_GR + col), ga = *(const GAS f16x8*)(PROJ + (size_t)row * DIN + PC_GA + col);
#pragma unroll
                    for (int e = 0; e < 4; ++e) { acc[ai][bj][m][0][e] *= (float)gr[e] * __builtin_amdgcn_rcpf(fmaxf((float)ga[e], 1e-4f)); acc[ai][bj][m][1][e] *= (float)gr[4 + e] * __builtin_amdgcn_rcpf(fmaxf((float)ga[4 + e], 1e-4f)); } }
                asm volatile("" ::: "memory"); }
    }
    template <int HA> __device__ __forceinline__ void run(const Acc& acc, const Unit& u, int wr, int wc, int fr, int fq) const {
        PG8_EPI_LOOP(
            const f16x8 ga = *(const GAS f16x8*)(PROJ + (size_t)row * DIN + PC_GA + col);
            _Pragma("unroll") for (int e = 0; e < 4; ++e) { v0[e] *= fmaxf((float)ga[e], 1e-4f); v1[e] *= fmaxf((float)ga[4 + e], 1e-4f); }
            store8(MG + (size_t)row * D + col, v0, v1);
        )
    } };
}

__device__ __forceinline__ void kv_prep(const Params& p0, const Ctx& c0, int l) {
    const Ctx c = fresh(c0); FRESH_P(p0);
    const GAS f16* PROJ = (const GAS f16*)(p.ws + WS_R1); GAS f16* KN = (GAS f16*)(p.ws + WS_KN); GAS f16* VT = (GAS f16*)(p.ws + WS_VT);
    const int d = c.lane;
    const float kg = IN(27)[l * HD + d];
    const int axis = d >> 5, half = (d >> 4) & 1, f = d & 15;
    const float freq = exp2f(-(float)f * (13.287712379549449f / 16.0f));
    for (int it = c.gw; it < (M / 8) * 2; it += c.ngw) {
        const int kvh = it & 1, row0 = (it >> 1) * 8;
        float kx[8], vx[8];
#pragma unroll
        for (int r = 0; r < 8; ++r) { const GAS f16* pr = PROJ + (size_t)(row0 + r) * DIN + kvh * HD + d; kx[r] = (float)pr[PC_KA]; vx[r] = (float)pr[PC_VA]; }
#pragma unroll
        for (int r = 0; r < 8; ++r) kx[r] = kx[r] * rsqrtf(wave_sum(kx[r] * kx[r]) * (1.0f / HD) + 1e-6f) * kg;
        f16x8 vv;
#pragma unroll
        for (int r = 0; r < 8; ++r) vv[r] = (f16)vx[r];
        if (row0 < M_CTX) { const int b = row0 >> 8, t0 = row0 & 255;
#pragma unroll
            for (int r = 0; r < 8; ++r) { const size_t o = ((((size_t)b * NL + l) * T_CTX + t0 + r) * 2 + kvh) * HD + d;
                p.out[O_CK + o] = kx[r]; p.out[O_CV + o] = vx[r];
                KN[(((size_t)b * 2 + kvh) * T_CTX + t0 + r) * HD + d] = (f16)kx[r]; }
            *(GAS f16x8*)(VT + (((size_t)b * 2 + kvh) * HD + d) * T_CTX + t0) = vv;
        } else { const int rr = row0 - M_CTX, b = rr >> 10, t0 = rr & 1023;
#pragma unroll
            for (int r = 0; r < 8; ++r) { const int t = t0 + r; const float pos = (float)(axis == 0 ? (t >> 6) : (t & 63));
                const float ang = pos * freq; const float cs = __cosf(ang), sn = __sinf(ang);
                const float other = xor16(kx[r]);
                const float ko = half == 0 ? kx[r] * cs - other * sn : kx[r] * cs + other * sn;
                KN[KN_SMP_OFF + (((size_t)b * 2 + kvh) * KV_SMP + PAST + t) * HD + d] = (f16)ko; }
            *(GAS f16x8*)(VT + KN_SMP_OFF + (((size_t)b * 2 + kvh) * HD + d) * KV_SMP + PAST + t0) = vv;
        }
    }
    for (int it = c.gw; it < B_SMP * (PAST / 8) * 2; it += c.ngw) {
        const int kvh = it & 1, j0 = ((it >> 1) & 31) * 8, b = it >> 6;
        f16x8 vv;
#pragma unroll
        for (int r = 0; r < 8; ++r) { const size_t s = ((((size_t)b * NL + l) * PAST + j0 + r) * 2 + kvh) * HD + d;
            KN[KN_SMP_OFF + (((size_t)b * 2 + kvh) * KV_SMP + j0 + r) * HD + d] = (f16)IN(2)[s]; vv[r] = (f16)IN(3)[s]; }
        *(GAS f16x8*)(VT + KN_SMP_OFF + (((size_t)b * 2 + kvh) * HD + d) * KV_SMP + j0) = vv;
    }
}

constexpr int TC = 32, ST_STEP = 6 * 64, ST_BUF = TC * ST_STEP;
struct StageRegs { f16x4 r[3], k[3], v[3], w, a; };
__device__ __forceinline__ void scan_task(const DParams& p, const Ctx& c, int l, int task) {
    const GAS f16* PROJ = (const GAS f16*)(p.ws + WS_R1); const GAS f16* WA = (const GAS f16*)(p.ws + WS_R2);
    GAS f16* Y = (GAS f16*)(p.ws + WS_R3); GAS float* RK = (GAS float*)(p.ws + WS_RK);
    LAS float* st = (LAS float*)c.lds;
    int sq, dir, h;
    if (task < 64) { h = task & 7; dir = (task >> 3) & 1; sq = B_CTX + (task >> 4); } else { const int id = task - 64; h = id & 7; dir = (id >> 3) & 1; sq = id >> 4; }
    const bool smp = sq >= B_CTX; const int T = smp ? T_SMP : T_CTX; const int row0 = smp ? M_CTX + (sq - B_CTX) * T_SMP : sq * T_CTX;
    const int nch = T / TC;
    const int tt = c.tid >> 4, cq = c.tid & 15, ch0 = h * HD + cq * 4;
    const f32x4 mu_r = *(const GAS f32x4*)(IN(15) + (l * 3 + 0) * CW + ch0), mu_k = *(const GAS f32x4*)(IN(15) + (l * 3 + 1) * CW + ch0), mu_v = *(const GAS f32x4*)(IN(15) + (l * 3 + 2) * CW + ch0);
    const f32x4 k_k = *(const GAS f32x4*)(IN(16) + l * CW + ch0), k_a = *(const GAS f32x4*)(IN(17) + l * CW + ch0), r_k = *(const GAS f32x4*)(IN(18) + l * CW + ch0);
    const int ks = c.lane & 7, srow = c.wave * 8 + (c.lane >> 3);
    float S[8];
    if (smp) { const GAS float* s0 = IN(4) + (((((size_t)(sq - B_CTX) * NL + l) * 2 + dir) * NH + h) * HD + srow) * HD + ks * 8;
        const f32x4 a = *(const GAS f32x4*)s0, b = *(const GAS f32x4*)(s0 + 4);
        S[0] = a[0]; S[1] = a[1]; S[2] = a[2]; S[3] = a[3]; S[4] = b[0]; S[5] = b[1]; S[6] = b[2]; S[7] = b[3];
    } else {
#pragma unroll
        for (int j = 0; j < 8; ++j) S[j] = 0.f;
    }
    StageRegs sr;
    const f16x4 z4 = {(f16)0.f, (f16)0.f, (f16)0.f, (f16)0.f};
#define SCAN_LOAD(chunk) do { const int S_ = (chunk) * TC + tt; const int t_ = dir ? T - 1 - S_ : S_; const GAS f16* pr_ = PROJ + (size_t)(row0 + t_) * DIN + ch0; \
        sr.r[1] = *(const GAS f16x4*)(pr_ + PC_R); sr.k[1] = *(const GAS f16x4*)(pr_ + PC_K); sr.v[1] = *(const GAS f16x4*)(pr_ + PC_V); \
        if (t_ > 0) { sr.r[0] = *(const GAS f16x4*)(pr_ - DIN + PC_R); sr.k[0] = *(const GAS f16x4*)(pr_ - DIN + PC_K); sr.v[0] = *(const GAS f16x4*)(pr_ - DIN + PC_V); } else { sr.r[0] = z4; sr.k[0] = z4; sr.v[0] = z4; } \
        if (t_ < T - 1) { sr.r[2] = *(const GAS f16x4*)(pr_ + DIN + PC_R); sr.k[2] = *(const GAS f16x4*)(pr_ + DIN + PC_K); sr.v[2] = *(const GAS f16x4*)(pr_ + DIN + PC_V); } else { sr.r[2] = z4; sr.k[2] = z4; sr.v[2] = z4; } \
        const GAS f16* wa_ = WA + (size_t)(row0 + t_) * 2048 + dir * 512 + ch0; sr.w = *(const GAS f16x4*)wa_; sr.a = *(const GAS f16x4*)(wa_ + 1024); } while (0)
#define SCAN_STAGE(chunk) do { const int S_ = (chunk) * TC + tt; const int t_ = dir ? T - 1 - S_ : S_; \
        f32x4 r_, k_, v_, kk_, w_, a_, kh_, kt_, b_; float ss_ = 0.f, rk_ = 0.f; \
        _Pragma("unroll") for (int e = 0; e < 4; ++e) { const float rc = (float)sr.r[1][e], kc = (float)sr.k[1][e], vc = (float)sr.v[1][e]; \
            r_[e] = rc + mu_r[e] * (0.5f * ((float)sr.r[0][e] + (float)sr.r[2][e]) - rc); k_[e] = kc + mu_k[e] * (0.5f * ((float)sr.k[0][e] + (float)sr.k[2][e]) - kc); \
            v_[e] = vc + mu_v[e] * (0.5f * ((float)sr.v[0][e] + (float)sr.v[2][e]) - vc); kk_[e] = k_[e] * k_k[e]; ss_ += kk_[e] * kk_[e]; w_[e] = (float)sr.w[e]; a_[e] = (float)sr.a[e]; } \
        ss_ = dpp_sum16(ss_); const float ri_ = rsqrtf(ss_ + 1e-12f); \
        _Pragma("unroll") for (int e = 0; e < 4; ++e) { kh_[e] = kk_[e] * ri_; kt_[e] = k_[e] * (1.0f + (a_[e] - 1.0f) * k_a[e]); b_[e] = a_[e] * kh_[e]; rk_ += r_[e] * kt_[e] * r_k[e]; } \
        rk_ = dpp_sum16(rk_); if (cq == 0) RK[((size_t)dir * M + row0 + t_) * 8 + h] = rk_; \
        LAS float* sb_ = st + ((chunk) & 1) * ST_BUF + tt * ST_STEP + cq * 4; \
        *(LAS f32x4*)(sb_) = kh_; *(LAS f32x4*)(sb_ + 64) = w_; *(LAS f32x4*)(sb_ + 128) = b_; *(LAS f32x4*)(sb_ + 192) = kt_; *(LAS f32x4*)(sb_ + 256) = r_; *(LAS f32x4*)(sb_ + 320) = v_; } while (0)
    SCAN_LOAD(0);
    SCAN_STAGE(0);
    __syncthreads();
    for (int chunk = 0; chunk < nch; ++chunk) {
        if (chunk + 1 < nch) SCAN_LOAD(chunk + 1);
        const LAS float* sb = st + (chunk & 1) * ST_BUF + ks * 8;
        const LAS float* vb = st + (chunk & 1) * ST_BUF + 320 + srow;
#pragma unroll 2
        for (int s = 0; s < TC; ++s) {
            const LAS float* q = sb + s * ST_STEP;
            const f32x4 kh0 = *(const LAS f32x4*)(q), kh1 = *(const LAS f32x4*)(q + 4);
            const f32x4 w0 = *(const LAS f32x4*)(q + 64), w1 = *(const LAS f32x4*)(q + 68);
            const f32x4 b0 = *(const LAS f32x4*)(q + 128), b1 = *(const LAS f32x4*)(q + 132);
            const f32x4 t0 = *(const LAS f32x4*)(q + 192), t1 = *(const LAS f32x4*)(q + 196);
            const f32x4 r0 = *(const LAS f32x4*)(q + 256), r1 = *(const LAS f32x4*)(q + 260);
            const float v = vb[s * ST_STEP];
            float sk = (S[0] * kh0[0] + S[1] * kh0[1]) + (S[2] * kh0[2] + S[3] * kh0[3]) + ((S[4] * kh1[0] + S[5] * kh1[1]) + (S[6] * kh1[2] + S[7] * kh1[3]));
            sk = dpp_sum8(sk);
#pragma unroll
            for (int e = 0; e < 4; ++e) { S[e] = S[e] * w0[e] + (v * t0[e] - sk * b0[e]); S[4 + e] = S[4 + e] * w1[e] + (v * t1[e] - sk * b1[e]); }
            float y = (S[0] * r0[0] + S[1] * r0[1]) + (S[2] * r0[2] + S[3] * r0[3]) + ((S[4] * r1[0] + S[5] * r1[1]) + (S[6] * r1[2] + S[7] * r1[3]));
            y = dpp_sum8(y);
            const int Sg = chunk * TC + s; const int t = dir ? T - 1 - Sg : Sg;
            if (ks == 0) Y[((size_t)dir * M + row0 + t) * CW + h * HD + srow] = (f16)y;
        }
        if (chunk + 1 < nch) SCAN_STAGE(chunk + 1);
        __syncthreads();
    }
#undef SCAN_LOAD
#undef SCAN_STAGE
    if (!smp) { GAS float* so = p.out + O_ST + (((((size_t)sq * NL + l) * 2 + dir) * NH + h) * HD + srow) * HD + ks * 8;
        *(GAS f32x4*)so = (f32x4){S[0], S[1], S[2], S[3]}; *(GAS f32x4*)(so + 4) = (f32x4){S[4], S[5], S[6], S[7]}; }
}
__device__ __forceinline__ void fast_scan(const Params& p0, const Ctx& c0, int l) {
    const Ctx c = fresh(c0); FRESH_P(p0);
    const int b = c.bid;
    if (b < 64) scan_task(p, c, l, b);
    else for (int task = b; task < 576; task += 192) scan_task(p, c, l, task);
}


namespace ms {
constexpr int O_AM = 0, O_BM = 4608, O_AT = 9216, O_VP = 14336, O_GT = 19456, O_NF = 22016, O_WM = 23040, O_WE = 23296, BUF = 23552;
constexpr int RS = 144, RT = 80;
}
__device__ __forceinline__ void mscan_task(const DParams& p, const Ctx& c, int l, int task) {
    using namespace ms;
    const GAS f16* PROJ = (const GAS f16*)(p.ws + WS_R1); const GAS f16* WA = (const GAS f16*)(p.ws + WS_R2);
    GAS f16* Y = (GAS f16*)(p.ws + WS_R3); GAS float* RK = (GAS float*)(p.ws + WS_RK);
    int sq, dir, h;
    if (task < 64) { h = task & 7; dir = (task >> 3) & 1; sq = B_CTX + (task >> 4); } else { const int id = task - 64; h = id & 7; dir = (id >> 3) & 1; sq = id >> 4; }
    const bool smp = sq >= B_CTX; const int T = smp ? T_SMP : T_CTX; const int row0 = smp ? M_CTX + (sq - B_CTX) * T_SMP : sq * T_CTX;
    const int nch = T / 16;
    const int vl = c.lane & 31, hh = c.lane >> 5;
    const int tq = c.tid - 128, ss = (tq >> 4) & 15, cq = tq & 15, k0 = cq * 4, ch0 = h * HD + k0;
    LAS float* cst = (LAS float*)(c.lds + 3 * BUF);
    if (c.wave == 7) { const int chn_ = h * HD + c.lane;
        cst[c.lane] = IN(15)[(l * 3 + 0) * CW + chn_]; cst[64 + c.lane] = IN(15)[(l * 3 + 1) * CW + chn_]; cst[128 + c.lane] = IN(15)[(l * 3 + 2) * CW + chn_];
        cst[192 + c.lane] = IN(16)[l * CW + chn_]; cst[256 + c.lane] = IN(17)[l * CW + chn_]; cst[320 + c.lane] = IN(18)[l * CW + chn_]; }

#define MS_BARRIER() do { asm volatile("s_waitcnt lgkmcnt(0)" ::: "memory"); __builtin_amdgcn_s_barrier(); asm volatile("" ::: "memory"); } while (0)
    if (c.wave >= 2 && c.wave < 6) {
    f16x4 G_rc, G_kc, G_vc, G_rp, G_kp, G_vp, G_rn, G_kn, G_vn, G_av, G_wo, G_wp, G_w7;
    { const f16x4 z4 = {(f16)0.f, (f16)0.f, (f16)0.f, (f16)0.f}; G_rc = G_kc = G_vc = G_rp = G_kp = G_vp = G_rn = G_kn = G_vn = G_av = G_wo = G_wp = G_w7 = z4; }
        for (int it = -3; it < nch; ++it) {
            const int ch = it + 2;
            if (ch >= 0 && ch < nch) {
                LAS unsigned char* buf = c.lds + (ch % 3) * BUF;
                const int Sg = ch * 16 + ss; const int t = dir ? T - 1 - Sg : Sg; const size_t row = (size_t)row0 + t;
                const f32x4 mu_r = *(const LAS f32x4*)(cst + k0), mu_k = *(const LAS f32x4*)(cst + 64 + k0), mu_v = *(const LAS f32x4*)(cst + 128 + k0), k_k = *(const LAS f32x4*)(cst + 192 + k0), k_a = *(const LAS f32x4*)(cst + 256 + k0), r_k = *(const LAS f32x4*)(cst + 320 + k0);
                f32x4 r_, k_, v_, kk_, kh_, kt_, b_; float sq_ = 0.f, rk_ = 0.f;
                const float mp_ = t > 0 ? 0.5f : 0.f, mn_ = t < T - 1 ? 0.5f : 0.f;
#pragma unroll
                for (int e = 0; e < 4; ++e) { const float rcf = (float)G_rc[e], kcf = (float)G_kc[e], vcf = (float)G_vc[e];
                    r_[e] = rcf + mu_r[e] * ((mp_ * (float)G_rp[e] + mn_ * (float)G_rn[e]) - rcf); k_[e] = kcf + mu_k[e] * ((mp_ * (float)G_kp[e] + mn_ * (float)G_kn[e]) - kcf);
                    v_[e] = vcf + mu_v[e] * ((mp_ * (float)G_vp[e] + mn_ * (float)G_vn[e]) - vcf); kk_[e] = k_[e] * k_k[e]; sq_ += kk_[e] * kk_[e]; }
                sq_ = dpp_sum16(sq_); const float ri_ = rsqrtf(sq_ + 1e-12f);
#pragma unroll
                for (int e = 0; e < 4; ++e) { const float a_ = (float)G_av[e]; kh_[e] = kk_[e] * ri_; kt_[e] = k_[e] * (1.0f + (a_ - 1.0f) * k_a[e]); b_[e] = a_ * kh_[e]; rk_ += r_[e] * kt_[e] * r_k[e]; }
                rk_ = dpp_sum16(rk_); if (cq == 0) RK[((size_t)dir * M + row) * 8 + h] = rk_;
                float al[4], be[4], ka[4], rho[4];
#pragma unroll
                for (int e = 0; e < 4; ++e) { const float wm7 = (float)G_w7[e]; const float om = ss == 7 ? 1.0f : (float)G_wo[e]; const float omp = ss == 0 ? __builtin_amdgcn_rcpf(wm7) : (ss == 8 ? 1.0f : (float)G_wp[e]);
                    const float iom = __builtin_amdgcn_rcpf(om); al[e] = omp * kh_[e]; be[e] = b_[e] * iom; ka[e] = kt_[e] * iom; rho[e] = om * r_[e]; }
                v2u w2;
                w2.x = pkh(al[0], al[1]); w2.y = pkh(al[2], al[3]); *(LAS v2u*)(buf + O_BM + ss * RS + k0 * 2) = w2;
                w2.x = pkh(rho[0], rho[1]); w2.y = pkh(rho[2], rho[3]); *(LAS v2u*)(buf + O_BM + (16 + ss) * RS + k0 * 2) = w2;
                w2.x = pkh(be[0], be[1]); w2.y = pkh(be[2], be[3]); *(LAS v2u*)(buf + O_AM + ss * RS + k0 * 2) = w2;
                w2.x = pkh(ka[0], ka[1]); w2.y = pkh(ka[2], ka[3]); *(LAS v2u*)(buf + O_AM + (16 + ss) * RS + k0 * 2) = w2;
#pragma unroll
                for (int e = 0; e < 4; ++e) { *(LAS f16*)(buf + O_AT + (k0 + e) * RT + ss * 2) = (f16)ka[e]; *(LAS f16*)(buf + O_AT + (k0 + e) * RT + (16 + ss) * 2) = (f16)be[e];
                    *(LAS f16*)(buf + O_VP + (k0 + e) * RT + ss * 2) = (f16)v_[e]; }
                if (ss == 15) { f32x4 wm_, we_;
#pragma unroll
                    for (int e = 0; e < 4; ++e) { wm_[e] = (float)G_w7[e]; we_[e] = (float)G_wo[e]; }
                    *(LAS f32x4*)(buf + O_WM + k0 * 4) = wm_; *(LAS f32x4*)(buf + O_WE + k0 * 4) = we_; }
            }
            const int chn = it + 3;
            if (chn < nch) {
                const int Sg = chn * 16 + ss; const int t = dir ? T - 1 - Sg : Sg; const size_t row = (size_t)row0 + t;
                const GAS f16* pr = PROJ + row * DIN + ch0;
                const f16x4 z4 = {(f16)0.f, (f16)0.f, (f16)0.f, (f16)0.f};
                G_rc = *(const GAS f16x4*)(pr + PC_R); G_kc = *(const GAS f16x4*)(pr + PC_K); G_vc = *(const GAS f16x4*)(pr + PC_V);
                { const GAS f16* prp = t > 0 ? pr - DIN : pr; const GAS f16* prn = t < T - 1 ? pr + DIN : pr;
                  G_rp = *(const GAS f16x4*)(prp + PC_R); G_kp = *(const GAS f16x4*)(prp + PC_K); G_vp = *(const GAS f16x4*)(prp + PC_V);
                  G_rn = *(const GAS f16x4*)(prn + PC_R); G_kn = *(const GAS f16x4*)(prn + PC_K); G_vn = *(const GAS f16x4*)(prn + PC_V); }
                G_av = *(const GAS f16x4*)(WA + row * 2048 + 1024 + dir * 512 + ch0);
                const GAS f16* wo = WA + row * 2048 + dir * 512 + ch0;
                G_wo = *(const GAS f16x4*)wo; G_wp = *(const GAS f16x4*)(wo + (ss > 0 ? (dir ? 2048 : -2048) : 0)); G_w7 = *(const GAS f16x4*)(wo + (long)(7 - ss) * (dir ? -2048 : 2048));
            }
            MS_BARRIER();
        }
    } else if (c.wave == 6) {
        for (int it = -3; it < nch; ++it) {
            const int ch = it + 1;
            if (ch >= 0 && ch < nch) {
                LAS unsigned char* buf = c.lds + (ch % 3) * BUF;
                f32x16 g;
#pragma unroll
                for (int i = 0; i < 16; ++i) g[i] = 0.f;
#pragma unroll
                for (int s = 0; s < 4; ++s) { const f16x8 a = *(const LAS f16x8*)(buf + O_AM + vl * RS + (16 * s + 8 * hh) * 2), b = *(const LAS f16x8*)(buf + O_BM + vl * RS + (16 * s + 8 * hh) * 2);
                    g = __builtin_amdgcn_mfma_f32_32x32x16_f16(a, b, g, 0, 0, 0); }
                const int tcol = vl & 15; const bool incl = vl >= 16;
#pragma unroll
                for (int gq = 0; gq < 4; ++gq) { float o[4];
#pragma unroll
                    for (int e = 0; e < 4; ++e) { const int ip = 8 * gq + 4 * hh + e, i = ip & 15; const bool ok = incl ? (i <= tcol) : (i < tcol); o[e] = ok ? g[4 * gq + e] : 0.f; }
                    v2u w2; w2.x = pkh(o[0], o[1]); w2.y = pkh(o[2], o[3]);
                    *(LAS v2u*)(buf + O_GT + vl * RT + (8 * gq + 4 * hh) * 2) = w2;
                    if (gq < 2 && vl < 16) *(LAS f32x4*)(buf + O_NF + vl * 64 + (8 * gq + 4 * hh) * 4) = (f32x4){o[0], o[1], o[2], o[3]}; }
            }
            MS_BARRIER();
        }
    } else if (c.wave == 7) {
        unsigned pa0 = 0u, pa1 = 0u, pb0 = 0u, pb1 = 0u, pc0 = 0u, pc1 = 0u;
#define MS_TOUCH(chp_, r0_, r1_) do { const int chp = (chp_); if (chp < nch) { \
            _Pragma("unroll") for (int q_ = 0; q_ < 2; ++q_) { const int i_ = c.lane + 64 * q_; if (i_ < 86) { const GAS unsigned* a_; \
                if (i_ < 54) { const int rr_ = i_ / 3, sg_ = i_ - 3 * rr_; int t_ = dir ? T - 17 - 16 * chp + rr_ : 16 * chp - 1 + rr_; t_ = t_ < 0 ? 0 : (t_ > T - 1 ? T - 1 : t_); \
                    a_ = (const GAS unsigned*)(PROJ + (size_t)(row0 + t_) * DIN + (sg_ == 0 ? PC_R : (sg_ == 1 ? PC_K : PC_V)) + h * HD); } \
                else { const int j_ = i_ - 54, rr_ = j_ >> 1; const int t_ = dir ? T - 16 - 16 * chp + rr_ : 16 * chp + rr_; \
                    a_ = (const GAS unsigned*)(WA + (size_t)(row0 + t_) * 2048 + (j_ & 1) * 1024 + dir * 512 + h * HD); } \
                if (q_ == 0) r0_ = *a_; else r1_ = *a_; } } } } while (0)
        unsigned px0 = 0u, px1 = 0u, px2 = 0u, px3 = 0u, px4 = 0u, px5 = 0u;
        MS_TOUCH(0, px0, px1); MS_TOUCH(1, px2, px3); MS_TOUCH(2, px4, px5);
        for (int it = -3; it < nch; it += 3) {
            asm volatile("" :: "v"(pa0), "v"(pa1)); MS_TOUCH(it + 6, pa0, pa1); MS_BARRIER();
            if (it + 1 < nch) { asm volatile("" :: "v"(pb0), "v"(pb1)); MS_TOUCH(it + 7, pb0, pb1); MS_BARRIER(); }
            if (it + 2 < nch) { asm volatile("" :: "v"(pc0), "v"(pc1)); MS_TOUCH(it + 8, pc0, pc1); MS_BARRIER(); }
        }
        asm volatile("" :: "v"(px0), "v"(px1), "v"(px2), "v"(px3), "v"(px4), "v"(px5), "v"(pa0), "v"(pa1), "v"(pb0), "v"(pb1), "v"(pc0), "v"(pc1));
#undef MS_TOUCH
    } else {
    f32x16 St0, St1;
#pragma unroll
    for (int i = 0; i < 16; ++i) { St0[i] = 0.f; St1[i] = 0.f; }
    if (smp) { float one_ = 1.0f; asm volatile("" : "+v"(one_));
        const GAS float* s0 = IN(4) + (((((size_t)(sq - B_CTX) * NL + l) * 2 + dir) * NH + h) * HD + 32 * c.wave + vl) * HD + 4 * hh;
#pragma unroll
        for (int g = 0; g < 4; ++g) { const f32x4 a = *(const GAS f32x4*)(s0 + 8 * g), b = *(const GAS f32x4*)(s0 + 32 + 8 * g);
#pragma unroll
            for (int e = 0; e < 4; ++e) { St0[4 * g + e] = a[e] * one_; St1[4 * g + e] = b[e] * one_; } }
    }
        for (int it = -3; it < nch; ++it) {
            const int ch = it;
            if (ch >= 0) {
                LAS unsigned char* buf = c.lds + (ch % 3) * BUF;
                const int v = 32 * c.wave + vl;
                if (ch == 0) {
#pragma unroll
                for (int gq = 0; gq < 4; ++gq) { const f32x4 m0 = *(const LAS f32x4*)(buf + O_WM + (8 * gq + 4 * hh) * 4), m1 = *(const LAS f32x4*)(buf + O_WM + (32 + 8 * gq + 4 * hh) * 4);
#pragma unroll
                    for (int e = 0; e < 4; ++e) { St0[4 * gq + e] *= m0[e]; St1[4 * gq + e] *= m1[e]; } }
                }
                f16x4 bmlo[4], bmhi[4];
#pragma unroll
                for (int s = 0; s < 4; ++s) { bmlo[s] = *(const LAS f16x4*)(buf + O_BM + vl * RS + (16 * s + 4 * hh) * 2); bmhi[s] = *(const LAS f16x4*)(buf + O_BM + vl * RS + (16 * s + 8 + 4 * hh) * 2); }
                const f16x8 gtk = *(const LAS f16x8*)(buf + O_GT + vl * RT + (16 + 8 * hh) * 2), vpv = *(const LAS f16x8*)(buf + O_VP + v * RT + (8 * hh) * 2);
                const f16x8 aN = *(const LAS f16x8*)(buf + O_GT + vl * RT + (8 * hh) * 2);
                f32x4 nf[4][3];
#pragma unroll
                for (int a = 0; a < 4; ++a)
#pragma unroll
                    for (int e = 0; e < 3; ++e) nf[a][e] = *(const LAS f32x4*)(buf + O_NF + (4 * a + 1 + e) * 64 + 16 * a);
                f16x8 at0[2], at1[2];
#pragma unroll
                for (int s2 = 0; s2 < 2; ++s2) { at0[s2] = *(const LAS f16x8*)(buf + O_AT + vl * RT + (16 * s2 + 8 * hh) * 2); at1[s2] = *(const LAS f16x8*)(buf + O_AT + (32 + vl) * RT + (16 * s2 + 8 * hh) * 2); }
                f32x4 sc0[4], sc1[4];
                { LAS unsigned char* nbuf = c.lds + ((ch + 1) % 3) * BUF; const bool more = ch + 1 < nch;
#pragma unroll
                  for (int gq = 0; gq < 4; ++gq) { sc0[gq] = *(const LAS f32x4*)(buf + O_WE + (8 * gq + 4 * hh) * 4); sc1[gq] = *(const LAS f32x4*)(buf + O_WE + (32 + 8 * gq + 4 * hh) * 4);
                    if (more) { sc0[gq] *= *(const LAS f32x4*)(nbuf + O_WM + (8 * gq + 4 * hh) * 4); sc1[gq] *= *(const LAS f32x4*)(nbuf + O_WM + (32 + 8 * gq + 4 * hh) * 4); } } }
                f32x16 X;
#pragma unroll
                for (int i = 0; i < 16; ++i) X[i] = 0.f;
#pragma unroll
                for (int s = 0; s < 4; ++s) {
                    f16x8 sb;
#pragma unroll
                    for (int j = 0; j < 8; ++j) sb[j] = (f16)((s < 2) ? St0[8 * (s & 1) + j] : St1[8 * (s & 1) + j]);
                    const f16x8 af = {bmlo[s][0], bmlo[s][1], bmlo[s][2], bmlo[s][3], bmhi[s][0], bmhi[s][1], bmhi[s][2], bmhi[s][3]};
                    X = __builtin_amdgcn_mfma_f32_32x32x16_f16(af, sb, X, 0, 0, 0);
                }
                X = __builtin_amdgcn_mfma_f32_32x32x16_f16(gtk, vpv, X, 0, 0, 0);
                f16x8 pball;
#pragma unroll
                for (int j = 0; j < 8; ++j) pball[j] = (f16)0.f;
#define MS_BLK(a) do { const int xo_ = 4 * ((a) >> 1); \
                    const f32x4 n1_ = nf[a][0], n2_ = nf[a][1], n3_ = nf[a][2]; \
                    float q0_ = X[xo_]; float q1_ = X[xo_ + 1] - q0_ * n1_[0]; float q2_ = X[xo_ + 2] - q0_ * n2_[0] - q1_ * n2_[1]; float q3_ = X[xo_ + 3] - q0_ * n3_[0] - q1_ * n3_[1] - q2_ * n3_[2]; \
                    if (((a) & 1) != ((a) >> 1)) { float a_, b_; \
                        a_ = q0_; b_ = q0_; swap32(a_, b_); q0_ = ((a) & 1) ? b_ : a_; a_ = q1_; b_ = q1_; swap32(a_, b_); q1_ = ((a) & 1) ? b_ : a_; \
                        a_ = q2_; b_ = q2_; swap32(a_, b_); q2_ = ((a) & 1) ? b_ : a_; a_ = q3_; b_ = q3_; swap32(a_, b_); q3_ = ((a) & 1) ? b_ : a_; } \
                    const bool hold_ = hh == ((a) >> 1); \
                    const f16 z_ = (f16)0.f; const f16 e0_ = hold_ ? (f16)(-q0_) : z_, e1_ = hold_ ? (f16)(-q1_) : z_, e2_ = hold_ ? (f16)(-q2_) : z_, e3_ = hold_ ? (f16)(-q3_) : z_; \
                    f16x8 pb_ = {z_, z_, z_, z_, z_, z_, z_, z_}; \
                    pb_[4 * ((a) & 1)] = e0_; pb_[4 * ((a) & 1) + 1] = e1_; pb_[4 * ((a) & 1) + 2] = e2_; pb_[4 * ((a) & 1) + 3] = e3_; \
                    if (hold_) { pball[4 * ((a) & 1)] = e0_; pball[4 * ((a) & 1) + 1] = e1_; pball[4 * ((a) & 1) + 2] = e2_; pball[4 * ((a) & 1) + 3] = e3_; } \
                    X = __builtin_amdgcn_mfma_f32_32x32x16_f16(aN, pb_, X, 0, 0, 0); } while (0)
                MS_BLK(0); MS_BLK(1); MS_BLK(2); MS_BLK(3);
#undef MS_BLK
                St0 = __builtin_amdgcn_mfma_f32_32x32x16_f16(at0[0], vpv, St0, 0, 0, 0); St1 = __builtin_amdgcn_mfma_f32_32x32x16_f16(at1[0], vpv, St1, 0, 0, 0);
                St0 = __builtin_amdgcn_mfma_f32_32x32x16_f16(at0[1], pball, St0, 0, 0, 0); St1 = __builtin_amdgcn_mfma_f32_32x32x16_f16(at1[1], pball, St1, 0, 0, 0);
#pragma unroll
                for (int r = 8; r < 16; ++r) { const int t = (r & 3) + 8 * ((r >> 2) - 2) + 4 * hh; const int Sg = ch * 16 + t; const int tok = dir ? T - 1 - Sg : Sg;
                    Y[((size_t)dir * M + row0 + tok) * CW + h * HD + v] = (f16)X[r]; }
#pragma unroll
                for (int gq = 0; gq < 4; ++gq)
#pragma unroll
                    for (int e = 0; e < 4; ++e) { St0[4 * gq + e] *= sc0[gq][e]; St1[4 * gq + e] *= sc1[gq][e]; }
            }
            MS_BARRIER();
        }
    if (!smp) {
        GAS float* so = p.out + O_ST + (((((size_t)sq * NL + l) * 2 + dir) * NH + h) * HD + 32 * c.wave + vl) * HD + 4 * hh;
#pragma unroll
        for (int g = 0; g < 4; ++g) { *(GAS f32x4*)(so + 8 * g) = (f32x4){St0[4 * g], St0[4 * g + 1], St0[4 * g + 2], St0[4 * g + 3]};
            *(GAS f32x4*)(so + 32 + 8 * g) = (f32x4){St1[4 * g], St1[4 * g + 1], St1[4 * g + 2], St1[4 * g + 3]}; }
    }
    }
#undef MS_BARRIER
}
__device__ __forceinline__ void mfma_scan(const Params& p0, const Ctx& c0, int l) {
    const Ctx c = fresh(c0); FRESH_P(p0);
    const int b = c.bid, G = (int)gridDim.x;
    const bool deal = G >= 128;
    const int first = b, step = deal ? (b < 64 ? 576 : G - 64) : G;
#pragma nounroll
    for (int task = first; task < 576; task += step) mscan_task(p, c, l, task);
}

__device__ __forceinline__ int swap23(int r) { return (r & ~12) | ((r & 4) << 1) | ((r & 8) >> 1); }
__device__ __forceinline__ void attn_wave_task(const DParams& p, const Ctx& c, int l, int task) {
    const GAS f16* PROJ = (const GAS f16*)(p.ws + WS_R1); const GAS f16* KN = (const GAS f16*)(p.ws + WS_KN); const GAS f16* VT = (const GAS f16*)(p.ws + WS_VT);
    GAS f16* OA = (GAS f16*)(p.ws + WS_R4);
    const int hq = task & 7, qb = task >> 3, kvh = hq >> 2;
    const int r32 = c.lane & 31, hh = c.lane >> 5;
    int rowq0, L; const GAS f16* Kb; const GAS f16* Vb; bool smp;
    if (qb < 128) { smp = true; rowq0 = M_CTX + qb * 32; const int b = qb >> 5; L = KV_SMP;
        Kb = KN + KN_SMP_OFF + ((size_t)b * 2 + kvh) * KV_SMP * HD; Vb = VT + KN_SMP_OFF + ((size_t)b * 2 + kvh) * HD * KV_SMP; }
    else { smp = false; rowq0 = (qb - 128) * 32; const int b = rowq0 >> 8; L = T_CTX;
        Kb = KN + ((size_t)b * 2 + kvh) * T_CTX * HD; Vb = VT + ((size_t)b * 2 + kvh) * HD * T_CTX; }
    const int row = rowq0 + r32;
    float x[4][8]; float ss = 0.f;
#pragma unroll
    for (int s = 0; s < 4; ++s) { const f16x8 q = *(const GAS f16x8*)(PROJ + (size_t)row * DIN + PC_Q + hq * HD + 16 * s + 8 * hh);
#pragma unroll
        for (int j = 0; j < 8; ++j) { x[s][j] = (float)q[j]; ss += x[s][j] * x[s][j]; } }
    ss = half_sum(ss);
    const float rstd = rsqrtf(ss * (1.0f / HD) + 1e-6f);
#pragma unroll
    for (int s = 0; s < 4; ++s)
#pragma unroll
        for (int j = 0; j < 8; ++j) x[s][j] *= rstd * IN(26)[l * HD + 16 * s + 8 * hh + j];
    if (smp) { const int t = (row - M_CTX) & (T_SMP - 1); const float posr = (float)(t >> 6), posc = (float)(t & 63);
#pragma unroll
        for (int j = 0; j < 8; ++j) { const float freq = exp2f(-(float)(8 * hh + j) * (13.287712379549449f / 16.0f));
            const float ar = posr * freq, ac = posc * freq; const float cr = __cosf(ar), sr = __sinf(ar), cc = __cosf(ac), sc = __sinf(ac);
            const float a0 = x[0][j], a1 = x[1][j], b0 = x[2][j], b1 = x[3][j];
            x[0][j] = a0 * cr - a1 * sr; x[1][j] = a1 * cr + a0 * sr; x[2][j] = b0 * cc - b1 * sc; x[3][j] = b1 * cc + b0 * sc; } }
    f16x8 qf[4];
#pragma unroll
    for (int s = 0; s < 4; ++s)
#pragma unroll
        for (int j = 0; j < 8; ++j) qf[s][j] = (f16)(x[s][j] * (0.125f * 1.4426950408889634f));
    f32x16 o0, o1;
#pragma unroll
    for (int i = 0; i < 16; ++i) { o0[i] = 0.f; o1[i] = 0.f; }
    float mrun = -1e30f, lsum = 0.f;
    const GAS f16* kp = Kb + (size_t)swap23(r32) * HD + 8 * hh;
    const GAS f16* vp = Vb + (size_t)r32 * L + 8 * hh;
    const int ntile = L >> 5;
    f16x8 kf[4], vf[4];
#pragma unroll
    for (int s = 0; s < 4; ++s) kf[s] = *(const GAS f16x8*)(kp + 16 * s);
    vf[0] = *(const GAS f16x8*)(vp); vf[1] = *(const GAS f16x8*)(vp + 16); vf[2] = *(const GAS f16x8*)(vp + (size_t)32 * L); vf[3] = *(const GAS f16x8*)(vp + (size_t)32 * L + 16);
    for (int kt = 0; kt < ntile; ++kt) {
        f16x8 kn[4], vn[4];
        const int ktn = kt + 1 < ntile ? kt + 1 : kt;
#pragma unroll
        for (int s = 0; s < 4; ++s) kn[s] = *(const GAS f16x8*)(kp + (size_t)ktn * 32 * HD + 16 * s);
        vn[0] = *(const GAS f16x8*)(vp + ktn * 32); vn[1] = *(const GAS f16x8*)(vp + ktn * 32 + 16); vn[2] = *(const GAS f16x8*)(vp + (size_t)32 * L + ktn * 32); vn[3] = *(const GAS f16x8*)(vp + (size_t)32 * L + ktn * 32 + 16);
        f32x16 sa;
#pragma unroll
        for (int i = 0; i < 16; ++i) sa[i] = 0.f;
#pragma unroll
        for (int s = 0; s < 4; ++s) sa = __builtin_amdgcn_mfma_f32_32x32x16_f16(kf[s], qf[s], sa, 0, 0, 0);
        float mt = sa[0];
#pragma unroll
        for (int i = 1; i < 16; ++i) mt = fmaxf(mt, sa[i]);
        mt = half_max(mt);
        const float mn = fmaxf(mrun, mt); const float alpha = exp2f(mrun - mn); mrun = mn;
        float ps = 0.f;
#pragma unroll
        for (int i = 0; i < 16; ++i) { sa[i] = exp2f(sa[i] - mn); ps += sa[i]; }
        lsum = lsum * alpha + ps;
#pragma unroll
        for (int i = 0; i < 16; ++i) { o0[i] *= alpha; o1[i] *= alpha; }
        f16x8 pb0, pb1;
#pragma unroll
        for (int j = 0; j < 8; ++j) { pb0[j] = (f16)sa[j]; pb1[j] = (f16)sa[8 + j]; }
        o0 = __builtin_amdgcn_mfma_f32_32x32x16_f16(vf[0], pb0, o0, 0, 0, 0);
        o0 = __builtin_amdgcn_mfma_f32_32x32x16_f16(vf[1], pb1, o0, 0, 0, 0);
        o1 = __builtin_amdgcn_mfma_f32_32x32x16_f16(vf[2], pb0, o1, 0, 0, 0);
        o1 = __builtin_amdgcn_mfma_f32_32x32x16_f16(vf[3], pb1, o1, 0, 0, 0);
#pragma unroll
        for (int s = 0; s < 4; ++s) { kf[s] = kn[s]; vf[s] = vn[s]; }
    }
    lsum = half_sum(lsum);
    const float inv = 1.0f / lsum;
    GAS f16* op = OA + (size_t)row * D + CW + hq * HD + 4 * hh;
#pragma unroll
    for (int g = 0; g < 4; ++g) {
        v2u w0; w0.x = pkh(o0[4 * g] * inv, o0[4 * g + 1] * inv); w0.y = pkh(o0[4 * g + 2] * inv, o0[4 * g + 3] * inv);
        v2u w1; w1.x = pkh(o1[4 * g] * inv, o1[4 * g + 1] * inv); w1.y = pkh(o1[4 * g + 2] * inv, o1[4 * g + 3] * inv);
        *(GAS v2u*)(op + 8 * g) = w0; *(GAS v2u*)(op + 32 + 8 * g) = w1; }
}
constexpr int AT_KS = 144, AT_BUF = 2 * 64 * AT_KS;
__device__ __forceinline__ void attn_block_task(const DParams& p, const Ctx& c, int l, int item) {
    const GAS f16* PROJ = (const GAS f16*)(p.ws + WS_R1); const GAS f16* KN = (const GAS f16*)(p.ws + WS_KN); const GAS f16* VT = (const GAS f16*)(p.ws + WS_VT);
    GAS f16* OA = (GAS f16*)(p.ws + WS_R4);
    int rowq0, L, kvh; const GAS f16* Kb; const GAS f16* Vb; bool smp;
    if (item < 128) { smp = true; const int b = item >> 5; kvh = (item >> 4) & 1; rowq0 = M_CTX + b * T_SMP + (item & 15) * 64; L = KV_SMP;
        Kb = KN + KN_SMP_OFF + ((size_t)b * 2 + kvh) * KV_SMP * HD; Vb = VT + KN_SMP_OFF + ((size_t)b * 2 + kvh) * HD * KV_SMP; }
    else { smp = false; const int id = item - 128; const int b = id >> 3; kvh = (id >> 2) & 1; rowq0 = b * T_CTX + (id & 3) * 64; L = T_CTX;
        Kb = KN + ((size_t)b * 2 + kvh) * T_CTX * HD; Vb = VT + ((size_t)b * 2 + kvh) * HD * T_CTX; }
    const int hq = kvh * 4 + (c.wave & 3);
    const int r32 = c.lane & 31, hh = c.lane >> 5;
    const int row = rowq0 + 32 * (c.wave >> 2) + r32;
    const int kk = c.tid >> 3, chk = c.tid & 7;
    const GAS f16* ksrc = Kb + (size_t)kk * HD + chk * 8;
    const GAS f16* vsrc = Vb + (size_t)kk * L + chk * 8;
    const int sdst = kk * AT_KS + chk * 16;
    v4u kreg = *(const GAS v4u*)ksrc, vreg = *(const GAS v4u*)vsrc;
    float x[4][8]; float ss = 0.f;
#pragma unroll
    for (int s = 0; s < 4; ++s) { const f16x8 q = *(const GAS f16x8*)(PROJ + (size_t)row * DIN + PC_Q + hq * HD + 16 * s + 8 * hh);
#pragma unroll
        for (int j = 0; j < 8; ++j) { x[s][j] = (float)q[j]; ss += x[s][j] * x[s][j]; } }
    ss = half_sum(ss);
    const float rstd = rsqrtf(ss * (1.0f / HD) + 1e-6f);
#pragma unroll
    for (int s = 0; s < 4; ++s)
#pragma unroll
        for (int j = 0; j < 8; ++j) x[s][j] *= rstd * IN(26)[l * HD + 16 * s + 8 * hh + j];
    if (smp) { const int t = (row - M_CTX) & (T_SMP - 1); const float posr = (float)(t >> 6), posc = (float)(t & 63);
#pragma unroll
        for (int j = 0; j < 8; ++j) { const float freq = exp2f(-(float)(8 * hh + j) * (13.287712379549449f / 16.0f));
            const float ar = posr * freq, ac = posc * freq; const float cr = __cosf(ar), sr = __sinf(ar), cc = __cosf(ac), sc = __sinf(ac);
            const float a0 = x[0][j], a1 = x[1][j], b0 = x[2][j], b1 = x[3][j];
            x[0][j] = a0 * cr - a1 * sr; x[1][j] = a1 * cr + a0 * sr; x[2][j] = b0 * cc - b1 * sc; x[3][j] = b1 * cc + b0 * sc; } }
    f16x8 qf[4];
#pragma unroll
    for (int s = 0; s < 4; ++s)
#pragma unroll
        for (int j = 0; j < 8; ++j) qf[s][j] = (f16)(x[s][j] * (0.125f * 1.4426950408889634f));
    f32x16 o0, o1;
#pragma unroll
    for (int i = 0; i < 16; ++i) { o0[i] = 0.f; o1[i] = 0.f; }
    float mrun = -1e30f, lsum = 0.f;
    const int nstep = L >> 6;
    *(LAS v4u*)(c.lds + sdst) = kreg; *(LAS v4u*)(c.lds + 64 * AT_KS + sdst) = vreg;
    asm volatile("s_waitcnt lgkmcnt(0)" ::: "memory"); __builtin_amdgcn_s_barrier(); asm volatile("" ::: "memory");
    const int koff = swap23(r32) * AT_KS + 16 * hh, voff = 64 * AT_KS + r32 * AT_KS + 16 * hh;
    for (int st = 0; st < nstep; ++st) {
        if (st + 1 < nstep) { kreg = *(const GAS v4u*)(ksrc + (size_t)(st + 1) * 64 * HD); vreg = *(const GAS v4u*)(vsrc + (st + 1) * 64); }
        LAS unsigned char* sb = c.lds + (st & 1) * AT_BUF;
        f32x16 sa0, sa1;
#pragma unroll
        for (int i = 0; i < 16; ++i) { sa0[i] = 0.f; sa1[i] = 0.f; }
#pragma unroll
        for (int s = 0; s < 4; ++s) { const f16x8 k0 = *(const LAS f16x8*)(sb + koff + 32 * s), k1 = *(const LAS f16x8*)(sb + koff + 32 * AT_KS + 32 * s);
            sa0 = __builtin_amdgcn_mfma_f32_32x32x16_f16(k0, qf[s], sa0, 0, 0, 0); sa1 = __builtin_amdgcn_mfma_f32_32x32x16_f16(k1, qf[s], sa1, 0, 0, 0); }
        float mt = fmaxf(sa0[0], sa1[0]);
#pragma unroll
        for (int i = 1; i < 16; ++i) mt = fmaxf(mt, fmaxf(sa0[i], sa1[i]));
        mt = half_max(mt);
        const float mn = fmaxf(mrun, mt); const float alpha = __builtin_amdgcn_exp2f(mrun - mn); mrun = mn;
        float ps = 0.f;
#pragma unroll
        for (int i = 0; i < 16; ++i) { sa0[i] = __builtin_amdgcn_exp2f(sa0[i] - mn); sa1[i] = __builtin_amdgcn_exp2f(sa1[i] - mn); ps += sa0[i] + sa1[i]; }
        lsum = lsum * alpha + ps;
#pragma unroll
        for (int i = 0; i < 16; ++i) { o0[i] *= alpha; o1[i] *= alpha; }
        f16x8 pb[4];
#pragma unroll
        for (int j = 0; j < 8; ++j) { pb[0][j] = (f16)sa0[j]; pb[1][j] = (f16)sa0[8 + j]; pb[2][j] = (f16)sa1[j]; pb[3][j] = (f16)sa1[8 + j]; }
#pragma unroll
        for (int q4 = 0; q4 < 4; ++q4) {
            const f16x8 v0 = *(const LAS f16x8*)(sb + voff + 32 * q4), v1 = *(const LAS f16x8*)(sb + voff + 32 * AT_KS + 32 * q4);
            o0 = __builtin_amdgcn_mfma_f32_32x32x16_f16(v0, pb[q4], o0, 0, 0, 0); o1 = __builtin_amdgcn_mfma_f32_32x32x16_f16(v1, pb[q4], o1, 0, 0, 0); }
        if (st + 1 < nstep) { LAS unsigned char* nb = c.lds + ((st + 1) & 1) * AT_BUF; *(LAS v4u*)(nb + sdst) = kreg; *(LAS v4u*)(nb + 64 * AT_KS + sdst) = vreg; }
        asm volatile("s_waitcnt lgkmcnt(0)" ::: "memory"); __builtin_amdgcn_s_barrier(); asm volatile("" ::: "memory");
    }
    lsum = half_sum(lsum);
    const float inv = 1.0f / lsum;
    GAS f16* op = OA + (size_t)row * D + CW + hq * HD + 4 * hh;
#pragma unroll
    for (int g = 0; g < 4; ++g) {
        v2u w0; w0.x = pkh(o0[4 * g] * inv, o0[4 * g + 1] * inv); w0.y = pkh(o0[4 * g + 2] * inv, o0[4 * g + 3] * inv);
        v2u w1; w1.x = pkh(o1[4 * g] * inv, o1[4 * g + 1] * inv); w1.y = pkh(o1[4 * g + 2] * inv, o1[4 * g + 3] * inv);
        *(GAS v2u*)(op + 8 * g) = w0; *(GAS v2u*)(op + 32 + 8 * g) = w1; }
}
__device__ __forceinline__ void fast_attn(const Params& p0, const Ctx& c0, int l) {
    const Ctx c = fresh(c0); FRESH_P(p0);
    unsigned* ctr = (unsigned*)(p0.ws + WS_CTL) + 8192 + 64 * l;
    volatile LAS unsigned* slot = (volatile LAS unsigned*)(c.lds + MISC_OFF) + 16;
    for (;;) {
        if (c.tid == 0) slot[0] = __hip_atomic_fetch_add(ctr, 1u, __ATOMIC_RELAXED, __HIP_MEMORY_SCOPE_AGENT);
        __syncthreads();
        const int item = (int)slot[0];
        __syncthreads();
        if (item >= 384) break;
        attn_block_task(p, c, l, item);
    }
}

__device__ __forceinline__ void post_phase(const Params& p0, const Ctx& c0, int l) {
    const Ctx c = fresh(c0); FRESH_P(p0);
    const GAS f16* PROJ = (const GAS f16*)(p.ws + WS_R1); const GAS f16* Y = (const GAS f16*)(p.ws + WS_R3); const GAS float* RK = (const GAS float*)(p.ws + WS_RK);
    GAS f16* OA = (GAS f16*)(p.ws + WS_R4);
    const int ch0 = c.lane * 8, h = c.lane >> 3;
    float gnw[8], gnb[8], muv[8];
    { const f32x4 a0 = *(const GAS f32x4*)(IN(24) + l * CW + ch0), a1 = *(const GAS f32x4*)(IN(24) + l * CW + ch0 + 4), b0 = *(const GAS f32x4*)(IN(25) + l * CW + ch0), b1 = *(const GAS f32x4*)(IN(25) + l * CW + ch0 + 4);
      const f32x4 m0 = *(const GAS f32x4*)(IN(15) + (l * 3 + 2) * CW + ch0), m1 = *(const GAS f32x4*)(IN(15) + (l * 3 + 2) * CW + ch0 + 4);
#pragma unroll
      for (int e = 0; e < 4; ++e) { gnw[e] = a0[e]; gnw[4 + e] = a1[e]; gnb[e] = b0[e]; gnb[4 + e] = b1[e]; muv[e] = m0[e]; muv[4 + e] = m1[e]; } }
    for (int row = c.gw; row < M; row += c.ngw) {
        int g, t, T; row_info(row, g, t, T);
        const GAS f16* pr = PROJ + (size_t)row * DIN + PC_V + ch0;
        const f16x8 y0 = *(const GAS f16x8*)(Y + (size_t)row * CW + ch0), y1 = *(const GAS f16x8*)(Y + ((size_t)M + row) * CW + ch0);
        const f16x8 vc = *(const GAS f16x8*)pr; const f16x8 gv = *(const GAS f16x8*)(OA + (size_t)row * D + ch0);
        f16x8 vp, vn;
#pragma unroll
        for (int e = 0; e < 8; ++e) { vp[e] = (f16)0.f; vn[e] = (f16)0.f; }
        if (t > 0) vp = *(const GAS f16x8*)(pr - DIN);
        if (t < T - 1) vn = *(const GAS f16x8*)(pr + DIN);
        const float rk = RK[(size_t)row * 8 + h] + RK[((size_t)M + row) * 8 + h];
        float y[8]; float s = 0.f;
#pragma unroll
        for (int e = 0; e < 8; ++e) { y[e] = (float)y0[e] + (float)y1[e]; s += y[e]; }
        const float mean = dpp_sum8(s) * (1.0f / HD); float q = 0.f;
#pragma unroll
        for (int e = 0; e < 8; ++e) { y[e] -= mean; q += y[e] * y[e]; }
        const float rstd = rsqrtf(dpp_sum8(q) * (1.0f / HD) + 64e-5f);
        float o[8];
#pragma unroll
        for (int e = 0; e < 8; ++e) { const float vcf = (float)vc[e]; const float v = vcf + muv[e] * (0.5f * ((float)vp[e] + (float)vn[e]) - vcf);
            o[e] = (y[e] * rstd * gnw[e] + gnb[e] + rk * v) * (float)gv[e]; }
        v4u w; w.x = pkh(o[0], o[1]); w.y = pkh(o[2], o[3]); w.z = pkh(o[4], o[5]); w.w = pkh(o[6], o[7]);
        *(GAS v4u*)(OA + (size_t)row * D + ch0) = w;
    }
}

__device__ __forceinline__ void gemm_proj(const Params& p0, const Ctx& c0) { const Ctx c = fresh(c0); FRESH_P(p0);
    pg8::Gemm g{(const GAS f16*)(p.ws + WS_R4), (const GAS f16*)(p.ws + WS_W + WO_IN), D, D, D}; pg8::StaticOrder S; S.init(M, DIN, (int)gridDim.x, c.bid);
    pg8::gemm_phase(c.lds, g, S, pg8::EpiProjF{(GAS f16*)(p.ws + WS_R1)}, c.wave); }
__device__ __forceinline__ void gemm_wa(const Params& p0, const Ctx& c0, int l) { const Ctx c = fresh(c0); FRESH_P(p0);
    pg8::Gemm g{(const GAS f16*)(p.ws + WS_R1) + PC_LW, (const GAS f16*)(p.ws + WS_W + WO_SM), DIN, 128, 128}; pg8::StaticOrder S; S.init(M, 2048, (int)gridDim.x, c.bid);
    pg8::gemm_phase(c.lds, g, S, pg8::EpiWAF{(GAS f16*)(p.ws + WS_R2), IN(19) + (size_t)l * 2 * CW, IN(21) + (size_t)l * 2 * CW}, c.wave); }
__device__ __forceinline__ void gemm_gate(const Params& p0, const Ctx& c0) { const Ctx c = fresh(c0); FRESH_P(p0);
    pg8::Gemm g{(const GAS f16*)(p.ws + WS_R1) + PC_LG, (const GAS f16*)(p.ws + WS_W + WO_G), DIN, 128, 128}; pg8::StaticOrder S; if (gridDim.x >= 224) S.init(M, CW, (int)gridDim.x, c.bid - 128); else S.init(M, CW, (int)gridDim.x, c.bid);
    pg8::gemm_phase(c.lds, g, S, pg8::EpiF16F{(GAS f16*)(p.ws + WS_R4), D}, c.wave); }
__device__ __forceinline__ void gemm_merge(const Params& p0, const Ctx& c0) { const Ctx c = fresh(c0); FRESH_P(p0);
    const GAS f16* OA = (const GAS f16*)(p.ws + WS_R4); const GAS f16* WbrT = (const GAS f16*)(p.ws + WS_W + WO_BR); GAS f16* MG = (GAS f16*)(p.ws + WS_R3); const GAS f16* PROJ = (const GAS f16*)(p.ws + WS_R1);
    pg8::StaticOrder S; S.init(M, D, (int)gridDim.x, c.bid, 192);
    pg8::Gemm g{OA, WbrT, D, D, D}; pg8::gemm_phase<pg8::EpiMergeF, 96>(c.lds, g, S, pg8::EpiMergeF{MG, PROJ}, c.wave); }
__device__ __forceinline__ void gemm_out(const Params& p0, const Ctx& c0) { const Ctx c = fresh(c0); FRESH_P(p0);
    pg8::Gemm g{(const GAS f16*)(p.ws + WS_R3), (const GAS f16*)(p.ws + WS_W + WO_OUT), D, D, D}; pg8::StaticOrder S; S.init(M, D, (int)gridDim.x, c.bid, 192);
    pg8::gemm_phase<pg8::EpiF16F, 96>(c.lds, g, S, pg8::EpiF16F{(GAS f16*)(p.ws + WS_R2), D}, c.wave); }
__device__ __forceinline__ void gemm_up(const Params& p0, const Ctx& c0) { const Ctx c = fresh(c0); FRESH_P(p0);
    pg8::Gemm g{(const GAS f16*)(p.ws + WS_R4), (const GAS f16*)(p.ws + WS_W + WO_UP), D, D, D}; pg8::StaticOrder S; S.init(M, DFF, (int)gridDim.x, c.bid);
    pg8::gemm_phase(c.lds, g, S, pg8::EpiRelu2F{(GAS f16*)(p.ws + WS_R1), DFF}, c.wave); }
__device__ __forceinline__ void gemm_down(const Params& p0, const Ctx& c0) { const Ctx c = fresh(c0); FRESH_P(p0);
    pg8::Gemm g{(const GAS f16*)(p.ws + WS_R1), (const GAS f16*)(p.ws + WS_W + WO_DN), DFF, DFF, DFF}; pg8::StaticOrder S; S.init(M, D, (int)gridDim.x, c.bid, 192);
    pg8::gemm_phase<pg8::EpiF16F, 96>(c.lds, g, S, pg8::EpiF16F{(GAS f16*)(p.ws + WS_R2), D}, c.wave); }

__global__ void __launch_bounds__(NTHREADS, 2) fwd_kernel(Params p) {
    extern __shared__ __attribute__((aligned(16))) unsigned char lds_raw[];
    Ctx c;
    c.lds = (LAS unsigned char*)lds_raw;
    c.tid = threadIdx.x; c.lane = c.tid & 63; c.wave = __builtin_amdgcn_readfirstlane(c.tid >> 6);
    c.gw = blockIdx.x * NWAVES + c.wave; c.ngw = gridDim.x * NWAVES; c.gt = blockIdx.x * NTHREADS + c.tid; c.ngt = gridDim.x * NTHREADS;
    volatile LAS unsigned* MISC = (volatile LAS unsigned*)(c.lds + MISC_OFF);
    if (c.tid < 32) MISC[c.tid] = 0u;
    if (c.tid < 28) ((LAS unsigned long long*)(c.lds + PTAB_OFF))[c.tid] = (unsigned long long)p.in[c.tid];
    __syncthreads();
    unsigned* ctl = (unsigned*)(p.ws + WS_CTL);
    XcdBarrier bar = xcd_barrier_post(ctl + CW_BAR, MISC + 8);
#define GRID_BAR() xcd_barrier(bar)

    conv_weights(p, c, 0);
    __syncthreads();
    mod_phase(p, c);
    GRID_BAR();
    norm_phase<0>(p, c, 0);
    GRID_BAR();
#pragma nounroll
    for (int l = 0; l < NL; ++l) {
        gemm_proj(p, c);
        GRID_BAR();
        gemm_wa(p, c, l);
        gemm_gate(p, c);
        kv_prep(p, c, l);
        GRID_BAR();
        mfma_scan(p, c, l);
        __syncthreads();
        fast_attn(p, c, l);
        GRID_BAR();
        post_phase(p, c, l);
        GRID_BAR();
        gemm_merge(p, c);
        GRID_BAR();
        gemm_out(p, c);
        GRID_BAR();
        norm_phase<1>(p, c, l);
        GRID_BAR();
        gemm_up(p, c);
        GRID_BAR();
        gemm_down(p, c);
        GRID_BAR();
        norm_phase<2>(p, c, l);
        if (l + 1 < NL) { __syncthreads(); conv_weights(p, c, l + 1); }
        GRID_BAR();
    }
}

extern "C" void kernel_launch(void* const* d_in, const int* in_sizes, int n_in, void* d_out, int out_size, void* d_ws, size_t ws_size, hipStream_t stream) {
    static int grid = 0;
    if (grid == 0) {
        if (n_in != 28 || (size_t)out_size != O_TOTAL || ws_size < WS_END) { fprintf(stderr, "kernel_launch: unexpected shapes n_in %d out %d ws %zu\n", n_in, out_size, ws_size); grid = -1; return; }
        int dev = 0, cus = 0;
        if (hipGetDevice(&dev) != hipSuccess || hipDeviceGetAttribute(&cus, hipDeviceAttributeMultiprocessorCount, dev) != hipSuccess) { grid = -1; return; }
        if (hipFuncSetAttribute((const void*)fwd_kernel, hipFuncAttributeMaxDynamicSharedMemorySize, LDS_BYTES) != hipSuccess) { fprintf(stderr, "kernel_launch: hipFuncSetAttribute failed\n"); grid = -1; return; }
        grid = cus;
    }
    if (grid < 0) return;
    (void)hipMemsetAsync((char*)d_ws + WS_CTL, 0, CTL_BYTES + MiB, stream);
    Params p{};
    for (int i = 0; i < 28; ++i) p.in[i] = (const float*)d_in[i];
    p.out = (float*)d_out; p.ws = (unsigned char*)d_ws;
    hipLaunchKernelGGL(fwd_kernel, dim3(grid), dim3(NTHREADS), LDS_BYTES, stream, p);
}
```

```cpp
#include <hip/hip_runtime.h>
#include <cstdio>
#include <cstdint>

#define GAS __attribute__((address_space(1)))
#define LAS __attribute__((address_space(3)))
typedef _Float16 f16;
typedef _Float16 f16x8 __attribute__((ext_vector_type(8)));
typedef _Float16 f16x4 __attribute__((ext_vector_type(4)));
typedef _Float16 f16x2 __attribute__((ext_vector_type(2)));
typedef float f32x4 __attribute__((ext_vector_type(4)));
typedef float f32x16 __attribute__((ext_vector_type(16)));
typedef unsigned v4u __attribute__((ext_vector_type(4)));
typedef unsigned v2u __attribute__((ext_vector_type(2)));

constexpr int D = 1024, DIN = 4608, DFF = 4096, CW = 512, NL = 2, NH = 8, HD = 64;
constexpr int B_CTX = 32, T_CTX = 256, B_SMP = 4, T_SMP = 1024, PAST = 256, KV_SMP = PAST + T_SMP;
constexpr int M_CTX = B_CTX * T_CTX, M_SMP = B_SMP * T_SMP, M = M_CTX + M_SMP;
constexpr int NMOD = 6 * D;
constexpr int PC_R = 0, PC_K = 512, PC_V = 1024, PC_LW = 1536, PC_LA = 1600, PC_LG = 1664, PC_Q = 1792, PC_KA = 2304, PC_VA = 2432, PC_GR = 2560, PC_GA = 3584;
constexpr size_t O_Y = 0, O_CK = (size_t)M * D, O_CV = O_CK + (size_t)B_CTX * NL * T_CTX * 128, O_ST = O_CV + (size_t)B_CTX * NL * T_CTX * 128;
constexpr size_t O_TOTAL = O_ST + (size_t)B_CTX * NL * 2 * NH * HD * HD;

constexpr size_t MiB = 1u << 20;
constexpr size_t WS_CTL = 0, CTL_BYTES = 1 * MiB;
constexpr size_t WS_MOD = 1 * MiB;
constexpr size_t WS_W = 2 * MiB;
constexpr size_t WO_IN = 0, WO_BR = 9 * MiB, WO_OUT = 11 * MiB, WO_UP = 13 * MiB, WO_DN = 21 * MiB, WO_SM = 29 * MiB, WO_G = 29 * MiB + 512 * 1024;
constexpr size_t WS_R1 = 32 * MiB;
constexpr size_t WS_R2 = 140 * MiB;
constexpr size_t WS_R3 = 188 * MiB;
constexpr size_t WS_RK = 212 * MiB;
constexpr size_t WS_R4 = 213 * MiB;
constexpr size_t WS_KN = 237 * MiB;
constexpr size_t WS_VT = 241 * MiB;
constexpr size_t WS_END = 245 * MiB;
constexpr size_t KN_SMP_OFF = (size_t)B_CTX * 2 * T_CTX * 64;

constexpr int NWAVES = 8, NTHREADS = 512;
constexpr int LDS_BYTES = 147456;
constexpr int MISC_OFF = 131072 + 320, PTAB_OFF = 131072 + 1024;

#define XB_TMO      128
#define XB_XCNT(j)  (256  + 64 * (j))
#define XB_XSUB(j)  (1280 + 64 * (j))
#define XB_XGEN(j)  (2304 + 64 * (j))
#define XB_TOP      3328
#define XB_TOPGEN   3392
#define XCD_BAR_WORDS 3456
#define XB_SPIN_CAP (1u << 24)
constexpr int CW_BAR = 4096;

__device__ __forceinline__ unsigned xb_ld(unsigned* p)              { return __hip_atomic_load(p, __ATOMIC_RELAXED, __HIP_MEMORY_SCOPE_AGENT); }
__device__ __forceinline__ unsigned xb_add(unsigned* p, unsigned v) { return __hip_atomic_fetch_add(p, v, __ATOMIC_RELAXED, __HIP_MEMORY_SCOPE_AGENT); }
__device__ __forceinline__ unsigned xb_xcc_id() { return (unsigned)__builtin_amdgcn_s_getreg((3 << 11) | 20) & 0xFu; }
#define XB_SPIN(cond, bar) do { unsigned _sp = 0; while (cond) { __builtin_amdgcn_s_sleep(1); \
    if ((++_sp & 255u) == 0u) { if (xb_ld(&(bar)[XB_TMO])) break; if (_sp > XB_SPIN_CAP) { atomicAdd(&(bar)[XB_TMO], 1u); break; } } } } while (0)

struct XcdBarrier { unsigned* bar; unsigned x; volatile LAS unsigned* st; };

__device__ __forceinline__ XcdBarrier xcd_barrier_post(unsigned* bar, volatile LAS unsigned* st) {
    XcdBarrier b; b.bar = bar; b.x = xb_xcc_id(); b.st = st;
    if (threadIdx.x == 0) (void)xb_add(&bar[XB_XCNT(b.x)], 1u);
    return b;
}
__device__ __forceinline__ void xcd_barrier_complete(unsigned* bar, unsigned x, unsigned& nloc, unsigned& nx) {
    const unsigned G = gridDim.x * gridDim.y * gridDim.z;
    unsigned sum, cnt, mine, sp = 0u;
    for (;;) {
        sum = 0u; cnt = 0u; mine = 0u;
#pragma unroll
        for (unsigned j = 0; j < 16; ++j) { const unsigned c = xb_ld(&bar[XB_XCNT(j)]); sum += c; cnt += (c > 0u) ? 1u : 0u; mine = (j == x) ? c : mine; }
        if (sum == G) break;
        __builtin_amdgcn_s_sleep(1);
        if ((++sp & 255u) == 0u) { if (xb_ld(&bar[XB_TMO])) break; if (sp > XB_SPIN_CAP) { atomicAdd(&bar[XB_TMO], 1u); break; } }
    }
    nloc = mine > 0u ? mine : 1u; nx = cnt > 0u ? cnt : 1u;
}
__device__ __forceinline__ void xcd_barrier(const XcdBarrier& b) {
    asm volatile("s_waitcnt vmcnt(0)" ::: "memory");
    __syncthreads();
    if (threadIdx.x == 0) {
        unsigned* bar = b.bar; unsigned bx = b.x;
        asm volatile("" : "+s"(bar), "+s"(bx));
        __builtin_amdgcn_s_waitcnt(0);
        unsigned nloc = b.st[0], nx = b.st[1];
        if (nloc == 0u) { xcd_barrier_complete(bar, bx, nloc, nx); b.st[0] = nloc; b.st[1] = nx; }
        const unsigned old = xb_add(&bar[XB_XSUB(bx)], 1u);
        const unsigned gen = old / nloc;
        if (old + 1u == (gen + 1u) * nloc) {
            __builtin_amdgcn_fence(__ATOMIC_RELEASE, "agent");
            asm volatile("s_waitcnt vmcnt(0)" ::: "memory");
            const unsigned og = xb_add(&bar[XB_TOP], 1u);
            const unsigned tg = og / nx;
            if (og + 1u == (tg + 1u) * nx) xb_add(&bar[XB_TOPGEN], 1u);
            else XB_SPIN(xb_ld(&bar[XB_TOPGEN]) == tg, bar);
            __builtin_amdgcn_fence(__ATOMIC_ACQUIRE, "agent");
            xb_add(&bar[XB_XGEN(bx)], 1u);
            asm volatile("s_waitcnt vmcnt(0)" ::: "memory");
        } else {
            XB_SPIN(xb_ld(&bar[XB_XGEN(bx)]) == gen, bar);
            __builtin_amdgcn_fence(__ATOMIC_ACQUIRE, "agent");
            asm volatile("s_waitcnt vmcnt(0)" ::: "memory");
        }
    }
    __syncthreads();
}

#define LDS_WAIT() asm volatile("s_waitcnt lgkmcnt(0)" ::: "memory")
#define DPPF(x, ctrl, rmask, oldv) __builtin_bit_cast(float, __builtin_amdgcn_update_dpp(__builtin_bit_cast(int, (float)(oldv)), __builtin_bit_cast(int, (float)(x)), (ctrl), (rmask), 0xF, false))
__device__ __forceinline__ float wave_sum(float v) {
    v += DPPF(v, 0xB1, 0xF, 0.f); v += DPPF(v, 0x4E, 0xF, 0.f); v += DPPF(v, 0x141, 0xF, 0.f); v += DPPF(v, 0x140, 0xF, 0.f);
    v += DPPF(v, 0x142, 0xA, 0.f); v += DPPF(v, 0x143, 0xC, 0.f);
    return __builtin_bit_cast(float, __builtin_amdgcn_readlane(__builtin_bit_cast(int, v), 63));
}
__device__ __forceinline__ float dpp_f(float x, const int ctrl) { return x; }
#define DPP_ADD(x, ctrl) (x) += __builtin_bit_cast(float, __builtin_amdgcn_update_dpp(0, __builtin_bit_cast(int, (x)), (ctrl), 0xF, 0xF, true))
__device__ __forceinline__ float dpp_sum8(float x) { DPP_ADD(x, 0xB1); DPP_ADD(x, 0x4E); DPP_ADD(x, 0x141); return x; }
__device__ __forceinline__ float dpp_sum16(float x) { DPP_ADD(x, 0xB1); DPP_ADD(x, 0x4E); DPP_ADD(x, 0x141); DPP_ADD(x, 0x140); return x; }
__device__ __forceinline__ void swap32(float& a, float& b) { asm volatile("v_nop\n\tv_nop\n\tv_permlane32_swap_b32 %0, %1" : "+v"(a), "+v"(b)); }
__device__ __forceinline__ float half_sum(float v) { float a = v, b = v; swap32(a, b); return a + b; }
__device__ __forceinline__ float half_max(float v) { float a = v, b = v; swap32(a, b); return fmaxf(a, b); }
__device__ __forceinline__ float xor16(float v) { return __builtin_bit_cast(float, __builtin_amdgcn_ds_swizzle(__builtin_bit_cast(int, v), 0x401F)); }
__device__ __forceinline__ float sigmoidf_(float x) { return __builtin_amdgcn_rcpf(1.0f + __expf(-x)); }
__device__ __forceinline__ float tanhf_(float x) { return 1.0f - 2.0f * __builtin_amdgcn_rcpf(1.0f + __expf(2.0f * x)); }
__device__ __forceinline__ unsigned pkh(float lo, float hi) { f16x2 v = {(f16)lo, (f16)hi}; return __builtin_bit_cast(unsigned, v); }
__device__ __forceinline__ void row_info(int row, int& g, int& t, int& T) {
    if (row < M_CTX) { g = 0; t = row & (T_CTX - 1); T = T_CTX; }
    else { const int r = row - M_CTX; g = 1 + (r >> 10); t = r & (T_SMP - 1); T = T_SMP; }
}

struct Params {
    const float* in[28];
    float* out;
    unsigned char* ws;
};
struct DParams { GAS float* out; GAS unsigned char* ws; };
struct Ctx {
    LAS unsigned char* lds;
    int tid, lane, wave, gw, ngw, gt, ngt, bid;
};
__device__ __forceinline__ int lane_id() { int ln; asm volatile("v_mbcnt_lo_u32_b32 %0, -1, 0\n\tv_mbcnt_hi_u32_b32 %0, -1, %0" : "=v"(ln)); return ln; }
__device__ __forceinline__ const GAS float* inp(const Ctx& c, int i) {
    const unsigned long long v = ((const LAS unsigned long long*)(c.lds + PTAB_OFF))[i];
    const unsigned lo = __builtin_amdgcn_readfirstlane((unsigned)v), hi = __builtin_amdgcn_readfirstlane((unsigned)(v >> 32));
    return (const GAS float*)(((unsigned long long)hi << 32) | lo); }
#define IN(i) inp(c, (i))
#define FRESH_P(p0) DParams p; { float* o_ = (p0).out; unsigned char* w_ = (p0).ws; asm volatile("" : "+s"(o_), "+s"(w_)); p.out = (GAS float*)o_; p.ws = (GAS unsigned char*)w_; }
__device__ __forceinline__ Ctx fresh(const Ctx& c0) {
    Ctx c = c0; int w = c0.wave; asm volatile("" : "+s"(w)); int ln = lane_id(); asm volatile("" : "+v"(ln));
    int b = blockIdx.x; asm volatile("" : "+s"(b));
    c.wave = w; c.lane = ln; c.tid = w * 64 + ln; c.bid = b;
    c.gw = b * 8 + w; c.gt = b * 512 + c.tid; return c; }

__device__ __forceinline__ void conv_item(const GAS float* W, int N, GAS f16* WT, int ldt, int koff, LAS float* scr, int kb, int nb, int lane) {
    const int k0 = 64 * kb, n0 = 32 * nb;
#pragma unroll 8
    for (int i = 0; i < 32; ++i) { const int kk = 2 * i + (lane >> 5); scr[kk * 33 + (lane & 31)] = W[(size_t)(k0 + kk) * N + n0 + (lane & 31)]; }
    LDS_WAIT();
    const int c = lane & 7;
#pragma unroll
    for (int j = 0; j < 4; ++j) { const int n = (lane >> 3) + 8 * j; const LAS float* s = scr + (8 * c) * 33 + n;
        v4u o; o.x = pkh(s[0 * 33], s[1 * 33]); o.y = pkh(s[2 * 33], s[3 * 33]); o.z = pkh(s[4 * 33], s[5 * 33]); o.w = pkh(s[6 * 33], s[7 * 33]);
        *(GAS v4u*)(WT + (size_t)(n0 + n) * ldt + koff + k0 + 8 * c) = o; }
    LDS_WAIT();
}
__device__ __forceinline__ void conv_weights(const Params& p0, const Ctx& c0, int l) {
    const Ctx c = fresh(c0); FRESH_P(p0);
    LAS float* scr = (LAS float*)(c.lds + c.wave * 16384);
    GAS unsigned char* wb = p.ws + WS_W;
    GAS f16* WinT = (GAS f16*)(wb + WO_IN); GAS f16* WbrT = (GAS f16*)(wb + WO_BR); GAS f16* WoutT = (GAS f16*)(wb + WO_OUT); GAS f16* WupT = (GAS f16*)(wb + WO_UP); GAS f16* WdnT = (GAS f16*)(wb + WO_DN);
    GAS f16* WsmT = (GAS f16*)(wb + WO_SM); GAS f16* WgT = (GAS f16*)(wb + WO_G);
    const GAS float* w_in = IN(7) + (size_t)l * D * DIN; const GAS float* w_br = IN(8) + (size_t)l * 2 * CW * D; const GAS float* w_out = IN(9) + (size_t)l * D * D;
    const GAS float* w_up = IN(13) + (size_t)l * D * DFF; const GAS float* w_dn = IN(14) + (size_t)l * DFF * D;
    const GAS float* dec_up = IN(20) + (size_t)l * 2 * 64 * CW; const GAS float* icl_up = IN(22) + (size_t)l * 2 * 64 * CW; const GAS float* gate_up = IN(23) + (size_t)l * 128 * CW;
    constexpr int I0 = 16 * 144, I1 = 8 * 32, I2 = 8 * 32, I3 = 16 * 32, I4 = 16 * 128, I5 = 64 * 32, I6 = 16, I7 = 16, I8 = 16, I9 = 16, I10 = 2 * 16;
    constexpr int NIT = I0 + I1 + I2 + I3 + I4 + I5 + I6 + I7 + I8 + I9 + I10;
    for (int it = c.gw; it < NIT; it += c.ngw) {
        int r = it;
        if (r < I0) { conv_item(w_in, DIN, WinT, D, 0, scr, r / 144, r % 144, c.lane); continue; } r -= I0;
        if (r < I1) { conv_item(w_br, D, WbrT, D, 0, scr, r / 32, r % 32, c.lane); continue; } r -= I1;
        if (r < I2) { conv_item(w_br + (size_t)CW * D, D, WbrT, D, CW, scr, r / 32, r % 32, c.lane); continue; } r -= I2;
        if (r < I3) { conv_item(w_out, D, WoutT, D, 0, scr, r / 32, r % 32, c.lane); continue; } r -= I3;
        if (r < I4) { conv_item(w_up, DFF, WupT, D, 0, scr, r / 128, r % 128, c.lane); continue; } r -= I4;
        if (r < I5) { conv_item(w_dn, D, WdnT, DFF, 0, scr, r / 32, r % 32, c.lane); continue; } r -= I5;
        if (r < I6) { conv_item(dec_up, CW, WsmT, 128, 0, scr, 0, r, c.lane); continue; } r -= I6;
        if (r < I7) { conv_item(dec_up + 64 * CW, CW, WsmT + (size_t)512 * 128, 128, 0, scr, 0, r, c.lane); continue; } r -= I7;
        if (r < I8) { conv_item(icl_up, CW, WsmT + (size_t)1024 * 128, 128, 64, scr, 0, r, c.lane); continue; } r -= I8;
        if (r < I9) { conv_item(icl_up + 64 * CW, CW, WsmT + (size_t)1536 * 128, 128, 64, scr, 0, r, c.lane); continue; } r -= I9;
        conv_item(gate_up, CW, WgT, 128, 0, scr, r / 16, r % 16, c.lane);
    }
    unsigned zz_ = 0u; asm volatile("" : "+v"(zz_));
    for (int i = c.gt; i < 2048 * 8; i += c.ngt) { const int row = i >> 3, ch = i & 7; const int col = (row < 1024 ? 64 : 0) + ch * 8;
        *(GAS v4u*)(WsmT + (size_t)row * 128 + col) = (v4u){zz_, zz_, zz_, zz_}; }
}

__device__ __forceinline__ void mod_phase(const Params& p0, const Ctx& c0) {
    const Ctx c = fresh(c0); FRESH_P(p0);
    LAS float* sl = (LAS float*)(c.lds);
    LAS float* part = (LAS float*)(c.lds + 32768);
    GAS float* mod = (GAS float*)(p.ws + WS_MOD);
    for (int i = c.tid; i < 5 * D; i += NTHREADS) { const int g = i >> 10, k = i & 1023; const float v = g == 0 ? IN(6)[k] : IN(5)[(g - 1) * D + k]; sl[i] = v / (1.0f + __expf(-v)); }
    __syncthreads();
    for (int it = c.bid; it < NL * (NMOD / 64) * 4; it += gridDim.x) {
        const int kq = it & 3, lc = it >> 2, l = lc / (NMOD / 64), cc = lc % (NMOD / 64);
        const int kb = kq * 256 + c.wave * 32;
        const GAS float* w = IN(10) + (size_t)l * D * NMOD + (size_t)kb * NMOD + cc * 64 + c.lane;
        float a0 = 0.f, a1 = 0.f, a2 = 0.f, a3 = 0.f, a4 = 0.f;
        float wv[32];
#pragma unroll
        for (int k = 0; k < 32; ++k) wv[k] = w[(size_t)k * NMOD];
#pragma unroll
        for (int k = 0; k < 32; ++k) { a0 += sl[kb + k] * wv[k]; a1 += sl[D + kb + k] * wv[k]; a2 += sl[2 * D + kb + k] * wv[k]; a3 += sl[3 * D + kb + k] * wv[k]; a4 += sl[4 * D + kb + k] * wv[k]; }
        LAS float* pw = part + c.wave * 320 + c.lane;
        pw[0] = a0; pw[64] = a1; pw[128] = a2; pw[192] = a3; pw[256] = a4;
        __syncthreads();
        if (c.tid < 320) { float s = 0.f;
#pragma unroll
            for (int w8 = 0; w8 < 8; ++w8) s += part[w8 * 320 + c.tid];
            const int g = c.tid >> 6, col = cc * 64 + (c.tid & 63);
            if (kq == 0) s += IN(11)[(size_t)l * NMOD + col];
            atomicAdd((float*)(mod + ((size_t)l * 5 + g) * NMOD + col), s); }
        __syncthreads();
    }
}

template <int MODE, int NB>
__device__ __forceinline__ void norm_rows(const DParams& p, const Ctx& c, int l, int row_first, int row_end, int row_step) {
    GAS float* YO = p.out; GAS f16* XA = (GAS f16*)p.out;
    GAS f16* XB = (GAS f16*)(p.ws + WS_R3);
    const GAS f16* MO = (const GAS f16*)(p.ws + WS_R2); GAS f16* H = (GAS f16*)(p.ws + WS_R4);
    const GAS float* modb = (const GAS float*)(p.ws + WS_MOD);
    const GAS float* in0 = IN(0); const GAS float* in1 = IN(1); const GAS float* ngb = IN(12);
    for (int rowb = row_first; rowb < row_end; rowb += NB * row_step) {
        f32x4 x0[MODE == 0 ? NB : 1][4]; f16x4 xh[MODE == 0 ? 1 : NB][4]; f16x4 mh[MODE == 0 ? 1 : NB][4];
#pragma unroll
        for (int b = 0; b < NB; ++b) { const int row = rowb + b * row_step;
            if (row < row_end) {
                if (MODE == 0) { const GAS float* src = row < M_CTX ? in0 + (size_t)row * D : in1 + (size_t)(row - M_CTX) * D;
#pragma unroll
                    for (int j = 0; j < 4; ++j) x0[MODE == 0 ? b : 0][j] = __builtin_nontemporal_load((const GAS f32x4*)(src + 256 * j + 4 * c.lane)); }
                else { const GAS f16* xs = (MODE == 1 ? XA : XB) + (size_t)row * D;
#pragma unroll
                    for (int j = 0; j < 4; ++j) { xh[MODE == 0 ? 0 : b][j] = __builtin_nontemporal_load((const GAS f16x4*)(xs + 256 * j + 4 * c.lane));
                        mh[MODE == 0 ? 0 : b][j] = __builtin_nontemporal_load((const GAS f16x4*)(MO + (size_t)row * D + 256 * j + 4 * c.lane)); } } } }
#pragma unroll
        for (int b = 0; b < NB; ++b) { const int row = rowb + b * row_step;
            if (row < row_end) {
                int g, t, T; row_info(row, g, t, T);
                f32x4 x[4];
#pragma unroll
                for (int j = 0; j < 4; ++j) {
                    if (MODE == 0) x[j] = x0[MODE == 0 ? b : 0][j];
                    else {
#pragma unroll
                        for (int e = 0; e < 4; ++e) x[j][e] = (float)xh[MODE == 0 ? 0 : b][j][e]; } }
                if (MODE != 0) {
                    const GAS float* mo_mod = modb + ((size_t)l * 5 + g) * NMOD + (MODE == 1 ? 2 * D : 5 * D);
                    const GAS float* ngp = ngb + ((size_t)l * 4 + (MODE == 1 ? 1 : 3)) * D;
                    float mv[4][4]; float ss = 0.f;
#pragma unroll
                    for (int j = 0; j < 4; ++j)
#pragma unroll
                        for (int e = 0; e < 4; ++e) { mv[j][e] = (float)mh[MODE == 0 ? 0 : b][j][e]; ss += mv[j][e] * mv[j][e]; }
                    const float rstd = rsqrtf(wave_sum(ss) * (1.0f / D) + 1e-6f);
#pragma unroll
                    for (int j = 0; j < 4; ++j) { const f32x4 gg = *(const GAS f32x4*)(mo_mod + 256 * j + 4 * c.lane); const f32x4 nn = *(const GAS f32x4*)(ngp + 256 * j + 4 * c.lane);
#pragma unroll
                        for (int e = 0; e < 4; ++e) x[j][e] += gg[e] * (mv[j][e] * rstd * nn[e]); }
                }
                const int ln = MODE == 2 ? l + 1 : l;
                if (ln < NL) {
                    const GAS float* mb = modb + ((size_t)ln * 5 + g) * NMOD + (MODE == 1 ? 3 * D : 0);
                    const GAS float* ngp = ngb + ((size_t)ln * 4 + (MODE == 1 ? 2 : 0)) * D;
                    float ss = 0.f;
#pragma unroll
                    for (int j = 0; j < 4; ++j) ss += (x[j][0] * x[j][0] + x[j][1] * x[j][1]) + (x[j][2] * x[j][2] + x[j][3] * x[j][3]);
                    const float rstd = rsqrtf(wave_sum(ss) * (1.0f / D) + 1e-6f);
                    GAS f16* XW = (MODE == 1 ? XB : XA) + (size_t)row * D;
#pragma unroll
                    for (int j = 0; j < 4; ++j) { const f32x4 sh = *(const GAS f32x4*)(mb + 256 * j + 4 * c.lane); const f32x4 sc = *(const GAS f32x4*)(mb + D + 256 * j + 4 * c.lane);
                        const f32x4 nn = *(const GAS f32x4*)(ngp + 256 * j + 4 * c.lane);
                        float o[4];
#pragma unroll
                        for (int e = 0; e < 4; ++e) o[e] = x[j][e] * rstd * nn[e] * (1.0f + sc[e]) + sh[e];
                        v2u w; w.x = pkh(o[0], o[1]); w.y = pkh(o[2], o[3]);
                        *(GAS v2u*)(H + (size_t)row * D + 256 * j + 4 * c.lane) = w;
                        v2u xw; xw.x = pkh(x[j][0], x[j][1]); xw.y = pkh(x[j][2], x[j][3]);
                        __builtin_nontemporal_store(xw, (GAS v2u*)(XW + 256 * j + 4 * c.lane)); }
                } else {
#pragma unroll
                    for (int j = 0; j < 4; ++j) __builtin_nontemporal_store(x[j], (GAS f32x4*)(YO + (size_t)row * D + 256 * j + 4 * c.lane)); }
            } }
    }
}
template <int MODE>
__device__ __forceinline__ void norm_phase(const Params& p0, const Ctx& c0, int l) {
    const Ctx c = fresh(c0); FRESH_P(p0);
    norm_rows<MODE, 6>(p, c, l, c.gw, M, c.ngw);
}

namespace pg8 {
constexpr int BM = 256, BK = 64, HALF = 128, HTB = HALF * BK * 2, STAGE_BYTES = 8 * HTB, NXCD = 8, WGM = 8;
__host__ __device__ __forceinline__ int lds_byte(int r, int c) { const int st = (r >> 4) * 2 + (c >> 5), rr = r & 15, cc = c & 31, ob = rr * 64 + cc * 2; return st * 1024 + (ob ^ (((ob >> 9) & 1) << 5)); }
__host__ __device__ __forceinline__ void stage_rc(int b, int& R, int& C) { const int st = b / 1024, sb = b % 1024, swz = sb ^ (((sb >> 9) & 1) << 5); R = (st >> 1) * 16 + swz / 64; C = (st & 1) * 32 + (swz % 64) / 2; }
__host__ __device__ __forceinline__ int perm32(int rho) { const int n = rho >> 4, i = rho & 15; return 8 * (i >> 2) + 4 * n + (i & 3); }
struct Unit { int pm, pn; };
struct Gemm { const GAS f16* A; const GAS f16* Bt; int lda, ldb, K; };
struct StaticOrder {
    int nM, nN, nwg, G, c;
    __device__ void init(int Mr, int N, int G_, int c_, int bm = BM) { nM = Mr / bm; nN = N / BM; nwg = nM * nN; G = G_; c = c_; }
    __device__ bool next(int i, Unit& u) const {
        const long L = (long)i * G + c; if (c < 0 || L >= nwg) return false;
        int wgid = (int)L; { const int q = nwg / NXCD, r = nwg % NXCD, xcd = wgid % NXCD, off = wgid / NXCD; wgid = (xcd < r ? xcd * (q + 1) : r * (q + 1) + (xcd - r) * q) + off; }
        const int nig = WGM * nN, gid = wgid / nig, fm = gid * WGM, gsz = (nM - fm) < WGM ? (nM - fm) : WGM;
        u.pm = fm + ((wgid % nig) % gsz); u.pn = (wgid % nig) / gsz; return true;
    }
};
template <class Epi, int HA = 128, bool ALIGN_EPI = true, bool SP2 = true>
__device__ __forceinline__ void gemm_phase(LAS unsigned char* lds, const Gemm g, const StaticOrder& S, const Epi& E, int wave_sgpr) {
    asm volatile("" : "+s"(wave_sgpr)); int tid = wave_sgpr * 64 + lane_id(); asm volatile("" : "+v"(tid));
    const int wid = __builtin_amdgcn_readfirstlane(tid >> 6), lane = tid & 63, wr = wid >> 2, wc = wid & 3, fr = lane & 15, fq = lane >> 4;
    const int K = g.K, nt = K / BK;
    unsigned voffA[2], voffB[2];
#pragma unroll
    for (int i = 0; i < 2; ++i) { int R, C; stage_rc(tid * 16 + i * 8192, R, C); const int Rb = (R & ~31) + perm32(R & 31);
        voffA[i] = (unsigned)(R * g.lda + C) * 2u; voffB[i] = (unsigned)(Rb * g.ldb + C) * 2u; }
    const unsigned kstep = (unsigned)(BK * 2);
    constexpr int MF = HA / 32;
    const unsigned hstepA = (unsigned)HA * g.lda * 2, hstepB = (unsigned)HALF * g.ldb * 2;
    const unsigned tstepA = 2 * hstepA, tstepB = 2 * hstepB;
    const unsigned ldsw = (unsigned)wid * 1024u;
    const int aoff = lds_byte(wr * (HA / 2) + fr, fq * 8), boff = lds_byte(wc * 32 + fr, fq * 8);
#define PG8_SA(b, h) (((b) * 2 + (h)) * HTB)
#define PG8_SB(b, h) ((4 + (b) * 2 + (h)) * HTB)
#define PG8_STAGE(bufoff, gbase, soff, voff) do { _Pragma("unroll") for (int _i = 0; _i < 2; ++_i) \
        __builtin_amdgcn_raw_ptr_buffer_load_lds(rs##gbase, (LAS unsigned*)(lds + (bufoff) + ldsw + _i * 8192), 16, (voff)[_i], (int)(soff), 0, 0); } while (0)
#define PG8_LDA(dst, b, h) do { _Pragma("unroll") for (int m = 0; m < MF; ++m) _Pragma("unroll") for (int k = 0; k < 2; ++k) dst[m][k] = *(const LAS f16x8*)(lds + PG8_SA(b, h) + aoff + m * 2048 + k * 1024); } while (0)
#define PG8_LDB(dst, b, h) do { _Pragma("unroll") for (int n = 0; n < 2; ++n) _Pragma("unroll") for (int k = 0; k < 2; ++k) dst[n][k] = *(const LAS f16x8*)(lds + PG8_SB(b, h) + boff + n * 2048 + k * 1024); } while (0)
#define PG8_MMA(ai, bj, At, Bt) do { __builtin_amdgcn_s_setprio(1); _Pragma("unroll") for (int m = 0; m < MF; ++m) _Pragma("unroll") for (int n = 0; n < 2; ++n) _Pragma("unroll") for (int k = 0; k < 2; ++k) \
        acc[ai][bj][m][n] = __builtin_amdgcn_mfma_f32_16x16x32_f16(Bt[n][k], At[m][k], acc[ai][bj][m][n], 0, 0, 0); __builtin_amdgcn_s_setprio(0); } while (0)
#define PG8_WAIT_V(n) asm volatile("s_waitcnt vmcnt(" #n ")" ::: "memory")
#define PG8_WAIT_L(n) asm volatile("s_waitcnt lgkmcnt(" #n ")" ::: "memory")
#define PG8_BAR __builtin_amdgcn_s_barrier()
#define PG8_SCHED __builtin_amdgcn_sched_barrier(0)
    Unit cur, nxt; int ui = 0;
    if (!S.next(0, cur)) return;
    f32x4 acc[2][2][4][2];
#pragma unroll
    for (int a = 0; a < 2; ++a)
#pragma unroll
        for (int b = 0; b < 2; ++b)
#pragma unroll
            for (int m = 0; m < 4; ++m)
#pragma unroll
                for (int n = 0; n < 2; ++n) acc[a][b][m][n] = (f32x4){0.f, 0.f, 0.f, 0.f};
    f16x8 At[4][2], B0[2][2], B1[2][2];
    const auto rsA = __builtin_amdgcn_make_buffer_rsrc((GAS void*)g.A, 0, 0x7fffffff, 0x00020000); const auto rsB = __builtin_amdgcn_make_buffer_rsrc((GAS void*)g.Bt, 0, 0x7fffffff, 0x00020000);
    unsigned cA = (unsigned)cur.pm * tstepA, cB = (unsigned)cur.pn * tstepB;
    if constexpr (SP2) {
        PG8_STAGE(PG8_SB(0, 0), B, cB, voffB); PG8_STAGE(PG8_SB(0, 1), B, cB + hstepB, voffB); PG8_STAGE(PG8_SA(0, 0), A, cA, voffA); PG8_STAGE(PG8_SA(0, 1), A, cA + hstepA, voffA);
        if (wr == 1) PG8_BAR;
        PG8_WAIT_V(2); PG8_BAR;
        PG8_STAGE(PG8_SB(1, 0), B, cB + kstep, voffB); PG8_STAGE(PG8_SA(1, 0), A, cA + kstep, voffA); PG8_STAGE(PG8_SB(1, 1), B, cB + hstepB + kstep, voffB);
        PG8_WAIT_V(6); PG8_BAR;
    } else {
        PG8_STAGE(PG8_SB(0, 0), B, cB, voffB); PG8_STAGE(PG8_SA(0, 0), A, cA, voffA); PG8_STAGE(PG8_SB(0, 1), B, cB + hstepB, voffB); PG8_STAGE(PG8_SA(0, 1), A, cA + hstepA, voffA);
        if (wr == 1) PG8_BAR;
        PG8_WAIT_V(4); PG8_BAR;
        PG8_STAGE(PG8_SB(1, 0), B, cB + kstep, voffB); PG8_STAGE(PG8_SA(1, 0), A, cA + kstep, voffA); PG8_STAGE(PG8_SB(1, 1), B, cB + hstepB + kstep, voffB);
        PG8_WAIT_V(6); PG8_BAR;
    }
    for (;;) {
        const bool has_next = S.next(ui + 1, nxt);
        const unsigned nA = has_next ? (unsigned)nxt.pm * tstepA : cA, nB = has_next ? (unsigned)nxt.pn * tstepB : cB;
        for (int t = 0; t < nt; t += 2) {
            if constexpr (Epi::MID_T >= 0) { if (t == Epi::MID_T) { const int ln3 = lane_id(); E.template mid<HA>(acc, cur, wr, wc, ln3 & 15, ln3 >> 4); } }
            const bool last = (t == nt - 2);
            const unsigned a1 = cA + (unsigned)(t + 1) * kstep;
            const unsigned a2 = last ? nA : cA + (unsigned)(t + 2) * kstep, b2 = last ? nB : cB + (unsigned)(t + 2) * kstep;
            const unsigned a3 = a2 + kstep, b3 = b2 + kstep;
            if constexpr (SP2) {
            PG8_LDB(B0, 0, 0); PG8_LDB(B1, 0, 1); PG8_SCHED; PG8_LDA(At, 0, 0); PG8_STAGE(PG8_SA(1, 1), A, a1 + hstepA, voffA);
            PG8_WAIT_V(8); PG8_WAIT_L(0); PG8_BAR; PG8_MMA(0, 0, At, B0); PG8_MMA(0, 1, At, B1); PG8_BAR; PG8_SCHED;
            PG8_LDA(At, 0, 1); PG8_STAGE(PG8_SB(0, 0), B, b2, voffB); PG8_STAGE(PG8_SB(0, 1), B, b2 + hstepB, voffB); PG8_STAGE(PG8_SA(0, 0), A, a2, voffA);
            PG8_WAIT_V(8); PG8_WAIT_L(0); PG8_BAR; PG8_MMA(1, 0, At, B0); PG8_MMA(1, 1, At, B1); PG8_BAR; PG8_SCHED;
            PG8_LDB(B0, 1, 0); PG8_LDB(B1, 1, 1); PG8_SCHED; PG8_LDA(At, 1, 0); PG8_STAGE(PG8_SA(0, 1), A, a2 + hstepA, voffA);
            PG8_WAIT_V(8); PG8_WAIT_L(0); PG8_BAR; PG8_MMA(0, 0, At, B0); PG8_MMA(0, 1, At, B1); PG8_BAR; PG8_SCHED;
            PG8_LDA(At, 1, 1); PG8_STAGE(PG8_SB(1, 0), B, b3, voffB); PG8_STAGE(PG8_SB(1, 1), B, b3 + hstepB, voffB); PG8_STAGE(PG8_SA(1, 0), A, a3, voffA);
            PG8_WAIT_V(8); PG8_WAIT_L(0); PG8_BAR; PG8_MMA(1, 0, At, B0); PG8_MMA(1, 1, At, B1); PG8_BAR; PG8_SCHED;
            } else {
            PG8_LDB(B0, 0, 0); PG8_SCHED; PG8_LDA(At, 0, 0); PG8_STAGE(PG8_SA(1, 1), A, a1 + hstepA, voffA);
            PG8_WAIT_L(8); PG8_BAR; PG8_WAIT_L(0); PG8_MMA(0, 0, At, B0); PG8_BAR; PG8_SCHED;
            PG8_LDB(B1, 0, 1); PG8_STAGE(PG8_SB(0, 0), B, b2, voffB);
            PG8_BAR; PG8_WAIT_L(0); PG8_MMA(0, 1, At, B1); PG8_BAR;
            PG8_LDA(At, 0, 1); PG8_STAGE(PG8_SA(0, 0), A, a2, voffA);
            PG8_BAR; PG8_WAIT_L(0); PG8_MMA(1, 0, At, B0); PG8_BAR; PG8_SCHED;
            PG8_STAGE(PG8_SB(0, 1), B, b2 + hstepB, voffB);
            PG8_WAIT_V(6); PG8_BAR; PG8_MMA(1, 1, At, B1); PG8_BAR;
            PG8_LDB(B0, 1, 0); PG8_SCHED; PG8_LDA(At, 1, 0); PG8_STAGE(PG8_SA(0, 1), A, a2 + hstepA, voffA);
            PG8_WAIT_L(8); PG8_BAR; PG8_WAIT_L(0); PG8_MMA(0, 0, At, B0); PG8_BAR; PG8_SCHED;
            PG8_LDB(B1, 1, 1); PG8_STAGE(PG8_SB(1, 0), B, b3, voffB);
            PG8_BAR; PG8_WAIT_L(0); PG8_MMA(0, 1, At, B1); PG8_BAR;
            PG8_LDA(At, 1, 1); PG8_STAGE(PG8_SA(1, 0), A, a3, voffA);
            PG8_BAR; PG8_WAIT_L(0); PG8_MMA(1, 0, At, B0); PG8_BAR; PG8_SCHED;
            PG8_STAGE(PG8_SB(1, 1), B, b3 + hstepB, voffB);
            PG8_WAIT_V(6); PG8_BAR; PG8_MMA(1, 1, At, B1); PG8_BAR;
            }
        }
        if constexpr (ALIGN_EPI) { if (wr == 0) PG8_BAR; }
        { const int ln2 = lane_id(); E.template run<HA>(acc, cur, wr, wc, ln2 & 15, ln2 >> 4); }
        if (!has_next) break;
#pragma unroll
        for (int a = 0; a < 2; ++a)
#pragma unroll
            for (int b = 0; b < 2; ++b)
#pragma unroll
                for (int m = 0; m < 4; ++m)
#pragma unroll
                    for (int n = 0; n < 2; ++n) acc[a][b][m][n] = (f32x4){0.f, 0.f, 0.f, 0.f};
        cur = nxt; cA = nA; cB = nB; ++ui;
        if constexpr (ALIGN_EPI) { if (wr == 1) PG8_BAR; }
    }
    PG8_WAIT_V(0);
    if constexpr (!ALIGN_EPI) { if (wr == 0) PG8_BAR; }
    PG8_BAR;
#undef PG8_SA
#undef PG8_SB
#undef PG8_STAGE
#undef PG8_LDA
#undef PG8_LDB
#undef PG8_MMA
#undef PG8_WAIT_V
#undef PG8_WAIT_L
#undef PG8_BAR
#undef PG8_SCHED
}
typedef f32x4 Acc[2][2][4][2];
#define PG8_EPI_LOOP(...) \
    const int row0 = u.pm * (2 * HA) + wr * (HA / 2) + fr, col0 = u.pn * BM + wc * 32 + 8 * fq; \
    _Pragma("unroll") for (int ai = 0; ai < 2; ++ai) _Pragma("unroll") for (int m = 0; m < HA / 32; ++m) { const int row = row0 + ai * HA + m * 16; \
        _Pragma("unroll") for (int bj = 0; bj < 2; ++bj) { const int col = col0 + bj * HALF; f32x4 v0 = acc[ai][bj][m][0], v1 = acc[ai][bj][m][1]; __VA_ARGS__ } asm volatile("" ::: "memory"); }
__device__ __forceinline__ void store8(GAS f16* p, f32x4 v0, f32x4 v1) { v4u w; w.x = pkh(v0[0], v0[1]); w.y = pkh(v0[2], v0[3]); w.z = pkh(v1[0], v1[1]); w.w = pkh(v1[2], v1[3]); *(GAS v4u*)p = w; }
struct EpiProjF { static constexpr int MID_T = -1; GAS f16* P;
    template <int HA> __device__ __forceinline__ void run(const Acc& acc, const Unit& u, int wr, int wc, int fr, int fq) const {
        PG8_EPI_LOOP(
            if (u.pn == 6) {
                if (col < PC_LA) { _Pragma("unroll") for (int e = 0; e < 4; ++e) { v0[e] = tanhf_(v0[e]); v1[e] = tanhf_(v1[e]); } }
                else if (col >= PC_LG) { _Pragma("unroll") for (int e = 0; e < 4; ++e) { v0[e] = sigmoidf_(v0[e]); v1[e] = sigmoidf_(v1[e]); } }
            } else if (u.pn >= 10) { _Pragma("unroll") for (int e = 0; e < 4; ++e) { v0[e] = sigmoidf_(v0[e]); v1[e] = sigmoidf_(v1[e]); } }
            store8(P + (size_t)row * DIN + col, v0, v1);
        )
    } };
#define DPPM(x, ctrl) (x) *= __builtin_bit_cast(float, __builtin_amdgcn_update_dpp(0x3f800000, __builtin_bit_cast(int, (x)), (ctrl), 0xF, 0xF, false))
struct EpiWAF { static constexpr int MID_T = -1; GAS f16* WA; const GAS float* w0; const GAS float* a0;
    template <int HA> __device__ __forceinline__ void run(const Acc& acc, const Unit& u, int wr, int wc, int fr, int fq) const {
        PG8_EPI_LOOP(
            if (col < 1024) { const f32x4 b0 = *(const GAS f32x4*)(w0 + col), b1 = *(const GAS f32x4*)(w0 + col + 4);
                float x[8];
                _Pragma("unroll") for (int e = 0; e < 4; ++e) { x[e] = __expf(-0.606531f * sigmoidf_(v0[e] + b0[e])); x[4 + e] = __expf(-0.606531f * sigmoidf_(v1[e] + b1[e])); }
                if (col < 512) {
                    _Pragma("unroll") for (int e = 0; e < 8; ++e) { DPPM(x[e], 0x111); DPPM(x[e], 0x112); DPPM(x[e], 0x114); DPPM(x[e], 0x118);
                        const float wm = __builtin_bit_cast(float, __builtin_amdgcn_ds_swizzle(__builtin_bit_cast(int, x[e]), 0x00F0)); x[e] = (fr == 7) ? wm : x[e] * __builtin_amdgcn_rcpf(wm); }
                } else {
                    _Pragma("unroll") for (int e = 0; e < 8; ++e) { DPPM(x[e], 0x101); DPPM(x[e], 0x102); DPPM(x[e], 0x104); DPPM(x[e], 0x108);
                        const float wm = __builtin_bit_cast(float, __builtin_amdgcn_ds_swizzle(__builtin_bit_cast(int, x[e]), 0x0110)); x[e] = (fr == 8) ? wm : x[e] * __builtin_amdgcn_rcpf(wm); }
                }
                _Pragma("unroll") for (int e = 0; e < 4; ++e) { v0[e] = x[e]; v1[e] = x[4 + e]; } }
            else { const f32x4 b0 = *(const GAS f32x4*)(a0 + col - 1024), b1 = *(const GAS f32x4*)(a0 + col - 1024 + 4);
                _Pragma("unroll") for (int e = 0; e < 4; ++e) { v0[e] = sigmoidf_(v0[e] + b0[e]); v1[e] = sigmoidf_(v1[e] + b1[e]); } }
            store8(WA + (size_t)row * 2048 + col, v0, v1);
        )
    } };
struct EpiF16F { static constexpr int MID_T = -1; GAS f16* O; int ld;
    template <int HA> __device__ __forceinline__ void run(const Acc& acc, const Unit& u, int wr, int wc, int fr, int fq) const {
        PG8_EPI_LOOP( store8(O + (size_t)row * ld + col, v0, v1); )
    } };
struct EpiRelu2F { static constexpr int MID_T = -1; GAS f16* O; int ld;
    template <int HA> __device__ __forceinline__ void run(const Acc& acc, const Unit& u, int wr, int wc, int fr, int fq) const {
        PG8_EPI_LOOP(
            _Pragma("unroll") for (int e = 0; e < 4; ++e) { const float a = fmaxf(v0[e], 0.f), b = fmaxf(v1[e], 0.f); v0[e] = a * a; v1[e] = b * b; }
            store8(O + (size_t)row * ld + col, v0, v1);
        )
    } };
struct EpiMergeF { static constexpr int MID_T = 8; GAS f16* MG; const GAS f16* PROJ;
    template <int HA> __device__ __forceinline__ void mid(Acc& acc, const Unit& u, int wr, int wc, int fr, int fq) const {
        const int row0 = u.pm * (2 * HA) + wr * (HA / 2) + fr, col0 = u.pn * BM + wc * 32 + 8 * fq;
#pragma unroll
        for (int ai = 0; ai < 2; ++ai)
#pragma unroll
            for (int m = 0; m < HA / 32; ++m) { const int row = row0 + ai * HA + m * 16;
#pragma unroll
                for (int bj = 0; bj < 2; ++bj) { const int col = col0 + bj * HALF;
                    const f16x8 gr = *(const GAS f16x8*)(PROJ + (size_t)row * DIN + PC_GR + col), ga = *(const GAS f16x8*)(PROJ + (size_t)row * DIN + PC_GA + col);
#pragma unroll
                    for (int e = 0; e < 4; ++e) { acc[ai][bj][m][0][e] *= (float)gr[e] * __builtin_amdgcn_rcpf(fmaxf((float)ga[e], 1e-4f)); acc[ai][bj][m][1][e] *= (float)gr[4 + e] * __builtin_amdgcn_rcpf(fmaxf((float)ga[4 + e], 1e-4f)); } }
                asm volatile("" ::: "memory"); }
    }
    template <int HA> __device__ __forceinline__ void run(const Acc& acc, const Unit& u, int wr, int wc, int fr, int fq) const {
        PG8_EPI_LOOP(
            const f16x8 ga = *(const GAS f16x8*)(PROJ + (size_t)row * DIN + PC_GA + col);
            _Pragma("unroll") for (int e = 0; e < 4; ++e) { v0[e] *= fmaxf((float)ga[e], 1e-4f); v1[e] *= fmaxf((float)ga[4 + e], 1e-4f); }
            store8(MG + (size_t)row * D + col, v0, v1);
        )
    } };
}

__device__ __forceinline__ void kv_prep(const Params& p0, const Ctx& c0, int l) {
    const Ctx c = fresh(c0); FRESH_P(p0);
    const GAS f16* PROJ = (const GAS f16*)(p.ws + WS_R1); GAS f16* KN = (GAS f16*)(p.ws + WS_KN); GAS f16* VT = (GAS f16*)(p.ws + WS_VT);
    const int d = c.lane;
    const float kg = IN(27)[l * HD + d];
    const int axis = d >> 5, half = (d >> 4) & 1, f = d & 15;
    const float freq = exp2f(-(float)f * (13.287712379549449f / 16.0f));
    for (int it = c.gw; it < (M / 8) * 2; it += c.ngw) {
        const int kvh = it & 1, row0 = (it >> 1) * 8;
        float kx[8], vx[8];
#pragma unroll
        for (int r = 0; r < 8; ++r) { const GAS f16* pr = PROJ + (size_t)(row0 + r) * DIN + kvh * HD + d; kx[r] = (float)pr[PC_KA]; vx[r] = (float)pr[PC_VA]; }
#pragma unroll
        for (int r = 0; r < 8; ++r) kx[r] = kx[r] * rsqrtf(wave_sum(kx[r] * kx[r]) * (1.0f / HD) + 1e-6f) * kg;
        f16x8 vv;
#pragma unroll
        for (int r = 0; r < 8; ++r) vv[r] = (f16)vx[r];
        if (row0 < M_CTX) { const int b = row0 >> 8, t0 = row0 & 255;
#pragma unroll
            for (int r = 0; r < 8; ++r) { const size_t o = ((((size_t)b * NL + l) * T_CTX + t0 + r) * 2 + kvh) * HD + d;
                p.out[O_CK + o] = kx[r]; p.out[O_CV + o] = vx[r];
                KN[(((size_t)b * 2 + kvh) * T_CTX + t0 + r) * HD + d] = (f16)kx[r]; }
            *(GAS f16x8*)(VT + (((size_t)b * 2 + kvh) * HD + d) * T_CTX + t0) = vv;
        } else { const int rr = row0 - M_CTX, b = rr >> 10, t0 = rr & 1023;
#pragma unroll
            for (int r = 0; r < 8; ++r) { const int t = t0 + r; const float pos = (float)(axis == 0 ? (t >> 6) : (t & 63));
                const float ang = pos * freq; const float cs = __cosf(ang), sn = __sinf(ang);
                const float other = xor16(kx[r]);
                const float ko = half == 0 ? kx[r] * cs - other * sn : kx[r] * cs + other * sn;
                KN[KN_SMP_OFF + (((size_t)b * 2 + kvh) * KV_SMP + PAST + t) * HD + d] = (f16)ko; }
            *(GAS f16x8*)(VT + KN_SMP_OFF + (((size_t)b * 2 + kvh) * HD + d) * KV_SMP + PAST + t0) = vv;
        }
    }
    for (int it = c.gw; it < B_SMP * (PAST / 8) * 2; it += c.ngw) {
        const int kvh = it & 1, j0 = ((it >> 1) & 31) * 8, b = it >> 6;
        f16x8 vv;
#pragma unroll
        for (int r = 0; r < 8; ++r) { const size_t s = ((((size_t)b * NL + l) * PAST + j0 + r) * 2 + kvh) * HD + d;
            KN[KN_SMP_OFF + (((size_t)b * 2 + kvh) * KV_SMP + j0 + r) * HD + d] = (f16)IN(2)[s]; vv[r] = (f16)IN(3)[s]; }
        *(GAS f16x8*)(VT + KN_SMP_OFF + (((size_t)b * 2 + kvh) * HD + d) * KV_SMP + j0) = vv;
    }
}

constexpr int TC = 32, ST_STEP = 6 * 64, ST_BUF = TC * ST_STEP;
struct StageRegs { f16x4 r[3], k[3], v[3], w, a; };
__device__ __forceinline__ void scan_task(const DParams& p, const Ctx& c, int l, int task) {
    const GAS f16* PROJ = (const GAS f16*)(p.ws + WS_R1); const GAS f16* WA = (const GAS f16*)(p.ws + WS_R2);
    GAS f16* Y = (GAS f16*)(p.ws + WS_R3); GAS float* RK = (GAS float*)(p.ws + WS_RK);
    LAS float* st = (LAS float*)c.lds;
    int sq, dir, h;
    if (task < 64) { h = task & 7; dir = (task >> 3) & 1; sq = B_CTX + (task >> 4); } else { const int id = task - 64; h = id & 7; dir = (id >> 3) & 1; sq = id >> 4; }
    const bool smp = sq >= B_CTX; const int T = smp ? T_SMP : T_CTX; const int row0 = smp ? M_CTX + (sq - B_CTX) * T_SMP : sq * T_CTX;
    const int nch = T / TC;
    const int tt = c.tid >> 4, cq = c.tid & 15, ch0 = h * HD + cq * 4;
    const f32x4 mu_r = *(const GAS f32x4*)(IN(15) + (l * 3 + 0) * CW + ch0), mu_k = *(const GAS f32x4*)(IN(15) + (l * 3 + 1) * CW + ch0), mu_v = *(const GAS f32x4*)(IN(15) + (l * 3 + 2) * CW + ch0);
    const f32x4 k_k = *(const GAS f32x4*)(IN(16) + l * CW + ch0), k_a = *(const GAS f32x4*)(IN(17) + l * CW + ch0), r_k = *(const GAS f32x4*)(IN(18) + l * CW + ch0);
    const int ks = c.lane & 7, srow = c.wave * 8 + (c.lane >> 3);
    float S[8];
    if (smp) { const GAS float* s0 = IN(4) + (((((size_t)(sq - B_CTX) * NL + l) * 2 + dir) * NH + h) * HD + srow) * HD + ks * 8;
        const f32x4 a = *(const GAS f32x4*)s0, b = *(const GAS f32x4*)(s0 + 4);
        S[0] = a[0]; S[1] = a[1]; S[2] = a[2]; S[3] = a[3]; S[4] = b[0]; S[5] = b[1]; S[6] = b[2]; S[7] = b[3];
    } else {
#pragma unroll
        for (int j = 0; j < 8; ++j) S[j] = 0.f;
    }
    StageRegs sr;
    const f16x4 z4 = {(f16)0.f, (f16)0.f, (f16)0.f, (f16)0.f};
#define SCAN_LOAD(chunk) do { const int S_ = (chunk) * TC + tt; const int t_ = dir ? T - 1 - S_ : S_; const GAS f16* pr_ = PROJ + (size_t)(row0 + t_) * DIN + ch0; \
        sr.r[1] = *(const GAS f16x4*)(pr_ + PC_R); sr.k[1] = *(const GAS f16x4*)(pr_ + PC_K); sr.v[1] = *(const GAS f16x4*)(pr_ + PC_V); \
        if (t_ > 0) { sr.r[0] = *(const GAS f16x4*)(pr_ - DIN + PC_R); sr.k[0] = *(const GAS f16x4*)(pr_ - DIN + PC_K); sr.v[0] = *(const GAS f16x4*)(pr_ - DIN + PC_V); } else { sr.r[0] = z4; sr.k[0] = z4; sr.v[0] = z4; } \
        if (t_ < T - 1) { sr.r[2] = *(const GAS f16x4*)(pr_ + DIN + PC_R); sr.k[2] = *(const GAS f16x4*)(pr_ + DIN + PC_K); sr.v[2] = *(const GAS f16x4*)(pr_ + DIN + PC_V); } else { sr.r[2] = z4; sr.k[2] = z4; sr.v[2] = z4; } \
        const GAS f16* wa_ = WA + (size_t)(row0 + t_) * 2048 + dir * 512 + ch0; sr.w = *(const GAS f16x4*)wa_; sr.a = *(const GAS f16x4*)(wa_ + 1024); } while (0)
#define SCAN_STAGE(chunk) do { const int S_ = (chunk) * TC + tt; const int t_ = dir ? T - 1 - S_ : S_; \
        f32x4 r_, k_, v_, kk_, w_, a_, kh_, kt_, b_; float ss_ = 0.f, rk_ = 0.f; \
        _Pragma("unroll") for (int e = 0; e < 4; ++e) { const float rc = (float)sr.r[1][e], kc = (float)sr.k[1][e], vc = (float)sr.v[1][e]; \
            r_[e] = rc + mu_r[e] * (0.5f * ((float)sr.r[0][e] + (float)sr.r[2][e]) - rc); k_[e] = kc + mu_k[e] * (0.5f * ((float)sr.k[0][e] + (float)sr.k[2][e]) - kc); \
            v_[e] = vc + mu_v[e] * (0.5f * ((float)sr.v[0][e] + (float)sr.v[2][e]) - vc); kk_[e] = k_[e] * k_k[e]; ss_ += kk_[e] * kk_[e]; w_[e] = (float)sr.w[e]; a_[e] = (float)sr.a[e]; } \
        ss_ = dpp_sum16(ss_); const float ri_ = rsqrtf(ss_ + 1e-12f); \
        _Pragma("unroll") for (int e = 0; e < 4; ++e) { kh_[e] = kk_[e] * ri_; kt_[e] = k_[e] * (1.0f + (a_[e] - 1.0f) * k_a[e]); b_[e] = a_[e] * kh_[e]; rk_ += r_[e] * kt_[e] * r_k[e]; } \
        rk_ = dpp_sum16(rk_); if (cq == 0) RK[((size_t)dir * M + row0 + t_) * 8 + h] = rk_; \
        LAS float* sb_ = st + ((chunk) & 1) * ST_BUF + tt * ST_STEP + cq * 4; \
        *(LAS f32x4*)(sb_) = kh_; *(LAS f32x4*)(sb_ + 64) = w_; *(LAS f32x4*)(sb_ + 128) = b_; *(LAS f32x4*)(sb_ + 192) = kt_; *(LAS f32x4*)(sb_ + 256) = r_; *(LAS f32x4*)(sb_ + 320) = v_; } while (0)
    SCAN_LOAD(0);
    SCAN_STAGE(0);
    __syncthreads();
    for (int chunk = 0; chunk < nch; ++chunk) {
        if (chunk + 1 < nch) SCAN_LOAD(chunk + 1);
        const LAS float* sb = st + (chunk & 1) * ST_BUF + ks * 8;
        const LAS float* vb = st + (chunk & 1) * ST_BUF + 320 + srow;
#pragma unroll 2
        for (int s = 0; s < TC; ++s) {
            const LAS float* q = sb + s * ST_STEP;
            const f32x4 kh0 = *(const LAS f32x4*)(q), kh1 = *(const LAS f32x4*)(q + 4);
            const f32x4 w0 = *(const LAS f32x4*)(q + 64), w1 = *(const LAS f32x4*)(q + 68);
            const f32x4 b0 = *(const LAS f32x4*)(q + 128), b1 = *(const LAS f32x4*)(q + 132);
            const f32x4 t0 = *(const LAS f32x4*)(q + 192), t1 = *(const LAS f32x4*)(q + 196);
            const f32x4 r0 = *(const LAS f32x4*)(q + 256), r1 = *(const LAS f32x4*)(q + 260);
            const float v = vb[s * ST_STEP];
            float sk = (S[0] * kh0[0] + S[1] * kh0[1]) + (S[2] * kh0[2] + S[3] * kh0[3]) + ((S[4] * kh1[0] + S[5] * kh1[1]) + (S[6] * kh1[2] + S[7] * kh1[3]));
            sk = dpp_sum8(sk);
#pragma unroll
            for (int e = 0; e < 4; ++e) { S[e] = S[e] * w0[e] + (v * t0[e] - sk * b0[e]); S[4 + e] = S[4 + e] * w1[e] + (v * t1[e] - sk * b1[e]); }
            float y = (S[0] * r0[0] + S[1] * r0[1]) + (S[2] * r0[2] + S[3] * r0[3]) + ((S[4] * r1[0] + S[5] * r1[1]) + (S[6] * r1[2] + S[7] * r1[3]));
            y = dpp_sum8(y);
            const int Sg = chunk * TC + s; const int t = dir ? T - 1 - Sg : Sg;
            if (ks == 0) Y[((size_t)dir * M + row0 + t) * CW + h * HD + srow] = (f16)y;
        }
        if (chunk + 1 < nch) SCAN_STAGE(chunk + 1);
        __syncthreads();
    }
#undef SCAN_LOAD
#undef SCAN_STAGE
    if (!smp) { GAS float* so = p.out + O_ST + (((((size_t)sq * NL + l) * 2 + dir) * NH + h) * HD + srow) * HD + ks * 8;
        *(GAS f32x4*)so = (f32x4){S[0], S[1], S[2], S[3]}; *(GAS f32x4*)(so + 4) = (f32x4){S[4], S[5], S[6], S[7]}; }
}
__device__ __forceinline__ void fast_scan(const Params& p0, const Ctx& c0, int l) {
    const Ctx c = fresh(c0); FRESH_P(p0);
    const int b = c.bid;
    if (b < 64) scan_task(p, c, l, b);
    else for (int task = b; task < 576; task += 192) scan_task(p, c, l, task);
}


namespace ms {
constexpr int O_AM = 0, O_BM = 4608, O_AT = 9216, O_VP = 14336, O_GT = 19456, O_NF = 22016, O_WM = 23040, O_WE = 23296, BUF = 23552;
constexpr int RS = 144, RT = 80;
}
__device__ __forceinline__ void mscan_task(const DParams& p, const Ctx& c, int l, int task) {
    using namespace ms;
    const GAS f16* PROJ = (const GAS f16*)(p.ws + WS_R1); const GAS f16* WA = (const GAS f16*)(p.ws + WS_R2);
    GAS f16* Y = (GAS f16*)(p.ws + WS_R3); GAS float* RK = (GAS float*)(p.ws + WS_RK);
    int sq, dir, h;
    if (task < 64) { h = task & 7; dir = (task >> 3) & 1; sq = B_CTX + (task >> 4); } else { const int id = task - 64; h = id & 7; dir = (id >> 3) & 1; sq = id >> 4; }
    const bool smp = sq >= B_CTX; const int T = smp ? T_SMP : T_CTX; const int row0 = smp ? M_CTX + (sq - B_CTX) * T_SMP : sq * T_CTX;
    const int nch = T / 16;
    const int vl = c.lane & 31, hh = c.lane >> 5;
    const int tq = c.tid - 128, ss = (tq >> 4) & 15, cq = tq & 15, k0 = cq * 4, ch0 = h * HD + k0;
    LAS float* cst = (LAS float*)(c.lds + 3 * BUF);
    if (c.wave == 7) { const int chn_ = h * HD + c.lane;
        cst[c.lane] = IN(15)[(l * 3 + 0) * CW + chn_]; cst[64 + c.lane] = IN(15)[(l * 3 + 1) * CW + chn_]; cst[128 + c.lane] = IN(15)[(l * 3 + 2) * CW + chn_];
        cst[192 + c.lane] = IN(16)[l * CW + chn_]; cst[256 + c.lane] = IN(17)[l * CW + chn_]; cst[320 + c.lane] = IN(18)[l * CW + chn_]; }

#define MS_BARRIER() do { asm volatile("s_waitcnt lgkmcnt(0)" ::: "memory"); __builtin_amdgcn_s_barrier(); asm volatile("" ::: "memory"); } while (0)
    if (c.wave >= 2 && c.wave < 6) {
    f16x4 G_rc, G_kc, G_vc, G_rp, G_kp, G_vp, G_rn, G_kn, G_vn, G_av, G_wo, G_wp, G_w7;
    { const f16x4 z4 = {(f16)0.f, (f16)0.f, (f16)0.f, (f16)0.f}; G_rc = G_kc = G_vc = G_rp = G_kp = G_vp = G_rn = G_kn = G_vn = G_av = G_wo = G_wp = G_w7 = z4; }
        for (int it = -3; it < nch; ++it) {
            const int ch = it + 2;
            if (ch >= 0 && ch < nch) {
                LAS unsigned char* buf = c.lds + (ch % 3) * BUF;
                const int Sg = ch * 16 + ss; const int t = dir ? T - 1 - Sg : Sg; const size_t row = (size_t)row0 + t;
                const f32x4 mu_r = *(const LAS f32x4*)(cst + k0), mu_k = *(const LAS f32x4*)(cst + 64 + k0), mu_v = *(const LAS f32x4*)(cst + 128 + k0), k_k = *(const LAS f32x4*)(cst + 192 + k0), k_a = *(const LAS f32x4*)(cst + 256 + k0), r_k = *(const LAS f32x4*)(cst + 320 + k0);
                f32x4 r_, k_, v_, kk_, kh_, kt_, b_; float sq_ = 0.f, rk_ = 0.f;
                const float mp_ = t > 0 ? 0.5f : 0.f, mn_ = t < T - 1 ? 0.5f : 0.f;
#pragma unroll
                for (int e = 0; e < 4; ++e) { const float rcf = (float)G_rc[e], kcf = (float)G_kc[e], vcf = (float)G_vc[e];
                    r_[e] = rcf + mu_r[e] * ((mp_ * (float)G_rp[e] + mn_ * (float)G_rn[e]) - rcf); k_[e] = kcf + mu_k[e] * ((mp_ * (float)G_kp[e] + mn_ * (float)G_kn[e]) - kcf);
                    v_[e] = vcf + mu_v[e] * ((mp_ * (float)G_vp[e] + mn_ * (float)G_vn[e]) - vcf); kk_[e] = k_[e] * k_k[e]; sq_ += kk_[e] * kk_[e]; }
                sq_ = dpp_sum16(sq_); const float ri_ = rsqrtf(sq_ + 1e-12f);
#pragma unroll
                for (int e = 0; e < 4; ++e) { const float a_ = (float)G_av[e]; kh_[e] = kk_[e] * ri_; kt_[e] = k_[e] * (1.0f + (a_ - 1.0f) * k_a[e]); b_[e] = a_ * kh_[e]; rk_ += r_[e] * kt_[e] * r_k[e]; }
                rk_ = dpp_sum16(rk_); if (cq == 0) RK[((size_t)dir * M + row) * 8 + h] = rk_;
                float al[4], be[4], ka[4], rho[4];
#pragma unroll
                for (int e = 0; e < 4; ++e) { const float wm7 = (float)G_w7[e]; const float om = ss == 7 ? 1.0f : (float)G_wo[e]; const float omp = ss == 0 ? __builtin_amdgcn_rcpf(wm7) : (ss == 8 ? 1.0f : (float)G_wp[e]);
                    const float iom = __builtin_amdgcn_rcpf(om); al[e] = omp * kh_[e]; be[e] = b_[e] * iom; ka[e] = kt_[e] * iom; rho[e] = om * r_[e]; }
                v2u w2;
                w2.x = pkh(al[0], al[1]); w2.y = pkh(al[2], al[3]); *(LAS v2u*)(buf + O_BM + ss * RS + k0 * 2) = w2;
                w2.x = pkh(rho[0], rho[1]); w2.y = pkh(rho[2], rho[3]); *(LAS v2u*)(buf + O_BM + (16 + ss) * RS + k0 * 2) = w2;
                w2.x = pkh(be[0], be[1]); w2.y = pkh(be[2], be[3]); *(LAS v2u*)(buf + O_AM + ss * RS + k0 * 2) = w2;
                w2.x = pkh(ka[0], ka[1]); w2.y = pkh(ka[2], ka[3]); *(LAS v2u*)(buf + O_AM + (16 + ss) * RS + k0 * 2) = w2;
#pragma unroll
                for (int e = 0; e < 4; ++e) { *(LAS f16*)(buf + O_AT + (k0 + e) * RT + ss * 2) = (f16)ka[e]; *(LAS f16*)(buf + O_AT + (k0 + e) * RT + (16 + ss) * 2) = (f16)be[e];
                    *(LAS f16*)(buf + O_VP + (k0 + e) * RT + ss * 2) = (f16)v_[e]; }
                if (ss == 15) { f32x4 wm_, we_;
#pragma unroll
                    for (int e = 0; e < 4; ++e) { wm_[e] = (float)G_w7[e]; we_[e] = (float)G_wo[e]; }
                    *(LAS f32x4*)(buf + O_WM + k0 * 4) = wm_; *(LAS f32x4*)(buf + O_WE + k0 * 4) = we_; }
            }
            const int chn = it + 3;
            if (chn < nch) {
                const int Sg = chn * 16 + ss; const int t = dir ? T - 1 - Sg : Sg; const size_t row = (size_t)row0 + t;
                const GAS f16* pr = PROJ + row * DIN + ch0;
                const f16x4 z4 = {(f16)0.f, (f16)0.f, (f16)0.f, (f16)0.f};
                G_rc = *(const GAS f16x4*)(pr + PC_R); G_kc = *(const GAS f16x4*)(pr + PC_K); G_vc = *(const GAS f16x4*)(pr + PC_V);
                { const GAS f16* prp = t > 0 ? pr - DIN : pr; const GAS f16* prn = t < T - 1 ? pr + DIN : pr;
                  G_rp = *(const GAS f16x4*)(prp + PC_R); G_kp = *(const GAS f16x4*)(prp + PC_K); G_vp = *(const GAS f16x4*)(prp + PC_V);
                  G_rn = *(const GAS f16x4*)(prn + PC_R); G_kn = *(const GAS f16x4*)(prn + PC_K); G_vn = *(const GAS f16x4*)(prn + PC_V); }
                G_av = *(const GAS f16x4*)(WA + row * 2048 + 1024 + dir * 512 + ch0);
                const GAS f16* wo = WA + row * 2048 + dir * 512 + ch0;
                G_wo = *(const GAS f16x4*)wo; G_wp = *(const GAS f16x4*)(wo + (ss > 0 ? (dir ? 2048 : -2048) : 0)); G_w7 = *(const GAS f16x4*)(wo + (long)(7 - ss) * (dir ? -2048 : 2048));
            }
            MS_BARRIER();
        }
    } else if (c.wave == 6) {
        for (int it = -3; it < nch; ++it) {
            const int ch = it + 1;
            if (ch >= 0 && ch < nch) {
                LAS unsigned char* buf = c.lds + (ch % 3) * BUF;
                f32x16 g;
#pragma unroll
                for (int i = 0; i < 16; ++i) g[i] = 0.f;
#pragma unroll
                for (int s = 0; s < 4; ++s) { const f16x8 a = *(const LAS f16x8*)(buf + O_AM + vl * RS + (16 * s + 8 * hh) * 2), b = *(const LAS f16x8*)(buf + O_BM + vl * RS + (16 * s + 8 * hh) * 2);
                    g = __builtin_amdgcn_mfma_f32_32x32x16_f16(a, b, g, 0, 0, 0); }
                const int tcol = vl & 15; const bool incl = vl >= 16;
#pragma unroll
                for (int gq = 0; gq < 4; ++gq) { float o[4];
#pragma unroll
                    for (int e = 0; e < 4; ++e) { const int ip = 8 * gq + 4 * hh + e, i = ip & 15; const bool ok = incl ? (i <= tcol) : (i < tcol); o[e] = ok ? g[4 * gq + e] : 0.f; }
                    v2u w2; w2.x = pkh(o[0], o[1]); w2.y = pkh(o[2], o[3]);
                    *(LAS v2u*)(buf + O_GT + vl * RT + (8 * gq + 4 * hh) * 2) = w2;
                    if (gq < 2 && vl < 16) *(LAS f32x4*)(buf + O_NF + vl * 64 + (8 * gq + 4 * hh) * 4) = (f32x4){o[0], o[1], o[2], o[3]}; }
            }
            MS_BARRIER();
        }
    } else if (c.wave == 7) {
        unsigned pa0 = 0u, pa1 = 0u, pb0 = 0u, pb1 = 0u, pc0 = 0u, pc1 = 0u;
#define MS_TOUCH(chp_, r0_, r1_) do { const int chp = (chp_); if (chp < nch) { \
            _Pragma("unroll") for (int q_ = 0; q_ < 2; ++q_) { const int i_ = c.lane + 64 * q_; if (i_ < 86) { const GAS unsigned* a_; \
                if (i_ < 54) { const int rr_ = i_ / 3, sg_ = i_ - 3 * rr_; int t_ = dir ? T - 17 - 16 * chp + rr_ : 16 * chp - 1 + rr_; t_ = t_ < 0 ? 0 : (t_ > T - 1 ? T - 1 : t_); \
                    a_ = (const GAS unsigned*)(PROJ + (size_t)(row0 + t_) * DIN + (sg_ == 0 ? PC_R : (sg_ == 1 ? PC_K : PC_V)) + h * HD); } \
                else { const int j_ = i_ - 54, rr_ = j_ >> 1; const int t_ = dir ? T - 16 - 16 * chp + rr_ : 16 * chp + rr_; \
                    a_ = (const GAS unsigned*)(WA + (size_t)(row0 + t_) * 2048 + (j_ & 1) * 1024 + dir * 512 + h * HD); } \
                if (q_ == 0) r0_ = *a_; else r1_ = *a_; } } } } while (0)
        unsigned px0 = 0u, px1 = 0u, px2 = 0u, px3 = 0u, px4 = 0u, px5 = 0u;
        MS_TOUCH(0, px0, px1); MS_TOUCH(1, px2, px3); MS_TOUCH(2, px4, px5);
        for (int it = -3; it < nch; it += 3) {
            asm volatile("" :: "v"(pa0), "v"(pa1)); MS_TOUCH(it + 6, pa0, pa1); MS_BARRIER();
            if (it + 1 < nch) { asm volatile("" :: "v"(pb0), "v"(pb1)); MS_TOUCH(it + 7, pb0, pb1); MS_BARRIER(); }
            if (it + 2 < nch) { asm volatile("" :: "v"(pc0), "v"(pc1)); MS_TOUCH(it + 8, pc0, pc1); MS_BARRIER(); }
        }
        asm volatile("" :: "v"(px0), "v"(px1), "v"(px2), "v"(px3), "v"(px4), "v"(px5), "v"(pa0), "v"(pa1), "v"(pb0), "v"(pb1), "v"(pc0), "v"(pc1));
#undef MS_TOUCH
    } else {
    f32x16 St0, St1;
#pragma unroll
    for (int i = 0; i < 16; ++i) { St0[i] = 0.f; St1[i] = 0.f; }
    if (smp) { float one_ = 1.0f; asm volatile("" : "+v"(one_));
        const GAS float* s0 = IN(4) + (((((size_t)(sq - B_CTX) * NL + l) * 2 + dir) * NH + h) * HD + 32 * c.wave + vl) * HD + 4 * hh;
#pragma unroll
        for (int g = 0; g < 4; ++g) { const f32x4 a = *(const GAS f32x4*)(s0 + 8 * g), b = *(const GAS f32x4*)(s0 + 32 + 8 * g);
#pragma unroll
            for (int e = 0; e < 4; ++e) { St0[4 * g + e] = a[e] * one_; St1[4 * g + e] = b[e] * one_; } }
    }
        for (int it = -3; it < nch; ++it) {
            const int ch = it;
            if (ch >= 0) {
                LAS unsigned char* buf = c.lds + (ch % 3) * BUF;
                const int v = 32 * c.wave + vl;
                if (ch == 0) {
#pragma unroll
                for (int gq = 0; gq < 4; ++gq) { const f32x4 m0 = *(const LAS f32x4*)(buf + O_WM + (8 * gq + 4 * hh) * 4), m1 = *(const LAS f32x4*)(buf + O_WM + (32 + 8 * gq + 4 * hh) * 4);
#pragma unroll
                    for (int e = 0; e < 4; ++e) { St0[4 * gq + e] *= m0[e]; St1[4 * gq + e] *= m1[e]; } }
                }
                f16x4 bmlo[4], bmhi[4];
#pragma unroll
                for (int s = 0; s < 4; ++s) { bmlo[s] = *(const LAS f16x4*)(buf + O_BM + vl * RS + (16 * s + 4 * hh) * 2); bmhi[s] = *(const LAS f16x4*)(buf + O_BM + vl * RS + (16 * s + 8 + 4 * hh) * 2); }
                const f16x8 gtk = *(const LAS f16x8*)(buf + O_GT + vl * RT + (16 + 8 * hh) * 2), vpv = *(const LAS f16x8*)(buf + O_VP + v * RT + (8 * hh) * 2);
                const f16x8 aN = *(const LAS f16x8*)(buf + O_GT + vl * RT + (8 * hh) * 2);
                f32x4 nf[4][3];
#pragma unroll
                for (int a = 0; a < 4; ++a)
#pragma unroll
                    for (int e = 0; e < 3; ++e) nf[a][e] = *(const LAS f32x4*)(buf + O_NF + (4 * a + 1 + e) * 64 + 16 * a);
                f16x8 at0[2], at1[2];
#pragma unroll
                for (int s2 = 0; s2 < 2; ++s2) { at0[s2] = *(const LAS f16x8*)(buf + O_AT + vl * RT + (16 * s2 + 8 * hh) * 2); at1[s2] = *(const LAS f16x8*)(buf + O_AT + (32 + vl) * RT + (16 * s2 + 8 * hh) * 2); }
                f32x4 sc0[4], sc1[4];
                { LAS unsigned char* nbuf = c.lds + ((ch + 1) % 3) * BUF; const bool more = ch + 1 < nch;
#pragma unroll
                  for (int gq = 0; gq < 4; ++gq) { sc0[gq] = *(const LAS f32x4*)(buf + O_WE + (8 * gq + 4 * hh) * 4); sc1[gq] = *(const LAS f32x4*)(buf + O_WE + (32 + 8 * gq + 4 * hh) * 4);
                    if (more) { sc0[gq] *= *(const LAS f32x4*)(nbuf + O_WM + (8 * gq + 4 * hh) * 4); sc1[gq] *= *(const LAS f32x4*)(nbuf + O_WM + (32 + 8 * gq + 4 * hh) * 4); } } }
                f32x16 X;
#pragma unroll
                for (int i = 0; i < 16; ++i) X[i] = 0.f;
#pragma unroll
                for (int s = 0; s < 4; ++s) {
                    f16x8 sb;
#pragma unroll
                    for (int j = 0; j < 8; ++j) sb[j] = (f16)((s < 2) ? St0[8 * (s & 1) + j] : St1[8 * (s & 1) + j]);
                    const f16x8 af = {bmlo[s][0], bmlo[s][1], bmlo[s][2], bmlo[s][3], bmhi[s][0], bmhi[s][1], bmhi[s][2], bmhi[s][3]};
                    X = __builtin_amdgcn_mfma_f32_32x32x16_f16(af, sb, X, 0, 0, 0);
                }
                X = __builtin_amdgcn_mfma_f32_32x32x16_f16(gtk, vpv, X, 0, 0, 0);
                f16x8 pball;
#pragma unroll
                for (int j = 0; j < 8; ++j) pball[j] = (f16)0.f;
#define MS_BLK(a) do { const int xo_ = 4 * ((a) >> 1); \
                    const f32x4 n1_ = nf[a][0], n2_ = nf[a][1], n3_ = nf[a][2]; \
                    float q0_ = X[xo_]; float q1_ = X[xo_ + 1] - q0_ * n1_[0]; float q2_ = X[xo_ + 2] - q0_ * n2_[0] - q1_ * n2_[1]; float q3_ = X[xo_ + 3] - q0_ * n3_[0] - q1_ * n3_[1] - q2_ * n3_[2]; \
                    if (((a) & 1) != ((a) >> 1)) { float a_, b_; \
                        a_ = q0_; b_ = q0_; swap32(a_, b_); q0_ = ((a) & 1) ? b_ : a_; a_ = q1_; b_ = q1_; swap32(a_, b_); q1_ = ((a) & 1) ? b_ : a_; \
                        a_ = q2_; b_ = q2_; swap32(a_, b_); q2_ = ((a) & 1) ? b_ : a_; a_ = q3_; b_ = q3_; swap32(a_, b_); q3_ = ((a) & 1) ? b_ : a_; } \
                    const bool hold_ = hh == ((a) >> 1); \
                    const f16 z_ = (f16)0.f; const f16 e0_ = hold_ ? (f16)(-q0_) : z_, e1_ = hold_ ? (f16)(-q1_) : z_, e2_ = hold_ ? (f16)(-q2_) : z_, e3_ = hold_ ? (f16)(-q3_) : z_; \
                    f16x8 pb_ = {z_, z_, z_, z_, z_, z_, z_, z_}; \
                    pb_[4 * ((a) & 1)] = e0_; pb_[4 * ((a) & 1) + 1] = e1_; pb_[4 * ((a) & 1) + 2] = e2_; pb_[4 * ((a) & 1) + 3] = e3_; \
                    if (hold_) { pball[4 * ((a) & 1)] = e0_; pball[4 * ((a) & 1) + 1] = e1_; pball[4 * ((a) & 1) + 2] = e2_; pball[4 * ((a) & 1) + 3] = e3_; } \
                    X = __builtin_amdgcn_mfma_f32_32x32x16_f16(aN, pb_, X, 0, 0, 0); } while (0)
                MS_BLK(0); MS_BLK(1); MS_BLK(2); MS_BLK(3);
#undef MS_BLK
                St0 = __builtin_amdgcn_mfma_f32_32x32x16_f16(at0[0], vpv, St0, 0, 0, 0); St1 = __builtin_amdgcn_mfma_f32_32x32x16_f16(at1[0], vpv, St1, 0, 0, 0);
                St0 = __builtin_amdgcn_mfma_f32_32x32x16_f16(at0[1], pball, St0, 0, 0, 0); St1 = __builtin_amdgcn_mfma_f32_32x32x16_f16(at1[1], pball, St1, 0, 0, 0);
#pragma unroll
                for (int r = 8; r < 16; ++r) { const int t = (r & 3) + 8 * ((r >> 2) - 2) + 4 * hh; const int Sg = ch * 16 + t; const int tok = dir ? T - 1 - Sg : Sg;
                    Y[((size_t)dir * M + row0 + tok) * CW + h * HD + v] = (f16)X[r]; }
#pragma unroll
                for (int gq = 0; gq < 4; ++gq)
#pragma unroll
                    for (int e = 0; e < 4; ++e) { St0[4 * gq + e] *= sc0[gq][e]; St1[4 * gq + e] *= sc1[gq][e]; }
            }
            MS_BARRIER();
        }
    if (!smp) {
        GAS float* so = p.out + O_ST + (((((size_t)sq * NL + l) * 2 + dir) * NH + h) * HD + 32 * c.wave + vl) * HD + 4 * hh;
#pragma unroll
        for (int g = 0; g < 4; ++g) { *(GAS f32x4*)(so + 8 * g) = (f32x4){St0[4 * g], St0[4 * g + 1], St0[4 * g + 2], St0[4 * g + 3]};
            *(GAS f32x4*)(so + 32 + 8 * g) = (f32x4){St1[4 * g], St1[4 * g + 1], St1[4 * g + 2], St1[4 * g + 3]}; }
    }
    }
#undef MS_BARRIER
}
__device__ __forceinline__ void mfma_scan(const Params& p0, const Ctx& c0, int l) {
    const Ctx c = fresh(c0); FRESH_P(p0);
    const int b = c.bid, G = (int)gridDim.x;
    const bool deal = G >= 128;
    const int first = b, step = deal ? (b < 64 ? 576 : G - 64) : G;
#pragma nounroll
    for (int task = first; task < 576; task += step) mscan_task(p, c, l, task);
}

__device__ __forceinline__ int swap23(int r) { return (r & ~12) | ((r & 4) << 1) | ((r & 8) >> 1); }
__device__ __forceinline__ void attn_wave_task(const DParams& p, const Ctx& c, int l, int task) {
    const GAS f16* PROJ = (const GAS f16*)(p.ws + WS_R1); const GAS f16* KN = (const GAS f16*)(p.ws + WS_KN); const GAS f16* VT = (const GAS f16*)(p.ws + WS_VT);
    GAS f16* OA = (GAS f16*)(p.ws + WS_R4);
    const int hq = task & 7, qb = task >> 3, kvh = hq >> 2;
    const int r32 = c.lane & 31, hh = c.lane >> 5;
    int rowq0, L; const GAS f16* Kb; const GAS f16* Vb; bool smp;
    if (qb < 128) { smp = true; rowq0 = M_CTX + qb * 32; const int b = qb >> 5; L = KV_SMP;
        Kb = KN + KN_SMP_OFF + ((size_t)b * 2 + kvh) * KV_SMP * HD; Vb = VT + KN_SMP_OFF + ((size_t)b * 2 + kvh) * HD * KV_SMP; }
    else { smp = false; rowq0 = (qb - 128) * 32; const int b = rowq0 >> 8; L = T_CTX;
        Kb = KN + ((size_t)b * 2 + kvh) * T_CTX * HD; Vb = VT + ((size_t)b * 2 + kvh) * HD * T_CTX; }
    const int row = rowq0 + r32;
    float x[4][8]; float ss = 0.f;
#pragma unroll
    for (int s = 0; s < 4; ++s) { const f16x8 q = *(const GAS f16x8*)(PROJ + (size_t)row * DIN + PC_Q + hq * HD + 16 * s + 8 * hh);
#pragma unroll
        for (int j = 0; j < 8; ++j) { x[s][j] = (float)q[j]; ss += x[s][j] * x[s][j]; } }
    ss = half_sum(ss);
    const float rstd = rsqrtf(ss * (1.0f / HD) + 1e-6f);
#pragma unroll
    for (int s = 0; s < 4; ++s)
#pragma unroll
        for (int j = 0; j < 8; ++j) x[s][j] *= rstd * IN(26)[l * HD + 16 * s + 8 * hh + j];
    if (smp) { const int t = (row - M_CTX) & (T_SMP - 1); const float posr = (float)(t >> 6), posc = (float)(t & 63);
#pragma unroll
        for (int j = 0; j < 8; ++j) { const float freq = exp2f(-(float)(8 * hh + j) * (13.287712379549449f / 16.0f));
            const float ar = posr * freq, ac = posc * freq; const float cr = __cosf(ar), sr = __sinf(ar), cc = __cosf(ac), sc = __sinf(ac);
            const float a0 = x[0][j], a1 = x[1][j], b0 = x[2][j], b1 = x[3][j];
            x[0][j] = a0 * cr - a1 * sr; x[1][j] = a1 * cr + a0 * sr; x[2][j] = b0 * cc - b1 * sc; x[3][j] = b1 * cc + b0 * sc; } }
    f16x8 qf[4];
#pragma unroll
    for (int s = 0; s < 4; ++s)
#pragma unroll
        for (int j = 0; j < 8; ++j) qf[s][j] = (f16)(x[s][j] * (0.125f * 1.4426950408889634f));
    f32x16 o0, o1;
#pragma unroll
    for (int i = 0; i < 16; ++i) { o0[i] = 0.f; o1[i] = 0.f; }
    float mrun = -1e30f, lsum = 0.f;
    const GAS f16* kp = Kb + (size_t)swap23(r32) * HD + 8 * hh;
    const GAS f16* vp = Vb + (size_t)r32 * L + 8 * hh;
    const int ntile = L >> 5;
    f16x8 kf[4], vf[4];
#pragma unroll
    for (int s = 0; s < 4; ++s) kf[s] = *(const GAS f16x8*)(kp + 16 * s);
    vf[0] = *(const GAS f16x8*)(vp); vf[1] = *(const GAS f16x8*)(vp + 16); vf[2] = *(const GAS f16x8*)(vp + (size_t)32 * L); vf[3] = *(const GAS f16x8*)(vp + (size_t)32 * L + 16);
    for (int kt = 0; kt < ntile; ++kt) {
        f16x8 kn[4], vn[4];
        const int ktn = kt + 1 < ntile ? kt + 1 : kt;
#pragma unroll
        for (int s = 0; s < 4; ++s) kn[s] = *(const GAS f16x8*)(kp + (size_t)ktn * 32 * HD + 16 * s);
        vn[0] = *(const GAS f16x8*)(vp + ktn * 32); vn[1] = *(const GAS f16x8*)(vp + ktn * 32 + 16); vn[2] = *(const GAS f16x8*)(vp + (size_t)32 * L + ktn * 32); vn[3] = *(const GAS f16x8*)(vp + (size_t)32 * L + ktn * 32 + 16);
        f32x16 sa;
#pragma unroll
        for (int i = 0; i < 16; ++i) sa[i] = 0.f;
#pragma unroll
        for (int s = 0; s < 4; ++s) sa = __builtin_amdgcn_mfma_f32_32x32x16_f16(kf[s], qf[s], sa, 0, 0, 0);
        float mt = sa[0];
#pragma unroll
        for (int i = 1; i < 16; ++i) mt = fmaxf(mt, sa[i]);
        mt = half_max(mt);
        const float mn = fmaxf(mrun, mt); const float alpha = exp2f(mrun - mn); mrun = mn;
        float ps = 0.f;
#pragma unroll
        for (int i = 0; i < 16; ++i) { sa[i] = exp2f(sa[i] - mn); ps += sa[i]; }
        lsum = lsum * alpha + ps;
#pragma unroll
        for (int i = 0; i < 16; ++i) { o0[i] *= alpha; o1[i] *= alpha; }
        f16x8 pb0, pb1;
#pragma unroll
        for (int j = 0; j < 8; ++j) { pb0[j] = (f16)sa[j]; pb1[j] = (f16)sa[8 + j]; }
        o0 = __builtin_amdgcn_mfma_f32_32x32x16_f16(vf[0], pb0, o0, 0, 0, 0);
        o0 = __builtin_amdgcn_mfma_f32_32x32x16_f16(vf[1], pb1, o0, 0, 0, 0);
        o1 = __builtin_amdgcn_mfma_f32_32x32x16_f16(vf[2], pb0, o1, 0, 0, 0);
        o1 = __builtin_amdgcn_mfma_f32_32x32x16_f16(vf[3], pb1, o1, 0, 0, 0);
#pragma unroll
        for (int s = 0; s < 4; ++s) { kf[s] = kn[s]; vf[s] = vn[s]; }
    }
    lsum = half_sum(lsum);
    const float inv = 1.0f / lsum;
    GAS f16* op = OA + (size_t)row * D + CW + hq * HD + 4 * hh;
#pragma unroll
    for (int g = 0; g < 4; ++g) {
        v2u w0; w0.x = pkh(o0[4 * g] * inv, o0[4 * g + 1] * inv); w0.y = pkh(o0[4 * g + 2] * inv, o0[4 * g + 3] * inv);
        v2u w1; w1.x = pkh(o1[4 * g] * inv, o1[4 * g + 1] * inv); w1.y = pkh(o1[4 * g + 2] * inv, o1[4 * g + 3] * inv);
        *(GAS v2u*)(op + 8 * g) = w0; *(GAS v2u*)(op + 32 + 8 * g) = w1; }
}
constexpr int AT_KS = 144, AT_BUF = 2 * 64 * AT_KS;
__device__ __forceinline__ void attn_block_task(const DParams& p, const Ctx& c, int l, int item) {
    const GAS f16* PROJ = (const GAS f16*)(p.ws + WS_R1); const GAS f16* KN = (const GAS f16*)(p.ws + WS_KN); const GAS f16* VT = (const GAS f16*)(p.ws + WS_VT);
    GAS f16* OA = (GAS f16*)(p.ws + WS_R4);
    int rowq0, L, kvh; const GAS f16* Kb; const GAS f16* Vb; bool smp;
    if (item < 128) { smp = true; const int b = item >> 5; kvh = (item >> 4) & 1; rowq0 = M_CTX + b * T_SMP + (item & 15) * 64; L = KV_SMP;
        Kb = KN + KN_SMP_OFF + ((size_t)b * 2 + kvh) * KV_SMP * HD; Vb = VT + KN_SMP_OFF + ((size_t)b * 2 + kvh) * HD * KV_SMP; }
    else { smp = false; const int id = item - 128; const int b = id >> 3; kvh = (id >> 2) & 1; rowq0 = b * T_CTX + (id & 3) * 64; L = T_CTX;
        Kb = KN + ((size_t)b * 2 + kvh) * T_CTX * HD; Vb = VT + ((size_t)b * 2 + kvh) * HD * T_CTX; }
    const int hq = kvh * 4 + (c.wave & 3);
    const int r32 = c.lane & 31, hh = c.lane >> 5;
    const int row = rowq0 + 32 * (c.wave >> 2) + r32;
    const int kk = c.tid >> 3, chk = c.tid & 7;
    const GAS f16* ksrc = Kb + (size_t)kk * HD + chk * 8;
    const GAS f16* vsrc = Vb + (size_t)kk * L + chk * 8;
    const int sdst = kk * AT_KS + chk * 16;
    v4u kreg = *(const GAS v4u*)ksrc, vreg = *(const GAS v4u*)vsrc;
    float x[4][8]; float ss = 0.f;
#pragma unroll
    for (int s = 0; s < 4; ++s) { const f16x8 q = *(const GAS f16x8*)(PROJ + (size_t)row * DIN + PC_Q + hq * HD + 16 * s + 8 * hh);
#pragma unroll
        for (int j = 0; j < 8; ++j) { x[s][j] = (float)q[j]; ss += x[s][j] * x[s][j]; } }
    ss = half_sum(ss);
    const float rstd = rsqrtf(ss * (1.0f / HD) + 1e-6f);
#pragma unroll
    for (int s = 0; s < 4; ++s)
#pragma unroll
        for (int j = 0; j < 8; ++j) x[s][j] *= rstd * IN(26)[l * HD + 16 * s + 8 * hh + j];
    if (smp) { const int t = (row - M_CTX) & (T_SMP - 1); const float posr = (float)(t >> 6), posc = (float)(t & 63);
#pragma unroll
        for (int j = 0; j < 8; ++j) { const float freq = exp2f(-(float)(8 * hh + j) * (13.287712379549449f / 16.0f));
            const float ar = posr * freq, ac = posc * freq; const float cr = __cosf(ar), sr = __sinf(ar), cc = __cosf(ac), sc = __sinf(ac);
            const float a0 = x[0][j], a1 = x[1][j], b0 = x[2][j], b1 = x[3][j];
            x[0][j] = a0 * cr - a1 * sr; x[1][j] = a1 * cr + a0 * sr; x[2][j] = b0 * cc - b1 * sc; x[3][j] = b1 * cc + b0 * sc; } }
    f16x8 qf[4];
#pragma unroll
    for (int s = 0; s < 4; ++s)
#pragma unroll
        for (int j = 0; j < 8; ++j) qf[s][j] = (f16)(x[s][j] * (0.125f * 1.4426950408889634f));
    f32x16 o0, o1;
#pragma unroll
    for (int i = 0; i < 16; ++i) { o0[i] = 0.f; o1[i] = 0.f; }
    float mrun = -1e30f, lsum = 0.f;
    const int nstep = L >> 6;
    *(LAS v4u*)(c.lds + sdst) = kreg; *(LAS v4u*)(c.lds + 64 * AT_KS + sdst) = vreg;
    asm volatile("s_waitcnt lgkmcnt(0)" ::: "memory"); __builtin_amdgcn_s_barrier(); asm volatile("" ::: "memory");
    const int koff = swap23(r32) * AT_KS + 16 * hh, voff = 64 * AT_KS + r32 * AT_KS + 16 * hh;
    for (int st = 0; st < nstep; ++st) {
        if (st + 1 < nstep) { kreg = *(const GAS v4u*)(ksrc + (size_t)(st + 1) * 64 * HD); vreg = *(const GAS v4u*)(vsrc + (st + 1) * 64); }
        LAS unsigned char* sb = c.lds + (st & 1) * AT_BUF;
        f32x16 sa0, sa1;
#pragma unroll
        for (int i = 0; i < 16; ++i) { sa0[i] = 0.f; sa1[i] = 0.f; }
#pragma unroll
        for (int s = 0; s < 4; ++s) { const f16x8 k0 = *(const LAS f16x8*)(sb + koff + 32 * s), k1 = *(const LAS f16x8*)(sb + koff + 32 * AT_KS + 32 * s);
            sa0 = __builtin_amdgcn_mfma_f32_32x32x16_f16(k0, qf[s], sa0, 0, 0, 0); sa1 = __builtin_amdgcn_mfma_f32_32x32x16_f16(k1, qf[s], sa1, 0, 0, 0); }
        float mt = fmaxf(sa0[0], sa1[0]);
#pragma unroll
        for (int i = 1; i < 16; ++i) mt = fmaxf(mt, fmaxf(sa0[i], sa1[i]));
        mt = half_max(mt);
        const float mn = fmaxf(mrun, mt); const float alpha = __builtin_amdgcn_exp2f(mrun - mn); mrun = mn;
        float ps = 0.f;
#pragma unroll
        for (int i = 0; i < 16; ++i) { sa0[i] = __builtin_amdgcn_exp2f(sa0[i] - mn); sa1[i] = __builtin_amdgcn_exp2f(sa1[i] - mn); ps += sa0[i] + sa1[i]; }
        lsum = lsum * alpha + ps;
#pragma unroll
        for (int i = 0; i < 16; ++i) { o0[i] *= alpha; o1[i] *= alpha; }
        f16x8 pb[4];
#pragma unroll
        for (int j = 0; j < 8; ++j) { pb[0][j] = (f16)sa0[j]; pb[1][j] = (f16)sa0[8 + j]; pb[2][j] = (f16)sa1[j]; pb[3][j] = (f16)sa1[8 + j]; }
#pragma unroll
        for (int q4 = 0; q4 < 4; ++q4) {
            const f16x8 v0 = *(const LAS f16x8*)(sb + voff + 32 * q4), v1 = *(const LAS f16x8*)(sb + voff + 32 * AT_KS + 32 * q4);
            o0 = __builtin_amdgcn_mfma_f32_32x32x16_f16(v0, pb[q4], o0, 0, 0, 0); o1 = __builtin_amdgcn_mfma_f32_32x32x16_f16(v1, pb[q4], o1, 0, 0, 0); }
        if (st + 1 < nstep) { LAS unsigned char* nb = c.lds + ((st + 1) & 1) * AT_BUF; *(LAS v4u*)(nb + sdst) = kreg; *(LAS v4u*)(nb + 64 * AT_KS + sdst) = vreg; }
        asm volatile("s_waitcnt lgkmcnt(0)" ::: "memory"); __builtin_amdgcn_s_barrier(); asm volatile("" ::: "memory");
    }
    lsum = half_sum(lsum);
    const float inv = 1.0f / lsum;
    GAS f16* op = OA + (size_t)row * D + CW + hq * HD + 4 * hh;
#pragma unroll
    for (int g = 0; g < 4; ++g) {
        v2u w0; w0.x = pkh(o0[4 * g] * inv, o0[4 * g + 1] * inv); w0.y = pkh(o0[4 * g + 2] * inv, o0[4 * g + 3] * inv);
        v2u w1; w1.x = pkh(o1[4 * g] * inv, o1[4 * g + 1] * inv); w1.y = pkh(o1[4 * g + 2] * inv, o1[4 * g + 3] * inv);
        *(GAS v2u*)(op + 8 * g) = w0; *(GAS v2u*)(op + 32 + 8 * g) = w1; }
}
__device__ __forceinline__ void fast_attn(const Params& p0, const Ctx& c0, int l) {
    const Ctx c = fresh(c0); FRESH_P(p0);
    unsigned* ctr = (unsigned*)(p0.ws + WS_CTL) + 8192 + 64 * l;
    volatile LAS unsigned* slot = (volatile LAS unsigned*)(c.lds + MISC_OFF) + 16;
    for (;;) {
        if (c.tid == 0) slot[0] = __hip_atomic_fetch_add(ctr, 1u, __ATOMIC_RELAXED, __HIP_MEMORY_SCOPE_AGENT);
        __syncthreads();
        const int item = (int)slot[0];
        __syncthreads();
        if (item >= 384) break;
        attn_block_task(p, c, l, item);
    }
}

__device__ __forceinline__ void post_phase(const Params& p0, const Ctx& c0, int l) {
    const Ctx c = fresh(c0); FRESH_P(p0);
    const GAS f16* PROJ = (const GAS f16*)(p.ws + WS_R1); const GAS f16* Y = (const GAS f16*)(p.ws + WS_R3); const GAS float* RK = (const GAS float*)(p.ws + WS_RK);
    GAS f16* OA = (GAS f16*)(p.ws + WS_R4);
    const int ch0 = c.lane * 8, h = c.lane >> 3;
    float gnw[8], gnb[8], muv[8];
    { const f32x4 a0 = *(const GAS f32x4*)(IN(24) + l * CW + ch0), a1 = *(const GAS f32x4*)(IN(24) + l * CW + ch0 + 4), b0 = *(const GAS f32x4*)(IN(25) + l * CW + ch0), b1 = *(const GAS f32x4*)(IN(25) + l * CW + ch0 + 4);
      const f32x4 m0 = *(const GAS f32x4*)(IN(15) + (l * 3 + 2) * CW + ch0), m1 = *(const GAS f32x4*)(IN(15) + (l * 3 + 2) * CW + ch0 + 4);
#pragma unroll
      for (int e = 0; e < 4; ++e) { gnw[e] = a0[e]; gnw[4 + e] = a1[e]; gnb[e] = b0[e]; gnb[4 + e] = b1[e]; muv[e] = m0[e]; muv[4 + e] = m1[e]; } }
    for (int row = c.gw; row < M; row += c.ngw) {
        int g, t, T; row_info(row, g, t, T);
        const GAS f16* pr = PROJ + (size_t)row * DIN + PC_V + ch0;
        const f16x8 y0 = *(const GAS f16x8*)(Y + (size_t)row * CW + ch0), y1 = *(const GAS f16x8*)(Y + ((size_t)M + row) * CW + ch0);
        const f16x8 vc = *(const GAS f16x8*)pr; const f16x8 gv = *(const GAS f16x8*)(OA + (size_t)row * D + ch0);
        f16x8 vp, vn;
#pragma unroll
        for (int e = 0; e < 8; ++e) { vp[e] = (f16)0.f; vn[e] = (f16)0.f; }
        if (t > 0) vp = *(const GAS f16x8*)(pr - DIN);
        if (t < T - 1) vn = *(const GAS f16x8*)(pr + DIN);
        const float rk = RK[(size_t)row * 8 + h] + RK[((size_t)M + row) * 8 + h];
        float y[8]; float s = 0.f;
#pragma unroll
        for (int e = 0; e < 8; ++e) { y[e] = (float)y0[e] + (float)y1[e]; s += y[e]; }
        const float mean = dpp_sum8(s) * (1.0f / HD); float q = 0.f;
#pragma unroll
        for (int e = 0; e < 8; ++e) { y[e] -= mean; q += y[e] * y[e]; }
        const float rstd = rsqrtf(dpp_sum8(q) * (1.0f / HD) + 64e-5f);
        float o[8];
#pragma unroll
        for (int e = 0; e < 8; ++e) { const float vcf = (float)vc[e]; const float v = vcf + muv[e] * (0.5f * ((float)vp[e] + (float)vn[e]) - vcf);
            o[e] = (y[e] * rstd * gnw[e] + gnb[e] + rk * v) * (float)gv[e]; }
        v4u w; w.x = pkh(o[0], o[1]); w.y = pkh(o[2], o[3]); w.z = pkh(o[4], o[5]); w.w = pkh(o[6], o[7]);
        *(GAS v4u*)(OA + (size_t)row * D + ch0) = w;
    }
}

__device__ __forceinline__ void gemm_proj(const Params& p0, const Ctx& c0) { const Ctx c = fresh(c0); FRESH_P(p0);
    pg8::Gemm g{(const GAS f16*)(p.ws + WS_R4), (const GAS f16*)(p.ws + WS_W + WO_IN), D, D, D}; pg8::StaticOrder S; S.init(M, DIN, (int)gridDim.x, c.bid);
    pg8::gemm_phase(c.lds, g, S, pg8::EpiProjF{(GAS f16*)(p.ws + WS_R1)}, c.wave); }
__device__ __forceinline__ void gemm_wa(const Params& p0, const Ctx& c0, int l) { const Ctx c = fresh(c0); FRESH_P(p0);
    pg8::Gemm g{(const GAS f16*)(p.ws + WS_R1) + PC_LW, (const GAS f16*)(p.ws + WS_W + WO_SM), DIN, 128, 128}; pg8::StaticOrder S; S.init(M, 2048, (int)gridDim.x, c.bid);
    pg8::gemm_phase(c.lds, g, S, pg8::EpiWAF{(GAS f16*)(p.ws + WS_R2), IN(19) + (size_t)l * 2 * CW, IN(21) + (size_t)l * 2 * CW}, c.wave); }
__device__ __forceinline__ void gemm_gate(const Params& p0, const Ctx& c0) { const Ctx c = fresh(c0); FRESH_P(p0);
    pg8::Gemm g{(const GAS f16*)(p.ws + WS_R1) + PC_LG, (const GAS f16*)(p.ws + WS_W + WO_G), DIN, 128, 128}; pg8::StaticOrder S; if (gridDim.x >= 224) S.init(M, CW, (int)gridDim.x, c.bid - 128); else S.init(M, CW, (int)gridDim.x, c.bid);
    pg8::gemm_phase(c.lds, g, S, pg8::EpiF16F{(GAS f16*)(p.ws + WS_R4), D}, c.wave); }
__device__ __forceinline__ void gemm_merge(const Params& p0, const Ctx& c0) { const Ctx c = fresh(c0); FRESH_P(p0);
    const GAS f16* OA = (const GAS f16*)(p.ws + WS_R4); const GAS f16* WbrT = (const GAS f16*)(p.ws + WS_W + WO_BR); GAS f16* MG = (GAS f16*)(p.ws + WS_R3); const GAS f16* PROJ = (const GAS f16*)(p.ws + WS_R1);
    pg8::StaticOrder S; S.init(M, D, (int)gridDim.x, c.bid, 192);
    pg8::Gemm g{OA, WbrT, D, D, D}; pg8::gemm_phase<pg8::EpiMergeF, 96>(c.lds, g, S, pg8::EpiMergeF{MG, PROJ}, c.wave); }
__device__ __forceinline__ void gemm_out(const Params& p0, const Ctx& c0) { const Ctx c = fresh(c0); FRESH_P(p0);
    pg8::Gemm g{(const GAS f16*)(p.ws + WS_R3), (const GAS f16*)(p.ws + WS_W + WO_OUT), D, D, D}; pg8::StaticOrder S; S.init(M, D, (int)gridDim.x, c.bid, 192);
    pg8::gemm_phase<pg8::EpiF16F, 96>(c.lds, g, S, pg8::EpiF16F{(GAS f16*)(p.ws + WS_R2), D}, c.wave); }
__device__ __forceinline__ void gemm_up(const Params& p0, const Ctx& c0) { const Ctx c = fresh(c0); FRESH_P(p0);
    pg8::Gemm g{(const GAS f16*)(p.ws + WS_R4), (const GAS f16*)(p.ws + WS_W + WO_UP), D, D, D}; pg8::StaticOrder S; S.init(M, DFF, (int)gridDim.x, c.bid);
    pg8::gemm_phase(c.lds, g, S, pg8::EpiRelu2F{(GAS f16*)(p.ws + WS_R1), DFF}, c.wave); }
__device__ __forceinline__ void gemm_down(const Params& p0, const Ctx& c0) { const Ctx c = fresh(c0); FRESH_P(p0);
    pg8::Gemm g{(const GAS f16*)(p.ws + WS_R1), (const GAS f16*)(p.ws + WS_W + WO_DN), DFF, DFF, DFF}; pg8::StaticOrder S; S.init(M, D, (int)gridDim.x, c.bid, 192);
    pg8::gemm_phase<pg8::EpiF16F, 96>(c.lds, g, S, pg8::EpiF16F{(GAS f16*)(p.ws + WS_R2), D}, c.wave); }

__global__ void __launch_bounds__(NTHREADS, 2) fwd_kernel(Params p) {
    extern __shared__ __attribute__((aligned(16))) unsigned char lds_raw[];
    Ctx c;
    c.lds = (LAS unsigned char*)lds_raw;
    c.tid = threadIdx.x; c.lane = c.tid & 63; c.wave = __builtin_amdgcn_readfirstlane(c.tid >> 6);
    c.gw = blockIdx.x * NWAVES + c.wave; c.ngw = gridDim.x * NWAVES; c.gt = blockIdx.x * NTHREADS + c.tid; c.ngt = gridDim.x * NTHREADS;
    volatile LAS unsigned* MISC = (volatile LAS unsigned*)(c.lds + MISC_OFF);
    if (c.tid < 32) MISC[c.tid] = 0u;
    if (c.tid < 28) ((LAS unsigned long long*)(c.lds + PTAB_OFF))[c.tid] = (unsigned long long)p.in[c.tid];
    __syncthreads();
    unsigned* ctl = (unsigned*)(p.ws + WS_CTL);
    XcdBarrier bar = xcd_barrier_post(ctl + CW_BAR, MISC + 8);
#define GRID_BAR() xcd_barrier(bar)

    conv_weights(p, c, 0);
    __syncthreads();
    mod_phase(p, c);
    GRID_BAR();
    norm_phase<0>(p, c, 0);
    GRID_BAR();
#pragma nounroll
    for (int l = 0; l < NL; ++l) {
        gemm_proj(p, c);
        GRID_BAR();
        gemm_wa(p, c, l);
        gemm_gate(p, c);
        kv_prep(p, c, l);
        GRID_BAR();
        mfma_scan(p, c, l);
        __syncthreads();
        fast_attn(p, c, l);
        GRID_BAR();
        post_phase(p, c, l);
        GRID_BAR();
        gemm_merge(p, c);
        GRID_BAR();
        gemm_out(p, c);
        GRID_BAR();
        norm_phase<1>(p, c, l);
        GRID_BAR();
        gemm_up(p, c);
        GRID_BAR();
        gemm_down(p, c);
        GRID_BAR();
        norm_phase<2>(p, c, l);
        if (l + 1 < NL) { __syncthreads(); conv_weights(p, c, l + 1); }
        GRID_BAR();
    }
}

extern "C" void kernel_launch(void* const* d_in, const int* in_sizes, int n_in, void* d_out, int out_size, void* d_ws, size_t ws_size, hipStream_t stream) {
    static int grid = 0;
    if (grid == 0) {
        if (n_in != 28 || (size_t)out_size != O_TOTAL || ws_size < WS_END) { fprintf(stderr, "kernel_launch: unexpected shapes n_in %d out %d ws %zu\n", n_in, out_size, ws_size); grid = -1; return; }
        int dev = 0, cus = 0;
        if (hipGetDevice(&dev) != hipSuccess || hipDeviceGetAttribute(&cus, hipDeviceAttributeMultiprocessorCount, dev) != hipSuccess) { grid = -1; return; }
        if (hipFuncSetAttribute((const void*)fwd_kernel, hipFuncAttributeMaxDynamicSharedMemorySize, LDS_BYTES) != hipSuccess) { fprintf(stderr, "kernel_launch: hipFuncSetAttribute failed\n"); grid = -1; return; }
        grid = cus;
    }
    if (grid < 0) return;
    (void)hipMemsetAsync((char*)d_ws + WS_CTL, 0, CTL_BYTES + MiB, stream);
    Params p{};
    for (int i = 0; i < 28; ++i) p.in[i] = (const float*)d_in[i];
    p.out = (float*)d_out; p.ws = (unsigned char*)d_ws;
    hipLaunchKernelGGL(fwd_kernel, dim3(grid), dim3(NTHREADS), LDS_BYTES, stream, p);
}
```

```cpp
#include <hip/hip_runtime.h>
#include <cstdio>
#include <cstdint>

#define GAS __attribute__((address_space(1)))
#define LAS __attribute__((address_space(3)))
typedef _Float16 f16;
typedef _Float16 f16x8 __attribute__((ext_vector_type(8)));
typedef _Float16 f16x4 __attribute__((ext_vector_type(4)));
typedef _Float16 f16x2 __attribute__((ext_vector_type(2)));
typedef float f32x4 __attribute__((ext_vector_type(4)));
typedef float f32x16 __attribute__((ext_vector_type(16)));
typedef unsigned v4u __attribute__((ext_vector_type(4)));
typedef unsigned v2u __attribute__((ext_vector_type(2)));

constexpr int D = 1024, DIN = 4608, DFF = 4096, CW = 512, NL = 2, NH = 8, HD = 64;
constexpr int B_CTX = 32, T_CTX = 256, B_SMP = 4, T_SMP = 1024, PAST = 256, KV_SMP = PAST + T_SMP;
constexpr int M_CTX = B_CTX * T_CTX, M_SMP = B_SMP * T_SMP, M = M_CTX + M_SMP;
constexpr int NMOD = 6 * D;
constexpr int PC_R = 0, PC_K = 512, PC_V = 1024, PC_LW = 1536, PC_LA = 1600, PC_LG = 1664, PC_Q = 1792, PC_KA = 2304, PC_VA = 2432, PC_GR = 2560, PC_GA = 3584;
constexpr size_t O_Y = 0, O_CK = (size_t)M * D, O_CV = O_CK + (size_t)B_CTX * NL * T_CTX * 128, O_ST = O_CV + (size_t)B_CTX * NL * T_CTX * 128;
constexpr size_t O_TOTAL = O_ST + (size_t)B_CTX * NL * 2 * NH * HD * HD;

constexpr size_t MiB = 1u << 20;
constexpr size_t WS_CTL = 0, CTL_BYTES = 1 * MiB;
constexpr size_t WS_MOD = 1 * MiB;
constexpr size_t WS_W = 2 * MiB;
constexpr size_t WO_IN = 0, WO_BR = 9 * MiB, WO_OUT = 11 * MiB, WO_UP = 13 * MiB, WO_DN = 21 * MiB, WO_SM = 29 * MiB, WO_G = 29 * MiB + 512 * 1024;
constexpr size_t WS_R1 = 32 * MiB;
constexpr size_t WS_R2 = 140 * MiB;
constexpr size_t WS_R3 = 188 * MiB;
constexpr size_t WS_RK = 212 * MiB;
constexpr size_t WS_R4 = 213 * MiB;
constexpr size_t WS_KN = 237 * MiB;
constexpr size_t WS_VT = 241 * MiB;
constexpr size_t WS_END = 245 * MiB;
constexpr size_t KN_SMP_OFF = (size_t)B_CTX * 2 * T_CTX * 64;

constexpr int NWAVES = 8, NTHREADS = 512;
constexpr int LDS_BYTES = 147456;
constexpr int MISC_OFF = 131072 + 320, PTAB_OFF = 131072 + 1024;

#define XB_TMO      128
#define XB_XCNT(j)  (256  + 64 * (j))
#define XB_XSUB(j)  (1280 + 64 * (j))
#define XB_XGEN(j)  (2304 + 64 * (j))
#define XB_TOP      3328
#define XB_TOPGEN   3392
#define XCD_BAR_WORDS 3456
#define XB_SPIN_CAP (1u << 24)
constexpr int CW_BAR = 4096;

__device__ __forceinline__ unsigned xb_ld(unsigned* p)              { return __hip_atomic_load(p, __ATOMIC_RELAXED, __HIP_MEMORY_SCOPE_AGENT); }
__device__ __forceinline__ unsigned xb_add(unsigned* p, unsigned v) { return __hip_atomic_fetch_add(p, v, __ATOMIC_RELAXED, __HIP_MEMORY_SCOPE_AGENT); }
__device__ __forceinline__ unsigned xb_xcc_id() { return (unsigned)__builtin_amdgcn_s_getreg((3 << 11) | 20) & 0xFu; }
#define XB_SPIN(cond, bar) do { unsigned _sp = 0; while (cond) { __builtin_amdgcn_s_sleep(1); \
    if ((++_sp & 255u) == 0u) { if (xb_ld(&(bar)[XB_TMO])) break; if (_sp > XB_SPIN_CAP) { atomicAdd(&(bar)[XB_TMO], 1u); break; } } } } while (0)

struct XcdBarrier { unsigned* bar; unsigned x; volatile LAS unsigned* st; };

__device__ __forceinline__ XcdBarrier xcd_barrier_post(unsigned* bar, volatile LAS unsigned* st) {
    XcdBarrier b; b.bar = bar; b.x = xb_xcc_id(); b.st = st;
    if (threadIdx.x == 0) (void)xb_add(&bar[XB_XCNT(b.x)], 1u);
    return b;
}
__device__ __forceinline__ void xcd_barrier_complete(unsigned* bar, unsigned x, unsigned& nloc, unsigned& nx) {
    const unsigned G = gridDim.x * gridDim.y * gridDim.z;
    unsigned sum, cnt, mine, sp = 0u;
    for (;;) {
        sum = 0u; cnt = 0u; mine = 0u;
#pragma unroll
        for (unsigned j = 0; j < 16; ++j) { const unsigned c = xb_ld(&bar[XB_XCNT(j)]); sum += c; cnt += (c > 0u) ? 1u : 0u; mine = (j == x) ? c : mine; }
        if (sum == G) break;
        __builtin_amdgcn_s_sleep(1);
        if ((++sp & 255u) == 0u) { if (xb_ld(&bar[XB_TMO])) break; if (sp > XB_SPIN_CAP) { atomicAdd(&bar[XB_TMO], 1u); break; } }
    }
    nloc = mine > 0u ? mine : 1u; nx = cnt > 0u ? cnt : 1u;
}
__device__ __forceinline__ void xcd_barrier(const XcdBarrier& b) {
    asm volatile("s_waitcnt vmcnt(0)" ::: "memory");
    __syncthreads();
    if (threadIdx.x == 0) {
        unsigned* bar = b.bar; unsigned bx = b.x;
        asm volatile("" : "+s"(bar), "+s"(bx));
        __builtin_amdgcn_s_waitcnt(0);
        unsigned nloc = b.st[0], nx = b.st[1];
        if (nloc == 0u) { xcd_barrier_complete(bar, bx, nloc, nx); b.st[0] = nloc; b.st[1] = nx; }
        const unsigned old = xb_add(&bar[XB_XSUB(bx)], 1u);
        const unsigned gen = old / nloc;
        if (old + 1u == (gen + 1u) * nloc) {
            __builtin_amdgcn_fence(__ATOMIC_RELEASE, "agent");
            asm volatile("s_waitcnt vmcnt(0)" ::: "memory");
            const unsigned og = xb_add(&bar[XB_TOP], 1u);
            const unsigned tg = og / nx;
            if (og + 1u == (tg + 1u) * nx) xb_add(&bar[XB_TOPGEN], 1u);
            else XB_SPIN(xb_ld(&bar[XB_TOPGEN]) == tg, bar);
            __builtin_amdgcn_fence(__ATOMIC_ACQUIRE, "agent");
            xb_add(&bar[XB_XGEN(bx)], 1u);
            asm volatile("s_waitcnt vmcnt(0)" ::: "memory");
        } else {
            XB_SPIN(xb_ld(&bar[XB_XGEN(bx)]) == gen, bar);
            __builtin_amdgcn_fence(__ATOMIC_ACQUIRE, "agent");
            asm volatile("s_waitcnt vmcnt(0)" ::: "memory");
        }
    }
    __syncthreads();
}

#define LDS_WAIT() asm volatile("s_waitcnt lgkmcnt(0)" ::: "memory")
#define DPPF(x, ctrl, rmask, oldv) __builtin_bit_cast(float, __builtin_amdgcn_update_dpp(__builtin_bit_cast(int, (float)(oldv)), __builtin_bit_cast(int, (float)(x)), (ctrl), (rmask), 0xF, false))
__device__ __forceinline__ float wave_sum(float v) {
    v += DPPF(v, 0xB1, 0xF, 0.f); v += DPPF(v, 0x4E, 0xF, 0.f); v += DPPF(v, 0x141, 0xF, 0.f); v += DPPF(v, 0x140, 0xF, 0.f);
    v += DPPF(v, 0x142, 0xA, 0.f); v += DPPF(v, 0x143, 0xC, 0.f);
    return __builtin_bit_cast(float, __builtin_amdgcn_readlane(__builtin_bit_cast(int, v), 63));
}
__device__ __forceinline__ float dpp_f(float x, const int ctrl) { return x; }
#define DPP_ADD(x, ctrl) (x) += __builtin_bit_cast(float, __builtin_amdgcn_update_dpp(0, __builtin_bit_cast(int, (x)), (ctrl), 0xF, 0xF, true))
__device__ __forceinline__ float dpp_sum8(float x) { DPP_ADD(x, 0xB1); DPP_ADD(x, 0x4E); DPP_ADD(x, 0x141); return x; }
__device__ __forceinline__ float dpp_sum16(float x) { DPP_ADD(x, 0xB1); DPP_ADD(x, 0x4E); DPP_ADD(x, 0x141); DPP_ADD(x, 0x140); return x; }
__device__ __forceinline__ void swap32(float& a, float& b) { asm volatile("v_nop\n\tv_nop\n\tv_permlane32_swap_b32 %0, %1" : "+v"(a), "+v"(b)); }
__device__ __forceinline__ float half_sum(float v) { float a = v, b = v; swap32(a, b); return a + b; }
__device__ __forceinline__ float half_max(float v) { float a = v, b = v; swap32(a, b); return fmaxf(a, b); }
__device__ __forceinline__ float xor16(float v) { return __builtin_bit_cast(float, __builtin_amdgcn_ds_swizzle(__builtin_bit_cast(int, v), 0x401F)); }
__device__ __forceinline__ float sigmoidf_(float x) { return __builtin_amdgcn_rcpf(1.0f + __expf(-x)); }
__device__ __forceinline__ float tanhf_(float x) { return 1.0f - 2.0f * __builtin_amdgcn_rcpf(1.0f + __expf(2.0f * x)); }
__device__ __forceinline__ unsigned pkh(float lo, float hi) { f16x2 v = {(f16)lo, (f16)hi}; return __builtin_bit_cast(unsigned, v); }
__device__ __forceinline__ void row_info(int row, int& g, int& t, int& T) {
    if (row < M_CTX) { g = 0; t = row & (T_CTX - 1); T = T_CTX; }
    else { const int r = row - M_CTX; g = 1 + (r >> 10); t = r & (T_SMP - 1); T = T_SMP; }
}

struct Params {
    const float* in[28];
    float* out;
    unsigned char* ws;
};
struct DParams { GAS float* out; GAS unsigned char* ws; };
struct Ctx {
    LAS unsigned char* lds;
    int tid, lane, wave, gw, ngw, gt, ngt, bid;
};
__device__ __forceinline__ int lane_id() { int ln; asm volatile("v_mbcnt_lo_u32_b32 %0, -1, 0\n\tv_mbcnt_hi_u32_b32 %0, -1, %0" : "=v"(ln)); return ln; }
__device__ __forceinline__ const GAS float* inp(const Ctx& c, int i) {
    const unsigned long long v = ((const LAS unsigned long long*)(c.lds + PTAB_OFF))[i];
    const unsigned lo = __builtin_amdgcn_readfirstlane((unsigned)v), hi = __builtin_amdgcn_readfirstlane((unsigned)(v >> 32));
    return (const GAS float*)(((unsigned long long)hi << 32) | lo); }
#define IN(i) inp(c, (i))
#define FRESH_P(p0) DParams p; { float* o_ = (p0).out; unsigned char* w_ = (p0).ws; asm volatile("" : "+s"(o_), "+s"(w_)); p.out = (GAS float*)o_; p.ws = (GAS unsigned char*)w_; }
__device__ __forceinline__ Ctx fresh(const Ctx& c0) {
    Ctx c = c0; int w = c0.wave; asm volatile("" : "+s"(w)); int ln = lane_id(); asm volatile("" : "+v"(ln));
    int b = blockIdx.x; asm volatile("" : "+s"(b));
    c.wave = w; c.lane = ln; c.tid = w * 64 + ln; c.bid = b;
    c.gw = b * 8 + w; c.gt = b * 512 + c.tid; return c; }

__device__ __forceinline__ void conv_item(const GAS float* W, int N, GAS f16* WT, int ldt, int koff, LAS float* scr, int kb, int nb, int lane) {
    const int k0 = 64 * kb, n0 = 32 * nb;
    float v[32];
#pragma unroll
    for (int i = 0; i < 32; ++i) { const int kk = 2 * i + (lane >> 5); v[i] = __builtin_nontemporal_load(W + (size_t)(k0 + kk) * N + n0 + (lane & 31)); }
#pragma unroll
    for (int i = 0; i < 32; ++i) { const int kk = 2 * i + (lane >> 5); scr[kk * 33 + (lane & 31)] = v[i]; }
    LDS_WAIT();
    const int c = lane & 7;
#pragma unroll
    for (int j = 0; j < 4; ++j) { const int n = (lane >> 3) + 8 * j; const LAS float* s = scr + (8 * c) * 33 + n;
        v4u o; o.x = pkh(s[0 * 33], s[1 * 33]); o.y = pkh(s[2 * 33], s[3 * 33]); o.z = pkh(s[4 * 33], s[5 * 33]); o.w = pkh(s[6 * 33], s[7 * 33]);
        *(GAS v4u*)(WT + (size_t)(n0 + n) * ldt + koff + k0 + 8 * c) = o; }
    LDS_WAIT();
}
template <int PART>
__device__ __forceinline__ void conv_weights(const Params& p0, const Ctx& c0, int l, int gw, int ngw) {
    const Ctx c = fresh(c0); FRESH_P(p0);
    asm volatile("" : "+s"(gw), "+s"(ngw));
    LAS float* scr = (LAS float*)(c.lds + c.wave * 16384);
    GAS unsigned char* wb = p.ws + WS_W;
    if (PART == 0) {
        GAS f16* WinT = (GAS f16*)(wb + WO_IN); GAS f16* WsmT = (GAS f16*)(wb + WO_SM); GAS f16* WgT = (GAS f16*)(wb + WO_G);
        const GAS float* w_in = IN(7) + (size_t)l * D * DIN;
        const GAS float* dec_up = IN(20) + (size_t)l * 2 * 64 * CW; const GAS float* icl_up = IN(22) + (size_t)l * 2 * 64 * CW; const GAS float* gate_up = IN(23) + (size_t)l * 128 * CW;
        constexpr int I0 = 16 * 144, I6 = 16, I7 = 16, I8 = 16, I9 = 16, I10 = 2 * 16;
        constexpr int NIT = I0 + I6 + I7 + I8 + I9 + I10;
        for (int it = gw; it < NIT; it += ngw) {
            int r = it;
            if (r < I0) { conv_item(w_in, DIN, WinT, D, 0, scr, r / 144, r % 144, c.lane); continue; } r -= I0;
            if (r < I6) { conv_item(dec_up, CW, WsmT, 128, 0, scr, 0, r, c.lane); continue; } r -= I6;
            if (r < I7) { conv_item(dec_up + 64 * CW, CW, WsmT + (size_t)512 * 128, 128, 0, scr, 0, r, c.lane); continue; } r -= I7;
            if (r < I8) { conv_item(icl_up, CW, WsmT + (size_t)1024 * 128, 128, 64, scr, 0, r, c.lane); continue; } r -= I8;
            if (r < I9) { conv_item(icl_up + 64 * CW, CW, WsmT + (size_t)1536 * 128, 128, 64, scr, 0, r, c.lane); continue; } r -= I9;
            conv_item(gate_up, CW, WgT, 128, 0, scr, r / 16, r % 16, c.lane);
        }
        unsigned zz_ = 0u; asm volatile("" : "+v"(zz_));
        for (int i = gw * 64 + c.lane; i < 2048 * 8; i += ngw * 64) { const int row = i >> 3, ch = i & 7; const int col = (row < 1024 ? 64 : 0) + ch * 8;
            *(GAS v4u*)(WsmT + (size_t)row * 128 + col) = (v4u){zz_, zz_, zz_, zz_}; }
    } else {
        GAS f16* WbrT = (GAS f16*)(wb + WO_BR); GAS f16* WoutT = (GAS f16*)(wb + WO_OUT); GAS f16* WupT = (GAS f16*)(wb + WO_UP); GAS f16* WdnT = (GAS f16*)(wb + WO_DN);
        const GAS float* w_br = IN(8) + (size_t)l * 2 * CW * D; const GAS float* w_out = IN(9) + (size_t)l * D * D;
        const GAS float* w_up = IN(13) + (size_t)l * D * DFF; const GAS float* w_dn = IN(14) + (size_t)l * DFF * D;
        constexpr int I1 = 8 * 32, I2 = 8 * 32, I3 = 16 * 32, I4 = 16 * 128, I5 = 64 * 32;
        constexpr int NIT = I1 + I2 + I3 + I4 + I5;
        for (int it = gw; it < NIT; it += ngw) {
            int r = it;
            if (r < I1) { conv_item(w_br, D, WbrT, D, 0, scr, r / 32, r % 32, c.lane); continue; } r -= I1;
            if (r < I2) { conv_item(w_br + (size_t)CW * D, D, WbrT, D, CW, scr, r / 32, r % 32, c.lane); continue; } r -= I2;
            if (r < I3) { conv_item(w_out, D, WoutT, D, 0, scr, r / 32, r % 32, c.lane); continue; } r -= I3;
            if (r < I4) { conv_item(w_up, DFF, WupT, D, 0, scr, r / 128, r % 128, c.lane); continue; } r -= I4;
            conv_item(w_dn, D, WdnT, DFF, 0, scr, r / 32, r % 32, c.lane);
        }
    }
}

__device__ __forceinline__ void mod_phase(const Params& p0, const Ctx& c0) {
    const Ctx c = fresh(c0); FRESH_P(p0);
    LAS float* sl = (LAS float*)(c.lds);
    LAS float* part = (LAS float*)(c.lds + 32768);
    GAS float* mod = (GAS float*)(p.ws + WS_MOD);
    for (int i = c.tid; i < 5 * D; i += NTHREADS) { const int g = i >> 10, k = i & 1023; const float v = g == 0 ? IN(6)[k] : IN(5)[(g - 1) * D + k]; sl[i] = v / (1.0f + __expf(-v)); }
    __syncthreads();
    for (int it = c.bid; it < NL * (NMOD / 64) * 4; it += gridDim.x) {
        const int kq = it & 3, lc = it >> 2, l = lc / (NMOD / 64), cc = lc % (NMOD / 64);
        const int kb = kq * 256 + c.wave * 32;
        const GAS float* w = IN(10) + (size_t)l * D * NMOD + (size_t)kb * NMOD + cc * 64 + c.lane;
        float a0 = 0.f, a1 = 0.f, a2 = 0.f, a3 = 0.f, a4 = 0.f;
        float wv[32];
#pragma unroll
        for (int k = 0; k < 32; ++k) wv[k] = w[(size_t)k * NMOD];
#pragma unroll
        for (int k = 0; k < 32; ++k) { a0 += sl[kb + k] * wv[k]; a1 += sl[D + kb + k] * wv[k]; a2 += sl[2 * D + kb + k] * wv[k]; a3 += sl[3 * D + kb + k] * wv[k]; a4 += sl[4 * D + kb + k] * wv[k]; }
        LAS float* pw = part + c.wave * 320 + c.lane;
        pw[0] = a0; pw[64] = a1; pw[128] = a2; pw[192] = a3; pw[256] = a4;
        __syncthreads();
        if (c.tid < 320) { float s = 0.f;
#pragma unroll
            for (int w8 = 0; w8 < 8; ++w8) s += part[w8 * 320 + c.tid];
            const int g = c.tid >> 6, col = cc * 64 + (c.tid & 63);
            if (kq == 0) s += IN(11)[(size_t)l * NMOD + col];
            atomicAdd((float*)(mod + ((size_t)l * 5 + g) * NMOD + col), s); }
        __syncthreads();
    }
}

template <int MODE, int NB>
__device__ __forceinline__ void norm_rows(const DParams& p, const Ctx& c, int l, int row_first, int row_end, int row_step) {
    GAS float* YO = p.out; GAS f16* XA = (GAS f16*)p.out;
    GAS f16* XB = (GAS f16*)(p.ws + WS_R3);
    const GAS f16* MO = (const GAS f16*)(p.ws + WS_R2); GAS f16* H = (GAS f16*)(p.ws + WS_R4);
    const GAS float* modb = (const GAS float*)(p.ws + WS_MOD);
    const GAS float* in0 = IN(0); const GAS float* in1 = IN(1); const GAS float* ngb = IN(12);
    for (int rowb = row_first; rowb < row_end; rowb += NB * row_step) {
        f32x4 x0[MODE == 0 ? NB : 1][4]; f16x4 xh[MODE == 0 ? 1 : NB][4]; f16x4 mh[MODE == 0 ? 1 : NB][4];
#pragma unroll
        for (int b = 0; b < NB; ++b) { const int row = rowb + b * row_step;
            if (row < row_end) {
                if (MODE == 0) { const GAS float* src = row < M_CTX ? in0 + (size_t)row * D : in1 + (size_t)(row - M_CTX) * D;
#pragma unroll
                    for (int j = 0; j < 4; ++j) x0[MODE == 0 ? b : 0][j] = __builtin_nontemporal_load((const GAS f32x4*)(src + 256 * j + 4 * c.lane)); }
                else { const GAS f16* xs = (MODE == 1 ? XA : XB) + (size_t)row * D;
#pragma unroll
                    for (int j = 0; j < 4; ++j) { xh[MODE == 0 ? 0 : b][j] = __builtin_nontemporal_load((const GAS f16x4*)(xs + 256 * j + 4 * c.lane));
                        mh[MODE == 0 ? 0 : b][j] = __builtin_nontemporal_load((const GAS f16x4*)(MO + (size_t)row * D + 256 * j + 4 * c.lane)); } } } }
#pragma unroll
        for (int b = 0; b < NB; ++b) { const int row = rowb + b * row_step;
            if (row < row_end) {
                int g, t, T; row_info(row, g, t, T);
                f32x4 x[4];
#pragma unroll
                for (int j = 0; j < 4; ++j) {
                    if (MODE == 0) x[j] = x0[MODE == 0 ? b : 0][j];
                    else {
#pragma unroll
                        for (int e = 0; e < 4; ++e) x[j][e] = (float)xh[MODE == 0 ? 0 : b][j][e]; } }
                if (MODE != 0) {
                    const GAS float* mo_mod = modb + ((size_t)l * 5 + g) * NMOD + (MODE == 1 ? 2 * D : 5 * D);
                    const GAS float* ngp = ngb + ((size_t)l * 4 + (MODE == 1 ? 1 : 3)) * D;
                    float mv[4][4]; float ss = 0.f;
#pragma unroll
                    for (int j = 0; j < 4; ++j)
#pragma unroll
                        for (int e = 0; e < 4; ++e) { mv[j][e] = (float)mh[MODE == 0 ? 0 : b][j][e]; ss += mv[j][e] * mv[j][e]; }
                    const float rstd = rsqrtf(wave_sum(ss) * (1.0f / D) + 1e-6f);
#pragma unroll
                    for (int j = 0; j < 4; ++j) { const f32x4 gg = *(const GAS f32x4*)(mo_mod + 256 * j + 4 * c.lane); const f32x4 nn = *(const GAS f32x4*)(ngp + 256 * j + 4 * c.lane);
#pragma unroll
                        for (int e = 0; e < 4; ++e) x[j][e] += gg[e] * (mv[j][e] * rstd * nn[e]); }
                }
                const int ln = MODE == 2 ? l + 1 : l;
                if (ln < NL) {
                    const GAS float* mb = modb + ((size_t)ln * 5 + g) * NMOD + (MODE == 1 ? 3 * D : 0);
                    const GAS float* ngp = ngb + ((size_t)ln * 4 + (MODE == 1 ? 2 : 0)) * D;
                    float ss = 0.f;
#pragma unroll
                    for (int j = 0; j < 4; ++j) ss += (x[j][0] * x[j][0] + x[j][1] * x[j][1]) + (x[j][2] * x[j][2] + x[j][3] * x[j][3]);
                    const float rstd = rsqrtf(wave_sum(ss) * (1.0f / D) + 1e-6f);
                    GAS f16* XW = (MODE == 1 ? XB : XA) + (size_t)row * D;
#pragma unroll
                    for (int j = 0; j < 4; ++j) { const f32x4 sh = *(const GAS f32x4*)(mb + 256 * j + 4 * c.lane); const f32x4 sc = *(const GAS f32x4*)(mb + D + 256 * j + 4 * c.lane);
                        const f32x4 nn = *(const GAS f32x4*)(ngp + 256 * j + 4 * c.lane);
                        float o[4];
#pragma unroll
                        for (int e = 0; e < 4; ++e) o[e] = x[j][e] * rstd * nn[e] * (1.0f + sc[e]) + sh[e];
                        v2u w; w.x = pkh(o[0], o[1]); w.y = pkh(o[2], o[3]);
                        *(GAS v2u*)(H + (size_t)row * D + 256 * j + 4 * c.lane) = w;
                        v2u xw; xw.x = pkh(x[j][0], x[j][1]); xw.y = pkh(x[j][2], x[j][3]);
                        __builtin_nontemporal_store(xw, (GAS v2u*)(XW + 256 * j + 4 * c.lane)); }
                } else {
#pragma unroll
                    for (int j = 0; j < 4; ++j) __builtin_nontemporal_store(x[j], (GAS f32x4*)(YO + (size_t)row * D + 256 * j + 4 * c.lane)); }
            } }
    }
}
template <int MODE>
__device__ __forceinline__ void norm_phase(const Params& p0, const Ctx& c0, int l) {
    const Ctx c = fresh(c0); FRESH_P(p0);
    norm_rows<MODE, 6>(p, c, l, c.gw, M, c.ngw);
}

namespace pg8 {
constexpr int BM = 256, BK = 64, HALF = 128, HTB = HALF * BK * 2, STAGE_BYTES = 8 * HTB, NXCD = 8, WGM = 8;
__host__ __device__ __forceinline__ int lds_byte(int r, int c) { const int st = (r >> 4) * 2 + (c >> 5), rr = r & 15, cc = c & 31, ob = rr * 64 + cc * 2; return st * 1024 + (ob ^ (((ob >> 9) & 1) << 5)); }
__host__ __device__ __forceinline__ void stage_rc(int b, int& R, int& C) { const int st = b / 1024, sb = b % 1024, swz = sb ^ (((sb >> 9) & 1) << 5); R = (st >> 1) * 16 + swz / 64; C = (st & 1) * 32 + (swz % 64) / 2; }
__host__ __device__ __forceinline__ int perm32(int rho) { const int n = rho >> 4, i = rho & 15; return 8 * (i >> 2) + 4 * n + (i & 3); }
struct Unit { int pm, pn; };
struct Gemm { const GAS f16* A; const GAS f16* Bt; int lda, ldb, K; };
struct StaticOrder {
    int nM, nN, nwg, G, c;
    __device__ void init(int Mr, int N, int G_, int c_, int bm = BM) { nM = Mr / bm; nN = N / BM; nwg = nM * nN; G = G_; c = c_; }
    __device__ bool next(int i, Unit& u) const {
        const long L = (long)i * G + c; if (c < 0 || L >= nwg) return false;
        int wgid = (int)L; { const int q = nwg / NXCD, r = nwg % NXCD, xcd = wgid % NXCD, off = wgid / NXCD; wgid = (xcd < r ? xcd * (q + 1) : r * (q + 1) + (xcd - r) * q) + off; }
        const int nig = WGM * nN, gid = wgid / nig, fm = gid * WGM, gsz = (nM - fm) < WGM ? (nM - fm) : WGM;
        u.pm = fm + ((wgid % nig) % gsz); u.pn = (wgid % nig) / gsz; return true;
    }
};
template <class Epi, int HA = 128, bool ALIGN_EPI = true, bool SP2 = true>
__device__ __forceinline__ void gemm_phase(LAS unsigned char* lds, const Gemm g, const StaticOrder& S, const Epi& E, int wave_sgpr) {
    asm volatile("" : "+s"(wave_sgpr)); int tid = wave_sgpr * 64 + lane_id(); asm volatile("" : "+v"(tid));
    const int wid = __builtin_amdgcn_readfirstlane(tid >> 6), lane = tid & 63, wr = wid >> 2, wc = wid & 3, fr = lane & 15, fq = lane >> 4;
    const int K = g.K, nt = K / BK;
    unsigned voffA[2], voffB[2];
#pragma unroll
    for (int i = 0; i < 2; ++i) { int R, C; stage_rc(tid * 16 + i * 8192, R, C); const int Rb = (R & ~31) + perm32(R & 31);
        voffA[i] = (unsigned)(R * g.lda + C) * 2u; voffB[i] = (unsigned)(Rb * g.ldb + C) * 2u; }
    const unsigned kstep = (unsigned)(BK * 2);
    constexpr int MF = HA / 32;
    const unsigned hstepA = (unsigned)HA * g.lda * 2, hstepB = (unsigned)HALF * g.ldb * 2;
    const unsigned tstepA = 2 * hstepA, tstepB = 2 * hstepB;
    const unsigned ldsw = (unsigned)wid * 1024u;
    const int aoff = lds_byte(wr * (HA / 2) + fr, fq * 8), boff = lds_byte(wc * 32 + fr, fq * 8);
#define PG8_SA(b, h) (((b) * 2 + (h)) * HTB)
#define PG8_SB(b, h) ((4 + (b) * 2 + (h)) * HTB)
#define PG8_STAGE(bufoff, gbase, soff, voff) do { _Pragma("unroll") for (int _i = 0; _i < 2; ++_i) \
        __builtin_amdgcn_raw_ptr_buffer_load_lds(rs##gbase, (LAS unsigned*)(lds + (bufoff) + ldsw + _i * 8192), 16, (voff)[_i], (int)(soff), 0, 0); } while (0)
#define PG8_LDA(dst, b, h) do { _Pragma("unroll") for (int m = 0; m < MF; ++m) _Pragma("unroll") for (int k = 0; k < 2; ++k) dst[m][k] = *(const LAS f16x8*)(lds + PG8_SA(b, h) + aoff + m * 2048 + k * 1024); } while (0)
#define PG8_LDB(dst, b, h) do { _Pragma("unroll") for (int n = 0; n < 2; ++n) _Pragma("unroll") for (int k = 0; k < 2; ++k) dst[n][k] = *(const LAS f16x8*)(lds + PG8_SB(b, h) + boff + n * 2048 + k * 1024); } while (0)
#define PG8_MMA(ai, bj, At, Bt) do { __builtin_amdgcn_s_setprio(1); _Pragma("unroll") for (int m = 0; m < MF; ++m) _Pragma("unroll") for (int n = 0; n < 2; ++n) _Pragma("unroll") for (int k = 0; k < 2; ++k) \
        acc[ai][bj][m][n] = __builtin_amdgcn_mfma_f32_16x16x32_f16(Bt[n][k], At[m][k], acc[ai][bj][m][n], 0, 0, 0); __builtin_amdgcn_s_setprio(0); } while (0)
#define PG8_WAIT_V(n) asm volatile("s_waitcnt vmcnt(" #n ")" ::: "memory")
#define PG8_WAIT_L(n) asm volatile("s_waitcnt lgkmcnt(" #n ")" ::: "memory")
#define PG8_BAR __builtin_amdgcn_s_barrier()
#define PG8_SCHED __builtin_amdgcn_sched_barrier(0)
    Unit cur, nxt; int ui = 0;
    if (!S.next(0, cur)) return;
    f32x4 acc[2][2][4][2];
#pragma unroll
    for (int a = 0; a < 2; ++a)
#pragma unroll
        for (int b = 0; b < 2; ++b)
#pragma unroll
            for (int m = 0; m < 4; ++m)
#pragma unroll
                for (int n = 0; n < 2; ++n) acc[a][b][m][n] = (f32x4){0.f, 0.f, 0.f, 0.f};
    f16x8 At[4][2], B0[2][2], B1[2][2];
    const auto rsA = __builtin_amdgcn_make_buffer_rsrc((GAS void*)g.A, 0, 0x7fffffff, 0x00020000); const auto rsB = __builtin_amdgcn_make_buffer_rsrc((GAS void*)g.Bt, 0, 0x7fffffff, 0x00020000);
    unsigned cA = (unsigned)cur.pm * tstepA, cB = (unsigned)cur.pn * tstepB;
    if constexpr (SP2) {
        PG8_STAGE(PG8_SB(0, 0), B, cB, voffB); PG8_STAGE(PG8_SB(0, 1), B, cB + hstepB, voffB); PG8_STAGE(PG8_SA(0, 0), A, cA, voffA); PG8_STAGE(PG8_SA(0, 1), A, cA + hstepA, voffA);
        if (wr == 1) PG8_BAR;
        PG8_WAIT_V(2); PG8_BAR;
        PG8_STAGE(PG8_SB(1, 0), B, cB + kstep, voffB); PG8_STAGE(PG8_SA(1, 0), A, cA + kstep, voffA); PG8_STAGE(PG8_SB(1, 1), B, cB + hstepB + kstep, voffB);
        PG8_WAIT_V(6); PG8_BAR;
    } else {
        PG8_STAGE(PG8_SB(0, 0), B, cB, voffB); PG8_STAGE(PG8_SA(0, 0), A, cA, voffA); PG8_STAGE(PG8_SB(0, 1), B, cB + hstepB, voffB); PG8_STAGE(PG8_SA(0, 1), A, cA + hstepA, voffA);
        if (wr == 1) PG8_BAR;
        PG8_WAIT_V(4); PG8_BAR;
        PG8_STAGE(PG8_SB(1, 0), B, cB + kstep, voffB); PG8_STAGE(PG8_SA(1, 0), A, cA + kstep, voffA); PG8_STAGE(PG8_SB(1, 1), B, cB + hstepB + kstep, voffB);
        PG8_WAIT_V(6); PG8_BAR;
    }
    for (;;) {
        const bool has_next = S.next(ui + 1, nxt);
        const unsigned nA = has_next ? (unsigned)nxt.pm * tstepA : cA, nB = has_next ? (unsigned)nxt.pn * tstepB : cB;
        for (int t = 0; t < nt; t += 2) {
            if constexpr (Epi::MID_T >= 0) { if (t == Epi::MID_T) { const int ln3 = lane_id(); E.template mid<HA>(acc, cur, wr, wc, ln3 & 15, ln3 >> 4); } }
            const bool last = (t == nt - 2);
            const unsigned a1 = cA + (unsigned)(t + 1) * kstep;
            const unsigned a2 = last ? nA : cA + (unsigned)(t + 2) * kstep, b2 = last ? nB : cB + (unsigned)(t + 2) * kstep;
            const unsigned a3 = a2 + kstep, b3 = b2 + kstep;
            if constexpr (SP2) {
            PG8_LDB(B0, 0, 0); PG8_LDB(B1, 0, 1); PG8_SCHED; PG8_LDA(At, 0, 0); PG8_STAGE(PG8_SA(1, 1), A, a1 + hstepA, voffA);
            PG8_WAIT_V(8); PG8_WAIT_L(0); PG8_BAR; PG8_MMA(0, 0, At, B0); PG8_MMA(0, 1, At, B1); PG8_BAR; PG8_SCHED;
            PG8_LDA(At, 0, 1); PG8_STAGE(PG8_SB(0, 0), B, b2, voffB); PG8_STAGE(PG8_SB(0, 1), B, b2 + hstepB, voffB); PG8_STAGE(PG8_SA(0, 0), A, a2, voffA);
            PG8_WAIT_V(8); PG8_WAIT_L(0); PG8_BAR; PG8_MMA(1, 0, At, B0); PG8_MMA(1, 1, At, B1); PG8_BAR; PG8_SCHED;
            PG8_LDB(B0, 1, 0); PG8_LDB(B1, 1, 1); PG8_SCHED; PG8_LDA(At, 1, 0); PG8_STAGE(PG8_SA(0, 1), A, a2 + hstepA, voffA);
            PG8_WAIT_V(8); PG8_WAIT_L(0); PG8_BAR; PG8_MMA(0, 0, At, B0); PG8_MMA(0, 1, At, B1); PG8_BAR; PG8_SCHED;
            PG8_LDA(At, 1, 1); PG8_STAGE(PG8_SB(1, 0), B, b3, voffB); PG8_STAGE(PG8_SB(1, 1), B, b3 + hstepB, voffB); PG8_STAGE(PG8_SA(1, 0), A, a3, voffA);
            PG8_WAIT_V(8); PG8_WAIT_L(0); PG8_BAR; PG8_MMA(1, 0, At, B0); PG8_MMA(1, 1, At, B1); PG8_BAR; PG8_SCHED;
            } else {
            PG8_LDB(B0, 0, 0); PG8_SCHED; PG8_LDA(At, 0, 0); PG8_STAGE(PG8_SA(1, 1), A, a1 + hstepA, voffA);
            PG8_WAIT_L(8); PG8_BAR; PG8_WAIT_L(0); PG8_MMA(0, 0, At, B0); PG8_BAR; PG8_SCHED;
            PG8_LDB(B1, 0, 1); PG8_STAGE(PG8_SB(0, 0), B, b2, voffB);
            PG8_BAR; PG8_WAIT_L(0); PG8_MMA(0, 1, At, B1); PG8_BAR;
            PG8_LDA(At, 0, 1); PG8_STAGE(PG8_SA(0, 0), A, a2, voffA);
            PG8_BAR; PG8_WAIT_L(0); PG8_MMA(1, 0, At, B0); PG8_BAR; PG8_SCHED;
            PG8_STAGE(PG8_SB(0, 1), B, b2 + hstepB, voffB);
            PG8_WAIT_V(6); PG8_BAR; PG8_MMA(1, 1, At, B1); PG8_BAR;
            PG8_LDB(B0, 1, 0); PG8_SCHED; PG8_LDA(At, 1, 0); PG8_STAGE(PG8_SA(0, 1), A, a2 + hstepA, voffA);
            PG8_WAIT_L(8); PG8_BAR; PG8_WAIT_L(0); PG8_MMA(0, 0, At, B0); PG8_BAR; PG8_SCHED;
            PG8_LDB(B1, 1, 1); PG8_STAGE(PG8_SB(1, 0), B, b3, voffB);
            PG8_BAR; PG8_WAIT_L(0); PG8_MMA(0, 1, At, B1); PG8_BAR;
            PG8_LDA(At, 1, 1); PG8_STAGE(PG8_SA(1, 0), A, a3, voffA);
            PG8_BAR; PG8_WAIT_L(0); PG8_MMA(1, 0, At, B0); PG8_BAR; PG8_SCHED;
            PG8_STAGE(PG8_SB(1, 1), B, b3 + hstepB, voffB);
            PG8_WAIT_V(6); PG8_BAR; PG8_MMA(1, 1, At, B1); PG8_BAR;
            }
        }
        if constexpr (ALIGN_EPI) { if (wr == 0) PG8_BAR; }
        { const int ln2 = lane_id(); E.template run<HA>(acc, cur, wr, wc, ln2 & 15, ln2 >> 4); }
        if (!has_next) break;
#pragma unroll
        for (int a = 0; a < 2; ++a)
#pragma unroll
            for (int b = 0; b < 2; ++b)
#pragma unroll
                for (int m = 0; m < 4; ++m)
#pragma unroll
                    for (int n = 0; n < 2; ++n) acc[a][b][m][n] = (f32x4){0.f, 0.f, 0.f, 0.f};
        cur = nxt; cA = nA; cB = nB; ++ui;
        if constexpr (ALIGN_EPI) { if (wr == 1) PG8_BAR; }
    }
    PG8_WAIT_V(0);
    if constexpr (!ALIGN_EPI) { if (wr == 0) PG8_BAR; }
    PG8_BAR;
#undef PG8_SA
#undef PG8_SB
#undef PG8_STAGE
#undef PG8_LDA
#undef PG8_LDB
#undef PG8_MMA
#undef PG8_WAIT_V
#undef PG8_WAIT_L
#undef PG8_BAR
#undef PG8_SCHED
}
typedef f32x4 Acc[2][2][4][2];
#define PG8_EPI_LOOP(...) \
    const int row0 = u.pm * (2 * HA) + wr * (HA / 2) + fr, col0 = u.pn * BM + wc * 32 + 8 * fq; \
    _Pragma("unroll") for (int ai = 0; ai < 2; ++ai) _Pragma("unroll") for (int m = 0; m < HA / 32; ++m) { const int row = row0 + ai * HA + m * 16; \
        _Pragma("unroll") for (int bj = 0; bj < 2; ++bj) { const int col = col0 + bj * HALF; f32x4 v0 = acc[ai][bj][m][0], v1 = acc[ai][bj][m][1]; __VA_ARGS__ } asm volatile("" ::: "memory"); }
__device__ __forceinline__ void store8(GAS f16* p, f32x4 v0, f32x4 v1) { v4u w; w.x = pkh(v0[0], v0[1]); w.y = pkh(v0[2], v0[3]); w.z = pkh(v1[0], v1[1]); w.w = pkh(v1[2], v1[3]); *(GAS v4u*)p = w; }
struct EpiProjF { static constexpr int MID_T = -1; GAS f16* P;
    template <int HA> __device__ __forceinline__ void run(const Acc& acc, const Unit& u, int wr, int wc, int fr, int fq) const {
        PG8_EPI_LOOP(
            if (u.pn == 6) {
                if (col < PC_LA) { _Pragma("unroll") for (int e = 0; e < 4; ++e) { v0[e] = tanhf_(v0[e]); v1[e] = tanhf_(v1[e]); } }
                else if (col >= PC_LG) { _Pragma("unroll") for (int e = 0; e < 4; ++e) { v0[e] = sigmoidf_(v0[e]); v1[e] = sigmoidf_(v1[e]); } }
            } else if (u.pn >= 10) { _Pragma("unroll") for (int e = 0; e < 4; ++e) { v0[e] = sigmoidf_(v0[e]); v1[e] = sigmoidf_(v1[e]); } }
            store8(P + (size_t)row * DIN + col, v0, v1);
        )
    } };
#define DPPM(x, ctrl) (x) *= __builtin_bit_cast(float, __builtin_amdgcn_update_dpp(0x3f800000, __builtin_bit_cast(int, (x)), (ctrl), 0xF, 0xF, false))
struct EpiWAF { static constexpr int MID_T = -1; GAS f16* WA; const GAS float* w0; const GAS float* a0;
    template <int HA> __device__ __forceinline__ void run(const Acc& acc, const Unit& u, int wr, int wc, int fr, int fq) const {
        PG8_EPI_LOOP(
            if (col < 1024) { const f32x4 b0 = *(const GAS f32x4*)(w0 + col), b1 = *(const GAS f32x4*)(w0 + col + 4);
                float x[8];
                _Pragma("unroll") for (int e = 0; e < 4; ++e) { x[e] = __expf(-0.606531f * sigmoidf_(v0[e] + b0[e])); x[4 + e] = __expf(-0.606531f * sigmoidf_(v1[e] + b1[e])); }
                if (col < 512) {
                    _Pragma("unroll") for (int e = 0; e < 8; ++e) { DPPM(x[e], 0x111); DPPM(x[e], 0x112); DPPM(x[e], 0x114); DPPM(x[e], 0x118);
                        const float wm = __builtin_bit_cast(float, __builtin_amdgcn_ds_swizzle(__builtin_bit_cast(int, x[e]), 0x00F0)); x[e] = (fr == 7) ? wm : x[e] * __builtin_amdgcn_rcpf(wm); }
                } else {
                    _Pragma("unroll") for (int e = 0; e < 8; ++e) { DPPM(x[e], 0x101); DPPM(x[e], 0x102); DPPM(x[e], 0x104); DPPM(x[e], 0x108);
                        const float wm = __builtin_bit_cast(float, __builtin_amdgcn_ds_swizzle(__builtin_bit_cast(int, x[e]), 0x0110)); x[e] = (fr == 8) ? wm : x[e] * __builtin_amdgcn_rcpf(wm); }
                }
                _Pragma("unroll") for (int e = 0; e < 4; ++e) { v0[e] = x[e]; v1[e] = x[4 + e]; } }
            else { const f32x4 b0 = *(const GAS f32x4*)(a0 + col - 1024), b1 = *(const GAS f32x4*)(a0 + col - 1024 + 4);
                _Pragma("unroll") for (int e = 0; e < 4; ++e) { v0[e] = sigmoidf_(v0[e] + b0[e]); v1[e] = sigmoidf_(v1[e] + b1[e]); } }
            store8(WA + (size_t)row * 2048 + col, v0, v1);
        )
    } };
struct EpiF16F { static constexpr int MID_T = -1; GAS f16* O; int ld;
    template <int HA> __device__ __forceinline__ void run(const Acc& acc, const Unit& u, int wr, int wc, int fr, int fq) const {
        PG8_EPI_LOOP( store8(O + (size_t)row * ld + col, v0, v1); )
    } };
struct EpiRelu2F { static constexpr int MID_T = -1; GAS f16* O; int ld;
    template <int HA> __device__ __forceinline__ void run(const Acc& acc, const Unit& u, int wr, int wc, int fr, int fq) const {
        PG8_EPI_LOOP(
            _Pragma("unroll") for (int e = 0; e < 4; ++e) { const float a = fmaxf(v0[e], 0.f), b = fmaxf(v1[e], 0.f); v0[e] = a * a; v1[e] = b * b; }
            store8(O + (size_t)row * ld + col, v0, v1);
        )
    } };
struct EpiMergeF { static constexpr int MID_T = 8; GAS f16* MG; const GAS f16* PROJ;
    template <int HA> __device__ __forceinline__ void mid(Acc& acc, const Unit& u, int wr, int wc, int fr, int fq) const {
        const int row0 = u.pm * (2 * HA) + wr * (HA / 2) + fr, col0 = u.pn * BM + wc * 32 + 8 * fq;
#pragma unroll
        for (int ai = 0; ai < 2; ++ai)
#pragma unroll
            for (int m = 0; m < HA / 32; ++m) { const int row = row0 + ai * HA + m * 16;
#pragma unroll
                for (int bj = 0; bj < 2; ++bj) { const int col = col0 + bj * HALF;
                    const f16x8 gr = *(const GAS f16x8*)(PROJ + (size_t)row * DIN + PC_GR + col), ga = *(const GAS f16x8*)(PROJ + (size_t)row * DIN + PC_GA + col);
#pragma unroll
                    for (int e = 0; e < 4; ++e) { acc[ai][bj][m][0][e] *= (float)gr[e] * __builtin_amdgcn_rcpf(fmaxf((float)ga[e], 1e-4f)); acc[ai][bj][m][1][e] *= (float)gr[4 + e] * __builtin_amdgcn_rcpf(fmaxf((float)ga[4 + e], 1e-4f)); } }
                asm volatile("" ::: "memory"); }
    }
    template <int HA> __device__ __forceinline__ void run(const Acc& acc, const Unit& u, int wr, int wc, int fr, int fq) const {
        PG8_EPI_LOOP(
            const f16x8 ga = *(const GAS f16x8*)(PROJ + (size_t)row * DIN + PC_GA + col);
            _Pragma("unroll") for (int e = 0; e < 4; ++e) { v0[e] *= fmaxf((float)ga[e], 1e-4f); v1[e] *= fmaxf((float)ga[4 + e], 1e-4f); }
            store8(MG + (size_t)row * D + col, v0, v1);
        )
    } };
}

__device__ __forceinline__ void kv_prep(const Params& p0, const Ctx& c0, int l) {
    const Ctx c = fresh(c0); FRESH_P(p0);
    const GAS f16* PROJ = (const GAS f16*)(p.ws + WS_R1); GAS f16* KN = (GAS f16*)(p.ws + WS_KN); GAS f16* VT = (GAS f16*)(p.ws + WS_VT);
    const int d = c.lane;
    const float kg = IN(27)[l * HD + d];
    const int axis = d >> 5, half = (d >> 4) & 1, f = d & 15;
    const float freq = exp2f(-(float)f * (13.287712379549449f / 16.0f));
    for (int it = c.gw; it < (M / 8) * 2; it += c.ngw) {
        const int kvh = it & 1, row0 = (it >> 1) * 8;
        float kx[8], vx[8];
#pragma unroll
        for (int r = 0; r < 8; ++r) { const GAS f16* pr = PROJ + (size_t)(row0 + r) * DIN + kvh * HD + d; kx[r] = (float)pr[PC_KA]; vx[r] = (float)pr[PC_VA]; }
#pragma unroll
        for (int r = 0; r < 8; ++r) kx[r] = kx[r] * rsqrtf(wave_sum(kx[r] * kx[r]) * (1.0f / HD) + 1e-6f) * kg;
        f16x8 vv;
#pragma unroll
        for (int r = 0; r < 8; ++r) vv[r] = (f16)vx[r];
        if (row0 < M_CTX) { const int b = row0 >> 8, t0 = row0 & 255;
#pragma unroll
            for (int r = 0; r < 8; ++r) { const size_t o = ((((size_t)b * NL + l) * T_CTX + t0 + r) * 2 + kvh) * HD + d;
                p.out[O_CK + o] = kx[r]; p.out[O_CV + o] = vx[r];
                KN[(((size_t)b * 2 + kvh) * T_CTX + t0 + r) * HD + d] = (f16)kx[r]; }
            *(GAS f16x8*)(VT + (((size_t)b * 2 + kvh) * HD + d) * T_CTX + t0) = vv;
        } else { const int rr = row0 - M_CTX, b = rr >> 10, t0 = rr & 1023;
#pragma unroll
            for (int r = 0; r < 8; ++r) { const int t = t0 + r; const float pos = (float)(axis == 0 ? (t >> 6) : (t & 63));
                const float ang = pos * freq; const float cs = __cosf(ang), sn = __sinf(ang);
                const float other = xor16(kx[r]);
                const float ko = half == 0 ? kx[r] * cs - other * sn : kx[r] * cs + other * sn;
                KN[KN_SMP_OFF + (((size_t)b * 2 + kvh) * KV_SMP + PAST + t) * HD + d] = (f16)ko; }
            *(GAS f16x8*)(VT + KN_SMP_OFF + (((size_t)b * 2 + kvh) * HD + d) * KV_SMP + PAST + t0) = vv;
        }
    }
    for (int it = c.gw; it < B_SMP * (PAST / 8) * 2; it += c.ngw) {
        const int kvh = it & 1, j0 = ((it >> 1) & 31) * 8, b = it >> 6;
        f16x8 vv;
#pragma unroll
        for (int r = 0; r < 8; ++r) { const size_t s = ((((size_t)b * NL + l) * PAST + j0 + r) * 2 + kvh) * HD + d;
            KN[KN_SMP_OFF + (((size_t)b * 2 + kvh) * KV_SMP + j0 + r) * HD + d] = (f16)IN(2)[s]; vv[r] = (f16)IN(3)[s]; }
        *(GAS f16x8*)(VT + KN_SMP_OFF + (((size_t)b * 2 + kvh) * HD + d) * KV_SMP + j0) = vv;
    }
}

constexpr int TC = 32, ST_STEP = 6 * 64, ST_BUF = TC * ST_STEP;
struct StageRegs { f16x4 r[3], k[3], v[3], w, a; };
__device__ __forceinline__ void scan_task(const DParams& p, const Ctx& c, int l, int task) {
    const GAS f16* PROJ = (const GAS f16*)(p.ws + WS_R1); const GAS f16* WA = (const GAS f16*)(p.ws + WS_R2);
    GAS f16* Y = (GAS f16*)(p.ws + WS_R3); GAS float* RK = (GAS float*)(p.ws + WS_RK);
    LAS float* st = (LAS float*)c.lds;
    int sq, dir, h;
    if (task < 64) { h = task & 7; dir = (task >> 3) & 1; sq = B_CTX + (task >> 4); } else { const int id = task - 64; h = id & 7; dir = (id >> 3) & 1; sq = id >> 4; }
    const bool smp = sq >= B_CTX; const int T = smp ? T_SMP : T_CTX; const int row0 = smp ? M_CTX + (sq - B_CTX) * T_SMP : sq * T_CTX;
    const int nch = T / TC;
    const int tt = c.tid >> 4, cq = c.tid & 15, ch0 = h * HD + cq * 4;
    const f32x4 mu_r = *(const GAS f32x4*)(IN(15) + (l * 3 + 0) * CW + ch0), mu_k = *(const GAS f32x4*)(IN(15) + (l * 3 + 1) * CW + ch0), mu_v = *(const GAS f32x4*)(IN(15) + (l * 3 + 2) * CW + ch0);
    const f32x4 k_k = *(const GAS f32x4*)(IN(16) + l * CW + ch0), k_a = *(const GAS f32x4*)(IN(17) + l * CW + ch0), r_k = *(const GAS f32x4*)(IN(18) + l * CW + ch0);
    const int ks = c.lane & 7, srow = c.wave * 8 + (c.lane >> 3);
    float S[8];
    if (smp) { const GAS float* s0 = IN(4) + (((((size_t)(sq - B_CTX) * NL + l) * 2 + dir) * NH + h) * HD + srow) * HD + ks * 8;
        const f32x4 a = *(const GAS f32x4*)s0, b = *(const GAS f32x4*)(s0 + 4);
        S[0] = a[0]; S[1] = a[1]; S[2] = a[2]; S[3] = a[3]; S[4] = b[0]; S[5] = b[1]; S[6] = b[2]; S[7] = b[3];
    } else {
#pragma unroll
        for (int j = 0; j < 8; ++j) S[j] = 0.f;
    }
    StageRegs sr;
    const f16x4 z4 = {(f16)0.f, (f16)0.f, (f16)0.f, (f16)0.f};
#define SCAN_LOAD(chunk) do { const int S_ = (chunk) * TC + tt; const int t_ = dir ? T - 1 - S_ : S_; const GAS f16* pr_ = PROJ + (size_t)(row0 + t_) * DIN + ch0; \
        sr.r[1] = *(const GAS f16x4*)(pr_ + PC_R); sr.k[1] = *(const GAS f16x4*)(pr_ + PC_K); sr.v[1] = *(const GAS f16x4*)(pr_ + PC_V); \
        if (t_ > 0) { sr.r[0] = *(const GAS f16x4*)(pr_ - DIN + PC_R); sr.k[0] = *(const GAS f16x4*)(pr_ - DIN + PC_K); sr.v[0] = *(const GAS f16x4*)(pr_ - DIN + PC_V); } else { sr.r[0] = z4; sr.k[0] = z4; sr.v[0] = z4; } \
        if (t_ < T - 1) { sr.r[2] = *(const GAS f16x4*)(pr_ + DIN + PC_R); sr.k[2] = *(const GAS f16x4*)(pr_ + DIN + PC_K); sr.v[2] = *(const GAS f16x4*)(pr_ + DIN + PC_V); } else { sr.r[2] = z4; sr.k[2] = z4; sr.v[2] = z4; } \
        const GAS f16* wa_ = WA + (size_t)(row0 + t_) * 2048 + dir * 512 + ch0; sr.w = *(const GAS f16x4*)wa_; sr.a = *(const GAS f16x4*)(wa_ + 1024); } while (0)
#define SCAN_STAGE(chunk) do { const int S_ = (chunk) * TC + tt; const int t_ = dir ? T - 1 - S_ : S_; \
        f32x4 r_, k_, v_, kk_, w_, a_, kh_, kt_, b_; float ss_ = 0.f, rk_ = 0.f; \
        _Pragma("unroll") for (int e = 0; e < 4; ++e) { const float rc = (float)sr.r[1][e], kc = (float)sr.k[1][e], vc = (float)sr.v[1][e]; \
            r_[e] = rc + mu_r[e] * (0.5f * ((float)sr.r[0][e] + (float)sr.r[2][e]) - rc); k_[e] = kc + mu_k[e] * (0.5f * ((float)sr.k[0][e] + (float)sr.k[2][e]) - kc); \
            v_[e] = vc + mu_v[e] * (0.5f * ((float)sr.v[0][e] + (float)sr.v[2][e]) - vc); kk_[e] = k_[e] * k_k[e]; ss_ += kk_[e] * kk_[e]; w_[e] = (float)sr.w[e]; a_[e] = (float)sr.a[e]; } \
        ss_ = dpp_sum16(ss_); const float ri_ = rsqrtf(ss_ + 1e-12f); \
        _Pragma("unroll") for (int e = 0; e < 4; ++e) { kh_[e] = kk_[e] * ri_; kt_[e] = k_[e] * (1.0f + (a_[e] - 1.0f) * k_a[e]); b_[e] = a_[e] * kh_[e]; rk_ += r_[e] * kt_[e] * r_k[e]; } \
        rk_ = dpp_sum16(rk_); if (cq == 0) RK[((size_t)dir * M + row0 + t_) * 8 + h] = rk_; \
        LAS float* sb_ = st + ((chunk) & 1) * ST_BUF + tt * ST_STEP + cq * 4; \
        *(LAS f32x4*)(sb_) = kh_; *(LAS f32x4*)(sb_ + 64) = w_; *(LAS f32x4*)(sb_ + 128) = b_; *(LAS f32x4*)(sb_ + 192) = kt_; *(LAS f32x4*)(sb_ + 256) = r_; *(LAS f32x4*)(sb_ + 320) = v_; } while (0)
    SCAN_LOAD(0);
    SCAN_STAGE(0);
    __syncthreads();
    for (int chunk = 0; chunk < nch; ++chunk) {
        if (chunk + 1 < nch) SCAN_LOAD(chunk + 1);
        const LAS float* sb = st + (chunk & 1) * ST_BUF + ks * 8;
        const LAS float* vb = st + (chunk & 1) * ST_BUF + 320 + srow;
#pragma unroll 2
        for (int s = 0; s < TC; ++s) {
            const LAS float* q = sb + s * ST_STEP;
            const f32x4 kh0 = *(const LAS f32x4*)(q), kh1 = *(const LAS f32x4*)(q + 4);
            const f32x4 w0 = *(const LAS f32x4*)(q + 64), w1 = *(const LAS f32x4*)(q + 68);
            const f32x4 b0 = *(const LAS f32x4*)(q + 128), b1 = *(const LAS f32x4*)(q + 132);
            const f32x4 t0 = *(const LAS f32x4*)(q + 192), t1 = *(const LAS f32x4*)(q + 196);
            const f32x4 r0 = *(const LAS f32x4*)(q + 256), r1 = *(const LAS f32x4*)(q + 260);
            const float v = vb[s * ST_STEP];
            float sk = (S[0] * kh0[0] + S[1] * kh0[1]) + (S[2] * kh0[2] + S[3] * kh0[3]) + ((S[4] * kh1[0] + S[5] * kh1[1]) + (S[6] * kh1[2] + S[7] * kh1[3]));
            sk = dpp_sum8(sk);
#pragma unroll
            for (int e = 0; e < 4; ++e) { S[e] = S[e] * w0[e] + (v * t0[e] - sk * b0[e]); S[4 + e] = S[4 + e] * w1[e] + (v * t1[e] - sk * b1[e]); }
            float y = (S[0] * r0[0] + S[1] * r0[1]) + (S[2] * r0[2] + S[3] * r0[3]) + ((S[4] * r1[0] + S[5] * r1[1]) + (S[6] * r1[2] + S[7] * r1[3]));
            y = dpp_sum8(y);
            const int Sg = chunk * TC + s; const int t = dir ? T - 1 - Sg : Sg;
            if (ks == 0) Y[((size_t)dir * M + row0 + t) * CW + h * HD + srow] = (f16)y;
        }
        if (chunk + 1 < nch) SCAN_STAGE(chunk + 1);
        __syncthreads();
    }
#undef SCAN_LOAD
#undef SCAN_STAGE
    if (!smp) { GAS float* so = p.out + O_ST + (((((size_t)sq * NL + l) * 2 + dir) * NH + h) * HD + srow) * HD + ks * 8;
        *(GAS f32x4*)so = (f32x4){S[0], S[1], S[2], S[3]}; *(GAS f32x4*)(so + 4) = (f32x4){S[4], S[5], S[6], S[7]}; }
}
__device__ __forceinline__ void fast_scan(const Params& p0, const Ctx& c0, int l) {
    const Ctx c = fresh(c0); FRESH_P(p0);
    const int b = c.bid;
    if (b < 64) scan_task(p, c, l, b);
    else for (int task = b; task < 576; task += 192) scan_task(p, c, l, task);
}


namespace ms {
constexpr int O_AM = 0, O_BM = 4608, O_AT = 9216, O_VP = 14336, O_GT = 19456, O_NF = 22016, O_WM = 23040, O_WE = 23296, BUF = 23552;
constexpr int RS = 144, RT = 80;
}
__device__ __forceinline__ void mscan_task(const DParams& p, const Ctx& c, int l, int task) {
    using namespace ms;
    const GAS f16* PROJ = (const GAS f16*)(p.ws + WS_R1); const GAS f16* WA = (const GAS f16*)(p.ws + WS_R2);
    GAS f16* Y = (GAS f16*)(p.ws + WS_R3); GAS float* RK = (GAS float*)(p.ws + WS_RK);
    int sq, dir, h;
    if (task < 64) { h = task & 7; dir = (task >> 3) & 1; sq = B_CTX + (task >> 4); } else { const int id = task - 64; h = id & 7; dir = (id >> 3) & 1; sq = id >> 4; }
    const bool smp = sq >= B_CTX; const int T = smp ? T_SMP : T_CTX; const int row0 = smp ? M_CTX + (sq - B_CTX) * T_SMP : sq * T_CTX;
    const int nch = T / 16;
    const int vl = c.lane & 31, hh = c.lane >> 5;
    const int tq = c.tid - 128, ss = (tq >> 4) & 15, cq = tq & 15, k0 = cq * 4, ch0 = h * HD + k0;
    LAS float* cst = (LAS float*)(c.lds + 3 * BUF);
    if (c.wave == 7) { const int chn_ = h * HD + c.lane;
        cst[c.lane] = IN(15)[(l * 3 + 0) * CW + chn_]; cst[64 + c.lane] = IN(15)[(l * 3 + 1) * CW + chn_]; cst[128 + c.lane] = IN(15)[(l * 3 + 2) * CW + chn_];
        cst[192 + c.lane] = IN(16)[l * CW + chn_]; cst[256 + c.lane] = IN(17)[l * CW + chn_]; cst[320 + c.lane] = IN(18)[l * CW + chn_]; }

#define MS_BARRIER() do { asm volatile("s_waitcnt lgkmcnt(0)" ::: "memory"); __builtin_amdgcn_s_barrier(); asm volatile("" ::: "memory"); } while (0)
    if (c.wave >= 2 && c.wave < 6) {
    f16x4 G_rc, G_kc, G_vc, G_rp, G_kp, G_vp, G_rn, G_kn, G_vn, G_av, G_wo, G_wp, G_w7;
    { const f16x4 z4 = {(f16)0.f, (f16)0.f, (f16)0.f, (f16)0.f}; G_rc = G_kc = G_vc = G_rp = G_kp = G_vp = G_rn = G_kn = G_vn = G_av = G_wo = G_wp = G_w7 = z4; }
        for (int it = -3; it < nch; ++it) {
            const int ch = it + 2;
            if (ch >= 0 && ch < nch) {
                LAS unsigned char* buf = c.lds + (ch % 3) * BUF;
                const int Sg = ch * 16 + ss; const int t = dir ? T - 1 - Sg : Sg; const size_t row = (size_t)row0 + t;
                const f32x4 mu_r = *(const LAS f32x4*)(cst + k0), mu_k = *(const LAS f32x4*)(cst + 64 + k0), mu_v = *(const LAS f32x4*)(cst + 128 + k0), k_k = *(const LAS f32x4*)(cst + 192 + k0), k_a = *(const LAS f32x4*)(cst + 256 + k0), r_k = *(const LAS f32x4*)(cst + 320 + k0);
                f32x4 r_, k_, v_, kk_, kh_, kt_, b_; float sq_ = 0.f, rk_ = 0.f;
                const float mp_ = t > 0 ? 0.5f : 0.f, mn_ = t < T - 1 ? 0.5f : 0.f;
#pragma unroll
                for (int e = 0; e < 4; ++e) { const float rcf = (float)G_rc[e], kcf = (float)G_kc[e], vcf = (float)G_vc[e];
                    r_[e] = rcf + mu_r[e] * ((mp_ * (float)G_rp[e] + mn_ * (float)G_rn[e]) - rcf); k_[e] = kcf + mu_k[e] * ((mp_ * (float)G_kp[e] + mn_ * (float)G_kn[e]) - kcf);
                    v_[e] = vcf + mu_v[e] * ((mp_ * (float)G_vp[e] + mn_ * (float)G_vn[e]) - vcf); kk_[e] = k_[e] * k_k[e]; sq_ += kk_[e] * kk_[e]; }
                sq_ = dpp_sum16(sq_); const float ri_ = rsqrtf(sq_ + 1e-12f);
#pragma unroll
                for (int e = 0; e < 4; ++e) { const float a_ = (float)G_av[e]; kh_[e] = kk_[e] * ri_; kt_[e] = k_[e] * (1.0f + (a_ - 1.0f) * k_a[e]); b_[e] = a_ * kh_[e]; rk_ += r_[e] * kt_[e] * r_k[e]; }
                rk_ = dpp_sum16(rk_); if (cq == 0) RK[((size_t)dir * M + row) * 8 + h] = rk_;
                float al[4], be[4], ka[4], rho[4];
#pragma unroll
                for (int e = 0; e < 4; ++e) { const float wm7 = (float)G_w7[e]; const float om = ss == 7 ? 1.0f : (float)G_wo[e]; const float omp = ss == 0 ? __builtin_amdgcn_rcpf(wm7) : (ss == 8 ? 1.0f : (float)G_wp[e]);
                    const float iom = __builtin_amdgcn_rcpf(om); al[e] = omp * kh_[e]; be[e] = b_[e] * iom; ka[e] = kt_[e] * iom; rho[e] = om * r_[e]; }
                v2u w2;
                w2.x = pkh(al[0], al[1]); w2.y = pkh(al[2], al[3]); *(LAS v2u*)(buf + O_BM + ss * RS + k0 * 2) = w2;
                w2.x = pkh(rho[0], rho[1]); w2.y = pkh(rho[2], rho[3]); *(LAS v2u*)(buf + O_BM + (16 + ss) * RS + k0 * 2) = w2;
                w2.x = pkh(be[0], be[1]); w2.y = pkh(be[2], be[3]); *(LAS v2u*)(buf + O_AM + ss * RS + k0 * 2) = w2;
                w2.x = pkh(ka[0], ka[1]); w2.y = pkh(ka[2], ka[3]); *(LAS v2u*)(buf + O_AM + (16 + ss) * RS + k0 * 2) = w2;
#pragma unroll
                for (int e = 0; e < 4; ++e) { *(LAS f16*)(buf + O_AT + (k0 + e) * RT + ss * 2) = (f16)ka[e]; *(LAS f16*)(buf + O_AT + (k0 + e) * RT + (16 + ss) * 2) = (f16)be[e];
                    *(LAS f16*)(buf + O_VP + (k0 + e) * RT + ss * 2) = (f16)v_[e]; }
                if (ss == 15) { f32x4 wm_, we_;
#pragma unroll
                    for (int e = 0; e < 4; ++e) { wm_[e] = (float)G_w7[e]; we_[e] = (float)G_wo[e]; }
                    *(LAS f32x4*)(buf + O_WM + k0 * 4) = wm_; *(LAS f32x4*)(buf + O_WE + k0 * 4) = we_; }
            }
            const int chn = it + 3;
            if (chn < nch) {
                const int Sg = chn * 16 + ss; const int t = dir ? T - 1 - Sg : Sg; const size_t row = (size_t)row0 + t;
                const GAS f16* pr = PROJ + row * DIN + ch0;
                const f16x4 z4 = {(f16)0.f, (f16)0.f, (f16)0.f, (f16)0.f};
                G_rc = *(const GAS f16x4*)(pr + PC_R); G_kc = *(const GAS f16x4*)(pr + PC_K); G_vc = *(const GAS f16x4*)(pr + PC_V);
                { const GAS f16* prp = t > 0 ? pr - DIN : pr; const GAS f16* prn = t < T - 1 ? pr + DIN : pr;
                  G_rp = *(const GAS f16x4*)(prp + PC_R); G_kp = *(const GAS f16x4*)(prp + PC_K); G_vp = *(const GAS f16x4*)(prp + PC_V);
                  G_rn = *(const GAS f16x4*)(prn + PC_R); G_kn = *(const GAS f16x4*)(prn + PC_K); G_vn = *(const GAS f16x4*)(prn + PC_V); }
                G_av = *(const GAS f16x4*)(WA + row * 2048 + 1024 + dir * 512 + ch0);
                const GAS f16* wo = WA + row * 2048 + dir * 512 + ch0;
                G_wo = *(const GAS f16x4*)wo; G_wp = *(const GAS f16x4*)(wo + (ss > 0 ? (dir ? 2048 : -2048) : 0)); G_w7 = *(const GAS f16x4*)(wo + (long)(7 - ss) * (dir ? -2048 : 2048));
            }
            MS_BARRIER();
        }
    } else if (c.wave == 6) {
        for (int it = -3; it < nch; ++it) {
            const int ch = it + 1;
            if (ch >= 0 && ch < nch) {
                LAS unsigned char* buf = c.lds + (ch % 3) * BUF;
                f32x16 g;
#pragma unroll
                for (int i = 0; i < 16; ++i) g[i] = 0.f;
#pragma unroll
                for (int s = 0; s < 4; ++s) { const f16x8 a = *(const LAS f16x8*)(buf + O_AM + vl * RS + (16 * s + 8 * hh) * 2), b = *(const LAS f16x8*)(buf + O_BM + vl * RS + (16 * s + 8 * hh) * 2);
                    g = __builtin_amdgcn_mfma_f32_32x32x16_f16(a, b, g, 0, 0, 0); }
                const int tcol = vl & 15; const bool incl = vl >= 16;
#pragma unroll
                for (int gq = 0; gq < 4; ++gq) { float o[4];
#pragma unroll
                    for (int e = 0; e < 4; ++e) { const int ip = 8 * gq + 4 * hh + e, i = ip & 15; const bool ok = incl ? (i <= tcol) : (i < tcol); o[e] = ok ? g[4 * gq + e] : 0.f; }
                    v2u w2; w2.x = pkh(o[0], o[1]); w2.y = pkh(o[2], o[3]);
                    *(LAS v2u*)(buf + O_GT + vl * RT + (8 * gq + 4 * hh) * 2) = w2;
                    if (gq < 2 && vl < 16) *(LAS f32x4*)(buf + O_NF + vl * 64 + (8 * gq + 4 * hh) * 4) = (f32x4){o[0], o[1], o[2], o[3]}; }
            }
            MS_BARRIER();
        }
    } else if (c.wave == 7) {
        unsigned pa0 = 0u, pa1 = 0u, pb0 = 0u, pb1 = 0u, pc0 = 0u, pc1 = 0u;
#define MS_TOUCH(chp_, r0_, r1_) do { const int chp = (chp_); if (chp < nch) { \
            _Pragma("unroll") for (int q_ = 0; q_ < 2; ++q_) { const int i_ = c.lane + 64 * q_; if (i_ < 86) { const GAS unsigned* a_; \
                if (i_ < 54) { const int rr_ = i_ / 3, sg_ = i_ - 3 * rr_; int t_ = dir ? T - 17 - 16 * chp + rr_ : 16 * chp - 1 + rr_; t_ = t_ < 0 ? 0 : (t_ > T - 1 ? T - 1 : t_); \
                    a_ = (const GAS unsigned*)(PROJ + (size_t)(row0 + t_) * DIN + (sg_ == 0 ? PC_R : (sg_ == 1 ? PC_K : PC_V)) + h * HD); } \
                else { const int j_ = i_ - 54, rr_ = j_ >> 1; const int t_ = dir ? T - 16 - 16 * chp + rr_ : 16 * chp + rr_; \
                    a_ = (const GAS unsigned*)(WA + (size_t)(row0 + t_) * 2048 + (j_ & 1) * 1024 + dir * 512 + h * HD); } \
                if (q_ == 0) r0_ = *a_; else r1_ = *a_; } } } } while (0)
        unsigned px0 = 0u, px1 = 0u, px2 = 0u, px3 = 0u, px4 = 0u, px5 = 0u;
        MS_TOUCH(0, px0, px1); MS_TOUCH(1, px2, px3); MS_TOUCH(2, px4, px5);
        for (int it = -3; it < nch; it += 3) {
            asm volatile("" :: "v"(pa0), "v"(pa1)); MS_TOUCH(it + 6, pa0, pa1); MS_BARRIER();
            if (it + 1 < nch) { asm volatile("" :: "v"(pb0), "v"(pb1)); MS_TOUCH(it + 7, pb0, pb1); MS_BARRIER(); }
            if (it + 2 < nch) { asm volatile("" :: "v"(pc0), "v"(pc1)); MS_TOUCH(it + 8, pc0, pc1); MS_BARRIER(); }
        }
        asm volatile("" :: "v"(px0), "v"(px1), "v"(px2), "v"(px3), "v"(px4), "v"(px5), "v"(pa0), "v"(pa1), "v"(pb0), "v"(pb1), "v"(pc0), "v"(pc1));
#undef MS_TOUCH
    } else {
    f32x16 St0, St1;
#pragma unroll
    for (int i = 0; i < 16; ++i) { St0[i] = 0.f; St1[i] = 0.f; }
    if (smp) { float one_ = 1.0f; asm volatile("" : "+v"(one_));
        const GAS float* s0 = IN(4) + (((((size_t)(sq - B_CTX) * NL + l) * 2 + dir) * NH + h) * HD + 32 * c.wave + vl) * HD + 4 * hh;
#pragma unroll
        for (int g = 0; g < 4; ++g) { const f32x4 a = *(const GAS f32x4*)(s0 + 8 * g), b = *(const GAS f32x4*)(s0 + 32 + 8 * g);
#pragma unroll
            for (int e = 0; e < 4; ++e) { St0[4 * g + e] = a[e] * one_; St1[4 * g + e] = b[e] * one_; } }
    }
        for (int it = -3; it < nch; ++it) {
            const int ch = it;
            if (ch >= 0) {
                LAS unsigned char* buf = c.lds + (ch % 3) * BUF;
                const int v = 32 * c.wave + vl;
                if (ch == 0) {
#pragma unroll
                for (int gq = 0; gq < 4; ++gq) { const f32x4 m0 = *(const LAS f32x4*)(buf + O_WM + (8 * gq + 4 * hh) * 4), m1 = *(const LAS f32x4*)(buf + O_WM + (32 + 8 * gq + 4 * hh) * 4);
#pragma unroll
                    for (int e = 0; e < 4; ++e) { St0[4 * gq + e] *= m0[e]; St1[4 * gq + e] *= m1[e]; } }
                }
                f16x4 bmlo[4], bmhi[4];
#pragma unroll
                for (int s = 0; s < 4; ++s) { bmlo[s] = *(const LAS f16x4*)(buf + O_BM + vl * RS + (16 * s + 4 * hh) * 2); bmhi[s] = *(const LAS f16x4*)(buf + O_BM + vl * RS + (16 * s + 8 + 4 * hh) * 2); }
                const f16x8 gtk = *(const LAS f16x8*)(buf + O_GT + vl * RT + (16 + 8 * hh) * 2), vpv = *(const LAS f16x8*)(buf + O_VP + v * RT + (8 * hh) * 2);
                const f16x8 aN = *(const LAS f16x8*)(buf + O_GT + vl * RT + (8 * hh) * 2);
                f32x4 nf[4][3];
#pragma unroll
                for (int a = 0; a < 4; ++a)
#pragma unroll
                    for (int e = 0; e < 3; ++e) nf[a][e] = *(const LAS f32x4*)(buf + O_NF + (4 * a + 1 + e) * 64 + 16 * a);
                f16x8 at0[2], at1[2];
#pragma unroll
                for (int s2 = 0; s2 < 2; ++s2) { at0[s2] = *(const LAS f16x8*)(buf + O_AT + vl * RT + (16 * s2 + 8 * hh) * 2); at1[s2] = *(const LAS f16x8*)(buf + O_AT + (32 + vl) * RT + (16 * s2 + 8 * hh) * 2); }
                f32x4 sc0[4], sc1[4];
                { LAS unsigned char* nbuf = c.lds + ((ch + 1) % 3) * BUF; const bool more = ch + 1 < nch;
#pragma unroll
                  for (int gq = 0; gq < 4; ++gq) { sc0[gq] = *(const LAS f32x4*)(buf + O_WE + (8 * gq + 4 * hh) * 4); sc1[gq] = *(const LAS f32x4*)(buf + O_WE + (32 + 8 * gq + 4 * hh) * 4);
                    if (more) { sc0[gq] *= *(const LAS f32x4*)(nbuf + O_WM + (8 * gq + 4 * hh) * 4); sc1[gq] *= *(const LAS f32x4*)(nbuf + O_WM + (32 + 8 * gq + 4 * hh) * 4); } } }
                f32x16 X;
#pragma unroll
                for (int i = 0; i < 16; ++i) X[i] = 0.f;
#pragma unroll
                for (int s = 0; s < 4; ++s) {
                    f16x8 sb;
#pragma unroll
                    for (int j = 0; j < 8; ++j) sb[j] = (f16)((s < 2) ? St0[8 * (s & 1) + j] : St1[8 * (s & 1) + j]);
                    const f16x8 af = {bmlo[s][0], bmlo[s][1], bmlo[s][2], bmlo[s][3], bmhi[s][0], bmhi[s][1], bmhi[s][2], bmhi[s][3]};
                    X = __builtin_amdgcn_mfma_f32_32x32x16_f16(af, sb, X, 0, 0, 0);
                }
                X = __builtin_amdgcn_mfma_f32_32x32x16_f16(gtk, vpv, X, 0, 0, 0);
                f16x8 pball;
#pragma unroll
                for (int j = 0; j < 8; ++j) pball[j] = (f16)0.f;
#define MS_BLK(a) do { const int xo_ = 4 * ((a) >> 1); \
                    const f32x4 n1_ = nf[a][0], n2_ = nf[a][1], n3_ = nf[a][2]; \
                    float q0_ = X[xo_]; float q1_ = X[xo_ + 1] - q0_ * n1_[0]; float q2_ = X[xo_ + 2] - q0_ * n2_[0] - q1_ * n2_[1]; float q3_ = X[xo_ + 3] - q0_ * n3_[0] - q1_ * n3_[1] - q2_ * n3_[2]; \
                    if (((a) & 1) != ((a) >> 1)) { float a_, b_; \
                        a_ = q0_; b_ = q0_; swap32(a_, b_); q0_ = ((a) & 1) ? b_ : a_; a_ = q1_; b_ = q1_; swap32(a_, b_); q1_ = ((a) & 1) ? b_ : a_; \
                        a_ = q2_; b_ = q2_; swap32(a_, b_); q2_ = ((a) & 1) ? b_ : a_; a_ = q3_; b_ = q3_; swap32(a_, b_); q3_ = ((a) & 1) ? b_ : a_; } \
                    const bool hold_ = hh == ((a) >> 1); \
                    const f16 z_ = (f16)0.f; const f16 e0_ = hold_ ? (f16)(-q0_) : z_, e1_ = hold_ ? (f16)(-q1_) : z_, e2_ = hold_ ? (f16)(-q2_) : z_, e3_ = hold_ ? (f16)(-q3_) : z_; \
                    f16x8 pb_ = {z_, z_, z_, z_, z_, z_, z_, z_}; \
                    pb_[4 * ((a) & 1)] = e0_; pb_[4 * ((a) & 1) + 1] = e1_; pb_[4 * ((a) & 1) + 2] = e2_; pb_[4 * ((a) & 1) + 3] = e3_; \
                    if (hold_) { pball[4 * ((a) & 1)] = e0_; pball[4 * ((a) & 1) + 1] = e1_; pball[4 * ((a) & 1) + 2] = e2_; pball[4 * ((a) & 1) + 3] = e3_; } \
                    X = __builtin_amdgcn_mfma_f32_32x32x16_f16(aN, pb_, X, 0, 0, 0); } while (0)
                MS_BLK(0); MS_BLK(1); MS_BLK(2); MS_BLK(3);
#undef MS_BLK
                St0 = __builtin_amdgcn_mfma_f32_32x32x16_f16(at0[0], vpv, St0, 0, 0, 0); St1 = __builtin_amdgcn_mfma_f32_32x32x16_f16(at1[0], vpv, St1, 0, 0, 0);
                St0 = __builtin_amdgcn_mfma_f32_32x32x16_f16(at0[1], pball, St0, 0, 0, 0); St1 = __builtin_amdgcn_mfma_f32_32x32x16_f16(at1[1], pball, St1, 0, 0, 0);
#pragma unroll
                for (int r = 8; r < 16; ++r) { const int t = (r & 3) + 8 * ((r >> 2) - 2) + 4 * hh; const int Sg = ch * 16 + t; const int tok = dir ? T - 1 - Sg : Sg;
                    Y[((size_t)dir * M + row0 + tok) * CW + h * HD + v] = (f16)X[r]; }
#pragma unroll
                for (int gq = 0; gq < 4; ++gq)
#pragma unroll
                    for (int e = 0; e < 4; ++e) { St0[4 * gq + e] *= sc0[gq][e]; St1[4 * gq + e] *= sc1[gq][e]; }
            }
            MS_BARRIER();
        }
    if (!smp) {
        GAS float* so = p.out + O_ST + (((((size_t)sq * NL + l) * 2 + dir) * NH + h) * HD + 32 * c.wave + vl) * HD + 4 * hh;
#pragma unroll
        for (int g = 0; g < 4; ++g) { *(GAS f32x4*)(so + 8 * g) = (f32x4){St0[4 * g], St0[4 * g + 1], St0[4 * g + 2], St0[4 * g + 3]};
            *(GAS f32x4*)(so + 32 + 8 * g) = (f32x4){St1[4 * g], St1[4 * g + 1], St1[4 * g + 2], St1[4 * g + 3]}; }
    }
    }
#undef MS_BARRIER
}
__device__ __forceinline__ void mfma_scan(const Params& p0, const Ctx& c0, int l) {
    const Ctx c = fresh(c0); FRESH_P(p0);
    const int b = c.bid, G = (int)gridDim.x;
    const bool deal = G >= 128;
    const int first = b, step = deal ? (b < 64 ? 576 : G - 64) : G;
#pragma nounroll
    for (int task = first; task < 576; task += step) mscan_task(p, c, l, task);
}

__device__ __forceinline__ int swap23(int r) { return (r & ~12) | ((r & 4) << 1) | ((r & 8) >> 1); }
__device__ __forceinline__ void attn_wave_task(const DParams& p, const Ctx& c, int l, int task) {
    const GAS f16* PROJ = (const GAS f16*)(p.ws + WS_R1); const GAS f16* KN = (const GAS f16*)(p.ws + WS_KN); const GAS f16* VT = (const GAS f16*)(p.ws + WS_VT);
    GAS f16* OA = (GAS f16*)(p.ws + WS_R4);
    const int hq = task & 7, qb = task >> 3, kvh = hq >> 2;
    const int r32 = c.lane & 31, hh = c.lane >> 5;
    int rowq0, L; const GAS f16* Kb; const GAS f16* Vb; bool smp;
    if (qb < 128) { smp = true; rowq0 = M_CTX + qb * 32; const int b = qb >> 5; L = KV_SMP;
        Kb = KN + KN_SMP_OFF + ((size_t)b * 2 + kvh) * KV_SMP * HD; Vb = VT + KN_SMP_OFF + ((size_t)b * 2 + kvh) * HD * KV_SMP; }
    else { smp = false; rowq0 = (qb - 128) * 32; const int b = rowq0 >> 8; L = T_CTX;
        Kb = KN + ((size_t)b * 2 + kvh) * T_CTX * HD; Vb = VT + ((size_t)b * 2 + kvh) * HD * T_CTX; }
    const int row = rowq0 + r32;
    float x[4][8]; float ss = 0.f;
#pragma unroll
    for (int s = 0; s < 4; ++s) { const f16x8 q = *(const GAS f16x8*)(PROJ + (size_t)row * DIN + PC_Q + hq * HD + 16 * s + 8 * hh);
#pragma unroll
        for (int j = 0; j < 8; ++j) { x[s][j] = (float)q[j]; ss += x[s][j] * x[s][j]; } }
    ss = half_sum(ss);
    const float rstd = rsqrtf(ss * (1.0f / HD) + 1e-6f);
#pragma unroll
    for (int s = 0; s < 4; ++s)
#pragma unroll
        for (int j = 0; j < 8; ++j) x[s][j] *= rstd * IN(26)[l * HD + 16 * s + 8 * hh + j];
    if (smp) { const int t = (row - M_CTX) & (T_SMP - 1); const float posr = (float)(t >> 6), posc = (float)(t & 63);
#pragma unroll
        for (int j = 0; j < 8; ++j) { const float freq = exp2f(-(float)(8 * hh + j) * (13.287712379549449f / 16.0f));
            const float ar = posr * freq, ac = posc * freq; const float cr = __cosf(ar), sr = __sinf(ar), cc = __cosf(ac), sc = __sinf(ac);
            const float a0 = x[0][j], a1 = x[1][j], b0 = x[2][j], b1 = x[3][j];
            x[0][j] = a0 * cr - a1 * sr; x[1][j] = a1 * cr + a0 * sr; x[2][j] = b0 * cc - b1 * sc; x[3][j] = b1 * cc + b0 * sc; } }
    f16x8 qf[4];
#pragma unroll
    for (int s = 0; s < 4; ++s)
#pragma unroll
        for (int j = 0; j < 8; ++j) qf[s][j] = (f16)(x[s][j] * (0.125f * 1.4426950408889634f));
    f32x16 o0, o1;
#pragma unroll
    for (int i = 0; i < 16; ++i) { o0[i] = 0.f; o1[i] = 0.f; }
    float mrun = -1e30f, lsum = 0.f;
    const GAS f16* kp = Kb + (size_t)swap23(r32) * HD + 8 * hh;
    const GAS f16* vp = Vb + (size_t)r32 * L + 8 * hh;
    const int ntile = L >> 5;
    f16x8 kf[4], vf[4];
#pragma unroll
    for (int s = 0; s < 4; ++s) kf[s] = *(const GAS f16x8*)(kp + 16 * s);
    vf[0] = *(const GAS f16x8*)(vp); vf[1] = *(const GAS f16x8*)(vp + 16); vf[2] = *(const GAS f16x8*)(vp + (size_t)32 * L); vf[3] = *(const GAS f16x8*)(vp + (size_t)32 * L + 16);
    for (int kt = 0; kt < ntile; ++kt) {
        f16x8 kn[4], vn[4];
        const int ktn = kt + 1 < ntile ? kt + 1 : kt;
#pragma unroll
        for (int s = 0; s < 4; ++s) kn[s] = *(const GAS f16x8*)(kp + (size_t)ktn * 32 * HD + 16 * s);
        vn[0] = *(const GAS f16x8*)(vp + ktn * 32); vn[1] = *(const GAS f16x8*)(vp + ktn * 32 + 16); vn[2] = *(const GAS f16x8*)(vp + (size_t)32 * L + ktn * 32); vn[3] = *(const GAS f16x8*)(vp + (size_t)32 * L + ktn * 32 + 16);
        f32x16 sa;
#pragma unroll
        for (int i = 0; i < 16; ++i) sa[i] = 0.f;
#pragma unroll
        for (int s = 0; s < 4; ++s) sa = __builtin_amdgcn_mfma_f32_32x32x16_f16(kf[s], qf[s], sa, 0, 0, 0);
        float mt = sa[0];
#pragma unroll
        for (int i = 1; i < 16; ++i) mt = fmaxf(mt, sa[i]);
        mt = half_max(mt);
        const float mn = fmaxf(mrun, mt); const float alpha = exp2f(mrun - mn); mrun = mn;
        float ps = 0.f;
#pragma unroll
        for (int i = 0; i < 16; ++i) { sa[i] = exp2f(sa[i] - mn); ps += sa[i]; }
        lsum = lsum * alpha + ps;
#pragma unroll
        for (int i = 0; i < 16; ++i) { o0[i] *= alpha; o1[i] *= alpha; }
        f16x8 pb0, pb1;
#pragma unroll
        for (int j = 0; j < 8; ++j) { pb0[j] = (f16)sa[j]; pb1[j] = (f16)sa[8 + j]; }
        o0 = __builtin_amdgcn_mfma_f32_32x32x16_f16(vf[0], pb0, o0, 0, 0, 0);
        o0 = __builtin_amdgcn_mfma_f32_32x32x16_f16(vf[1], pb1, o0, 0, 0, 0);
        o1 = __builtin_amdgcn_mfma_f32_32x32x16_f16(vf[2], pb0, o1, 0, 0, 0);
        o1 = __builtin_amdgcn_mfma_f32_32x32x16_f16(vf[3], pb1, o1, 0, 0, 0);
#pragma unroll
        for (int s = 0; s < 4; ++s) { kf[s] = kn[s]; vf[s] = vn[s]; }
    }
    lsum = half_sum(lsum);
    const float inv = 1.0f / lsum;
    GAS f16* op = OA + (size_t)row * D + CW + hq * HD + 4 * hh;
#pragma unroll
    for (int g = 0; g < 4; ++g) {
        v2u w0; w0.x = pkh(o0[4 * g] * inv, o0[4 * g + 1] * inv); w0.y = pkh(o0[4 * g + 2] * inv, o0[4 * g + 3] * inv);
        v2u w1; w1.x = pkh(o1[4 * g] * inv, o1[4 * g + 1] * inv); w1.y = pkh(o1[4 * g + 2] * inv, o1[4 * g + 3] * inv);
        *(GAS v2u*)(op + 8 * g) = w0; *(GAS v2u*)(op + 32 + 8 * g) = w1; }
}
constexpr int AT_KS = 144, AT_BUF = 2 * 64 * AT_KS;
__device__ __forceinline__ void attn_block_task(const DParams& p, const Ctx& c, int l, int item) {
    const GAS f16* PROJ = (const GAS f16*)(p.ws + WS_R1); const GAS f16* KN = (const GAS f16*)(p.ws + WS_KN); const GAS f16* VT = (const GAS f16*)(p.ws + WS_VT);
    GAS f16* OA = (GAS f16*)(p.ws + WS_R4);
    int rowq0, L, kvh; const GAS f16* Kb; const GAS f16* Vb; bool smp;
    if (item < 128) { smp = true; const int b = item >> 5; kvh = (item >> 4) & 1; rowq0 = M_CTX + b * T_SMP + (item & 15) * 64; L = KV_SMP;
        Kb = KN + KN_SMP_OFF + ((size_t)b * 2 + kvh) * KV_SMP * HD; Vb = VT + KN_SMP_OFF + ((size_t)b * 2 + kvh) * HD * KV_SMP; }
    else { smp = false; const int id = item - 128; const int b = id >> 3; kvh = (id >> 2) & 1; rowq0 = b * T_CTX + (id & 3) * 64; L = T_CTX;
        Kb = KN + ((size_t)b * 2 + kvh) * T_CTX * HD; Vb = VT + ((size_t)b * 2 + kvh) * HD * T_CTX; }
    const int hq = kvh * 4 + (c.wave & 3);
    const int r32 = c.lane & 31, hh = c.lane >> 5;
    const int row = rowq0 + 32 * (c.wave >> 2) + r32;
    const int kk = c.tid >> 3, chk = c.tid & 7;
    const GAS f16* ksrc = Kb + (size_t)kk * HD + chk * 8;
    const GAS f16* vsrc = Vb + (size_t)kk * L + chk * 8;
    const int sdst = kk * AT_KS + chk * 16;
    v4u kreg = *(const GAS v4u*)ksrc, vreg = *(const GAS v4u*)vsrc;
    float x[4][8]; float ss = 0.f;
#pragma unroll
    for (int s = 0; s < 4; ++s) { const f16x8 q = *(const GAS f16x8*)(PROJ + (size_t)row * DIN + PC_Q + hq * HD + 16 * s + 8 * hh);
#pragma unroll
        for (int j = 0; j < 8; ++j) { x[s][j] = (float)q[j]; ss += x[s][j] * x[s][j]; } }
    ss = half_sum(ss);
    const float rstd = rsqrtf(ss * (1.0f / HD) + 1e-6f);
#pragma unroll
    for (int s = 0; s < 4; ++s)
#pragma unroll
        for (int j = 0; j < 8; ++j) x[s][j] *= rstd * IN(26)[l * HD + 16 * s + 8 * hh + j];
    if (smp) { const int t = (row - M_CTX) & (T_SMP - 1); const float posr = (float)(t >> 6), posc = (float)(t & 63);
#pragma unroll
        for (int j = 0; j < 8; ++j) { const float freq = exp2f(-(float)(8 * hh + j) * (13.287712379549449f / 16.0f));
            const float ar = posr * freq, ac = posc * freq; const float cr = __cosf(ar), sr = __sinf(ar), cc = __cosf(ac), sc = __sinf(ac);
            const float a0 = x[0][j], a1 = x[1][j], b0 = x[2][j], b1 = x[3][j];
            x[0][j] = a0 * cr - a1 * sr; x[1][j] = a1 * cr + a0 * sr; x[2][j] = b0 * cc - b1 * sc; x[3][j] = b1 * cc + b0 * sc; } }
    f16x8 qf[4];
#pragma unroll
    for (int s = 0; s < 4; ++s)
#pragma unroll
        for (int j = 0; j < 8; ++j) qf[s][j] = (f16)(x[s][j] * (0.125f * 1.4426950408889634f));
    f32x16 o0, o1;
#pragma unroll
    for (int i = 0; i < 16; ++i) { o0[i] = 0.f; o1[i] = 0.f; }
    float mrun = -1e30f, lsum = 0.f;
    const int nstep = L >> 6;
    *(LAS v4u*)(c.lds + sdst) = kreg; *(LAS v4u*)(c.lds + 64 * AT_KS + sdst) = vreg;
    asm volatile("s_waitcnt lgkmcnt(0)" ::: "memory"); __builtin_amdgcn_s_barrier(); asm volatile("" ::: "memory");
    const int koff = swap23(r32) * AT_KS + 16 * hh, voff = 64 * AT_KS + r32 * AT_KS + 16 * hh;
    for (int st = 0; st < nstep; ++st) {
        if (st + 1 < nstep) { kreg = *(const GAS v4u*)(ksrc + (size_t)(st + 1) * 64 * HD); vreg = *(const GAS v4u*)(vsrc + (st + 1) * 64); }
        LAS unsigned char* sb = c.lds + (st & 1) * AT_BUF;
        f32x16 sa0, sa1;
#pragma unroll
        for (int i = 0; i < 16; ++i) { sa0[i] = 0.f; sa1[i] = 0.f; }
#pragma unroll
        for (int s = 0; s < 4; ++s) { const f16x8 k0 = *(const LAS f16x8*)(sb + koff + 32 * s), k1 = *(const LAS f16x8*)(sb + koff + 32 * AT_KS + 32 * s);
            sa0 = __builtin_amdgcn_mfma_f32_32x32x16_f16(k0, qf[s], sa0, 0, 0, 0); sa1 = __builtin_amdgcn_mfma_f32_32x32x16_f16(k1, qf[s], sa1, 0, 0, 0); }
        float mt = fmaxf(sa0[0], sa1[0]);
#pragma unroll
        for (int i = 1; i < 16; ++i) mt = fmaxf(mt, fmaxf(sa0[i], sa1[i]));
        mt = half_max(mt);
        const float mn = fmaxf(mrun, mt); const float alpha = __builtin_amdgcn_exp2f(mrun - mn); mrun = mn;
        float ps = 0.f;
#pragma unroll
        for (int i = 0; i < 16; ++i) { sa0[i] = __builtin_amdgcn_exp2f(sa0[i] - mn); sa1[i] = __builtin_amdgcn_exp2f(sa1[i] - mn); ps += sa0[i] + sa1[i]; }
        lsum = lsum * alpha + ps;
#pragma unroll
        for (int i = 0; i < 16; ++i) { o0[i] *= alpha; o1[i] *= alpha; }
        f16x8 pb[4];
#pragma unroll
        for (int j = 0; j < 8; ++j) { pb[0][j] = (f16)sa0[j]; pb[1][j] = (f16)sa0[8 + j]; pb[2][j] = (f16)sa1[j]; pb[3][j] = (f16)sa1[8 + j]; }
#pragma unroll
        for (int q4 = 0; q4 < 4; ++q4) {
            const f16x8 v0 = *(const LAS f16x8*)(sb + voff + 32 * q4), v1 = *(const LAS f16x8*)(sb + voff + 32 * AT_KS + 32 * q4);
            o0 = __builtin_amdgcn_mfma_f32_32x32x16_f16(v0, pb[q4], o0, 0, 0, 0); o1 = __builtin_amdgcn_mfma_f32_32x32x16_f16(v1, pb[q4], o1, 0, 0, 0); }
        if (st + 1 < nstep) { LAS unsigned char* nb = c.lds + ((st + 1) & 1) * AT_BUF; *(LAS v4u*)(nb + sdst) = kreg; *(LAS v4u*)(nb + 64 * AT_KS + sdst) = vreg; }
        asm volatile("s_waitcnt lgkmcnt(0)" ::: "memory"); __builtin_amdgcn_s_barrier(); asm volatile("" ::: "memory");
    }
    lsum = half_sum(lsum);
    const float inv = 1.0f / lsum;
    GAS f16* op = OA + (size_t)row * D + CW + hq * HD + 4 * hh;
#pragma unroll
    for (int g = 0; g < 4; ++g) {
        v2u w0; w0.x = pkh(o0[4 * g] * inv, o0[4 * g + 1] * inv); w0.y = pkh(o0[4 * g + 2] * inv, o0[4 * g + 3] * inv);
        v2u w1; w1.x = pkh(o1[4 * g] * inv, o1[4 * g + 1] * inv); w1.y = pkh(o1[4 * g + 2] * inv, o1[4 * g + 3] * inv);
        *(GAS v2u*)(op + 8 * g) = w0; *(GAS v2u*)(op + 32 + 8 * g) = w1; }
}
__device__ __forceinline__ void fast_attn(const Params& p0, const Ctx& c0, int l) {
    const Ctx c = fresh(c0); FRESH_P(p0);
    unsigned* ctr = (unsigned*)(p0.ws + WS_CTL) + 8192 + 64 * l;
    volatile LAS unsigned* slot = (volatile LAS unsigned*)(c.lds + MISC_OFF) + 16;
    for (;;) {
        if (c.tid == 0) slot[0] = __hip_atomic_fetch_add(ctr, 1u, __ATOMIC_RELAXED, __HIP_MEMORY_SCOPE_AGENT);
        __syncthreads();
        const int item = (int)slot[0];
        __syncthreads();
        if (item >= 384) break;
        attn_block_task(p, c, l, item);
    }
}

__device__ __forceinline__ void post_phase(const Params& p0, const Ctx& c0, int l) {
    const Ctx c = fresh(c0); FRESH_P(p0);
    const GAS f16* PROJ = (const GAS f16*)(p.ws + WS_R1); const GAS f16* Y = (const GAS f16*)(p.ws + WS_R3); const GAS float* RK = (const GAS float*)(p.ws + WS_RK);
    GAS f16* OA = (GAS f16*)(p.ws + WS_R4);
    const int ch0 = c.lane * 8, h = c.lane >> 3;
    float gnw[8], gnb[8], muv[8];
    { const f32x4 a0 = *(const GAS f32x4*)(IN(24) + l * CW + ch0), a1 = *(const GAS f32x4*)(IN(24) + l * CW + ch0 + 4), b0 = *(const GAS f32x4*)(IN(25) + l * CW + ch0), b1 = *(const GAS f32x4*)(IN(25) + l * CW + ch0 + 4);
      const f32x4 m0 = *(const GAS f32x4*)(IN(15) + (l * 3 + 2) * CW + ch0), m1 = *(const GAS f32x4*)(IN(15) + (l * 3 + 2) * CW + ch0 + 4);
#pragma unroll
      for (int e = 0; e < 4; ++e) { gnw[e] = a0[e]; gnw[4 + e] = a1[e]; gnb[e] = b0[e]; gnb[4 + e] = b1[e]; muv[e] = m0[e]; muv[4 + e] = m1[e]; } }
    for (int row = c.gw; row < M; row += c.ngw) {
        int g, t, T; row_info(row, g, t, T);
        const GAS f16* pr = PROJ + (size_t)row * DIN + PC_V + ch0;
        const f16x8 y0 = *(const GAS f16x8*)(Y + (size_t)row * CW + ch0), y1 = *(const GAS f16x8*)(Y + ((size_t)M + row) * CW + ch0);
        const f16x8 vc = *(const GAS f16x8*)pr; const f16x8 gv = *(const GAS f16x8*)(OA + (size_t)row * D + ch0);
        f16x8 vp, vn;
#pragma unroll
        for (int e = 0; e < 8; ++e) { vp[e] = (f16)0.f; vn[e] = (f16)0.f; }
        if (t > 0) vp = *(const GAS f16x8*)(pr - DIN);
        if (t < T - 1) vn = *(const GAS f16x8*)(pr + DIN);
        const float rk = RK[(size_t)row * 8 + h] + RK[((size_t)M + row) * 8 + h];
        float y[8]; float s = 0.f;
#pragma unroll
        for (int e = 0; e < 8; ++e) { y[e] = (float)y0[e] + (float)y1[e]; s += y[e]; }
        const float mean = dpp_sum8(s) * (1.0f / HD); float q = 0.f;
#pragma unroll
        for (int e = 0; e < 8; ++e) { y[e] -= mean; q += y[e] * y[e]; }
        const float rstd = rsqrtf(dpp_sum8(q) * (1.0f / HD) + 64e-5f);
        float o[8];
#pragma unroll
        for (int e = 0; e < 8; ++e) { const float vcf = (float)vc[e]; const float v = vcf + muv[e] * (0.5f * ((float)vp[e] + (float)vn[e]) - vcf);
            o[e] = (y[e] * rstd * gnw[e] + gnb[e] + rk * v) * (float)gv[e]; }
        v4u w; w.x = pkh(o[0], o[1]); w.y = pkh(o[2], o[3]); w.z = pkh(o[4], o[5]); w.w = pkh(o[6], o[7]);
        *(GAS v4u*)(OA + (size_t)row * D + ch0) = w;
    }
}

__device__ __forceinline__ void gemm_proj(const Params& p0, const Ctx& c0) { const Ctx c = fresh(c0); FRESH_P(p0);
    pg8::Gemm g{(const GAS f16*)(p.ws + WS_R4), (const GAS f16*)(p.ws + WS_W + WO_IN), D, D, D}; pg8::StaticOrder S; S.init(M, DIN, (int)gridDim.x, c.bid);
    pg8::gemm_phase(c.lds, g, S, pg8::EpiProjF{(GAS f16*)(p.ws + WS_R1)}, c.wave); }
__device__ __forceinline__ void gemm_wa(const Params& p0, const Ctx& c0, int l) { const Ctx c = fresh(c0); FRESH_P(p0);
    pg8::Gemm g{(const GAS f16*)(p.ws + WS_R1) + PC_LW, (const GAS f16*)(p.ws + WS_W + WO_SM), DIN, 128, 128}; pg8::StaticOrder S; S.init(M, 2048, (int)gridDim.x, c.bid);
    pg8::gemm_phase(c.lds, g, S, pg8::EpiWAF{(GAS f16*)(p.ws + WS_R2), IN(19) + (size_t)l * 2 * CW, IN(21) + (size_t)l * 2 * CW}, c.wave); }
__device__ __forceinline__ void gemm_gate(const Params& p0, const Ctx& c0) { const Ctx c = fresh(c0); FRESH_P(p0);
    pg8::Gemm g{(const GAS f16*)(p.ws + WS_R1) + PC_LG, (const GAS f16*)(p.ws + WS_W + WO_G), DIN, 128, 128}; pg8::StaticOrder S; if (gridDim.x >= 224) S.init(M, CW, (int)gridDim.x, c.bid - 128); else S.init(M, CW, (int)gridDim.x, c.bid);
    pg8::gemm_phase(c.lds, g, S, pg8::EpiF16F{(GAS f16*)(p.ws + WS_R4), D}, c.wave); }
__device__ __forceinline__ void gemm_merge(const Params& p0, const Ctx& c0) { const Ctx c = fresh(c0); FRESH_P(p0);
    const GAS f16* OA = (const GAS f16*)(p.ws + WS_R4); const GAS f16* WbrT = (const GAS f16*)(p.ws + WS_W + WO_BR); GAS f16* MG = (GAS f16*)(p.ws + WS_R3); const GAS f16* PROJ = (const GAS f16*)(p.ws + WS_R1);
    pg8::StaticOrder S; S.init(M, D, (int)gridDim.x, c.bid, 192);
    pg8::Gemm g{OA, WbrT, D, D, D}; pg8::gemm_phase<pg8::EpiMergeF, 96>(c.lds, g, S, pg8::EpiMergeF{MG, PROJ}, c.wave); }
__device__ __forceinline__ void gemm_out(const Params& p0, const Ctx& c0) { const Ctx c = fresh(c0); FRESH_P(p0);
    pg8::Gemm g{(const GAS f16*)(p.ws + WS_R3), (const GAS f16*)(p.ws + WS_W + WO_OUT), D, D, D}; pg8::StaticOrder S; S.init(M, D, (int)gridDim.x, c.bid, 192);
    pg8::gemm_phase<pg8::EpiF16F, 96>(c.lds, g, S, pg8::EpiF16F{(GAS f16*)(p.ws + WS_R2), D}, c.wave); }
__device__ __forceinline__ void gemm_up(const Params& p0, const Ctx& c0) { const Ctx c = fresh(c0); FRESH_P(p0);
    pg8::Gemm g{(const GAS f16*)(p.ws + WS_R4), (const GAS f16*)(p.ws + WS_W + WO_UP), D, D, D}; pg8::StaticOrder S; S.init(M, DFF, (int)gridDim.x, c.bid);
    pg8::gemm_phase(c.lds, g, S, pg8::EpiRelu2F{(GAS f16*)(p.ws + WS_R1), DFF}, c.wave); }
__device__ __forceinline__ void gemm_down(const Params& p0, const Ctx& c0) { const Ctx c = fresh(c0); FRESH_P(p0);
    pg8::Gemm g{(const GAS f16*)(p.ws + WS_R1), (const GAS f16*)(p.ws + WS_W + WO_DN), DFF, DFF, DFF}; pg8::StaticOrder S; S.init(M, D, (int)gridDim.x, c.bid, 192);
    pg8::gemm_phase<pg8::EpiF16F, 96>(c.lds, g, S, pg8::EpiF16F{(GAS f16*)(p.ws + WS_R2), D}, c.wave); }

__global__ void __launch_bounds__(NTHREADS, 2) fwd_kernel(Params p) {
    extern __shared__ __attribute__((aligned(16))) unsigned char lds_raw[];
    Ctx c;
    c.lds = (LAS unsigned char*)lds_raw;
    c.tid = threadIdx.x; c.lane = c.tid & 63; c.wave = __builtin_amdgcn_readfirstlane(c.tid >> 6);
    c.gw = blockIdx.x * NWAVES + c.wave; c.ngw = gridDim.x * NWAVES; c.gt = blockIdx.x * NTHREADS + c.tid; c.ngt = gridDim.x * NTHREADS;
    volatile LAS unsigned* MISC = (volatile LAS unsigned*)(c.lds + MISC_OFF);
    if (c.tid < 32) MISC[c.tid] = 0u;
    if (c.tid < 28) ((LAS unsigned long long*)(c.lds + PTAB_OFF))[c.tid] = (unsigned long long)p.in[c.tid];
    __syncthreads();
    unsigned* ctl = (unsigned*)(p.ws + WS_CTL);
    XcdBarrier bar = xcd_barrier_post(ctl + CW_BAR, MISC + 8);
#define GRID_BAR() xcd_barrier(bar)

    conv_weights<0>(p, c, 0, c.gw, c.ngw);
    __syncthreads();
    mod_phase(p, c);
    GRID_BAR();
    norm_phase<0>(p, c, 0);
    GRID_BAR();
#pragma nounroll
    for (int l = 0; l < NL; ++l) {
        gemm_proj(p, c);
        {
            const int first = (M / 256) * (DIN / 256) % (int)gridDim.x;
            __syncthreads();
            if ((int)blockIdx.x >= first) conv_weights<1>(p, c, l, ((int)blockIdx.x - first) * NWAVES + c.wave, ((int)gridDim.x - first) * NWAVES);
        }
        GRID_BAR();
        gemm_wa(p, c, l);
        gemm_gate(p, c);
        kv_prep(p, c, l);
        GRID_BAR();
        mfma_scan(p, c, l);
        __syncthreads();
        fast_attn(p, c, l);
        GRID_BAR();
        post_phase(p, c, l);
        GRID_BAR();
        gemm_merge(p, c);
        GRID_BAR();
        gemm_out(p, c);
        GRID_BAR();
        norm_phase<1>(p, c, l);
        GRID_BAR();
        gemm_up(p, c);
        GRID_BAR();
        gemm_down(p, c);
        GRID_BAR();
        norm_phase<2>(p, c, l);
        if (l + 1 < NL) { __syncthreads(); conv_weights<0>(p, c, l + 1, c.gw, c.ngw); }
        GRID_BAR();
    }
}

extern "C" void kernel_launch(void* const* d_in, const int* in_sizes, int n_in, void* d_out, int out_size, void* d_ws, size_t ws_size, hipStream_t stream) {
    static int grid = 0;
    if (grid == 0) {
        if (n_in != 28 || (size_t)out_size != O_TOTAL || ws_size < WS_END) { fprintf(stderr, "kernel_launch: unexpected shapes n_in %d out %d ws %zu\n", n_in, out_size, ws_size); grid = -1; return; }
        int dev = 0, cus = 0;
        if (hipGetDevice(&dev) != hipSuccess || hipDeviceGetAttribute(&cus, hipDeviceAttributeMultiprocessorCount, dev) != hipSuccess) { grid = -1; return; }
        if (hipFuncSetAttribute((const void*)fwd_kernel, hipFuncAttributeMaxDynamicSharedMemorySize, LDS_BYTES) != hipSuccess) { fprintf(stderr, "kernel_launch: hipFuncSetAttribute failed\n"); grid = -1; return; }
        grid = cus;
    }
    if (grid < 0) return;
    (void)hipMemsetAsync((char*)d_ws + WS_CTL, 0, CTL_BYTES + MiB, stream);
    Params p{};
    for (int i = 0; i < 28; ++i) p.in[i] = (const float*)d_in[i];
    p.out = (float*)d_out; p.ws = (unsigned char*)d_ws;
    hipLaunchKernelGGL(fwd_kernel, dim3(grid), dim3(NTHREADS), LDS_BYTES, stream, p);
}
```

```cpp
#include <hip/hip_runtime.h>
#include <cstdio>
#include <cstdint>

#define GAS __attribute__((address_space(1)))
#define LAS __attribute__((address_space(3)))
typedef _Float16 f16;
typedef _Float16 f16x8 __attribute__((ext_vector_type(8)));
typedef _Float16 f16x4 __attribute__((ext_vector_type(4)));
typedef _Float16 f16x2 __attribute__((ext_vector_type(2)));
typedef float f32x4 __attribute__((ext_vector_type(4)));
typedef float f32x16 __attribute__((ext_vector_type(16)));
typedef unsigned v4u __attribute__((ext_vector_type(4)));
typedef unsigned v2u __attribute__((ext_vector_type(2)));

constexpr int D = 1024, DIN = 4608, DFF = 4096, CW = 512, NL = 2, NH = 8, HD = 64;
constexpr int B_CTX = 32, T_CTX = 256, B_SMP = 4, T_SMP = 1024, PAST = 256, KV_SMP = PAST + T_SMP;
constexpr int M_CTX = B_CTX * T_CTX, M_SMP = B_SMP * T_SMP, M = M_CTX + M_SMP;
constexpr int NMOD = 6 * D;
constexpr int PC_R = 0, PC_K = 512, PC_V = 1024, PC_LW = 1536, PC_LA = 1600, PC_LG = 1664, PC_Q = 1792, PC_KA = 2304, PC_VA = 2432, PC_GR = 2560, PC_GA = 3584;
constexpr size_t O_Y = 0, O_CK = (size_t)M * D, O_CV = O_CK + (size_t)B_CTX * NL * T_CTX * 128, O_ST = O_CV + (size_t)B_CTX * NL * T_CTX * 128;
constexpr size_t O_TOTAL = O_ST + (size_t)B_CTX * NL * 2 * NH * HD * HD;

constexpr size_t MiB = 1u << 20;
constexpr size_t WS_CTL = 0, CTL_BYTES = 1 * MiB;
constexpr size_t WS_MOD = 1 * MiB;
constexpr size_t WS_W = 2 * MiB;
constexpr size_t WO_IN = 0, WO_BR = 9 * MiB, WO_OUT = 11 * MiB, WO_UP = 13 * MiB, WO_DN = 21 * MiB, WO_SM = 29 * MiB, WO_G = 29 * MiB + 512 * 1024;
constexpr size_t WS_R1 = 32 * MiB;
constexpr size_t WS_R2 = 140 * MiB;
constexpr size_t WS_R3 = 188 * MiB;
constexpr size_t WS_RK = 212 * MiB;
constexpr size_t WS_R4 = 213 * MiB;
constexpr size_t WS_KN = 237 * MiB;
constexpr size_t WS_VT = 241 * MiB;
constexpr size_t WS_END = 245 * MiB;
constexpr size_t KN_SMP_OFF = (size_t)B_CTX * 2 * T_CTX * 64;

constexpr int NWAVES = 8, NTHREADS = 512;
constexpr int LDS_BYTES = 147456;
constexpr int MISC_OFF = 131072 + 320, PTAB_OFF = 131072 + 1024;

#define XB_TMO      128
#define XB_XCNT(j)  (256  + 64 * (j))
#define XB_XSUB(j)  (1280 + 64 * (j))
#define XB_XGEN(j)  (2304 + 64 * (j))
#define XB_TOP      3328
#define XB_TOPGEN   3392
#define XCD_BAR_WORDS 3456
#define XB_SPIN_CAP (1u << 24)
constexpr int CW_BAR = 4096;

__device__ __forceinline__ unsigned xb_ld(unsigned* p)              { return __hip_atomic_load(p, __ATOMIC_RELAXED, __HIP_MEMORY_SCOPE_AGENT); }
__device__ __forceinline__ unsigned xb_add(unsigned* p, unsigned v) { return __hip_atomic_fetch_add(p, v, __ATOMIC_RELAXED, __HIP_MEMORY_SCOPE_AGENT); }
__device__ __forceinline__ unsigned xb_xcc_id() { return (unsigned)__builtin_amdgcn_s_getreg((3 << 11) | 20) & 0xFu; }
#define XB_SPIN(cond, bar) do { unsigned _sp = 0; while (cond) { __builtin_amdgcn_s_sleep(1); \
    if ((++_sp & 255u) == 0u) { if (xb_ld(&(bar)[XB_TMO])) break; if (_sp > XB_SPIN_CAP) { atomicAdd(&(bar)[XB_TMO], 1u); break; } } } } while (0)

struct XcdBarrier { unsigned* bar; unsigned x; volatile LAS unsigned* st; };

__device__ __forceinline__ XcdBarrier xcd_barrier_post(unsigned* bar, volatile LAS unsigned* st) {
    XcdBarrier b; b.bar = bar; b.x = xb_xcc_id(); b.st = st;
    if (threadIdx.x == 0) (void)xb_add(&bar[XB_XCNT(b.x)], 1u);
    return b;
}
__device__ __forceinline__ void xcd_barrier_complete(unsigned* bar, unsigned x, unsigned& nloc, unsigned& nx) {
    const unsigned G = gridDim.x * gridDim.y * gridDim.z;
    unsigned sum, cnt, mine, sp = 0u;
    for (;;) {
        sum = 0u; cnt = 0u; mine = 0u;
#pragma unroll
        for (unsigned j = 0; j < 16; ++j) { const unsigned c = xb_ld(&bar[XB_XCNT(j)]); sum += c; cnt += (c > 0u) ? 1u : 0u; mine = (j == x) ? c : mine; }
        if (sum == G) break;
        __builtin_amdgcn_s_sleep(1);
        if ((++sp & 255u) == 0u) { if (xb_ld(&bar[XB_TMO])) break; if (sp > XB_SPIN_CAP) { atomicAdd(&bar[XB_TMO], 1u); break; } }
    }
    nloc = mine > 0u ? mine : 1u; nx = cnt > 0u ? cnt : 1u;
}
__device__ __forceinline__ void xcd_barrier(const XcdBarrier& b) {
    asm volatile("s_waitcnt vmcnt(0)" ::: "memory");
    __syncthreads();
    if (threadIdx.x == 0) {
        unsigned* bar = b.bar; unsigned bx = b.x;
        asm volatile("" : "+s"(bar), "+s"(bx));
        __builtin_amdgcn_s_waitcnt(0);
        unsigned nloc = b.st[0], nx = b.st[1];
        if (nloc == 0u) { xcd_barrier_complete(bar, bx, nloc, nx); b.st[0] = nloc; b.st[1] = nx; }
        const unsigned old = xb_add(&bar[XB_XSUB(bx)], 1u);
        const unsigned gen = old / nloc;
        if (old + 1u == (gen + 1u) * nloc) {
            __builtin_amdgcn_fence(__ATOMIC_RELEASE, "agent");
            asm volatile("s_waitcnt vmcnt(0)" ::: "memory");
            const unsigned og = xb_add(&bar[XB_TOP], 1u);
            const unsigned tg = og / nx;
            if (og + 1u == (tg + 1u) * nx) xb_add(&bar[XB_TOPGEN], 1u);
            else XB_SPIN(xb_ld(&bar[XB_TOPGEN]) == tg, bar);
            __builtin_amdgcn_fence(__ATOMIC_ACQUIRE, "agent");
            xb_add(&bar[XB_XGEN(bx)], 1u);
            asm volatile("s_waitcnt vmcnt(0)" ::: "memory");
        } else {
            XB_SPIN(xb_ld(&bar[XB_XGEN(bx)]) == gen, bar);
            __builtin_amdgcn_fence(__ATOMIC_ACQUIRE, "agent");
            asm volatile("s_waitcnt vmcnt(0)" ::: "memory");
        }
    }
    __syncthreads();
}

#define LDS_WAIT() asm volatile("s_waitcnt lgkmcnt(0)" ::: "memory")
#define DPPF(x, ctrl, rmask, oldv) __builtin_bit_cast(float, __builtin_amdgcn_update_dpp(__builtin_bit_cast(int, (float)(oldv)), __builtin_bit_cast(int, (float)(x)), (ctrl), (rmask), 0xF, false))
__device__ __forceinline__ float wave_sum(float v) {
    v += DPPF(v, 0xB1, 0xF, 0.f); v += DPPF(v, 0x4E, 0xF, 0.f); v += DPPF(v, 0x141, 0xF, 0.f); v += DPPF(v, 0x140, 0xF, 0.f);
    v += DPPF(v, 0x142, 0xA, 0.f); v += DPPF(v, 0x143, 0xC, 0.f);
    return __builtin_bit_cast(float, __builtin_amdgcn_readlane(__builtin_bit_cast(int, v), 63));
}
__device__ __forceinline__ float dpp_f(float x, const int ctrl) { return x; }
#define DPP_ADD(x, ctrl) (x) += __builtin_bit_cast(float, __builtin_amdgcn_update_dpp(0, __builtin_bit_cast(int, (x)), (ctrl), 0xF, 0xF, true))
__device__ __forceinline__ float dpp_sum8(float x) { DPP_ADD(x, 0xB1); DPP_ADD(x, 0x4E); DPP_ADD(x, 0x141); return x; }
__device__ __forceinline__ float dpp_sum16(float x) { DPP_ADD(x, 0xB1); DPP_ADD(x, 0x4E); DPP_ADD(x, 0x141); DPP_ADD(x, 0x140); return x; }
__device__ __forceinline__ void swap32(float& a, float& b) { asm volatile("v_nop\n\tv_nop\n\tv_permlane32_swap_b32 %0, %1" : "+v"(a), "+v"(b)); }
__device__ __forceinline__ float half_sum(float v) { float a = v, b = v; swap32(a, b); return a + b; }
__device__ __forceinline__ float half_max(float v) { float a = v, b = v; swap32(a, b); return fmaxf(a, b); }
__device__ __forceinline__ float xor16(float v) { return __builtin_bit_cast(float, __builtin_amdgcn_ds_swizzle(__builtin_bit_cast(int, v), 0x401F)); }
__device__ __forceinline__ float sigmoidf_(float x) { return __builtin_amdgcn_rcpf(1.0f + __expf(-x)); }
__device__ __forceinline__ float tanhf_(float x) { return 1.0f - 2.0f * __builtin_amdgcn_rcpf(1.0f + __expf(2.0f * x)); }
__device__ __forceinline__ unsigned pkh(float lo, float hi) { f16x2 v = {(f16)lo, (f16)hi}; return __builtin_bit_cast(unsigned, v); }
__device__ __forceinline__ void row_info(int row, int& g, int& t, int& T) {
    if (row < M_CTX) { g = 0; t = row & (T_CTX - 1); T = T_CTX; }
    else { const int r = row - M_CTX; g = 1 + (r >> 10); t = r & (T_SMP - 1); T = T_SMP; }
}

struct Params {
    const float* in[28];
    float* out;
    unsigned char* ws;
};
struct DParams { GAS float* out; GAS unsigned char* ws; };
struct Ctx {
    LAS unsigned char* lds;
    int tid, lane, wave, gw, ngw, gt, ngt, bid;
};
__device__ __forceinline__ int lane_id() { int ln; asm volatile("v_mbcnt_lo_u32_b32 %0, -1, 0\n\tv_mbcnt_hi_u32_b32 %0, -1, %0" : "=v"(ln)); return ln; }
__device__ __forceinline__ const GAS float* inp(const Ctx& c, int i) {
    const unsigned long long v = ((const LAS unsigned long long*)(c.lds + PTAB_OFF))[i];
    const unsigned lo = __builtin_amdgcn_readfirstlane((unsigned)v), hi = __builtin_amdgcn_readfirstlane((unsigned)(v >> 32));
    return (const GAS float*)(((unsigned long long)hi << 32) | lo); }
#define IN(i) inp(c, (i))
#define FRESH_P(p0) DParams p; { float* o_ = (p0).out; unsigned char* w_ = (p0).ws; asm volatile("" : "+s"(o_), "+s"(w_)); p.out = (GAS float*)o_; p.ws = (GAS unsigned char*)w_; }
__device__ __forceinline__ Ctx fresh(const Ctx& c0) {
    Ctx c = c0; int w = c0.wave; asm volatile("" : "+s"(w)); int ln = lane_id(); asm volatile("" : "+v"(ln));
    int b = blockIdx.x; asm volatile("" : "+s"(b));
    c.wave = w; c.lane = ln; c.tid = w * 64 + ln; c.bid = b;
    c.gw = b * 8 + w; c.gt = b * 512 + c.tid; return c; }

__device__ __forceinline__ void conv_item(const GAS float* W, int N, GAS f16* WT, int ldt, int koff, LAS float* scr, int kb, int nb, int lane) {
    const int k0 = 64 * kb, n0 = 32 * nb;
    float v[32];
#pragma unroll
    for (int i = 0; i < 32; ++i) { const int kk = 2 * i + (lane >> 5); v[i] = __builtin_nontemporal_load(W + (size_t)(k0 + kk) * N + n0 + (lane & 31)); }
#pragma unroll
    for (int i = 0; i < 32; ++i) { const int kk = 2 * i + (lane >> 5); scr[kk * 33 + (lane & 31)] = v[i]; }
    LDS_WAIT();
    const int c = lane & 7;
#pragma unroll
    for (int j = 0; j < 4; ++j) { const int n = (lane >> 3) + 8 * j; const LAS float* s = scr + (8 * c) * 33 + n;
        v4u o; o.x = pkh(s[0 * 33], s[1 * 33]); o.y = pkh(s[2 * 33], s[3 * 33]); o.z = pkh(s[4 * 33], s[5 * 33]); o.w = pkh(s[6 * 33], s[7 * 33]);
        *(GAS v4u*)(WT + (size_t)(n0 + n) * ldt + koff + k0 + 8 * c) = o; }
    LDS_WAIT();
}
template <int PART>
__device__ __forceinline__ void conv_weights(const Params& p0, const Ctx& c0, int l, int gw, int ngw) {
    const Ctx c = fresh(c0); FRESH_P(p0);
    asm volatile("" : "+s"(gw), "+s"(ngw));
    LAS float* scr = (LAS float*)(c.lds + c.wave * 16384);
    GAS unsigned char* wb = p.ws + WS_W;
    if (PART == 0) {
        GAS f16* WinT = (GAS f16*)(wb + WO_IN); GAS f16* WsmT = (GAS f16*)(wb + WO_SM); GAS f16* WgT = (GAS f16*)(wb + WO_G);
        const GAS float* w_in = IN(7) + (size_t)l * D * DIN;
        const GAS float* dec_up = IN(20) + (size_t)l * 2 * 64 * CW; const GAS float* icl_up = IN(22) + (size_t)l * 2 * 64 * CW; const GAS float* gate_up = IN(23) + (size_t)l * 128 * CW;
        constexpr int I0 = 16 * 144, I6 = 16, I7 = 16, I8 = 16, I9 = 16, I10 = 2 * 16;
        constexpr int NIT = I0 + I6 + I7 + I8 + I9 + I10;
        for (int it = gw; it < NIT; it += ngw) {
            int r = it;
            if (r < I0) { conv_item(w_in, DIN, WinT, D, 0, scr, r / 144, r % 144, c.lane); continue; } r -= I0;
            if (r < I6) { conv_item(dec_up, CW, WsmT, 128, 0, scr, 0, r, c.lane); continue; } r -= I6;
            if (r < I7) { conv_item(dec_up + 64 * CW, CW, WsmT + (size_t)512 * 128, 128, 0, scr, 0, r, c.lane); continue; } r -= I7;
            if (r < I8) { conv_item(icl_up, CW, WsmT + (size_t)1024 * 128, 128, 64, scr, 0, r, c.lane); continue; } r -= I8;
            if (r < I9) { conv_item(icl_up + 64 * CW, CW, WsmT + (size_t)1536 * 128, 128, 64, scr, 0, r, c.lane); continue; } r -= I9;
            conv_item(gate_up, CW, WgT, 128, 0, scr, r / 16, r % 16, c.lane);
        }
        unsigned zz_ = 0u; asm volatile("" : "+v"(zz_));
        for (int i = gw * 64 + c.lane; i < 2048 * 8; i += ngw * 64) { const int row = i >> 3, ch = i & 7; const int col = (row < 1024 ? 64 : 0) + ch * 8;
            *(GAS v4u*)(WsmT + (size_t)row * 128 + col) = (v4u){zz_, zz_, zz_, zz_}; }
    } else {
        GAS f16* WbrT = (GAS f16*)(wb + WO_BR); GAS f16* WoutT = (GAS f16*)(wb + WO_OUT); GAS f16* WupT = (GAS f16*)(wb + WO_UP); GAS f16* WdnT = (GAS f16*)(wb + WO_DN);
        const GAS float* w_br = IN(8) + (size_t)l * 2 * CW * D; const GAS float* w_out = IN(9) + (size_t)l * D * D;
        const GAS float* w_up = IN(13) + (size_t)l * D * DFF; const GAS float* w_dn = IN(14) + (size_t)l * DFF * D;
        constexpr int I1 = 8 * 32, I2 = 8 * 32, I3 = 16 * 32, I4 = 16 * 128, I5 = 64 * 32;
        constexpr int NIT = I1 + I2 + I3 + I4 + I5;
        for (int it = gw; it < NIT; it += ngw) {
            int r = it;
            if (r < I1) { conv_item(w_br, D, WbrT, D, 0, scr, r / 32, r % 32, c.lane); continue; } r -= I1;
            if (r < I2) { conv_item(w_br + (size_t)CW * D, D, WbrT, D, CW, scr, r / 32, r % 32, c.lane); continue; } r -= I2;
            if (r < I3) { conv_item(w_out, D, WoutT, D, 0, scr, r / 32, r % 32, c.lane); continue; } r -= I3;
            if (r < I4) { conv_item(w_up, DFF, WupT, D, 0, scr, r / 128, r % 128, c.lane); continue; } r -= I4;
            conv_item(w_dn, D, WdnT, DFF, 0, scr, r / 32, r % 32, c.lane);
        }
    }
}

__device__ __forceinline__ void mod_phase(const Params& p0, const Ctx& c0) {
    const Ctx c = fresh(c0); FRESH_P(p0);
    LAS float* sl = (LAS float*)(c.lds);
    LAS float* part = (LAS float*)(c.lds + 32768);
    GAS float* mod = (GAS float*)(p.ws + WS_MOD);
    for (int i = c.tid; i < 5 * D; i += NTHREADS) { const int g = i >> 10, k = i & 1023; const float v = g == 0 ? IN(6)[k] : IN(5)[(g - 1) * D + k]; sl[i] = v / (1.0f + __expf(-v)); }
    __syncthreads();
    for (int it = c.bid; it < NL * (NMOD / 64) * 4; it += gridDim.x) {
        const int kq = it & 3, lc = it >> 2, l = lc / (NMOD / 64), cc = lc % (NMOD / 64);
        const int kb = kq * 256 + c.wave * 32;
        const GAS float* w = IN(10) + (size_t)l * D * NMOD + (size_t)kb * NMOD + cc * 64 + c.lane;
        float a0 = 0.f, a1 = 0.f, a2 = 0.f, a3 = 0.f, a4 = 0.f;
        float wv[32];
#pragma unroll
        for (int k = 0; k < 32; ++k) wv[k] = w[(size_t)k * NMOD];
#pragma unroll
        for (int k = 0; k < 32; ++k) { a0 += sl[kb + k] * wv[k]; a1 += sl[D + kb + k] * wv[k]; a2 += sl[2 * D + kb + k] * wv[k]; a3 += sl[3 * D + kb + k] * wv[k]; a4 += sl[4 * D + kb + k] * wv[k]; }
        LAS float* pw = part + c.wave * 320 + c.lane;
        pw[0] = a0; pw[64] = a1; pw[128] = a2; pw[192] = a3; pw[256] = a4;
        __syncthreads();
        if (c.tid < 320) { float s = 0.f;
#pragma unroll
            for (int w8 = 0; w8 < 8; ++w8) s += part[w8 * 320 + c.tid];
            const int g = c.tid >> 6, col = cc * 64 + (c.tid & 63);
            if (kq == 0) s += IN(11)[(size_t)l * NMOD + col];
            atomicAdd((float*)(mod + ((size_t)l * 5 + g) * NMOD + col), s); }
        __syncthreads();
    }
}

template <int MODE, int NB>
__device__ __forceinline__ void norm_rows(const DParams& p, const Ctx& c, int l, int row_first, int row_end, int row_step) {
    GAS float* YO = p.out; GAS f16* XA = (GAS f16*)p.out;
    GAS f16* XB = (GAS f16*)(p.ws + WS_R3);
    const GAS f16* MO = (const GAS f16*)(p.ws + WS_R2); GAS f16* H = (GAS f16*)(p.ws + WS_R4);
    const GAS float* modb = (const GAS float*)(p.ws + WS_MOD);
    const GAS float* in0 = IN(0); const GAS float* in1 = IN(1); const GAS float* ngb = IN(12);
    for (int rowb = row_first; rowb < row_end; rowb += NB * row_step) {
        f32x4 x0[MODE == 0 ? NB : 1][4]; f16x4 xh[MODE == 0 ? 1 : NB][4]; f16x4 mh[MODE == 0 ? 1 : NB][4];
#pragma unroll
        for (int b = 0; b < NB; ++b) { const int row = rowb + b * row_step;
            if (row < row_end) {
                if (MODE == 0) { const GAS float* src = row < M_CTX ? in0 + (size_t)row * D : in1 + (size_t)(row - M_CTX) * D;
#pragma unroll
                    for (int j = 0; j < 4; ++j) x0[MODE == 0 ? b : 0][j] = __builtin_nontemporal_load((const GAS f32x4*)(src + 256 * j + 4 * c.lane)); }
                else { const GAS f16* xs = (MODE == 1 ? XA : XB) + (size_t)row * D;
#pragma unroll
                    for (int j = 0; j < 4; ++j) { xh[MODE == 0 ? 0 : b][j] = __builtin_nontemporal_load((const GAS f16x4*)(xs + 256 * j + 4 * c.lane));
                        mh[MODE == 0 ? 0 : b][j] = __builtin_nontemporal_load((const GAS f16x4*)(MO + (size_t)row * D + 256 * j + 4 * c.lane)); } } } }
#pragma unroll
        for (int b = 0; b < NB; ++b) { const int row = rowb + b * row_step;
            if (row < row_end) {
                int g, t, T; row_info(row, g, t, T);
                f32x4 x[4];
#pragma unroll
                for (int j = 0; j < 4; ++j) {
                    if (MODE == 0) x[j] = x0[MODE == 0 ? b : 0][j];
                    else {
#pragma unroll
                        for (int e = 0; e < 4; ++e) x[j][e] = (float)xh[MODE == 0 ? 0 : b][j][e]; } }
                if (MODE != 0) {
                    const GAS float* mo_mod = modb + ((size_t)l * 5 + g) * NMOD + (MODE == 1 ? 2 * D : 5 * D);
                    const GAS float* ngp = ngb + ((size_t)l * 4 + (MODE == 1 ? 1 : 3)) * D;
                    float mv[4][4]; float ss = 0.f;
#pragma unroll
                    for (int j = 0; j < 4; ++j)
#pragma unroll
                        for (int e = 0; e < 4; ++e) { mv[j][e] = (float)mh[MODE == 0 ? 0 : b][j][e]; ss += mv[j][e] * mv[j][e]; }
                    const float rstd = rsqrtf(wave_sum(ss) * (1.0f / D) + 1e-6f);
#pragma unroll
                    for (int j = 0; j < 4; ++j) { const f32x4 gg = *(const GAS f32x4*)(mo_mod + 256 * j + 4 * c.lane); const f32x4 nn = *(const GAS f32x4*)(ngp + 256 * j + 4 * c.lane);
#pragma unroll
                        for (int e = 0; e < 4; ++e) x[j][e] += gg[e] * (mv[j][e] * rstd * nn[e]); }
                }
                const int ln = MODE == 2 ? l + 1 : l;
                if (ln < NL) {
                    const GAS float* mb = modb + ((size_t)ln * 5 + g) * NMOD + (MODE == 1 ? 3 * D : 0);
                    const GAS float* ngp = ngb + ((size_t)ln * 4 + (MODE == 1 ? 2 : 0)) * D;
                    float ss = 0.f;
#pragma unroll
                    for (int j = 0; j < 4; ++j) ss += (x[j][0] * x[j][0] + x[j][1] * x[j][1]) + (x[j][2] * x[j][2] + x[j][3] * x[j][3]);
                    const float rstd = rsqrtf(wave_sum(ss) * (1.0f / D) + 1e-6f);
                    GAS f16* XW = (MODE == 1 ? XB : XA) + (size_t)row * D;
#pragma unroll
                    for (int j = 0; j < 4; ++j) { const f32x4 sh = *(const GAS f32x4*)(mb + 256 * j + 4 * c.lane); const f32x4 sc = *(const GAS f32x4*)(mb + D + 256 * j + 4 * c.lane);
                        const f32x4 nn = *(const GAS f32x4*)(ngp + 256 * j + 4 * c.lane);
                        float o[4];
#pragma unroll
                        for (int e = 0; e < 4; ++e) o[e] = x[j][e] * rstd * nn[e] * (1.0f + sc[e]) + sh[e];
                        v2u w; w.x = pkh(o[0], o[1]); w.y = pkh(o[2], o[3]);
                        *(GAS v2u*)(H + (size_t)row * D + 256 * j + 4 * c.lane) = w;
                        v2u xw; xw.x = pkh(x[j][0], x[j][1]); xw.y = pkh(x[j][2], x[j][3]);
                        __builtin_nontemporal_store(xw, (GAS v2u*)(XW + 256 * j + 4 * c.lane)); }
                } else {
#pragma unroll
                    for (int j = 0; j < 4; ++j) __builtin_nontemporal_store(x[j], (GAS f32x4*)(YO + (size_t)row * D + 256 * j + 4 * c.lane)); }
            } }
    }
}
template <int MODE>
__device__ __forceinline__ void norm_phase(const Params& p0, const Ctx& c0, int l) {
    const Ctx c = fresh(c0); FRESH_P(p0);
    norm_rows<MODE, 6>(p, c, l, c.gw, M, c.ngw);
}

namespace pg8 {
constexpr int BM = 256, BK = 64, HALF = 128, HTB = HALF * BK * 2, STAGE_BYTES = 8 * HTB, NXCD = 8, WGM = 8;
__host__ __device__ __forceinline__ int lds_byte(int r, int c) { const int st = (r >> 4) * 2 + (c >> 5), rr = r & 15, cc = c & 31, ob = rr * 64 + cc * 2; return st * 1024 + (ob ^ (((ob >> 9) & 1) << 5)); }
__host__ __device__ __forceinline__ void stage_rc(int b, int& R, int& C) { const int st = b / 1024, sb = b % 1024, swz = sb ^ (((sb >> 9) & 1) << 5); R = (st >> 1) * 16 + swz / 64; C = (st & 1) * 32 + (swz % 64) / 2; }
__host__ __device__ __forceinline__ int perm32(int rho) { const int n = rho >> 4, i = rho & 15; return 8 * (i >> 2) + 4 * n + (i & 3); }
struct Unit { int pm, pn; };
struct Gemm { const GAS f16* A; const GAS f16* Bt; int lda, ldb, K; };
struct StaticOrder {
    int nM, nN, nwg, G, c;
    __device__ void init(int Mr, int N, int G_, int c_, int bm = BM) { nM = Mr / bm; nN = N / BM; nwg = nM * nN; G = G_; c = c_; }
    __device__ bool next(int i, Unit& u) const {
        const long L = (long)i * G + c; if (c < 0 || L >= nwg) return false;
        int wgid = (int)L; { const int q = nwg / NXCD, r = nwg % NXCD, xcd = wgid % NXCD, off = wgid / NXCD; wgid = (xcd < r ? xcd * (q + 1) : r * (q + 1) + (xcd - r) * q) + off; }
        const int nig = WGM * nN, gid = wgid / nig, fm = gid * WGM, gsz = (nM - fm) < WGM ? (nM - fm) : WGM;
        u.pm = fm + ((wgid % nig) % gsz); u.pn = (wgid % nig) / gsz; return true;
    }
};
template <class Epi, int HA = 128, bool ALIGN_EPI = true, bool SP2 = true>
__device__ __forceinline__ void gemm_phase(LAS unsigned char* lds, const Gemm g, const StaticOrder& S, const Epi& E, int wave_sgpr) {
    asm volatile("" : "+s"(wave_sgpr)); int tid = wave_sgpr * 64 + lane_id(); asm volatile("" : "+v"(tid));
    const int wid = __builtin_amdgcn_readfirstlane(tid >> 6), lane = tid & 63, wr = wid >> 2, wc = wid & 3, fr = lane & 15, fq = lane >> 4;
    const int K = g.K, nt = K / BK;
    unsigned voffA[2], voffB[2];
#pragma unroll
    for (int i = 0; i < 2; ++i) { int R, C; stage_rc(tid * 16 + i * 8192, R, C); const int Rb = (R & ~31) + perm32(R & 31);
        voffA[i] = (unsigned)(R * g.lda + C) * 2u; voffB[i] = (unsigned)(Rb * g.ldb + C) * 2u; }
    const unsigned kstep = (unsigned)(BK * 2);
    constexpr int MF = HA / 32;
    const unsigned hstepA = (unsigned)HA * g.lda * 2, hstepB = (unsigned)HALF * g.ldb * 2;
    const unsigned tstepA = 2 * hstepA, tstepB = 2 * hstepB;
    const unsigned ldsw = (unsigned)wid * 1024u;
    const int aoff = lds_byte(wr * (HA / 2) + fr, fq * 8), boff = lds_byte(wc * 32 + fr, fq * 8);
#define PG8_SA(b, h) (((b) * 2 + (h)) * HTB)
#define PG8_SB(b, h) ((4 + (b) * 2 + (h)) * HTB)
#define PG8_STAGE(bufoff, gbase, soff, voff) do { _Pragma("unroll") for (int _i = 0; _i < 2; ++_i) \
        __builtin_amdgcn_raw_ptr_buffer_load_lds(rs##gbase, (LAS unsigned*)(lds + (bufoff) + ldsw + _i * 8192), 16, (voff)[_i], (int)(soff), 0, 0); } while (0)
#define PG8_LDA(dst, b, h) do { _Pragma("unroll") for (int m = 0; m < MF; ++m) _Pragma("unroll") for (int k = 0; k < 2; ++k) dst[m][k] = *(const LAS f16x8*)(lds + PG8_SA(b, h) + aoff + m * 2048 + k * 1024); } while (0)
#define PG8_LDB(dst, b, h) do { _Pragma("unroll") for (int n = 0; n < 2; ++n) _Pragma("unroll") for (int k = 0; k < 2; ++k) dst[n][k] = *(const LAS f16x8*)(lds + PG8_SB(b, h) + boff + n * 2048 + k * 1024); } while (0)
#define PG8_MMA(ai, bj, At, Bt) do { __builtin_amdgcn_s_setprio(1); _Pragma("unroll") for (int m = 0; m < MF; ++m) _Pragma("unroll") for (int n = 0; n < 2; ++n) _Pragma("unroll") for (int k = 0; k < 2; ++k) \
        acc[ai][bj][m][n] = __builtin_amdgcn_mfma_f32_16x16x32_f16(Bt[n][k], At[m][k], acc[ai][bj][m][n], 0, 0, 0); __builtin_amdgcn_s_setprio(0); } while (0)
#define PG8_WAIT_V(n) asm volatile("s_waitcnt vmcnt(" #n ")" ::: "memory")
#define PG8_WAIT_L(n) asm volatile("s_waitcnt lgkmcnt(" #n ")" ::: "memory")
#define PG8_BAR __builtin_amdgcn_s_barrier()
#define PG8_SCHED __builtin_amdgcn_sched_barrier(0)
    Unit cur, nxt; int ui = 0;
    if (!S.next(0, cur)) return;
    f32x4 acc[2][2][4][2];
#pragma unroll
    for (int a = 0; a < 2; ++a)
#pragma unroll
        for (int b = 0; b < 2; ++b)
#pragma unroll
            for (int m = 0; m < 4; ++m)
#pragma unroll
                for (int n = 0; n < 2; ++n) acc[a][b][m][n] = (f32x4){0.f, 0.f, 0.f, 0.f};
    f16x8 At[4][2], B0[2][2], B1[2][2];
    const auto rsA = __builtin_amdgcn_make_buffer_rsrc((GAS void*)g.A, 0, 0x7fffffff, 0x00020000); const auto rsB = __builtin_amdgcn_make_buffer_rsrc((GAS void*)g.Bt, 0, 0x7fffffff, 0x00020000);
    unsigned cA = (unsigned)cur.pm * tstepA, cB = (unsigned)cur.pn * tstepB;
    if constexpr (SP2) {
        PG8_STAGE(PG8_SB(0, 0), B, cB, voffB); PG8_STAGE(PG8_SB(0, 1), B, cB + hstepB, voffB); PG8_STAGE(PG8_SA(0, 0), A, cA, voffA); PG8_STAGE(PG8_SA(0, 1), A, cA + hstepA, voffA);
        if (wr == 1) PG8_BAR;
        PG8_WAIT_V(2); PG8_BAR;
        PG8_STAGE(PG8_SB(1, 0), B, cB + kstep, voffB); PG8_STAGE(PG8_SA(1, 0), A, cA + kstep, voffA); PG8_STAGE(PG8_SB(1, 1), B, cB + hstepB + kstep, voffB);
        PG8_WAIT_V(6); PG8_BAR;
    } else {
        PG8_STAGE(PG8_SB(0, 0), B, cB, voffB); PG8_STAGE(PG8_SA(0, 0), A, cA, voffA); PG8_STAGE(PG8_SB(0, 1), B, cB + hstepB, voffB); PG8_STAGE(PG8_SA(0, 1), A, cA + hstepA, voffA);
        if (wr == 1) PG8_BAR;
        PG8_WAIT_V(4); PG8_BAR;
        PG8_STAGE(PG8_SB(1, 0), B, cB + kstep, voffB); PG8_STAGE(PG8_SA(1, 0), A, cA + kstep, voffA); PG8_STAGE(PG8_SB(1, 1), B, cB + hstepB + kstep, voffB);
        PG8_WAIT_V(6); PG8_BAR;
    }
    for (;;) {
        const bool has_next = S.next(ui + 1, nxt);
        const unsigned nA = has_next ? (unsigned)nxt.pm * tstepA : cA, nB = has_next ? (unsigned)nxt.pn * tstepB : cB;
        for (int t = 0; t < nt; t += 2) {
            if constexpr (Epi::MID_T >= 0) { if (t == Epi::MID_T) { const int ln3 = lane_id(); E.template mid<HA>(acc, cur, wr, wc, ln3 & 15, ln3 >> 4); } }
            const bool last = (t == nt - 2);
            const unsigned a1 = cA + (unsigned)(t + 1) * kstep;
            const unsigned a2 = last ? nA : cA + (unsigned)(t + 2) * kstep, b2 = last ? nB : cB + (unsigned)(t + 2) * kstep;
            const unsigned a3 = a2 + kstep, b3 = b2 + kstep;
            if constexpr (SP2) {
            PG8_LDB(B0, 0, 0); PG8_LDB(B1, 0, 1); PG8_SCHED; PG8_LDA(At, 0, 0); PG8_STAGE(PG8_SA(1, 1), A, a1 + hstepA, voffA);
            PG8_WAIT_V(8); PG8_WAIT_L(0); PG8_BAR; PG8_MMA(0, 0, At, B0); PG8_MMA(0, 1, At, B1); PG8_BAR; PG8_SCHED;
            PG8_LDA(At, 0, 1); PG8_STAGE(PG8_SB(0, 0), B, b2, voffB); PG8_STAGE(PG8_SB(0, 1), B, b2 + hstepB, voffB); PG8_STAGE(PG8_SA(0, 0), A, a2, voffA);
            PG8_WAIT_V(8); PG8_WAIT_L(0); PG8_BAR; PG8_MMA(1, 0, At, B0); PG8_MMA(1, 1, At, B1); PG8_BAR; PG8_SCHED;
            PG8_LDB(B0, 1, 0); PG8_LDB(B1, 1, 1); PG8_SCHED; PG8_LDA(At, 1, 0); PG8_STAGE(PG8_SA(0, 1), A, a2 + hstepA, voffA);
            PG8_WAIT_V(8); PG8_WAIT_L(0); PG8_BAR; PG8_MMA(0, 0, At, B0); PG8_MMA(0, 1, At, B1); PG8_BAR; PG8_SCHED;
            PG8_LDA(At, 1, 1); PG8_STAGE(PG8_SB(1, 0), B, b3, voffB); PG8_STAGE(PG8_SB(1, 1), B, b3 + hstepB, voffB); PG8_STAGE(PG8_SA(1, 0), A, a3, voffA);
            PG8_WAIT_V(8); PG8_WAIT_L(0); PG8_BAR; PG8_MMA(1, 0, At, B0); PG8_MMA(1, 1, At, B1); PG8_BAR; PG8_SCHED;
            } else {
            PG8_LDB(B0, 0, 0); PG8_SCHED; PG8_LDA(At, 0, 0); PG8_STAGE(PG8_SA(1, 1), A, a1 + hstepA, voffA);
            PG8_WAIT_L(8); PG8_BAR; PG8_WAIT_L(0); PG8_MMA(0, 0, At, B0); PG8_BAR; PG8_SCHED;
            PG8_LDB(B1, 0, 1); PG8_STAGE(PG8_SB(0, 0), B, b2, voffB);
            PG8_BAR; PG8_WAIT_L(0); PG8_MMA(0, 1, At, B1); PG8_BAR;
            PG8_LDA(At, 0, 1); PG8_STAGE(PG8_SA(0, 0), A, a2, voffA);
            PG8_BAR; PG8_WAIT_L(0); PG8_MMA(1, 0, At, B0); PG8_BAR; PG8_SCHED;
            PG8_STAGE(PG8_SB(0, 1), B, b2 + hstepB, voffB);
            PG8_WAIT_V(6); PG8_BAR; PG8_MMA(1, 1, At, B1); PG8_BAR;
            PG8_LDB(B0, 1, 0); PG8_SCHED; PG8_LDA(At, 1, 0); PG8_STAGE(PG8_SA(0, 1), A, a2 + hstepA, voffA);
            PG8_WAIT_L(8); PG8_BAR; PG8_WAIT_L(0); PG8_MMA(0, 0, At, B0); PG8_BAR; PG8_SCHED;
            PG8_LDB(B1, 1, 1); PG8_STAGE(PG8_SB(1, 0), B, b3, voffB);
            PG8_BAR; PG8_WAIT_L(0); PG8_MMA(0, 1, At, B1); PG8_BAR;
            PG8_LDA(At, 1, 1); PG8_STAGE(PG8_SA(1, 0), A, a3, voffA);
            PG8_BAR; PG8_WAIT_L(0); PG8_MMA(1, 0, At, B0); PG8_BAR; PG8_SCHED;
            PG8_STAGE(PG8_SB(1, 1), B, b3 + hstepB, voffB);
            PG8_WAIT_V(6); PG8_BAR; PG8_MMA(1, 1, At, B1); PG8_BAR;
            }
        }
        if constexpr (ALIGN_EPI) { if (wr == 0) PG8_BAR; }
        { const int ln2 = lane_id(); E.template run<HA>(acc, cur, wr, wc, ln2 & 15, ln2 >> 4); }
        if (!has_next) break;
#pragma unroll
        for (int a = 0; a < 2; ++a)
#pragma unroll
            for (int b = 0; b < 2; ++b)
#pragma unroll
                for (int m = 0; m < 4; ++m)
#pragma unroll
                    for (int n = 0; n < 2; ++n) acc[a][b][m][n] = (f32x4){0.f, 0.f, 0.f, 0.f};
        cur = nxt; cA = nA; cB = nB; ++ui;
        if constexpr (ALIGN_EPI) { if (wr == 1) PG8_BAR; }
    }
    PG8_WAIT_V(0);
    if constexpr (!ALIGN_EPI) { if (wr == 0) PG8_BAR; }
    PG8_BAR;
#undef PG8_SA
#undef PG8_SB
#undef PG8_STAGE
#undef PG8_LDA
#undef PG8_LDB
#undef PG8_MMA
#undef PG8_WAIT_V
#undef PG8_WAIT_L
#undef PG8_BAR
#undef PG8_SCHED
}
typedef f32x4 Acc[2][2][4][2];
#define PG8_EPI_LOOP(...) \
    const int row0 = u.pm * (2 * HA) + wr * (HA / 2) + fr, col0 = u.pn * BM + wc * 32 + 8 * fq; \
    _Pragma("unroll") for (int ai = 0; ai < 2; ++ai) _Pragma("unroll") for (int m = 0; m < HA / 32; ++m) { const int row = row0 + ai * HA + m * 16; \
        _Pragma("unroll") for (int bj = 0; bj < 2; ++bj) { const int col = col0 + bj * HALF; f32x4 v0 = acc[ai][bj][m][0], v1 = acc[ai][bj][m][1]; __VA_ARGS__ } asm volatile("" ::: "memory"); }
__device__ __forceinline__ void store8(GAS f16* p, f32x4 v0, f32x4 v1) { v4u w; w.x = pkh(v0[0], v0[1]); w.y = pkh(v0[2], v0[3]); w.z = pkh(v1[0], v1[1]); w.w = pkh(v1[2], v1[3]); *(GAS v4u*)p = w; }
struct EpiProjF { static constexpr int MID_T = -1; GAS f16* P;
    template <int HA> __device__ __forceinline__ void run(const Acc& acc, const Unit& u, int wr, int wc, int fr, int fq) const {
        PG8_EPI_LOOP(
            if (u.pn == 6) {
                if (col < PC_LA) { _Pragma("unroll") for (int e = 0; e < 4; ++e) { v0[e] = tanhf_(v0[e]); v1[e] = tanhf_(v1[e]); } }
                else if (col >= PC_LG) { _Pragma("unroll") for (int e = 0; e < 4; ++e) { v0[e] = sigmoidf_(v0[e]); v1[e] = sigmoidf_(v1[e]); } }
            } else if (u.pn >= 10) { _Pragma("unroll") for (int e = 0; e < 4; ++e) { v0[e] = sigmoidf_(v0[e]); v1[e] = sigmoidf_(v1[e]); } }
            store8(P + (size_t)row * DIN + col, v0, v1);
        )
    } };
#define DPPM(x, ctrl) (x) *= __builtin_bit_cast(float, __builtin_amdgcn_update_dpp(0x3f800000, __builtin_bit_cast(int, (x)), (ctrl), 0xF, 0xF, false))
struct EpiWAF { static constexpr int MID_T = -1; GAS f16* WA; const GAS float* w0; const GAS float* a0;
    template <int HA> __device__ __forceinline__ void run(const Acc& acc, const Unit& u, int wr, int wc, int fr, int fq) const {
        PG8_EPI_LOOP(
            if (col < 1024) { const f32x4 b0 = *(const GAS f32x4*)(w0 + col), b1 = *(const GAS f32x4*)(w0 + col + 4);
                float x[8];
                _Pragma("unroll") for (int e = 0; e < 4; ++e) { x[e] = __expf(-0.606531f * sigmoidf_(v0[e] + b0[e])); x[4 + e] = __expf(-0.606531f * sigmoidf_(v1[e] + b1[e])); }
                if (col < 512) {
                    _Pragma("unroll") for (int e = 0; e < 8; ++e) { DPPM(x[e], 0x111); DPPM(x[e], 0x112); DPPM(x[e], 0x114); DPPM(x[e], 0x118);
                        const float wm = __builtin_bit_cast(float, __builtin_amdgcn_ds_swizzle(__builtin_bit_cast(int, x[e]), 0x00F0)); x[e] = (fr == 7) ? wm : x[e] * __builtin_amdgcn_rcpf(wm); }
                } else {
                    _Pragma("unroll") for (int e = 0; e < 8; ++e) { DPPM(x[e], 0x101); DPPM(x[e], 0x102); DPPM(x[e], 0x104); DPPM(x[e], 0x108);
                        const float wm = __builtin_bit_cast(float, __builtin_amdgcn_ds_swizzle(__builtin_bit_cast(int, x[e]), 0x0110)); x[e] = (fr == 8) ? wm : x[e] * __builtin_amdgcn_rcpf(wm); }
                }
                _Pragma("unroll") for (int e = 0; e < 4; ++e) { v0[e] = x[e]; v1[e] = x[4 + e]; } }
            else { const f32x4 b0 = *(const GAS f32x4*)(a0 + col - 1024), b1 = *(const GAS f32x4*)(a0 + col - 1024 + 4);
                _Pragma("unroll") for (int e = 0; e < 4; ++e) { v0[e] = sigmoidf_(v0[e] + b0[e]); v1[e] = sigmoidf_(v1[e] + b1[e]); } }
            store8(WA + (size_t)row * 2048 + col, v0, v1);
        )
    } };
struct EpiF16F { static constexpr int MID_T = -1; GAS f16* O; int ld;
    template <int HA> __device__ __forceinline__ void run(const Acc& acc, const Unit& u, int wr, int wc, int fr, int fq) const {
        PG8_EPI_LOOP( store8(O + (size_t)row * ld + col, v0, v1); )
    } };
struct EpiRelu2F { static constexpr int MID_T = -1; GAS f16* O; int ld;
    template <int HA> __device__ __forceinline__ void run(const Acc& acc, const Unit& u, int wr, int wc, int fr, int fq) const {
        PG8_EPI_LOOP(
            _Pragma("unroll") for (int e = 0; e < 4; ++e) { const float a = fmaxf(v0[e], 0.f), b = fmaxf(v1[e], 0.f); v0[e] = a * a; v1[e] = b * b; }
            store8(O + (size_t)row * ld + col, v0, v1);
        )
    } };
struct EpiMergeF { static constexpr int MID_T = 8; GAS f16* MG; const GAS f16* PROJ;
    template <int HA> __device__ __forceinline__ void mid(Acc& acc, const Unit& u, int wr, int wc, int fr, int fq) const {
        const int row0 = u.pm * (2 * HA) + wr * (HA / 2) + fr, col0 = u.pn * BM + wc * 32 + 8 * fq;
#pragma unroll
        for (int ai = 0; ai < 2; ++ai)
#pragma unroll
            for (int m = 0; m < HA / 32; ++m) { const int row = row0 + ai * HA + m * 16;
#pragma unroll
                for (int bj = 0; bj < 2; ++bj) { const int col = col0 + bj * HALF;
                    const f16x8 gr = *(const GAS f16x8*)(PROJ + (size_t)row * DIN + PC_GR + col), ga = *(const GAS f16x8*)(PROJ + (size_t)row * DIN + PC_GA + col);
#pragma unroll
                    for (int e = 0; e < 4; ++e) { acc[ai][bj][m][0][e] *= (float)gr[e] * __builtin_amdgcn_rcpf(fmaxf((float)ga[e], 1e-4f)); acc[ai][bj][m][1][e] *= (float)gr[4 + e] * __builtin_amdgcn_rcpf(fmaxf((float)ga[4 + e], 1e-4f)); } }
                asm volatile("" ::: "memory"); }
    }
    template <int HA> __device__ __forceinline__ void run(const Acc& acc, const Unit& u, int wr, int wc, int fr, int fq) const {
        PG8_EPI_LOOP(
            const f16x8 ga = *(const GAS f16x8*)(PROJ + (size_t)row * DIN + PC_GA + col);
            _Pragma("unroll") for (int e = 0; e < 4; ++e) { v0[e] *= fmaxf((float)ga[e], 1e-4f); v1[e] *= fmaxf((float)ga[4 + e], 1e-4f); }
            store8(MG + (size_t)row * D + col, v0, v1);
        )
    } };
}

__device__ __forceinline__ void kv_prep(const Params& p0, const Ctx& c0, int l) {
    const Ctx c = fresh(c0); FRESH_P(p0);
    const GAS f16* PROJ = (const GAS f16*)(p.ws + WS_R1); GAS f16* KN = (GAS f16*)(p.ws + WS_KN); GAS f16* VT = (GAS f16*)(p.ws + WS_VT);
    const int d = c.lane;
    const float kg = IN(27)[l * HD + d];
    const int axis = d >> 5, half = (d >> 4) & 1, f = d & 15;
    const float freq = exp2f(-(float)f * (13.287712379549449f / 16.0f));
    for (int it = c.gw; it < (M / 8) * 2; it += c.ngw) {
        const int kvh = it & 1, row0 = (it >> 1) * 8;
        float kx[8], vx[8];
#pragma unroll
        for (int r = 0; r < 8; ++r) { const GAS f16* pr = PROJ + (size_t)(row0 + r) * DIN + kvh * HD + d; kx[r] = (float)pr[PC_KA]; vx[r] = (float)pr[PC_VA]; }
#pragma unroll
        for (int r = 0; r < 8; ++r) kx[r] = kx[r] * rsqrtf(wave_sum(kx[r] * kx[r]) * (1.0f / HD) + 1e-6f) * kg;
        f16x8 vv;
#pragma unroll
        for (int r = 0; r < 8; ++r) vv[r] = (f16)vx[r];
        if (row0 < M_CTX) { const int b = row0 >> 8, t0 = row0 & 255;
#pragma unroll
            for (int r = 0; r < 8; ++r) { const size_t o = ((((size_t)b * NL + l) * T_CTX + t0 + r) * 2 + kvh) * HD + d;
                p.out[O_CK + o] = kx[r]; p.out[O_CV + o] = vx[r];
                KN[(((size_t)b * 2 + kvh) * T_CTX + t0 + r) * HD + d] = (f16)kx[r]; }
            *(GAS f16x8*)(VT + (((size_t)b * 2 + kvh) * HD + d) * T_CTX + t0) = vv;
        } else { const int rr = row0 - M_CTX, b = rr >> 10, t0 = rr & 1023;
#pragma unroll
            for (int r = 0; r < 8; ++r) { const int t = t0 + r; const float pos = (float)(axis == 0 ? (t >> 6) : (t & 63));
                const float ang = pos * freq; const float cs = __cosf(ang), sn = __sinf(ang);
                const float other = xor16(kx[r]);
                const float ko = half == 0 ? kx[r] * cs - other * sn : kx[r] * cs + other * sn;
                KN[KN_SMP_OFF + (((size_t)b * 2 + kvh) * KV_SMP + PAST + t) * HD + d] = (f16)ko; }
            *(GAS f16x8*)(VT + KN_SMP_OFF + (((size_t)b * 2 + kvh) * HD + d) * KV_SMP + PAST + t0) = vv;
        }
    }
    for (int it = c.gw; it < B_SMP * (PAST / 8) * 2; it += c.ngw) {
        const int kvh = it & 1, j0 = ((it >> 1) & 31) * 8, b = it >> 6;
        f16x8 vv;
#pragma unroll
        for (int r = 0; r < 8; ++r) { const size_t s = ((((size_t)b * NL + l) * PAST + j0 + r) * 2 + kvh) * HD + d;
            KN[KN_SMP_OFF + (((size_t)b * 2 + kvh) * KV_SMP + j0 + r) * HD + d] = (f16)IN(2)[s]; vv[r] = (f16)IN(3)[s]; }
        *(GAS f16x8*)(VT + KN_SMP_OFF + (((size_t)b * 2 + kvh) * HD + d) * KV_SMP + j0) = vv;
    }
}

constexpr int TC = 32, ST_STEP = 6 * 64, ST_BUF = TC * ST_STEP;
struct StageRegs { f16x4 r[3], k[3], v[3], w, a; };
__device__ __forceinline__ void scan_task(const DParams& p, const Ctx& c, int l, int task) {
    const GAS f16* PROJ = (const GAS f16*)(p.ws + WS_R1); const GAS f16* WA = (const GAS f16*)(p.ws + WS_R2);
    GAS f16* Y = (GAS f16*)(p.ws + WS_R3); GAS float* RK = (GAS float*)(p.ws + WS_RK);
    LAS float* st = (LAS float*)c.lds;
    int sq, dir, h;
    if (task < 64) { h = task & 7; dir = (task >> 3) & 1; sq = B_CTX + (task >> 4); } else { const int id = task - 64; h = id & 7; dir = (id >> 3) & 1; sq = id >> 4; }
    const bool smp = sq >= B_CTX; const int T = smp ? T_SMP : T_CTX; const int row0 = smp ? M_CTX + (sq - B_CTX) * T_SMP : sq * T_CTX;
    const int nch = T / TC;
    const int tt = c.tid >> 4, cq = c.tid & 15, ch0 = h * HD + cq * 4;
    const f32x4 mu_r = *(const GAS f32x4*)(IN(15) + (l * 3 + 0) * CW + ch0), mu_k = *(const GAS f32x4*)(IN(15) + (l * 3 + 1) * CW + ch0), mu_v = *(const GAS f32x4*)(IN(15) + (l * 3 + 2) * CW + ch0);
    const f32x4 k_k = *(const GAS f32x4*)(IN(16) + l * CW + ch0), k_a = *(const GAS f32x4*)(IN(17) + l * CW + ch0), r_k = *(const GAS f32x4*)(IN(18) + l * CW + ch0);
    const int ks = c.lane & 7, srow = c.wave * 8 + (c.lane >> 3);
    float S[8];
    if (smp) { const GAS float* s0 = IN(4) + (((((size_t)(sq - B_CTX) * NL + l) * 2 + dir) * NH + h) * HD + srow) * HD + ks * 8;
        const f32x4 a = *(const GAS f32x4*)s0, b = *(const GAS f32x4*)(s0 + 4);
        S[0] = a[0]; S[1] = a[1]; S[2] = a[2]; S[3] = a[3]; S[4] = b[0]; S[5] = b[1]; S[6] = b[2]; S[7] = b[3];
    } else {
#pragma unroll
        for (int j = 0; j < 8; ++j) S[j] = 0.f;
    }
    StageRegs sr;
    const f16x4 z4 = {(f16)0.f, (f16)0.f, (f16)0.f, (f16)0.f};
#define SCAN_LOAD(chunk) do { const int S_ = (chunk) * TC + tt; const int t_ = dir ? T - 1 - S_ : S_; const GAS f16* pr_ = PROJ + (size_t)(row0 + t_) * DIN + ch0; \
        sr.r[1] = *(const GAS f16x4*)(pr_ + PC_R); sr.k[1] = *(const GAS f16x4*)(pr_ + PC_K); sr.v[1] = *(const GAS f16x4*)(pr_ + PC_V); \
        if (t_ > 0) { sr.r[0] = *(const GAS f16x4*)(pr_ - DIN + PC_R); sr.k[0] = *(const GAS f16x4*)(pr_ - DIN + PC_K); sr.v[0] = *(const GAS f16x4*)(pr_ - DIN + PC_V); } else { sr.r[0] = z4; sr.k[0] = z4; sr.v[0] = z4; } \
        if (t_ < T - 1) { sr.r[2] = *(const GAS f16x4*)(pr_ + DIN + PC_R); sr.k[2] = *(const GAS f16x4*)(pr_ + DIN + PC_K); sr.v[2] = *(const GAS f16x4*)(pr_ + DIN + PC_V); } else { sr.r[2] = z4; sr.k[2] = z4; sr.v[2] = z4; } \
        const GAS f16* wa_ = WA + (size_t)(row0 + t_) * 2048 + dir * 512 + ch0; sr.w = *(const GAS f16x4*)wa_; sr.a = *(const GAS f16x4*)(wa_ + 1024); } while (0)
#define SCAN_STAGE(chunk) do { const int S_ = (chunk) * TC + tt; const int t_ = dir ? T - 1 - S_ : S_; \
        f32x4 r_, k_, v_, kk_, w_, a_, kh_, kt_, b_; float ss_ = 0.f, rk_ = 0.f; \
        _Pragma("unroll") for (int e = 0; e < 4; ++e) { const float rc = (float)sr.r[1][e], kc = (float)sr.k[1][e], vc = (float)sr.v[1][e]; \
            r_[e] = rc + mu_r[e] * (0.5f * ((float)sr.r[0][e] + (float)sr.r[2][e]) - rc); k_[e] = kc + mu_k[e] * (0.5f * ((float)sr.k[0][e] + (float)sr.k[2][e]) - kc); \
            v_[e] = vc + mu_v[e] * (0.5f * ((float)sr.v[0][e] + (float)sr.v[2][e]) - vc); kk_[e] = k_[e] * k_k[e]; ss_ += kk_[e] * kk_[e]; w_[e] = (float)sr.w[e]; a_[e] = (float)sr.a[e]; } \
        ss_ = dpp_sum16(ss_); const float ri_ = rsqrtf(ss_ + 1e-12f); \
        _Pragma("unroll") for (int e = 0; e < 4; ++e) { kh_[e] = kk_[e] * ri_; kt_[e] = k_[e] * (1.0f + (a_[e] - 1.0f) * k_a[e]); b_[e] = a_[e] * kh_[e]; rk_ += r_[e] * kt_[e] * r_k[e]; } \
        rk_ = dpp_sum16(rk_); if (cq == 0) RK[((size_t)dir * M + row0 + t_) * 8 + h] = rk_; \
        LAS float* sb_ = st + ((chunk) & 1) * ST_BUF + tt * ST_STEP + cq * 4; \
        *(LAS f32x4*)(sb_) = kh_; *(LAS f32x4*)(sb_ + 64) = w_; *(LAS f32x4*)(sb_ + 128) = b_; *(LAS f32x4*)(sb_ + 192) = kt_; *(LAS f32x4*)(sb_ + 256) = r_; *(LAS f32x4*)(sb_ + 320) = v_; } while (0)
    SCAN_LOAD(0);
    SCAN_STAGE(0);
    __syncthreads();
    for (int chunk = 0; chunk < nch; ++chunk) {
        if (chunk + 1 < nch) SCAN_LOAD(chunk + 1);
        const LAS float* sb = st + (chunk & 1) * ST_BUF + ks * 8;
        const LAS float* vb = st + (chunk & 1) * ST_BUF + 320 + srow;
#pragma unroll 2
        for (int s = 0; s < TC; ++s) {
            const LAS float* q = sb + s * ST_STEP;
            const f32x4 kh0 = *(const LAS f32x4*)(q), kh1 = *(const LAS f32x4*)(q + 4);
            const f32x4 w0 = *(const LAS f32x4*)(q + 64), w1 = *(const LAS f32x4*)(q + 68);
            const f32x4 b0 = *(const LAS f32x4*)(q + 128), b1 = *(const LAS f32x4*)(q + 132);
            const f32x4 t0 = *(const LAS f32x4*)(q + 192), t1 = *(const LAS f32x4*)(q + 196);
            const f32x4 r0 = *(const LAS f32x4*)(q + 256), r1 = *(const LAS f32x4*)(q + 260);
            const float v = vb[s * ST_STEP];
            float sk = (S[0] * kh0[0] + S[1] * kh0[1]) + (S[2] * kh0[2] + S[3] * kh0[3]) + ((S[4] * kh1[0] + S[5] * kh1[1]) + (S[6] * kh1[2] + S[7] * kh1[3]));
            sk = dpp_sum8(sk);
#pragma unroll
            for (int e = 0; e < 4; ++e) { S[e] = S[e] * w0[e] + (v * t0[e] - sk * b0[e]); S[4 + e] = S[4 + e] * w1[e] + (v * t1[e] - sk * b1[e]); }
            float y = (S[0] * r0[0] + S[1] * r0[1]) + (S[2] * r0[2] + S[3] * r0[3]) + ((S[4] * r1[0] + S[5] * r1[1]) + (S[6] * r1[2] + S[7] * r1[3]));
            y = dpp_sum8(y);
            const int Sg = chunk * TC + s; const int t = dir ? T - 1 - Sg : Sg;
            if (ks == 0) Y[((size_t)dir * M + row0 + t) * CW + h * HD + srow] = (f16)y;
        }
        if (chunk + 1 < nch) SCAN_STAGE(chunk + 1);
        __syncthreads();
    }
#undef SCAN_LOAD
#undef SCAN_STAGE
    if (!smp) { GAS float* so = p.out + O_ST + (((((size_t)sq * NL + l) * 2 + dir) * NH + h) * HD + srow) * HD + ks * 8;
        *(GAS f32x4*)so = (f32x4){S[0], S[1], S[2], S[3]}; *(GAS f32x4*)(so + 4) = (f32x4){S[4], S[5], S[6], S[7]}; }
}
__device__ __forceinline__ void fast_scan(const Params& p0, const Ctx& c0, int l) {
    const Ctx c = fresh(c0); FRESH_P(p0);
    const int b = c.bid;
    if (b < 64) scan_task(p, c, l, b);
    else for (int task = b; task < 576; task += 192) scan_task(p, c, l, task);
}


namespace ms {
constexpr int O_AM = 0, O_BM = 4608, O_AT = 9216, O_VP = 14336, O_GT = 19456, O_NF = 22016, O_WM = 23040, O_WE = 23296, BUF = 23552;
constexpr int RS = 144, RT = 80;
}
__device__ __forceinline__ void mscan_task(const DParams& p, const Ctx& c, int l, int task) {
    using namespace ms;
    const GAS f16* PROJ = (const GAS f16*)(p.ws + WS_R1); const GAS f16* WA = (const GAS f16*)(p.ws + WS_R2);
    GAS f16* Y = (GAS f16*)(p.ws + WS_R3); GAS float* RK = (GAS float*)(p.ws + WS_RK);
    int sq, dir, h;
    if (task < 64) { h = task & 7; dir = (task >> 3) & 1; sq = B_CTX + (task >> 4); } else { const int id = task - 64; h = id & 7; dir = (id >> 3) & 1; sq = id >> 4; }
    const bool smp = sq >= B_CTX; const int T = smp ? T_SMP : T_CTX; const int row0 = smp ? M_CTX + (sq - B_CTX) * T_SMP : sq * T_CTX;
    const int nch = T / 16;
    const int vl = c.lane & 31, hh = c.lane >> 5;
    const int tq = c.tid - 128, ss = (tq >> 4) & 15, cq = tq & 15, k0 = cq * 4, ch0 = h * HD + k0;
    LAS float* cst = (LAS float*)(c.lds + 3 * BUF);
    if (c.wave == 7) { const int chn_ = h * HD + c.lane;
        cst[c.lane] = IN(15)[(l * 3 + 0) * CW + chn_]; cst[64 + c.lane] = IN(15)[(l * 3 + 1) * CW + chn_]; cst[128 + c.lane] = IN(15)[(l * 3 + 2) * CW + chn_];
        cst[192 + c.lane] = IN(16)[l * CW + chn_]; cst[256 + c.lane] = IN(17)[l * CW + chn_]; cst[320 + c.lane] = IN(18)[l * CW + chn_]; }

#define MS_BARRIER() do { asm volatile("s_waitcnt lgkmcnt(0)" ::: "memory"); __builtin_amdgcn_s_barrier(); asm volatile("" ::: "memory"); } while (0)
    if (c.wave >= 2 && c.wave < 6) {
    f16x4 G_rc, G_kc, G_vc, G_rp, G_kp, G_vp, G_rn, G_kn, G_vn, G_av, G_wo, G_wp, G_w7;
    { const f16x4 z4 = {(f16)0.f, (f16)0.f, (f16)0.f, (f16)0.f}; G_rc = G_kc = G_vc = G_rp = G_kp = G_vp = G_rn = G_kn = G_vn = G_av = G_wo = G_wp = G_w7 = z4; }
        for (int it = -3; it < nch; ++it) {
            const int ch = it + 2;
            if (ch >= 0 && ch < nch) {
                LAS unsigned char* buf = c.lds + (ch % 3) * BUF;
                const int Sg = ch * 16 + ss; const int t = dir ? T - 1 - Sg : Sg; const size_t row = (size_t)row0 + t;
                const f32x4 mu_r = *(const LAS f32x4*)(cst + k0), mu_k = *(const LAS f32x4*)(cst + 64 + k0), mu_v = *(const LAS f32x4*)(cst + 128 + k0), k_k = *(const LAS f32x4*)(cst + 192 + k0), k_a = *(const LAS f32x4*)(cst + 256 + k0), r_k = *(const LAS f32x4*)(cst + 320 + k0);
                f32x4 r_, k_, v_, kk_, kh_, kt_, b_; float sq_ = 0.f, rk_ = 0.f;
                const float mp_ = t > 0 ? 0.5f : 0.f, mn_ = t < T - 1 ? 0.5f : 0.f;
#pragma unroll
                for (int e = 0; e < 4; ++e) { const float rcf = (float)G_rc[e], kcf = (float)G_kc[e], vcf = (float)G_vc[e];
                    r_[e] = rcf + mu_r[e] * ((mp_ * (float)G_rp[e] + mn_ * (float)G_rn[e]) - rcf); k_[e] = kcf + mu_k[e] * ((mp_ * (float)G_kp[e] + mn_ * (float)G_kn[e]) - kcf);
                    v_[e] = vcf + mu_v[e] * ((mp_ * (float)G_vp[e] + mn_ * (float)G_vn[e]) - vcf); kk_[e] = k_[e] * k_k[e]; sq_ += kk_[e] * kk_[e]; }
                sq_ = dpp_sum16(sq_); const float ri_ = rsqrtf(sq_ + 1e-12f);
#pragma unroll
                for (int e = 0; e < 4; ++e) { const float a_ = (float)G_av[e]; kh_[e] = kk_[e] * ri_; kt_[e] = k_[e] * (1.0f + (a_ - 1.0f) * k_a[e]); b_[e] = a_ * kh_[e]; rk_ += r_[e] * kt_[e] * r_k[e]; }
                rk_ = dpp_sum16(rk_); if (cq == 0) RK[((size_t)dir * M + row) * 8 + h] = rk_;
                float al[4], be[4], ka[4], rho[4];
#pragma unroll
                for (int e = 0; e < 4; ++e) { const float wm7 = (float)G_w7[e]; const float om = ss == 7 ? 1.0f : (float)G_wo[e]; const float omp = ss == 0 ? __builtin_amdgcn_rcpf(wm7) : (ss == 8 ? 1.0f : (float)G_wp[e]);
                    const float iom = __builtin_amdgcn_rcpf(om); al[e] = omp * kh_[e]; be[e] = b_[e] * iom; ka[e] = kt_[e] * iom; rho[e] = om * r_[e]; }
                v2u w2;
                w2.x = pkh(al[0], al[1]); w2.y = pkh(al[2], al[3]); *(LAS v2u*)(buf + O_BM + ss * RS + k0 * 2) = w2;
                w2.x = pkh(rho[0], rho[1]); w2.y = pkh(rho[2], rho[3]); *(LAS v2u*)(buf + O_BM + (16 + ss) * RS + k0 * 2) = w2;
                w2.x = pkh(be[0], be[1]); w2.y = pkh(be[2], be[3]); *(LAS v2u*)(buf + O_AM + ss * RS + k0 * 2) = w2;
                w2.x = pkh(ka[0], ka[1]); w2.y = pkh(ka[2], ka[3]); *(LAS v2u*)(buf + O_AM + (16 + ss) * RS + k0 * 2) = w2;
#pragma unroll
                for (int e = 0; e < 4; ++e) { *(LAS f16*)(buf + O_AT + (k0 + e) * RT + ss * 2) = (f16)ka[e]; *(LAS f16*)(buf + O_AT + (k0 + e) * RT + (16 + ss) * 2) = (f16)be[e];
                    *(LAS f16*)(buf + O_VP + (k0 + e) * RT + ss * 2) = (f16)v_[e]; }
                if (ss == 15) { f32x4 wm_, we_;
#pragma unroll
                    for (int e = 0; e < 4; ++e) { wm_[e] = (float)G_w7[e]; we_[e] = (float)G_wo[e]; }
                    *(LAS f32x4*)(buf + O_WM + k0 * 4) = wm_; *(LAS f32x4*)(buf + O_WE + k0 * 4) = we_; }
            }
            const int chn = it + 3;
            if (chn < nch) {
                const int Sg = chn * 16 + ss; const int t = dir ? T - 1 - Sg : Sg; const size_t row = (size_t)row0 + t;
                const GAS f16* pr = PROJ + row * DIN + ch0;
                const f16x4 z4 = {(f16)0.f, (f16)0.f, (f16)0.f, (f16)0.f};
                G_rc = *(const GAS f16x4*)(pr + PC_R); G_kc = *(const GAS f16x4*)(pr + PC_K); G_vc = *(const GAS f16x4*)(pr + PC_V);
                { const GAS f16* prp = t > 0 ? pr - DIN : pr; const GAS f16* prn = t < T - 1 ? pr + DIN : pr;
                  G_rp = *(const GAS f16x4*)(prp + PC_R); G_kp = *(const GAS f16x4*)(prp + PC_K); G_vp = *(const GAS f16x4*)(prp + PC_V);
                  G_rn = *(const GAS f16x4*)(prn + PC_R); G_kn = *(const GAS f16x4*)(prn + PC_K); G_vn = *(const GAS f16x4*)(prn + PC_V); }
                G_av = *(const GAS f16x4*)(WA + row * 2048 + 1024 + dir * 512 + ch0);
                const GAS f16* wo = WA + row * 2048 + dir * 512 + ch0;
                G_wo = *(const GAS f16x4*)wo; G_wp = *(const GAS f16x4*)(wo + (ss > 0 ? (dir ? 2048 : -2048) : 0)); G_w7 = *(const GAS f16x4*)(wo + (long)(7 - ss) * (dir ? -2048 : 2048));
            }
            MS_BARRIER();
        }
    } else if (c.wave == 6) {
        for (int it = -3; it < nch; ++it) {
            const int ch = it + 1;
            if (ch >= 0 && ch < nch) {
                LAS unsigned char* buf = c.lds + (ch % 3) * BUF;
                f32x16 g;
#pragma unroll
                for (int i = 0; i < 16; ++i) g[i] = 0.f;
#pragma unroll
                for (int s = 0; s < 4; ++s) { const f16x8 a = *(const LAS f16x8*)(buf + O_AM + vl * RS + (16 * s + 8 * hh) * 2), b = *(const LAS f16x8*)(buf + O_BM + vl * RS + (16 * s + 8 * hh) * 2);
                    g = __builtin_amdgcn_mfma_f32_32x32x16_f16(a, b, g, 0, 0, 0); }
                const int tcol = vl & 15; const bool incl = vl >= 16;
#pragma unroll
                for (int gq = 0; gq < 4; ++gq) { float o[4];
#pragma unroll
                    for (int e = 0; e < 4; ++e) { const int ip = 8 * gq + 4 * hh + e, i = ip & 15; const bool ok = incl ? (i <= tcol) : (i < tcol); o[e] = ok ? g[4 * gq + e] : 0.f; }
                    v2u w2; w2.x = pkh(o[0], o[1]); w2.y = pkh(o[2], o[3]);
                    *(LAS v2u*)(buf + O_GT + vl * RT + (8 * gq + 4 * hh) * 2) = w2;
                    if (gq < 2 && vl < 16) *(LAS f32x4*)(buf + O_NF + vl * 64 + (8 * gq + 4 * hh) * 4) = (f32x4){o[0], o[1], o[2], o[3]}; }
            }
            MS_BARRIER();
        }
    } else if (c.wave == 7) {
        unsigned pa0 = 0u, pa1 = 0u, pb0 = 0u, pb1 = 0u, pc0 = 0u, pc1 = 0u;
#define MS_TOUCH(chp_, r0_, r1_) do { const int chp = (chp_); if (chp < nch) { \
            _Pragma("unroll") for (int q_ = 0; q_ < 2; ++q_) { const int i_ = c.lane + 64 * q_; if (i_ < 86) { const GAS unsigned* a_; \
                if (i_ < 54) { const int rr_ = i_ / 3, sg_ = i_ - 3 * rr_; int t_ = dir ? T - 17 - 16 * chp + rr_ : 16 * chp - 1 + rr_; t_ = t_ < 0 ? 0 : (t_ > T - 1 ? T - 1 : t_); \
                    a_ = (const GAS unsigned*)(PROJ + (size_t)(row0 + t_) * DIN + (sg_ == 0 ? PC_R : (sg_ == 1 ? PC_K : PC_V)) + h * HD); } \
                else { const int j_ = i_ - 54, rr_ = j_ >> 1; const int t_ = dir ? T - 16 - 16 * chp + rr_ : 16 * chp + rr_; \
                    a_ = (const GAS unsigned*)(WA + (size_t)(row0 + t_) * 2048 + (j_ & 1) * 1024 + dir * 512 + h * HD); } \
                if (q_ == 0) r0_ = *a_; else r1_ = *a_; } } } } while (0)
        unsigned px0 = 0u, px1 = 0u, px2 = 0u, px3 = 0u, px4 = 0u, px5 = 0u;
        MS_TOUCH(0, px0, px1); MS_TOUCH(1, px2, px3); MS_TOUCH(2, px4, px5);
        for (int it = -3; it < nch; it += 3) {
            asm volatile("" :: "v"(pa0), "v"(pa1)); MS_TOUCH(it + 6, pa0, pa1); MS_BARRIER();
            if (it + 1 < nch) { asm volatile("" :: "v"(pb0), "v"(pb1)); MS_TOUCH(it + 7, pb0, pb1); MS_BARRIER(); }
            if (it + 2 < nch) { asm volatile("" :: "v"(pc0), "v"(pc1)); MS_TOUCH(it + 8, pc0, pc1); MS_BARRIER(); }
        }
        asm volatile("" :: "v"(px0), "v"(px1), "v"(px2), "v"(px3), "v"(px4), "v"(px5), "v"(pa0), "v"(pa1), "v"(pb0), "v"(pb1), "v"(pc0), "v"(pc1));
#undef MS_TOUCH
    } else {
    f32x16 St0, St1;
#pragma unroll
    for (int i = 0; i < 16; ++i) { St0[i] = 0.f; St1[i] = 0.f; }
    if (smp) { float one_ = 1.0f; asm volatile("" : "+v"(one_));
        const GAS float* s0 = IN(4) + (((((size_t)(sq - B_CTX) * NL + l) * 2 + dir) * NH + h) * HD + 32 * c.wave + vl) * HD + 4 * hh;
#pragma unroll
        for (int g = 0; g < 4; ++g) { const f32x4 a = *(const GAS f32x4*)(s0 + 8 * g), b = *(const GAS f32x4*)(s0 + 32 + 8 * g);
#pragma unroll
            for (int e = 0; e < 4; ++e) { St0[4 * g + e] = a[e] * one_; St1[4 * g + e] = b[e] * one_; } }
    }
        for (int it = -3; it < nch; ++it) {
            const int ch = it;
            if (ch >= 0) {
                LAS unsigned char* buf = c.lds + (ch % 3) * BUF;
                const int v = 32 * c.wave + vl;
                if (ch == 0) {
#pragma unroll
                for (int gq = 0; gq < 4; ++gq) { const f32x4 m0 = *(const LAS f32x4*)(buf + O_WM + (8 * gq + 4 * hh) * 4), m1 = *(const LAS f32x4*)(buf + O_WM + (32 + 8 * gq + 4 * hh) * 4);
#pragma unroll
                    for (int e = 0; e < 4; ++e) { St0[4 * gq + e] *= m0[e]; St1[4 * gq + e] *= m1[e]; } }
                }
                f16x4 bmlo[4], bmhi[4];
#pragma unroll
                for (int s = 0; s < 4; ++s) { bmlo[s] = *(const LAS f16x4*)(buf + O_BM + vl * RS + (16 * s + 4 * hh) * 2); bmhi[s] = *(const LAS f16x4*)(buf + O_BM + vl * RS + (16 * s + 8 + 4 * hh) * 2); }
                const f16x8 gtk = *(const LAS f16x8*)(buf + O_GT + vl * RT + (16 + 8 * hh) * 2), vpv = *(const LAS f16x8*)(buf + O_VP + v * RT + (8 * hh) * 2);
                const f16x8 aN = *(const LAS f16x8*)(buf + O_GT + vl * RT + (8 * hh) * 2);
                f32x4 nf[4][3];
#pragma unroll
                for (int a = 0; a < 4; ++a)
#pragma unroll
                    for (int e = 0; e < 3; ++e) nf[a][e] = *(const LAS f32x4*)(buf + O_NF + (4 * a + 1 + e) * 64 + 16 * a);
                f16x8 at0[2], at1[2];
#pragma unroll
                for (int s2 = 0; s2 < 2; ++s2) { at0[s2] = *(const LAS f16x8*)(buf + O_AT + vl * RT + (16 * s2 + 8 * hh) * 2); at1[s2] = *(const LAS f16x8*)(buf + O_AT + (32 + vl) * RT + (16 * s2 + 8 * hh) * 2); }
                f32x4 sc0[4], sc1[4];
                { LAS unsigned char* nbuf = c.lds + ((ch + 1) % 3) * BUF; const bool more = ch + 1 < nch;
#pragma unroll
                  for (int gq = 0; gq < 4; ++gq) { sc0[gq] = *(const LAS f32x4*)(buf + O_WE + (8 * gq + 4 * hh) * 4); sc1[gq] = *(const LAS f32x4*)(buf + O_WE + (32 + 8 * gq + 4 * hh) * 4);
                    if (more) { sc0[gq] *= *(const LAS f32x4*)(nbuf + O_WM + (8 * gq + 4 * hh) * 4); sc1[gq] *= *(const LAS f32x4*)(nbuf + O_WM + (32 + 8 * gq + 4 * hh) * 4); } } }
                f32x16 X;
#pragma unroll
                for (int i = 0; i < 16; ++i) X[i] = 0.f;
#pragma unroll
                for (int s = 0; s < 4; ++s) {
                    f16x8 sb;
#pragma unroll
                    for (int j = 0; j < 8; ++j) sb[j] = (f16)((s < 2) ? St0[8 * (s & 1) + j] : St1[8 * (s & 1) + j]);
                    const f16x8 af = {bmlo[s][0], bmlo[s][1], bmlo[s][2], bmlo[s][3], bmhi[s][0], bmhi[s][1], bmhi[s][2], bmhi[s][3]};
                    X = __builtin_amdgcn_mfma_f32_32x32x16_f16(af, sb, X, 0, 0, 0);
                }
                X = __builtin_amdgcn_mfma_f32_32x32x16_f16(gtk, vpv, X, 0, 0, 0);
                f16x8 pball;
#pragma unroll
                for (int j = 0; j < 8; ++j) pball[j] = (f16)0.f;
#define MS_BLK(a) do { const int xo_ = 4 * ((a) >> 1); \
                    const f32x4 n1_ = nf[a][0], n2_ = nf[a][1], n3_ = nf[a][2]; \
                    float q0_ = X[xo_]; float q1_ = X[xo_ + 1] - q0_ * n1_[0]; float q2_ = X[xo_ + 2] - q0_ * n2_[0] - q1_ * n2_[1]; float q3_ = X[xo_ + 3] - q0_ * n3_[0] - q1_ * n3_[1] - q2_ * n3_[2]; \
                    if (((a) & 1) != ((a) >> 1)) { float a_, b_; \
                        a_ = q0_; b_ = q0_; swap32(a_, b_); q0_ = ((a) & 1) ? b_ : a_; a_ = q1_; b_ = q1_; swap32(a_, b_); q1_ = ((a) & 1) ? b_ : a_; \
                        a_ = q2_; b_ = q2_; swap32(a_, b_); q2_ = ((a) & 1) ? b_ : a_; a_ = q3_; b_ = q3_; swap32(a_, b_); q3_ = ((a) & 1) ? b_ : a_; } \
                    const bool hold_ = hh == ((a) >> 1); \
                    const f16 z_ = (f16)0.f; const f16 e0_ = hold_ ? (f16)(-q0_) : z_, e1_ = hold_ ? (f16)(-q1_) : z_, e2_ = hold_ ? (f16)(-q2_) : z_, e3_ = hold_ ? (f16)(-q3_) : z_; \
                    f16x8 pb_ = {z_, z_, z_, z_, z_, z_, z_, z_}; \
                    pb_[4 * ((a) & 1)] = e0_; pb_[4 * ((a) & 1) + 1] = e1_; pb_[4 * ((a) & 1) + 2] = e2_; pb_[4 * ((a) & 1) + 3] = e3_; \
                    if (hold_) { pball[4 * ((a) & 1)] = e0_; pball[4 * ((a) & 1) + 1] = e1_; pball[4 * ((a) & 1) + 2] = e2_; pball[4 * ((a) & 1) + 3] = e3_; } \
                    X = __builtin_amdgcn_mfma_f32_32x32x16_f16(aN, pb_, X, 0, 0, 0); } while (0)
                MS_BLK(0); MS_BLK(1); MS_BLK(2); MS_BLK(3);
#undef MS_BLK
                St0 = __builtin_amdgcn_mfma_f32_32x32x16_f16(at0[0], vpv, St0, 0, 0, 0); St1 = __builtin_amdgcn_mfma_f32_32x32x16_f16(at1[0], vpv, St1, 0, 0, 0);
                St0 = __builtin_amdgcn_mfma_f32_32x32x16_f16(at0[1], pball, St0, 0, 0, 0); St1 = __builtin_amdgcn_mfma_f32_32x32x16_f16(at1[1], pball, St1, 0, 0, 0);
#pragma unroll
                for (int r = 8; r < 16; ++r) { const int t = (r & 3) + 8 * ((r >> 2) - 2) + 4 * hh; const int Sg = ch * 16 + t; const int tok = dir ? T - 1 - Sg : Sg;
                    Y[((size_t)dir * M + row0 + tok) * CW + h * HD + v] = (f16)X[r]; }
#pragma unroll
                for (int gq = 0; gq < 4; ++gq)
#pragma unroll
                    for (int e = 0; e < 4; ++e) { St0[4 * gq + e] *= sc0[gq][e]; St1[4 * gq + e] *= sc1[gq][e]; }
            }
            MS_BARRIER();
        }
    if (!smp) {
        GAS float* so = p.out + O_ST + (((((size_t)sq * NL + l) * 2 + dir) * NH + h) * HD + 32 * c.wave + vl) * HD + 4 * hh;
#pragma unroll
        for (int g = 0; g < 4; ++g) { *(GAS f32x4*)(so + 8 * g) = (f32x4){St0[4 * g], St0[4 * g + 1], St0[4 * g + 2], St0[4 * g + 3]};
            *(GAS f32x4*)(so + 32 + 8 * g) = (f32x4){St1[4 * g], St1[4 * g + 1], St1[4 * g + 2], St1[4 * g + 3]}; }
    }
    }
#undef MS_BARRIER
}
__device__ __forceinline__ void mfma_scan(const Params& p0, const Ctx& c0, int l) {
    const Ctx c = fresh(c0); FRESH_P(p0);
    const int b = c.bid, G = (int)gridDim.x;
    const bool deal = G >= 128;
    const int first = b, step = deal ? (b < 64 ? 576 : G - 64) : G;
#pragma nounroll
    for (int task = first; task < 576; task += step) mscan_task(p, c, l, task);
}

__device__ __forceinline__ int swap23(int r) { return (r & ~12) | ((r & 4) << 1) | ((r & 8) >> 1); }
__device__ __forceinline__ void attn_wave_task(const DParams& p, const Ctx& c, int l, int task) {
    const GAS f16* PROJ = (const GAS f16*)(p.ws + WS_R1); const GAS f16* KN = (const GAS f16*)(p.ws + WS_KN); const GAS f16* VT = (const GAS f16*)(p.ws + WS_VT);
    GAS f16* OA = (GAS f16*)(p.ws + WS_R4);
    const int hq = task & 7, qb = task >> 3, kvh = hq >> 2;
    const int r32 = c.lane & 31, hh = c.lane >> 5;
    int rowq0, L; const GAS f16* Kb; const GAS f16* Vb; bool smp;
    if (qb < 128) { smp = true; rowq0 = M_CTX + qb * 32; const int b = qb >> 5; L = KV_SMP;
        Kb = KN + KN_SMP_OFF + ((size_t)b * 2 + kvh) * KV_SMP * HD; Vb = VT + KN_SMP_OFF + ((size_t)b * 2 + kvh) * HD * KV_SMP; }
    else { smp = false; rowq0 = (qb - 128) * 32; const int b = rowq0 >> 8; L = T_CTX;
        Kb = KN + ((size_t)b * 2 + kvh) * T_CTX * HD; Vb = VT + ((size_t)b * 2 + kvh) * HD * T_CTX; }
    const int row = rowq0 + r32;
    float x[4][8]; float ss = 0.f;
#pragma unroll
    for (int s = 0; s < 4; ++s) { const f16x8 q = *(const GAS f16x8*)(PROJ + (size_t)row * DIN + PC_Q + hq * HD + 16 * s + 8 * hh);
#pragma unroll
        for (int j = 0; j < 8; ++j) { x[s][j] = (float)q[j]; ss += x[s][j] * x[s][j]; } }
    ss = half_sum(ss);
    const float rstd = rsqrtf(ss * (1.0f / HD) + 1e-6f);
#pragma unroll
    for (int s = 0; s < 4; ++s)
#pragma unroll
        for (int j = 0; j < 8; ++j) x[s][j] *= rstd * IN(26)[l * HD + 16 * s + 8 * hh + j];
    if (smp) { const int t = (row - M_CTX) & (T_SMP - 1); const float posr = (float)(t >> 6), posc = (float)(t & 63);
#pragma unroll
        for (int j = 0; j < 8; ++j) { const float freq = exp2f(-(float)(8 * hh + j) * (13.287712379549449f / 16.0f));
            const float ar = posr * freq, ac = posc * freq; const float cr = __cosf(ar), sr = __sinf(ar), cc = __cosf(ac), sc = __sinf(ac);
            const float a0 = x[0][j], a1 = x[1][j], b0 = x[2][j], b1 = x[3][j];
            x[0][j] = a0 * cr - a1 * sr; x[1][j] = a1 * cr + a0 * sr; x[2][j] = b0 * cc - b1 * sc; x[3][j] = b1 * cc + b0 * sc; } }
    f16x8 qf[4];
#pragma unroll
    for (int s = 0; s < 4; ++s)
#pragma unroll
        for (int j = 0; j < 8; ++j) qf[s][j] = (f16)(x[s][j] * (0.125f * 1.4426950408889634f));
    f32x16 o0, o1;
#pragma unroll
    for (int i = 0; i < 16; ++i) { o0[i] = 0.f; o1[i] = 0.f; }
    float mrun = -1e30f, lsum = 0.f;
    const GAS f16* kp = Kb + (size_t)swap23(r32) * HD + 8 * hh;
    const GAS f16* vp = Vb + (size_t)r32 * L + 8 * hh;
    const int ntile = L >> 5;
    f16x8 kf[4], vf[4];
#pragma unroll
    for (int s = 0; s < 4; ++s) kf[s] = *(const GAS f16x8*)(kp + 16 * s);
    vf[0] = *(const GAS f16x8*)(vp); vf[1] = *(const GAS f16x8*)(vp + 16); vf[2] = *(const GAS f16x8*)(vp + (size_t)32 * L); vf[3] = *(const GAS f16x8*)(vp + (size_t)32 * L + 16);
    for (int kt = 0; kt < ntile; ++kt) {
        f16x8 kn[4], vn[4];
        const int ktn = kt + 1 < ntile ? kt + 1 : kt;
#pragma unroll
        for (int s = 0; s < 4; ++s) kn[s] = *(const GAS f16x8*)(kp + (size_t)ktn * 32 * HD + 16 * s);
        vn[0] = *(const GAS f16x8*)(vp + ktn * 32); vn[1] = *(const GAS f16x8*)(vp + ktn * 32 + 16); vn[2] = *(const GAS f16x8*)(vp + (size_t)32 * L + ktn * 32); vn[3] = *(const GAS f16x8*)(vp + (size_t)32 * L + ktn * 32 + 16);
        f32x16 sa;
#pragma unroll
        for (int i = 0; i < 16; ++i) sa[i] = 0.f;
#pragma unroll
        for (int s = 0; s < 4; ++s) sa = __builtin_amdgcn_mfma_f32_32x32x16_f16(kf[s], qf[s], sa, 0, 0, 0);
        float mt = sa[0];
#pragma unroll
        for (int i = 1; i < 16; ++i) mt = fmaxf(mt, sa[i]);
        mt = half_max(mt);
        const float mn = fmaxf(mrun, mt); const float alpha = exp2f(mrun - mn); mrun = mn;
        float ps = 0.f;
#pragma unroll
        for (int i = 0; i < 16; ++i) { sa[i] = exp2f(sa[i] - mn); ps += sa[i]; }
        lsum = lsum * alpha + ps;
#pragma unroll
        for (int i = 0; i < 16; ++i) { o0[i] *= alpha; o1[i] *= alpha; }
        f16x8 pb0, pb1;
#pragma unroll
        for (int j = 0; j < 8; ++j) { pb0[j] = (f16)sa[j]; pb1[j] = (f16)sa[8 + j]; }
        o0 = __builtin_amdgcn_mfma_f32_32x32x16_f16(vf[0], pb0, o0, 0, 0, 0);
        o0 = __builtin_amdgcn_mfma_f32_32x32x16_f16(vf[1], pb1, o0, 0, 0, 0);
        o1 = __builtin_amdgcn_mfma_f32_32x32x16_f16(vf[2], pb0, o1, 0, 0, 0);
        o1 = __builtin_amdgcn_mfma_f32_32x32x16_f16(vf[3], pb1, o1, 0, 0, 0);
#pragma unroll
        for (int s = 0; s < 4; ++s) { kf[s] = kn[s]; vf[s] = vn[s]; }
    }
    lsum = half_sum(lsum);
    const float inv = 1.0f / lsum;
    GAS f16* op = OA + (size_t)row * D + CW + hq * HD + 4 * hh;
#pragma unroll
    for (int g = 0; g < 4; ++g) {
        v2u w0; w0.x = pkh(o0[4 * g] * inv, o0[4 * g + 1] * inv); w0.y = pkh(o0[4 * g + 2] * inv, o0[4 * g + 3] * inv);
        v2u w1; w1.x = pkh(o1[4 * g] * inv, o1[4 * g + 1] * inv); w1.y = pkh(o1[4 * g + 2] * inv, o1[4 * g + 3] * inv);
        *(GAS v2u*)(op + 8 * g) = w0; *(GAS v2u*)(op + 32 + 8 * g) = w1; }
}
constexpr int AT_KS = 144, AT_BUF = 2 * 64 * AT_KS;
__device__ __forceinline__ void attn_block_task(const DParams& p, const Ctx& c, int l, int item) {
    const GAS f16* PROJ = (const GAS f16*)(p.ws + WS_R1); const GAS f16* KN = (const GAS f16*)(p.ws + WS_KN); const GAS f16* VT = (const GAS f16*)(p.ws + WS_VT);
    GAS f16* OA = (GAS f16*)(p.ws + WS_R4);
    int rowq0, L, kvh; const GAS f16* Kb; const GAS f16* Vb; bool smp;
    if (item < 128) { smp = true; const int b = item >> 5; kvh = (item >> 4) & 1; rowq0 = M_CTX + b * T_SMP + (item & 15) * 64; L = KV_SMP;
        Kb = KN + KN_SMP_OFF + ((size_t)b * 2 + kvh) * KV_SMP * HD; Vb = VT + KN_SMP_OFF + ((size_t)b * 2 + kvh) * HD * KV_SMP; }
    else { smp = false; const int id = item - 128; const int b = id >> 3; kvh = (id >> 2) & 1; rowq0 = b * T_CTX + (id & 3) * 64; L = T_CTX;
        Kb = KN + ((size_t)b * 2 + kvh) * T_CTX * HD; Vb = VT + ((size_t)b * 2 + kvh) * HD * T_CTX; }
    const int hq = kvh * 4 + (c.wave & 3);
    const int r32 = c.lane & 31, hh = c.lane >> 5;
    const int row = rowq0 + 32 * (c.wave >> 2) + r32;
    const int kk = c.tid >> 3, chk = c.tid & 7;
    const GAS f16* ksrc = Kb + (size_t)kk * HD + chk * 8;
    const GAS f16* vsrc = Vb + (size_t)kk * L + chk * 8;
    const int sdst = kk * AT_KS + chk * 16;
    v4u kreg = *(const GAS v4u*)ksrc, vreg = *(const GAS v4u*)vsrc;
    float x[4][8]; float ss = 0.f;
#pragma unroll
    for (int s = 0; s < 4; ++s) { const f16x8 q = *(const GAS f16x8*)(PROJ + (size_t)row * DIN + PC_Q + hq * HD + 16 * s + 8 * hh);
#pragma unroll
        for (int j = 0; j < 8; ++j) { x[s][j] = (float)q[j]; ss += x[s][j] * x[s][j]; } }
    ss = half_sum(ss);
    const float rstd = rsqrtf(ss * (1.0f / HD) + 1e-6f);
#pragma unroll
    for (int s = 0; s < 4; ++s)
#pragma unroll
        for (int j = 0; j < 8; ++j) x[s][j] *= rstd * IN(26)[l * HD + 16 * s + 8 * hh + j];
    if (smp) { const int t = (row - M_CTX) & (T_SMP - 1); const float posr = (float)(t >> 6), posc = (float)(t & 63);
#pragma unroll
        for (int j = 0; j < 8; ++j) { const float freq = exp2f(-(float)(8 * hh + j) * (13.287712379549449f / 16.0f));
            const float ar = posr * freq, ac = posc * freq; const float cr = __cosf(ar), sr = __sinf(ar), cc = __cosf(ac), sc = __sinf(ac);
            const float a0 = x[0][j], a1 = x[1][j], b0 = x[2][j], b1 = x[3][j];
            x[0][j] = a0 * cr - a1 * sr; x[1][j] = a1 * cr + a0 * sr; x[2][j] = b0 * cc - b1 * sc; x[3][j] = b1 * cc + b0 * sc; } }
    f16x8 qf[4];
#pragma unroll
    for (int s = 0; s < 4; ++s)
#pragma unroll
        for (int j = 0; j < 8; ++j) qf[s][j] = (f16)(x[s][j] * (0.125f * 1.4426950408889634f));
    f32x16 o0, o1;
#pragma unroll
    for (int i = 0; i < 16; ++i) { o0[i] = 0.f; o1[i] = 0.f; }
    f32x16 negm;
#pragma unroll
    for (int i = 0; i < 16; ++i) negm[i] = 0.f;
    float lsum = 0.f;
    const int nstep = L >> 6;
    *(LAS v4u*)(c.lds + sdst) = kreg; *(LAS v4u*)(c.lds + 64 * AT_KS + sdst) = vreg;
    asm volatile("s_waitcnt lgkmcnt(0)" ::: "memory"); __builtin_amdgcn_s_barrier(); asm volatile("" ::: "memory");
    const int koff = swap23(r32) * AT_KS + 16 * hh, voff = 64 * AT_KS + r32 * AT_KS + 16 * hh;
    for (int st = 0; st < nstep; ++st) {
        if (st + 1 < nstep) { kreg = *(const GAS v4u*)(ksrc + (size_t)(st + 1) * 64 * HD); vreg = *(const GAS v4u*)(vsrc + (st + 1) * 64); }
        LAS unsigned char* sb = c.lds + (st & 1) * AT_BUF;
        f32x16 sa0 = negm, sa1 = negm;
#pragma unroll
        for (int s = 0; s < 4; ++s) { const f16x8 k0 = *(const LAS f16x8*)(sb + koff + 32 * s), k1 = *(const LAS f16x8*)(sb + koff + 32 * AT_KS + 32 * s);
            sa0 = __builtin_amdgcn_mfma_f32_32x32x16_f16(k0, qf[s], sa0, 0, 0, 0); sa1 = __builtin_amdgcn_mfma_f32_32x32x16_f16(k1, qf[s], sa1, 0, 0, 0); }
        if (st == 0) {
            float mt = fmaxf(sa0[0], sa1[0]);
#pragma unroll
            for (int i = 1; i < 16; ++i) mt = fmaxf(mt, fmaxf(sa0[i], sa1[i]));
            mt = half_max(mt);
#pragma unroll
            for (int i = 0; i < 16; ++i) { sa0[i] -= mt; sa1[i] -= mt; negm[i] = -mt; }
        }
        float ps = 0.f;
#pragma unroll
        for (int i = 0; i < 16; ++i) { sa0[i] = __builtin_amdgcn_exp2f(sa0[i]); sa1[i] = __builtin_amdgcn_exp2f(sa1[i]); ps += sa0[i] + sa1[i]; }
        if (__builtin_amdgcn_ballot_w64(ps > 32768.f) != 0ull) {
            const float pm = half_max(ps);
            const float dl = pm > 32768.f ? ceilf(__log2f(pm)) : 0.f; const float f = __builtin_amdgcn_exp2f(-dl);
#pragma unroll
            for (int i = 0; i < 16; ++i) { sa0[i] *= f; sa1[i] *= f; o0[i] *= f; o1[i] *= f; negm[i] -= dl; }
            ps *= f; lsum *= f;
        }
        lsum += ps;
        f16x8 pb[4];
#pragma unroll
        for (int j = 0; j < 8; ++j) { pb[0][j] = (f16)sa0[j]; pb[1][j] = (f16)sa0[8 + j]; pb[2][j] = (f16)sa1[j]; pb[3][j] = (f16)sa1[8 + j]; }
#pragma unroll
        for (int q4 = 0; q4 < 4; ++q4) {
            const f16x8 v0 = *(const LAS f16x8*)(sb + voff + 32 * q4), v1 = *(const LAS f16x8*)(sb + voff + 32 * AT_KS + 32 * q4);
            o0 = __builtin_amdgcn_mfma_f32_32x32x16_f16(v0, pb[q4], o0, 0, 0, 0); o1 = __builtin_amdgcn_mfma_f32_32x32x16_f16(v1, pb[q4], o1, 0, 0, 0); }
        if (st + 1 < nstep) { LAS unsigned char* nb = c.lds + ((st + 1) & 1) * AT_BUF; *(LAS v4u*)(nb + sdst) = kreg; *(LAS v4u*)(nb + 64 * AT_KS + sdst) = vreg; }
        asm volatile("s_waitcnt lgkmcnt(0)" ::: "memory"); __builtin_amdgcn_s_barrier(); asm volatile("" ::: "memory");
    }
    lsum = half_sum(lsum);
    const float inv = 1.0f / lsum;
    GAS f16* op = OA + (size_t)row * D + CW + hq * HD + 4 * hh;
#pragma unroll
    for (int g = 0; g < 4; ++g) {
        v2u w0; w0.x = pkh(o0[4 * g] * inv, o0[4 * g + 1] * inv); w0.y = pkh(o0[4 * g + 2] * inv, o0[4 * g + 3] * inv);
        v2u w1; w1.x = pkh(o1[4 * g] * inv, o1[4 * g + 1] * inv); w1.y = pkh(o1[4 * g + 2] * inv, o1[4 * g + 3] * inv);
        *(GAS v2u*)(op + 8 * g) = w0; *(GAS v2u*)(op + 32 + 8 * g) = w1; }
}
__device__ __forceinline__ void fast_attn(const Params& p0, const Ctx& c0, int l) {
    const Ctx c = fresh(c0); FRESH_P(p0);
    unsigned* ctr = (unsigned*)(p0.ws + WS_CTL) + 8192 + 64 * l;
    volatile LAS unsigned* slot = (volatile LAS unsigned*)(c.lds + MISC_OFF) + 16;
    for (;;) {
        if (c.tid == 0) slot[0] = __hip_atomic_fetch_add(ctr, 1u, __ATOMIC_RELAXED, __HIP_MEMORY_SCOPE_AGENT);
        __syncthreads();
        const int item = (int)slot[0];
        __syncthreads();
        if (item >= 384) break;
        attn_block_task(p, c, l, item);
    }
}

__device__ __forceinline__ void post_phase(const Params& p0, const Ctx& c0, int l) {
    const Ctx c = fresh(c0); FRESH_P(p0);
    const GAS f16* PROJ = (const GAS f16*)(p.ws + WS_R1); const GAS f16* Y = (const GAS f16*)(p.ws + WS_R3); const GAS float* RK = (const GAS float*)(p.ws + WS_RK);
    GAS f16* OA = (GAS f16*)(p.ws + WS_R4);
    const int ch0 = c.lane * 8, h = c.lane >> 3;
    float gnw[8], gnb[8], muv[8];
    { const f32x4 a0 = *(const GAS f32x4*)(IN(24) + l * CW + ch0), a1 = *(const GAS f32x4*)(IN(24) + l * CW + ch0 + 4), b0 = *(const GAS f32x4*)(IN(25) + l * CW + ch0), b1 = *(const GAS f32x4*)(IN(25) + l * CW + ch0 + 4);
      const f32x4 m0 = *(const GAS f32x4*)(IN(15) + (l * 3 + 2) * CW + ch0), m1 = *(const GAS f32x4*)(IN(15) + (l * 3 + 2) * CW + ch0 + 4);
#pragma unroll
      for (int e = 0; e < 4; ++e) { gnw[e] = a0[e]; gnw[4 + e] = a1[e]; gnb[e] = b0[e]; gnb[4 + e] = b1[e]; muv[e] = m0[e]; muv[4 + e] = m1[e]; } }
    for (int row = c.gw; row < M; row += c.ngw) {
        int g, t, T; row_info(row, g, t, T);
        const GAS f16* pr = PROJ + (size_t)row * DIN + PC_V + ch0;
        const f16x8 y0 = *(const GAS f16x8*)(Y + (size_t)row * CW + ch0), y1 = *(const GAS f16x8*)(Y + ((size_t)M + row) * CW + ch0);
        const f16x8 vc = *(const GAS f16x8*)pr; const f16x8 gv = *(const GAS f16x8*)(OA + (size_t)row * D + ch0);
        f16x8 vp, vn;
#pragma unroll
        for (int e = 0; e < 8; ++e) { vp[e] = (f16)0.f; vn[e] = (f16)0.f; }
        if (t > 0) vp = *(const GAS f16x8*)(pr - DIN);
        if (t < T - 1) vn = *(const GAS f16x8*)(pr + DIN);
        const float rk = RK[(size_t)row * 8 + h] + RK[((size_t)M + row) * 8 + h];
        float y[8]; float s = 0.f;
#pragma unroll
        for (int e = 0; e < 8; ++e) { y[e] = (float)y0[e] + (float)y1[e]; s += y[e]; }
        const float mean = dpp_sum8(s) * (1.0f / HD); float q = 0.f;
#pragma unroll
        for (int e = 0; e < 8; ++e) { y[e] -= mean; q += y[e] * y[e]; }
        const float rstd = rsqrtf(dpp_sum8(q) * (1.0f / HD) + 64e-5f);
        float o[8];
#pragma unroll
        for (int e = 0; e < 8; ++e) { const float vcf = (float)vc[e]; const float v = vcf + muv[e] * (0.5f * ((float)vp[e] + (float)vn[e]) - vcf);
            o[e] = (y[e] * rstd * gnw[e] + gnb[e] + rk * v) * (float)gv[e]; }
        v4u w; w.x = pkh(o[0], o[1]); w.y = pkh(o[2], o[3]); w.z = pkh(o[4], o[5]); w.w = pkh(o[6], o[7]);
        *(GAS v4u*)(OA + (size_t)row * D + ch0) = w;
    }
}

__device__ __forceinline__ void gemm_proj(const Params& p0, const Ctx& c0) { const Ctx c = fresh(c0); FRESH_P(p0);
    pg8::Gemm g{(const GAS f16*)(p.ws + WS_R4), (const GAS f16*)(p.ws + WS_W + WO_IN), D, D, D}; pg8::StaticOrder S; S.init(M, DIN, (int)gridDim.x, c.bid);
    pg8::gemm_phase(c.lds, g, S, pg8::EpiProjF{(GAS f16*)(p.ws + WS_R1)}, c.wave); }
__device__ __forceinline__ void gemm_wa(const Params& p0, const Ctx& c0, int l) { const Ctx c = fresh(c0); FRESH_P(p0);
    pg8::Gemm g{(const GAS f16*)(p.ws + WS_R1) + PC_LW, (const GAS f16*)(p.ws + WS_W + WO_SM), DIN, 128, 128}; pg8::StaticOrder S; S.init(M, 2048, (int)gridDim.x, c.bid);
    pg8::gemm_phase(c.lds, g, S, pg8::EpiWAF{(GAS f16*)(p.ws + WS_R2), IN(19) + (size_t)l * 2 * CW, IN(21) + (size_t)l * 2 * CW}, c.wave); }
__device__ __forceinline__ void gemm_gate(const Params& p0, const Ctx& c0) { const Ctx c = fresh(c0); FRESH_P(p0);
    pg8::Gemm g{(const GAS f16*)(p.ws + WS_R1) + PC_LG, (const GAS f16*)(p.ws + WS_W + WO_G), DIN, 128, 128}; pg8::StaticOrder S; if (gridDim.x >= 224) S.init(M, CW, (int)gridDim.x, c.bid - 128); else S.init(M, CW, (int)gridDim.x, c.bid);
    pg8::gemm_phase(c.lds, g, S, pg8::EpiF16F{(GAS f16*)(p.ws + WS_R4), D}, c.wave); }
__device__ __forceinline__ void gemm_merge(const Params& p0, const Ctx& c0) { const Ctx c = fresh(c0); FRESH_P(p0);
    const GAS f16* OA = (const GAS f16*)(p.ws + WS_R4); const GAS f16* WbrT = (const GAS f16*)(p.ws + WS_W + WO_BR); GAS f16* MG = (GAS f16*)(p.ws + WS_R3); const GAS f16* PROJ = (const GAS f16*)(p.ws + WS_R1);
    pg8::StaticOrder S; S.init(M, D, (int)gridDim.x, c.bid, 192);
    pg8::Gemm g{OA, WbrT, D, D, D}; pg8::gemm_phase<pg8::EpiMergeF, 96>(c.lds, g, S, pg8::EpiMergeF{MG, PROJ}, c.wave); }
__device__ __forceinline__ void gemm_out(const Params& p0, const Ctx& c0) { const Ctx c = fresh(c0); FRESH_P(p0);
    pg8::Gemm g{(const GAS f16*)(p.ws + WS_R3), (const GAS f16*)(p.ws + WS_W + WO_OUT), D, D, D}; pg8::StaticOrder S; S.init(M, D, (int)gridDim.x, c.bid, 192);
    pg8::gemm_phase<pg8::EpiF16F, 96>(c.lds, g, S, pg8::EpiF16F{(GAS f16*)(p.ws + WS_R2), D}, c.wave); }
__device__ __forceinline__ void gemm_up(const Params& p0, const Ctx& c0) { const Ctx c = fresh(c0); FRESH_P(p0);
    pg8::Gemm g{(const GAS f16*)(p.ws + WS_R4), (const GAS f16*)(p.ws + WS_W + WO_UP), D, D, D}; pg8::StaticOrder S; S.init(M, DFF, (int)gridDim.x, c.bid);
    pg8::gemm_phase(c.lds, g, S, pg8::EpiRelu2F{(GAS f16*)(p.ws + WS_R1), DFF}, c.wave); }
__device__ __forceinline__ void gemm_down(const Params& p0, const Ctx& c0) { const Ctx c = fresh(c0); FRESH_P(p0);
    pg8::Gemm g{(const GAS f16*)(p.ws + WS_R1), (const GAS f16*)(p.ws + WS_W + WO_DN), DFF, DFF, DFF}; pg8::StaticOrder S; S.init(M, D, (int)gridDim.x, c.bid, 192);
    pg8::gemm_phase<pg8::EpiF16F, 96>(c.lds, g, S, pg8::EpiF16F{(GAS f16*)(p.ws + WS_R2), D}, c.wave); }

__global__ void __launch_bounds__(NTHREADS, 2) fwd_kernel(Params p) {
    extern __shared__ __attribute__((aligned(16))) unsigned char lds_raw[];
    Ctx c;
    c.lds = (LAS unsigned char*)lds_raw;
    c.tid = threadIdx.x; c.lane = c.tid & 63; c.wave = __builtin_amdgcn_readfirstlane(c.tid >> 6);
    c.gw = blockIdx.x * NWAVES + c.wave; c.ngw = gridDim.x * NWAVES; c.gt = blockIdx.x * NTHREADS + c.tid; c.ngt = gridDim.x * NTHREADS;
    volatile LAS unsigned* MISC = (volatile LAS unsigned*)(c.lds + MISC_OFF);
    if (c.tid < 32) MISC[c.tid] = 0u;
    if (c.tid < 28) ((LAS unsigned long long*)(c.lds + PTAB_OFF))[c.tid] = (unsigned long long)p.in[c.tid];
    __syncthreads();
    unsigned* ctl = (unsigned*)(p.ws + WS_CTL);
    XcdBarrier bar = xcd_barrier_post(ctl + CW_BAR, MISC + 8);
#define GRID_BAR() xcd_barrier(bar)

    conv_weights<0>(p, c, 0, c.gw, c.ngw);
    __syncthreads();
    mod_phase(p, c);
    GRID_BAR();
    norm_phase<0>(p, c, 0);
    GRID_BAR();
#pragma nounroll
    for (int l = 0; l < NL; ++l) {
        gemm_proj(p, c);
        {
            const int first = (M / 256) * (DIN / 256) % (int)gridDim.x;
            __syncthreads();
            if ((int)blockIdx.x >= first) conv_weights<1>(p, c, l, ((int)blockIdx.x - first) * NWAVES + c.wave, ((int)gridDim.x - first) * NWAVES);
        }
        GRID_BAR();
        gemm_wa(p, c, l);
        gemm_gate(p, c);
        kv_prep(p, c, l);
        GRID_BAR();
        mfma_scan(p, c, l);
        __syncthreads();
        fast_attn(p, c, l);
        GRID_BAR();
        post_phase(p, c, l);
        GRID_BAR();
        gemm_merge(p, c);
        GRID_BAR();
        gemm_out(p, c);
        GRID_BAR();
        norm_phase<1>(p, c, l);
        GRID_BAR();
        gemm_up(p, c);
        GRID_BAR();
        gemm_down(p, c);
        GRID_BAR();
        norm_phase<2>(p, c, l);
        if (l + 1 < NL) { __syncthreads(); conv_weights<0>(p, c, l + 1, c.gw, c.ngw); }
        GRID_BAR();
    }
}

extern "C" void kernel_launch(void* const* d_in, const int* in_sizes, int n_in, void* d_out, int out_size, void* d_ws, size_t ws_size, hipStream_t stream) {
    static int grid = 0;
    if (grid == 0) {
        if (n_in != 28 || (size_t)out_size != O_TOTAL || ws_size < WS_END) { fprintf(stderr, "kernel_launch: unexpected shapes n_in %d out %d ws %zu\n", n_in, out_size, ws_size); grid = -1; return; }
        int dev = 0, cus = 0;
        if (hipGetDevice(&dev) != hipSuccess || hipDeviceGetAttribute(&cus, hipDeviceAttributeMultiprocessorCount, dev) != hipSuccess) { grid = -1; return; }
        if (hipFuncSetAttribute((const void*)fwd_kernel, hipFuncAttributeMaxDynamicSharedMemorySize, LDS_BYTES) != hipSuccess) { fprintf(stderr, "kernel_launch: hipFuncSetAttribute failed\n"); grid = -1; return; }
        grid = cus;
    }
    if (grid < 0) return;
    (void)hipMemsetAsync((char*)d_ws + WS_CTL, 0, CTL_BYTES + MiB, stream);
    Params p{};
    for (int i = 0; i < 28; ++i) p.in[i] = (const float*)d_in[i];
    p.out = (float*)d_out; p.ws = (unsigned char*)d_ws;
    hipLaunchKernelGGL(fwd_kernel, dim3(grid), dim3(NTHREADS), LDS_BYTES, stream, p);
}
```

```cpp
#include <hip/hip_runtime.h>
#include <cstdio>
#include <cstdint>

#define GAS __attribute__((address_space(1)))
#define LAS __attribute__((address_space(3)))
typedef _Float16 f16;
typedef _Float16 f16x8 __attribute__((ext_vector_type(8)));
typedef __fp16 h4v __attribute__((__vector_size__(4 * sizeof(__fp16))));
typedef _Float16 f16x4 __attribute__((ext_vector_type(4)));
typedef _Float16 f16x2 __attribute__((ext_vector_type(2)));
typedef float f32x4 __attribute__((ext_vector_type(4)));
typedef float f32x16 __attribute__((ext_vector_type(16)));
typedef unsigned v4u __attribute__((ext_vector_type(4)));
typedef unsigned v2u __attribute__((ext_vector_type(2)));

constexpr int D = 1024, DIN = 4608, DFF = 4096, CW = 512, NL = 2, NH = 8, HD = 64;
constexpr int B_CTX = 32, T_CTX = 256, B_SMP = 4, T_SMP = 1024, PAST = 256, KV_SMP = PAST + T_SMP;
constexpr int M_CTX = B_CTX * T_CTX, M_SMP = B_SMP * T_SMP, M = M_CTX + M_SMP;
constexpr int NMOD = 6 * D;
constexpr int PC_R = 0, PC_K = 512, PC_V = 1024, PC_LW = 1536, PC_LA = 1600, PC_LG = 1664, PC_Q = 1792, PC_KA = 2304, PC_VA = 2432, PC_GR = 2560, PC_GA = 3584;
constexpr size_t O_Y = 0, O_CK = (size_t)M * D, O_CV = O_CK + (size_t)B_CTX * NL * T_CTX * 128, O_ST = O_CV + (size_t)B_CTX * NL * T_CTX * 128;
constexpr size_t O_TOTAL = O_ST + (size_t)B_CTX * NL * 2 * NH * HD * HD;

constexpr size_t MiB = 1u << 20;
constexpr size_t WS_CTL = 0, CTL_BYTES = 1 * MiB;
constexpr size_t WS_MOD = 1 * MiB;
constexpr size_t WS_W = 2 * MiB;
constexpr size_t WO_IN = 0, WO_BR = 9 * MiB, WO_OUT = 11 * MiB, WO_UP = 13 * MiB, WO_DN = 21 * MiB, WO_SM = 29 * MiB, WO_G = 29 * MiB + 512 * 1024;
constexpr size_t WS_R1 = 32 * MiB;
constexpr size_t WS_R2 = 140 * MiB;
constexpr size_t WS_R3 = 188 * MiB;
constexpr size_t WS_RK = 212 * MiB;
constexpr size_t WS_R4 = 213 * MiB;
constexpr size_t WS_KN = 237 * MiB;
constexpr size_t WS_VT = 241 * MiB;
constexpr size_t WS_END = 245 * MiB;
constexpr size_t KN_SMP_OFF = (size_t)B_CTX * 2 * T_CTX * 64;

constexpr int NWAVES = 8, NTHREADS = 512;
constexpr int LDS_BYTES = 147456;
constexpr int MISC_OFF = 131072 + 320, PTAB_OFF = 131072 + 1024;

#define XB_TMO      128
#define XB_XCNT(j)  (256  + 64 * (j))
#define XB_XSUB(j)  (1280 + 64 * (j))
#define XB_XGEN(j)  (2304 + 64 * (j))
#define XB_TOP      3328
#define XB_TOPGEN   3392
#define XCD_BAR_WORDS 3456
#define XB_SPIN_CAP (1u << 24)
constexpr int CW_BAR = 4096;

__device__ __forceinline__ unsigned xb_ld(unsigned* p)              { return __hip_atomic_load(p, __ATOMIC_RELAXED, __HIP_MEMORY_SCOPE_AGENT); }
__device__ __forceinline__ unsigned xb_add(unsigned* p, unsigned v) { return __hip_atomic_fetch_add(p, v, __ATOMIC_RELAXED, __HIP_MEMORY_SCOPE_AGENT); }
__device__ __forceinline__ unsigned xb_xcc_id() { return (unsigned)__builtin_amdgcn_s_getreg((3 << 11) | 20) & 0xFu; }
#define XB_SPIN(cond, bar) do { unsigned _sp = 0; while (cond) { __builtin_amdgcn_s_sleep(1); \
    if ((++_sp & 255u) == 0u) { if (xb_ld(&(bar)[XB_TMO])) break; if (_sp > XB_SPIN_CAP) { atomicAdd(&(bar)[XB_TMO], 1u); break; } } } } while (0)

struct XcdBarrier { unsigned* bar; unsigned x; volatile LAS unsigned* st; };

__device__ __forceinline__ XcdBarrier xcd_barrier_post(unsigned* bar, volatile LAS unsigned* st) {
    XcdBarrier b; b.bar = bar; b.x = xb_xcc_id(); b.st = st;
    if (threadIdx.x == 0) (void)xb_add(&bar[XB_XCNT(b.x)], 1u);
    return b;
}
__device__ __forceinline__ void xcd_barrier_complete(unsigned* bar, unsigned x, unsigned& nloc, unsigned& nx) {
    const unsigned G = gridDim.x * gridDim.y * gridDim.z;
    unsigned sum, cnt, mine, sp = 0u;
    for (;;) {
        sum = 0u; cnt = 0u; mine = 0u;
#pragma unroll
        for (unsigned j = 0; j < 16; ++j) { const unsigned c = xb_ld(&bar[XB_XCNT(j)]); sum += c; cnt += (c > 0u) ? 1u : 0u; mine = (j == x) ? c : mine; }
        if (sum == G) break;
        __builtin_amdgcn_s_sleep(1);
        if ((++sp & 255u) == 0u) { if (xb_ld(&bar[XB_TMO])) break; if (sp > XB_SPIN_CAP) { atomicAdd(&bar[XB_TMO], 1u); break; } }
    }
    nloc = mine > 0u ? mine : 1u; nx = cnt > 0u ? cnt : 1u;
}
__device__ __forceinline__ void xcd_barrier(const XcdBarrier& b) {
    asm volatile("s_waitcnt vmcnt(0)" ::: "memory");
    __syncthreads();
    if (threadIdx.x == 0) {
        unsigned* bar = b.bar; unsigned bx = b.x;
        asm volatile("" : "+s"(bar), "+s"(bx));
        __builtin_amdgcn_s_waitcnt(0);
        unsigned nloc = b.st[0], nx = b.st[1];
        if (nloc == 0u) { xcd_barrier_complete(bar, bx, nloc, nx); b.st[0] = nloc; b.st[1] = nx; }
        const unsigned old = xb_add(&bar[XB_XSUB(bx)], 1u);
        const unsigned gen = old / nloc;
        if (old + 1u == (gen + 1u) * nloc) {
            __builtin_amdgcn_fence(__ATOMIC_RELEASE, "agent");
            asm volatile("s_waitcnt vmcnt(0)" ::: "memory");
            const unsigned og = xb_add(&bar[XB_TOP], 1u);
            const unsigned tg = og / nx;
            if (og + 1u == (tg + 1u) * nx) xb_add(&bar[XB_TOPGEN], 1u);
            else XB_SPIN(xb_ld(&bar[XB_TOPGEN]) == tg, bar);
            __builtin_amdgcn_fence(__ATOMIC_ACQUIRE, "agent");
            xb_add(&bar[XB_XGEN(bx)], 1u);
            asm volatile("s_waitcnt vmcnt(0)" ::: "memory");
        } else {
            XB_SPIN(xb_ld(&bar[XB_XGEN(bx)]) == gen, bar);
            __builtin_amdgcn_fence(__ATOMIC_ACQUIRE, "agent");
            asm volatile("s_waitcnt vmcnt(0)" ::: "memory");
        }
    }
    __syncthreads();
}

#define LDS_WAIT() asm volatile("s_waitcnt lgkmcnt(0)" ::: "memory")
#define DPPF(x, ctrl, rmask, oldv) __builtin_bit_cast(float, __builtin_amdgcn_update_dpp(__builtin_bit_cast(int, (float)(oldv)), __builtin_bit_cast(int, (float)(x)), (ctrl), (rmask), 0xF, false))
__device__ __forceinline__ float wave_sum(float v) {
    v += DPPF(v, 0xB1, 0xF, 0.f); v += DPPF(v, 0x4E, 0xF, 0.f); v += DPPF(v, 0x141, 0xF, 0.f); v += DPPF(v, 0x140, 0xF, 0.f);
    v += DPPF(v, 0x142, 0xA, 0.f); v += DPPF(v, 0x143, 0xC, 0.f);
    return __builtin_bit_cast(float, __builtin_amdgcn_readlane(__builtin_bit_cast(int, v), 63));
}
__device__ __forceinline__ float dpp_f(float x, const int ctrl) { return x; }
#define DPP_ADD(x, ctrl) (x) += __builtin_bit_cast(float, __builtin_amdgcn_update_dpp(0, __builtin_bit_cast(int, (x)), (ctrl), 0xF, 0xF, true))
__device__ __forceinline__ float dpp_sum8(float x) { DPP_ADD(x, 0xB1); DPP_ADD(x, 0x4E); DPP_ADD(x, 0x141); return x; }
__device__ __forceinline__ float dpp_sum16(float x) { DPP_ADD(x, 0xB1); DPP_ADD(x, 0x4E); DPP_ADD(x, 0x141); DPP_ADD(x, 0x140); return x; }
__device__ __forceinline__ void swap32(float& a, float& b) { asm volatile("v_nop\n\tv_nop\n\tv_permlane32_swap_b32 %0, %1" : "+v"(a), "+v"(b)); }
__device__ __forceinline__ void swap32u(unsigned& a, unsigned& b) { asm volatile("v_nop\n\tv_nop\n\tv_permlane32_swap_b32 %0, %1" : "+v"(a), "+v"(b)); }
__device__ __forceinline__ float half_sum(float v) { float a = v, b = v; swap32(a, b); return a + b; }
__device__ __forceinline__ float half_max(float v) { float a = v, b = v; swap32(a, b); return fmaxf(a, b); }
__device__ __forceinline__ float xor16(float v) { return __builtin_bit_cast(float, __builtin_amdgcn_ds_swizzle(__builtin_bit_cast(int, v), 0x401F)); }
__device__ __forceinline__ float sigmoidf_(float x) { return __builtin_amdgcn_rcpf(1.0f + __expf(-x)); }
__device__ __forceinline__ float tanhf_(float x) { return 1.0f - 2.0f * __builtin_amdgcn_rcpf(1.0f + __expf(2.0f * x)); }
__device__ __forceinline__ unsigned pkh(float lo, float hi) { f16x2 v = {(f16)lo, (f16)hi}; return __builtin_bit_cast(unsigned, v); }
__device__ __forceinline__ void row_info(int row, int& g, int& t, int& T) {
    if (row < M_CTX) { g = 0; t = row & (T_CTX - 1); T = T_CTX; }
    else { const int r = row - M_CTX; g = 1 + (r >> 10); t = r & (T_SMP - 1); T = T_SMP; }
}

struct Params {
    const float* in[28];
    float* out;
    unsigned char* ws;
};
struct DParams { GAS float* out; GAS unsigned char* ws; };
struct Ctx {
    LAS unsigned char* lds;
    int tid, lane, wave, gw, ngw, gt, ngt, bid;
};
__device__ __forceinline__ int lane_id() { int ln; asm volatile("v_mbcnt_lo_u32_b32 %0, -1, 0\n\tv_mbcnt_hi_u32_b32 %0, -1, %0" : "=v"(ln)); return ln; }
__device__ __forceinline__ const GAS float* inp(const Ctx& c, int i) {
    const unsigned long long v = ((const LAS unsigned long long*)(c.lds + PTAB_OFF))[i];
    const unsigned lo = __builtin_amdgcn_readfirstlane((unsigned)v), hi = __builtin_amdgcn_readfirstlane((unsigned)(v >> 32));
    return (const GAS float*)(((unsigned long long)hi << 32) | lo); }
#define IN(i) inp(c, (i))
#define FRESH_P(p0) DParams p; { float* o_ = (p0).out; unsigned char* w_ = (p0).ws; asm volatile("" : "+s"(o_), "+s"(w_)); p.out = (GAS float*)o_; p.ws = (GAS unsigned char*)w_; }
__device__ __forceinline__ Ctx fresh(const Ctx& c0) {
    Ctx c = c0; int w = c0.wave; asm volatile("" : "+s"(w)); int ln = lane_id(); asm volatile("" : "+v"(ln));
    int b = blockIdx.x; asm volatile("" : "+s"(b));
    c.wave = w; c.lane = ln; c.tid = w * 64 + ln; c.bid = b;
    c.gw = b * 8 + w; c.gt = b * 512 + c.tid; return c; }

__device__ __forceinline__ void conv_item(const GAS float* W, int N, GAS f16* WT, int ldt, int koff, LAS float* scr, int kb, int nb, int lane) {
    const int k0 = 64 * kb, n0 = 32 * nb;
    float v[32];
#pragma unroll
    for (int i = 0; i < 32; ++i) { const int kk = 2 * i + (lane >> 5); v[i] = __builtin_nontemporal_load(W + (size_t)(k0 + kk) * N + n0 + (lane & 31)); }
#pragma unroll
    for (int i = 0; i < 32; ++i) { const int kk = 2 * i + (lane >> 5); scr[kk * 33 + (lane & 31)] = v[i]; }
    LDS_WAIT();
    const int c = lane & 7;
#pragma unroll
    for (int j = 0; j < 4; ++j) { const int n = (lane >> 3) + 8 * j; const LAS float* s = scr + (8 * c) * 33 + n;
        v4u o; o.x = pkh(s[0 * 33], s[1 * 33]); o.y = pkh(s[2 * 33], s[3 * 33]); o.z = pkh(s[4 * 33], s[5 * 33]); o.w = pkh(s[6 * 33], s[7 * 33]);
        *(GAS v4u*)(WT + (size_t)(n0 + n) * ldt + koff + k0 + 8 * c) = o; }
    LDS_WAIT();
}
template <int PART>
__device__ __forceinline__ void conv_weights(const Params& p0, const Ctx& c0, int l, int gw, int ngw) {
    const Ctx c = fresh(c0); FRESH_P(p0);
    asm volatile("" : "+s"(gw), "+s"(ngw));
    LAS float* scr = (LAS float*)(c.lds + c.wave * 16384);
    GAS unsigned char* wb = p.ws + WS_W;
    if (PART == 0) {
        GAS f16* WinT = (GAS f16*)(wb + WO_IN); GAS f16* WsmT = (GAS f16*)(wb + WO_SM); GAS f16* WgT = (GAS f16*)(wb + WO_G);
        const GAS float* w_in = IN(7) + (size_t)l * D * DIN;
        const GAS float* dec_up = IN(20) + (size_t)l * 2 * 64 * CW; const GAS float* icl_up = IN(22) + (size_t)l * 2 * 64 * CW; const GAS float* gate_up = IN(23) + (size_t)l * 128 * CW;
        constexpr int I0 = 16 * 144, I6 = 16, I7 = 16, I8 = 16, I9 = 16, I10 = 2 * 16;
        constexpr int NIT = I0 + I6 + I7 + I8 + I9 + I10;
        for (int it = gw; it < NIT; it += ngw) {
            int r = it;
            if (r < I0) { conv_item(w_in, DIN, WinT, D, 0, scr, r / 144, r % 144, c.lane); continue; } r -= I0;
            if (r < I6) { conv_item(dec_up, CW, WsmT, 128, 0, scr, 0, r, c.lane); continue; } r -= I6;
            if (r < I7) { conv_item(dec_up + 64 * CW, CW, WsmT + (size_t)512 * 128, 128, 0, scr, 0, r, c.lane); continue; } r -= I7;
            if (r < I8) { conv_item(icl_up, CW, WsmT + (size_t)1024 * 128, 128, 64, scr, 0, r, c.lane); continue; } r -= I8;
            if (r < I9) { conv_item(icl_up + 64 * CW, CW, WsmT + (size_t)1536 * 128, 128, 64, scr, 0, r, c.lane); continue; } r -= I9;
            conv_item(gate_up, CW, WgT, 128, 0, scr, r / 16, r % 16, c.lane);
        }
        unsigned zz_ = 0u; asm volatile("" : "+v"(zz_));
        for (int i = gw * 64 + c.lane; i < 2048 * 8; i += ngw * 64) { const int row = i >> 3, ch = i & 7; const int col = (row < 1024 ? 64 : 0) + ch * 8;
            *(GAS v4u*)(WsmT + (size_t)row * 128 + col) = (v4u){zz_, zz_, zz_, zz_}; }
    } else {
        GAS f16* WbrT = (GAS f16*)(wb + WO_BR); GAS f16* WoutT = (GAS f16*)(wb + WO_OUT); GAS f16* WupT = (GAS f16*)(wb + WO_UP); GAS f16* WdnT = (GAS f16*)(wb + WO_DN);
        const GAS float* w_br = IN(8) + (size_t)l * 2 * CW * D; const GAS float* w_out = IN(9) + (size_t)l * D * D;
        const GAS float* w_up = IN(13) + (size_t)l * D * DFF; const GAS float* w_dn = IN(14) + (size_t)l * DFF * D;
        constexpr int I1 = 8 * 32, I2 = 8 * 32, I3 = 16 * 32, I4 = 16 * 128, I5 = 64 * 32;
        constexpr int NIT = I1 + I2 + I3 + I4 + I5;
        for (int it = gw; it < NIT; it += ngw) {
            int r = it;
            if (r < I1) { conv_item(w_br, D, WbrT, D, 0, scr, r / 32, r % 32, c.lane); continue; } r -= I1;
            if (r < I2) { conv_item(w_br + (size_t)CW * D, D, WbrT, D, CW, scr, r / 32, r % 32, c.lane); continue; } r -= I2;
            if (r < I3) { conv_item(w_out, D, WoutT, D, 0, scr, r / 32, r % 32, c.lane); continue; } r -= I3;
            if (r < I4) { conv_item(w_up, DFF, WupT, D, 0, scr, r / 128, r % 128, c.lane); continue; } r -= I4;
            conv_item(w_dn, D, WdnT, DFF, 0, scr, r / 32, r % 32, c.lane);
        }
    }
}

__device__ __forceinline__ void mod_phase(const Params& p0, const Ctx& c0) {
    const Ctx c = fresh(c0); FRESH_P(p0);
    LAS float* sl = (LAS float*)(c.lds);
    LAS float* part = (LAS float*)(c.lds + 32768);
    GAS float* mod = (GAS float*)(p.ws + WS_MOD);
    for (int i = c.tid; i < 5 * D; i += NTHREADS) { const int g = i >> 10, k = i & 1023; const float v = g == 0 ? IN(6)[k] : IN(5)[(g - 1) * D + k]; sl[i] = v / (1.0f + __expf(-v)); }
    __syncthreads();
    for (int it = c.bid; it < NL * (NMOD / 64) * 4; it += gridDim.x) {
        const int kq = it & 3, lc = it >> 2, l = lc / (NMOD / 64), cc = lc % (NMOD / 64);
        const int kb = kq * 256 + c.wave * 32;
        const GAS float* w = IN(10) + (size_t)l * D * NMOD + (size_t)kb * NMOD + cc * 64 + c.lane;
        float a0 = 0.f, a1 = 0.f, a2 = 0.f, a3 = 0.f, a4 = 0.f;
        float wv[32];
#pragma unroll
        for (int k = 0; k < 32; ++k) wv[k] = w[(size_t)k * NMOD];
#pragma unroll
        for (int k = 0; k < 32; ++k) { a0 += sl[kb + k] * wv[k]; a1 += sl[D + kb + k] * wv[k]; a2 += sl[2 * D + kb + k] * wv[k]; a3 += sl[3 * D + kb + k] * wv[k]; a4 += sl[4 * D + kb + k] * wv[k]; }
        LAS float* pw = part + c.wave * 320 + c.lane;
        pw[0] = a0; pw[64] = a1; pw[128] = a2; pw[192] = a3; pw[256] = a4;
        __syncthreads();
        if (c.tid < 320) { float s = 0.f;
#pragma unroll
            for (int w8 = 0; w8 < 8; ++w8) s += part[w8 * 320 + c.tid];
            const int g = c.tid >> 6, col = cc * 64 + (c.tid & 63);
            if (kq == 0) s += IN(11)[(size_t)l * NMOD + col];
            atomicAdd((float*)(mod + ((size_t)l * 5 + g) * NMOD + col), s); }
        __syncthreads();
    }
}

template <int MODE, int NB>
__device__ __forceinline__ void norm_rows(const DParams& p, const Ctx& c, int l, int row_first, int row_end, int row_step) {
    GAS float* YO = p.out; GAS f16* XA = (GAS f16*)p.out;
    GAS f16* XB = (GAS f16*)(p.ws + WS_R3);
    const GAS f16* MO = (const GAS f16*)(p.ws + WS_R2); GAS f16* H = (GAS f16*)(p.ws + WS_R4);
    const GAS float* modb = (const GAS float*)(p.ws + WS_MOD);
    const GAS float* in0 = IN(0); const GAS float* in1 = IN(1); const GAS float* ngb = IN(12);
    for (int rowb = row_first; rowb < row_end; rowb += NB * row_step) {
        f32x4 x0[MODE == 0 ? NB : 1][4]; f16x4 xh[MODE == 0 ? 1 : NB][4]; f16x4 mh[MODE == 0 ? 1 : NB][4];
#pragma unroll
        for (int b = 0; b < NB; ++b) { const int row = rowb + b * row_step;
            if (row < row_end) {
                if (MODE == 0) { const GAS float* src = row < M_CTX ? in0 + (size_t)row * D : in1 + (size_t)(row - M_CTX) * D;
#pragma unroll
                    for (int j = 0; j < 4; ++j) x0[MODE == 0 ? b : 0][j] = __builtin_nontemporal_load((const GAS f32x4*)(src + 256 * j + 4 * c.lane)); }
                else { const GAS f16* xs = (MODE == 1 ? XA : XB) + (size_t)row * D;
#pragma unroll
                    for (int j = 0; j < 4; ++j) { xh[MODE == 0 ? 0 : b][j] = __builtin_nontemporal_load((const GAS f16x4*)(xs + 256 * j + 4 * c.lane));
                        mh[MODE == 0 ? 0 : b][j] = __builtin_nontemporal_load((const GAS f16x4*)(MO + (size_t)row * D + 256 * j + 4 * c.lane)); } } } }
#pragma unroll
        for (int b = 0; b < NB; ++b) { const int row = rowb + b * row_step;
            if (row < row_end) {
                int g, t, T; row_info(row, g, t, T);
                f32x4 x[4];
#pragma unroll
                for (int j = 0; j < 4; ++j) {
                    if (MODE == 0) x[j] = x0[MODE == 0 ? b : 0][j];
                    else {
#pragma unroll
                        for (int e = 0; e < 4; ++e) x[j][e] = (float)xh[MODE == 0 ? 0 : b][j][e]; } }
                if (MODE != 0) {
                    const GAS float* mo_mod = modb + ((size_t)l * 5 + g) * NMOD + (MODE == 1 ? 2 * D : 5 * D);
                    const GAS float* ngp = ngb + ((size_t)l * 4 + (MODE == 1 ? 1 : 3)) * D;
                    float mv[4][4]; float ss = 0.f;
#pragma unroll
                    for (int j = 0; j < 4; ++j)
#pragma unroll
                        for (int e = 0; e < 4; ++e) { mv[j][e] = (float)mh[MODE == 0 ? 0 : b][j][e]; ss += mv[j][e] * mv[j][e]; }
                    const float rstd = rsqrtf(wave_sum(ss) * (1.0f / D) + 1e-6f);
#pragma unroll
                    for (int j = 0; j < 4; ++j) { const f32x4 gg = *(const GAS f32x4*)(mo_mod + 256 * j + 4 * c.lane); const f32x4 nn = *(const GAS f32x4*)(ngp + 256 * j + 4 * c.lane);
#pragma unroll
                        for (int e = 0; e < 4; ++e) x[j][e] += gg[e] * (mv[j][e] * rstd * nn[e]); }
                }
                const int ln = MODE == 2 ? l + 1 : l;
                if (ln < NL) {
                    const GAS float* mb = modb + ((size_t)ln * 5 + g) * NMOD + (MODE == 1 ? 3 * D : 0);
                    const GAS float* ngp = ngb + ((size_t)ln * 4 + (MODE == 1 ? 2 : 0)) * D;
                    float ss = 0.f;
#pragma unroll
                    for (int j = 0; j < 4; ++j) ss += (x[j][0] * x[j][0] + x[j][1] * x[j][1]) + (x[j][2] * x[j][2] + x[j][3] * x[j][3]);
                    const float rstd = rsqrtf(wave_sum(ss) * (1.0f / D) + 1e-6f);
                    GAS f16* XW = (MODE == 1 ? XB : XA) + (size_t)row * D;
#pragma unroll
                    for (int j = 0; j < 4; ++j) { const f32x4 sh = *(const GAS f32x4*)(mb + 256 * j + 4 * c.lane); const f32x4 sc = *(const GAS f32x4*)(mb + D + 256 * j + 4 * c.lane);
                        const f32x4 nn = *(const GAS f32x4*)(ngp + 256 * j + 4 * c.lane);
                        float o[4];
#pragma unroll
                        for (int e = 0; e < 4; ++e) o[e] = x[j][e] * rstd * nn[e] * (1.0f + sc[e]) + sh[e];
                        v2u w; w.x = pkh(o[0], o[1]); w.y = pkh(o[2], o[3]);
                        *(GAS v2u*)(H + (size_t)row * D + 256 * j + 4 * c.lane) = w;
                        v2u xw; xw.x = pkh(x[j][0], x[j][1]); xw.y = pkh(x[j][2], x[j][3]);
                        __builtin_nontemporal_store(xw, (GAS v2u*)(XW + 256 * j + 4 * c.lane)); }
                } else {
#pragma unroll
                    for (int j = 0; j < 4; ++j) __builtin_nontemporal_store(x[j], (GAS f32x4*)(YO + (size_t)row * D + 256 * j + 4 * c.lane)); }
            } }
    }
}
template <int MODE>
__device__ __forceinline__ void norm_phase(const Params& p0, const Ctx& c0, int l) {
    const Ctx c = fresh(c0); FRESH_P(p0);
    norm_rows<MODE, 6>(p, c, l, c.gw, M, c.ngw);
}

namespace pg8 {
constexpr int BM = 256, BK = 64, HALF = 128, HTB = HALF * BK * 2, STAGE_BYTES = 8 * HTB, NXCD = 8, WGM = 8;
__host__ __device__ __forceinline__ int lds_byte(int r, int c) { const int st = (r >> 4) * 2 + (c >> 5), rr = r & 15, cc = c & 31, ob = rr * 64 + cc * 2; return st * 1024 + (ob ^ (((ob >> 9) & 1) << 5)); }
__host__ __device__ __forceinline__ void stage_rc(int b, int& R, int& C) { const int st = b / 1024, sb = b % 1024, swz = sb ^ (((sb >> 9) & 1) << 5); R = (st >> 1) * 16 + swz / 64; C = (st & 1) * 32 + (swz % 64) / 2; }
__host__ __device__ __forceinline__ int perm32(int rho) { const int n = rho >> 4, i = rho & 15; return 8 * (i >> 2) + 4 * n + (i & 3); }
struct Unit { int pm, pn; };
struct Gemm { const GAS f16* A; const GAS f16* Bt; int lda, ldb, K; };
struct StaticOrder {
    int nM, nN, nwg, G, c, mode;
    __device__ void init(int Mr, int N, int G_, int c_, int bm = BM) { nM = Mr / bm; nN = N / BM; nwg = nM * nN; G = G_; c = c_; mode = 0; }
    __device__ bool next(int i, Unit& u) const {
        if (mode == 1) {
            if (c < 192) { if (i == 0) { u.pm = c % 48; u.pn = c / 48; return true; }
                           if (i == 1 && c < 64) { const int id = 128 + c; u.pm = id % 48; u.pn = 4 + id / 48; return true; } return false; }
            if (i < 2) { const int id = 2 * (c - 192) + i; u.pm = id % 48; u.pn = 4 + id / 48; return true; }
            return false; }
        const long L = (long)i * G + c; if (c < 0 || L >= nwg) return false;
        int wgid = (int)L; { const int q = nwg / NXCD, r = nwg % NXCD, xcd = wgid % NXCD, off = wgid / NXCD; wgid = (xcd < r ? xcd * (q + 1) : r * (q + 1) + (xcd - r) * q) + off; }
        const int nig = WGM * nN, gid = wgid / nig, fm = gid * WGM, gsz = (nM - fm) < WGM ? (nM - fm) : WGM;
        u.pm = fm + ((wgid % nig) % gsz); u.pn = (wgid % nig) / gsz; return true;
    }
};
template <class Epi, int HA = 128, bool ALIGN_EPI = true, bool SP2 = true>
__device__ __forceinline__ void gemm_phase(LAS unsigned char* lds, const Gemm g, const StaticOrder& S, const Epi& E, int wave_sgpr) {
    asm volatile("" : "+s"(wave_sgpr)); int tid = wave_sgpr * 64 + lane_id(); asm volatile("" : "+v"(tid));
    const int wid = __builtin_amdgcn_readfirstlane(tid >> 6), lane = tid & 63, wr = wid >> 2, wc = wid & 3, fr = lane & 15, fq = lane >> 4;
    const int K = g.K, nt = K / BK;
    unsigned voffA[2], voffB[2];
#pragma unroll
    for (int i = 0; i < 2; ++i) { int R, C; stage_rc(tid * 16 + i * 8192, R, C); const int Rb = (R & ~31) + perm32(R & 31);
        voffA[i] = (unsigned)(R * g.lda + C) * 2u; voffB[i] = (unsigned)(Rb * g.ldb + C) * 2u; }
    const unsigned kstep = (unsigned)(BK * 2);
    constexpr int MF = HA / 32;
    const unsigned hstepA = (unsigned)HA * g.lda * 2, hstepB = (unsigned)HALF * g.ldb * 2;
    const unsigned tstepA = 2 * hstepA, tstepB = 2 * hstepB;
    const unsigned ldsw = (unsigned)wid * 1024u;
    const int aoff = lds_byte(wr * (HA / 2) + fr, fq * 8), boff = lds_byte(wc * 32 + fr, fq * 8);
#define PG8_SA(b, h) (((b) * 2 + (h)) * HTB)
#define PG8_SB(b, h) ((4 + (b) * 2 + (h)) * HTB)
#define PG8_STAGE(bufoff, gbase, soff, voff) do { _Pragma("unroll") for (int _i = 0; _i < 2; ++_i) \
        __builtin_amdgcn_raw_ptr_buffer_load_lds(rs##gbase, (LAS unsigned*)(lds + (bufoff) + ldsw + _i * 8192), 16, (voff)[_i], (int)(soff), 0, 0); } while (0)
#define PG8_LDA(dst, b, h) do { _Pragma("unroll") for (int m = 0; m < MF; ++m) _Pragma("unroll") for (int k = 0; k < 2; ++k) dst[m][k] = *(const LAS f16x8*)(lds + PG8_SA(b, h) + aoff + m * 2048 + k * 1024); } while (0)
#define PG8_LDB(dst, b, h) do { _Pragma("unroll") for (int n = 0; n < 2; ++n) _Pragma("unroll") for (int k = 0; k < 2; ++k) dst[n][k] = *(const LAS f16x8*)(lds + PG8_SB(b, h) + boff + n * 2048 + k * 1024); } while (0)
#define PG8_MMA(ai, bj, At, Bt) do { __builtin_amdgcn_s_setprio(1); _Pragma("unroll") for (int m = 0; m < MF; ++m) _Pragma("unroll") for (int n = 0; n < 2; ++n) _Pragma("unroll") for (int k = 0; k < 2; ++k) \
        acc[ai][bj][m][n] = __builtin_amdgcn_mfma_f32_16x16x32_f16(Bt[n][k], At[m][k], acc[ai][bj][m][n], 0, 0, 0); __builtin_amdgcn_s_setprio(0); } while (0)
#define PG8_WAIT_V(n) asm volatile("s_waitcnt vmcnt(" #n ")" ::: "memory")
#define PG8_WAIT_L(n) asm volatile("s_waitcnt lgkmcnt(" #n ")" ::: "memory")
#define PG8_BAR __builtin_amdgcn_s_barrier()
#define PG8_SCHED __builtin_amdgcn_sched_barrier(0)
    Unit cur, nxt; int ui = 0;
    if (!S.next(0, cur)) return;
    f32x4 acc[2][2][4][2];
#pragma unroll
    for (int a = 0; a < 2; ++a)
#pragma unroll
        for (int b = 0; b < 2; ++b)
#pragma unroll
            for (int m = 0; m < 4; ++m)
#pragma unroll
                for (int n = 0; n < 2; ++n) acc[a][b][m][n] = (f32x4){0.f, 0.f, 0.f, 0.f};
    f16x8 At[4][2], B0[2][2], B1[2][2];
    const auto rsA = __builtin_amdgcn_make_buffer_rsrc((GAS void*)g.A, 0, 0x7fffffff, 0x00020000); const auto rsB = __builtin_amdgcn_make_buffer_rsrc((GAS void*)g.Bt, 0, 0x7fffffff, 0x00020000);
    unsigned cA = (unsigned)cur.pm * tstepA, cB = (unsigned)cur.pn * tstepB;
    if constexpr (SP2) {
        PG8_STAGE(PG8_SB(0, 0), B, cB, voffB); PG8_STAGE(PG8_SB(0, 1), B, cB + hstepB, voffB); PG8_STAGE(PG8_SA(0, 0), A, cA, voffA); PG8_STAGE(PG8_SA(0, 1), A, cA + hstepA, voffA);
        if (wr == 1) PG8_BAR;
        PG8_WAIT_V(2); PG8_BAR;
        PG8_STAGE(PG8_SB(1, 0), B, cB + kstep, voffB); PG8_STAGE(PG8_SA(1, 0), A, cA + kstep, voffA); PG8_STAGE(PG8_SB(1, 1), B, cB + hstepB + kstep, voffB);
        PG8_WAIT_V(6); PG8_BAR;
    } else {
        PG8_STAGE(PG8_SB(0, 0), B, cB, voffB); PG8_STAGE(PG8_SA(0, 0), A, cA, voffA); PG8_STAGE(PG8_SB(0, 1), B, cB + hstepB, voffB); PG8_STAGE(PG8_SA(0, 1), A, cA + hstepA, voffA);
        if (wr == 1) PG8_BAR;
        PG8_WAIT_V(4); PG8_BAR;
        PG8_STAGE(PG8_SB(1, 0), B, cB + kstep, voffB); PG8_STAGE(PG8_SA(1, 0), A, cA + kstep, voffA); PG8_STAGE(PG8_SB(1, 1), B, cB + hstepB + kstep, voffB);
        PG8_WAIT_V(6); PG8_BAR;
    }
    for (;;) {
        const bool has_next = S.next(ui + 1, nxt);
        const unsigned nA = has_next ? (unsigned)nxt.pm * tstepA : cA, nB = has_next ? (unsigned)nxt.pn * tstepB : cB;
        for (int t = 0; t < nt; t += 2) {
            if constexpr (Epi::MID_T >= 0) { if (t == Epi::MID_T) { const int ln3 = lane_id(); E.template mid<HA>(acc, cur, wr, wc, ln3 & 15, ln3 >> 4); } }
            const bool last = (t == nt - 2);
            const unsigned a1 = cA + (unsigned)(t + 1) * kstep;
            const unsigned a2 = last ? nA : cA + (unsigned)(t + 2) * kstep, b2 = last ? nB : cB + (unsigned)(t + 2) * kstep;
            const unsigned a3 = a2 + kstep, b3 = b2 + kstep;
            if constexpr (SP2) {
            PG8_LDB(B0, 0, 0); PG8_LDB(B1, 0, 1); PG8_SCHED; PG8_LDA(At, 0, 0); PG8_STAGE(PG8_SA(1, 1), A, a1 + hstepA, voffA);
            PG8_WAIT_V(8); PG8_WAIT_L(0); PG8_BAR; PG8_MMA(0, 0, At, B0); PG8_MMA(0, 1, At, B1); PG8_BAR; PG8_SCHED;
            PG8_LDA(At, 0, 1); PG8_STAGE(PG8_SB(0, 0), B, b2, voffB); PG8_STAGE(PG8_SB(0, 1), B, b2 + hstepB, voffB); PG8_STAGE(PG8_SA(0, 0), A, a2, voffA);
            PG8_WAIT_V(8); PG8_WAIT_L(0); PG8_BAR; PG8_MMA(1, 0, At, B0); PG8_MMA(1, 1, At, B1); PG8_BAR; PG8_SCHED;
            PG8_LDB(B0, 1, 0); PG8_LDB(B1, 1, 1); PG8_SCHED; PG8_LDA(At, 1, 0); PG8_STAGE(PG8_SA(0, 1), A, a2 + hstepA, voffA);
            PG8_WAIT_V(8); PG8_WAIT_L(0); PG8_BAR; PG8_MMA(0, 0, At, B0); PG8_MMA(0, 1, At, B1); PG8_BAR; PG8_SCHED;
            PG8_LDA(At, 1, 1); PG8_STAGE(PG8_SB(1, 0), B, b3, voffB); PG8_STAGE(PG8_SB(1, 1), B, b3 + hstepB, voffB); PG8_STAGE(PG8_SA(1, 0), A, a3, voffA);
            PG8_WAIT_V(8); PG8_WAIT_L(0); PG8_BAR; PG8_MMA(1, 0, At, B0); PG8_MMA(1, 1, At, B1); PG8_BAR; PG8_SCHED;
            } else {
            PG8_LDB(B0, 0, 0); PG8_SCHED; PG8_LDA(At, 0, 0); PG8_STAGE(PG8_SA(1, 1), A, a1 + hstepA, voffA);
            PG8_WAIT_L(8); PG8_BAR; PG8_WAIT_L(0); PG8_MMA(0, 0, At, B0); PG8_BAR; PG8_SCHED;
            PG8_LDB(B1, 0, 1); PG8_STAGE(PG8_SB(0, 0), B, b2, voffB);
            PG8_BAR; PG8_WAIT_L(0); PG8_MMA(0, 1, At, B1); PG8_BAR;
            PG8_LDA(At, 0, 1); PG8_STAGE(PG8_SA(0, 0), A, a2, voffA);
            PG8_BAR; PG8_WAIT_L(0); PG8_MMA(1, 0, At, B0); PG8_BAR; PG8_SCHED;
            PG8_STAGE(PG8_SB(0, 1), B, b2 + hstepB, voffB);
            PG8_WAIT_V(6); PG8_BAR; PG8_MMA(1, 1, At, B1); PG8_BAR;
            PG8_LDB(B0, 1, 0); PG8_SCHED; PG8_LDA(At, 1, 0); PG8_STAGE(PG8_SA(0, 1), A, a2 + hstepA, voffA);
            PG8_WAIT_L(8); PG8_BAR; PG8_WAIT_L(0); PG8_MMA(0, 0, At, B0); PG8_BAR; PG8_SCHED;
            PG8_LDB(B1, 1, 1); PG8_STAGE(PG8_SB(1, 0), B, b3, voffB);
            PG8_BAR; PG8_WAIT_L(0); PG8_MMA(0, 1, At, B1); PG8_BAR;
            PG8_LDA(At, 1, 1); PG8_STAGE(PG8_SA(1, 0), A, a3, voffA);
            PG8_BAR; PG8_WAIT_L(0); PG8_MMA(1, 0, At, B0); PG8_BAR; PG8_SCHED;
            PG8_STAGE(PG8_SB(1, 1), B, b3 + hstepB, voffB);
            PG8_WAIT_V(6); PG8_BAR; PG8_MMA(1, 1, At, B1); PG8_BAR;
            }
        }
        if constexpr (ALIGN_EPI) { if (wr == 0) PG8_BAR; }
        { const int ln2 = lane_id(); E.template run<HA>(acc, cur, wr, wc, ln2 & 15, ln2 >> 4); }
        if (!has_next) break;
#pragma unroll
        for (int a = 0; a < 2; ++a)
#pragma unroll
            for (int b = 0; b < 2; ++b)
#pragma unroll
                for (int m = 0; m < 4; ++m)
#pragma unroll
                    for (int n = 0; n < 2; ++n) acc[a][b][m][n] = (f32x4){0.f, 0.f, 0.f, 0.f};
        cur = nxt; cA = nA; cB = nB; ++ui;
        if constexpr (ALIGN_EPI) { if (wr == 1) PG8_BAR; }
    }
    PG8_WAIT_V(0);
    if constexpr (!ALIGN_EPI) { if (wr == 0) PG8_BAR; }
    PG8_BAR;
#undef PG8_SA
#undef PG8_SB
#undef PG8_STAGE
#undef PG8_LDA
#undef PG8_LDB
#undef PG8_MMA
#undef PG8_WAIT_V
#undef PG8_WAIT_L
#undef PG8_BAR
#undef PG8_SCHED
}
typedef f32x4 Acc[2][2][4][2];
#define PG8_EPI_LOOP(...) \
    const int row0 = u.pm * (2 * HA) + wr * (HA / 2) + fr, col0 = u.pn * BM + wc * 32 + 8 * fq; \
    _Pragma("unroll") for (int ai = 0; ai < 2; ++ai) _Pragma("unroll") for (int m = 0; m < HA / 32; ++m) { const int row = row0 + ai * HA + m * 16; \
        _Pragma("unroll") for (int bj = 0; bj < 2; ++bj) { const int col = col0 + bj * HALF; f32x4 v0 = acc[ai][bj][m][0], v1 = acc[ai][bj][m][1]; __VA_ARGS__ } asm volatile("" ::: "memory"); }
__device__ __forceinline__ void store8(GAS f16* p, f32x4 v0, f32x4 v1) { v4u w; w.x = pkh(v0[0], v0[1]); w.y = pkh(v0[2], v0[3]); w.z = pkh(v1[0], v1[1]); w.w = pkh(v1[2], v1[3]); *(GAS v4u*)p = w; }
struct EpiProjF { static constexpr int MID_T = -1; GAS f16* P;
    template <int HA> __device__ __forceinline__ void run(const Acc& acc, const Unit& u, int wr, int wc, int fr, int fq) const {
        PG8_EPI_LOOP(
            if (u.pn == 6) {
                if (col < PC_LA) { _Pragma("unroll") for (int e = 0; e < 4; ++e) { v0[e] = tanhf_(v0[e]); v1[e] = tanhf_(v1[e]); } }
                else if (col >= PC_LG) { _Pragma("unroll") for (int e = 0; e < 4; ++e) { v0[e] = sigmoidf_(v0[e]); v1[e] = sigmoidf_(v1[e]); } }
            } else if (u.pn >= 10) { _Pragma("unroll") for (int e = 0; e < 4; ++e) { v0[e] = sigmoidf_(v0[e]); v1[e] = sigmoidf_(v1[e]); } }
            store8(P + (size_t)row * DIN + col, v0, v1);
        )
    } };
#define DPPM(x, ctrl) (x) *= __builtin_bit_cast(float, __builtin_amdgcn_update_dpp(0x3f800000, __builtin_bit_cast(int, (x)), (ctrl), 0xF, 0xF, false))
struct EpiWAF { static constexpr int MID_T = -1; GAS f16* WA; const GAS float* w0; const GAS float* a0;
    template <int HA> __device__ __forceinline__ void run(const Acc& acc, const Unit& u, int wr, int wc, int fr, int fq) const {
        const int colb_ = u.pn * BM + wc * 32 + 8 * fq; const GAS float* bp_ = colb_ < 1024 ? w0 + colb_ : a0 + (colb_ - 1024);
        const f32x4 bq0_ = *(const GAS f32x4*)bp_, bq1_ = *(const GAS f32x4*)(bp_ + 4), bq2_ = *(const GAS f32x4*)(bp_ + HALF), bq3_ = *(const GAS f32x4*)(bp_ + HALF + 4);
        PG8_EPI_LOOP(
            if (col < 1024) { const f32x4 b0 = bj ? bq2_ : bq0_, b1 = bj ? bq3_ : bq1_;
                float x[8];
                _Pragma("unroll") for (int e = 0; e < 4; ++e) { x[e] = (-0.606531f * 1.44269504f) * sigmoidf_(v0[e] + b0[e]); x[4 + e] = (-0.606531f * 1.44269504f) * sigmoidf_(v1[e] + b1[e]); }
                float wm[8];
                if (col < 512) {
                    _Pragma("unroll") for (int e = 0; e < 8; ++e) { DPP_ADD(x[e], 0x111); DPP_ADD(x[e], 0x112); DPP_ADD(x[e], 0x114); DPP_ADD(x[e], 0x118); }
                    _Pragma("unroll") for (int e = 0; e < 8; ++e) wm[e] = __builtin_bit_cast(float, __builtin_amdgcn_ds_swizzle(__builtin_bit_cast(int, x[e]), 0x00F0));
                    _Pragma("unroll") for (int e = 0; e < 8; ++e) x[e] = __builtin_amdgcn_exp2f((fr == 7) ? wm[e] : x[e] - wm[e]);
                } else {
                    _Pragma("unroll") for (int e = 0; e < 8; ++e) { DPP_ADD(x[e], 0x101); DPP_ADD(x[e], 0x102); DPP_ADD(x[e], 0x104); DPP_ADD(x[e], 0x108); }
                    _Pragma("unroll") for (int e = 0; e < 8; ++e) wm[e] = __builtin_bit_cast(float, __builtin_amdgcn_ds_swizzle(__builtin_bit_cast(int, x[e]), 0x0110));
                    _Pragma("unroll") for (int e = 0; e < 8; ++e) x[e] = __builtin_amdgcn_exp2f((fr == 8) ? wm[e] : x[e] - wm[e]);
                }
                _Pragma("unroll") for (int e = 0; e < 4; ++e) { v0[e] = x[e]; v1[e] = x[4 + e]; } }
            else { const f32x4 b0 = bj ? bq2_ : bq0_, b1 = bj ? bq3_ : bq1_;
                _Pragma("unroll") for (int e = 0; e < 4; ++e) { v0[e] = sigmoidf_(v0[e] + b0[e]); v1[e] = sigmoidf_(v1[e] + b1[e]); } }
            store8(WA + (size_t)row * 2048 + col, v0, v1);
        )
    } };
struct EpiF16F { static constexpr int MID_T = -1; GAS f16* O; int ld;
    template <int HA> __device__ __forceinline__ void run(const Acc& acc, const Unit& u, int wr, int wc, int fr, int fq) const {
        PG8_EPI_LOOP( store8(O + (size_t)row * ld + col, v0, v1); )
    } };
struct EpiRelu2F { static constexpr int MID_T = -1; GAS f16* O; int ld;
    template <int HA> __device__ __forceinline__ void run(const Acc& acc, const Unit& u, int wr, int wc, int fr, int fq) const {
        PG8_EPI_LOOP(
            _Pragma("unroll") for (int e = 0; e < 4; ++e) { const float a = fmaxf(v0[e], 0.f), b = fmaxf(v1[e], 0.f); v0[e] = a * a; v1[e] = b * b; }
            store8(O + (size_t)row * ld + col, v0, v1);
        )
    } };
struct EpiMergeF { static constexpr int MID_T = 8; GAS f16* MG; const GAS f16* PROJ;
    template <int HA> __device__ __forceinline__ void mid(Acc& acc, const Unit& u, int wr, int wc, int fr, int fq) const {
        const int row0 = u.pm * (2 * HA) + wr * (HA / 2) + fr, col0 = u.pn * BM + wc * 32 + 8 * fq;
        constexpr int MF = HA / 32, NG = 2 * MF * 2;
        f16x8 gr[NG], ga[NG];
#define MG_LD(g_) do { constexpr int ai_ = (g_) / (2 * MF), m_ = ((g_) / 2) % MF, bj_ = (g_) & 1; const GAS f16* gp_ = PROJ + (size_t)(row0 + ai_ * HA + m_ * 16) * DIN + col0 + bj_ * HALF; \
            gr[g_] = *(const GAS f16x8*)(gp_ + PC_GR); ga[g_] = *(const GAS f16x8*)(gp_ + PC_GA); asm volatile("" ::: "memory"); } while (0)
#define MG_CP(g_) do { constexpr int ai_ = (g_) / (2 * MF), m_ = ((g_) / 2) % MF, bj_ = (g_) & 1; \
            _Pragma("unroll") for (int e = 0; e < 4; ++e) { acc[ai_][bj_][m_][0][e] *= (float)gr[g_][e] * __builtin_amdgcn_rcpf(fmaxf((float)ga[g_][e], 1e-4f)); \
                acc[ai_][bj_][m_][1][e] *= (float)gr[g_][4 + e] * __builtin_amdgcn_rcpf(fmaxf((float)ga[g_][4 + e], 1e-4f)); } asm volatile("" ::: "memory"); } while (0)
#define MG_STEP(g_) do { MG_CP(g_); if constexpr ((g_) + 3 < NG) MG_LD((g_) + 3); } while (0)
        MG_LD(0); MG_LD(1); MG_LD(2);
        MG_STEP(0); MG_STEP(1); MG_STEP(2); MG_STEP(3); MG_STEP(4); MG_STEP(5); MG_STEP(6); MG_STEP(7);
        if constexpr (NG > 8) { MG_STEP(8); MG_STEP(9); MG_STEP(10); MG_STEP(11); }
        if constexpr (NG > 12) { MG_STEP(12); MG_STEP(13); MG_STEP(14); MG_STEP(15); }
#undef MG_STEP
#undef MG_CP
#undef MG_LD
    }
    template <int HA> __device__ __forceinline__ void run(const Acc& acc, const Unit& u, int wr, int wc, int fr, int fq) const {
        PG8_EPI_LOOP(
            const f16x8 ga = *(const GAS f16x8*)(PROJ + (size_t)row * DIN + PC_GA + col);
            _Pragma("unroll") for (int e = 0; e < 4; ++e) { v0[e] *= fmaxf((float)ga[e], 1e-4f); v1[e] *= fmaxf((float)ga[4 + e], 1e-4f); }
            store8(MG + (size_t)row * D + col, v0, v1);
        )
    } };
}

__device__ __forceinline__ void kv_prep(const Params& p0, const Ctx& c0, int l) {
    const Ctx c = fresh(c0); FRESH_P(p0);
    const GAS f16* PROJ = (const GAS f16*)(p.ws + WS_R1); GAS f16* KN = (GAS f16*)(p.ws + WS_KN); GAS f16* VT = (GAS f16*)(p.ws + WS_VT);
    const int d = c.lane;
    const float kg = IN(27)[l * HD + d];
    const int axis = d >> 5, half = (d >> 4) & 1, f = d & 15;
    const float freq = exp2f(-(float)f * (13.287712379549449f / 16.0f));
    for (int it = c.ngw - 1 - c.gw; it < (M / 8) * 2; it += c.ngw) {
        const int kvh = it & 1, row0 = (it >> 1) * 8;
        float kx[8], vx[8];
#pragma unroll
        for (int r = 0; r < 8; ++r) { const GAS f16* pr = PROJ + (size_t)(row0 + r) * DIN + kvh * HD + d; kx[r] = (float)pr[PC_KA]; vx[r] = (float)pr[PC_VA]; }
#pragma unroll
        for (int r = 0; r < 8; ++r) kx[r] = kx[r] * rsqrtf(wave_sum(kx[r] * kx[r]) * (1.0f / HD) + 1e-6f) * kg;
        f16x8 vv;
#pragma unroll
        for (int r = 0; r < 8; ++r) vv[r] = (f16)vx[r];
        if (row0 < M_CTX) { const int b = row0 >> 8, t0 = row0 & 255;
#pragma unroll
            for (int r = 0; r < 8; ++r) { const size_t o = ((((size_t)b * NL + l) * T_CTX + t0 + r) * 2 + kvh) * HD + d;
                p.out[O_CK + o] = kx[r]; p.out[O_CV + o] = vx[r];
                KN[(((size_t)b * 2 + kvh) * T_CTX + t0 + r) * HD + d] = (f16)kx[r]; }
            *(GAS f16x8*)(VT + (((size_t)b * 2 + kvh) * HD + d) * T_CTX + t0) = vv;
        } else { const int rr = row0 - M_CTX, b = rr >> 10, t0 = rr & 1023;
#pragma unroll
            for (int r = 0; r < 8; ++r) { const int t = t0 + r; const float pos = (float)(axis == 0 ? (t >> 6) : (t & 63));
                const float ang = pos * freq; const float cs = __cosf(ang), sn = __sinf(ang);
                const float other = xor16(kx[r]);
                const float ko = half == 0 ? kx[r] * cs - other * sn : kx[r] * cs + other * sn;
                KN[KN_SMP_OFF + (((size_t)b * 2 + kvh) * KV_SMP + PAST + t) * HD + d] = (f16)ko; }
            *(GAS f16x8*)(VT + KN_SMP_OFF + (((size_t)b * 2 + kvh) * HD + d) * KV_SMP + PAST + t0) = vv;
        }
    }
    for (int it = (c.ngw >= 1536 ? c.gw - 1280 : c.gw); it < B_SMP * (PAST / 8) * 2; it += c.ngw) {
        if (it < 0) continue;
        const int kvh = it & 1, j0 = ((it >> 1) & 31) * 8, b = it >> 6;
        f16x8 vv;
#pragma unroll
        for (int r = 0; r < 8; ++r) { const size_t s = ((((size_t)b * NL + l) * PAST + j0 + r) * 2 + kvh) * HD + d;
            KN[KN_SMP_OFF + (((size_t)b * 2 + kvh) * KV_SMP + j0 + r) * HD + d] = (f16)IN(2)[s]; vv[r] = (f16)IN(3)[s]; }
        *(GAS f16x8*)(VT + KN_SMP_OFF + (((size_t)b * 2 + kvh) * HD + d) * KV_SMP + j0) = vv;
    }
}

constexpr int TC = 32, ST_STEP = 6 * 64, ST_BUF = TC * ST_STEP;
struct StageRegs { f16x4 r[3], k[3], v[3], w, a; };
__device__ __forceinline__ void scan_task(const DParams& p, const Ctx& c, int l, int task) {
    const GAS f16* PROJ = (const GAS f16*)(p.ws + WS_R1); const GAS f16* WA = (const GAS f16*)(p.ws + WS_R2);
    GAS f16* Y = (GAS f16*)(p.ws + WS_R3); GAS float* RK = (GAS float*)(p.ws + WS_RK);
    LAS float* st = (LAS float*)c.lds;
    int sq, dir, h;
    if (task < 64) { h = task & 7; dir = (task >> 3) & 1; sq = B_CTX + (task >> 4); } else { const int id = task - 64; h = id & 7; dir = (id >> 3) & 1; sq = id >> 4; }
    const bool smp = sq >= B_CTX; const int T = smp ? T_SMP : T_CTX; const int row0 = smp ? M_CTX + (sq - B_CTX) * T_SMP : sq * T_CTX;
    const int nch = T / TC;
    const int tt = c.tid >> 4, cq = c.tid & 15, ch0 = h * HD + cq * 4;
    const f32x4 mu_r = *(const GAS f32x4*)(IN(15) + (l * 3 + 0) * CW + ch0), mu_k = *(const GAS f32x4*)(IN(15) + (l * 3 + 1) * CW + ch0), mu_v = *(const GAS f32x4*)(IN(15) + (l * 3 + 2) * CW + ch0);
    const f32x4 k_k = *(const GAS f32x4*)(IN(16) + l * CW + ch0), k_a = *(const GAS f32x4*)(IN(17) + l * CW + ch0), r_k = *(const GAS f32x4*)(IN(18) + l * CW + ch0);
    const int ks = c.lane & 7, srow = c.wave * 8 + (c.lane >> 3);
    float S[8];
    if (smp) { const GAS float* s0 = IN(4) + (((((size_t)(sq - B_CTX) * NL + l) * 2 + dir) * NH + h) * HD + srow) * HD + ks * 8;
        const f32x4 a = *(const GAS f32x4*)s0, b = *(const GAS f32x4*)(s0 + 4);
        S[0] = a[0]; S[1] = a[1]; S[2] = a[2]; S[3] = a[3]; S[4] = b[0]; S[5] = b[1]; S[6] = b[2]; S[7] = b[3];
    } else {
#pragma unroll
        for (int j = 0; j < 8; ++j) S[j] = 0.f;
    }
    StageRegs sr;
    const f16x4 z4 = {(f16)0.f, (f16)0.f, (f16)0.f, (f16)0.f};
#define SCAN_LOAD(chunk) do { const int S_ = (chunk) * TC + tt; const int t_ = dir ? T - 1 - S_ : S_; const GAS f16* pr_ = PROJ + (size_t)(row0 + t_) * DIN + ch0; \
        sr.r[1] = *(const GAS f16x4*)(pr_ + PC_R); sr.k[1] = *(const GAS f16x4*)(pr_ + PC_K); sr.v[1] = *(const GAS f16x4*)(pr_ + PC_V); \
        if (t_ > 0) { sr.r[0] = *(const GAS f16x4*)(pr_ - DIN + PC_R); sr.k[0] = *(const GAS f16x4*)(pr_ - DIN + PC_K); sr.v[0] = *(const GAS f16x4*)(pr_ - DIN + PC_V); } else { sr.r[0] = z4; sr.k[0] = z4; sr.v[0] = z4; } \
        if (t_ < T - 1) { sr.r[2] = *(const GAS f16x4*)(pr_ + DIN + PC_R); sr.k[2] = *(const GAS f16x4*)(pr_ + DIN + PC_K); sr.v[2] = *(const GAS f16x4*)(pr_ + DIN + PC_V); } else { sr.r[2] = z4; sr.k[2] = z4; sr.v[2] = z4; } \
        const GAS f16* wa_ = WA + (size_t)(row0 + t_) * 2048 + dir * 512 + ch0; sr.w = *(const GAS f16x4*)wa_; sr.a = *(const GAS f16x4*)(wa_ + 1024); } while (0)
#define SCAN_STAGE(chunk) do { const int S_ = (chunk) * TC + tt; const int t_ = dir ? T - 1 - S_ : S_; \
        f32x4 r_, k_, v_, kk_, w_, a_, kh_, kt_, b_; float ss_ = 0.f, rk_ = 0.f; \
        _Pragma("unroll") for (int e = 0; e < 4; ++e) { const float rc = (float)sr.r[1][e], kc = (float)sr.k[1][e], vc = (float)sr.v[1][e]; \
            r_[e] = rc + mu_r[e] * (0.5f * ((float)sr.r[0][e] + (float)sr.r[2][e]) - rc); k_[e] = kc + mu_k[e] * (0.5f * ((float)sr.k[0][e] + (float)sr.k[2][e]) - kc); \
            v_[e] = vc + mu_v[e] * (0.5f * ((float)sr.v[0][e] + (float)sr.v[2][e]) - vc); kk_[e] = k_[e] * k_k[e]; ss_ += kk_[e] * kk_[e]; w_[e] = (float)sr.w[e]; a_[e] = (float)sr.a[e]; } \
        ss_ = dpp_sum16(ss_); const float ri_ = rsqrtf(ss_ + 1e-12f); \
        _Pragma("unroll") for (int e = 0; e < 4; ++e) { kh_[e] = kk_[e] * ri_; kt_[e] = k_[e] * (1.0f + (a_[e] - 1.0f) * k_a[e]); b_[e] = a_[e] * kh_[e]; rk_ += r_[e] * kt_[e] * r_k[e]; } \
        rk_ = dpp_sum16(rk_); if (cq == 0) RK[((size_t)dir * M + row0 + t_) * 8 + h] = rk_; \
        LAS float* sb_ = st + ((chunk) & 1) * ST_BUF + tt * ST_STEP + cq * 4; \
        *(LAS f32x4*)(sb_) = kh_; *(LAS f32x4*)(sb_ + 64) = w_; *(LAS f32x4*)(sb_ + 128) = b_; *(LAS f32x4*)(sb_ + 192) = kt_; *(LAS f32x4*)(sb_ + 256) = r_; *(LAS f32x4*)(sb_ + 320) = v_; } while (0)
    SCAN_LOAD(0);
    SCAN_STAGE(0);
    __syncthreads();
    for (int chunk = 0; chunk < nch; ++chunk) {
        if (chunk + 1 < nch) SCAN_LOAD(chunk + 1);
        const LAS float* sb = st + (chunk & 1) * ST_BUF + ks * 8;
        const LAS float* vb = st + (chunk & 1) * ST_BUF + 320 + srow;
#pragma unroll 2
        for (int s = 0; s < TC; ++s) {
            const LAS float* q = sb + s * ST_STEP;
            const f32x4 kh0 = *(const LAS f32x4*)(q), kh1 = *(const LAS f32x4*)(q + 4);
            const f32x4 w0 = *(const LAS f32x4*)(q + 64), w1 = *(const LAS f32x4*)(q + 68);
            const f32x4 b0 = *(const LAS f32x4*)(q + 128), b1 = *(const LAS f32x4*)(q + 132);
            const f32x4 t0 = *(const LAS f32x4*)(q + 192), t1 = *(const LAS f32x4*)(q + 196);
            const f32x4 r0 = *(const LAS f32x4*)(q + 256), r1 = *(const LAS f32x4*)(q + 260);
            const float v = vb[s * ST_STEP];
            float sk = (S[0] * kh0[0] + S[1] * kh0[1]) + (S[2] * kh0[2] + S[3] * kh0[3]) + ((S[4] * kh1[0] + S[5] * kh1[1]) + (S[6] * kh1[2] + S[7] * kh1[3]));
            sk = dpp_sum8(sk);
#pragma unroll
            for (int e = 0; e < 4; ++e) { S[e] = S[e] * w0[e] + (v * t0[e] - sk * b0[e]); S[4 + e] = S[4 + e] * w1[e] + (v * t1[e] - sk * b1[e]); }
            float y = (S[0] * r0[0] + S[1] * r0[1]) + (S[2] * r0[2] + S[3] * r0[3]) + ((S[4] * r1[0] + S[5] * r1[1]) + (S[6] * r1[2] + S[7] * r1[3]));
            y = dpp_sum8(y);
            const int Sg = chunk * TC + s; const int t = dir ? T - 1 - Sg : Sg;
            if (ks == 0) Y[((size_t)dir * M + row0 + t) * CW + h * HD + srow] = (f16)y;
        }
        if (chunk + 1 < nch) SCAN_STAGE(chunk + 1);
        __syncthreads();
    }
#undef SCAN_LOAD
#undef SCAN_STAGE
    if (!smp) { GAS float* so = p.out + O_ST + (((((size_t)sq * NL + l) * 2 + dir) * NH + h) * HD + srow) * HD + ks * 8;
        *(GAS f32x4*)so = (f32x4){S[0], S[1], S[2], S[3]}; *(GAS f32x4*)(so + 4) = (f32x4){S[4], S[5], S[6], S[7]}; }
}
__device__ __forceinline__ void fast_scan(const Params& p0, const Ctx& c0, int l) {
    const Ctx c = fresh(c0); FRESH_P(p0);
    const int b = c.bid;
    if (b < 64) scan_task(p, c, l, b);
    else for (int task = b; task < 576; task += 192) scan_task(p, c, l, task);
}


namespace ms {
constexpr int O_AM = 0, O_BM = 4608, O_AT = 9216, O_VP = 14336, O_GT = 19456, O_NF = 22016, O_WM = 23040, O_WE = 23296, O_RK = 23552, O_TI = 23616, BUF = 24640;
constexpr int RS = 144, RT = 80;
}
__device__ __forceinline__ void mscan_task(const DParams& p, const Ctx& c, int l, int task) {
    using namespace ms;
    const GAS f16* PROJ = (const GAS f16*)(p.ws + WS_R1); const GAS f16* WA = (const GAS f16*)(p.ws + WS_R2);
    GAS f16* Y = (GAS f16*)(p.ws + WS_R3); GAS float* RK = (GAS float*)(p.ws + WS_RK);
    int sq, dir, h;
    if (task < 64) { h = task & 7; dir = (task >> 3) & 1; sq = B_CTX + (task >> 4); } else { const int id = task - 64; h = id & 7; dir = (id >> 3) & 1; sq = id >> 4; }
    const bool smp = sq >= B_CTX; const int T = smp ? T_SMP : T_CTX; const int row0 = smp ? M_CTX + (sq - B_CTX) * T_SMP : sq * T_CTX;
    const int nch = T / 16;
    const int vl = c.lane & 31, hh = c.lane >> 5;
    const int tq = c.tid - 128, ss = (tq >> 4) & 15, cq = tq & 15, k0 = cq * 4, ch0 = h * HD + k0;
    LAS float* cst = (LAS float*)(c.lds + 3 * BUF);
    if (c.wave == 7) { const int chn_ = h * HD + c.lane;
        cst[c.lane] = IN(15)[(l * 3 + 0) * CW + chn_]; cst[64 + c.lane] = IN(15)[(l * 3 + 1) * CW + chn_]; cst[128 + c.lane] = IN(15)[(l * 3 + 2) * CW + chn_];
        cst[192 + c.lane] = IN(16)[l * CW + chn_]; cst[256 + c.lane] = IN(17)[l * CW + chn_]; cst[320 + c.lane] = IN(18)[l * CW + chn_];
        LAS f16* csth_ = (LAS f16*)(cst + 384);
#pragma unroll
        for (int q = 0; q < 6; ++q) csth_[64 * q + c.lane] = (f16)cst[64 * q + c.lane]; }

#define MS_BARRIER() do { asm volatile("s_waitcnt lgkmcnt(0)" ::: "memory"); __builtin_amdgcn_s_barrier(); asm volatile("" ::: "memory"); } while (0)
    if (c.wave >= 2 && c.wave < 6) {
    f16x4 G_rc, G_kc, G_vc, G_rp, G_kp, G_vp, G_rn, G_kn, G_vn, G_av, G_wo, G_wp, G_w7;
    { const f16x4 z4 = {(f16)0.f, (f16)0.f, (f16)0.f, (f16)0.f}; G_rc = G_kc = G_vc = G_rp = G_kp = G_vp = G_rn = G_kn = G_vn = G_av = G_wo = G_wp = G_w7 = z4; }
        int tl = dir ? T - 1 - ss : ss; const int tstep = dir ? -16 : 16;
        const GAS f16* prl = PROJ + ((size_t)row0 + tl) * DIN + ch0; const GAS f16* wol = WA + ((size_t)row0 + tl) * 2048 + dir * 512 + ch0;
        const long pstep = (long)tstep * DIN, wstep = (long)tstep * 2048;
        for (int it = -3; it < nch; ++it) {
            const int ch = it + 2;
            if (ch >= 0 && ch < nch) {
                LAS unsigned char* buf = c.lds + (ch % 3) * BUF;
                const int t = tl - tstep;
                const LAS f16* csth = (const LAS f16*)(cst + 384);
                const f16x4 mh_r = *(const LAS f16x4*)(csth + k0), mh_k = *(const LAS f16x4*)(csth + 64 + k0), mh_v = *(const LAS f16x4*)(csth + 128 + k0);
                const f16x4 kkh = *(const LAS f16x4*)(csth + 192 + k0), kah = *(const LAS f16x4*)(csth + 256 + k0), rkh = *(const LAS f16x4*)(csth + 320 + k0);
                const f16 mp_ = t > 0 ? (f16)0.5f : (f16)0.f, mn_ = t < T - 1 ? (f16)0.5f : (f16)0.f;
                const f16x4 rh_ = G_rc + mh_r * ((G_rp * mp_ + G_rn * mn_) - G_rc), kq_ = G_kc + mh_k * ((G_kp * mp_ + G_kn * mn_) - G_kc), v_ = G_vc + mh_v * ((G_vp * mp_ + G_vn * mn_) - G_vc);
                const f16x4 kk4 = kq_ * kkh;
                float sq_ = __builtin_amdgcn_fdot2(kk4.xy, kk4.xy, 0.f, false); sq_ = __builtin_amdgcn_fdot2(kk4.zw, kk4.zw, sq_, false);
                sq_ = dpp_sum16(sq_); const f16 ri_ = (f16)rsqrtf(sq_ + 1e-12f);
                const f16 one_h = (f16)1.0f;
                const f16x4 kh4 = kk4 * ri_, kt4 = kq_ * ((G_av - one_h) * kah + one_h), b4 = G_av * kh4, rr4 = rh_ * rkh;
                float rk_ = __builtin_amdgcn_fdot2(rr4.xy, kt4.xy, 0.f, false); rk_ = __builtin_amdgcn_fdot2(rr4.zw, kt4.zw, rk_, false);
                rk_ = dpp_sum16(rk_); if (cq == 0) *(LAS float*)(buf + O_RK + ss * 4) = rk_;
                f16x4 om4 = G_wo, omp4 = G_wp;
                if (ss == 7) { om4 = (f16x4){one_h, one_h, one_h, one_h}; }
                if (ss == 8) { omp4 = (f16x4){one_h, one_h, one_h, one_h}; }
                if (ss == 0) {
#pragma unroll
                    for (int e = 0; e < 4; ++e) omp4[e] = __builtin_amdgcn_rcph(G_w7[e]); }
                f16x4 iom4;
#pragma unroll
                for (int e = 0; e < 4; ++e) iom4[e] = __builtin_amdgcn_rcph(om4[e]);
                const f16x4 al4 = omp4 * kh4, be4 = b4 * iom4, ka4 = kt4 * iom4, rho4 = om4 * rh_;
                *(LAS v2u*)(buf + O_BM + ss * RS + k0 * 2) = __builtin_bit_cast(v2u, al4);
                *(LAS v2u*)(buf + O_BM + (16 + ss) * RS + k0 * 2) = __builtin_bit_cast(v2u, rho4);
                *(LAS v2u*)(buf + O_AM + ss * RS + k0 * 2) = __builtin_bit_cast(v2u, be4);
                *(LAS v2u*)(buf + O_AM + (16 + ss) * RS + k0 * 2) = __builtin_bit_cast(v2u, ka4);
                *(LAS v2u*)(buf + O_VP + ss * RS + k0 * 2) = __builtin_bit_cast(v2u, v_);
                if (ss == 15) { f32x4 wm_, we_;
#pragma unroll
                    for (int e = 0; e < 4; ++e) { wm_[e] = (float)G_w7[e]; we_[e] = (float)G_wo[e]; }
                    *(LAS f32x4*)(buf + O_WM + k0 * 4) = wm_; *(LAS f32x4*)(buf + O_WE + k0 * 4) = we_; }
            }
            const int chn = it + 3;
            if (chn < nch) {
                const int t = tl; const GAS f16* pr = prl;
                G_rc = *(const GAS f16x4*)(pr + PC_R); G_kc = *(const GAS f16x4*)(pr + PC_K); G_vc = *(const GAS f16x4*)(pr + PC_V);
                { const GAS f16* prp = t > 0 ? pr - DIN : pr; const GAS f16* prn = t < T - 1 ? pr + DIN : pr;
                  G_rp = *(const GAS f16x4*)(prp + PC_R); G_kp = *(const GAS f16x4*)(prp + PC_K); G_vp = *(const GAS f16x4*)(prp + PC_V);
                  G_rn = *(const GAS f16x4*)(prn + PC_R); G_kn = *(const GAS f16x4*)(prn + PC_K); G_vn = *(const GAS f16x4*)(prn + PC_V); }
                const GAS f16* wo = wol;
                G_av = *(const GAS f16x4*)(wo + 1024);
                G_wo = *(const GAS f16x4*)wo; G_wp = *(const GAS f16x4*)(wo + (ss > 0 ? (dir ? 2048 : -2048) : 0)); G_w7 = *(const GAS f16x4*)(wo + (long)(7 - ss) * (dir ? -2048 : 2048));
            }
            tl += tstep; prl += pstep; wol += wstep;
            MS_BARRIER();
        }
    } else if (c.wave == 6) {
        for (int it = -3; it < nch; ++it) {
            const int ch = it + 1;
            if (ch >= 0 && ch < nch) {
                LAS unsigned char* buf = c.lds + (ch % 3) * BUF;
                f32x16 g, gt;
#pragma unroll
                for (int i = 0; i < 16; ++i) { g[i] = 0.f; gt[i] = 0.f; }
#pragma unroll
                for (int s = 0; s < 4; ++s) { const f16x8 a = *(const LAS f16x8*)(buf + O_AM + vl * RS + (16 * s + 8 * hh) * 2), b = *(const LAS f16x8*)(buf + O_BM + vl * RS + (16 * s + 8 * hh) * 2);
                    g = __builtin_amdgcn_mfma_f32_32x32x16_f16(a, b, g, 0, 0, 0); gt = __builtin_amdgcn_mfma_f32_32x32x16_f16(b, a, gt, 0, 0, 0); }
                const int tcol = vl & 15; const bool incl = vl >= 16;
#pragma unroll
                for (int gq = 0; gq < 4; ++gq) { float o[4];
#pragma unroll
                    for (int e = 0; e < 4; ++e) { const int ip = 8 * gq + 4 * hh + e, i = ip & 15; const bool ok = incl ? (i <= tcol) : (i < tcol); o[e] = ok ? g[4 * gq + e] : 0.f; }
                    v2u w2; w2.x = pkh(o[0], o[1]); w2.y = pkh(o[2], o[3]);
                    *(LAS v2u*)(buf + O_GT + vl * RT + (8 * gq + 4 * hh) * 2) = w2;
                    }
                {
#define MS_OP(src_) __builtin_bit_cast(f16x8, (v4u){pkh((src_)[0], (src_)[1]), pkh((src_)[2], (src_)[3]), pkh((src_)[4], (src_)[5]), pkh((src_)[6], (src_)[7])})
                    f32x16 qd, md, sd, zz;
#pragma unroll
                    for (int r = 0; r < 16; ++r) { zz[r] = 0.f; qd[r] = 0.f; md[r] = 0.f; sd[r] = 0.f; }
#pragma unroll
                    for (int r = 0; r < 8; ++r) { const int i = (r & 3) + 8 * (r >> 2) + 4 * hh;
                        qd[r] = (vl < 16 && i < vl) ? -g[r] : 0.f;
                        md[r] = (vl < 16 && vl < i) ? -gt[r] : 0.f;
                        sd[r] = qd[r] + ((vl == i) ? 1.0f : 0.f); }
                    const f16x8 q1o = MS_OP(qd), m1o = MS_OP(md);
                    const f32x16 q2 = __builtin_amdgcn_mfma_f32_32x32x16_f16(m1o, q1o, zz, 0, 0, 0), m2 = __builtin_amdgcn_mfma_f32_32x32x16_f16(q1o, m1o, zz, 0, 0, 0);
                    const f16x8 q2o = MS_OP(q2), m2o = MS_OP(m2);
                    const f32x16 q4 = __builtin_amdgcn_mfma_f32_32x32x16_f16(m2o, q2o, zz, 0, 0, 0), m4 = __builtin_amdgcn_mfma_f32_32x32x16_f16(q2o, m2o, zz, 0, 0, 0);
                    sd = __builtin_amdgcn_mfma_f32_32x32x16_f16(m2o, MS_OP(sd), sd, 0, 0, 0);
                    const f16x8 q4o = MS_OP(q4), m4o = MS_OP(m4);
                    const f32x16 m8 = __builtin_amdgcn_mfma_f32_32x32x16_f16(q4o, m4o, zz, 0, 0, 0);
                    sd = __builtin_amdgcn_mfma_f32_32x32x16_f16(m4o, MS_OP(sd), sd, 0, 0, 0);
                    sd = __builtin_amdgcn_mfma_f32_32x32x16_f16(MS_OP(m8), MS_OP(sd), sd, 0, 0, 0);
                    v2u w2; w2.x = pkh(sd[0], sd[1]); w2.y = pkh(sd[2], sd[3]); *(LAS v2u*)(buf + O_TI + vl * 32 + (4 * hh) * 2) = w2;
                    w2.x = pkh(sd[4], sd[5]); w2.y = pkh(sd[6], sd[7]); *(LAS v2u*)(buf + O_TI + vl * 32 + (8 + 4 * hh) * 2) = w2;
#undef MS_OP
                }
                if (c.lane < 16) { const int Sg = ch * 16 + c.lane; const int t = dir ? T - 1 - Sg : Sg; RK[((size_t)dir * M + row0 + t) * 8 + h] = *(const LAS float*)(buf + O_RK + c.lane * 4); }
            }
            MS_BARRIER();
        }
    } else if (c.wave == 7) {
        unsigned pa0 = 0u, pa1 = 0u, pb0 = 0u, pb1 = 0u, pc0 = 0u, pc1 = 0u;
#define MS_TOUCH(chp_, r0_, r1_) do { const int chp = (chp_); if (chp < nch) { \
            _Pragma("unroll") for (int q_ = 0; q_ < 2; ++q_) { const int i_ = c.lane + 64 * q_; if (i_ < 86) { const GAS unsigned* a_; \
                if (i_ < 54) { const int rr_ = i_ / 3, sg_ = i_ - 3 * rr_; int t_ = dir ? T - 17 - 16 * chp + rr_ : 16 * chp - 1 + rr_; t_ = t_ < 0 ? 0 : (t_ > T - 1 ? T - 1 : t_); \
                    a_ = (const GAS unsigned*)(PROJ + (size_t)(row0 + t_) * DIN + (sg_ == 0 ? PC_R : (sg_ == 1 ? PC_K : PC_V)) + h * HD); } \
                else { const int j_ = i_ - 54, rr_ = j_ >> 1; const int t_ = dir ? T - 16 - 16 * chp + rr_ : 16 * chp + rr_; \
                    a_ = (const GAS unsigned*)(WA + (size_t)(row0 + t_) * 2048 + (j_ & 1) * 1024 + dir * 512 + h * HD); } \
                if (q_ == 0) r0_ = *a_; else r1_ = *a_; } } } } while (0)
        unsigned px0 = 0u, px1 = 0u, px2 = 0u, px3 = 0u, px4 = 0u, px5 = 0u;
        MS_TOUCH(0, px0, px1); MS_TOUCH(1, px2, px3); MS_TOUCH(2, px4, px5);
        for (int it = -3; it < nch; it += 3) {
            asm volatile("" :: "v"(pa0), "v"(pa1)); MS_TOUCH(it + 6, pa0, pa1); MS_BARRIER();
            if (it + 1 < nch) { asm volatile("" :: "v"(pb0), "v"(pb1)); MS_TOUCH(it + 7, pb0, pb1); MS_BARRIER(); }
            if (it + 2 < nch) { asm volatile("" :: "v"(pc0), "v"(pc1)); MS_TOUCH(it + 8, pc0, pc1); MS_BARRIER(); }
        }
        asm volatile("" :: "v"(px0), "v"(px1), "v"(px2), "v"(px3), "v"(px4), "v"(px5), "v"(pa0), "v"(pa1), "v"(pb0), "v"(pb1), "v"(pc0), "v"(pc1));
#undef MS_TOUCH
    } else {
    f32x16 St0, St1;
#pragma unroll
    for (int i = 0; i < 16; ++i) { St0[i] = 0.f; St1[i] = 0.f; }
    if (smp) { float one_ = 1.0f; asm volatile("" : "+v"(one_));
        const GAS float* s0 = IN(4) + (((((size_t)(sq - B_CTX) * NL + l) * 2 + dir) * NH + h) * HD + 32 * c.wave + vl) * HD + 4 * hh;
#pragma unroll
        for (int g = 0; g < 4; ++g) { const f32x4 a = *(const GAS f32x4*)(s0 + 8 * g), b = *(const GAS f32x4*)(s0 + 32 + 8 * g);
#pragma unroll
            for (int e = 0; e < 4; ++e) { St0[4 * g + e] = a[e] * one_; St1[4 * g + e] = b[e] * one_; } }
    }
        v4u ypk = {0u, 0u, 0u, 0u};
#define MS_YSTORE(chv_) do { const int t0_ = (chv_) * 16 + 4 * hh; int vv_ = 32 * c.wave + vl; asm volatile("" : "+v"(vv_)); GAS f16* yb_ = Y + ((size_t)dir * M + row0) * CW + h * HD + vv_; const f16x8 yv_ = __builtin_bit_cast(f16x8, ypk); \
            if (dir == 0) { GAS f16* y0_ = yb_ + (size_t)t0_ * CW; GAS f16* y8_ = y0_ + 8 * CW; \
                _Pragma("unroll") for (int j = 0; j < 4; ++j) { y0_[j * CW] = yv_[j]; y8_[j * CW] = yv_[4 + j]; } } \
            else { GAS f16* y0_ = yb_ + (size_t)(T - 1 - t0_) * CW; GAS f16* y8_ = y0_ - 8 * CW; \
                _Pragma("unroll") for (int j = 0; j < 4; ++j) { y0_[-j * CW] = yv_[j]; y8_[-j * CW] = yv_[4 + j]; } } } while (0)
        for (int it = -3; it < nch; ++it) {
            const int ch = it;
            if (ch >= 0) {
                LAS unsigned char* buf = c.lds + (ch % 3) * BUF;
                const int v = 32 * c.wave + vl;
                if (ch == 0) {
#pragma unroll
                for (int gq = 0; gq < 4; ++gq) { const f32x4 m0 = *(const LAS f32x4*)(buf + O_WM + (8 * gq + 4 * hh) * 4), m1 = *(const LAS f32x4*)(buf + O_WM + (32 + 8 * gq + 4 * hh) * 4);
#pragma unroll
                    for (int e = 0; e < 4; ++e) { St0[4 * gq + e] *= m0[e]; St1[4 * gq + e] *= m1[e]; } }
                }
                f16x4 bmlo[4], bmhi[4];
#pragma unroll
                for (int s = 0; s < 4; ++s) { bmlo[s] = *(const LAS f16x4*)(buf + O_BM + vl * RS + (16 * s + 4 * hh) * 2); bmhi[s] = *(const LAS f16x4*)(buf + O_BM + vl * RS + (16 * s + 8 + 4 * hh) * 2); }
                const int trl_ = lane_id();
                const int troff = (8 * (trl_ >> 5) + ((trl_ >> 2) & 3)) * RS + (16 * ((trl_ >> 4) & 1) + 4 * (trl_ & 3)) * 2;
#define MS_TR(off_) __builtin_bit_cast(f16x4, __builtin_amdgcn_ds_read_tr16_b64_v4f16((LAS h4v*)(buf + (off_))))
#define MS_TR8(dst_, off_) do { const f16x4 lo_ = MS_TR(off_), hi_ = MS_TR((off_) + 4 * RS); dst_ = (f16x8){lo_[0], lo_[1], lo_[2], lo_[3], hi_[0], hi_[1], hi_[2], hi_[3]}; } while (0)
                const f16x8 gtk = *(const LAS f16x8*)(buf + O_GT + vl * RT + (16 + 8 * hh) * 2); f16x8 vpv; MS_TR8(vpv, O_VP + troff + 64 * c.wave);
                const f16x8 aN = *(const LAS f16x8*)(buf + O_GT + vl * RT + (8 * hh) * 2);
                const f16x8 tA = *(const LAS f16x8*)(buf + O_TI + vl * 32 + hh * 16);
                f16x8 at0[2], at1[2];
                MS_TR8(at0[0], O_AM + 16 * RS + troff); MS_TR8(at1[0], O_AM + 16 * RS + troff + 64); MS_TR8(at0[1], O_AM + troff); MS_TR8(at1[1], O_AM + troff + 64);
#undef MS_TR8
#undef MS_TR
                f32x4 sc0[4], sc1[4];
                { LAS unsigned char* nbuf = c.lds + ((ch + 1) % 3) * BUF;
#pragma unroll
                  for (int gq = 0; gq < 4; ++gq) { sc0[gq] = *(const LAS f32x4*)(buf + O_WE + (8 * gq + 4 * hh) * 4); sc1[gq] = *(const LAS f32x4*)(buf + O_WE + (32 + 8 * gq + 4 * hh) * 4); }
                  if (ch + 1 < nch) {
                    f32x4 n0[4], n1[4];
#pragma unroll
                    for (int gq = 0; gq < 4; ++gq) { n0[gq] = *(const LAS f32x4*)(nbuf + O_WM + (8 * gq + 4 * hh) * 4); n1[gq] = *(const LAS f32x4*)(nbuf + O_WM + (32 + 8 * gq + 4 * hh) * 4); }
#pragma unroll
                    for (int gq = 0; gq < 4; ++gq) { sc0[gq] *= n0[gq]; sc1[gq] *= n1[gq]; } } }
                if (ch > 0) MS_YSTORE(ch - 1);
                f32x16 X;
#pragma unroll
                for (int i = 0; i < 16; ++i) X[i] = 0.f;
#pragma unroll
                for (int s = 0; s < 4; ++s) {
                    f16x8 sb;
#pragma unroll
                    for (int j = 0; j < 8; ++j) sb[j] = (f16)((s < 2) ? St0[8 * (s & 1) + j] : St1[8 * (s & 1) + j]);
                    const f16x8 af = {bmlo[s][0], bmlo[s][1], bmlo[s][2], bmlo[s][3], bmhi[s][0], bmhi[s][1], bmhi[s][2], bmhi[s][3]};
                    X = __builtin_amdgcn_mfma_f32_32x32x16_f16(af, sb, X, 0, 0, 0);
                }
                X = __builtin_amdgcn_mfma_f32_32x32x16_f16(gtk, vpv, X, 0, 0, 0);
                f16x8 pball;
                {   unsigned l0 = pkh(X[0], X[1]), l1 = pkh(X[2], X[3]), h0 = pkh(X[4], X[5]), h1 = pkh(X[6], X[7]);
                    swap32u(l0, h0); swap32u(l1, h1);
                    const f16x8 xal = __builtin_bit_cast(f16x8, (v4u){l0, l1, h0, h1});
                    f32x16 Pm;
#pragma unroll
                    for (int i = 0; i < 16; ++i) Pm[i] = 0.f;
                    Pm = __builtin_amdgcn_mfma_f32_32x32x16_f16(tA, xal, Pm, 0, 0, 0);
                    l0 = pkh(-Pm[0], -Pm[1]); l1 = pkh(-Pm[2], -Pm[3]); h0 = pkh(-Pm[4], -Pm[5]); h1 = pkh(-Pm[6], -Pm[7]);
                    swap32u(l0, h0); swap32u(l1, h1);
                    pball = __builtin_bit_cast(f16x8, (v4u){l0, l1, h0, h1}); }
                X = __builtin_amdgcn_mfma_f32_32x32x16_f16(aN, pball, X, 0, 0, 0);
                St0 = __builtin_amdgcn_mfma_f32_32x32x16_f16(at0[0], vpv, St0, 0, 0, 0); St1 = __builtin_amdgcn_mfma_f32_32x32x16_f16(at1[0], vpv, St1, 0, 0, 0);
                St0 = __builtin_amdgcn_mfma_f32_32x32x16_f16(at0[1], pball, St0, 0, 0, 0); St1 = __builtin_amdgcn_mfma_f32_32x32x16_f16(at1[1], pball, St1, 0, 0, 0);
                ypk.x = pkh(X[8], X[9]); ypk.y = pkh(X[10], X[11]); ypk.z = pkh(X[12], X[13]); ypk.w = pkh(X[14], X[15]);
#pragma unroll
                for (int gq = 0; gq < 4; ++gq)
#pragma unroll
                    for (int e = 0; e < 4; ++e) { St0[4 * gq + e] *= sc0[gq][e]; St1[4 * gq + e] *= sc1[gq][e]; }
            }
            MS_BARRIER();
        }
        MS_YSTORE(nch - 1);
#undef MS_YSTORE
    if (!smp) {
        GAS float* so = p.out + O_ST + (((((size_t)sq * NL + l) * 2 + dir) * NH + h) * HD + 32 * c.wave + vl) * HD + 4 * hh;
#pragma unroll
        for (int g = 0; g < 4; ++g) { *(GAS f32x4*)(so + 8 * g) = (f32x4){St0[4 * g], St0[4 * g + 1], St0[4 * g + 2], St0[4 * g + 3]};
            *(GAS f32x4*)(so + 32 + 8 * g) = (f32x4){St1[4 * g], St1[4 * g + 1], St1[4 * g + 2], St1[4 * g + 3]}; }
    }
    }
#undef MS_BARRIER
}
__device__ __forceinline__ void mfma_scan(const Params& p0, const Ctx& c0, int l) {
    const Ctx c = fresh(c0); FRESH_P(p0);
    const int b = c.bid, G = (int)gridDim.x;
    const bool deal = G >= 128;
    const int first = b, step = deal ? (b < 64 ? 576 : G - 64) : G;
#pragma nounroll
    for (int task = first; task < 576; task += step) mscan_task(p, c, l, task);
}

__device__ __forceinline__ int swap23(int r) { return (r & ~12) | ((r & 4) << 1) | ((r & 8) >> 1); }
__device__ __forceinline__ void attn_wave_task(const DParams& p, const Ctx& c, int l, int task) {
    const GAS f16* PROJ = (const GAS f16*)(p.ws + WS_R1); const GAS f16* KN = (const GAS f16*)(p.ws + WS_KN); const GAS f16* VT = (const GAS f16*)(p.ws + WS_VT);
    GAS f16* OA = (GAS f16*)(p.ws + WS_R4);
    const int hq = task & 7, qb = task >> 3, kvh = hq >> 2;
    const int r32 = c.lane & 31, hh = c.lane >> 5;
    int rowq0, L; const GAS f16* Kb; const GAS f16* Vb; bool smp;
    if (qb < 128) { smp = true; rowq0 = M_CTX + qb * 32; const int b = qb >> 5; L = KV_SMP;
        Kb = KN + KN_SMP_OFF + ((size_t)b * 2 + kvh) * KV_SMP * HD; Vb = VT + KN_SMP_OFF + ((size_t)b * 2 + kvh) * HD * KV_SMP; }
    else { smp = false; rowq0 = (qb - 128) * 32; const int b = rowq0 >> 8; L = T_CTX;
        Kb = KN + ((size_t)b * 2 + kvh) * T_CTX * HD; Vb = VT + ((size_t)b * 2 + kvh) * HD * T_CTX; }
    const int row = rowq0 + r32;
    float x[4][8]; float ss = 0.f;
#pragma unroll
    for (int s = 0; s < 4; ++s) { const f16x8 q = *(const GAS f16x8*)(PROJ + (size_t)row * DIN + PC_Q + hq * HD + 16 * s + 8 * hh);
#pragma unroll
        for (int j = 0; j < 8; ++j) { x[s][j] = (float)q[j]; ss += x[s][j] * x[s][j]; } }
    ss = half_sum(ss);
    const float rstd = rsqrtf(ss * (1.0f / HD) + 1e-6f);
#pragma unroll
    for (int s = 0; s < 4; ++s)
#pragma unroll
        for (int j = 0; j < 8; ++j) x[s][j] *= rstd * IN(26)[l * HD + 16 * s + 8 * hh + j];
    if (smp) { const int t = (row - M_CTX) & (T_SMP - 1); const float posr = (float)(t >> 6), posc = (float)(t & 63);
#pragma unroll
        for (int j = 0; j < 8; ++j) { const float freq = exp2f(-(float)(8 * hh + j) * (13.287712379549449f / 16.0f));
            const float ar = posr * freq, ac = posc * freq; const float cr = __cosf(ar), sr = __sinf(ar), cc = __cosf(ac), sc = __sinf(ac);
            const float a0 = x[0][j], a1 = x[1][j], b0 = x[2][j], b1 = x[3][j];
            x[0][j] = a0 * cr - a1 * sr; x[1][j] = a1 * cr + a0 * sr; x[2][j] = b0 * cc - b1 * sc; x[3][j] = b1 * cc + b0 * sc; } }
    f16x8 qf[4];
#pragma unroll
    for (int s = 0; s < 4; ++s)
#pragma unroll
        for (int j = 0; j < 8; ++j) qf[s][j] = (f16)(x[s][j] * (0.125f * 1.4426950408889634f));
    f32x16 o0, o1;
#pragma unroll
    for (int i = 0; i < 16; ++i) { o0[i] = 0.f; o1[i] = 0.f; }
    float mrun = -1e30f, lsum = 0.f;
    const GAS f16* kp = Kb + (size_t)swap23(r32) * HD + 8 * hh;
    const GAS f16* vp = Vb + (size_t)r32 * L + 8 * hh;
    const int ntile = L >> 5;
    f16x8 kf[4], vf[4];
#pragma unroll
    for (int s = 0; s < 4; ++s) kf[s] = *(const GAS f16x8*)(kp + 16 * s);
    vf[0] = *(const GAS f16x8*)(vp); vf[1] = *(const GAS f16x8*)(vp + 16); vf[2] = *(const GAS f16x8*)(vp + (size_t)32 * L); vf[3] = *(const GAS f16x8*)(vp + (size_t)32 * L + 16);
    for (int kt = 0; kt < ntile; ++kt) {
        f16x8 kn[4], vn[4];
        const int ktn = kt + 1 < ntile ? kt + 1 : kt;
#pragma unroll
        for (int s = 0; s < 4; ++s) kn[s] = *(const GAS f16x8*)(kp + (size_t)ktn * 32 * HD + 16 * s);
        vn[0] = *(const GAS f16x8*)(vp + ktn * 32); vn[1] = *(const GAS f16x8*)(vp + ktn * 32 + 16); vn[2] = *(const GAS f16x8*)(vp + (size_t)32 * L + ktn * 32); vn[3] = *(const GAS f16x8*)(vp + (size_t)32 * L + ktn * 32 + 16);
        f32x16 sa;
#pragma unroll
        for (int i = 0; i < 16; ++i) sa[i] = 0.f;
#pragma unroll
        for (int s = 0; s < 4; ++s) sa = __builtin_amdgcn_mfma_f32_32x32x16_f16(kf[s], qf[s], sa, 0, 0, 0);
        float mt = sa[0];
#pragma unroll
        for (int i = 1; i < 16; ++i) mt = fmaxf(mt, sa[i]);
        mt = half_max(mt);
        const float mn = fmaxf(mrun, mt); const float alpha = exp2f(mrun - mn); mrun = mn;
        float ps = 0.f;
#pragma unroll
        for (int i = 0; i < 16; ++i) { sa[i] = exp2f(sa[i] - mn); ps += sa[i]; }
        lsum = lsum * alpha + ps;
#pragma unroll
        for (int i = 0; i < 16; ++i) { o0[i] *= alpha; o1[i] *= alpha; }
        f16x8 pb0, pb1;
#pragma unroll
        for (int j = 0; j < 8; ++j) { pb0[j] = (f16)sa[j]; pb1[j] = (f16)sa[8 + j]; }
        o0 = __builtin_amdgcn_mfma_f32_32x32x16_f16(vf[0], pb0, o0, 0, 0, 0);
        o0 = __builtin_amdgcn_mfma_f32_32x32x16_f16(vf[1], pb1, o0, 0, 0, 0);
        o1 = __builtin_amdgcn_mfma_f32_32x32x16_f16(vf[2], pb0, o1, 0, 0, 0);
        o1 = __builtin_amdgcn_mfma_f32_32x32x16_f16(vf[3], pb1, o1, 0, 0, 0);
#pragma unroll
        for (int s = 0; s < 4; ++s) { kf[s] = kn[s]; vf[s] = vn[s]; }
    }
    lsum = half_sum(lsum);
    const float inv = 1.0f / lsum;
    GAS f16* op = OA + (size_t)row * D + CW + hq * HD + 4 * hh;
#pragma unroll
    for (int g = 0; g < 4; ++g) {
        v2u w0; w0.x = pkh(o0[4 * g] * inv, o0[4 * g + 1] * inv); w0.y = pkh(o0[4 * g + 2] * inv, o0[4 * g + 3] * inv);
        v2u w1; w1.x = pkh(o1[4 * g] * inv, o1[4 * g + 1] * inv); w1.y = pkh(o1[4 * g + 2] * inv, o1[4 * g + 3] * inv);
        *(GAS v2u*)(op + 8 * g) = w0; *(GAS v2u*)(op + 32 + 8 * g) = w1; }
}
constexpr int AT_KS = 144, AT_BUF = 2 * 64 * AT_KS;
__device__ __forceinline__ void attn_block_task(const DParams& p, const Ctx& c, int l, int item) {
    const GAS f16* PROJ = (const GAS f16*)(p.ws + WS_R1); const GAS f16* KN = (const GAS f16*)(p.ws + WS_KN); const GAS f16* VT = (const GAS f16*)(p.ws + WS_VT);
    GAS f16* OA = (GAS f16*)(p.ws + WS_R4);
    int rowq0, L, kvh; const GAS f16* Kb; const GAS f16* Vb; bool smp;
    if (item < 128) { smp = true; const int b = item >> 5; kvh = (item >> 4) & 1; rowq0 = M_CTX + b * T_SMP + (item & 15) * 64; L = KV_SMP;
        Kb = KN + KN_SMP_OFF + ((size_t)b * 2 + kvh) * KV_SMP * HD; Vb = VT + KN_SMP_OFF + ((size_t)b * 2 + kvh) * HD * KV_SMP; }
    else { smp = false; const int id = item - 128; const int b = id >> 3; kvh = (id >> 2) & 1; rowq0 = b * T_CTX + (id & 3) * 64; L = T_CTX;
        Kb = KN + ((size_t)b * 2 + kvh) * T_CTX * HD; Vb = VT + ((size_t)b * 2 + kvh) * HD * T_CTX; }
    const int hq = kvh * 4 + (c.wave & 3);
    const int r32 = c.lane & 31, hh = c.lane >> 5;
    const int row = rowq0 + 32 * (c.wave >> 2) + r32;
    const int kk = c.tid >> 3, chk = c.tid & 7;
    const GAS f16* ksrc = Kb + (size_t)kk * HD + chk * 8;
    const GAS f16* vsrc = Vb + (size_t)kk * L + chk * 8;
    const int sdst = kk * AT_KS + chk * 16;
    v4u kreg = *(const GAS v4u*)ksrc, vreg = *(const GAS v4u*)vsrc;
    float x[4][8]; float ss = 0.f;
#pragma unroll
    for (int s = 0; s < 4; ++s) { const f16x8 q = *(const GAS f16x8*)(PROJ + (size_t)row * DIN + PC_Q + hq * HD + 16 * s + 8 * hh);
#pragma unroll
        for (int j = 0; j < 8; ++j) { x[s][j] = (float)q[j]; ss += x[s][j] * x[s][j]; } }
    ss = half_sum(ss);
    const float rstd = rsqrtf(ss * (1.0f / HD) + 1e-6f);
#pragma unroll
    for (int s = 0; s < 4; ++s)
#pragma unroll
        for (int j = 0; j < 8; ++j) x[s][j] *= rstd * IN(26)[l * HD + 16 * s + 8 * hh + j];
    if (smp) { const int t = (row - M_CTX) & (T_SMP - 1); const float posr = (float)(t >> 6), posc = (float)(t & 63);
#pragma unroll
        for (int j = 0; j < 8; ++j) { const float freq = exp2f(-(float)(8 * hh + j) * (13.287712379549449f / 16.0f));
            const float ar = posr * freq, ac = posc * freq; const float cr = __cosf(ar), sr = __sinf(ar), cc = __cosf(ac), sc = __sinf(ac);
            const float a0 = x[0][j], a1 = x[1][j], b0 = x[2][j], b1 = x[3][j];
            x[0][j] = a0 * cr - a1 * sr; x[1][j] = a1 * cr + a0 * sr; x[2][j] = b0 * cc - b1 * sc; x[3][j] = b1 * cc + b0 * sc; } }
    f16x8 qf[4];
#pragma unroll
    for (int s = 0; s < 4; ++s)
#pragma unroll
        for (int j = 0; j < 8; ++j) qf[s][j] = (f16)(x[s][j] * (0.125f * 1.4426950408889634f));
    f32x16 o0, o1;
#pragma unroll
    for (int i = 0; i < 16; ++i) { o0[i] = 0.f; o1[i] = 0.f; }
    f32x16 negm;
#pragma unroll
    for (int i = 0; i < 16; ++i) negm[i] = 0.f;
    float lsum = 0.f;
    const int nstep = L >> 6;
    *(LAS v4u*)(c.lds + sdst) = kreg; *(LAS v4u*)(c.lds + 64 * AT_KS + sdst) = vreg;
    asm volatile("s_waitcnt lgkmcnt(0)" ::: "memory"); __builtin_amdgcn_s_barrier(); asm volatile("" ::: "memory");
    const int koff = swap23(r32) * AT_KS + 16 * hh, voff = 64 * AT_KS + r32 * AT_KS + 16 * hh;
    for (int st = 0; st < nstep; ++st) {
        if (st + 1 < nstep) { kreg = *(const GAS v4u*)(ksrc + (size_t)(st + 1) * 64 * HD); vreg = *(const GAS v4u*)(vsrc + (st + 1) * 64); }
        LAS unsigned char* sb = c.lds + (st & 1) * AT_BUF;
        f32x16 sa0 = negm, sa1 = negm;
#pragma unroll
        for (int s = 0; s < 4; ++s) { const f16x8 k0 = *(const LAS f16x8*)(sb + koff + 32 * s), k1 = *(const LAS f16x8*)(sb + koff + 32 * AT_KS + 32 * s);
            sa0 = __builtin_amdgcn_mfma_f32_32x32x16_f16(k0, qf[s], sa0, 0, 0, 0); sa1 = __builtin_amdgcn_mfma_f32_32x32x16_f16(k1, qf[s], sa1, 0, 0, 0); }
        if (st == 0) {
            float mt = fmaxf(sa0[0], sa1[0]);
#pragma unroll
            for (int i = 1; i < 16; ++i) mt = fmaxf(mt, fmaxf(sa0[i], sa1[i]));
            mt = half_max(mt);
#pragma unroll
            for (int i = 0; i < 16; ++i) { sa0[i] -= mt; sa1[i] -= mt; negm[i] = -mt; }
        }
        float ps = 0.f;
#pragma unroll
        for (int i = 0; i < 16; ++i) { sa0[i] = __builtin_amdgcn_exp2f(sa0[i]); sa1[i] = __builtin_amdgcn_exp2f(sa1[i]); ps += sa0[i] + sa1[i]; }
        if (__builtin_amdgcn_ballot_w64(ps > 32768.f) != 0ull) {
            const float pm = half_max(ps);
            const float dl = pm > 32768.f ? ceilf(__log2f(pm)) : 0.f; const float f = __builtin_amdgcn_exp2f(-dl);
#pragma unroll
            for (int i = 0; i < 16; ++i) { sa0[i] *= f; sa1[i] *= f; o0[i] *= f; o1[i] *= f; negm[i] -= dl; }
            ps *= f; lsum *= f;
        }
        lsum += ps;
        f16x8 pb[4];
#pragma unroll
        for (int j = 0; j < 8; ++j) { pb[0][j] = (f16)sa0[j]; pb[1][j] = (f16)sa0[8 + j]; pb[2][j] = (f16)sa1[j]; pb[3][j] = (f16)sa1[8 + j]; }
#pragma unroll
        for (int q4 = 0; q4 < 4; ++q4) {
            const f16x8 v0 = *(const LAS f16x8*)(sb + voff + 32 * q4), v1 = *(const LAS f16x8*)(sb + voff + 32 * AT_KS + 32 * q4);
            o0 = __builtin_amdgcn_mfma_f32_32x32x16_f16(v0, pb[q4], o0, 0, 0, 0); o1 = __builtin_amdgcn_mfma_f32_32x32x16_f16(v1, pb[q4], o1, 0, 0, 0); }
        if (st + 1 < nstep) { LAS unsigned char* nb = c.lds + ((st + 1) & 1) * AT_BUF; *(LAS v4u*)(nb + sdst) = kreg; *(LAS v4u*)(nb + 64 * AT_KS + sdst) = vreg; }
        asm volatile("s_waitcnt lgkmcnt(0)" ::: "memory"); __builtin_amdgcn_s_barrier(); asm volatile("" ::: "memory");
    }
    lsum = half_sum(lsum);
    const float inv = 1.0f / lsum;
    GAS f16* op = OA + (size_t)row * D + CW + hq * HD + 4 * hh;
#pragma unroll
    for (int g = 0; g < 4; ++g) {
        v2u w0; w0.x = pkh(o0[4 * g] * inv, o0[4 * g + 1] * inv); w0.y = pkh(o0[4 * g + 2] * inv, o0[4 * g + 3] * inv);
        v2u w1; w1.x = pkh(o1[4 * g] * inv, o1[4 * g + 1] * inv); w1.y = pkh(o1[4 * g + 2] * inv, o1[4 * g + 3] * inv);
        *(GAS v2u*)(op + 8 * g) = w0; *(GAS v2u*)(op + 32 + 8 * g) = w1; }
}
__device__ __forceinline__ void fast_attn(const Params& p0, const Ctx& c0, int l) {
    const Ctx c = fresh(c0); FRESH_P(p0);
    unsigned* ctr = (unsigned*)(p0.ws + WS_CTL) + 8192 + 64 * l;
    volatile LAS unsigned* slot = (volatile LAS unsigned*)(c.lds + MISC_OFF) + 16;
    for (;;) {
        if (c.tid == 0) slot[0] = __hip_atomic_fetch_add(ctr, 1u, __ATOMIC_RELAXED, __HIP_MEMORY_SCOPE_AGENT);
        __syncthreads();
        const int item = (int)slot[0];
        __syncthreads();
        if (item >= 384) break;
        attn_block_task(p, c, l, item);
    }
}

__device__ __forceinline__ void post_phase(const Params& p0, const Ctx& c0, int l) {
    const Ctx c = fresh(c0); FRESH_P(p0);
    const GAS f16* PROJ = (const GAS f16*)(p.ws + WS_R1); const GAS f16* Y = (const GAS f16*)(p.ws + WS_R3); const GAS float* RK = (const GAS float*)(p.ws + WS_RK);
    GAS f16* OA = (GAS f16*)(p.ws + WS_R4);
    const int ch0 = c.lane * 8, h = c.lane >> 3;
    float gnw[8], gnb[8], muv[8];
    { const f32x4 a0 = *(const GAS f32x4*)(IN(24) + l * CW + ch0), a1 = *(const GAS f32x4*)(IN(24) + l * CW + ch0 + 4), b0 = *(const GAS f32x4*)(IN(25) + l * CW + ch0), b1 = *(const GAS f32x4*)(IN(25) + l * CW + ch0 + 4);
      const f32x4 m0 = *(const GAS f32x4*)(IN(15) + (l * 3 + 2) * CW + ch0), m1 = *(const GAS f32x4*)(IN(15) + (l * 3 + 2) * CW + ch0 + 4);
#pragma unroll
      for (int e = 0; e < 4; ++e) { gnw[e] = a0[e]; gnw[4 + e] = a1[e]; gnb[e] = b0[e]; gnb[4 + e] = b1[e]; muv[e] = m0[e]; muv[4 + e] = m1[e]; } }
    for (int row = c.gw; row < M; row += c.ngw) {
        int g, t, T; row_info(row, g, t, T);
        const GAS f16* pr = PROJ + (size_t)row * DIN + PC_V + ch0;
        const f16x8 y0 = *(const GAS f16x8*)(Y + (size_t)row * CW + ch0), y1 = *(const GAS f16x8*)(Y + ((size_t)M + row) * CW + ch0);
        const f16x8 vc = *(const GAS f16x8*)pr; const f16x8 gv = *(const GAS f16x8*)(OA + (size_t)row * D + ch0);
        f16x8 vp, vn;
#pragma unroll
        for (int e = 0; e < 8; ++e) { vp[e] = (f16)0.f; vn[e] = (f16)0.f; }
        if (t > 0) vp = *(const GAS f16x8*)(pr - DIN);
        if (t < T - 1) vn = *(const GAS f16x8*)(pr + DIN);
        const float rk = RK[(size_t)row * 8 + h] + RK[((size_t)M + row) * 8 + h];
        float y[8]; float s = 0.f;
#pragma unroll
        for (int e = 0; e < 8; ++e) { y[e] = (float)y0[e] + (float)y1[e]; s += y[e]; }
        const float mean = dpp_sum8(s) * (1.0f / HD); float q = 0.f;
#pragma unroll
        for (int e = 0; e < 8; ++e) { y[e] -= mean; q += y[e] * y[e]; }
        const float rstd = rsqrtf(dpp_sum8(q) * (1.0f / HD) + 64e-5f);
        float o[8];
#pragma unroll
        for (int e = 0; e < 8; ++e) { const float vcf = (float)vc[e]; const float v = vcf + muv[e] * (0.5f * ((float)vp[e] + (float)vn[e]) - vcf);
            o[e] = (y[e] * rstd * gnw[e] + gnb[e] + rk * v) * (float)gv[e]; }
        v4u w; w.x = pkh(o[0], o[1]); w.y = pkh(o[2], o[3]); w.z = pkh(o[4], o[5]); w.w = pkh(o[6], o[7]);
        *(GAS v4u*)(OA + (size_t)row * D + ch0) = w;
    }
}

__device__ __forceinline__ void gemm_proj(const Params& p0, const Ctx& c0) { const Ctx c = fresh(c0); FRESH_P(p0);
    pg8::Gemm g{(const GAS f16*)(p.ws + WS_R4), (const GAS f16*)(p.ws + WS_W + WO_IN), D, D, D}; pg8::StaticOrder S; S.init(M, DIN, (int)gridDim.x, c.bid);
    pg8::gemm_phase(c.lds, g, S, pg8::EpiProjF{(GAS f16*)(p.ws + WS_R1)}, c.wave); }
__device__ __forceinline__ void gemm_wa(const Params& p0, const Ctx& c0, int l) { const Ctx c = fresh(c0); FRESH_P(p0);
    pg8::Gemm g{(const GAS f16*)(p.ws + WS_R1) + PC_LW, (const GAS f16*)(p.ws + WS_W + WO_SM), DIN, 128, 128}; pg8::StaticOrder S; S.init(M, 2048, (int)gridDim.x, c.bid); if (gridDim.x == 256) S.mode = 1;
    pg8::gemm_phase(c.lds, g, S, pg8::EpiWAF{(GAS f16*)(p.ws + WS_R2), IN(19) + (size_t)l * 2 * CW, IN(21) + (size_t)l * 2 * CW}, c.wave); }
__device__ __forceinline__ void gemm_gate(const Params& p0, const Ctx& c0) { const Ctx c = fresh(c0); FRESH_P(p0);
    pg8::Gemm g{(const GAS f16*)(p.ws + WS_R1) + PC_LG, (const GAS f16*)(p.ws + WS_W + WO_G), DIN, 128, 128}; pg8::StaticOrder S; if (gridDim.x == 256) S.init(M, CW, (int)gridDim.x, c.bid - 64); else S.init(M, CW, (int)gridDim.x, c.bid);
    pg8::gemm_phase(c.lds, g, S, pg8::EpiF16F{(GAS f16*)(p.ws + WS_R4), D}, c.wave); }
__device__ __forceinline__ void gemm_merge(const Params& p0, const Ctx& c0) { const Ctx c = fresh(c0); FRESH_P(p0);
    const GAS f16* OA = (const GAS f16*)(p.ws + WS_R4); const GAS f16* WbrT = (const GAS f16*)(p.ws + WS_W + WO_BR); GAS f16* MG = (GAS f16*)(p.ws + WS_R3); const GAS f16* PROJ = (const GAS f16*)(p.ws + WS_R1);
    pg8::StaticOrder S; S.init(M, D, (int)gridDim.x, c.bid, 192);
    pg8::Gemm g{OA, WbrT, D, D, D}; pg8::gemm_phase<pg8::EpiMergeF, 96>(c.lds, g, S, pg8::EpiMergeF{MG, PROJ}, c.wave); }
__device__ __forceinline__ void gemm_out(const Params& p0, const Ctx& c0) { const Ctx c = fresh(c0); FRESH_P(p0);
    pg8::Gemm g{(const GAS f16*)(p.ws + WS_R3), (const GAS f16*)(p.ws + WS_W + WO_OUT), D, D, D}; pg8::StaticOrder S; S.init(M, D, (int)gridDim.x, c.bid, 192);
    pg8::gemm_phase<pg8::EpiF16F, 96>(c.lds, g, S, pg8::EpiF16F{(GAS f16*)(p.ws + WS_R2), D}, c.wave); }
__device__ __forceinline__ void gemm_up(const Params& p0, const Ctx& c0) { const Ctx c = fresh(c0); FRESH_P(p0);
    pg8::Gemm g{(const GAS f16*)(p.ws + WS_R4), (const GAS f16*)(p.ws + WS_W + WO_UP), D, D, D}; pg8::StaticOrder S; S.init(M, DFF, (int)gridDim.x, c.bid);
    pg8::gemm_phase(c.lds, g, S, pg8::EpiRelu2F{(GAS f16*)(p.ws + WS_R1), DFF}, c.wave); }
__device__ __forceinline__ void gemm_down(const Params& p0, const Ctx& c0) { const Ctx c = fresh(c0); FRESH_P(p0);
    pg8::Gemm g{(const GAS f16*)(p.ws + WS_R1), (const GAS f16*)(p.ws + WS_W + WO_DN), DFF, DFF, DFF}; pg8::StaticOrder S; S.init(M, D, (int)gridDim.x, c.bid, 192);
    pg8::gemm_phase<pg8::EpiF16F, 96>(c.lds, g, S, pg8::EpiF16F{(GAS f16*)(p.ws + WS_R2), D}, c.wave); }

__global__ void __launch_bounds__(NTHREADS, 2) fwd_kernel(Params p) {
    extern __shared__ __attribute__((aligned(16))) unsigned char lds_raw[];
    Ctx c;
    c.lds = (LAS unsigned char*)lds_raw;
    c.tid = threadIdx.x; c.lane = c.tid & 63; c.wave = __builtin_amdgcn_readfirstlane(c.tid >> 6);
    c.gw = blockIdx.x * NWAVES + c.wave; c.ngw = gridDim.x * NWAVES; c.gt = blockIdx.x * NTHREADS + c.tid; c.ngt = gridDim.x * NTHREADS;
    volatile LAS unsigned* MISC = (volatile LAS unsigned*)(c.lds + MISC_OFF);
    if (c.tid < 32) MISC[c.tid] = 0u;
    if (c.tid < 28) ((LAS unsigned long long*)(c.lds + PTAB_OFF))[c.tid] = (unsigned long long)p.in[c.tid];
    __syncthreads();
    unsigned* ctl = (unsigned*)(p.ws + WS_CTL);
    XcdBarrier bar = xcd_barrier_post(ctl + CW_BAR, MISC + 8);
#define GRID_BAR() xcd_barrier(bar)

    conv_weights<0>(p, c, 0, c.gw, c.ngw);
    __syncthreads();
    mod_phase(p, c);
    GRID_BAR();
    norm_phase<0>(p, c, 0);
    GRID_BAR();
#pragma nounroll
    for (int l = 0; l < NL; ++l) {
        gemm_proj(p, c);
        {
            const int first = (M / 256) * (DIN / 256) % (int)gridDim.x;
            __syncthreads();
            if ((int)blockIdx.x >= first) conv_weights<1>(p, c, l, ((int)blockIdx.x - first) * NWAVES + c.wave, ((int)gridDim.x - first) * NWAVES);
        }
        GRID_BAR();
        gemm_wa(p, c, l);
        gemm_gate(p, c);
        kv_prep(p, c, l);
        GRID_BAR();
        mfma_scan(p, c, l);
        __syncthreads();
        fast_attn(p, c, l);
        GRID_BAR();
        post_phase(p, c, l);
        GRID_BAR();
        gemm_merge(p, c);
        GRID_BAR();
        gemm_out(p, c);
        GRID_BAR();
        norm_phase<1>(p, c, l);
        GRID_BAR();
        gemm_up(p, c);
        GRID_BAR();
        gemm_down(p, c);
        GRID_BAR();
        norm_phase<2>(p, c, l);
        if (l + 1 < NL) { __syncthreads(); conv_weights<0>(p, c, l + 1, c.gw, c.ngw); GRID_BAR(); }
    }
}

extern "C" void kernel_launch(void* const* d_in, const int* in_sizes, int n_in, void* d_out, int out_size, void* d_ws, size_t ws_size, hipStream_t stream) {
    static int grid = 0;
    if (grid == 0) {
        if (n_in != 28 || (size_t)out_size != O_TOTAL || ws_size < WS_END) { fprintf(stderr, "kernel_launch: unexpected shapes n_in %d out %d ws %zu\n", n_in, out_size, ws_size); grid = -1; return; }
        int dev = 0, cus = 0;
        if (hipGetDevice(&dev) != hipSuccess || hipDeviceGetAttribute(&cus, hipDeviceAttributeMultiprocessorCount, dev) != hipSuccess) { grid = -1; return; }
        if (hipFuncSetAttribute((const void*)fwd_kernel, hipFuncAttributeMaxDynamicSharedMemorySize, LDS_BYTES) != hipSuccess) { fprintf(stderr, "kernel_launch: hipFuncSetAttribute failed\n"); grid = -1; return; }
        grid = cus;
    }
    if (grid < 0) return;
    (void)hipMemsetAsync((char*)d_ws + WS_CTL, 0, CTL_BYTES + MiB, stream);
    Params p{};
    for (int i = 0; i < 28; ++i) p.in[i] = (const float*)d_in[i];
    p.out = (float*)d_out; p.ws = (unsigned char*)d_ws;
    hipLaunchKernelGGL(fwd_kernel, dim3(grid), dim3(NTHREADS), LDS_BYTES, stream, p);
}
```
